# Optimizing an MI355X kernel written in HIP

```python
import jax, jax.numpy as jnp
from jax import lax
import numpy as np

D_MODEL = 2048
BATCH = 4
SEQ = 4096
DEPTH = 1

CHUNK = 64
D_MIX = D_MODEL
GMLP_WIDTH = D_MIX // 2
GMLP_HEADS = 8
GMLP_HEAD_DIM = GMLP_WIDTH // GMLP_HEADS
GMLP_BLOCK = 128
CONV_CH = D_MIX - GMLP_WIDTH
CONV_GROUPS = 8
CONV_K = 3
D_IN_PROJ = 2 * GMLP_WIDTH + 3 * CONV_CH
N_GROUPS = 4
EXPERTS_PER_GROUP = 8
N_EXPERTS = N_GROUPS * EXPERTS_PER_GROUP
TOP_K_IN_GROUP = 2
D_EXPERT = 512
MOE_BLOCK = 128
EPS = 1e-6

kernel_name = "hymba_gmlp_shortconv_hiermoe_block"


def rmsnorm(x, g):
    xf = x.astype(jnp.float32)
    y = xf * lax.rsqrt(jnp.mean(xf * xf, axis=-1, keepdims=True) + EPS)
    return (y * g.astype(jnp.float32)).astype(x.dtype)


def gmlp_mixer(u, v, v_norm_g, ws, bs):
    b_, s_, _ = v.shape
    nb = s_ // GMLP_BLOCK
    v = rmsnorm(v.reshape(b_, s_, GMLP_HEADS, GMLP_HEAD_DIM), v_norm_g.reshape(GMLP_HEADS, GMLP_HEAD_DIM))
    v = v.reshape(b_, nb, GMLP_BLOCK, GMLP_HEADS, GMLP_HEAD_DIM)
    pos = jnp.arange(GMLP_BLOCK)
    mask = (pos[:, None] // CHUNK) >= (pos[None, :] // CHUNK)
    w = jnp.where(mask[None], ws, 0).astype(v.dtype)
    mixed = jnp.einsum('hij,bnjhd->bnihd', w, v) + bs.T.astype(v.dtype)[None, None, :, :, None]
    return u * mixed.reshape(b_, s_, GMLP_WIDTH)


def conv_mixer(b_gate, c_gate, hv, conv_w):
    z = c_gate * hv
    s_ = z.shape[1]
    zp = jnp.pad(z, ((0, 0), (CONV_K - 1, 0), (0, 0)))
    conv = sum(conv_w[k] * zp[:, k:k + s_, :] for k in range(CONV_K))
    return b_gate * conv


def hier_moe(x, wgr, bgr, wer, ber, w_gate, w_up, w_down):
    t_ = x.shape[0]
    d_ = x.shape[1]
    p_g = jax.nn.softmax((x @ wgr + bgr).astype(jnp.float32), axis=-1)
    pg_top, g_idx = lax.top_k(p_g, 1)
    logits_e = (x @ wer + ber).astype(jnp.float32).reshape(t_, N_GROUPS, EXPERTS_PER_GROUP)
    le = jnp.take_along_axis(logits_e, g_idx[:, :, None], axis=1)[:, 0]
    q = jax.nn.softmax(le, axis=-1)
    q_top, e_local = lax.top_k(q, TOP_K_IN_GROUP)
    q_top = q_top / jnp.sum(q_top, axis=-1, keepdims=True)
    gate = pg_top * q_top
    expert = g_idx * EXPERTS_PER_GROUP + e_local

    n_assign = t_ * TOP_K_IN_GROUP
    e_flat = expert.reshape(n_assign)
    tok_flat = jnp.repeat(jnp.arange(t_, dtype=jnp.int32), TOP_K_IN_GROUP)
    w_flat = gate.reshape(n_assign)
    order = jnp.argsort(e_flat)
    e_s = e_flat[order]
    tok_s = tok_flat[order]
    w_s = w_flat[order]
    counts = jnp.bincount(e_flat, length=N_EXPERTS)
    start = jnp.cumsum(counts) - counts
    padded = (counts + MOE_BLOCK - 1) // MOE_BLOCK * MOE_BLOCK
    pad_end = jnp.cumsum(padded)
    pad_start = pad_end - padded
    dest = pad_start[e_s] + jnp.arange(n_assign) - start[e_s]
    n_blocks = -(-n_assign // MOE_BLOCK) + N_EXPERTS
    rows = n_blocks * MOE_BLOCK
    buf_tok = jnp.zeros((rows,), jnp.int32).at[dest].set(tok_s)
    buf_w = jnp.zeros((rows,), jnp.float32).at[dest].set(w_s)
    blk_expert = jnp.minimum(
        jnp.searchsorted(pad_end, jnp.arange(n_blocks) * MOE_BLOCK, side='right'), N_EXPERTS - 1)

    def run_block(args):
        toks, e = args
        xb = x[toks]
        hb = jax.nn.silu(xb @ w_gate[e]) * (xb @ w_up[e])
        return hb @ w_down[e]

    out = lax.map(run_block, (buf_tok.reshape(n_blocks, MOE_BLOCK), blk_expert))
    out = out.reshape(rows, d_) * buf_w[:, None].astype(x.dtype)
    return jnp.zeros_like(x).at[buf_tok].add(out)


def setup_inputs(seed: int = 0) -> dict:
    key = jax.random.key(seed)
    ks = jax.random.split(key, 24)
    L = DEPTH

    def nrm(k, shape, scale):
        return jax.random.normal(k, shape, jnp.float32) * scale

    def gain(k, shape):
        return 1.0 + nrm(k, shape, 0.02)

    return {
        'x': nrm(ks[0], (BATCH, SEQ, D_MODEL), 1.0),
        'norm_mix_g': gain(ks[1], (L, D_MODEL)),
        'w_in': nrm(ks[2], (L, D_MODEL, D_IN_PROJ), D_MODEL ** -0.5),
        'gmlp_v_norm_g': gain(ks[3], (L, GMLP_WIDTH)),
        'gmlp_ws': nrm(ks[4], (L, GMLP_HEADS, GMLP_BLOCK, GMLP_BLOCK), GMLP_BLOCK ** -0.5),
        'gmlp_bs': gain(ks[5], (L, GMLP_HEADS, GMLP_BLOCK)),
        'conv_w': nrm(ks[6], (L, CONV_K, CONV_CH), CONV_K ** -0.5),
        'out_norm_gmlp_g': gain(ks[7], (L, GMLP_WIDTH)),
        'out_norm_conv_g': gain(ks[8], (L, CONV_CH)),
        'w_out': nrm(ks[9], (L, D_MIX, D_MODEL), D_MIX ** -0.5),
        'norm_ffn_g': gain(ks[10], (L, D_MODEL)),
        'router_group_w': nrm(ks[11], (L, D_MODEL, N_GROUPS), D_MODEL ** -0.5),
        'router_group_b': nrm(ks[12], (L, N_GROUPS), 0.01),
        'router_expert_w': nrm(ks[13], (L, D_MODEL, N_EXPERTS), D_MODEL ** -0.5),
        'router_expert_b': nrm(ks[14], (L, N_EXPERTS), 0.01),
        'expert_w_gate': nrm(ks[15], (L, N_EXPERTS, D_MODEL, D_EXPERT), D_MODEL ** -0.5),
        'expert_w_up': nrm(ks[16], (L, N_EXPERTS, D_MODEL, D_EXPERT), D_MODEL ** -0.5),
        'expert_w_down': nrm(ks[17], (L, N_EXPERTS, D_EXPERT, D_MODEL), D_EXPERT ** -0.5),
        'norm_final_g': gain(ks[18], (D_MODEL,)),
    }


def reference(x, norm_mix_g, w_in, gmlp_v_norm_g, gmlp_ws, gmlp_bs, conv_w, out_norm_gmlp_g,
              out_norm_conv_g, w_out, norm_ffn_g, router_group_w, router_group_b, router_expert_w,
              router_expert_b, expert_w_gate, expert_w_up, expert_w_down, norm_final_g):
    b_, s_, d_ = x.shape
    splits = [GMLP_WIDTH, 2 * GMLP_WIDTH, 2 * GMLP_WIDTH + CONV_CH, 2 * GMLP_WIDTH + 2 * CONV_CH]
    h = x
    for l in range(DEPTH):
        xn = rmsnorm(h, norm_mix_g[l])
        proj = xn @ w_in[l]
        u, v, bg, cg, hv = jnp.split(proj, splits, axis=-1)
        ya = gmlp_mixer(jax.nn.gelu(u), jax.nn.gelu(v), gmlp_v_norm_g[l], gmlp_ws[l], gmlp_bs[l])
        yb = conv_mixer(bg, cg, hv, conv_w[l])
        y = jnp.concatenate([rmsnorm(ya, out_norm_gmlp_g[l]), rmsnorm(yb, out_norm_conv_g[l])], axis=-1)
        h = h + y @ w_out[l]
        hn = rmsnorm(h, norm_ffn_g[l]).reshape(b_ * s_, d_)
        m = hier_moe(hn, router_group_w[l], router_group_b[l], router_expert_w[l], router_expert_b[l],
                     expert_w_gate[l], expert_w_up[l], expert_w_down[l])
        h = h + m.reshape(b_, s_, d_)
    return rmsnorm(h, norm_final_g)
```

```cpp
#include <hip/hip_runtime.h>
#include <hip/hip_cooperative_groups.h>
#include <cstdio>
namespace cg = cooperative_groups;

typedef unsigned short bf16_t;
typedef float f32x4 __attribute__((ext_vector_type(4)));
typedef unsigned u32x4 __attribute__((ext_vector_type(4)));
typedef unsigned u32x2 __attribute__((ext_vector_type(2)));
typedef short bf16x8 __attribute__((ext_vector_type(8)));

constexpr int T_ = 16384, D_ = 2048, DIN = 5120, NE = 32, DE = 512, SEQ = 4096, LCAP = 16384;
constexpr float EPS = 1e-6f;
constexpr int NTHR = 512;
constexpr int LDS_BYTES = 147456;

constexpr size_t SZ_A = (size_t)T_ * DIN * 2;
constexpr size_t SZ_B = (size_t)T_ * D_ * 2;
constexpr size_t OFF_A = 0;
constexpr size_t OFF_B = OFF_A + SZ_A;
constexpr size_t OFF_HB = OFF_B + SZ_B;
constexpr size_t OFF_WIN = OFF_HB + SZ_B;
constexpr size_t OFF_WOUT = OFF_WIN + (size_t)DIN * D_ * 2;
constexpr size_t OFF_WGU = OFF_WOUT + (size_t)D_ * D_ * 2;
constexpr size_t OFF_WD = OFF_WGU + (size_t)NE * 1024 * D_ * 2;
constexpr size_t OFF_WR = OFF_WD + (size_t)NE * D_ * DE * 2;
constexpr size_t OFF_SSQ = OFF_WR + (size_t)48 * D_ * 2;
constexpr size_t OFF_CNT = OFF_SSQ + (size_t)3 * T_ * 4;
constexpr size_t OFF_RINFO = OFF_CNT + 256;
constexpr size_t OFF_RW = OFF_RINFO + (size_t)NE * LCAP * 4;
constexpr size_t WS_END = OFF_RW + (size_t)NE * LCAP * 4;

struct Params {
    const float *x, *norm_mix_g, *w_in, *v_norm_g, *gmlp_ws, *gmlp_bs, *conv_w, *g_a, *g_b, *w_out, *g_ffn, *rgw, *rgb, *rew, *reb, *ewg, *ewu, *ewd, *g_final;
    float* out; unsigned char* ws;
};

__device__ __forceinline__ unsigned cvt_pk_bf16(float lo, float hi) { unsigned r; asm volatile("v_cvt_pk_bf16_f32 %0, %1, %2" : "=v"(r) : "v"(lo), "v"(hi)); return r; }
__device__ __forceinline__ float bflo(unsigned w) { return __uint_as_float(w << 16); }
__device__ __forceinline__ float bfhi(unsigned w) { return __uint_as_float(w & 0xffff0000u); }
__device__ __forceinline__ float wave_sum(float v) {
#pragma unroll
    for (int o = 1; o < 64; o <<= 1) v += __shfl_xor(v, o);
    return v;
}
__device__ __forceinline__ float gelu_t(float x) {
    const float u = x * (0.7978845608f + 0.0356774081f * x * x);
    return x * __builtin_amdgcn_rcpf(1.f + __builtin_amdgcn_exp2f(-2.885390082f * u));
}
__device__ __forceinline__ float silu_f(float x) { return x * __builtin_amdgcn_rcpf(1.f + __builtin_amdgcn_exp2f(-1.442695041f * x)); }

struct Unit { int pm, pn, e, r0, pnl; };

__device__ __forceinline__ bool moe_unit(const int* cnt, int NT, int L, Unit& u) {
    int ptile = 0;
    for (int e = 0; e < NE; ++e) {
        const int nt = (cnt[e] + 255) >> 8, nu = nt * NT;
        if (L < nu) { const int mt = L / NT, j = L - mt * NT; u.e = e; u.pm = ptile + mt; u.r0 = mt * 256; u.pnl = j; u.pn = e * NT + j; return true; }
        L -= nu; ptile += nt;
    }
    return false;
}

struct Epi1 {
    static constexpr bool PERM = true, MIDSCALE = false;
    bf16_t* P;
    __device__ __forceinline__ void operator()(f32x4 (&acc)[2][2][4][2], const Unit& u, int wr, int wc, int fr, int fq) const {
        const bool act = u.pn < 8;
#pragma unroll
        for (int ai = 0; ai < 2; ++ai)
#pragma unroll
            for (int m = 0; m < 4; ++m) {
                const int row = u.pm * 256 + ai * 128 + wr * 64 + m * 16 + fr;
                bf16_t* rowp = P + (size_t)row * DIN + u.pn * 256 + wc * 32 + 8 * fq;
#pragma unroll
                for (int bj = 0; bj < 2; ++bj) {
                    f32x4 v0 = acc[ai][bj][m][0], v1 = acc[ai][bj][m][1];
                    if (act) {
#pragma unroll
                        for (int j = 0; j < 4; ++j) { v0[j] = gelu_t(v0[j]); v1[j] = gelu_t(v1[j]); }
                    }
                    u32x4 w; w.x = cvt_pk_bf16(v0[0], v0[1]); w.y = cvt_pk_bf16(v0[2], v0[3]); w.z = cvt_pk_bf16(v1[0], v1[1]); w.w = cvt_pk_bf16(v1[2], v1[3]);
                    *(u32x4*)(rowp + bj * 128) = w;
                }
            }
    }
};
struct Epi2 {
    static constexpr bool PERM = true, MIDSCALE = true;
    const float* x; bf16_t* hb; const float* ssq_a; const float* ssq_b; float* ssq_h;
    __device__ __forceinline__ void midscale(f32x4 (&acc)[2][2][4][2], const Unit& u, int wr, int wc, int fr, int fq) const {
#pragma unroll
        for (int ai = 0; ai < 2; ++ai)
#pragma unroll
            for (int m = 0; m < 4; ++m) {
                const int row = u.pm * 256 + ai * 128 + wr * 64 + m * 16 + fr;
                const float ra = rsqrtf(ssq_a[row] * (1.f / 1024.f) + EPS), rb = rsqrtf(ssq_b[row] * (1.f / 1024.f) + EPS);
                const float s = ra / rb;
#pragma unroll
                for (int bj = 0; bj < 2; ++bj)
#pragma unroll
                    for (int n = 0; n < 2; ++n) acc[ai][bj][m][n] *= s;
            }
    }
    __device__ __forceinline__ void operator()(f32x4 (&acc)[2][2][4][2], const Unit& u, int wr, int wc, int fr, int fq) const {
#pragma unroll
        for (int ai = 0; ai < 2; ++ai)
#pragma unroll
            for (int m = 0; m < 4; ++m) {
                const int row = u.pm * 256 + ai * 128 + wr * 64 + m * 16 + fr;
                const float rb = rsqrtf(ssq_b[row] * (1.f / 1024.f) + EPS);
                const size_t off = (size_t)row * D_ + u.pn * 256 + wc * 32 + 8 * fq;
                float ss = 0.f;
#pragma unroll
                for (int bj = 0; bj < 2; ++bj) {
                    const f32x4 x0 = *(const f32x4*)(x + off + bj * 128), x1 = *(const f32x4*)(x + off + bj * 128 + 4);
                    const f32x4 h0 = x0 + acc[ai][bj][m][0] * rb, h1 = x1 + acc[ai][bj][m][1] * rb;
                    ss += (h0[0] * h0[0] + h0[1] * h0[1]) + (h0[2] * h0[2] + h0[3] * h0[3]) + (h1[0] * h1[0] + h1[1] * h1[1]) + (h1[2] * h1[2] + h1[3] * h1[3]);
                    u32x4 w; w.x = cvt_pk_bf16(h0[0], h0[1]); w.y = cvt_pk_bf16(h0[2], h0[3]); w.z = cvt_pk_bf16(h1[0], h1[1]); w.w = cvt_pk_bf16(h1[2], h1[3]);
                    *(u32x4*)(hb + off + bj * 128) = w;
                }
                ss += __shfl_xor(ss, 16); ss += __shfl_xor(ss, 32);
                if (fq == 0) atomicAdd(ssq_h + row, ss);
            }
    }
};
struct Epi5 {
    static constexpr bool PERM = true, MIDSCALE = false;
    bf16_t* hbuf; const float* ssq_h; const int* rinfo; const int* cnt;
    __device__ __forceinline__ void operator()(f32x4 (&acc)[2][2][4][2], const Unit& u, int wr, int wc, int fr, int fq) const {
        const int ce = cnt[u.e];
#pragma unroll
        for (int ai = 0; ai < 2; ++ai)
#pragma unroll
            for (int m = 0; m < 4; ++m) {
                const int r = ai * 128 + wr * 64 + m * 16 + fr, i = u.r0 + r;
                const int tok = (i < ce) ? (rinfo[u.e * LCAP + i] >> 1) : 0;
                const float rs = rsqrtf(ssq_h[tok] * (1.f / 2048.f) + EPS);
                float o[8];
#pragma unroll
                for (int n = 0; n < 2; ++n)
#pragma unroll
                    for (int j = 0; j < 4; ++j) o[4 * n + j] = silu_f(acc[ai][0][m][n][j] * rs) * (acc[ai][1][m][n][j] * rs);
                u32x4 w; w.x = cvt_pk_bf16(o[0], o[1]); w.y = cvt_pk_bf16(o[2], o[3]); w.z = cvt_pk_bf16(o[4], o[5]); w.w = cvt_pk_bf16(o[6], o[7]);
                *(u32x4*)(hbuf + (size_t)(u.pm * 256 + r) * DE + u.pnl * 128 + wc * 32 + 8 * fq) = w;
            }
    }
};
struct Epi6 {
    static constexpr bool PERM = true, MIDSCALE = false;
    bf16_t* ys2; const int* rinfo; const float* rw; const int* cnt;
    __device__ __forceinline__ void operator()(f32x4 (&acc)[2][2][4][2], const Unit& u, int wr, int wc, int fr, int fq) const {
        const int ce = cnt[u.e];
#pragma unroll
        for (int ai = 0; ai < 2; ++ai)
#pragma unroll
            for (int m = 0; m < 4; ++m) {
                const int r = ai * 128 + wr * 64 + m * 16 + fr, i = u.r0 + r;
                if (i < ce) {
                    const int info = rinfo[u.e * LCAP + i]; const float g = rw[u.e * LCAP + i];
                    bf16_t* dst = ys2 + (size_t)info * D_ + u.pnl * 256 + wc * 32 + 8 * fq;
#pragma unroll
                    for (int bj = 0; bj < 2; ++bj) {
                        const f32x4 v0 = acc[ai][bj][m][0] * g, v1 = acc[ai][bj][m][1] * g;
                        u32x4 w; w.x = cvt_pk_bf16(v0[0], v0[1]); w.y = cvt_pk_bf16(v0[2], v0[3]); w.z = cvt_pk_bf16(v1[0], v1[1]); w.w = cvt_pk_bf16(v1[2], v1[3]);
                        *(u32x4*)(dst + bj * 128) = w;
                    }
                }
            }
    }
};

struct ASrcDirect { const bf16_t* A; int K; __device__ __forceinline__ const bf16_t* row(const Unit& u, int r) const { return A + (size_t)(u.pm * 256 + r) * K; } };
struct ASrcGather { const bf16_t* A; const int* rinfo; const int* cnt;
    __device__ __forceinline__ const bf16_t* row(const Unit& u, int r) const { const int i = u.r0 + r; const int tok = (i < cnt[u.e]) ? (rinfo[u.e * LCAP + i] >> 1) : 0; return A + (size_t)tok * D_; } };

template <class Epi, class ASrc>
__device__ void gemm_simple_unit(unsigned char* lds, const ASrc& AS, const bf16_t* Bt, int K, const Epi& E, const Unit& u) {
    float* As = (float*)lds; float* Bs = As + 32 * 256;
    const int tid = threadIdx.x, wid = tid >> 6, lane = tid & 63, wr = wid >> 2, wc = wid & 3, fr = lane & 15, fq = lane >> 4;
    f32x4 acc[2][2][4][2];
#pragma unroll
    for (int a = 0; a < 2; ++a)
#pragma unroll
        for (int b = 0; b < 2; ++b)
#pragma unroll
            for (int m = 0; m < 4; ++m)
#pragma unroll
                for (int n = 0; n < 2; ++n) acc[a][b][m][n] = (f32x4){0.f, 0.f, 0.f, 0.f};
    const bf16_t* ap[2]; const bf16_t* bp[2]; int lrow[2], lkc[2];
#pragma unroll
    for (int i = 0; i < 2; ++i) { const int p = tid + 512 * i; lrow[i] = p >> 2; lkc[i] = (p & 3) * 8; ap[i] = AS.row(u, lrow[i]) + lkc[i]; bp[i] = Bt + (size_t)lrow[i] * K + lkc[i]; }
    for (int k0 = 0; k0 < K; k0 += 32) {
        if constexpr (Epi::MIDSCALE) { if (k0 == K / 2) E.midscale(acc, u, wr, wc, fr, fq); }
        __syncthreads();
#pragma unroll
        for (int i = 0; i < 2; ++i) {
            const u32x4 a = *(const u32x4*)(ap[i] + k0), b = *(const u32x4*)(bp[i] + k0);
#pragma unroll
            for (int q = 0; q < 4; ++q) {
                As[(lkc[i] + 2 * q) * 256 + lrow[i]] = bflo(a[q]); As[(lkc[i] + 2 * q + 1) * 256 + lrow[i]] = bfhi(a[q]);
                Bs[(lkc[i] + 2 * q) * 256 + lrow[i]] = bflo(b[q]); Bs[(lkc[i] + 2 * q + 1) * 256 + lrow[i]] = bfhi(b[q]);
            }
        }
        __syncthreads();
#pragma unroll 2
        for (int k = 0; k < 32; ++k) {
            float a[2][4]; f32x4 b[2][2];
#pragma unroll
            for (int ai = 0; ai < 2; ++ai)
#pragma unroll
                for (int m = 0; m < 4; ++m) a[ai][m] = As[k * 256 + ai * 128 + wr * 64 + m * 16 + fr];
#pragma unroll
            for (int bj = 0; bj < 2; ++bj)
#pragma unroll
                for (int n = 0; n < 2; ++n) b[bj][n] = *(const f32x4*)&Bs[k * 256 + bj * 128 + wc * 32 + (Epi::PERM ? (8 * fq + 4 * n) : (16 * n + 4 * fq))];
#pragma unroll
            for (int ai = 0; ai < 2; ++ai)
#pragma unroll
                for (int bj = 0; bj < 2; ++bj)
#pragma unroll
                    for (int m = 0; m < 4; ++m)
#pragma unroll
                        for (int n = 0; n < 2; ++n) acc[ai][bj][m][n] += a[ai][m] * b[bj][n];
        }
    }
    E(acc, u, wr, wc, fr, fq);
    __syncthreads();
}

__device__ void transpose_tile(float* lt, const float* src, int ldsrc, int r0, int c0, bf16_t* dst, int lddst, int dr0, const float* sA, const float* sB, int split) {
    const int tid = threadIdx.x;
    { const int r = tid >> 3, cc = (tid & 7) * 8;
      const float* s = src + (size_t)(r0 + r) * ldsrc + c0 + cc;
      const f32x4 v0 = *(const f32x4*)s, v1 = *(const f32x4*)(s + 4);
      float sc = 1.f; if (sA) { const int rr = r0 + r; sc = rr < split ? sA[rr] : sB[rr - split]; }
#pragma unroll
      for (int q = 0; q < 4; ++q) { lt[r * 65 + cc + q] = v0[q] * sc; lt[r * 65 + cc + 4 + q] = v1[q] * sc; } }
    __syncthreads();
    { const int c = tid >> 3, rr = (tid & 7) * 8;
      float v[8];
#pragma unroll
      for (int q = 0; q < 8; ++q) v[q] = lt[(rr + q) * 65 + c];
      u32x4 w; w.x = cvt_pk_bf16(v[0], v[1]); w.y = cvt_pk_bf16(v[2], v[3]); w.z = cvt_pk_bf16(v[4], v[5]); w.w = cvt_pk_bf16(v[6], v[7]);
      *(u32x4*)(dst + (size_t)(dr0 + c) * lddst + r0 + rr) = w; }
    __syncthreads();
}
__device__ void phase0(const Params& p, unsigned char* lds) {
    const int tid = threadIdx.x, nb = gridDim.x, bid = blockIdx.x, wid = tid >> 6, lane = tid & 63;
    { float* z = (float*)(p.ws + OFF_SSQ);
      for (int i = bid * NTHR + tid; i < 3 * T_ + 64; i += nb * NTHR) z[i] = 0.f; }
    { bf16_t* wrt = (bf16_t*)(p.ws + OFF_WR);
      for (int i = bid * NTHR + tid; i < 48 * D_; i += nb * NTHR) {
          const int o = i >> 11, k = i & 2047; float v = 0.f;
          if (o < 4) v = p.rgw[k * 4 + o]; else if (o < 36) v = p.rew[k * 32 + (o - 4)];
          wrt[i] = (bf16_t)(cvt_pk_bf16(v * p.g_ffn[k], 0.f) & 0xffffu); } }
    { bf16_t* xn = (bf16_t*)(p.ws + OFF_B);
      for (int row = bid * 8 + wid; row < T_; row += nb * 8) {
          const float* xr = p.x + (size_t)row * D_;
          f32x4 v[8]; float s = 0.f;
#pragma unroll
          for (int i = 0; i < 8; ++i) { v[i] = *(const f32x4*)(xr + i * 256 + lane * 4); s += (v[i][0] * v[i][0] + v[i][1] * v[i][1]) + (v[i][2] * v[i][2] + v[i][3] * v[i][3]); }
          const float rstd = rsqrtf(wave_sum(s) * (1.f / D_) + EPS);
#pragma unroll
          for (int i = 0; i < 8; ++i) { const f32x4 g = *(const f32x4*)(p.norm_mix_g + i * 256 + lane * 4); const f32x4 o = v[i] * rstd * g;
              u32x2 w; w.x = cvt_pk_bf16(o[0], o[1]); w.y = cvt_pk_bf16(o[2], o[3]); *(u32x2*)(xn + (size_t)row * D_ + i * 256 + lane * 4) = w; } } }
    float* lt = (float*)lds;
    constexpr int N_IN = 32 * 80, N_OUT = 32 * 32, N_G = 32 * 256, N_TOT = N_IN + N_OUT + 3 * N_G;
    for (int tile = bid; tile < N_TOT; tile += nb) {
        int q = tile;
        if (q < N_IN) { const int tr = q / 80, tc = q % 80; transpose_tile(lt, p.w_in, DIN, tr * 64, tc * 64, (bf16_t*)(p.ws + OFF_WIN), D_, tc * 64, nullptr, nullptr, 0); continue; } q -= N_IN;
        if (q < N_OUT) { const int tr = q / 32, tc = q % 32; transpose_tile(lt, p.w_out, D_, tr * 64, tc * 64, (bf16_t*)(p.ws + OFF_WOUT), D_, tc * 64, p.g_a, p.g_b, 1024); continue; } q -= N_OUT;
        if (q < 2 * N_G) { const int up = q >= N_G; if (up) q -= N_G; const int e = q >> 8, rem = q & 255, tr = rem >> 3, tc = rem & 7; const int c0 = tc * 64;
            transpose_tile(lt, (up ? p.ewu : p.ewg) + (size_t)e * D_ * DE, DE, tr * 64, c0, (bf16_t*)(p.ws + OFF_WGU) + (size_t)e * 1024 * D_, D_, (c0 >> 7) * 256 + (up ? 128 : 0) + (c0 & 127), p.g_ffn, p.g_ffn, 1 << 30); continue; } q -= 2 * N_G;
        { const int e = q >> 8, rem = q & 255, tr = rem >> 5, tc = rem & 31;
          transpose_tile(lt, p.ewd + (size_t)e * DE * D_, D_, tr * 64, tc * 64, (bf16_t*)(p.ws + OFF_WD) + (size_t)e * D_ * DE, DE, tc * 64, nullptr, nullptr, 0); }
    }
}

__device__ void phase1(const Params& p, unsigned char* lds) {
    const ASrcDirect AS{(const bf16_t*)(p.ws + OFF_B), D_}; const Epi1 E{(bf16_t*)(p.ws + OFF_A)};
    const bf16_t* Bt = (const bf16_t*)(p.ws + OFF_WIN);
    for (int L = blockIdx.x; L < 64 * 20; L += gridDim.x) { Unit u; u.pm = L / 20; u.pn = L % 20; u.e = 0; u.r0 = 0; u.pnl = u.pn;
        gemm_simple_unit(lds, AS, Bt + (size_t)u.pn * 256 * D_, D_, E, u); }
}

__device__ void mixer_gmlp_item(const Params& p, unsigned char* lds, int item) {
    const int tid = threadIdx.x, wid = tid >> 6, lane = tid & 63, fr = lane & 15, fq = lane >> 4;
    const int h = item & 7, t0 = (item >> 3) * 128;
    const bf16_t* P = (const bf16_t*)(p.ws + OFF_A); bf16_t* Y = (bf16_t*)(p.ws + OFF_B); float* ssq_a = (float*)(p.ws + OFF_SSQ);
    bf16_t* Vt = (bf16_t*)lds;
    bf16_t* Wl = Vt + 128 * 136;
    float* rs = (float*)(Wl + 128 * 136);
    { const int j = tid >> 2, dc = (tid & 3) * 32;
      const u32x4* src = (const u32x4*)(P + (size_t)(t0 + j) * DIN + 1024 + h * 128 + dc);
      u32x4 v[4]; float s = 0.f;
#pragma unroll
      for (int q = 0; q < 4; ++q) { v[q] = src[q];
#pragma unroll
          for (int w = 0; w < 4; ++w) { const float lo = bflo(v[q][w]), hi = bfhi(v[q][w]); s += lo * lo + hi * hi; } }
      s += __shfl_xor(s, 1); s += __shfl_xor(s, 2);
      if ((tid & 3) == 0) rs[j] = rsqrtf(s * (1.f / 128.f) + EPS);
#pragma unroll
      for (int q = 0; q < 4; ++q)
#pragma unroll
          for (int w = 0; w < 4; ++w) { const int d = dc + q * 8 + w * 2; Vt[d * 136 + j] = (bf16_t)(v[q][w] & 0xffffu); Vt[(d + 1) * 136 + j] = (bf16_t)(v[q][w] >> 16); } }
    __syncthreads();
    { const int i = tid >> 2, jc = (tid & 3) * 32;
      const f32x4* src = (const f32x4*)(p.gmlp_ws + (size_t)h * 16384 + i * 128 + jc);
      const bool live = (i >> 6) >= (jc >> 6);
#pragma unroll
      for (int q = 0; q < 4; ++q) { f32x4 w0 = src[2 * q], w1 = src[2 * q + 1];
          const f32x4 r0 = *(const f32x4*)(rs + jc + 8 * q), r1 = *(const f32x4*)(rs + jc + 8 * q + 4);
          w0 = live ? w0 * r0 : (f32x4){0.f, 0.f, 0.f, 0.f}; w1 = live ? w1 * r1 : (f32x4){0.f, 0.f, 0.f, 0.f};
          u32x4 o; o.x = cvt_pk_bf16(w0[0], w0[1]); o.y = cvt_pk_bf16(w0[2], w0[3]); o.z = cvt_pk_bf16(w1[0], w1[1]); o.w = cvt_pk_bf16(w1[2], w1[3]);
          *(u32x4*)(Wl + i * 136 + jc + 8 * q) = o; } }
    __syncthreads();
    f32x4 acc[8];
#pragma unroll
    for (int n = 0; n < 8; ++n) acc[n] = (f32x4){0.f, 0.f, 0.f, 0.f};
    const int ksteps = (wid < 4) ? 2 : 4;
    for (int ks = 0; ks < ksteps; ++ks) {
        const bf16x8 bw = *(const bf16x8*)(Wl + (16 * wid + fr) * 136 + ks * 32 + fq * 8);
#pragma unroll
        for (int n = 0; n < 8; ++n) { const bf16x8 av = *(const bf16x8*)(Vt + (16 * n + fr) * 136 + ks * 32 + fq * 8);
            acc[n] = __builtin_amdgcn_mfma_f32_16x16x32_bf16(av, bw, acc[n], 0, 0, 0); }
    }
    { const int i = 16 * wid + fr, t = t0 + i; const float bias = p.gmlp_bs[h * 128 + i]; float ss = 0.f;
#pragma unroll
      for (int n = 0; n < 8; ++n) { const int c = h * 128 + 16 * n + 4 * fq;
          const f32x4 g = *(const f32x4*)(p.v_norm_g + c); const u32x2 uu = *(const u32x2*)(P + (size_t)t * DIN + c);
          const float y0 = bflo(uu.x) * (acc[n][0] * g[0] + bias), y1 = bfhi(uu.x) * (acc[n][1] * g[1] + bias), y2 = bflo(uu.y) * (acc[n][2] * g[2] + bias), y3 = bfhi(uu.y) * (acc[n][3] * g[3] + bias);
          ss += (y0 * y0 + y1 * y1) + (y2 * y2 + y3 * y3);
          u32x2 w; w.x = cvt_pk_bf16(y0, y1); w.y = cvt_pk_bf16(y2, y3); *(u32x2*)(Y + (size_t)t * D_ + c) = w; }
      ss += __shfl_xor(ss, 16); ss += __shfl_xor(ss, 32);
      if (fq == 0) atomicAdd(ssq_a + t, ss); }
    __syncthreads();
}
__device__ void mixer_conv_item(const Params& p, int item) {
    const int tid = threadIdx.x, cl = tid & 31, ts = tid >> 5;
    const int c = (item & 3) * 256 + cl * 8, tbeg = (item >> 2) * 128 + ts * 8;
    const bf16_t* P = (const bf16_t*)(p.ws + OFF_A); bf16_t* Y = (bf16_t*)(p.ws + OFF_B); float* ssq_b = (float*)(p.ws + OFF_SSQ) + T_;
    float w0[8], w1[8], w2[8], z1[8], z2[8];
    { const f32x4 a0 = *(const f32x4*)(p.conv_w + c), a1 = *(const f32x4*)(p.conv_w + c + 4), b0 = *(const f32x4*)(p.conv_w + 1024 + c), b1 = *(const f32x4*)(p.conv_w + 1024 + c + 4),
                  c0 = *(const f32x4*)(p.conv_w + 2048 + c), c1 = *(const f32x4*)(p.conv_w + 2048 + c + 4);
#pragma unroll
      for (int q = 0; q < 4; ++q) { w0[q] = a0[q]; w0[4 + q] = a1[q]; w1[q] = b0[q]; w1[4 + q] = b1[q]; w2[q] = c0[q]; w2[4 + q] = c1[q]; } }
#pragma unroll
    for (int q = 0; q < 8; ++q) { z1[q] = 0.f; z2[q] = 0.f; }
    if ((tbeg % SEQ) != 0) {
        const u32x4 ca = *(const u32x4*)(P + (size_t)(tbeg - 1) * DIN + 3072 + c), ha = *(const u32x4*)(P + (size_t)(tbeg - 1) * DIN + 4096 + c);
        const u32x4 cb = *(const u32x4*)(P + (size_t)(tbeg - 2) * DIN + 3072 + c), hb2 = *(const u32x4*)(P + (size_t)(tbeg - 2) * DIN + 4096 + c);
#pragma unroll
        for (int q = 0; q < 4; ++q) { z1[2 * q] = bflo(ca[q]) * bflo(ha[q]); z1[2 * q + 1] = bfhi(ca[q]) * bfhi(ha[q]); z2[2 * q] = bflo(cb[q]) * bflo(hb2[q]); z2[2 * q + 1] = bfhi(cb[q]) * bfhi(hb2[q]); }
    }
    for (int tt = 0; tt < 8; ++tt) {
        const int t = tbeg + tt; const bf16_t* pr = P + (size_t)t * DIN + c;
        const u32x4 bg = *(const u32x4*)(pr + 2048), cgv = *(const u32x4*)(pr + 3072), hv = *(const u32x4*)(pr + 4096);
        float z[8], y[8], ss = 0.f;
#pragma unroll
        for (int q = 0; q < 4; ++q) { z[2 * q] = bflo(cgv[q]) * bflo(hv[q]); z[2 * q + 1] = bfhi(cgv[q]) * bfhi(hv[q]); }
#pragma unroll
        for (int q = 0; q < 4; ++q) {
            y[2 * q] = bflo(bg[q]) * (w0[2 * q] * z2[2 * q] + w1[2 * q] * z1[2 * q] + w2[2 * q] * z[2 * q]);
            y[2 * q + 1] = bfhi(bg[q]) * (w0[2 * q + 1] * z2[2 * q + 1] + w1[2 * q + 1] * z1[2 * q + 1] + w2[2 * q + 1] * z[2 * q + 1]); }
#pragma unroll
        for (int q = 0; q < 8; ++q) { ss += y[q] * y[q]; z2[q] = z1[q]; z1[q] = z[q]; }
        u32x4 w; w.x = cvt_pk_bf16(y[0], y[1]); w.y = cvt_pk_bf16(y[2], y[3]); w.z = cvt_pk_bf16(y[4], y[5]); w.w = cvt_pk_bf16(y[6], y[7]);
        *(u32x4*)(Y + (size_t)t * D_ + 1024 + c) = w;
        ss += __shfl_xor(ss, 1); ss += __shfl_xor(ss, 2); ss += __shfl_xor(ss, 4); ss += __shfl_xor(ss, 8); ss += __shfl_xor(ss, 16);
        if (cl == 0) atomicAdd(ssq_b + t, ss);
    }
}
__device__ void phase2(const Params& p, unsigned char* lds) {
    for (int it = blockIdx.x; it < 512 + 1024; it += gridDim.x) { if (it < 512) mixer_conv_item(p, it); else mixer_gmlp_item(p, lds, it - 512); }
}

__device__ void phase3(const Params& p, unsigned char* lds) {
    const ASrcDirect AS{(const bf16_t*)(p.ws + OFF_B), D_};
    float* ssq = (float*)(p.ws + OFF_SSQ);
    const Epi2 E{p.x, (bf16_t*)(p.ws + OFF_HB), ssq, ssq + T_, ssq + 2 * T_};
    const bf16_t* Bt = (const bf16_t*)(p.ws + OFF_WOUT);
    for (int L = blockIdx.x; L < 64 * 8; L += gridDim.x) { Unit u; u.pm = L / 8; u.pn = L % 8; u.e = 0; u.r0 = 0; u.pnl = u.pn;
        gemm_simple_unit(lds, AS, Bt + (size_t)u.pn * 256 * D_, D_, E, u); }
}

__device__ void route_item(const Params& p, unsigned char* lds, int item) {
    const int tid = threadIdx.x, wid = tid >> 6, lane = tid & 63, fr = lane & 15, fq = lane >> 4;
    float* lg = (float*)lds;
    int* lcnt = (int*)(lg + 8 * 16 * 48); int* lbase = lcnt + 32;
    const bf16_t* hb = (const bf16_t*)(p.ws + OFF_HB); const bf16_t* wrt = (const bf16_t*)(p.ws + OFF_WR);
    const float* ssq_h = (const float*)(p.ws + OFF_SSQ) + 2 * T_;
    int* cnt = (int*)(p.ws + OFF_CNT); int* rinfo = (int*)(p.ws + OFF_RINFO); float* rw = (float*)(p.ws + OFF_RW);
    const int tw = item * 128 + wid * 16;
    if (tid < 32) lcnt[tid] = 0;
    f32x4 acc[3];
#pragma unroll
    for (int n = 0; n < 3; ++n) acc[n] = (f32x4){0.f, 0.f, 0.f, 0.f};
    const bf16_t* ap = hb + (size_t)(tw + fr) * D_ + fq * 8; const bf16_t* bp = wrt + (size_t)fr * D_ + fq * 8;
#pragma unroll 4
    for (int ks = 0; ks < 64; ++ks) { const bf16x8 a = *(const bf16x8*)(ap + ks * 32);
#pragma unroll
        for (int n = 0; n < 3; ++n) { const bf16x8 b = *(const bf16x8*)(bp + (size_t)n * 16 * D_ + ks * 32); acc[n] = __builtin_amdgcn_mfma_f32_16x16x32_bf16(a, b, acc[n], 0, 0, 0); } }
#pragma unroll
    for (int n = 0; n < 3; ++n)
#pragma unroll
        for (int j = 0; j < 4; ++j) lg[(wid * 16 + 4 * fq + j) * 48 + 16 * n + fr] = acc[n][j];
    __syncthreads();
    int e0 = 0, e1 = 0, r0 = 0, r1 = 0; float g0 = 0.f, g1 = 0.f; const int t = tw + lane;
    if (lane < 16) {
        const float* l = lg + (wid * 16 + lane) * 48; const float rstd = rsqrtf(ssq_h[t] * (1.f / D_) + EPS);
        float gm = -3.0e38f; int gi = 0; float gl[4];
#pragma unroll
        for (int o = 0; o < 4; ++o) { gl[o] = l[o] * rstd + p.rgb[o]; if (gl[o] > gm) { gm = gl[o]; gi = o; } }
        float gs = 0.f;
#pragma unroll
        for (int o = 0; o < 4; ++o) gs += __expf(gl[o] - gm);
        const float pg = 1.f / gs;
        float b1 = -3.0e38f, b2 = -3.0e38f; int i1 = 0, i2 = 0;
        for (int q = 0; q < 8; ++q) { const float v = l[4 + gi * 8 + q] * rstd + p.reb[gi * 8 + q];
            if (v > b1) { b2 = b1; i2 = i1; b1 = v; i1 = q; } else if (v > b2) { b2 = v; i2 = q; } }
        const float wa = 1.f / (1.f + __expf(b2 - b1));
        e0 = gi * 8 + i1; e1 = gi * 8 + i2; g0 = pg * wa; g1 = pg * (1.f - wa);
        r0 = atomicAdd(&lcnt[e0], 1); r1 = atomicAdd(&lcnt[e1], 1);
    }
    __syncthreads();
    if (tid < 32) lbase[tid] = atomicAdd(cnt + tid, lcnt[tid]);
    __syncthreads();
    if (lane < 16) { const int i0 = lbase[e0] + r0, i1 = lbase[e1] + r1;
        rinfo[e0 * LCAP + i0] = 2 * t; rw[e0 * LCAP + i0] = g0; rinfo[e1 * LCAP + i1] = 2 * t + 1; rw[e1 * LCAP + i1] = g1; }
    __syncthreads();
}
__device__ void phase4(const Params& p, unsigned char* lds) { for (int it = blockIdx.x; it < T_ / 128; it += gridDim.x) route_item(p, lds, it); }

__device__ void phase5(const Params& p, unsigned char* lds) {
    const int* cnt = (const int*)(p.ws + OFF_CNT); const int* rinfo = (const int*)(p.ws + OFF_RINFO);
    const ASrcGather AS{(const bf16_t*)(p.ws + OFF_HB), rinfo, cnt};
    const Epi5 E{(bf16_t*)(p.ws + OFF_B), (const float*)(p.ws + OFF_SSQ) + 2 * T_, rinfo, cnt};
    const bf16_t* Bt = (const bf16_t*)(p.ws + OFF_WGU);
    for (int L = blockIdx.x;; L += gridDim.x) { Unit u; if (!moe_unit(cnt, 4, L, u)) break; gemm_simple_unit(lds, AS, Bt + (size_t)u.pn * 256 * D_, D_, E, u); }
}
__device__ void phase6(const Params& p, unsigned char* lds) {
    const int* cnt = (const int*)(p.ws + OFF_CNT); const int* rinfo = (const int*)(p.ws + OFF_RINFO);
    const ASrcDirect AS{(const bf16_t*)(p.ws + OFF_B), DE};
    const Epi6 E{(bf16_t*)(p.ws + OFF_A), rinfo, (const float*)(p.ws + OFF_RW), cnt};
    const bf16_t* Bt = (const bf16_t*)(p.ws + OFF_WD);
    for (int L = blockIdx.x;; L += gridDim.x) { Unit u; if (!moe_unit(cnt, 8, L, u)) break; gemm_simple_unit(lds, AS, Bt + (size_t)u.pn * 256 * DE, DE, E, u); }
}
__device__ void phase7(const Params& p) {
    const int tid = threadIdx.x, wid = tid >> 6, lane = tid & 63;
    const bf16_t* hb = (const bf16_t*)(p.ws + OFF_HB); const bf16_t* ys2 = (const bf16_t*)(p.ws + OFF_A);
    for (int t = blockIdx.x * 8 + wid; t < T_; t += gridDim.x * 8) {
        float v[4][8]; float s = 0.f;
#pragma unroll
        for (int i = 0; i < 4; ++i) { const int c = i * 512 + lane * 8;
            const u32x4 a = *(const u32x4*)(hb + (size_t)t * D_ + c), b = *(const u32x4*)(ys2 + (size_t)(2 * t) * D_ + c), d = *(const u32x4*)(ys2 + (size_t)(2 * t + 1) * D_ + c);
#pragma unroll
            for (int q = 0; q < 4; ++q) { v[i][2 * q] = bflo(a[q]) + bflo(b[q]) + bflo(d[q]); v[i][2 * q + 1] = bfhi(a[q]) + bfhi(b[q]) + bfhi(d[q]); s += v[i][2 * q] * v[i][2 * q] + v[i][2 * q + 1] * v[i][2 * q + 1]; } }
        const float rstd = rsqrtf(wave_sum(s) * (1.f / D_) + EPS);
#pragma unroll
        for (int i = 0; i < 4; ++i) { const int c = i * 512 + lane * 8;
            const f32x4 g0 = *(const f32x4*)(p.g_final + c), g1 = *(const f32x4*)(p.g_final + c + 4);
            f32x4 o0, o1;
#pragma unroll
            for (int q = 0; q < 4; ++q) { o0[q] = v[i][q] * rstd * g0[q]; o1[q] = v[i][4 + q] * rstd * g1[q]; }
            *(f32x4*)(p.out + (size_t)t * D_ + c) = o0; *(f32x4*)(p.out + (size_t)t * D_ + c + 4) = o1; }
    }
}

template <int PH> __global__ void __launch_bounds__(NTHR, 2) k_phase(Params p) {
    extern __shared__ __attribute__((aligned(16))) unsigned char lds[];
    if (PH == 0) phase0(p, lds);
    if (PH == 1) phase1(p, lds);
    if (PH == 2) phase2(p, lds);
    if (PH == 3) phase3(p, lds);
    if (PH == 4) phase4(p, lds);
    if (PH == 5) phase5(p, lds);
    if (PH == 6) phase6(p, lds);
    if (PH == 7) phase7(p);
}

extern "C" void kernel_launch(void* const* d_in, const int* in_sizes, int n_in, void* d_out, int out_size, void* d_ws, size_t ws_size, hipStream_t stream) {
    static int grid = 0;
    if (grid == 0) {
        if (n_in != 19 || in_sizes[0] != T_ * D_ || out_size != T_ * D_ || ws_size < WS_END) { fprintf(stderr, "kernel_launch: unexpected shapes (n_in %d, in0 %d, out %d, ws %zu < %zu); nothing launched\n", n_in, n_in > 0 ? in_sizes[0] : -1, out_size, ws_size, (size_t)WS_END); grid = -1; return; }
        int dev = 0, cus = 0;
        if (hipGetDevice(&dev) != hipSuccess || hipDeviceGetAttribute(&cus, hipDeviceAttributeMultiprocessorCount, dev) != hipSuccess) { grid = -1; return; }
        (void)hipFuncSetAttribute((const void*)k_phase<0>, hipFuncAttributeMaxDynamicSharedMemorySize, LDS_BYTES);
        (void)hipFuncSetAttribute((const void*)k_phase<1>, hipFuncAttributeMaxDynamicSharedMemorySize, LDS_BYTES);
        (void)hipFuncSetAttribute((const void*)k_phase<2>, hipFuncAttributeMaxDynamicSharedMemorySize, LDS_BYTES);
        (void)hipFuncSetAttribute((const void*)k_phase<3>, hipFuncAttributeMaxDynamicSharedMemorySize, LDS_BYTES);
        (void)hipFuncSetAttribute((const void*)k_phase<4>, hipFuncAttributeMaxDynamicSharedMemorySize, LDS_BYTES);
        (void)hipFuncSetAttribute((const void*)k_phase<5>, hipFuncAttributeMaxDynamicSharedMemorySize, LDS_BYTES);
        (void)hipFuncSetAttribute((const void*)k_phase<6>, hipFuncAttributeMaxDynamicSharedMemorySize, LDS_BYTES);
        (void)hipFuncSetAttribute((const void*)k_phase<7>, hipFuncAttributeMaxDynamicSharedMemorySize, LDS_BYTES);
        grid = cus > 0 ? cus : 256;
    }
    if (grid < 0) return;
    Params p{};
    const float** f = (const float**)&p;
    for (int i = 0; i < 19; ++i) f[i] = (const float*)d_in[i];
    p.out = (float*)d_out; p.ws = (unsigned char*)d_ws;
    hipLaunchKernelGGL(k_phase<0>, dim3(grid), dim3(NTHR), LDS_BYTES, stream, p);
    hipLaunchKernelGGL(k_phase<1>, dim3(grid), dim3(NTHR), LDS_BYTES, stream, p);
    hipLaunchKernelGGL(k_phase<2>, dim3(grid), dim3(NTHR), LDS_BYTES, stream, p);
    hipLaunchKernelGGL(k_phase<3>, dim3(grid), dim3(NTHR), LDS_BYTES, stream, p);
    hipLaunchKernelGGL(k_phase<4>, dim3(grid), dim3(NTHR), LDS_BYTES, stream, p);
    hipLaunchKernelGGL(k_phase<5>, dim3(grid), dim3(NTHR), LDS_BYTES, stream, p);
    hipLaunchKernelGGL(k_phase<6>, dim3(grid), dim3(NTHR), LDS_BYTES, stream, p);
    hipLaunchKernelGGL(k_phase<7>, dim3(grid), dim3(NTHR), LDS_BYTES, stream, p);
}
```

```cpp
#include <hip/hip_runtime.h>
#include <hip/hip_cooperative_groups.h>
#include <cstdio>
namespace cg = cooperative_groups;

typedef unsigned short bf16_t;
typedef float f32x4 __attribute__((ext_vector_type(4)));
typedef unsigned u32x4 __attribute__((ext_vector_type(4)));
typedef unsigned u32x2 __attribute__((ext_vector_type(2)));
typedef short bf16x8 __attribute__((ext_vector_type(8)));

constexpr int T_ = 16384, D_ = 2048, DIN = 5120, NE = 32, DE = 512, SEQ = 4096, LCAP = 16384;
constexpr float EPS = 1e-6f;
constexpr int NTHR = 512;
constexpr int LDS_BYTES = 147456;

constexpr size_t SZ_A = (size_t)T_ * DIN * 2;
constexpr size_t SZ_B = (size_t)T_ * D_ * 2;
constexpr size_t OFF_A = 0;
constexpr size_t OFF_B = OFF_A + SZ_A;
constexpr size_t OFF_HB = OFF_B + SZ_B;
constexpr size_t OFF_WIN = OFF_HB + SZ_B;
constexpr size_t OFF_WOUT = OFF_WIN + (size_t)DIN * D_ * 2;
constexpr size_t OFF_WGU = OFF_WOUT + (size_t)D_ * D_ * 2;
constexpr size_t OFF_WD = OFF_WGU + (size_t)NE * 1024 * D_ * 2;
constexpr size_t OFF_WR = OFF_WD + (size_t)NE * D_ * DE * 2;
constexpr size_t OFF_SSQ = OFF_WR + (size_t)48 * D_ * 2;
constexpr size_t OFF_CNT = OFF_SSQ + (size_t)3 * T_ * 4;
constexpr size_t OFF_RINFO = OFF_CNT + 256;
constexpr size_t OFF_RW = OFF_RINFO + (size_t)NE * LCAP * 4;
constexpr size_t WS_END = OFF_RW + (size_t)NE * LCAP * 4;

struct Params {
    const float *x, *norm_mix_g, *w_in, *v_norm_g, *gmlp_ws, *gmlp_bs, *conv_w, *g_a, *g_b, *w_out, *g_ffn, *rgw, *rgb, *rew, *reb, *ewg, *ewu, *ewd, *g_final;
    float* out; unsigned char* ws;
};

__device__ __forceinline__ unsigned cvt_pk_bf16(float lo, float hi) { unsigned r; asm volatile("v_cvt_pk_bf16_f32 %0, %1, %2" : "=v"(r) : "v"(lo), "v"(hi)); return r; }
__device__ __forceinline__ float bflo(unsigned w) { return __uint_as_float(w << 16); }
__device__ __forceinline__ float bfhi(unsigned w) { return __uint_as_float(w & 0xffff0000u); }
__device__ __forceinline__ float wave_sum(float v) {
#pragma unroll
    for (int o = 1; o < 64; o <<= 1) v += __shfl_xor(v, o);
    return v;
}
__device__ __forceinline__ float gelu_t(float x) {
    const float u = x * (0.7978845608f + 0.0356774081f * x * x);
    return x * __builtin_amdgcn_rcpf(1.f + __builtin_amdgcn_exp2f(-2.885390082f * u));
}
__device__ __forceinline__ float silu_f(float x) { return x * __builtin_amdgcn_rcpf(1.f + __builtin_amdgcn_exp2f(-1.442695041f * x)); }

struct Unit { int pm, pn, e, r0, pnl; };

__device__ __forceinline__ bool moe_unit(const int* cnt, int NT, int L, Unit& u) {
    int ptile = 0;
    for (int e = 0; e < NE; ++e) {
        const int nt = (cnt[e] + 255) >> 8, nu = nt * NT;
        if (L < nu) { const int mt = L / NT, j = L - mt * NT; u.e = e; u.pm = ptile + mt; u.r0 = mt * 256; u.pnl = j; u.pn = e * NT + j; return true; }
        L -= nu; ptile += nt;
    }
    return false;
}

struct Epi1 {
    static constexpr bool PERM = true, MIDSCALE = false;
    bf16_t* P;
    __device__ __forceinline__ void operator()(f32x4 (&acc)[2][2][4][2], const Unit& u, int wr, int wc, int fr, int fq) const {
        const bool act = u.pn < 8;
#pragma unroll
        for (int ai = 0; ai < 2; ++ai)
#pragma unroll
            for (int m = 0; m < 4; ++m) {
                const int row = u.pm * 256 + ai * 128 + wr * 64 + m * 16 + fr;
                bf16_t* rowp = P + (size_t)row * DIN + u.pn * 256 + wc * 32 + 8 * fq;
#pragma unroll
                for (int bj = 0; bj < 2; ++bj) {
                    f32x4 v0 = acc[ai][bj][m][0], v1 = acc[ai][bj][m][1];
                    if (act) {
#pragma unroll
                        for (int j = 0; j < 4; ++j) { v0[j] = gelu_t(v0[j]); v1[j] = gelu_t(v1[j]); }
                    }
                    u32x4 w; w.x = cvt_pk_bf16(v0[0], v0[1]); w.y = cvt_pk_bf16(v0[2], v0[3]); w.z = cvt_pk_bf16(v1[0], v1[1]); w.w = cvt_pk_bf16(v1[2], v1[3]);
                    *(u32x4*)(rowp + bj * 128) = w;
                }
            }
    }
};
struct Epi2 {
    static constexpr bool PERM = true, MIDSCALE = true;
    const float* x; bf16_t* hb; const float* ssq_a; const float* ssq_b; float* ssq_h;
    __device__ __forceinline__ void midscale(f32x4 (&acc)[2][2][4][2], const Unit& u, int wr, int wc, int fr, int fq) const {
        int rowb = u.pm * 256 + wr * 64 + fr; asm volatile("" : "+v"(rowb));
        const float* pa = ssq_a + rowb; const float* pb = ssq_b + rowb;
#pragma unroll
        for (int ai = 0; ai < 2; ++ai)
#pragma unroll
            for (int m = 0; m < 4; ++m) {
                const float s = __builtin_amdgcn_sqrtf((pb[ai * 128 + m * 16] * (1.f / 1024.f) + EPS) * __builtin_amdgcn_rcpf(pa[ai * 128 + m * 16] * (1.f / 1024.f) + EPS));
#pragma unroll
                for (int bj = 0; bj < 2; ++bj)
#pragma unroll
                    for (int n = 0; n < 2; ++n) acc[ai][bj][m][n] *= s;
                if (m & 1) asm volatile("" ::: "memory");
            }
    }
    __device__ __forceinline__ void operator()(f32x4 (&acc)[2][2][4][2], const Unit& u, int wr, int wc, int fr, int fq) const {
#pragma unroll
        for (int ai = 0; ai < 2; ++ai)
#pragma unroll
            for (int m = 0; m < 4; ++m) {
                const int row = u.pm * 256 + ai * 128 + wr * 64 + m * 16 + fr;
                const float rb = rsqrtf(ssq_b[row] * (1.f / 1024.f) + EPS);
                const size_t off = (size_t)row * D_ + u.pn * 256 + wc * 32 + 8 * fq;
                float ss = 0.f;
#pragma unroll
                for (int bj = 0; bj < 2; ++bj) {
                    const f32x4 x0 = *(const f32x4*)(x + off + bj * 128), x1 = *(const f32x4*)(x + off + bj * 128 + 4);
                    const f32x4 h0 = x0 + acc[ai][bj][m][0] * rb, h1 = x1 + acc[ai][bj][m][1] * rb;
                    ss += (h0[0] * h0[0] + h0[1] * h0[1]) + (h0[2] * h0[2] + h0[3] * h0[3]) + (h1[0] * h1[0] + h1[1] * h1[1]) + (h1[2] * h1[2] + h1[3] * h1[3]);
                    u32x4 w; w.x = cvt_pk_bf16(h0[0], h0[1]); w.y = cvt_pk_bf16(h0[2], h0[3]); w.z = cvt_pk_bf16(h1[0], h1[1]); w.w = cvt_pk_bf16(h1[2], h1[3]);
                    *(u32x4*)(hb + off + bj * 128) = w;
                }
                ss += __shfl_xor(ss, 16); ss += __shfl_xor(ss, 32);
                if (fq == 0) atomicAdd(ssq_h + row, ss);
                asm volatile("" ::: "memory");
            }
    }
};
struct Epi5 {
    static constexpr bool PERM = true, MIDSCALE = false;
    bf16_t* hbuf; const float* ssq_h; const int* rinfo; const int* cnt;
    __device__ __forceinline__ void operator()(f32x4 (&acc)[2][2][4][2], const Unit& u, int wr, int wc, int fr, int fq) const {
        const int ce = cnt[u.e];
#pragma unroll
        for (int ai = 0; ai < 2; ++ai)
#pragma unroll
            for (int m = 0; m < 4; ++m) {
                const int r = ai * 128 + wr * 64 + m * 16 + fr, i = u.r0 + r;
                const int tok = (i < ce) ? (rinfo[u.e * LCAP + i] >> 1) : 0;
                const float rs = rsqrtf(ssq_h[tok] * (1.f / 2048.f) + EPS);
                float o[8];
#pragma unroll
                for (int n = 0; n < 2; ++n)
#pragma unroll
                    for (int j = 0; j < 4; ++j) o[4 * n + j] = silu_f(acc[ai][0][m][n][j] * rs) * (acc[ai][1][m][n][j] * rs);
                u32x4 w; w.x = cvt_pk_bf16(o[0], o[1]); w.y = cvt_pk_bf16(o[2], o[3]); w.z = cvt_pk_bf16(o[4], o[5]); w.w = cvt_pk_bf16(o[6], o[7]);
                *(u32x4*)(hbuf + (size_t)(u.pm * 256 + r) * DE + u.pnl * 128 + wc * 32 + 8 * fq) = w;
            }
    }
};
struct Epi6 {
    static constexpr bool PERM = true, MIDSCALE = false;
    bf16_t* ys2; const int* rinfo; const float* rw; const int* cnt;
    __device__ __forceinline__ void operator()(f32x4 (&acc)[2][2][4][2], const Unit& u, int wr, int wc, int fr, int fq) const {
        const int ce = cnt[u.e];
#pragma unroll
        for (int ai = 0; ai < 2; ++ai)
#pragma unroll
            for (int m = 0; m < 4; ++m) {
                const int r = ai * 128 + wr * 64 + m * 16 + fr, i = u.r0 + r;
                if (i < ce) {
                    const int info = rinfo[u.e * LCAP + i]; const float g = rw[u.e * LCAP + i];
                    bf16_t* dst = ys2 + (size_t)info * D_ + u.pnl * 256 + wc * 32 + 8 * fq;
#pragma unroll
                    for (int bj = 0; bj < 2; ++bj) {
                        const f32x4 v0 = acc[ai][bj][m][0] * g, v1 = acc[ai][bj][m][1] * g;
                        u32x4 w; w.x = cvt_pk_bf16(v0[0], v0[1]); w.y = cvt_pk_bf16(v0[2], v0[3]); w.z = cvt_pk_bf16(v1[0], v1[1]); w.w = cvt_pk_bf16(v1[2], v1[3]);
                        *(u32x4*)(dst + bj * 128) = w;
                    }
                }
            }
    }
};

struct ASrcDirect { const bf16_t* A; int K; __device__ __forceinline__ const bf16_t* row(const Unit& u, int r) const { return A + (size_t)(u.pm * 256 + r) * K; } };
struct ASrcGather { const bf16_t* A; const int* rinfo; const int* cnt;
    __device__ __forceinline__ const bf16_t* row(const Unit& u, int r) const { const int i = u.r0 + r; const int tok = (i < cnt[u.e]) ? (rinfo[u.e * LCAP + i] >> 1) : 0; return A + (size_t)tok * D_; } };

template <class Epi, class ASrc>
__device__ void gemm_simple_unit(unsigned char* lds, const ASrc& AS, const bf16_t* Bt, int K, const Epi& E, const Unit& u) {
    float* As = (float*)lds; float* Bs = As + 32 * 256;
    const int tid = threadIdx.x, wid = tid >> 6, lane = tid & 63, wr = wid >> 2, wc = wid & 3, fr = lane & 15, fq = lane >> 4;
    f32x4 acc[2][2][4][2];
#pragma unroll
    for (int a = 0; a < 2; ++a)
#pragma unroll
        for (int b = 0; b < 2; ++b)
#pragma unroll
            for (int m = 0; m < 4; ++m)
#pragma unroll
                for (int n = 0; n < 2; ++n) acc[a][b][m][n] = (f32x4){0.f, 0.f, 0.f, 0.f};
    const bf16_t* ap[2]; const bf16_t* bp[2]; int lrow[2], lkc[2];
#pragma unroll
    for (int i = 0; i < 2; ++i) { const int p = tid + 512 * i; lrow[i] = p >> 2; lkc[i] = (p & 3) * 8; ap[i] = AS.row(u, lrow[i]) + lkc[i]; bp[i] = Bt + (size_t)lrow[i] * K + lkc[i]; }
    for (int k0 = 0; k0 < K; k0 += 32) {
        if constexpr (Epi::MIDSCALE) { if (k0 == K / 2) E.midscale(acc, u, wr, wc, fr, fq); }
        __syncthreads();
#pragma unroll
        for (int i = 0; i < 2; ++i) {
            const u32x4 a = *(const u32x4*)(ap[i] + k0), b = *(const u32x4*)(bp[i] + k0);
#pragma unroll
            for (int q = 0; q < 4; ++q) {
                As[(lkc[i] + 2 * q) * 256 + lrow[i]] = bflo(a[q]); As[(lkc[i] + 2 * q + 1) * 256 + lrow[i]] = bfhi(a[q]);
                Bs[(lkc[i] + 2 * q) * 256 + lrow[i]] = bflo(b[q]); Bs[(lkc[i] + 2 * q + 1) * 256 + lrow[i]] = bfhi(b[q]);
            }
        }
        __syncthreads();
#pragma unroll 2
        for (int k = 0; k < 32; ++k) {
            float a[2][4]; f32x4 b[2][2];
#pragma unroll
            for (int ai = 0; ai < 2; ++ai)
#pragma unroll
                for (int m = 0; m < 4; ++m) a[ai][m] = As[k * 256 + ai * 128 + wr * 64 + m * 16 + fr];
#pragma unroll
            for (int bj = 0; bj < 2; ++bj)
#pragma unroll
                for (int n = 0; n < 2; ++n) b[bj][n] = *(const f32x4*)&Bs[k * 256 + bj * 128 + wc * 32 + (Epi::PERM ? (8 * fq + 4 * n) : (16 * n + 4 * fq))];
#pragma unroll
            for (int ai = 0; ai < 2; ++ai)
#pragma unroll
                for (int bj = 0; bj < 2; ++bj)
#pragma unroll
                    for (int m = 0; m < 4; ++m)
#pragma unroll
                        for (int n = 0; n < 2; ++n) acc[ai][bj][m][n] += a[ai][m] * b[bj][n];
        }
    }
    E(acc, u, wr, wc, fr, fq);
    __syncthreads();
}


#define PG8_LAS __attribute__((address_space(3)))
namespace pg8 {
constexpr int BM = 256, BK = 64, HALF = 128, HTB = HALF * BK * 2, STAGE_BYTES = 8 * HTB, NXCD = 8, WGM = 8;
__host__ __device__ __forceinline__ int lds_byte(int r, int c) { const int st = (r >> 4) * 2 + (c >> 5), rr = r & 15, cc = c & 31, ob = rr * 64 + cc * 2; return st * 1024 + (ob ^ (((ob >> 9) & 1) << 5)); }
__host__ __device__ __forceinline__ void stage_rc(int b, int& R, int& C) { const int st = b / 1024, sb = b % 1024, swz = sb ^ (((sb >> 9) & 1) << 5); R = (st >> 1) * 16 + swz / 64; C = (st & 1) * 32 + (swz % 64) / 2; }
__host__ __device__ __forceinline__ int perm32(int rho) { const int n = rho >> 4, i = rho & 15; return 8 * (i >> 2) + 4 * n + (i & 3); }

struct StaticOrder {
    int nM, nN, nwg, G, c;
    __device__ void init(int M, int N, int G_, int c_) { nM = M / BM; nN = N / BM; nwg = nM * nN; G = G_; c = c_; }
    __device__ bool next(int i, Unit& u) const {
        const long L = (long)i * G + c; if (L >= nwg) return false;
        int wgid = (int)L; { const int q = nwg / NXCD, r = nwg % NXCD, xcd = wgid % NXCD, off = wgid / NXCD; wgid = (xcd < r ? xcd * (q + 1) : r * (q + 1) + (xcd - r) * q) + off; }
        const int nig = WGM * nN, gid = wgid / nig, fm = gid * WGM, gsz = (nM - fm) < WGM ? (nM - fm) : WGM;
        u.pm = fm + ((wgid % nig) % gsz); u.pn = (wgid % nig) / gsz; u.e = 0; u.r0 = 0; u.pnl = u.pn; return true;
    }
};
struct MoeOrder {
    const int* cnt; int NT, G, c;
    __device__ bool next(int i, Unit& u) const { return moe_unit(cnt, NT, i * G + c, u); }
};
struct AOffDirect { int K; __device__ __forceinline__ unsigned operator()(const Unit& u, int h, int R, int C) const { return (unsigned)(((u.pm * 256 + h * 128 + R) * K + C) * 2); } };
struct AOffGather { const int* rinfo; const int* cnt;
    __device__ __forceinline__ unsigned operator()(const Unit& u, int h, int R, int C) const { const int i = u.r0 + h * 128 + R; const int tok = (i < cnt[u.e]) ? (rinfo[u.e * LCAP + i] >> 1) : 0; return (unsigned)((tok * D_ + C) * 2); } };

template <class Epi, class Sched, class AOff, bool ALIGN_EPI>
__device__ __forceinline__ void gemm_phase(PG8_LAS unsigned char* lds, const bf16_t* Ag, const bf16_t* Btg, const int K, const Sched& S, const AOff& AO, const Epi& E) {
    const int tid = threadIdx.x, wid = __builtin_amdgcn_readfirstlane(tid >> 6), lane = tid & 63, wr = wid >> 2, wc = wid & 3, fr = lane & 15, fq = lane >> 4;
    const int nt = K / BK;
    int RA[2], CA[2]; unsigned voffB[2];
#pragma unroll
    for (int i = 0; i < 2; ++i) { int R, C; stage_rc(tid * 16 + i * 8192, R, C); RA[i] = R; CA[i] = C; const int Rb = Epi::PERM ? ((R & ~31) + perm32(R & 31)) : R; voffB[i] = (unsigned)(Rb * K + C) * 2u; }
    const size_t kstep = (size_t)(BK * 2), hstep = (size_t)HALF * K * 2, tstep = 2 * hstep;
    const unsigned ldsw = (unsigned)wid * 1024u;
    const int aoff = lds_byte(wr * 64 + fr, fq * 8), boff = lds_byte(wc * 32 + fr, fq * 8);
    const char* const Ab = (const char*)Ag;
#define PG8_SA(b, h) (((b) * 2 + (h)) * HTB)
#define PG8_SB(b, h) ((4 + (b) * 2 + (h)) * HTB)
#define PG8_STAGE(bufoff, gbase, voff) do { _Pragma("unroll") for (int _i = 0; _i < 2; ++_i) \
        __builtin_amdgcn_global_load_lds((const unsigned*)((const char*)(gbase) + (voff)[_i]), (PG8_LAS unsigned*)(lds + (bufoff) + ldsw + _i * 8192), 16, 0, 0); } while (0)
#define PG8_LDA(dst, b, h) do { _Pragma("unroll") for (int m = 0; m < 4; ++m) _Pragma("unroll") for (int k = 0; k < 2; ++k) dst[m][k] = *(const PG8_LAS bf16x8*)(lds + PG8_SA(b, h) + aoff + m * 2048 + k * 1024); } while (0)
#define PG8_LDB(dst, b, h) do { _Pragma("unroll") for (int n = 0; n < 2; ++n) _Pragma("unroll") for (int k = 0; k < 2; ++k) dst[n][k] = *(const PG8_LAS bf16x8*)(lds + PG8_SB(b, h) + boff + n * 2048 + k * 1024); } while (0)
#define PG8_MMA(ai, bj, At, Bt) do { __builtin_amdgcn_s_setprio(1); _Pragma("unroll") for (int m = 0; m < 4; ++m) _Pragma("unroll") for (int n = 0; n < 2; ++n) _Pragma("unroll") for (int k = 0; k < 2; ++k) \
        acc[ai][bj][m][n] = __builtin_amdgcn_mfma_f32_16x16x32_bf16(Bt[n][k], At[m][k], acc[ai][bj][m][n], 0, 0, 0); __builtin_amdgcn_s_setprio(0); } while (0)
#define PG8_WAIT_V(n) asm volatile("s_waitcnt vmcnt(" #n ")" ::: "memory")
#define PG8_WAIT_L(n) asm volatile("s_waitcnt lgkmcnt(" #n ")" ::: "memory")
#define PG8_BAR __builtin_amdgcn_s_barrier()
#define PG8_SCHED __builtin_amdgcn_sched_barrier(0)
    Unit cur, nxt; int ui = 0;
    if (!S.next(0, cur)) return;
    f32x4 acc[2][2][4][2];
#pragma unroll
    for (int a = 0; a < 2; ++a)
#pragma unroll
        for (int b = 0; b < 2; ++b)
#pragma unroll
            for (int m = 0; m < 4; ++m)
#pragma unroll
                for (int n = 0; n < 2; ++n) acc[a][b][m][n] = (f32x4){0.f, 0.f, 0.f, 0.f};
    bf16x8 At[4][2], B0[2][2], B1[2][2];
    unsigned vo0[2], vo1[2];
#pragma unroll
    for (int i = 0; i < 2; ++i) { vo0[i] = AO(cur, 0, RA[i], CA[i]); vo1[i] = AO(cur, 1, RA[i], CA[i]); }
    const char* cB = (const char*)Btg + (size_t)cur.pn * tstep;
    PG8_STAGE(PG8_SB(0, 0), cB, voffB); PG8_STAGE(PG8_SB(0, 1), cB + hstep, voffB); PG8_STAGE(PG8_SA(0, 0), Ab, vo0); PG8_STAGE(PG8_SA(0, 1), Ab, vo1);
    if (wr == 1) PG8_BAR;
    PG8_WAIT_V(2); PG8_BAR;
    PG8_STAGE(PG8_SB(1, 0), cB + kstep, voffB); PG8_STAGE(PG8_SA(1, 0), Ab + kstep, vo0); PG8_STAGE(PG8_SB(1, 1), cB + hstep + kstep, voffB);
    PG8_WAIT_V(6); PG8_BAR;
    for (;;) {
        const bool has_next = S.next(ui + 1, nxt);
        const char* nB = has_next ? (const char*)Btg + (size_t)nxt.pn * tstep : cB;
        for (int t = 0; t < nt; t += 2) {
            const bool last = (t == nt - 2);
            if constexpr (Epi::MIDSCALE) { if (t == nt / 2) E.midscale(acc, cur, wr, wc, fr, fq); }
            const size_t k1 = (size_t)(t + 1) * kstep, k2 = last ? (size_t)0 : (size_t)(t + 2) * kstep, k3 = k2 + kstep;
            const char* b2 = last ? nB : cB + (size_t)(t + 2) * kstep; const char* b3 = b2 + kstep;
            PG8_LDB(B0, 0, 0); PG8_LDB(B1, 0, 1); PG8_SCHED; PG8_LDA(At, 0, 0); PG8_STAGE(PG8_SA(1, 1), Ab + k1, vo1);
            PG8_WAIT_V(8); PG8_WAIT_L(0); PG8_BAR; PG8_MMA(0, 0, At, B0); PG8_MMA(0, 1, At, B1); PG8_BAR; PG8_SCHED;
            if (last && has_next) {
#pragma unroll
                for (int i = 0; i < 2; ++i) { vo0[i] = AO(nxt, 0, RA[i], CA[i]); vo1[i] = AO(nxt, 1, RA[i], CA[i]); }
            }
            PG8_LDA(At, 0, 1); PG8_STAGE(PG8_SB(0, 0), b2, voffB); PG8_STAGE(PG8_SB(0, 1), b2 + hstep, voffB); PG8_STAGE(PG8_SA(0, 0), Ab + k2, vo0);
            PG8_WAIT_V(8); PG8_WAIT_L(0); PG8_BAR; PG8_MMA(1, 0, At, B0); PG8_MMA(1, 1, At, B1); PG8_BAR; PG8_SCHED;
            PG8_LDB(B0, 1, 0); PG8_LDB(B1, 1, 1); PG8_SCHED; PG8_LDA(At, 1, 0); PG8_STAGE(PG8_SA(0, 1), Ab + k2, vo1);
            PG8_WAIT_V(8); PG8_WAIT_L(0); PG8_BAR; PG8_MMA(0, 0, At, B0); PG8_MMA(0, 1, At, B1); PG8_BAR; PG8_SCHED;
            PG8_LDA(At, 1, 1); PG8_STAGE(PG8_SB(1, 0), b3, voffB); PG8_STAGE(PG8_SB(1, 1), b3 + hstep, voffB); PG8_STAGE(PG8_SA(1, 0), Ab + k3, vo0);
            PG8_WAIT_V(8); PG8_WAIT_L(0); PG8_BAR; PG8_MMA(1, 0, At, B0); PG8_MMA(1, 1, At, B1); PG8_BAR; PG8_SCHED;
        }
        if constexpr (ALIGN_EPI) { if (wr == 0) PG8_BAR; }
        E(acc, cur, wr, wc, fr, fq);
        if (!has_next) break;
#pragma unroll
        for (int a = 0; a < 2; ++a)
#pragma unroll
            for (int b = 0; b < 2; ++b)
#pragma unroll
                for (int m = 0; m < 4; ++m)
#pragma unroll
                    for (int n = 0; n < 2; ++n) acc[a][b][m][n] = (f32x4){0.f, 0.f, 0.f, 0.f};
        cur = nxt; cB = nB; ++ui;
        if constexpr (ALIGN_EPI) { if (wr == 1) PG8_BAR; }
    }
    PG8_WAIT_V(0);
    if constexpr (!ALIGN_EPI) { if (wr == 0) PG8_BAR; }
    PG8_BAR;
#undef PG8_SA
#undef PG8_SB
#undef PG8_STAGE
#undef PG8_LDA
#undef PG8_LDB
#undef PG8_MMA
#undef PG8_WAIT_V
#undef PG8_WAIT_L
#undef PG8_BAR
#undef PG8_SCHED
}
}

#ifndef FAST_MASK
#define FAST_MASK 0x6A
#endif

__device__ void transpose_tile(float* lt, const float* src, int ldsrc, int r0, int c0, bf16_t* dst, int lddst, int dr0, const float* sA, const float* sB, int split) {
    const int tid = threadIdx.x;
    { const int r = tid >> 3, cc = (tid & 7) * 8;
      const float* s = src + (size_t)(r0 + r) * ldsrc + c0 + cc;
      const f32x4 v0 = *(const f32x4*)s, v1 = *(const f32x4*)(s + 4);
      float sc = 1.f; if (sA) { const int rr = r0 + r; sc = rr < split ? sA[rr] : sB[rr - split]; }
#pragma unroll
      for (int q = 0; q < 4; ++q) { lt[r * 65 + cc + q] = v0[q] * sc; lt[r * 65 + cc + 4 + q] = v1[q] * sc; } }
    __syncthreads();
    { const int c = tid >> 3, rr = (tid & 7) * 8;
      float v[8];
#pragma unroll
      for (int q = 0; q < 8; ++q) v[q] = lt[(rr + q) * 65 + c];
      u32x4 w; w.x = cvt_pk_bf16(v[0], v[1]); w.y = cvt_pk_bf16(v[2], v[3]); w.z = cvt_pk_bf16(v[4], v[5]); w.w = cvt_pk_bf16(v[6], v[7]);
      *(u32x4*)(dst + (size_t)(dr0 + c) * lddst + r0 + rr) = w; }
    __syncthreads();
}
__device__ void phase0(const Params& p, unsigned char* lds) {
    const int tid = threadIdx.x, nb = gridDim.x, bid = blockIdx.x, wid = tid >> 6, lane = tid & 63;
    { float* z = (float*)(p.ws + OFF_SSQ);
      for (int i = bid * NTHR + tid; i < 3 * T_ + 64; i += nb * NTHR) z[i] = 0.f; }
    { bf16_t* wrt = (bf16_t*)(p.ws + OFF_WR);
      for (int i = bid * NTHR + tid; i < 48 * D_; i += nb * NTHR) {
          const int o = i >> 11, k = i & 2047; float v = 0.f;
          if (o < 4) v = p.rgw[k * 4 + o]; else if (o < 36) v = p.rew[k * 32 + (o - 4)];
          wrt[i] = (bf16_t)(cvt_pk_bf16(v * p.g_ffn[k], 0.f) & 0xffffu); } }
    { bf16_t* xn = (bf16_t*)(p.ws + OFF_B);
      for (int row = bid * 8 + wid; row < T_; row += nb * 8) {
          const float* xr = p.x + (size_t)row * D_;
          f32x4 v[8]; float s = 0.f;
#pragma unroll
          for (int i = 0; i < 8; ++i) { v[i] = *(const f32x4*)(xr + i * 256 + lane * 4); s += (v[i][0] * v[i][0] + v[i][1] * v[i][1]) + (v[i][2] * v[i][2] + v[i][3] * v[i][3]); }
          const float rstd = rsqrtf(wave_sum(s) * (1.f / D_) + EPS);
#pragma unroll
          for (int i = 0; i < 8; ++i) { const f32x4 g = *(const f32x4*)(p.norm_mix_g + i * 256 + lane * 4); const f32x4 o = v[i] * rstd * g;
              u32x2 w; w.x = cvt_pk_bf16(o[0], o[1]); w.y = cvt_pk_bf16(o[2], o[3]); *(u32x2*)(xn + (size_t)row * D_ + i * 256 + lane * 4) = w; } } }
    float* lt = (float*)lds;
    constexpr int N_IN = 32 * 80, N_OUT = 32 * 32, N_G = 32 * 256, N_TOT = N_IN + N_OUT + 3 * N_G;
    for (int tile = bid; tile < N_TOT; tile += nb) {
        int q = tile;
        if (q < N_IN) { const int tr = q / 80, tc = q % 80; transpose_tile(lt, p.w_in, DIN, tr * 64, tc * 64, (bf16_t*)(p.ws + OFF_WIN), D_, tc * 64, nullptr, nullptr, 0); continue; } q -= N_IN;
        if (q < N_OUT) { const int tr = q / 32, tc = q % 32; transpose_tile(lt, p.w_out, D_, tr * 64, tc * 64, (bf16_t*)(p.ws + OFF_WOUT), D_, tc * 64, p.g_a, p.g_b, 1024); continue; } q -= N_OUT;
        if (q < 2 * N_G) { const int up = q >= N_G; if (up) q -= N_G; const int e = q >> 8, rem = q & 255, tr = rem >> 3, tc = rem & 7; const int c0 = tc * 64;
            transpose_tile(lt, (up ? p.ewu : p.ewg) + (size_t)e * D_ * DE, DE, tr * 64, c0, (bf16_t*)(p.ws + OFF_WGU) + (size_t)e * 1024 * D_, D_, (c0 >> 7) * 256 + (up ? 128 : 0) + (c0 & 127), p.g_ffn, p.g_ffn, 1 << 30); continue; } q -= 2 * N_G;
        { const int e = q >> 8, rem = q & 255, tr = rem >> 5, tc = rem & 31;
          transpose_tile(lt, p.ewd + (size_t)e * DE * D_, D_, tr * 64, tc * 64, (bf16_t*)(p.ws + OFF_WD) + (size_t)e * D_ * DE, DE, tc * 64, nullptr, nullptr, 0); }
    }
}

__device__ void phase1(const Params& p, unsigned char* lds) {
    const ASrcDirect AS{(const bf16_t*)(p.ws + OFF_B), D_}; const Epi1 E{(bf16_t*)(p.ws + OFF_A)};
    const bf16_t* Bt = (const bf16_t*)(p.ws + OFF_WIN);
    if (FAST_MASK & 2) { pg8::StaticOrder S; S.init(T_, DIN, gridDim.x, blockIdx.x); const pg8::AOffDirect AO{D_};
        pg8::gemm_phase<Epi1, pg8::StaticOrder, pg8::AOffDirect, true>((PG8_LAS unsigned char*)lds, AS.A, Bt, D_, S, AO, E); return; }
    for (int L = blockIdx.x; L < 64 * 20; L += gridDim.x) { Unit u; u.pm = L / 20; u.pn = L % 20; u.e = 0; u.r0 = 0; u.pnl = u.pn;
        gemm_simple_unit(lds, AS, Bt + (size_t)u.pn * 256 * D_, D_, E, u); }
}

__device__ void mixer_gmlp_item(const Params& p, unsigned char* lds, int item) {
    const int tid = threadIdx.x, wid = tid >> 6, lane = tid & 63, fr = lane & 15, fq = lane >> 4;
    const int h = item & 7, t0 = (item >> 3) * 128;
    const bf16_t* P = (const bf16_t*)(p.ws + OFF_A); bf16_t* Y = (bf16_t*)(p.ws + OFF_B); float* ssq_a = (float*)(p.ws + OFF_SSQ);
    bf16_t* Vt = (bf16_t*)lds;
    bf16_t* Wl = Vt + 128 * 136;
    float* rs = (float*)(Wl + 128 * 136);
    { const int j = tid >> 2, dc = (tid & 3) * 32;
      const u32x4* src = (const u32x4*)(P + (size_t)(t0 + j) * DIN + 1024 + h * 128 + dc);
      u32x4 v[4]; float s = 0.f;
#pragma unroll
      for (int q = 0; q < 4; ++q) { v[q] = src[q];
#pragma unroll
          for (int w = 0; w < 4; ++w) { const float lo = bflo(v[q][w]), hi = bfhi(v[q][w]); s += lo * lo + hi * hi; } }
      s += __shfl_xor(s, 1); s += __shfl_xor(s, 2);
      if ((tid & 3) == 0) rs[j] = rsqrtf(s * (1.f / 128.f) + EPS);
#pragma unroll
      for (int q = 0; q < 4; ++q)
#pragma unroll
          for (int w = 0; w < 4; ++w) { const int d = dc + q * 8 + w * 2; Vt[d * 136 + j] = (bf16_t)(v[q][w] & 0xffffu); Vt[(d + 1) * 136 + j] = (bf16_t)(v[q][w] >> 16); } }
    __syncthreads();
    { const int i = tid >> 2, jc = (tid & 3) * 32;
      const f32x4* src = (const f32x4*)(p.gmlp_ws + (size_t)h * 16384 + i * 128 + jc);
      const bool live = (i >> 6) >= (jc >> 6);
#pragma unroll
      for (int q = 0; q < 4; ++q) { f32x4 w0 = src[2 * q], w1 = src[2 * q + 1];
          const f32x4 r0 = *(const f32x4*)(rs + jc + 8 * q), r1 = *(const f32x4*)(rs + jc + 8 * q + 4);
          w0 = live ? w0 * r0 : (f32x4){0.f, 0.f, 0.f, 0.f}; w1 = live ? w1 * r1 : (f32x4){0.f, 0.f, 0.f, 0.f};
          u32x4 o; o.x = cvt_pk_bf16(w0[0], w0[1]); o.y = cvt_pk_bf16(w0[2], w0[3]); o.z = cvt_pk_bf16(w1[0], w1[1]); o.w = cvt_pk_bf16(w1[2], w1[3]);
          *(u32x4*)(Wl + i * 136 + jc + 8 * q) = o; } }
    __syncthreads();
    f32x4 acc[8];
#pragma unroll
    for (int n = 0; n < 8; ++n) acc[n] = (f32x4){0.f, 0.f, 0.f, 0.f};
    const int ksteps = (wid < 4) ? 2 : 4;
    for (int ks = 0; ks < ksteps; ++ks) {
        const bf16x8 bw = *(const bf16x8*)(Wl + (16 * wid + fr) * 136 + ks * 32 + fq * 8);
#pragma unroll
        for (int n = 0; n < 8; ++n) { const bf16x8 av = *(const bf16x8*)(Vt + (16 * n + fr) * 136 + ks * 32 + fq * 8);
            acc[n] = __builtin_amdgcn_mfma_f32_16x16x32_bf16(av, bw, acc[n], 0, 0, 0); }
    }
    { const int i = 16 * wid + fr, t = t0 + i; const float bias = p.gmlp_bs[h * 128 + i]; float ss = 0.f;
#pragma unroll
      for (int n = 0; n < 8; ++n) { const int c = h * 128 + 16 * n + 4 * fq;
          const f32x4 g = *(const f32x4*)(p.v_norm_g + c); const u32x2 uu = *(const u32x2*)(P + (size_t)t * DIN + c);
          const float y0 = bflo(uu.x) * (acc[n][0] * g[0] + bias), y1 = bfhi(uu.x) * (acc[n][1] * g[1] + bias), y2 = bflo(uu.y) * (acc[n][2] * g[2] + bias), y3 = bfhi(uu.y) * (acc[n][3] * g[3] + bias);
          ss += (y0 * y0 + y1 * y1) + (y2 * y2 + y3 * y3);
          u32x2 w; w.x = cvt_pk_bf16(y0, y1); w.y = cvt_pk_bf16(y2, y3); *(u32x2*)(Y + (size_t)t * D_ + c) = w; }
      ss += __shfl_xor(ss, 16); ss += __shfl_xor(ss, 32);
      if (fq == 0) atomicAdd(ssq_a + t, ss); }
    __syncthreads();
}
__device__ void mixer_conv_item(const Params& p, int item) {
    const int tid = threadIdx.x, cl = tid & 31, ts = tid >> 5;
    const int c = (item & 3) * 256 + cl * 8, tbeg = (item >> 2) * 128 + ts * 8;
    const bf16_t* P = (const bf16_t*)(p.ws + OFF_A); bf16_t* Y = (bf16_t*)(p.ws + OFF_B); float* ssq_b = (float*)(p.ws + OFF_SSQ) + T_;
    float w0[8], w1[8], w2[8], z1[8], z2[8];
    { const f32x4 a0 = *(const f32x4*)(p.conv_w + c), a1 = *(const f32x4*)(p.conv_w + c + 4), b0 = *(const f32x4*)(p.conv_w + 1024 + c), b1 = *(const f32x4*)(p.conv_w + 1024 + c + 4),
                  c0 = *(const f32x4*)(p.conv_w + 2048 + c), c1 = *(const f32x4*)(p.conv_w + 2048 + c + 4);
#pragma unroll
      for (int q = 0; q < 4; ++q) { w0[q] = a0[q]; w0[4 + q] = a1[q]; w1[q] = b0[q]; w1[4 + q] = b1[q]; w2[q] = c0[q]; w2[4 + q] = c1[q]; } }
#pragma unroll
    for (int q = 0; q < 8; ++q) { z1[q] = 0.f; z2[q] = 0.f; }
    if ((tbeg % SEQ) != 0) {
        const u32x4 ca = *(const u32x4*)(P + (size_t)(tbeg - 1) * DIN + 3072 + c), ha = *(const u32x4*)(P + (size_t)(tbeg - 1) * DIN + 4096 + c);
        const u32x4 cb = *(const u32x4*)(P + (size_t)(tbeg - 2) * DIN + 3072 + c), hb2 = *(const u32x4*)(P + (size_t)(tbeg - 2) * DIN + 4096 + c);
#pragma unroll
        for (int q = 0; q < 4; ++q) { z1[2 * q] = bflo(ca[q]) * bflo(ha[q]); z1[2 * q + 1] = bfhi(ca[q]) * bfhi(ha[q]); z2[2 * q] = bflo(cb[q]) * bflo(hb2[q]); z2[2 * q + 1] = bfhi(cb[q]) * bfhi(hb2[q]); }
    }
    for (int tt = 0; tt < 8; ++tt) {
        const int t = tbeg + tt; const bf16_t* pr = P + (size_t)t * DIN + c;
        const u32x4 bg = *(const u32x4*)(pr + 2048), cgv = *(const u32x4*)(pr + 3072), hv = *(const u32x4*)(pr + 4096);
        float z[8], y[8], ss = 0.f;
#pragma unroll
        for (int q = 0; q < 4; ++q) { z[2 * q] = bflo(cgv[q]) * bflo(hv[q]); z[2 * q + 1] = bfhi(cgv[q]) * bfhi(hv[q]); }
#pragma unroll
        for (int q = 0; q < 4; ++q) {
            y[2 * q] = bflo(bg[q]) * (w0[2 * q] * z2[2 * q] + w1[2 * q] * z1[2 * q] + w2[2 * q] * z[2 * q]);
            y[2 * q + 1] = bfhi(bg[q]) * (w0[2 * q + 1] * z2[2 * q + 1] + w1[2 * q + 1] * z1[2 * q + 1] + w2[2 * q + 1] * z[2 * q + 1]); }
#pragma unroll
        for (int q = 0; q < 8; ++q) { ss += y[q] * y[q]; z2[q] = z1[q]; z1[q] = z[q]; }
        u32x4 w; w.x = cvt_pk_bf16(y[0], y[1]); w.y = cvt_pk_bf16(y[2], y[3]); w.z = cvt_pk_bf16(y[4], y[5]); w.w = cvt_pk_bf16(y[6], y[7]);
        *(u32x4*)(Y + (size_t)t * D_ + 1024 + c) = w;
        ss += __shfl_xor(ss, 1); ss += __shfl_xor(ss, 2); ss += __shfl_xor(ss, 4); ss += __shfl_xor(ss, 8); ss += __shfl_xor(ss, 16);
        if (cl == 0) atomicAdd(ssq_b + t, ss);
    }
}
__device__ void phase2(const Params& p, unsigned char* lds) {
    for (int it = blockIdx.x; it < 512 + 1024; it += gridDim.x) { if (it < 512) mixer_conv_item(p, it); else mixer_gmlp_item(p, lds, it - 512); }
}

__device__ void phase3(const Params& p, unsigned char* lds) {
    const ASrcDirect AS{(const bf16_t*)(p.ws + OFF_B), D_};
    float* ssq = (float*)(p.ws + OFF_SSQ);
    const Epi2 E{p.x, (bf16_t*)(p.ws + OFF_HB), ssq, ssq + T_, ssq + 2 * T_};
    const bf16_t* Bt = (const bf16_t*)(p.ws + OFF_WOUT);
    if (FAST_MASK & 8) { pg8::StaticOrder S; S.init(T_, D_, gridDim.x, blockIdx.x); const pg8::AOffDirect AO{D_};
        pg8::gemm_phase<Epi2, pg8::StaticOrder, pg8::AOffDirect, true>((PG8_LAS unsigned char*)lds, AS.A, Bt, D_, S, AO, E); return; }
    for (int L = blockIdx.x; L < 64 * 8; L += gridDim.x) { Unit u; u.pm = L / 8; u.pn = L % 8; u.e = 0; u.r0 = 0; u.pnl = u.pn;
        gemm_simple_unit(lds, AS, Bt + (size_t)u.pn * 256 * D_, D_, E, u); }
}

__device__ void route_item(const Params& p, unsigned char* lds, int item) {
    const int tid = threadIdx.x, wid = tid >> 6, lane = tid & 63, fr = lane & 15, fq = lane >> 4;
    float* lg = (float*)lds;
    int* lcnt = (int*)(lg + 8 * 16 * 48); int* lbase = lcnt + 32;
    const bf16_t* hb = (const bf16_t*)(p.ws + OFF_HB); const bf16_t* wrt = (const bf16_t*)(p.ws + OFF_WR);
    const float* ssq_h = (const float*)(p.ws + OFF_SSQ) + 2 * T_;
    int* cnt = (int*)(p.ws + OFF_CNT); int* rinfo = (int*)(p.ws + OFF_RINFO); float* rw = (float*)(p.ws + OFF_RW);
    const int tw = item * 128 + wid * 16;
    if (tid < 32) lcnt[tid] = 0;
    f32x4 acc[3];
#pragma unroll
    for (int n = 0; n < 3; ++n) acc[n] = (f32x4){0.f, 0.f, 0.f, 0.f};
    const bf16_t* ap = hb + (size_t)(tw + fr) * D_ + fq * 8; const bf16_t* bp = wrt + (size_t)fr * D_ + fq * 8;
#pragma unroll 4
    for (int ks = 0; ks < 64; ++ks) { const bf16x8 a = *(const bf16x8*)(ap + ks * 32);
#pragma unroll
        for (int n = 0; n < 3; ++n) { const bf16x8 b = *(const bf16x8*)(bp + (size_t)n * 16 * D_ + ks * 32); acc[n] = __builtin_amdgcn_mfma_f32_16x16x32_bf16(a, b, acc[n], 0, 0, 0); } }
#pragma unroll
    for (int n = 0; n < 3; ++n)
#pragma unroll
        for (int j = 0; j < 4; ++j) lg[(wid * 16 + 4 * fq + j) * 48 + 16 * n + fr] = acc[n][j];
    __syncthreads();
    int e0 = 0, e1 = 0, r0 = 0, r1 = 0; float g0 = 0.f, g1 = 0.f; const int t = tw + lane;
    if (lane < 16) {
        const float* l = lg + (wid * 16 + lane) * 48; const float rstd = rsqrtf(ssq_h[t] * (1.f / D_) + EPS);
        float gm = -3.0e38f; int gi = 0; float gl[4];
#pragma unroll
        for (int o = 0; o < 4; ++o) { gl[o] = l[o] * rstd + p.rgb[o]; if (gl[o] > gm) { gm = gl[o]; gi = o; } }
        float gs = 0.f;
#pragma unroll
        for (int o = 0; o < 4; ++o) gs += __expf(gl[o] - gm);
        const float pg = 1.f / gs;
        float b1 = -3.0e38f, b2 = -3.0e38f; int i1 = 0, i2 = 0;
        for (int q = 0; q < 8; ++q) { const float v = l[4 + gi * 8 + q] * rstd + p.reb[gi * 8 + q];
            if (v > b1) { b2 = b1; i2 = i1; b1 = v; i1 = q; } else if (v > b2) { b2 = v; i2 = q; } }
        const float wa = 1.f / (1.f + __expf(b2 - b1));
        e0 = gi * 8 + i1; e1 = gi * 8 + i2; g0 = pg * wa; g1 = pg * (1.f - wa);
        r0 = atomicAdd(&lcnt[e0], 1); r1 = atomicAdd(&lcnt[e1], 1);
    }
    __syncthreads();
    if (tid < 32) lbase[tid] = atomicAdd(cnt + tid, lcnt[tid]);
    __syncthreads();
    if (lane < 16) { const int i0 = lbase[e0] + r0, i1 = lbase[e1] + r1;
        rinfo[e0 * LCAP + i0] = 2 * t; rw[e0 * LCAP + i0] = g0; rinfo[e1 * LCAP + i1] = 2 * t + 1; rw[e1 * LCAP + i1] = g1; }
    __syncthreads();
}
__device__ void phase4(const Params& p, unsigned char* lds) { for (int it = blockIdx.x; it < T_ / 128; it += gridDim.x) route_item(p, lds, it); }

__device__ void phase5(const Params& p, unsigned char* lds) {
    const int* cnt = (const int*)(p.ws + OFF_CNT); const int* rinfo = (const int*)(p.ws + OFF_RINFO);
    const ASrcGather AS{(const bf16_t*)(p.ws + OFF_HB), rinfo, cnt};
    const Epi5 E{(bf16_t*)(p.ws + OFF_B), (const float*)(p.ws + OFF_SSQ) + 2 * T_, rinfo, cnt};
    const bf16_t* Bt = (const bf16_t*)(p.ws + OFF_WGU);
    if (FAST_MASK & 32) { const pg8::MoeOrder S{cnt, 4, (int)gridDim.x, (int)blockIdx.x}; const pg8::AOffGather AO{rinfo, cnt};
        pg8::gemm_phase<Epi5, pg8::MoeOrder, pg8::AOffGather, true>((PG8_LAS unsigned char*)lds, AS.A, Bt, D_, S, AO, E); return; }
    for (int L = blockIdx.x;; L += gridDim.x) { Unit u; if (!moe_unit(cnt, 4, L, u)) break; gemm_simple_unit(lds, AS, Bt + (size_t)u.pn * 256 * D_, D_, E, u); }
}
__device__ void phase6(const Params& p, unsigned char* lds) {
    const int* cnt = (const int*)(p.ws + OFF_CNT); const int* rinfo = (const int*)(p.ws + OFF_RINFO);
    const ASrcDirect AS{(const bf16_t*)(p.ws + OFF_B), DE};
    const Epi6 E{(bf16_t*)(p.ws + OFF_A), rinfo, (const float*)(p.ws + OFF_RW), cnt};
    const bf16_t* Bt = (const bf16_t*)(p.ws + OFF_WD);
    if (FAST_MASK & 64) { const pg8::MoeOrder S{cnt, 8, (int)gridDim.x, (int)blockIdx.x}; const pg8::AOffDirect AO{DE};
        pg8::gemm_phase<Epi6, pg8::MoeOrder, pg8::AOffDirect, true>((PG8_LAS unsigned char*)lds, AS.A, Bt, DE, S, AO, E); return; }
    for (int L = blockIdx.x;; L += gridDim.x) { Unit u; if (!moe_unit(cnt, 8, L, u)) break; gemm_simple_unit(lds, AS, Bt + (size_t)u.pn * 256 * DE, DE, E, u); }
}
__device__ void phase7(const Params& p) {
    const int tid = threadIdx.x, wid = tid >> 6, lane = tid & 63;
    const bf16_t* hb = (const bf16_t*)(p.ws + OFF_HB); const bf16_t* ys2 = (const bf16_t*)(p.ws + OFF_A);
    for (int t = blockIdx.x * 8 + wid; t < T_; t += gridDim.x * 8) {
        float v[4][8]; float s = 0.f;
#pragma unroll
        for (int i = 0; i < 4; ++i) { const int c = i * 512 + lane * 8;
            const u32x4 a = *(const u32x4*)(hb + (size_t)t * D_ + c), b = *(const u32x4*)(ys2 + (size_t)(2 * t) * D_ + c), d = *(const u32x4*)(ys2 + (size_t)(2 * t + 1) * D_ + c);
#pragma unroll
            for (int q = 0; q < 4; ++q) { v[i][2 * q] = bflo(a[q]) + bflo(b[q]) + bflo(d[q]); v[i][2 * q + 1] = bfhi(a[q]) + bfhi(b[q]) + bfhi(d[q]); s += v[i][2 * q] * v[i][2 * q] + v[i][2 * q + 1] * v[i][2 * q + 1]; } }
        const float rstd = rsqrtf(wave_sum(s) * (1.f / D_) + EPS);
#pragma unroll
        for (int i = 0; i < 4; ++i) { const int c = i * 512 + lane * 8;
            const f32x4 g0 = *(const f32x4*)(p.g_final + c), g1 = *(const f32x4*)(p.g_final + c + 4);
            f32x4 o0, o1;
#pragma unroll
            for (int q = 0; q < 4; ++q) { o0[q] = v[i][q] * rstd * g0[q]; o1[q] = v[i][4 + q] * rstd * g1[q]; }
            *(f32x4*)(p.out + (size_t)t * D_ + c) = o0; *(f32x4*)(p.out + (size_t)t * D_ + c + 4) = o1; }
    }
}

template <int PH> __global__ void __launch_bounds__(NTHR, 2) k_phase(Params p) {
    extern __shared__ __attribute__((aligned(16))) unsigned char lds[];
    if (PH == 0) phase0(p, lds);
    if (PH == 1) phase1(p, lds);
    if (PH == 2) phase2(p, lds);
    if (PH == 3) phase3(p, lds);
    if (PH == 4) phase4(p, lds);
    if (PH == 5) phase5(p, lds);
    if (PH == 6) phase6(p, lds);
    if (PH == 7) phase7(p);
}

extern "C" void kernel_launch(void* const* d_in, const int* in_sizes, int n_in, void* d_out, int out_size, void* d_ws, size_t ws_size, hipStream_t stream) {
    static int grid = 0;
    if (grid == 0) {
        if (n_in != 19 || in_sizes[0] != T_ * D_ || out_size != T_ * D_ || ws_size < WS_END) { fprintf(stderr, "kernel_launch: unexpected shapes (n_in %d, in0 %d, out %d, ws %zu < %zu); nothing launched\n", n_in, n_in > 0 ? in_sizes[0] : -1, out_size, ws_size, (size_t)WS_END); grid = -1; return; }
        int dev = 0, cus = 0;
        if (hipGetDevice(&dev) != hipSuccess || hipDeviceGetAttribute(&cus, hipDeviceAttributeMultiprocessorCount, dev) != hipSuccess) { grid = -1; return; }
        (void)hipFuncSetAttribute((const void*)k_phase<0>, hipFuncAttributeMaxDynamicSharedMemorySize, LDS_BYTES);
        (void)hipFuncSetAttribute((const void*)k_phase<1>, hipFuncAttributeMaxDynamicSharedMemorySize, LDS_BYTES);
        (void)hipFuncSetAttribute((const void*)k_phase<2>, hipFuncAttributeMaxDynamicSharedMemorySize, LDS_BYTES);
        (void)hipFuncSetAttribute((const void*)k_phase<3>, hipFuncAttributeMaxDynamicSharedMemorySize, LDS_BYTES);
        (void)hipFuncSetAttribute((const void*)k_phase<4>, hipFuncAttributeMaxDynamicSharedMemorySize, LDS_BYTES);
        (void)hipFuncSetAttribute((const void*)k_phase<5>, hipFuncAttributeMaxDynamicSharedMemorySize, LDS_BYTES);
        (void)hipFuncSetAttribute((const void*)k_phase<6>, hipFuncAttributeMaxDynamicSharedMemorySize, LDS_BYTES);
        (void)hipFuncSetAttribute((const void*)k_phase<7>, hipFuncAttributeMaxDynamicSharedMemorySize, LDS_BYTES);
        grid = cus > 0 ? cus : 256;
    }
    if (grid < 0) return;
    Params p{};
    const float** f = (const float**)&p;
    for (int i = 0; i < 19; ++i) f[i] = (const float*)d_in[i];
    p.out = (float*)d_out; p.ws = (unsigned char*)d_ws;
    hipLaunchKernelGGL(k_phase<0>, dim3(grid), dim3(NTHR), LDS_BYTES, stream, p);
    hipLaunchKernelGGL(k_phase<1>, dim3(grid), dim3(NTHR), LDS_BYTES, stream, p);
    hipLaunchKernelGGL(k_phase<2>, dim3(grid), dim3(NTHR), LDS_BYTES, stream, p);
    hipLaunchKernelGGL(k_phase<3>, dim3(grid), dim3(NTHR), LDS_BYTES, stream, p);
    hipLaunchKernelGGL(k_phase<4>, dim3(grid), dim3(NTHR), LDS_BYTES, stream, p);
    hipLaunchKernelGGL(k_phase<5>, dim3(grid), dim3(NTHR), LDS_BYTES, stream, p);
    hipLaunchKernelGGL(k_phase<6>, dim3(grid), dim3(NTHR), LDS_BYTES, stream, p);
    hipLaunchKernelGGL(k_phase<7>, dim3(grid), dim3(NTHR), LDS_BYTES, stream, p);
}
```

```cpp
#include <hip/hip_runtime.h>
#include <hip/hip_cooperative_groups.h>
#include <cstdio>
namespace cg = cooperative_groups;

typedef unsigned short bf16_t;
typedef float f32x4 __attribute__((ext_vector_type(4)));
typedef unsigned u32x4 __attribute__((ext_vector_type(4)));
typedef unsigned u32x2 __attribute__((ext_vector_type(2)));
typedef short bf16x8 __attribute__((ext_vector_type(8)));

constexpr int T_ = 16384, D_ = 2048, DIN = 5120, NE = 32, DE = 512, SEQ = 4096, LCAP = 16384;
constexpr float EPS = 1e-6f;
constexpr int NTHR = 512;
constexpr int LDS_BYTES = 147456;
constexpr int LCNT_OFF = 131072;

constexpr size_t SZ_A = (size_t)T_ * DIN * 2;
constexpr size_t SZ_B = (size_t)T_ * D_ * 2;
constexpr size_t OFF_A = 0;
constexpr size_t OFF_B = OFF_A + SZ_A;
constexpr size_t OFF_HB = OFF_B + SZ_B;
constexpr size_t OFF_WIN = OFF_HB + SZ_B;
constexpr size_t OFF_WOUT = OFF_WIN + (size_t)DIN * D_ * 2;
constexpr size_t OFF_WGU = OFF_WOUT + (size_t)D_ * D_ * 2;
constexpr size_t OFF_WD = OFF_WGU + (size_t)NE * 1024 * D_ * 2;
constexpr size_t OFF_WR = OFF_WD + (size_t)NE * D_ * DE * 2;
constexpr size_t OFF_SSQ = OFF_WR + (size_t)48 * D_ * 2;
constexpr size_t OFF_CNT = OFF_SSQ + (size_t)3 * T_ * 4;
constexpr size_t OFF_RINFO = OFF_CNT + 256;
constexpr size_t OFF_RW = OFF_RINFO + (size_t)NE * LCAP * 4;
constexpr size_t WS_END = OFF_RW + (size_t)NE * LCAP * 4;

struct Params {
    const float *x, *norm_mix_g, *w_in, *v_norm_g, *gmlp_ws, *gmlp_bs, *conv_w, *g_a, *g_b, *w_out, *g_ffn, *rgw, *rgb, *rew, *reb, *ewg, *ewu, *ewd, *g_final;
    float* out; unsigned char* ws;
};

__device__ __forceinline__ unsigned cvt_pk_bf16(float lo, float hi) { unsigned r; asm volatile("v_cvt_pk_bf16_f32 %0, %1, %2" : "=v"(r) : "v"(lo), "v"(hi)); return r; }
__device__ __forceinline__ int opaque_tid() { int t = threadIdx.x; asm volatile("" : "+v"(t)); return t; }
__device__ __forceinline__ float bflo(unsigned w) { return __uint_as_float(w << 16); }
__device__ __forceinline__ float bfhi(unsigned w) { return __uint_as_float(w & 0xffff0000u); }
__device__ __forceinline__ float wave_sum(float v) {
#pragma unroll
    for (int o = 1; o < 64; o <<= 1) v += __shfl_xor(v, o);
    return v;
}
__device__ __forceinline__ float gelu_t(float x) {
    const float u = x * (0.7978845608f + 0.0356774081f * x * x);
    return x * __builtin_amdgcn_rcpf(1.f + __builtin_amdgcn_exp2f(-2.885390082f * u));
}
__device__ __forceinline__ float silu_f(float x) { return x * __builtin_amdgcn_rcpf(1.f + __builtin_amdgcn_exp2f(-1.442695041f * x)); }

#define PG8_LAS __attribute__((address_space(3)))
struct Unit { int pm, pn, e, r0, pnl; };

template <class CntPtr> __device__ __forceinline__ bool moe_unit(CntPtr cnt, int NT, int L, Unit& u) {
    int ptile = 0;
    for (int e = 0; e < NE; ++e) {
        const int nt = (cnt[e] + 255) >> 8, nu = nt * NT;
        if (L < nu) { const int mt = L / NT, j = L - mt * NT; u.e = e; u.pm = ptile + mt; u.r0 = mt * 256; u.pnl = j; u.pn = e * NT + j; return true; }
        L -= nu; ptile += nt;
    }
    return false;
}

struct Epi1 {
    static constexpr bool PERM = true, MIDSCALE = false;
    bf16_t* P;
    __device__ __forceinline__ void operator()(f32x4 (&acc)[2][2][4][2], const Unit& u, int wr, int wc, int fr, int fq) const {
        const bool act = u.pn < 8;
#pragma unroll
        for (int ai = 0; ai < 2; ++ai)
#pragma unroll
            for (int m = 0; m < 4; ++m) {
                const int row = u.pm * 256 + ai * 128 + wr * 64 + m * 16 + fr;
                bf16_t* rowp = P + (size_t)row * DIN + u.pn * 256 + wc * 32 + 8 * fq;
#pragma unroll
                for (int bj = 0; bj < 2; ++bj) {
                    f32x4 v0 = acc[ai][bj][m][0], v1 = acc[ai][bj][m][1];
                    if (act) {
#pragma unroll
                        for (int j = 0; j < 4; ++j) { v0[j] = gelu_t(v0[j]); v1[j] = gelu_t(v1[j]); }
                    }
                    u32x4 w; w.x = cvt_pk_bf16(v0[0], v0[1]); w.y = cvt_pk_bf16(v0[2], v0[3]); w.z = cvt_pk_bf16(v1[0], v1[1]); w.w = cvt_pk_bf16(v1[2], v1[3]);
                    *(u32x4*)(rowp + bj * 128) = w;
                }
            }
    }
};
struct Epi2 {
    static constexpr bool PERM = true, MIDSCALE = true;
    const float* x; bf16_t* hb; const float* ssq_a; const float* ssq_b; float* ssq_h;
    __device__ __forceinline__ void midscale(f32x4 (&acc)[2][2][4][2], const Unit& u, int wr, int wc, int fr, int fq) const {
        int rowb = u.pm * 256 + wr * 64 + fr; asm volatile("" : "+v"(rowb));
        const float* pa = ssq_a + rowb; const float* pb = ssq_b + rowb;
#pragma unroll
        for (int ai = 0; ai < 2; ++ai)
#pragma unroll
            for (int m = 0; m < 4; ++m) {
                const float s = __builtin_amdgcn_sqrtf((pb[ai * 128 + m * 16] * (1.f / 1024.f) + EPS) * __builtin_amdgcn_rcpf(pa[ai * 128 + m * 16] * (1.f / 1024.f) + EPS));
#pragma unroll
                for (int bj = 0; bj < 2; ++bj)
#pragma unroll
                    for (int n = 0; n < 2; ++n) acc[ai][bj][m][n] *= s;
                if (m & 1) asm volatile("" ::: "memory");
            }
    }
    __device__ __forceinline__ void operator()(f32x4 (&acc)[2][2][4][2], const Unit& u, int wr, int wc, int fr, int fq) const {
#pragma unroll
        for (int ai = 0; ai < 2; ++ai)
#pragma unroll
            for (int m = 0; m < 4; ++m) {
                const int row = u.pm * 256 + ai * 128 + wr * 64 + m * 16 + fr;
                const float rb = rsqrtf(ssq_b[row] * (1.f / 1024.f) + EPS);
                const size_t off = (size_t)row * D_ + u.pn * 256 + wc * 32 + 8 * fq;
                float ss = 0.f;
#pragma unroll
                for (int bj = 0; bj < 2; ++bj) {
                    const f32x4 x0 = *(const f32x4*)(x + off + bj * 128), x1 = *(const f32x4*)(x + off + bj * 128 + 4);
                    const f32x4 h0 = x0 + acc[ai][bj][m][0] * rb, h1 = x1 + acc[ai][bj][m][1] * rb;
                    ss += (h0[0] * h0[0] + h0[1] * h0[1]) + (h0[2] * h0[2] + h0[3] * h0[3]) + (h1[0] * h1[0] + h1[1] * h1[1]) + (h1[2] * h1[2] + h1[3] * h1[3]);
                    u32x4 w; w.x = cvt_pk_bf16(h0[0], h0[1]); w.y = cvt_pk_bf16(h0[2], h0[3]); w.z = cvt_pk_bf16(h1[0], h1[1]); w.w = cvt_pk_bf16(h1[2], h1[3]);
                    *(u32x4*)(hb + off + bj * 128) = w;
                }
                ss += __shfl_xor(ss, 16); ss += __shfl_xor(ss, 32);
                if (fq == 0) atomicAdd(ssq_h + row, ss);
                asm volatile("" ::: "memory");
            }
    }
};
struct Epi5 {
    static constexpr bool PERM = true, MIDSCALE = false;
    bf16_t* hbuf; const float* ssq_h; const int* rinfo; const int* cnt;
    __device__ __forceinline__ void operator()(f32x4 (&acc)[2][2][4][2], const Unit& u, int wr, int wc, int fr, int fq) const {
        const int ce = cnt[u.e];
#pragma unroll
        for (int ai = 0; ai < 2; ++ai)
#pragma unroll
            for (int m = 0; m < 4; ++m) {
                const int r = ai * 128 + wr * 64 + m * 16 + fr, i = u.r0 + r;
                const int tok = (i < ce) ? (rinfo[u.e * LCAP + i] >> 1) : 0;
                const float rs = rsqrtf(ssq_h[tok] * (1.f / 2048.f) + EPS);
                float o[8];
#pragma unroll
                for (int n = 0; n < 2; ++n)
#pragma unroll
                    for (int j = 0; j < 4; ++j) o[4 * n + j] = silu_f(acc[ai][0][m][n][j] * rs) * (acc[ai][1][m][n][j] * rs);
                u32x4 w; w.x = cvt_pk_bf16(o[0], o[1]); w.y = cvt_pk_bf16(o[2], o[3]); w.z = cvt_pk_bf16(o[4], o[5]); w.w = cvt_pk_bf16(o[6], o[7]);
                *(u32x4*)(hbuf + (size_t)(u.pm * 256 + r) * DE + u.pnl * 128 + wc * 32 + 8 * fq) = w;
            }
    }
};
struct Epi6 {
    static constexpr bool PERM = true, MIDSCALE = false;
    bf16_t* ys2; const int* rinfo; const float* rw; const int* cnt;
    __device__ __forceinline__ void operator()(f32x4 (&acc)[2][2][4][2], const Unit& u, int wr, int wc, int fr, int fq) const {
        const int ce = cnt[u.e];
#pragma unroll
        for (int ai = 0; ai < 2; ++ai)
#pragma unroll
            for (int m = 0; m < 4; ++m) {
                const int r = ai * 128 + wr * 64 + m * 16 + fr, i = u.r0 + r;
                if (i < ce) {
                    const int info = rinfo[u.e * LCAP + i]; const float g = rw[u.e * LCAP + i];
                    bf16_t* dst = ys2 + (size_t)info * D_ + u.pnl * 256 + wc * 32 + 8 * fq;
#pragma unroll
                    for (int bj = 0; bj < 2; ++bj) {
                        const f32x4 v0 = acc[ai][bj][m][0] * g, v1 = acc[ai][bj][m][1] * g;
                        u32x4 w; w.x = cvt_pk_bf16(v0[0], v0[1]); w.y = cvt_pk_bf16(v0[2], v0[3]); w.z = cvt_pk_bf16(v1[0], v1[1]); w.w = cvt_pk_bf16(v1[2], v1[3]);
                        *(u32x4*)(dst + bj * 128) = w;
                    }
                }
            }
    }
};

struct ASrcDirect { const bf16_t* A; int K; __device__ __forceinline__ const bf16_t* row(const Unit& u, int r) const { return A + (size_t)(u.pm * 256 + r) * K; } };
struct ASrcGather { const bf16_t* A; const int* rinfo; const int* cnt;
    __device__ __forceinline__ const bf16_t* row(const Unit& u, int r) const { const int i = u.r0 + r; const int tok = (i < cnt[u.e]) ? (rinfo[u.e * LCAP + i] >> 1) : 0; return A + (size_t)tok * D_; } };

template <class Epi, class ASrc>
__device__ __forceinline__ void gemm_simple_unit(unsigned char* lds, const ASrc& AS, const bf16_t* Bt, int K, const Epi& E, const Unit& u) {
    float* As = (float*)lds; float* Bs = As + 32 * 256;
    const int tid = opaque_tid(), wid = tid >> 6, lane = tid & 63, wr = wid >> 2, wc = wid & 3, fr = lane & 15, fq = lane >> 4;
    f32x4 acc[2][2][4][2];
#pragma unroll
    for (int a = 0; a < 2; ++a)
#pragma unroll
        for (int b = 0; b < 2; ++b)
#pragma unroll
            for (int m = 0; m < 4; ++m)
#pragma unroll
                for (int n = 0; n < 2; ++n) acc[a][b][m][n] = (f32x4){0.f, 0.f, 0.f, 0.f};
    const bf16_t* ap[2]; const bf16_t* bp[2]; int lrow[2], lkc[2];
#pragma unroll
    for (int i = 0; i < 2; ++i) { const int p = tid + 512 * i; lrow[i] = p >> 2; lkc[i] = (p & 3) * 8; ap[i] = AS.row(u, lrow[i]) + lkc[i]; bp[i] = Bt + (size_t)lrow[i] * K + lkc[i]; }
    for (int k0 = 0; k0 < K; k0 += 32) {
        if constexpr (Epi::MIDSCALE) { if (k0 == K / 2) E.midscale(acc, u, wr, wc, fr, fq); }
        __syncthreads();
#pragma unroll
        for (int i = 0; i < 2; ++i) {
            const u32x4 a = *(const u32x4*)(ap[i] + k0), b = *(const u32x4*)(bp[i] + k0);
#pragma unroll
            for (int q = 0; q < 4; ++q) {
                As[(lkc[i] + 2 * q) * 256 + lrow[i]] = bflo(a[q]); As[(lkc[i] + 2 * q + 1) * 256 + lrow[i]] = bfhi(a[q]);
                Bs[(lkc[i] + 2 * q) * 256 + lrow[i]] = bflo(b[q]); Bs[(lkc[i] + 2 * q + 1) * 256 + lrow[i]] = bfhi(b[q]);
            }
        }
        __syncthreads();
#pragma unroll 2
        for (int k = 0; k < 32; ++k) {
            float a[2][4]; f32x4 b[2][2];
#pragma unroll
            for (int ai = 0; ai < 2; ++ai)
#pragma unroll
                for (int m = 0; m < 4; ++m) a[ai][m] = As[k * 256 + ai * 128 + wr * 64 + m * 16 + fr];
#pragma unroll
            for (int bj = 0; bj < 2; ++bj)
#pragma unroll
                for (int n = 0; n < 2; ++n) b[bj][n] = *(const f32x4*)&Bs[k * 256 + bj * 128 + wc * 32 + (Epi::PERM ? (8 * fq + 4 * n) : (16 * n + 4 * fq))];
#pragma unroll
            for (int ai = 0; ai < 2; ++ai)
#pragma unroll
                for (int bj = 0; bj < 2; ++bj)
#pragma unroll
                    for (int m = 0; m < 4; ++m)
#pragma unroll
                        for (int n = 0; n < 2; ++n) acc[ai][bj][m][n] += a[ai][m] * b[bj][n];
        }
    }
    E(acc, u, wr, wc, fr, fq);
    __syncthreads();
}


namespace pg8 {
constexpr int BM = 256, BK = 64, HALF = 128, HTB = HALF * BK * 2, STAGE_BYTES = 8 * HTB, NXCD = 8, WGM = 8;
__host__ __device__ __forceinline__ int lds_byte(int r, int c) { const int st = (r >> 4) * 2 + (c >> 5), rr = r & 15, cc = c & 31, ob = rr * 64 + cc * 2; return st * 1024 + (ob ^ (((ob >> 9) & 1) << 5)); }
__host__ __device__ __forceinline__ void stage_rc(int b, int& R, int& C) { const int st = b / 1024, sb = b % 1024, swz = sb ^ (((sb >> 9) & 1) << 5); R = (st >> 1) * 16 + swz / 64; C = (st & 1) * 32 + (swz % 64) / 2; }
__host__ __device__ __forceinline__ int perm32(int rho) { const int n = rho >> 4, i = rho & 15; return 8 * (i >> 2) + 4 * n + (i & 3); }

struct StaticOrder {
    int nM, nN, nwg, G, c;
    __device__ void init(int M, int N, int G_, int c_) { nM = M / BM; nN = N / BM; nwg = nM * nN; G = G_; c = c_; }
    __device__ bool next(int i, Unit& u) const {
        const long L = (long)i * G + c; if (L >= nwg) return false;
        int wgid = (int)L; { const int q = nwg / NXCD, r = nwg % NXCD, xcd = wgid % NXCD, off = wgid / NXCD; wgid = (xcd < r ? xcd * (q + 1) : r * (q + 1) + (xcd - r) * q) + off; }
        const int nig = WGM * nN, gid = wgid / nig, fm = gid * WGM, gsz = (nM - fm) < WGM ? (nM - fm) : WGM;
        u.pm = fm + ((wgid % nig) % gsz); u.pn = (wgid % nig) / gsz; u.e = 0; u.r0 = 0; u.pnl = u.pn; return true;
    }
};
typedef const PG8_LAS int* lcnt_t;
struct MoeOrder {
    lcnt_t cnt; int NT, G, c;
    __device__ bool next(int i, Unit& u) const { return moe_unit(cnt, NT, i * G + c, u); }
};
struct AOffDirect { int K; __device__ __forceinline__ unsigned operator()(const Unit& u, int h, int R, int C) const { return (unsigned)(((u.pm * 256 + h * 128 + R) * K + C) * 2); } };
struct AOffGather { const int* rinfo; lcnt_t cnt;
    __device__ __forceinline__ unsigned operator()(const Unit& u, int h, int R, int C) const { const int i = u.r0 + h * 128 + R; const int tok = (i < cnt[u.e]) ? (rinfo[u.e * LCAP + i] >> 1) : 0; return (unsigned)((tok * D_ + C) * 2); } };

template <class Epi, class Sched, class AOff, bool ALIGN_EPI>
__device__ __forceinline__ void gemm_phase(PG8_LAS unsigned char* lds, const bf16_t* Ag, const bf16_t* Btg, const int K, const Sched& S, const AOff& AO, const Epi& E) {
    const int tid = opaque_tid(), wid = __builtin_amdgcn_readfirstlane(tid >> 6), lane = tid & 63, wr = wid >> 2, wc = wid & 3, fr = lane & 15, fq = lane >> 4;
    const int nt = K / BK;
    unsigned voffB[2];
#pragma unroll
    for (int i = 0; i < 2; ++i) { int R, C; stage_rc(tid * 16 + i * 8192, R, C); const int Rb = Epi::PERM ? ((R & ~31) + perm32(R & 31)) : R; voffB[i] = (unsigned)(Rb * K + C) * 2u; }
#define PG8_AOFFS(u) do { int _t = tid; asm volatile("" : "+v"(_t)); _Pragma("unroll") for (int _i = 0; _i < 2; ++_i) { int _R, _C; stage_rc(_t * 16 + _i * 8192, _R, _C); vo0[_i] = AO(u, 0, _R, _C); vo1[_i] = AO(u, 1, _R, _C); } } while (0)
    const size_t kstep = (size_t)(BK * 2), hstep = (size_t)HALF * K * 2, tstep = 2 * hstep;
    const unsigned ldsw = (unsigned)wid * 1024u;
    const int aoff = lds_byte(wr * 64 + fr, fq * 8), boff = lds_byte(wc * 32 + fr, fq * 8);
    const char* const Ab = (const char*)Ag;
#define PG8_SA(b, h) (((b) * 2 + (h)) * HTB)
#define PG8_SB(b, h) ((4 + (b) * 2 + (h)) * HTB)
#define PG8_STAGE(bufoff, gbase, voff) do { _Pragma("unroll") for (int _i = 0; _i < 2; ++_i) \
        __builtin_amdgcn_global_load_lds((const unsigned*)((const char*)(gbase) + (voff)[_i]), (PG8_LAS unsigned*)(lds + (bufoff) + ldsw + _i * 8192), 16, 0, 0); } while (0)
#define PG8_LDA(dst, b, h) do { _Pragma("unroll") for (int m = 0; m < 4; ++m) _Pragma("unroll") for (int k = 0; k < 2; ++k) dst[m][k] = *(const PG8_LAS bf16x8*)(lds + PG8_SA(b, h) + aoff + m * 2048 + k * 1024); } while (0)
#define PG8_LDB(dst, b, h) do { _Pragma("unroll") for (int n = 0; n < 2; ++n) _Pragma("unroll") for (int k = 0; k < 2; ++k) dst[n][k] = *(const PG8_LAS bf16x8*)(lds + PG8_SB(b, h) + boff + n * 2048 + k * 1024); } while (0)
#define PG8_MMA(ai, bj, At, Bt) do { __builtin_amdgcn_s_setprio(1); _Pragma("unroll") for (int m = 0; m < 4; ++m) _Pragma("unroll") for (int n = 0; n < 2; ++n) _Pragma("unroll") for (int k = 0; k < 2; ++k) \
        acc[ai][bj][m][n] = __builtin_amdgcn_mfma_f32_16x16x32_bf16(Bt[n][k], At[m][k], acc[ai][bj][m][n], 0, 0, 0); __builtin_amdgcn_s_setprio(0); } while (0)
#define PG8_WAIT_V(n) asm volatile("s_waitcnt vmcnt(" #n ")" ::: "memory")
#define PG8_WAIT_L(n) asm volatile("s_waitcnt lgkmcnt(" #n ")" ::: "memory")
#define PG8_BAR __builtin_amdgcn_s_barrier()
#define PG8_SCHED __builtin_amdgcn_sched_barrier(0)
    Unit cur, nxt; int ui = 0;
    if (!S.next(0, cur)) return;
    f32x4 acc[2][2][4][2];
#pragma unroll
    for (int a = 0; a < 2; ++a)
#pragma unroll
        for (int b = 0; b < 2; ++b)
#pragma unroll
            for (int m = 0; m < 4; ++m)
#pragma unroll
                for (int n = 0; n < 2; ++n) acc[a][b][m][n] = (f32x4){0.f, 0.f, 0.f, 0.f};
    bf16x8 At[4][2], B0[2][2], B1[2][2];
    unsigned vo0[2], vo1[2];
    PG8_AOFFS(cur);
    const char* cB = (const char*)Btg + (size_t)cur.pn * tstep;
    PG8_STAGE(PG8_SB(0, 0), cB, voffB); PG8_STAGE(PG8_SB(0, 1), cB + hstep, voffB); PG8_STAGE(PG8_SA(0, 0), Ab, vo0); PG8_STAGE(PG8_SA(0, 1), Ab, vo1);
    if (wr == 1) PG8_BAR;
    PG8_WAIT_V(2); PG8_BAR;
    PG8_STAGE(PG8_SB(1, 0), cB + kstep, voffB); PG8_STAGE(PG8_SA(1, 0), Ab + kstep, vo0); PG8_STAGE(PG8_SB(1, 1), cB + hstep + kstep, voffB);
    PG8_WAIT_V(6); PG8_BAR;
    for (;;) {
        const bool has_next = S.next(ui + 1, nxt);
        const char* nB = has_next ? (const char*)Btg + (size_t)nxt.pn * tstep : cB;
        for (int t = 0; t < nt; t += 2) {
            const bool last = (t == nt - 2);
            if constexpr (Epi::MIDSCALE) { if (t == nt / 2) { int _t = tid; asm volatile("" : "+v"(_t)); const int _l = _t & 63; E.midscale(acc, cur, wr, wc, _l & 15, _l >> 4); } }
            const size_t k1 = (size_t)(t + 1) * kstep, k2 = last ? (size_t)0 : (size_t)(t + 2) * kstep, k3 = k2 + kstep;
            const char* b2 = last ? nB : cB + (size_t)(t + 2) * kstep; const char* b3 = b2 + kstep;
            PG8_LDB(B0, 0, 0); PG8_LDB(B1, 0, 1); PG8_SCHED; PG8_LDA(At, 0, 0); PG8_STAGE(PG8_SA(1, 1), Ab + k1, vo1);
            PG8_WAIT_V(8); PG8_WAIT_L(0); PG8_BAR; PG8_MMA(0, 0, At, B0); PG8_MMA(0, 1, At, B1); PG8_BAR; PG8_SCHED;
            if (last && has_next) { PG8_AOFFS(nxt); }
            PG8_LDA(At, 0, 1); PG8_STAGE(PG8_SB(0, 0), b2, voffB); PG8_STAGE(PG8_SB(0, 1), b2 + hstep, voffB); PG8_STAGE(PG8_SA(0, 0), Ab + k2, vo0);
            PG8_WAIT_V(8); PG8_WAIT_L(0); PG8_BAR; PG8_MMA(1, 0, At, B0); PG8_MMA(1, 1, At, B1); PG8_BAR; PG8_SCHED;
            PG8_LDB(B0, 1, 0); PG8_LDB(B1, 1, 1); PG8_SCHED; PG8_LDA(At, 1, 0); PG8_STAGE(PG8_SA(0, 1), Ab + k2, vo1);
            PG8_WAIT_V(8); PG8_WAIT_L(0); PG8_BAR; PG8_MMA(0, 0, At, B0); PG8_MMA(0, 1, At, B1); PG8_BAR; PG8_SCHED;
            PG8_LDA(At, 1, 1); PG8_STAGE(PG8_SB(1, 0), b3, voffB); PG8_STAGE(PG8_SB(1, 1), b3 + hstep, voffB); PG8_STAGE(PG8_SA(1, 0), Ab + k3, vo0);
            PG8_WAIT_V(8); PG8_WAIT_L(0); PG8_BAR; PG8_MMA(1, 0, At, B0); PG8_MMA(1, 1, At, B1); PG8_BAR; PG8_SCHED;
        }
        if constexpr (ALIGN_EPI) { if (wr == 0) PG8_BAR; }
        { int _t = tid; asm volatile("" : "+v"(_t)); const int _l = _t & 63; E(acc, cur, wr, wc, _l & 15, _l >> 4); }
        if (!has_next) break;
#pragma unroll
        for (int a = 0; a < 2; ++a)
#pragma unroll
            for (int b = 0; b < 2; ++b)
#pragma unroll
                for (int m = 0; m < 4; ++m)
#pragma unroll
                    for (int n = 0; n < 2; ++n) acc[a][b][m][n] = (f32x4){0.f, 0.f, 0.f, 0.f};
        cur = nxt; cB = nB; ++ui;
        if constexpr (ALIGN_EPI) { if (wr == 1) PG8_BAR; }
    }
    PG8_WAIT_V(0);
    if constexpr (!ALIGN_EPI) { if (wr == 0) PG8_BAR; }
    PG8_BAR;
#undef PG8_AOFFS
#undef PG8_SA
#undef PG8_SB
#undef PG8_STAGE
#undef PG8_LDA
#undef PG8_LDB
#undef PG8_MMA
#undef PG8_WAIT_V
#undef PG8_WAIT_L
#undef PG8_BAR
#undef PG8_SCHED
}
}

#ifndef FAST_MASK
#define FAST_MASK 0x6A
#endif

__device__ __forceinline__ void transpose_tile(float* lt, const float* src, int ldsrc, int r0, int c0, bf16_t* dst, int lddst, int dr0, const float* sA, const float* sB, int split) {
    const int tid = opaque_tid();
    { const int r = tid >> 3, cc = (tid & 7) * 8;
      const float* s = src + (size_t)(r0 + r) * ldsrc + c0 + cc;
      const f32x4 v0 = *(const f32x4*)s, v1 = *(const f32x4*)(s + 4);
      float sc = 1.f; if (sA) { const int rr = r0 + r; sc = rr < split ? sA[rr] : sB[rr - split]; }
#pragma unroll
      for (int q = 0; q < 4; ++q) { lt[r * 65 + cc + q] = v0[q] * sc; lt[r * 65 + cc + 4 + q] = v1[q] * sc; } }
    __syncthreads();
    { const int c = tid >> 3, rr = (tid & 7) * 8;
      float v[8];
#pragma unroll
      for (int q = 0; q < 8; ++q) v[q] = lt[(rr + q) * 65 + c];
      u32x4 w; w.x = cvt_pk_bf16(v[0], v[1]); w.y = cvt_pk_bf16(v[2], v[3]); w.z = cvt_pk_bf16(v[4], v[5]); w.w = cvt_pk_bf16(v[6], v[7]);
      *(u32x4*)(dst + (size_t)(dr0 + c) * lddst + r0 + rr) = w; }
    __syncthreads();
}
__device__ __forceinline__ void phase0(const Params& p, unsigned char* lds) {
    const int tid = opaque_tid(), nb = gridDim.x, bid = blockIdx.x, wid = tid >> 6, lane = tid & 63;
    { float* z = (float*)(p.ws + OFF_SSQ);
      for (int i = bid * NTHR + tid; i < 3 * T_ + 64; i += nb * NTHR) z[i] = 0.f; }
    { bf16_t* wrt = (bf16_t*)(p.ws + OFF_WR);
      for (int i = bid * NTHR + tid; i < 48 * D_; i += nb * NTHR) {
          const int o = i >> 11, k = i & 2047; float v = 0.f;
          if (o < 4) v = p.rgw[k * 4 + o]; else if (o < 36) v = p.rew[k * 32 + (o - 4)];
          wrt[i] = (bf16_t)(cvt_pk_bf16(v * p.g_ffn[k], 0.f) & 0xffffu); } }
    { bf16_t* xn = (bf16_t*)(p.ws + OFF_B);
      for (int row = bid * 8 + wid; row < T_; row += nb * 8) {
          const float* xr = p.x + (size_t)row * D_;
          f32x4 v[8]; float s = 0.f;
#pragma unroll
          for (int i = 0; i < 8; ++i) { v[i] = *(const f32x4*)(xr + i * 256 + lane * 4); s += (v[i][0] * v[i][0] + v[i][1] * v[i][1]) + (v[i][2] * v[i][2] + v[i][3] * v[i][3]); }
          const float rstd = rsqrtf(wave_sum(s) * (1.f / D_) + EPS);
#pragma unroll
          for (int i = 0; i < 8; ++i) { const f32x4 g = *(const f32x4*)(p.norm_mix_g + i * 256 + lane * 4); const f32x4 o = v[i] * rstd * g;
              u32x2 w; w.x = cvt_pk_bf16(o[0], o[1]); w.y = cvt_pk_bf16(o[2], o[3]); *(u32x2*)(xn + (size_t)row * D_ + i * 256 + lane * 4) = w; } } }
    float* lt = (float*)lds;
    constexpr int N_IN = 32 * 80, N_OUT = 32 * 32, N_G = 32 * 256, N_TOT = N_IN + N_OUT + 3 * N_G;
    for (int tile = bid; tile < N_TOT; tile += nb) {
        int q = tile;
        if (q < N_IN) { const int tr = q / 80, tc = q % 80; transpose_tile(lt, p.w_in, DIN, tr * 64, tc * 64, (bf16_t*)(p.ws + OFF_WIN), D_, tc * 64, nullptr, nullptr, 0); continue; } q -= N_IN;
        if (q < N_OUT) { const int tr = q / 32, tc = q % 32; transpose_tile(lt, p.w_out, D_, tr * 64, tc * 64, (bf16_t*)(p.ws + OFF_WOUT), D_, tc * 64, p.g_a, p.g_b, 1024); continue; } q -= N_OUT;
        if (q < 2 * N_G) { const int up = q >= N_G; if (up) q -= N_G; const int e = q >> 8, rem = q & 255, tr = rem >> 3, tc = rem & 7; const int c0 = tc * 64;
            transpose_tile(lt, (up ? p.ewu : p.ewg) + (size_t)e * D_ * DE, DE, tr * 64, c0, (bf16_t*)(p.ws + OFF_WGU) + (size_t)e * 1024 * D_, D_, (c0 >> 7) * 256 + (up ? 128 : 0) + (c0 & 127), p.g_ffn, p.g_ffn, 1 << 30); continue; } q -= 2 * N_G;
        { const int e = q >> 8, rem = q & 255, tr = rem >> 5, tc = rem & 31;
          transpose_tile(lt, p.ewd + (size_t)e * DE * D_, D_, tr * 64, tc * 64, (bf16_t*)(p.ws + OFF_WD) + (size_t)e * D_ * DE, DE, tc * 64, nullptr, nullptr, 0); }
    }
}

__device__ __forceinline__ void phase1(const Params& p, unsigned char* lds) {
    const ASrcDirect AS{(const bf16_t*)(p.ws + OFF_B), D_}; const Epi1 E{(bf16_t*)(p.ws + OFF_A)};
    const bf16_t* Bt = (const bf16_t*)(p.ws + OFF_WIN);
    if (FAST_MASK & 2) { pg8::StaticOrder S; S.init(T_, DIN, gridDim.x, blockIdx.x); const pg8::AOffDirect AO{D_};
        pg8::gemm_phase<Epi1, pg8::StaticOrder, pg8::AOffDirect, true>((PG8_LAS unsigned char*)lds, AS.A, Bt, D_, S, AO, E); return; }
    for (int L = blockIdx.x; L < 64 * 20; L += gridDim.x) { Unit u; u.pm = L / 20; u.pn = L % 20; u.e = 0; u.r0 = 0; u.pnl = u.pn;
        gemm_simple_unit(lds, AS, Bt + (size_t)u.pn * 256 * D_, D_, E, u); }
}

__device__ __forceinline__ void mixer_gmlp_item(const Params& p, unsigned char* lds, int item) {
    const int tid = opaque_tid(), wid = tid >> 6, lane = tid & 63, fr = lane & 15, fq = lane >> 4;
    const int h = item & 7, t0 = (item >> 3) * 128;
    const bf16_t* P = (const bf16_t*)(p.ws + OFF_A); bf16_t* Y = (bf16_t*)(p.ws + OFF_B); float* ssq_a = (float*)(p.ws + OFF_SSQ);
    bf16_t* Vt = (bf16_t*)lds;
    bf16_t* Wl = Vt + 128 * 136;
    float* rs = (float*)(Wl + 128 * 136);
    { const int j = tid >> 2, dc = (tid & 3) * 32;
      const u32x4* src = (const u32x4*)(P + (size_t)(t0 + j) * DIN + 1024 + h * 128 + dc);
      u32x4 v[4]; float s = 0.f;
#pragma unroll
      for (int q = 0; q < 4; ++q) { v[q] = src[q];
#pragma unroll
          for (int w = 0; w < 4; ++w) { const float lo = bflo(v[q][w]), hi = bfhi(v[q][w]); s += lo * lo + hi * hi; } }
      s += __shfl_xor(s, 1); s += __shfl_xor(s, 2);
      if ((tid & 3) == 0) rs[j] = rsqrtf(s * (1.f / 128.f) + EPS);
#pragma unroll
      for (int q = 0; q < 4; ++q)
#pragma unroll
          for (int w = 0; w < 4; ++w) { const int d = dc + q * 8 + w * 2; Vt[d * 136 + j] = (bf16_t)(v[q][w] & 0xffffu); Vt[(d + 1) * 136 + j] = (bf16_t)(v[q][w] >> 16); } }
    __syncthreads();
    { const int i = tid >> 2, jc = (tid & 3) * 32;
      const f32x4* src = (const f32x4*)(p.gmlp_ws + (size_t)h * 16384 + i * 128 + jc);
      const bool live = (i >> 6) >= (jc >> 6);
#pragma unroll
      for (int q = 0; q < 4; ++q) { f32x4 w0 = src[2 * q], w1 = src[2 * q + 1];
          const f32x4 r0 = *(const f32x4*)(rs + jc + 8 * q), r1 = *(const f32x4*)(rs + jc + 8 * q + 4);
          w0 = live ? w0 * r0 : (f32x4){0.f, 0.f, 0.f, 0.f}; w1 = live ? w1 * r1 : (f32x4){0.f, 0.f, 0.f, 0.f};
          u32x4 o; o.x = cvt_pk_bf16(w0[0], w0[1]); o.y = cvt_pk_bf16(w0[2], w0[3]); o.z = cvt_pk_bf16(w1[0], w1[1]); o.w = cvt_pk_bf16(w1[2], w1[3]);
          *(u32x4*)(Wl + i * 136 + jc + 8 * q) = o; } }
    __syncthreads();
    f32x4 acc[8];
#pragma unroll
    for (int n = 0; n < 8; ++n) acc[n] = (f32x4){0.f, 0.f, 0.f, 0.f};
    const int ksteps = (wid < 4) ? 2 : 4;
    for (int ks = 0; ks < ksteps; ++ks) {
        const bf16x8 bw = *(const bf16x8*)(Wl + (16 * wid + fr) * 136 + ks * 32 + fq * 8);
#pragma unroll
        for (int n = 0; n < 8; ++n) { const bf16x8 av = *(const bf16x8*)(Vt + (16 * n + fr) * 136 + ks * 32 + fq * 8);
            acc[n] = __builtin_amdgcn_mfma_f32_16x16x32_bf16(av, bw, acc[n], 0, 0, 0); }
    }
    { const int i = 16 * wid + fr, t = t0 + i; const float bias = p.gmlp_bs[h * 128 + i]; float ss = 0.f;
#pragma unroll
      for (int n = 0; n < 8; ++n) { const int c = h * 128 + 16 * n + 4 * fq;
          const f32x4 g = *(const f32x4*)(p.v_norm_g + c); const u32x2 uu = *(const u32x2*)(P + (size_t)t * DIN + c);
          const float y0 = bflo(uu.x) * (acc[n][0] * g[0] + bias), y1 = bfhi(uu.x) * (acc[n][1] * g[1] + bias), y2 = bflo(uu.y) * (acc[n][2] * g[2] + bias), y3 = bfhi(uu.y) * (acc[n][3] * g[3] + bias);
          ss += (y0 * y0 + y1 * y1) + (y2 * y2 + y3 * y3);
          u32x2 w; w.x = cvt_pk_bf16(y0, y1); w.y = cvt_pk_bf16(y2, y3); *(u32x2*)(Y + (size_t)t * D_ + c) = w; }
      ss += __shfl_xor(ss, 16); ss += __shfl_xor(ss, 32);
      if (fq == 0) atomicAdd(ssq_a + t, ss); }
    __syncthreads();
}
__device__ __forceinline__ void mixer_conv_item(const Params& p, int item) {
    const int tid = opaque_tid(), cl = tid & 31, ts = tid >> 5;
    const int c = (item & 3) * 256 + cl * 8, tbeg = (item >> 2) * 128 + ts * 8;
    const bf16_t* P = (const bf16_t*)(p.ws + OFF_A); bf16_t* Y = (bf16_t*)(p.ws + OFF_B); float* ssq_b = (float*)(p.ws + OFF_SSQ) + T_;
    float w0[8], w1[8], w2[8], z1[8], z2[8];
    { const f32x4 a0 = *(const f32x4*)(p.conv_w + c), a1 = *(const f32x4*)(p.conv_w + c + 4), b0 = *(const f32x4*)(p.conv_w + 1024 + c), b1 = *(const f32x4*)(p.conv_w + 1024 + c + 4),
                  c0 = *(const f32x4*)(p.conv_w + 2048 + c), c1 = *(const f32x4*)(p.conv_w + 2048 + c + 4);
#pragma unroll
      for (int q = 0; q < 4; ++q) { w0[q] = a0[q]; w0[4 + q] = a1[q]; w1[q] = b0[q]; w1[4 + q] = b1[q]; w2[q] = c0[q]; w2[4 + q] = c1[q]; } }
#pragma unroll
    for (int q = 0; q < 8; ++q) { z1[q] = 0.f; z2[q] = 0.f; }
    if ((tbeg % SEQ) != 0) {
        const u32x4 ca = *(const u32x4*)(P + (size_t)(tbeg - 1) * DIN + 3072 + c), ha = *(const u32x4*)(P + (size_t)(tbeg - 1) * DIN + 4096 + c);
        const u32x4 cb = *(const u32x4*)(P + (size_t)(tbeg - 2) * DIN + 3072 + c), hb2 = *(const u32x4*)(P + (size_t)(tbeg - 2) * DIN + 4096 + c);
#pragma unroll
        for (int q = 0; q < 4; ++q) { z1[2 * q] = bflo(ca[q]) * bflo(ha[q]); z1[2 * q + 1] = bfhi(ca[q]) * bfhi(ha[q]); z2[2 * q] = bflo(cb[q]) * bflo(hb2[q]); z2[2 * q + 1] = bfhi(cb[q]) * bfhi(hb2[q]); }
    }
    for (int tt = 0; tt < 8; ++tt) {
        const int t = tbeg + tt; const bf16_t* pr = P + (size_t)t * DIN + c;
        const u32x4 bg = *(const u32x4*)(pr + 2048), cgv = *(const u32x4*)(pr + 3072), hv = *(const u32x4*)(pr + 4096);
        float z[8], y[8], ss = 0.f;
#pragma unroll
        for (int q = 0; q < 4; ++q) { z[2 * q] = bflo(cgv[q]) * bflo(hv[q]); z[2 * q + 1] = bfhi(cgv[q]) * bfhi(hv[q]); }
#pragma unroll
        for (int q = 0; q < 4; ++q) {
            y[2 * q] = bflo(bg[q]) * (w0[2 * q] * z2[2 * q] + w1[2 * q] * z1[2 * q] + w2[2 * q] * z[2 * q]);
            y[2 * q + 1] = bfhi(bg[q]) * (w0[2 * q + 1] * z2[2 * q + 1] + w1[2 * q + 1] * z1[2 * q + 1] + w2[2 * q + 1] * z[2 * q + 1]); }
#pragma unroll
        for (int q = 0; q < 8; ++q) { ss += y[q] * y[q]; z2[q] = z1[q]; z1[q] = z[q]; }
        u32x4 w; w.x = cvt_pk_bf16(y[0], y[1]); w.y = cvt_pk_bf16(y[2], y[3]); w.z = cvt_pk_bf16(y[4], y[5]); w.w = cvt_pk_bf16(y[6], y[7]);
        *(u32x4*)(Y + (size_t)t * D_ + 1024 + c) = w;
        ss += __shfl_xor(ss, 1); ss += __shfl_xor(ss, 2); ss += __shfl_xor(ss, 4); ss += __shfl_xor(ss, 8); ss += __shfl_xor(ss, 16);
        if (cl == 0) atomicAdd(ssq_b + t, ss);
    }
}
__device__ __forceinline__ void phase2(const Params& p, unsigned char* lds) {
    for (int it = blockIdx.x; it < 512 + 1024; it += gridDim.x) { if (it < 512) mixer_conv_item(p, it); else mixer_gmlp_item(p, lds, it - 512); }
}

__device__ __forceinline__ void phase3(const Params& p, unsigned char* lds) {
    const ASrcDirect AS{(const bf16_t*)(p.ws + OFF_B), D_};
    float* ssq = (float*)(p.ws + OFF_SSQ);
    const Epi2 E{p.x, (bf16_t*)(p.ws + OFF_HB), ssq, ssq + T_, ssq + 2 * T_};
    const bf16_t* Bt = (const bf16_t*)(p.ws + OFF_WOUT);
    if (FAST_MASK & 8) { pg8::StaticOrder S; S.init(T_, D_, gridDim.x, blockIdx.x); const pg8::AOffDirect AO{D_};
        pg8::gemm_phase<Epi2, pg8::StaticOrder, pg8::AOffDirect, true>((PG8_LAS unsigned char*)lds, AS.A, Bt, D_, S, AO, E); return; }
    for (int L = blockIdx.x; L < 64 * 8; L += gridDim.x) { Unit u; u.pm = L / 8; u.pn = L % 8; u.e = 0; u.r0 = 0; u.pnl = u.pn;
        gemm_simple_unit(lds, AS, Bt + (size_t)u.pn * 256 * D_, D_, E, u); }
}

__device__ __forceinline__ void route_item(const Params& p, unsigned char* lds, int item) {
    const int tid = opaque_tid(), wid = tid >> 6, lane = tid & 63, fr = lane & 15, fq = lane >> 4;
    float* lg = (float*)lds;
    int* lcnt = (int*)(lg + 8 * 16 * 48); int* lbase = lcnt + 32;
    const bf16_t* hb = (const bf16_t*)(p.ws + OFF_HB); const bf16_t* wrt = (const bf16_t*)(p.ws + OFF_WR);
    const float* ssq_h = (const float*)(p.ws + OFF_SSQ) + 2 * T_;
    int* cnt = (int*)(p.ws + OFF_CNT); int* rinfo = (int*)(p.ws + OFF_RINFO); float* rw = (float*)(p.ws + OFF_RW);
    const int tw = item * 128 + wid * 16;
    if (tid < 32) lcnt[tid] = 0;
    f32x4 acc[3];
#pragma unroll
    for (int n = 0; n < 3; ++n) acc[n] = (f32x4){0.f, 0.f, 0.f, 0.f};
    const bf16_t* ap = hb + (size_t)(tw + fr) * D_ + fq * 8; const bf16_t* bp = wrt + (size_t)fr * D_ + fq * 8;
#pragma unroll 4
    for (int ks = 0; ks < 64; ++ks) { const bf16x8 a = *(const bf16x8*)(ap + ks * 32);
#pragma unroll
        for (int n = 0; n < 3; ++n) { const bf16x8 b = *(const bf16x8*)(bp + (size_t)n * 16 * D_ + ks * 32); acc[n] = __builtin_amdgcn_mfma_f32_16x16x32_bf16(a, b, acc[n], 0, 0, 0); } }
#pragma unroll
    for (int n = 0; n < 3; ++n)
#pragma unroll
        for (int j = 0; j < 4; ++j) lg[(wid * 16 + 4 * fq + j) * 48 + 16 * n + fr] = acc[n][j];
    __syncthreads();
    int e0 = 0, e1 = 0, r0 = 0, r1 = 0; float g0 = 0.f, g1 = 0.f; const int t = tw + lane;
    if (lane < 16) {
        const float* l = lg + (wid * 16 + lane) * 48; const float rstd = rsqrtf(ssq_h[t] * (1.f / D_) + EPS);
        float gm = -3.0e38f; int gi = 0; float gl[4];
#pragma unroll
        for (int o = 0; o < 4; ++o) { gl[o] = l[o] * rstd + p.rgb[o]; if (gl[o] > gm) { gm = gl[o]; gi = o; } }
        float gs = 0.f;
#pragma unroll
        for (int o = 0; o < 4; ++o) gs += __expf(gl[o] - gm);
        const float pg = 1.f / gs;
        float b1 = -3.0e38f, b2 = -3.0e38f; int i1 = 0, i2 = 0;
        for (int q = 0; q < 8; ++q) { const float v = l[4 + gi * 8 + q] * rstd + p.reb[gi * 8 + q];
            if (v > b1) { b2 = b1; i2 = i1; b1 = v; i1 = q; } else if (v > b2) { b2 = v; i2 = q; } }
        const float wa = 1.f / (1.f + __expf(b2 - b1));
        e0 = gi * 8 + i1; e1 = gi * 8 + i2; g0 = pg * wa; g1 = pg * (1.f - wa);
        r0 = atomicAdd(&lcnt[e0], 1); r1 = atomicAdd(&lcnt[e1], 1);
    }
    __syncthreads();
    if (tid < 32) lbase[tid] = atomicAdd(cnt + tid, lcnt[tid]);
    __syncthreads();
    if (lane < 16) { const int i0 = lbase[e0] + r0, i1 = lbase[e1] + r1;
        rinfo[e0 * LCAP + i0] = 2 * t; rw[e0 * LCAP + i0] = g0; rinfo[e1 * LCAP + i1] = 2 * t + 1; rw[e1 * LCAP + i1] = g1; }
    __syncthreads();
}
__device__ __forceinline__ void phase4(const Params& p, unsigned char* lds) { for (int it = blockIdx.x; it < T_ / 128; it += gridDim.x) route_item(p, lds, it); }

__device__ __forceinline__ void phase5(const Params& p, unsigned char* lds) {
    const int* cnt = (const int*)(p.ws + OFF_CNT); const int* rinfo = (const int*)(p.ws + OFF_RINFO);
    const ASrcGather AS{(const bf16_t*)(p.ws + OFF_HB), rinfo, cnt};
    const Epi5 E{(bf16_t*)(p.ws + OFF_B), (const float*)(p.ws + OFF_SSQ) + 2 * T_, rinfo, cnt};
    const bf16_t* Bt = (const bf16_t*)(p.ws + OFF_WGU);
    if (FAST_MASK & 32) { PG8_LAS int* lc = (PG8_LAS int*)((PG8_LAS unsigned char*)lds + LCNT_OFF);
        if (threadIdx.x < NE) lc[threadIdx.x] = __hip_atomic_load(cnt + threadIdx.x, __ATOMIC_RELAXED, __HIP_MEMORY_SCOPE_AGENT);
        __syncthreads();
        const pg8::MoeOrder S{lc, 4, (int)gridDim.x, (int)blockIdx.x}; const pg8::AOffGather AO{rinfo, lc};
        pg8::gemm_phase<Epi5, pg8::MoeOrder, pg8::AOffGather, true>((PG8_LAS unsigned char*)lds, AS.A, Bt, D_, S, AO, E); return; }
    for (int L = blockIdx.x;; L += gridDim.x) { Unit u; if (!moe_unit(cnt, 4, L, u)) break; gemm_simple_unit(lds, AS, Bt + (size_t)u.pn * 256 * D_, D_, E, u); }
}
__device__ __forceinline__ void phase6(const Params& p, unsigned char* lds) {
    const int* cnt = (const int*)(p.ws + OFF_CNT); const int* rinfo = (const int*)(p.ws + OFF_RINFO);
    const ASrcDirect AS{(const bf16_t*)(p.ws + OFF_B), DE};
    const Epi6 E{(bf16_t*)(p.ws + OFF_A), rinfo, (const float*)(p.ws + OFF_RW), cnt};
    const bf16_t* Bt = (const bf16_t*)(p.ws + OFF_WD);
    if (FAST_MASK & 64) { PG8_LAS int* lc = (PG8_LAS int*)((PG8_LAS unsigned char*)lds + LCNT_OFF);
        if (threadIdx.x < NE) lc[threadIdx.x] = __hip_atomic_load(cnt + threadIdx.x, __ATOMIC_RELAXED, __HIP_MEMORY_SCOPE_AGENT);
        __syncthreads();
        const pg8::MoeOrder S{lc, 8, (int)gridDim.x, (int)blockIdx.x}; const pg8::AOffDirect AO{DE};
        pg8::gemm_phase<Epi6, pg8::MoeOrder, pg8::AOffDirect, true>((PG8_LAS unsigned char*)lds, AS.A, Bt, DE, S, AO, E); return; }
    for (int L = blockIdx.x;; L += gridDim.x) { Unit u; if (!moe_unit(cnt, 8, L, u)) break; gemm_simple_unit(lds, AS, Bt + (size_t)u.pn * 256 * DE, DE, E, u); }
}
__device__ __forceinline__ void phase7(const Params& p) {
    const int tid = opaque_tid(), wid = tid >> 6, lane = tid & 63;
    const bf16_t* hb = (const bf16_t*)(p.ws + OFF_HB); const bf16_t* ys2 = (const bf16_t*)(p.ws + OFF_A);
    for (int t = blockIdx.x * 8 + wid; t < T_; t += gridDim.x * 8) {
        float v[4][8]; float s = 0.f;
#pragma unroll
        for (int i = 0; i < 4; ++i) { const int c = i * 512 + lane * 8;
            const u32x4 a = *(const u32x4*)(hb + (size_t)t * D_ + c), b = *(const u32x4*)(ys2 + (size_t)(2 * t) * D_ + c), d = *(const u32x4*)(ys2 + (size_t)(2 * t + 1) * D_ + c);
#pragma unroll
            for (int q = 0; q < 4; ++q) { v[i][2 * q] = bflo(a[q]) + bflo(b[q]) + bflo(d[q]); v[i][2 * q + 1] = bfhi(a[q]) + bfhi(b[q]) + bfhi(d[q]); s += v[i][2 * q] * v[i][2 * q] + v[i][2 * q + 1] * v[i][2 * q + 1]; } }
        const float rstd = rsqrtf(wave_sum(s) * (1.f / D_) + EPS);
#pragma unroll
        for (int i = 0; i < 4; ++i) { const int c = i * 512 + lane * 8;
            const f32x4 g0 = *(const f32x4*)(p.g_final + c), g1 = *(const f32x4*)(p.g_final + c + 4);
            f32x4 o0, o1;
#pragma unroll
            for (int q = 0; q < 4; ++q) { o0[q] = v[i][q] * rstd * g0[q]; o1[q] = v[i][4 + q] * rstd * g1[q]; }
            *(f32x4*)(p.out + (size_t)t * D_ + c) = o0; *(f32x4*)(p.out + (size_t)t * D_ + c + 4) = o1; }
    }
}

#ifndef ONE_LAUNCH
#define ONE_LAUNCH 1
#endif
template <int PH> __global__ void __launch_bounds__(NTHR, 2) k_phase(Params p) {
    extern __shared__ __attribute__((aligned(16))) unsigned char lds[];
    if (PH == 0) phase0(p, lds);
    if (PH == 1) phase1(p, lds);
    if (PH == 2) phase2(p, lds);
    if (PH == 3) phase3(p, lds);
    if (PH == 4) phase4(p, lds);
    if (PH == 5) phase5(p, lds);
    if (PH == 6) phase6(p, lds);
    if (PH == 7) phase7(p);
}
__global__ void __launch_bounds__(NTHR, 2) k_mega(Params p) {
    extern __shared__ __attribute__((aligned(16))) unsigned char lds[];
    cg::grid_group grid = cg::this_grid();
    phase0(p, lds); grid.sync();
    phase1(p, lds); grid.sync();
    phase2(p, lds); grid.sync();
    phase3(p, lds); grid.sync();
    phase4(p, lds); grid.sync();
    phase5(p, lds); grid.sync();
    phase6(p, lds); grid.sync();
    phase7(p);
}

extern "C" void kernel_launch(void* const* d_in, const int* in_sizes, int n_in, void* d_out, int out_size, void* d_ws, size_t ws_size, hipStream_t stream) {
    static int grid = 0;
    if (grid == 0) {
        if (n_in != 19 || in_sizes[0] != T_ * D_ || out_size != T_ * D_ || ws_size < WS_END) { fprintf(stderr, "kernel_launch: unexpected shapes (n_in %d, in0 %d, out %d, ws %zu < %zu); nothing launched\n", n_in, n_in > 0 ? in_sizes[0] : -1, out_size, ws_size, (size_t)WS_END); grid = -1; return; }
        int dev = 0, cus = 0, per_cu = 0;
        if (hipGetDevice(&dev) != hipSuccess || hipDeviceGetAttribute(&cus, hipDeviceAttributeMultiprocessorCount, dev) != hipSuccess) { grid = -1; return; }
#if ONE_LAUNCH
        if (hipFuncSetAttribute((const void*)k_mega, hipFuncAttributeMaxDynamicSharedMemorySize, LDS_BYTES) != hipSuccess) { fprintf(stderr, "kernel_launch: hipFuncSetAttribute failed\n"); grid = -1; return; }
        if (hipOccupancyMaxActiveBlocksPerMultiprocessor(&per_cu, (const void*)k_mega, NTHR, LDS_BYTES) != hipSuccess || per_cu < 1) { fprintf(stderr, "kernel_launch: occupancy query says %d blocks per CU\n", per_cu); grid = -1; return; }
        grid = cus * per_cu;
#else
        (void)hipFuncSetAttribute((const void*)k_phase<0>, hipFuncAttributeMaxDynamicSharedMemorySize, LDS_BYTES);
        (void)hipFuncSetAttribute((const void*)k_phase<1>, hipFuncAttributeMaxDynamicSharedMemorySize, LDS_BYTES);
        (void)hipFuncSetAttribute((const void*)k_phase<2>, hipFuncAttributeMaxDynamicSharedMemorySize, LDS_BYTES);
        (void)hipFuncSetAttribute((const void*)k_phase<3>, hipFuncAttributeMaxDynamicSharedMemorySize, LDS_BYTES);
        (void)hipFuncSetAttribute((const void*)k_phase<4>, hipFuncAttributeMaxDynamicSharedMemorySize, LDS_BYTES);
        (void)hipFuncSetAttribute((const void*)k_phase<5>, hipFuncAttributeMaxDynamicSharedMemorySize, LDS_BYTES);
        (void)hipFuncSetAttribute((const void*)k_phase<6>, hipFuncAttributeMaxDynamicSharedMemorySize, LDS_BYTES);
        (void)hipFuncSetAttribute((const void*)k_phase<7>, hipFuncAttributeMaxDynamicSharedMemorySize, LDS_BYTES);
        grid = cus > 0 ? cus : 256;
#endif
    }
    if (grid < 0) return;
    Params p{};
    const float** f = (const float**)&p;
    for (int i = 0; i < 19; ++i) f[i] = (const float*)d_in[i];
    p.out = (float*)d_out; p.ws = (unsigned char*)d_ws;
#if ONE_LAUNCH
    void* args[] = {&p};
    const hipError_t e = hipLaunchCooperativeKernel((const void*)k_mega, dim3(grid), dim3(NTHR), args, LDS_BYTES, stream);
    if (e != hipSuccess) fprintf(stderr, "kernel_launch: cooperative launch failed: %s (grid %d)\n", hipGetErrorString(e), grid);
#else
    hipLaunchKernelGGL(k_phase<0>, dim3(grid), dim3(NTHR), LDS_BYTES, stream, p);
    hipLaunchKernelGGL(k_phase<1>, dim3(grid), dim3(NTHR), LDS_BYTES, stream, p);
    hipLaunchKernelGGL(k_phase<2>, dim3(grid), dim3(NTHR), LDS_BYTES, stream, p);
    hipLaunchKernelGGL(k_phase<3>, dim3(grid), dim3(NTHR), LDS_BYTES, stream, p);
    hipLaunchKernelGGL(k_phase<4>, dim3(grid), dim3(NTHR), LDS_BYTES, stream, p);
    hipLaunchKernelGGL(k_phase<5>, dim3(grid), dim3(NTHR), LDS_BYTES, stream, p);
    hipLaunchKernelGGL(k_phase<6>, dim3(grid), dim3(NTHR), LDS_BYTES, stream, p);
    hipLaunchKernelGGL(k_phase<7>, dim3(grid), dim3(NTHR), LDS_BYTES, stream, p);
#endif
}
```

```cpp
#include <hip/hip_runtime.h>
#include <hip/hip_cooperative_groups.h>
#include <cstdio>
namespace cg = cooperative_groups;

typedef unsigned short bf16_t;
typedef float f32x4 __attribute__((ext_vector_type(4)));
typedef unsigned u32x4 __attribute__((ext_vector_type(4)));
typedef unsigned u32x2 __attribute__((ext_vector_type(2)));
typedef short bf16x8 __attribute__((ext_vector_type(8)));

constexpr int T_ = 16384, D_ = 2048, DIN = 5120, NE = 32, DE = 512, SEQ = 4096, LCAP = 16384;
constexpr float EPS = 1e-6f;
constexpr int NTHR = 512;
constexpr int LDS_BYTES = 147456;
constexpr int LCNT_OFF = 131072, LBAR_OFF = 131072 + 256;

constexpr size_t SZ_A = (size_t)T_ * DIN * 2;
constexpr size_t SZ_B = (size_t)T_ * D_ * 2;
constexpr size_t OFF_A = 0;
constexpr size_t OFF_B = OFF_A + SZ_A;
constexpr size_t OFF_HB = OFF_B + SZ_B;
constexpr size_t OFF_WIN = OFF_HB + SZ_B;
constexpr size_t OFF_WOUT = OFF_WIN + (size_t)DIN * D_ * 2;
constexpr size_t OFF_WGU = OFF_WOUT + (size_t)D_ * D_ * 2;
constexpr size_t OFF_WD = OFF_WGU + (size_t)NE * 1024 * D_ * 2;
constexpr size_t OFF_WR = OFF_WD + (size_t)NE * D_ * DE * 2;
constexpr size_t OFF_SSQ = OFF_WR + (size_t)48 * D_ * 2;
constexpr size_t OFF_CNT = OFF_SSQ + (size_t)3 * T_ * 4;
constexpr size_t OFF_RINFO = OFF_CNT + 256;
constexpr size_t OFF_RW = OFF_RINFO + (size_t)NE * LCAP * 4;
constexpr size_t OFF_BAR = OFF_RW + (size_t)NE * LCAP * 4;
constexpr size_t BAR_BYTES = 16384;
constexpr size_t WS_END = OFF_BAR + BAR_BYTES;

struct Params {
    const float *x, *norm_mix_g, *w_in, *v_norm_g, *gmlp_ws, *gmlp_bs, *conv_w, *g_a, *g_b, *w_out, *g_ffn, *rgw, *rgb, *rew, *reb, *ewg, *ewu, *ewd, *g_final;
    float* out; unsigned char* ws;
};

__device__ __forceinline__ unsigned cvt_pk_bf16(float lo, float hi) { unsigned r; asm volatile("v_cvt_pk_bf16_f32 %0, %1, %2" : "=v"(r) : "v"(lo), "v"(hi)); return r; }
__device__ __forceinline__ int opaque_tid() { int t = threadIdx.x; asm volatile("" : "+v"(t)); return t; }
__device__ __forceinline__ float bflo(unsigned w) { return __uint_as_float(w << 16); }
__device__ __forceinline__ float bfhi(unsigned w) { return __uint_as_float(w & 0xffff0000u); }
__device__ __forceinline__ float wave_sum(float v) {
#pragma unroll
    for (int o = 1; o < 64; o <<= 1) v += __shfl_xor(v, o);
    return v;
}
__device__ __forceinline__ float gelu_t(float x) {
    const float u = x * (0.7978845608f + 0.0356774081f * x * x);
    return x * __builtin_amdgcn_rcpf(1.f + __builtin_amdgcn_exp2f(-2.885390082f * u));
}
__device__ __forceinline__ float silu_f(float x) { return x * __builtin_amdgcn_rcpf(1.f + __builtin_amdgcn_exp2f(-1.442695041f * x)); }

#define PG8_LAS __attribute__((address_space(3)))
struct Unit { int pm, pn, e, r0, pnl; };

template <class CntPtr> __device__ __forceinline__ bool moe_unit(CntPtr cnt, int NT, int L, Unit& u) {
    int ptile = 0;
    for (int e = 0; e < NE; ++e) {
        const int nt = (cnt[e] + 255) >> 8, nu = nt * NT;
        if (L < nu) { const int mt = L / NT, j = L - mt * NT; u.e = e; u.pm = ptile + mt; u.r0 = mt * 256; u.pnl = j; u.pn = e * NT + j; return true; }
        L -= nu; ptile += nt;
    }
    return false;
}

struct Epi1 {
    static constexpr bool PERM = true, MIDSCALE = false;
    bf16_t* P;
    __device__ __forceinline__ void operator()(f32x4 (&acc)[2][2][4][2], const Unit& u, int wr, int wc, int fr, int fq) const {
        const bool act = u.pn < 8;
#pragma unroll
        for (int ai = 0; ai < 2; ++ai)
#pragma unroll
            for (int m = 0; m < 4; ++m) {
                const int row = u.pm * 256 + ai * 128 + wr * 64 + m * 16 + fr;
                bf16_t* rowp = P + (size_t)row * DIN + u.pn * 256 + wc * 32 + 8 * fq;
#pragma unroll
                for (int bj = 0; bj < 2; ++bj) {
                    f32x4 v0 = acc[ai][bj][m][0], v1 = acc[ai][bj][m][1];
                    if (act) {
#pragma unroll
                        for (int j = 0; j < 4; ++j) { v0[j] = gelu_t(v0[j]); v1[j] = gelu_t(v1[j]); }
                    }
                    u32x4 w; w.x = cvt_pk_bf16(v0[0], v0[1]); w.y = cvt_pk_bf16(v0[2], v0[3]); w.z = cvt_pk_bf16(v1[0], v1[1]); w.w = cvt_pk_bf16(v1[2], v1[3]);
                    *(u32x4*)(rowp + bj * 128) = w;
                }
            }
    }
};
struct Epi2 {
    static constexpr bool PERM = true, MIDSCALE = true;
    const float* x; bf16_t* hb; const float* ssq_a; const float* ssq_b; float* ssq_h;
    __device__ __forceinline__ void midscale(f32x4 (&acc)[2][2][4][2], const Unit& u, int wr, int wc, int fr, int fq) const {
        int rowb = u.pm * 256 + wr * 64 + fr; asm volatile("" : "+v"(rowb));
        const float* pa = ssq_a + rowb; const float* pb = ssq_b + rowb;
#pragma unroll
        for (int ai = 0; ai < 2; ++ai)
#pragma unroll
            for (int m = 0; m < 4; ++m) {
                const float s = __builtin_amdgcn_sqrtf((pb[ai * 128 + m * 16] * (1.f / 1024.f) + EPS) * __builtin_amdgcn_rcpf(pa[ai * 128 + m * 16] * (1.f / 1024.f) + EPS));
#pragma unroll
                for (int bj = 0; bj < 2; ++bj)
#pragma unroll
                    for (int n = 0; n < 2; ++n) acc[ai][bj][m][n] *= s;
                if (m & 1) asm volatile("" ::: "memory");
            }
    }
    __device__ __forceinline__ void operator()(f32x4 (&acc)[2][2][4][2], const Unit& u, int wr, int wc, int fr, int fq) const {
#pragma unroll
        for (int ai = 0; ai < 2; ++ai)
#pragma unroll
            for (int m = 0; m < 4; ++m) {
                const int row = u.pm * 256 + ai * 128 + wr * 64 + m * 16 + fr;
                const float rb = rsqrtf(ssq_b[row] * (1.f / 1024.f) + EPS);
                const size_t off = (size_t)row * D_ + u.pn * 256 + wc * 32 + 8 * fq;
                float ss = 0.f;
#pragma unroll
                for (int bj = 0; bj < 2; ++bj) {
                    const f32x4 x0 = *(const f32x4*)(x + off + bj * 128), x1 = *(const f32x4*)(x + off + bj * 128 + 4);
                    const f32x4 h0 = x0 + acc[ai][bj][m][0] * rb, h1 = x1 + acc[ai][bj][m][1] * rb;
                    ss += (h0[0] * h0[0] + h0[1] * h0[1]) + (h0[2] * h0[2] + h0[3] * h0[3]) + (h1[0] * h1[0] + h1[1] * h1[1]) + (h1[2] * h1[2] + h1[3] * h1[3]);
                    u32x4 w; w.x = cvt_pk_bf16(h0[0], h0[1]); w.y = cvt_pk_bf16(h0[2], h0[3]); w.z = cvt_pk_bf16(h1[0], h1[1]); w.w = cvt_pk_bf16(h1[2], h1[3]);
                    *(u32x4*)(hb + off + bj * 128) = w;
                }
                ss += __shfl_xor(ss, 16); ss += __shfl_xor(ss, 32);
                if (fq == 0) atomicAdd(ssq_h + row, ss);
                asm volatile("" ::: "memory");
            }
    }
};
struct Epi5 {
    static constexpr bool PERM = true, MIDSCALE = false;
    bf16_t* hbuf; const float* ssq_h; const int* rinfo; const int* cnt;
    __device__ __forceinline__ void operator()(f32x4 (&acc)[2][2][4][2], const Unit& u, int wr, int wc, int fr, int fq) const {
        const int ce = cnt[u.e];
#pragma unroll
        for (int ai = 0; ai < 2; ++ai)
#pragma unroll
            for (int m = 0; m < 4; ++m) {
                const int r = ai * 128 + wr * 64 + m * 16 + fr, i = u.r0 + r;
                const int tok = (i < ce) ? (rinfo[u.e * LCAP + i] >> 1) : 0;
                const float rs = rsqrtf(ssq_h[tok] * (1.f / 2048.f) + EPS);
                float o[8];
#pragma unroll
                for (int n = 0; n < 2; ++n)
#pragma unroll
                    for (int j = 0; j < 4; ++j) o[4 * n + j] = silu_f(acc[ai][0][m][n][j] * rs) * (acc[ai][1][m][n][j] * rs);
                u32x4 w; w.x = cvt_pk_bf16(o[0], o[1]); w.y = cvt_pk_bf16(o[2], o[3]); w.z = cvt_pk_bf16(o[4], o[5]); w.w = cvt_pk_bf16(o[6], o[7]);
                *(u32x4*)(hbuf + (size_t)(u.pm * 256 + r) * DE + u.pnl * 128 + wc * 32 + 8 * fq) = w;
            }
    }
};
struct Epi6 {
    static constexpr bool PERM = true, MIDSCALE = false;
    bf16_t* ys2; const int* rinfo; const float* rw; const int* cnt;
    __device__ __forceinline__ void operator()(f32x4 (&acc)[2][2][4][2], const Unit& u, int wr, int wc, int fr, int fq) const {
        const int ce = cnt[u.e];
#pragma unroll
        for (int ai = 0; ai < 2; ++ai)
#pragma unroll
            for (int m = 0; m < 4; ++m) {
                const int r = ai * 128 + wr * 64 + m * 16 + fr, i = u.r0 + r;
                if (i < ce) {
                    const int info = rinfo[u.e * LCAP + i]; const float g = rw[u.e * LCAP + i];
                    bf16_t* dst = ys2 + (size_t)info * D_ + u.pnl * 256 + wc * 32 + 8 * fq;
#pragma unroll
                    for (int bj = 0; bj < 2; ++bj) {
                        const f32x4 v0 = acc[ai][bj][m][0] * g, v1 = acc[ai][bj][m][1] * g;
                        u32x4 w; w.x = cvt_pk_bf16(v0[0], v0[1]); w.y = cvt_pk_bf16(v0[2], v0[3]); w.z = cvt_pk_bf16(v1[0], v1[1]); w.w = cvt_pk_bf16(v1[2], v1[3]);
                        *(u32x4*)(dst + bj * 128) = w;
                    }
                }
            }
    }
};

struct ASrcDirect { const bf16_t* A; int K; __device__ __forceinline__ const bf16_t* row(const Unit& u, int r) const { return A + (size_t)(u.pm * 256 + r) * K; } };
struct ASrcGather { const bf16_t* A; const int* rinfo; const int* cnt;
    __device__ __forceinline__ const bf16_t* row(const Unit& u, int r) const { const int i = u.r0 + r; const int tok = (i < cnt[u.e]) ? (rinfo[u.e * LCAP + i] >> 1) : 0; return A + (size_t)tok * D_; } };

template <class Epi, class ASrc>
__device__ __forceinline__ void gemm_simple_unit(unsigned char* lds, const ASrc& AS, const bf16_t* Bt, int K, const Epi& E, const Unit& u) {
    float* As = (float*)lds; float* Bs = As + 32 * 256;
    const int tid = opaque_tid(), wid = tid >> 6, lane = tid & 63, wr = wid >> 2, wc = wid & 3, fr = lane & 15, fq = lane >> 4;
    f32x4 acc[2][2][4][2];
#pragma unroll
    for (int a = 0; a < 2; ++a)
#pragma unroll
        for (int b = 0; b < 2; ++b)
#pragma unroll
            for (int m = 0; m < 4; ++m)
#pragma unroll
                for (int n = 0; n < 2; ++n) acc[a][b][m][n] = (f32x4){0.f, 0.f, 0.f, 0.f};
    const bf16_t* ap[2]; const bf16_t* bp[2]; int lrow[2], lkc[2];
#pragma unroll
    for (int i = 0; i < 2; ++i) { const int p = tid + 512 * i; lrow[i] = p >> 2; lkc[i] = (p & 3) * 8; ap[i] = AS.row(u, lrow[i]) + lkc[i]; bp[i] = Bt + (size_t)lrow[i] * K + lkc[i]; }
    for (int k0 = 0; k0 < K; k0 += 32) {
        if constexpr (Epi::MIDSCALE) { if (k0 == K / 2) E.midscale(acc, u, wr, wc, fr, fq); }
        __syncthreads();
#pragma unroll
        for (int i = 0; i < 2; ++i) {
            const u32x4 a = *(const u32x4*)(ap[i] + k0), b = *(const u32x4*)(bp[i] + k0);
#pragma unroll
            for (int q = 0; q < 4; ++q) {
                As[(lkc[i] + 2 * q) * 256 + lrow[i]] = bflo(a[q]); As[(lkc[i] + 2 * q + 1) * 256 + lrow[i]] = bfhi(a[q]);
                Bs[(lkc[i] + 2 * q) * 256 + lrow[i]] = bflo(b[q]); Bs[(lkc[i] + 2 * q + 1) * 256 + lrow[i]] = bfhi(b[q]);
            }
        }
        __syncthreads();
#pragma unroll 2
        for (int k = 0; k < 32; ++k) {
            float a[2][4]; f32x4 b[2][2];
#pragma unroll
            for (int ai = 0; ai < 2; ++ai)
#pragma unroll
                for (int m = 0; m < 4; ++m) a[ai][m] = As[k * 256 + ai * 128 + wr * 64 + m * 16 + fr];
#pragma unroll
            for (int bj = 0; bj < 2; ++bj)
#pragma unroll
                for (int n = 0; n < 2; ++n) b[bj][n] = *(const f32x4*)&Bs[k * 256 + bj * 128 + wc * 32 + (Epi::PERM ? (8 * fq + 4 * n) : (16 * n + 4 * fq))];
#pragma unroll
            for (int ai = 0; ai < 2; ++ai)
#pragma unroll
                for (int bj = 0; bj < 2; ++bj)
#pragma unroll
                    for (int m = 0; m < 4; ++m)
#pragma unroll
                        for (int n = 0; n < 2; ++n) acc[ai][bj][m][n] += a[ai][m] * b[bj][n];
        }
    }
    E(acc, u, wr, wc, fr, fq);
    __syncthreads();
}


namespace pg8 {
constexpr int BM = 256, BK = 64, HALF = 128, HTB = HALF * BK * 2, STAGE_BYTES = 8 * HTB, NXCD = 8, WGM = 8;
__host__ __device__ __forceinline__ int lds_byte(int r, int c) { const int st = (r >> 4) * 2 + (c >> 5), rr = r & 15, cc = c & 31, ob = rr * 64 + cc * 2; return st * 1024 + (ob ^ (((ob >> 9) & 1) << 5)); }
__host__ __device__ __forceinline__ void stage_rc(int b, int& R, int& C) { const int st = b / 1024, sb = b % 1024, swz = sb ^ (((sb >> 9) & 1) << 5); R = (st >> 1) * 16 + swz / 64; C = (st & 1) * 32 + (swz % 64) / 2; }
__host__ __device__ __forceinline__ int perm32(int rho) { const int n = rho >> 4, i = rho & 15; return 8 * (i >> 2) + 4 * n + (i & 3); }

struct StaticOrder {
    int nM, nN, nwg, G, c;
    __device__ void init(int M, int N, int G_, int c_) { nM = M / BM; nN = N / BM; nwg = nM * nN; G = G_; c = c_; }
    __device__ bool next(int i, Unit& u) const {
        const long L = (long)i * G + c; if (L >= nwg) return false;
        int wgid = (int)L; { const int q = nwg / NXCD, r = nwg % NXCD, xcd = wgid % NXCD, off = wgid / NXCD; wgid = (xcd < r ? xcd * (q + 1) : r * (q + 1) + (xcd - r) * q) + off; }
        const int nig = WGM * nN, gid = wgid / nig, fm = gid * WGM, gsz = (nM - fm) < WGM ? (nM - fm) : WGM;
        u.pm = fm + ((wgid % nig) % gsz); u.pn = (wgid % nig) / gsz; u.e = 0; u.r0 = 0; u.pnl = u.pn; return true;
    }
};
typedef const PG8_LAS int* lcnt_t;
struct MoeOrder {
    lcnt_t cnt; int NT, G, c;
    __device__ bool next(int i, Unit& u) const { return moe_unit(cnt, NT, i * G + c, u); }
};
struct AOffDirect { int K; __device__ __forceinline__ unsigned operator()(const Unit& u, int h, int R, int C) const { return (unsigned)(((u.pm * 256 + h * 128 + R) * K + C) * 2); } };
struct AOffGather { const int* rinfo; lcnt_t cnt;
    __device__ __forceinline__ unsigned operator()(const Unit& u, int h, int R, int C) const { const int i = u.r0 + h * 128 + R; const int tok = (i < cnt[u.e]) ? (rinfo[u.e * LCAP + i] >> 1) : 0; return (unsigned)((tok * D_ + C) * 2); } };

template <class Epi, class Sched, class AOff, bool ALIGN_EPI>
__device__ __forceinline__ void gemm_phase(PG8_LAS unsigned char* lds, const bf16_t* Ag, const bf16_t* Btg, const int K, const Sched& S, const AOff& AO, const Epi& E) {
    const int tid = opaque_tid(), wid = __builtin_amdgcn_readfirstlane(tid >> 6), lane = tid & 63, wr = wid >> 2, wc = wid & 3, fr = lane & 15, fq = lane >> 4;
    const int nt = K / BK;
    unsigned voffB[2];
#pragma unroll
    for (int i = 0; i < 2; ++i) { int R, C; stage_rc(tid * 16 + i * 8192, R, C); const int Rb = Epi::PERM ? ((R & ~31) + perm32(R & 31)) : R; voffB[i] = (unsigned)(Rb * K + C) * 2u; }
#define PG8_AOFFS(u) do { int _t = tid; asm volatile("" : "+v"(_t)); _Pragma("unroll") for (int _i = 0; _i < 2; ++_i) { int _R, _C; stage_rc(_t * 16 + _i * 8192, _R, _C); vo0[_i] = AO(u, 0, _R, _C); vo1[_i] = AO(u, 1, _R, _C); } } while (0)
    const size_t kstep = (size_t)(BK * 2), hstep = (size_t)HALF * K * 2, tstep = 2 * hstep;
    const unsigned ldsw = (unsigned)wid * 1024u;
    const int aoff = lds_byte(wr * 64 + fr, fq * 8), boff = lds_byte(wc * 32 + fr, fq * 8);
    const char* const Ab = (const char*)Ag;
#define PG8_SA(b, h) (((b) * 2 + (h)) * HTB)
#define PG8_SB(b, h) ((4 + (b) * 2 + (h)) * HTB)
#define PG8_STAGE(bufoff, gbase, voff) do { _Pragma("unroll") for (int _i = 0; _i < 2; ++_i) \
        __builtin_amdgcn_global_load_lds((const unsigned*)((const char*)(gbase) + (voff)[_i]), (PG8_LAS unsigned*)(lds + (bufoff) + ldsw + _i * 8192), 16, 0, 0); } while (0)
#define PG8_LDA(dst, b, h) do { _Pragma("unroll") for (int m = 0; m < 4; ++m) _Pragma("unroll") for (int k = 0; k < 2; ++k) dst[m][k] = *(const PG8_LAS bf16x8*)(lds + PG8_SA(b, h) + aoff + m * 2048 + k * 1024); } while (0)
#define PG8_LDB(dst, b, h) do { _Pragma("unroll") for (int n = 0; n < 2; ++n) _Pragma("unroll") for (int k = 0; k < 2; ++k) dst[n][k] = *(const PG8_LAS bf16x8*)(lds + PG8_SB(b, h) + boff + n * 2048 + k * 1024); } while (0)
#define PG8_MMA(ai, bj, At, Bt) do { __builtin_amdgcn_s_setprio(1); _Pragma("unroll") for (int m = 0; m < 4; ++m) _Pragma("unroll") for (int n = 0; n < 2; ++n) _Pragma("unroll") for (int k = 0; k < 2; ++k) \
        acc[ai][bj][m][n] = __builtin_amdgcn_mfma_f32_16x16x32_bf16(Bt[n][k], At[m][k], acc[ai][bj][m][n], 0, 0, 0); __builtin_amdgcn_s_setprio(0); } while (0)
#define PG8_WAIT_V(n) asm volatile("s_waitcnt vmcnt(" #n ")" ::: "memory")
#define PG8_WAIT_L(n) asm volatile("s_waitcnt lgkmcnt(" #n ")" ::: "memory")
#define PG8_BAR __builtin_amdgcn_s_barrier()
#define PG8_SCHED __builtin_amdgcn_sched_barrier(0)
    Unit cur, nxt; int ui = 0;
    if (!S.next(0, cur)) return;
    f32x4 acc[2][2][4][2];
#pragma unroll
    for (int a = 0; a < 2; ++a)
#pragma unroll
        for (int b = 0; b < 2; ++b)
#pragma unroll
            for (int m = 0; m < 4; ++m)
#pragma unroll
                for (int n = 0; n < 2; ++n) acc[a][b][m][n] = (f32x4){0.f, 0.f, 0.f, 0.f};
    bf16x8 At[4][2], B0[2][2], B1[2][2];
    unsigned vo0[2], vo1[2];
    PG8_AOFFS(cur);
    const char* cB = (const char*)Btg + (size_t)cur.pn * tstep;
    PG8_STAGE(PG8_SB(0, 0), cB, voffB); PG8_STAGE(PG8_SB(0, 1), cB + hstep, voffB); PG8_STAGE(PG8_SA(0, 0), Ab, vo0); PG8_STAGE(PG8_SA(0, 1), Ab, vo1);
    if (wr == 1) PG8_BAR;
    PG8_WAIT_V(2); PG8_BAR;
    PG8_STAGE(PG8_SB(1, 0), cB + kstep, voffB); PG8_STAGE(PG8_SA(1, 0), Ab + kstep, vo0); PG8_STAGE(PG8_SB(1, 1), cB + hstep + kstep, voffB);
    PG8_WAIT_V(6); PG8_BAR;
    for (;;) {
        const bool has_next = S.next(ui + 1, nxt);
        const char* nB = has_next ? (const char*)Btg + (size_t)nxt.pn * tstep : cB;
        for (int t = 0; t < nt; t += 2) {
            const bool last = (t == nt - 2);
            if constexpr (Epi::MIDSCALE) { if (t == nt / 2) { int _t = tid; asm volatile("" : "+v"(_t)); const int _l = _t & 63; E.midscale(acc, cur, wr, wc, _l & 15, _l >> 4); } }
            const size_t k1 = (size_t)(t + 1) * kstep, k2 = last ? (size_t)0 : (size_t)(t + 2) * kstep, k3 = k2 + kstep;
            const char* b2 = last ? nB : cB + (size_t)(t + 2) * kstep; const char* b3 = b2 + kstep;
            PG8_LDB(B0, 0, 0); PG8_LDB(B1, 0, 1); PG8_SCHED; PG8_LDA(At, 0, 0); PG8_STAGE(PG8_SA(1, 1), Ab + k1, vo1);
            PG8_WAIT_V(8); PG8_WAIT_L(0); PG8_BAR; PG8_MMA(0, 0, At, B0); PG8_MMA(0, 1, At, B1); PG8_BAR; PG8_SCHED;
            if (last && has_next) { PG8_AOFFS(nxt); }
            PG8_LDA(At, 0, 1); PG8_STAGE(PG8_SB(0, 0), b2, voffB); PG8_STAGE(PG8_SB(0, 1), b2 + hstep, voffB); PG8_STAGE(PG8_SA(0, 0), Ab + k2, vo0);
            PG8_WAIT_V(8); PG8_WAIT_L(0); PG8_BAR; PG8_MMA(1, 0, At, B0); PG8_MMA(1, 1, At, B1); PG8_BAR; PG8_SCHED;
            PG8_LDB(B0, 1, 0); PG8_LDB(B1, 1, 1); PG8_SCHED; PG8_LDA(At, 1, 0); PG8_STAGE(PG8_SA(0, 1), Ab + k2, vo1);
            PG8_WAIT_V(8); PG8_WAIT_L(0); PG8_BAR; PG8_MMA(0, 0, At, B0); PG8_MMA(0, 1, At, B1); PG8_BAR; PG8_SCHED;
            PG8_LDA(At, 1, 1); PG8_STAGE(PG8_SB(1, 0), b3, voffB); PG8_STAGE(PG8_SB(1, 1), b3 + hstep, voffB); PG8_STAGE(PG8_SA(1, 0), Ab + k3, vo0);
            PG8_WAIT_V(8); PG8_WAIT_L(0); PG8_BAR; PG8_MMA(1, 0, At, B0); PG8_MMA(1, 1, At, B1); PG8_BAR; PG8_SCHED;
        }
        if constexpr (ALIGN_EPI) { if (wr == 0) PG8_BAR; }
        { int _t = tid; asm volatile("" : "+v"(_t)); const int _l = _t & 63; E(acc, cur, wr, wc, _l & 15, _l >> 4); }
        if (!has_next) break;
#pragma unroll
        for (int a = 0; a < 2; ++a)
#pragma unroll
            for (int b = 0; b < 2; ++b)
#pragma unroll
                for (int m = 0; m < 4; ++m)
#pragma unroll
                    for (int n = 0; n < 2; ++n) acc[a][b][m][n] = (f32x4){0.f, 0.f, 0.f, 0.f};
        cur = nxt; cB = nB; ++ui;
        if constexpr (ALIGN_EPI) { if (wr == 1) PG8_BAR; }
    }
    PG8_WAIT_V(0);
    if constexpr (!ALIGN_EPI) { if (wr == 0) PG8_BAR; }
    PG8_BAR;
#undef PG8_AOFFS
#undef PG8_SA
#undef PG8_SB
#undef PG8_STAGE
#undef PG8_LDA
#undef PG8_LDB
#undef PG8_MMA
#undef PG8_WAIT_V
#undef PG8_WAIT_L
#undef PG8_BAR
#undef PG8_SCHED
}
}

#ifndef FAST_MASK
#define FAST_MASK 0x6A
#endif


#define XB_TMO      128
#define XB_XCNT(j)  (256  + 64 * (j))
#define XB_XSUB(j)  (1280 + 64 * (j))
#define XB_XGEN(j)  (2304 + 64 * (j))
#define XB_TOP      3328
#define XB_TOPGEN   3392
#define XCD_BAR_WORDS 3456
#define XB_SPIN_CAP (1u << 18)
__device__ __forceinline__ unsigned xb_ld(unsigned* p)              { return __hip_atomic_load(p, __ATOMIC_RELAXED, __HIP_MEMORY_SCOPE_AGENT); }
__device__ __forceinline__ unsigned xb_add(unsigned* p, unsigned v) { return __hip_atomic_fetch_add(p, v, __ATOMIC_RELAXED, __HIP_MEMORY_SCOPE_AGENT); }
__device__ __forceinline__ unsigned xb_xcc_id() { return (unsigned)__builtin_amdgcn_s_getreg((3 << 11) | 20) & 0xFu; }
#define XB_SPIN(cond, bar) do { unsigned _sp = 0; while (cond) { __builtin_amdgcn_s_sleep(1); \
    if ((++_sp & 255u) == 0u) { if (xb_ld(&(bar)[XB_TMO])) break; if (_sp > XB_SPIN_CAP) { atomicAdd(&(bar)[XB_TMO], 1u); break; } } } } while (0)
struct XcdBarrier { unsigned* bar; unsigned x; volatile PG8_LAS unsigned* st; };
__device__ __forceinline__ XcdBarrier xcd_barrier_post(unsigned* bar, volatile PG8_LAS unsigned* st) {
    XcdBarrier b; b.bar = bar; b.x = xb_xcc_id(); b.st = st;
    if (threadIdx.x == 0) (void)xb_add(&bar[XB_XCNT(b.x)], 1u);
    return b;
}
__device__ __forceinline__ void xcd_barrier_complete(unsigned* bar, unsigned x, unsigned& nloc, unsigned& nx) {
    const unsigned G = gridDim.x * gridDim.y * gridDim.z;
    unsigned sum, cnt, mine, sp = 0u;
    for (;;) {
        sum = 0u; cnt = 0u; mine = 0u;
#pragma unroll
        for (unsigned j = 0; j < 16; ++j) { const unsigned c = xb_ld(&bar[XB_XCNT(j)]); sum += c; cnt += (c > 0u) ? 1u : 0u; mine = (j == x) ? c : mine; }
        if (sum == G) break;
        __builtin_amdgcn_s_sleep(1);
        if ((++sp & 255u) == 0u) { if (xb_ld(&bar[XB_TMO])) break; if (sp > XB_SPIN_CAP) { atomicAdd(&bar[XB_TMO], 1u); break; } }
    }
    nloc = mine > 0u ? mine : 1u; nx = cnt > 0u ? cnt : 1u;
}
__device__ __forceinline__ void xcd_barrier(const XcdBarrier& b) {
    asm volatile("s_waitcnt vmcnt(0)" ::: "memory");
    __syncthreads();
    if (threadIdx.x == 0) {
        unsigned* bar = b.bar;
        __builtin_amdgcn_s_waitcnt(0);
        unsigned nloc = b.st[0], nx = b.st[1];
        if (nloc == 0u) { xcd_barrier_complete(bar, b.x, nloc, nx); b.st[0] = nloc; b.st[1] = nx; }
        const unsigned old = xb_add(&bar[XB_XSUB(b.x)], 1u);
        const unsigned gen = old / nloc;
        if (old + 1u == (gen + 1u) * nloc) {
            __builtin_amdgcn_fence(__ATOMIC_RELEASE, "agent");
            asm volatile("s_waitcnt vmcnt(0)" ::: "memory");
            const unsigned og = xb_add(&bar[XB_TOP], 1u);
            const unsigned tg = og / nx;
            if (og + 1u == (tg + 1u) * nx) xb_add(&bar[XB_TOPGEN], 1u);
            else XB_SPIN(xb_ld(&bar[XB_TOPGEN]) == tg, bar);
            __builtin_amdgcn_fence(__ATOMIC_ACQUIRE, "agent");
            xb_add(&bar[XB_XGEN(b.x)], 1u);
            asm volatile("s_waitcnt vmcnt(0)" ::: "memory");
        } else {
            XB_SPIN(xb_ld(&bar[XB_XGEN(b.x)]) == gen, bar);
            __builtin_amdgcn_fence(__ATOMIC_ACQUIRE, "agent");
            asm volatile("s_waitcnt vmcnt(0)" ::: "memory");
        }
    }
    __syncthreads();
}

__device__ __forceinline__ void transpose_tile(float* lt, const float* src, int ldsrc, int r0, int c0, bf16_t* dst, int lddst, int dr0, const float* sA, const float* sB, int split) {
    const int tid = opaque_tid();
    { const int r = tid >> 3, cc = (tid & 7) * 8;
      const float* s = src + (size_t)(r0 + r) * ldsrc + c0 + cc;
      const f32x4 v0 = *(const f32x4*)s, v1 = *(const f32x4*)(s + 4);
      float sc = 1.f; if (sA) { const int rr = r0 + r; sc = rr < split ? sA[rr] : sB[rr - split]; }
#pragma unroll
      for (int q = 0; q < 4; ++q) { lt[r * 65 + cc + q] = v0[q] * sc; lt[r * 65 + cc + 4 + q] = v1[q] * sc; } }
    __syncthreads();
    { const int c = tid >> 3, rr = (tid & 7) * 8;
      float v[8];
#pragma unroll
      for (int q = 0; q < 8; ++q) v[q] = lt[(rr + q) * 65 + c];
      u32x4 w; w.x = cvt_pk_bf16(v[0], v[1]); w.y = cvt_pk_bf16(v[2], v[3]); w.z = cvt_pk_bf16(v[4], v[5]); w.w = cvt_pk_bf16(v[6], v[7]);
      *(u32x4*)(dst + (size_t)(dr0 + c) * lddst + r0 + rr) = w; }
    __syncthreads();
}
__device__ __forceinline__ void phase0(const Params& p, unsigned char* lds) {
    const int tid = opaque_tid(), nb = gridDim.x, bid = blockIdx.x, wid = tid >> 6, lane = tid & 63;
    { float* z = (float*)(p.ws + OFF_SSQ);
      for (int i = bid * NTHR + tid; i < 3 * T_ + 64; i += nb * NTHR) z[i] = 0.f; }
    { bf16_t* wrt = (bf16_t*)(p.ws + OFF_WR);
      for (int i = bid * NTHR + tid; i < 48 * D_; i += nb * NTHR) {
          const int o = i >> 11, k = i & 2047; float v = 0.f;
          if (o < 4) v = p.rgw[k * 4 + o]; else if (o < 36) v = p.rew[k * 32 + (o - 4)];
          wrt[i] = (bf16_t)(cvt_pk_bf16(v * p.g_ffn[k], 0.f) & 0xffffu); } }
    { bf16_t* xn = (bf16_t*)(p.ws + OFF_B);
      for (int row = bid * 8 + wid; row < T_; row += nb * 8) {
          const float* xr = p.x + (size_t)row * D_;
          f32x4 v[8]; float s = 0.f;
#pragma unroll
          for (int i = 0; i < 8; ++i) { v[i] = *(const f32x4*)(xr + i * 256 + lane * 4); s += (v[i][0] * v[i][0] + v[i][1] * v[i][1]) + (v[i][2] * v[i][2] + v[i][3] * v[i][3]); }
          const float rstd = rsqrtf(wave_sum(s) * (1.f / D_) + EPS);
#pragma unroll
          for (int i = 0; i < 8; ++i) { const f32x4 g = *(const f32x4*)(p.norm_mix_g + i * 256 + lane * 4); const f32x4 o = v[i] * rstd * g;
              u32x2 w; w.x = cvt_pk_bf16(o[0], o[1]); w.y = cvt_pk_bf16(o[2], o[3]); *(u32x2*)(xn + (size_t)row * D_ + i * 256 + lane * 4) = w; } } }
    float* lt = (float*)lds;
    constexpr int N_IN = 32 * 80, N_OUT = 32 * 32, N_G = 32 * 256, N_TOT = N_IN + N_OUT + 3 * N_G;
    for (int tile = bid; tile < N_TOT; tile += nb) {
        int q = tile;
        if (q < N_IN) { const int tr = q / 80, tc = q % 80; transpose_tile(lt, p.w_in, DIN, tr * 64, tc * 64, (bf16_t*)(p.ws + OFF_WIN), D_, tc * 64, nullptr, nullptr, 0); continue; } q -= N_IN;
        if (q < N_OUT) { const int tr = q / 32, tc = q % 32; transpose_tile(lt, p.w_out, D_, tr * 64, tc * 64, (bf16_t*)(p.ws + OFF_WOUT), D_, tc * 64, p.g_a, p.g_b, 1024); continue; } q -= N_OUT;
        if (q < 2 * N_G) { const int up = q >= N_G; if (up) q -= N_G; const int e = q >> 8, rem = q & 255, tr = rem >> 3, tc = rem & 7; const int c0 = tc * 64;
            transpose_tile(lt, (up ? p.ewu : p.ewg) + (size_t)e * D_ * DE, DE, tr * 64, c0, (bf16_t*)(p.ws + OFF_WGU) + (size_t)e * 1024 * D_, D_, (c0 >> 7) * 256 + (up ? 128 : 0) + (c0 & 127), p.g_ffn, p.g_ffn, 1 << 30); continue; } q -= 2 * N_G;
        { const int e = q >> 8, rem = q & 255, tr = rem >> 5, tc = rem & 31;
          transpose_tile(lt, p.ewd + (size_t)e * DE * D_, D_, tr * 64, tc * 64, (bf16_t*)(p.ws + OFF_WD) + (size_t)e * D_ * DE, DE, tc * 64, nullptr, nullptr, 0); }
    }
}

__device__ __forceinline__ void phase1(const Params& p, unsigned char* lds) {
    const ASrcDirect AS{(const bf16_t*)(p.ws + OFF_B), D_}; const Epi1 E{(bf16_t*)(p.ws + OFF_A)};
    const bf16_t* Bt = (const bf16_t*)(p.ws + OFF_WIN);
    if (FAST_MASK & 2) { pg8::StaticOrder S; S.init(T_, DIN, gridDim.x, blockIdx.x); const pg8::AOffDirect AO{D_};
        pg8::gemm_phase<Epi1, pg8::StaticOrder, pg8::AOffDirect, true>((PG8_LAS unsigned char*)lds, AS.A, Bt, D_, S, AO, E); return; }
    for (int L = blockIdx.x; L < 64 * 20; L += gridDim.x) { Unit u; u.pm = L / 20; u.pn = L % 20; u.e = 0; u.r0 = 0; u.pnl = u.pn;
        gemm_simple_unit(lds, AS, Bt + (size_t)u.pn * 256 * D_, D_, E, u); }
}

__device__ __forceinline__ void mixer_gmlp_item(const Params& p, unsigned char* lds, int item) {
    const int tid = opaque_tid(), wid = tid >> 6, lane = tid & 63, fr = lane & 15, fq = lane >> 4;
    const int h = item & 7, t0 = (item >> 3) * 128;
    const bf16_t* P = (const bf16_t*)(p.ws + OFF_A); bf16_t* Y = (bf16_t*)(p.ws + OFF_B); float* ssq_a = (float*)(p.ws + OFF_SSQ);
    bf16_t* Vt = (bf16_t*)lds;
    bf16_t* Wl = Vt + 128 * 136;
    float* rs = (float*)(Wl + 128 * 136);
    { const int j = tid >> 2, dc = (tid & 3) * 32;
      const u32x4* src = (const u32x4*)(P + (size_t)(t0 + j) * DIN + 1024 + h * 128 + dc);
      u32x4 v[4]; float s = 0.f;
#pragma unroll
      for (int q = 0; q < 4; ++q) { v[q] = src[q];
#pragma unroll
          for (int w = 0; w < 4; ++w) { const float lo = bflo(v[q][w]), hi = bfhi(v[q][w]); s += lo * lo + hi * hi; } }
      s += __shfl_xor(s, 1); s += __shfl_xor(s, 2);
      if ((tid & 3) == 0) rs[j] = rsqrtf(s * (1.f / 128.f) + EPS);
#pragma unroll
      for (int q = 0; q < 4; ++q)
#pragma unroll
          for (int w = 0; w < 4; ++w) { const int d = dc + q * 8 + w * 2; Vt[d * 136 + j] = (bf16_t)(v[q][w] & 0xffffu); Vt[(d + 1) * 136 + j] = (bf16_t)(v[q][w] >> 16); } }
    __syncthreads();
    { const int i = tid >> 2, jc = (tid & 3) * 32;
      const f32x4* src = (const f32x4*)(p.gmlp_ws + (size_t)h * 16384 + i * 128 + jc);
      const bool live = (i >> 6) >= (jc >> 6);
#pragma unroll
      for (int q = 0; q < 4; ++q) { f32x4 w0 = src[2 * q], w1 = src[2 * q + 1];
          const f32x4 r0 = *(const f32x4*)(rs + jc + 8 * q), r1 = *(const f32x4*)(rs + jc + 8 * q + 4);
          w0 = live ? w0 * r0 : (f32x4){0.f, 0.f, 0.f, 0.f}; w1 = live ? w1 * r1 : (f32x4){0.f, 0.f, 0.f, 0.f};
          u32x4 o; o.x = cvt_pk_bf16(w0[0], w0[1]); o.y = cvt_pk_bf16(w0[2], w0[3]); o.z = cvt_pk_bf16(w1[0], w1[1]); o.w = cvt_pk_bf16(w1[2], w1[3]);
          *(u32x4*)(Wl + i * 136 + jc + 8 * q) = o; } }
    __syncthreads();
    f32x4 acc[8];
#pragma unroll
    for (int n = 0; n < 8; ++n) acc[n] = (f32x4){0.f, 0.f, 0.f, 0.f};
    const int ksteps = (wid < 4) ? 2 : 4;
    for (int ks = 0; ks < ksteps; ++ks) {
        const bf16x8 bw = *(const bf16x8*)(Wl + (16 * wid + fr) * 136 + ks * 32 + fq * 8);
#pragma unroll
        for (int n = 0; n < 8; ++n) { const bf16x8 av = *(const bf16x8*)(Vt + (16 * n + fr) * 136 + ks * 32 + fq * 8);
            acc[n] = __builtin_amdgcn_mfma_f32_16x16x32_bf16(av, bw, acc[n], 0, 0, 0); }
    }
    { const int i = 16 * wid + fr, t = t0 + i; const float bias = p.gmlp_bs[h * 128 + i]; float ss = 0.f;
#pragma unroll
      for (int n = 0; n < 8; ++n) { const int c = h * 128 + 16 * n + 4 * fq;
          const f32x4 g = *(const f32x4*)(p.v_norm_g + c); const u32x2 uu = *(const u32x2*)(P + (size_t)t * DIN + c);
          const float y0 = bflo(uu.x) * (acc[n][0] * g[0] + bias), y1 = bfhi(uu.x) * (acc[n][1] * g[1] + bias), y2 = bflo(uu.y) * (acc[n][2] * g[2] + bias), y3 = bfhi(uu.y) * (acc[n][3] * g[3] + bias);
          ss += (y0 * y0 + y1 * y1) + (y2 * y2 + y3 * y3);
          u32x2 w; w.x = cvt_pk_bf16(y0, y1); w.y = cvt_pk_bf16(y2, y3); *(u32x2*)(Y + (size_t)t * D_ + c) = w; }
      ss += __shfl_xor(ss, 16); ss += __shfl_xor(ss, 32);
      if (fq == 0) atomicAdd(ssq_a + t, ss); }
    __syncthreads();
}
__device__ __forceinline__ void mixer_conv_item(const Params& p, int item) {
    const int tid = opaque_tid(), cl = tid & 31, ts = tid >> 5;
    const int c = (item & 3) * 256 + cl * 8, tbeg = (item >> 2) * 128 + ts * 8;
    const bf16_t* P = (const bf16_t*)(p.ws + OFF_A); bf16_t* Y = (bf16_t*)(p.ws + OFF_B); float* ssq_b = (float*)(p.ws + OFF_SSQ) + T_;
    float w0[8], w1[8], w2[8], z1[8], z2[8];
    { const f32x4 a0 = *(const f32x4*)(p.conv_w + c), a1 = *(const f32x4*)(p.conv_w + c + 4), b0 = *(const f32x4*)(p.conv_w + 1024 + c), b1 = *(const f32x4*)(p.conv_w + 1024 + c + 4),
                  c0 = *(const f32x4*)(p.conv_w + 2048 + c), c1 = *(const f32x4*)(p.conv_w + 2048 + c + 4);
#pragma unroll
      for (int q = 0; q < 4; ++q) { w0[q] = a0[q]; w0[4 + q] = a1[q]; w1[q] = b0[q]; w1[4 + q] = b1[q]; w2[q] = c0[q]; w2[4 + q] = c1[q]; } }
#pragma unroll
    for (int q = 0; q < 8; ++q) { z1[q] = 0.f; z2[q] = 0.f; }
    if ((tbeg % SEQ) != 0) {
        const u32x4 ca = *(const u32x4*)(P + (size_t)(tbeg - 1) * DIN + 3072 + c), ha = *(const u32x4*)(P + (size_t)(tbeg - 1) * DIN + 4096 + c);
        const u32x4 cb = *(const u32x4*)(P + (size_t)(tbeg - 2) * DIN + 3072 + c), hb2 = *(const u32x4*)(P + (size_t)(tbeg - 2) * DIN + 4096 + c);
#pragma unroll
        for (int q = 0; q < 4; ++q) { z1[2 * q] = bflo(ca[q]) * bflo(ha[q]); z1[2 * q + 1] = bfhi(ca[q]) * bfhi(ha[q]); z2[2 * q] = bflo(cb[q]) * bflo(hb2[q]); z2[2 * q + 1] = bfhi(cb[q]) * bfhi(hb2[q]); }
    }
    for (int tt = 0; tt < 8; ++tt) {
        const int t = tbeg + tt; const bf16_t* pr = P + (size_t)t * DIN + c;
        const u32x4 bg = *(const u32x4*)(pr + 2048), cgv = *(const u32x4*)(pr + 3072), hv = *(const u32x4*)(pr + 4096);
        float z[8], y[8], ss = 0.f;
#pragma unroll
        for (int q = 0; q < 4; ++q) { z[2 * q] = bflo(cgv[q]) * bflo(hv[q]); z[2 * q + 1] = bfhi(cgv[q]) * bfhi(hv[q]); }
#pragma unroll
        for (int q = 0; q < 4; ++q) {
            y[2 * q] = bflo(bg[q]) * (w0[2 * q] * z2[2 * q] + w1[2 * q] * z1[2 * q] + w2[2 * q] * z[2 * q]);
            y[2 * q + 1] = bfhi(bg[q]) * (w0[2 * q + 1] * z2[2 * q + 1] + w1[2 * q + 1] * z1[2 * q + 1] + w2[2 * q + 1] * z[2 * q + 1]); }
#pragma unroll
        for (int q = 0; q < 8; ++q) { ss += y[q] * y[q]; z2[q] = z1[q]; z1[q] = z[q]; }
        u32x4 w; w.x = cvt_pk_bf16(y[0], y[1]); w.y = cvt_pk_bf16(y[2], y[3]); w.z = cvt_pk_bf16(y[4], y[5]); w.w = cvt_pk_bf16(y[6], y[7]);
        *(u32x4*)(Y + (size_t)t * D_ + 1024 + c) = w;
        ss += __shfl_xor(ss, 1); ss += __shfl_xor(ss, 2); ss += __shfl_xor(ss, 4); ss += __shfl_xor(ss, 8); ss += __shfl_xor(ss, 16);
        if (cl == 0) atomicAdd(ssq_b + t, ss);
    }
}
__device__ __forceinline__ void phase2(const Params& p, unsigned char* lds) {
    for (int it = blockIdx.x; it < 512 + 1024; it += gridDim.x) { if (it < 512) mixer_conv_item(p, it); else mixer_gmlp_item(p, lds, it - 512); }
}

__device__ __forceinline__ void phase3(const Params& p, unsigned char* lds) {
    const ASrcDirect AS{(const bf16_t*)(p.ws + OFF_B), D_};
    float* ssq = (float*)(p.ws + OFF_SSQ);
    const Epi2 E{p.x, (bf16_t*)(p.ws + OFF_HB), ssq, ssq + T_, ssq + 2 * T_};
    const bf16_t* Bt = (const bf16_t*)(p.ws + OFF_WOUT);
    if (FAST_MASK & 8) { pg8::StaticOrder S; S.init(T_, D_, gridDim.x, blockIdx.x); const pg8::AOffDirect AO{D_};
        pg8::gemm_phase<Epi2, pg8::StaticOrder, pg8::AOffDirect, true>((PG8_LAS unsigned char*)lds, AS.A, Bt, D_, S, AO, E); return; }
    for (int L = blockIdx.x; L < 64 * 8; L += gridDim.x) { Unit u; u.pm = L / 8; u.pn = L % 8; u.e = 0; u.r0 = 0; u.pnl = u.pn;
        gemm_simple_unit(lds, AS, Bt + (size_t)u.pn * 256 * D_, D_, E, u); }
}

__device__ __forceinline__ void route_item(const Params& p, unsigned char* lds, int item) {
    const int tid = opaque_tid(), wid = tid >> 6, lane = tid & 63, fr = lane & 15, fq = lane >> 4;
    float* lg = (float*)lds;
    int* lcnt = (int*)(lg + 8 * 16 * 48); int* lbase = lcnt + 32;
    const bf16_t* hb = (const bf16_t*)(p.ws + OFF_HB); const bf16_t* wrt = (const bf16_t*)(p.ws + OFF_WR);
    const float* ssq_h = (const float*)(p.ws + OFF_SSQ) + 2 * T_;
    int* cnt = (int*)(p.ws + OFF_CNT); int* rinfo = (int*)(p.ws + OFF_RINFO); float* rw = (float*)(p.ws + OFF_RW);
    const int tw = item * 128 + wid * 16;
    if (tid < 32) lcnt[tid] = 0;
    f32x4 acc[3];
#pragma unroll
    for (int n = 0; n < 3; ++n) acc[n] = (f32x4){0.f, 0.f, 0.f, 0.f};
    const bf16_t* ap = hb + (size_t)(tw + fr) * D_ + fq * 8; const bf16_t* bp = wrt + (size_t)fr * D_ + fq * 8;
#pragma unroll 4
    for (int ks = 0; ks < 64; ++ks) { const bf16x8 a = *(const bf16x8*)(ap + ks * 32);
#pragma unroll
        for (int n = 0; n < 3; ++n) { const bf16x8 b = *(const bf16x8*)(bp + (size_t)n * 16 * D_ + ks * 32); acc[n] = __builtin_amdgcn_mfma_f32_16x16x32_bf16(a, b, acc[n], 0, 0, 0); } }
#pragma unroll
    for (int n = 0; n < 3; ++n)
#pragma unroll
        for (int j = 0; j < 4; ++j) lg[(wid * 16 + 4 * fq + j) * 48 + 16 * n + fr] = acc[n][j];
    __syncthreads();
    int e0 = 0, e1 = 0, r0 = 0, r1 = 0; float g0 = 0.f, g1 = 0.f; const int t = tw + lane;
    if (lane < 16) {
        const float* l = lg + (wid * 16 + lane) * 48; const float rstd = rsqrtf(ssq_h[t] * (1.f / D_) + EPS);
        float gm = -3.0e38f; int gi = 0; float gl[4];
#pragma unroll
        for (int o = 0; o < 4; ++o) { gl[o] = l[o] * rstd + p.rgb[o]; if (gl[o] > gm) { gm = gl[o]; gi = o; } }
        float gs = 0.f;
#pragma unroll
        for (int o = 0; o < 4; ++o) gs += __expf(gl[o] - gm);
        const float pg = 1.f / gs;
        float b1 = -3.0e38f, b2 = -3.0e38f; int i1 = 0, i2 = 0;
        for (int q = 0; q < 8; ++q) { const float v = l[4 + gi * 8 + q] * rstd + p.reb[gi * 8 + q];
            if (v > b1) { b2 = b1; i2 = i1; b1 = v; i1 = q; } else if (v > b2) { b2 = v; i2 = q; } }
        const float wa = 1.f / (1.f + __expf(b2 - b1));
        e0 = gi * 8 + i1; e1 = gi * 8 + i2; g0 = pg * wa; g1 = pg * (1.f - wa);
        r0 = atomicAdd(&lcnt[e0], 1); r1 = atomicAdd(&lcnt[e1], 1);
    }
    __syncthreads();
    if (tid < 32) lbase[tid] = atomicAdd(cnt + tid, lcnt[tid]);
    __syncthreads();
    if (lane < 16) { const int i0 = lbase[e0] + r0, i1 = lbase[e1] + r1;
        rinfo[e0 * LCAP + i0] = 2 * t; rw[e0 * LCAP + i0] = g0; rinfo[e1 * LCAP + i1] = 2 * t + 1; rw[e1 * LCAP + i1] = g1; }
    __syncthreads();
}
__device__ __forceinline__ void phase4(const Params& p, unsigned char* lds) { for (int it = blockIdx.x; it < T_ / 128; it += gridDim.x) route_item(p, lds, it); }

__device__ __forceinline__ void phase5(const Params& p, unsigned char* lds) {
    const int* cnt = (const int*)(p.ws + OFF_CNT); const int* rinfo = (const int*)(p.ws + OFF_RINFO);
    const ASrcGather AS{(const bf16_t*)(p.ws + OFF_HB), rinfo, cnt};
    const Epi5 E{(bf16_t*)(p.ws + OFF_B), (const float*)(p.ws + OFF_SSQ) + 2 * T_, rinfo, cnt};
    const bf16_t* Bt = (const bf16_t*)(p.ws + OFF_WGU);
    if (FAST_MASK & 32) { PG8_LAS int* lc = (PG8_LAS int*)((PG8_LAS unsigned char*)lds + LCNT_OFF);
        if (threadIdx.x < NE) lc[threadIdx.x] = __hip_atomic_load(cnt + threadIdx.x, __ATOMIC_RELAXED, __HIP_MEMORY_SCOPE_AGENT);
        __syncthreads();
        const pg8::MoeOrder S{lc, 4, (int)gridDim.x, (int)blockIdx.x}; const pg8::AOffGather AO{rinfo, lc};
        pg8::gemm_phase<Epi5, pg8::MoeOrder, pg8::AOffGather, true>((PG8_LAS unsigned char*)lds, AS.A, Bt, D_, S, AO, E); return; }
    for (int L = blockIdx.x;; L += gridDim.x) { Unit u; if (!moe_unit(cnt, 4, L, u)) break; gemm_simple_unit(lds, AS, Bt + (size_t)u.pn * 256 * D_, D_, E, u); }
}
__device__ __forceinline__ void phase6(const Params& p, unsigned char* lds) {
    const int* cnt = (const int*)(p.ws + OFF_CNT); const int* rinfo = (const int*)(p.ws + OFF_RINFO);
    const ASrcDirect AS{(const bf16_t*)(p.ws + OFF_B), DE};
    const Epi6 E{(bf16_t*)(p.ws + OFF_A), rinfo, (const float*)(p.ws + OFF_RW), cnt};
    const bf16_t* Bt = (const bf16_t*)(p.ws + OFF_WD);
    if (FAST_MASK & 64) { PG8_LAS int* lc = (PG8_LAS int*)((PG8_LAS unsigned char*)lds + LCNT_OFF);
        if (threadIdx.x < NE) lc[threadIdx.x] = __hip_atomic_load(cnt + threadIdx.x, __ATOMIC_RELAXED, __HIP_MEMORY_SCOPE_AGENT);
        __syncthreads();
        const pg8::MoeOrder S{lc, 8, (int)gridDim.x, (int)blockIdx.x}; const pg8::AOffDirect AO{DE};
        pg8::gemm_phase<Epi6, pg8::MoeOrder, pg8::AOffDirect, true>((PG8_LAS unsigned char*)lds, AS.A, Bt, DE, S, AO, E); return; }
    for (int L = blockIdx.x;; L += gridDim.x) { Unit u; if (!moe_unit(cnt, 8, L, u)) break; gemm_simple_unit(lds, AS, Bt + (size_t)u.pn * 256 * DE, DE, E, u); }
}
__device__ __forceinline__ void phase7(const Params& p) {
    const int tid = opaque_tid(), wid = tid >> 6, lane = tid & 63;
    const bf16_t* hb = (const bf16_t*)(p.ws + OFF_HB); const bf16_t* ys2 = (const bf16_t*)(p.ws + OFF_A);
    for (int t = blockIdx.x * 8 + wid; t < T_; t += gridDim.x * 8) {
        float v[4][8]; float s = 0.f;
#pragma unroll
        for (int i = 0; i < 4; ++i) { const int c = i * 512 + lane * 8;
            const u32x4 a = *(const u32x4*)(hb + (size_t)t * D_ + c), b = *(const u32x4*)(ys2 + (size_t)(2 * t) * D_ + c), d = *(const u32x4*)(ys2 + (size_t)(2 * t + 1) * D_ + c);
#pragma unroll
            for (int q = 0; q < 4; ++q) { v[i][2 * q] = bflo(a[q]) + bflo(b[q]) + bflo(d[q]); v[i][2 * q + 1] = bfhi(a[q]) + bfhi(b[q]) + bfhi(d[q]); s += v[i][2 * q] * v[i][2 * q] + v[i][2 * q + 1] * v[i][2 * q + 1]; } }
        const float rstd = rsqrtf(wave_sum(s) * (1.f / D_) + EPS);
#pragma unroll
        for (int i = 0; i < 4; ++i) { const int c = i * 512 + lane * 8;
            const f32x4 g0 = *(const f32x4*)(p.g_final + c), g1 = *(const f32x4*)(p.g_final + c + 4);
            f32x4 o0, o1;
#pragma unroll
            for (int q = 0; q < 4; ++q) { o0[q] = v[i][q] * rstd * g0[q]; o1[q] = v[i][4 + q] * rstd * g1[q]; }
            *(f32x4*)(p.out + (size_t)t * D_ + c) = o0; *(f32x4*)(p.out + (size_t)t * D_ + c + 4) = o1; }
    }
}

#ifndef ONE_LAUNCH
#define ONE_LAUNCH 1
#endif
template <int PH> __global__ void __launch_bounds__(NTHR, 2) k_phase(Params p) {
    extern __shared__ __attribute__((aligned(16))) unsigned char lds[];
    if (PH == 0) phase0(p, lds);
    if (PH == 1) phase1(p, lds);
    if (PH == 2) phase2(p, lds);
    if (PH == 3) phase3(p, lds);
    if (PH == 4) phase4(p, lds);
    if (PH == 5) phase5(p, lds);
    if (PH == 6) phase6(p, lds);
    if (PH == 7) phase7(p);
}
__global__ void __launch_bounds__(NTHR, 2) k_mega(Params p) {
    extern __shared__ __attribute__((aligned(16))) unsigned char lds[];
    cg::grid_group grid = cg::this_grid();
    volatile PG8_LAS unsigned* bst = (volatile PG8_LAS unsigned*)((PG8_LAS unsigned char*)lds + LBAR_OFF);
    if (threadIdx.x < 2) bst[threadIdx.x] = 0u;
    __syncthreads();
    const XcdBarrier bar = xcd_barrier_post((unsigned*)(p.ws + OFF_BAR), bst);
    phase0(p, lds); grid.sync();
    phase1(p, lds); xcd_barrier(bar);
    phase2(p, lds); xcd_barrier(bar);
    phase3(p, lds); xcd_barrier(bar);
    phase4(p, lds); xcd_barrier(bar);
    phase5(p, lds); xcd_barrier(bar);
    phase6(p, lds); xcd_barrier(bar);
    phase7(p);
}

extern "C" void kernel_launch(void* const* d_in, const int* in_sizes, int n_in, void* d_out, int out_size, void* d_ws, size_t ws_size, hipStream_t stream) {
    static int grid = 0;
    if (grid == 0) {
        if (n_in != 19 || in_sizes[0] != T_ * D_ || out_size != T_ * D_ || ws_size < WS_END) { fprintf(stderr, "kernel_launch: unexpected shapes (n_in %d, in0 %d, out %d, ws %zu < %zu); nothing launched\n", n_in, n_in > 0 ? in_sizes[0] : -1, out_size, ws_size, (size_t)WS_END); grid = -1; return; }
        int dev = 0, cus = 0, per_cu = 0;
        if (hipGetDevice(&dev) != hipSuccess || hipDeviceGetAttribute(&cus, hipDeviceAttributeMultiprocessorCount, dev) != hipSuccess) { grid = -1; return; }
#if ONE_LAUNCH
        if (hipFuncSetAttribute((const void*)k_mega, hipFuncAttributeMaxDynamicSharedMemorySize, LDS_BYTES) != hipSuccess) { fprintf(stderr, "kernel_launch: hipFuncSetAttribute failed\n"); grid = -1; return; }
        if (hipOccupancyMaxActiveBlocksPerMultiprocessor(&per_cu, (const void*)k_mega, NTHR, LDS_BYTES) != hipSuccess || per_cu < 1) { fprintf(stderr, "kernel_launch: occupancy query says %d blocks per CU\n", per_cu); grid = -1; return; }
        grid = cus * per_cu;
#else
        (void)hipFuncSetAttribute((const void*)k_phase<0>, hipFuncAttributeMaxDynamicSharedMemorySize, LDS_BYTES);
        (void)hipFuncSetAttribute((const void*)k_phase<1>, hipFuncAttributeMaxDynamicSharedMemorySize, LDS_BYTES);
        (void)hipFuncSetAttribute((const void*)k_phase<2>, hipFuncAttributeMaxDynamicSharedMemorySize, LDS_BYTES);
        (void)hipFuncSetAttribute((const void*)k_phase<3>, hipFuncAttributeMaxDynamicSharedMemorySize, LDS_BYTES);
        (void)hipFuncSetAttribute((const void*)k_phase<4>, hipFuncAttributeMaxDynamicSharedMemorySize, LDS_BYTES);
        (void)hipFuncSetAttribute((const void*)k_phase<5>, hipFuncAttributeMaxDynamicSharedMemorySize, LDS_BYTES);
        (void)hipFuncSetAttribute((const void*)k_phase<6>, hipFuncAttributeMaxDynamicSharedMemorySize, LDS_BYTES);
        (void)hipFuncSetAttribute((const void*)k_phase<7>, hipFuncAttributeMaxDynamicSharedMemorySize, LDS_BYTES);
        grid = cus > 0 ? cus : 256;
#endif
    }
    if (grid < 0) return;
    Params p{};
    const float** f = (const float**)&p;
    for (int i = 0; i < 19; ++i) f[i] = (const float*)d_in[i];
    p.out = (float*)d_out; p.ws = (unsigned char*)d_ws;
#if ONE_LAUNCH
    if (hipMemsetAsync((unsigned char*)d_ws + OFF_BAR, 0, BAR_BYTES, stream) != hipSuccess) { fprintf(stderr, "kernel_launch: memset of the barrier words failed\n"); return; }
    void* args[] = {&p};
    const hipError_t e = hipLaunchCooperativeKernel((const void*)k_mega, dim3(grid), dim3(NTHR), args, LDS_BYTES, stream);
    if (e != hipSuccess) fprintf(stderr, "kernel_launch: cooperative launch failed: %s (grid %d)\n", hipGetErrorString(e), grid);
#else
    hipLaunchKernelGGL(k_phase<0>, dim3(grid), dim3(NTHR), LDS_BYTES, stream, p);
    hipLaunchKernelGGL(k_phase<1>, dim3(grid), dim3(NTHR), LDS_BYTES, stream, p);
    hipLaunchKernelGGL(k_phase<2>, dim3(grid), dim3(NTHR), LDS_BYTES, stream, p);
    hipLaunchKernelGGL(k_phase<3>, dim3(grid), dim3(NTHR), LDS_BYTES, stream, p);
    hipLaunchKernelGGL(k_phase<4>, dim3(grid), dim3(NTHR), LDS_BYTES, stream, p);
    hipLaunchKernelGGL(k_phase<5>, dim3(grid), dim3(NTHR), LDS_BYTES, stream, p);
    hipLaunchKernelGGL(k_phase<6>, dim3(grid), dim3(NTHR), LDS_BYTES, stream, p);
    hipLaunchKernelGGL(k_phase<7>, dim3(grid), dim3(NTHR), LDS_BYTES, stream, p);
#endif
}
```

```cpp
#include <hip/hip_runtime.h>
#include <hip/hip_cooperative_groups.h>
#include <cstdio>
namespace cg = cooperative_groups;

typedef unsigned short bf16_t;
typedef float f32x4 __attribute__((ext_vector_type(4)));
typedef unsigned u32x4 __attribute__((ext_vector_type(4)));
typedef unsigned u32x2 __attribute__((ext_vector_type(2)));
typedef short bf16x8 __attribute__((ext_vector_type(8)));

constexpr int T_ = 16384, D_ = 2048, DIN = 5120, NE = 32, DE = 512, SEQ = 4096, LCAP = 16384;
constexpr float EPS = 1e-6f;
#ifndef DUP_PHASE
#define DUP_PHASE -1
#endif
constexpr int NTHR = 512;
constexpr int LDS_BYTES = 147456;
constexpr int LCNT_OFF = 131072, LBAR_OFF = 131072 + 256;

constexpr size_t SZ_A = (size_t)T_ * DIN * 2;
constexpr size_t SZ_B = (size_t)T_ * D_ * 2;
constexpr size_t OFF_A = 0;
constexpr size_t OFF_B = OFF_A + SZ_A;
constexpr size_t OFF_HB = OFF_B + SZ_B;
constexpr size_t OFF_WIN = OFF_HB + SZ_B;
constexpr size_t OFF_WOUT = OFF_WIN + (size_t)DIN * D_ * 2;
constexpr size_t OFF_WGU = OFF_WOUT + (size_t)D_ * D_ * 2;
constexpr size_t OFF_WD = OFF_WGU + (size_t)NE * 1024 * D_ * 2;
constexpr size_t OFF_WR = OFF_WD + (size_t)NE * D_ * DE * 2;
constexpr size_t OFF_SSQ = OFF_WR + (size_t)48 * D_ * 2;
constexpr size_t OFF_CNT = OFF_SSQ + (size_t)3 * T_ * 4;
constexpr size_t OFF_RINFO = OFF_CNT + 256;
constexpr size_t OFF_RW = OFF_RINFO + (size_t)NE * LCAP * 4;
constexpr size_t OFF_BAR = OFF_RW + (size_t)NE * LCAP * 4;
constexpr size_t BAR_BYTES = 16384;
constexpr size_t WS_END = OFF_BAR + BAR_BYTES;
constexpr size_t OFF_DUMMY = WS_END;
constexpr size_t DUMMY_BYTES = (OFF_BAR - OFF_SSQ);

struct Params {
    const float *x, *norm_mix_g, *w_in, *v_norm_g, *gmlp_ws, *gmlp_bs, *conv_w, *g_a, *g_b, *w_out, *g_ffn, *rgw, *rgb, *rew, *reb, *ewg, *ewu, *ewd, *g_final;
    float* out; unsigned char* ws;
};

__device__ __forceinline__ unsigned cvt_pk_bf16(float lo, float hi) { unsigned r; asm volatile("v_cvt_pk_bf16_f32 %0, %1, %2" : "=v"(r) : "v"(lo), "v"(hi)); return r; }
__device__ __forceinline__ int opaque_tid() { int t = threadIdx.x; asm volatile("" : "+v"(t)); return t; }
__device__ __forceinline__ float bflo(unsigned w) { return __uint_as_float(w << 16); }
__device__ __forceinline__ float bfhi(unsigned w) { return __uint_as_float(w & 0xffff0000u); }
__device__ __forceinline__ float wave_sum(float v) {
#pragma unroll
    for (int o = 1; o < 64; o <<= 1) v += __shfl_xor(v, o);
    return v;
}
__device__ __forceinline__ float gelu_t(float x) {
    const float u = x * (0.7978845608f + 0.0356774081f * x * x);
    return x * __builtin_amdgcn_rcpf(1.f + __builtin_amdgcn_exp2f(-2.885390082f * u));
}
__device__ __forceinline__ float silu_f(float x) { return x * __builtin_amdgcn_rcpf(1.f + __builtin_amdgcn_exp2f(-1.442695041f * x)); }

#define PG8_LAS __attribute__((address_space(3)))
struct Unit { int pm, pn, e, r0, pnl; };

template <class CntPtr> __device__ __forceinline__ bool moe_unit(CntPtr cnt, int NT, int L, Unit& u) {
    int ptile = 0;
    for (int e = 0; e < NE; ++e) {
        const int nt = (cnt[e] + 255) >> 8, nu = nt * NT;
        if (L < nu) { const int mt = L / NT, j = L - mt * NT; u.e = e; u.pm = ptile + mt; u.r0 = mt * 256; u.pnl = j; u.pn = e * NT + j; return true; }
        L -= nu; ptile += nt;
    }
    return false;
}

struct Epi1 {
    static constexpr bool PERM = true, MIDSCALE = false;
    bf16_t* P;
    __device__ __forceinline__ void operator()(f32x4 (&acc)[2][2][4][2], const Unit& u, int wr, int wc, int fr, int fq) const {
        const bool act = u.pn < 8;
#pragma unroll
        for (int ai = 0; ai < 2; ++ai)
#pragma unroll
            for (int m = 0; m < 4; ++m) {
                const int row = u.pm * 256 + ai * 128 + wr * 64 + m * 16 + fr;
                bf16_t* rowp = P + (size_t)row * DIN + u.pn * 256 + wc * 32 + 8 * fq;
#pragma unroll
                for (int bj = 0; bj < 2; ++bj) {
                    f32x4 v0 = acc[ai][bj][m][0], v1 = acc[ai][bj][m][1];
                    if (act) {
#pragma unroll
                        for (int j = 0; j < 4; ++j) { v0[j] = gelu_t(v0[j]); v1[j] = gelu_t(v1[j]); }
                    }
                    u32x4 w; w.x = cvt_pk_bf16(v0[0], v0[1]); w.y = cvt_pk_bf16(v0[2], v0[3]); w.z = cvt_pk_bf16(v1[0], v1[1]); w.w = cvt_pk_bf16(v1[2], v1[3]);
                    *(u32x4*)(rowp + bj * 128) = w;
                }
            }
    }
};
struct Epi2 {
    static constexpr bool PERM = true, MIDSCALE = true;
    const float* x; bf16_t* hb; const float* ssq_a; const float* ssq_b; float* ssq_h;
    __device__ __forceinline__ void midscale(f32x4 (&acc)[2][2][4][2], const Unit& u, int wr, int wc, int fr, int fq) const {
        int rowb = u.pm * 256 + wr * 64 + fr; asm volatile("" : "+v"(rowb));
        const float* pa = ssq_a + rowb; const float* pb = ssq_b + rowb;
#pragma unroll
        for (int ai = 0; ai < 2; ++ai)
#pragma unroll
            for (int m = 0; m < 4; ++m) {
                const float s = __builtin_amdgcn_sqrtf((pb[ai * 128 + m * 16] * (1.f / 1024.f) + EPS) * __builtin_amdgcn_rcpf(pa[ai * 128 + m * 16] * (1.f / 1024.f) + EPS));
#pragma unroll
                for (int bj = 0; bj < 2; ++bj)
#pragma unroll
                    for (int n = 0; n < 2; ++n) acc[ai][bj][m][n] *= s;
                if (m & 1) asm volatile("" ::: "memory");
            }
    }
    __device__ __forceinline__ void operator()(f32x4 (&acc)[2][2][4][2], const Unit& u, int wr, int wc, int fr, int fq) const {
#pragma unroll
        for (int ai = 0; ai < 2; ++ai)
#pragma unroll
            for (int m = 0; m < 4; ++m) {
                const int row = u.pm * 256 + ai * 128 + wr * 64 + m * 16 + fr;
                const float rb = rsqrtf(ssq_b[row] * (1.f / 1024.f) + EPS);
                const size_t off = (size_t)row * D_ + u.pn * 256 + wc * 32 + 8 * fq;
                float ss = 0.f;
#pragma unroll
                for (int bj = 0; bj < 2; ++bj) {
                    const f32x4 x0 = *(const f32x4*)(x + off + bj * 128), x1 = *(const f32x4*)(x + off + bj * 128 + 4);
                    const f32x4 h0 = x0 + acc[ai][bj][m][0] * rb, h1 = x1 + acc[ai][bj][m][1] * rb;
                    ss += (h0[0] * h0[0] + h0[1] * h0[1]) + (h0[2] * h0[2] + h0[3] * h0[3]) + (h1[0] * h1[0] + h1[1] * h1[1]) + (h1[2] * h1[2] + h1[3] * h1[3]);
                    u32x4 w; w.x = cvt_pk_bf16(h0[0], h0[1]); w.y = cvt_pk_bf16(h0[2], h0[3]); w.z = cvt_pk_bf16(h1[0], h1[1]); w.w = cvt_pk_bf16(h1[2], h1[3]);
                    *(u32x4*)(hb + off + bj * 128) = w;
                }
                ss += __shfl_xor(ss, 16); ss += __shfl_xor(ss, 32);
                if (fq == 0) atomicAdd(ssq_h + row, ss);
                if (m == 3) asm volatile("" ::: "memory");
            }
    }
};
struct Epi5 {
    static constexpr bool PERM = true, MIDSCALE = false;
    bf16_t* hbuf; const float* ssq_h; const int* rinfo; const int* cnt;
    __device__ __forceinline__ void operator()(f32x4 (&acc)[2][2][4][2], const Unit& u, int wr, int wc, int fr, int fq) const {
        const int ce = cnt[u.e];
#pragma unroll
        for (int ai = 0; ai < 2; ++ai)
#pragma unroll
            for (int m = 0; m < 4; ++m) {
                const int r = ai * 128 + wr * 64 + m * 16 + fr, i = u.r0 + r;
                const int tok = (i < ce) ? (rinfo[u.e * LCAP + i] >> 1) : 0;
                const float rs = rsqrtf(ssq_h[tok] * (1.f / 2048.f) + EPS);
                float o[8];
#pragma unroll
                for (int n = 0; n < 2; ++n)
#pragma unroll
                    for (int j = 0; j < 4; ++j) o[4 * n + j] = silu_f(acc[ai][0][m][n][j] * rs) * (acc[ai][1][m][n][j] * rs);
                u32x4 w; w.x = cvt_pk_bf16(o[0], o[1]); w.y = cvt_pk_bf16(o[2], o[3]); w.z = cvt_pk_bf16(o[4], o[5]); w.w = cvt_pk_bf16(o[6], o[7]);
                *(u32x4*)(hbuf + (size_t)(u.pm * 256 + r) * DE + u.pnl * 128 + wc * 32 + 8 * fq) = w;
            }
    }
};
struct Epi6 {
    static constexpr bool PERM = true, MIDSCALE = false;
    bf16_t* ys2; const int* rinfo; const float* rw; const int* cnt;
    __device__ __forceinline__ void operator()(f32x4 (&acc)[2][2][4][2], const Unit& u, int wr, int wc, int fr, int fq) const {
        const int ce = cnt[u.e];
#pragma unroll
        for (int ai = 0; ai < 2; ++ai)
#pragma unroll
            for (int m = 0; m < 4; ++m) {
                const int r = ai * 128 + wr * 64 + m * 16 + fr, i = u.r0 + r;
                if (i < ce) {
                    const int info = rinfo[u.e * LCAP + i]; const float g = rw[u.e * LCAP + i];
                    bf16_t* dst = ys2 + (size_t)info * D_ + u.pnl * 256 + wc * 32 + 8 * fq;
#pragma unroll
                    for (int bj = 0; bj < 2; ++bj) {
                        const f32x4 v0 = acc[ai][bj][m][0] * g, v1 = acc[ai][bj][m][1] * g;
                        u32x4 w; w.x = cvt_pk_bf16(v0[0], v0[1]); w.y = cvt_pk_bf16(v0[2], v0[3]); w.z = cvt_pk_bf16(v1[0], v1[1]); w.w = cvt_pk_bf16(v1[2], v1[3]);
                        *(u32x4*)(dst + bj * 128) = w;
                    }
                }
            }
    }
};

struct ASrcDirect { const bf16_t* A; int K; __device__ __forceinline__ const bf16_t* row(const Unit& u, int r) const { return A + (size_t)(u.pm * 256 + r) * K; } };
struct ASrcGather { const bf16_t* A; const int* rinfo; const int* cnt;
    __device__ __forceinline__ const bf16_t* row(const Unit& u, int r) const { const int i = u.r0 + r; const int tok = (i < cnt[u.e]) ? (rinfo[u.e * LCAP + i] >> 1) : 0; return A + (size_t)tok * D_; } };

template <class Epi, class ASrc>
__device__ __forceinline__ void gemm_simple_unit(unsigned char* lds, const ASrc& AS, const bf16_t* Bt, int K, const Epi& E, const Unit& u) {
    float* As = (float*)lds; float* Bs = As + 32 * 256;
    const int tid = opaque_tid(), wid = tid >> 6, lane = tid & 63, wr = wid >> 2, wc = wid & 3, fr = lane & 15, fq = lane >> 4;
    f32x4 acc[2][2][4][2];
#pragma unroll
    for (int a = 0; a < 2; ++a)
#pragma unroll
        for (int b = 0; b < 2; ++b)
#pragma unroll
            for (int m = 0; m < 4; ++m)
#pragma unroll
                for (int n = 0; n < 2; ++n) acc[a][b][m][n] = (f32x4){0.f, 0.f, 0.f, 0.f};
    const bf16_t* ap[2]; const bf16_t* bp[2]; int lrow[2], lkc[2];
#pragma unroll
    for (int i = 0; i < 2; ++i) { const int p = tid + 512 * i; lrow[i] = p >> 2; lkc[i] = (p & 3) * 8; ap[i] = AS.row(u, lrow[i]) + lkc[i]; bp[i] = Bt + (size_t)lrow[i] * K + lkc[i]; }
    for (int k0 = 0; k0 < K; k0 += 32) {
        if constexpr (Epi::MIDSCALE) { if (k0 == K / 2) E.midscale(acc, u, wr, wc, fr, fq); }
        __syncthreads();
#pragma unroll
        for (int i = 0; i < 2; ++i) {
            const u32x4 a = *(const u32x4*)(ap[i] + k0), b = *(const u32x4*)(bp[i] + k0);
#pragma unroll
            for (int q = 0; q < 4; ++q) {
                As[(lkc[i] + 2 * q) * 256 + lrow[i]] = bflo(a[q]); As[(lkc[i] + 2 * q + 1) * 256 + lrow[i]] = bfhi(a[q]);
                Bs[(lkc[i] + 2 * q) * 256 + lrow[i]] = bflo(b[q]); Bs[(lkc[i] + 2 * q + 1) * 256 + lrow[i]] = bfhi(b[q]);
            }
        }
        __syncthreads();
#pragma unroll 2
        for (int k = 0; k < 32; ++k) {
            float a[2][4]; f32x4 b[2][2];
#pragma unroll
            for (int ai = 0; ai < 2; ++ai)
#pragma unroll
                for (int m = 0; m < 4; ++m) a[ai][m] = As[k * 256 + ai * 128 + wr * 64 + m * 16 + fr];
#pragma unroll
            for (int bj = 0; bj < 2; ++bj)
#pragma unroll
                for (int n = 0; n < 2; ++n) b[bj][n] = *(const f32x4*)&Bs[k * 256 + bj * 128 + wc * 32 + (Epi::PERM ? (8 * fq + 4 * n) : (16 * n + 4 * fq))];
#pragma unroll
            for (int ai = 0; ai < 2; ++ai)
#pragma unroll
                for (int bj = 0; bj < 2; ++bj)
#pragma unroll
                    for (int m = 0; m < 4; ++m)
#pragma unroll
                        for (int n = 0; n < 2; ++n) acc[ai][bj][m][n] += a[ai][m] * b[bj][n];
        }
    }
    E(acc, u, wr, wc, fr, fq);
    __syncthreads();
}


namespace pg8 {
constexpr int BM = 256, BK = 64, HALF = 128, HTB = HALF * BK * 2, STAGE_BYTES = 8 * HTB, NXCD = 8, WGM = 8;
__host__ __device__ __forceinline__ int lds_byte(int r, int c) { const int st = (r >> 4) * 2 + (c >> 5), rr = r & 15, cc = c & 31, ob = rr * 64 + cc * 2; return st * 1024 + (ob ^ (((ob >> 9) & 1) << 5)); }
__host__ __device__ __forceinline__ void stage_rc(int b, int& R, int& C) { const int st = b / 1024, sb = b % 1024, swz = sb ^ (((sb >> 9) & 1) << 5); R = (st >> 1) * 16 + swz / 64; C = (st & 1) * 32 + (swz % 64) / 2; }
__host__ __device__ __forceinline__ int perm32(int rho) { const int n = rho >> 4, i = rho & 15; return 8 * (i >> 2) + 4 * n + (i & 3); }

struct StaticOrder {
    int nM, nN, nwg, G, c;
    __device__ void init(int M, int N, int G_, int c_) { nM = M / BM; nN = N / BM; nwg = nM * nN; G = G_; c = c_; }
    __device__ bool next(int i, Unit& u) const {
        const long L = (long)i * G + c; if (L >= nwg) return false;
        int wgid = (int)L; { const int q = nwg / NXCD, r = nwg % NXCD, xcd = wgid % NXCD, off = wgid / NXCD; wgid = (xcd < r ? xcd * (q + 1) : r * (q + 1) + (xcd - r) * q) + off; }
        const int nig = WGM * nN, gid = wgid / nig, fm = gid * WGM, gsz = (nM - fm) < WGM ? (nM - fm) : WGM;
        u.pm = fm + ((wgid % nig) % gsz); u.pn = (wgid % nig) / gsz; u.e = 0; u.r0 = 0; u.pnl = u.pn; return true;
    }
};
typedef const PG8_LAS int* lcnt_t;
struct MoeOrder {
    lcnt_t cnt; int NT, G, c;
    __device__ bool next(int i, Unit& u) const { return moe_unit(cnt, NT, i * G + c, u); }
};
struct AOffDirect { int K; __device__ __forceinline__ unsigned operator()(const Unit& u, int h, int R, int C) const { return (unsigned)(((u.pm * 256 + h * 128 + R) * K + C) * 2); } };
struct AOffGather { const int* rinfo; lcnt_t cnt;
    __device__ __forceinline__ unsigned operator()(const Unit& u, int h, int R, int C) const { const int i = u.r0 + h * 128 + R; const int tok = (i < cnt[u.e]) ? (rinfo[u.e * LCAP + i] >> 1) : 0; return (unsigned)((tok * D_ + C) * 2); } };

template <class Epi, class Sched, class AOff, bool ALIGN_EPI>
__device__ __forceinline__ void gemm_phase(PG8_LAS unsigned char* lds, const bf16_t* Ag, const bf16_t* Btg, const int K, const Sched& S, const AOff& AO, const Epi& E) {
    const int tid = opaque_tid(), wid = __builtin_amdgcn_readfirstlane(tid >> 6), lane = tid & 63, wr = wid >> 2, wc = wid & 3, fr = lane & 15, fq = lane >> 4;
    const int nt = K / BK;
    unsigned voffB[2];
#pragma unroll
    for (int i = 0; i < 2; ++i) { int R, C; stage_rc(tid * 16 + i * 8192, R, C); const int Rb = Epi::PERM ? ((R & ~31) + perm32(R & 31)) : R; voffB[i] = (unsigned)(Rb * K + C) * 2u; }
#define PG8_AOFFS(u) do { int _t = tid; asm volatile("" : "+v"(_t)); _Pragma("unroll") for (int _i = 0; _i < 2; ++_i) { int _R, _C; stage_rc(_t * 16 + _i * 8192, _R, _C); vo0[_i] = AO(u, 0, _R, _C); vo1[_i] = AO(u, 1, _R, _C); } } while (0)
    const size_t kstep = (size_t)(BK * 2), hstep = (size_t)HALF * K * 2, tstep = 2 * hstep;
    const unsigned ldsw = (unsigned)wid * 1024u;
    const int aoff = lds_byte(wr * 64 + fr, fq * 8), boff = lds_byte(wc * 32 + fr, fq * 8);
    const char* const Ab = (const char*)Ag;
#define PG8_SA(b, h) (((b) * 2 + (h)) * HTB)
#define PG8_SB(b, h) ((4 + (b) * 2 + (h)) * HTB)
#define PG8_STAGE(bufoff, gbase, voff) do { _Pragma("unroll") for (int _i = 0; _i < 2; ++_i) \
        __builtin_amdgcn_global_load_lds((const unsigned*)((const char*)(gbase) + (voff)[_i]), (PG8_LAS unsigned*)(lds + (bufoff) + ldsw + _i * 8192), 16, 0, 0); } while (0)
#define PG8_LDA(dst, b, h) do { _Pragma("unroll") for (int m = 0; m < 4; ++m) _Pragma("unroll") for (int k = 0; k < 2; ++k) dst[m][k] = *(const PG8_LAS bf16x8*)(lds + PG8_SA(b, h) + aoff + m * 2048 + k * 1024); } while (0)
#define PG8_LDB(dst, b, h) do { _Pragma("unroll") for (int n = 0; n < 2; ++n) _Pragma("unroll") for (int k = 0; k < 2; ++k) dst[n][k] = *(const PG8_LAS bf16x8*)(lds + PG8_SB(b, h) + boff + n * 2048 + k * 1024); } while (0)
#define PG8_MMA(ai, bj, At, Bt) do { __builtin_amdgcn_s_setprio(1); _Pragma("unroll") for (int m = 0; m < 4; ++m) _Pragma("unroll") for (int n = 0; n < 2; ++n) _Pragma("unroll") for (int k = 0; k < 2; ++k) \
        acc[ai][bj][m][n] = __builtin_amdgcn_mfma_f32_16x16x32_bf16(Bt[n][k], At[m][k], acc[ai][bj][m][n], 0, 0, 0); __builtin_amdgcn_s_setprio(0); } while (0)
#define PG8_WAIT_V(n) asm volatile("s_waitcnt vmcnt(" #n ")" ::: "memory")
#define PG8_WAIT_L(n) asm volatile("s_waitcnt lgkmcnt(" #n ")" ::: "memory")
#define PG8_BAR __builtin_amdgcn_s_barrier()
#define PG8_SCHED __builtin_amdgcn_sched_barrier(0)
    Unit cur, nxt; int ui = 0;
    if (!S.next(0, cur)) return;
    f32x4 acc[2][2][4][2];
#pragma unroll
    for (int a = 0; a < 2; ++a)
#pragma unroll
        for (int b = 0; b < 2; ++b)
#pragma unroll
            for (int m = 0; m < 4; ++m)
#pragma unroll
                for (int n = 0; n < 2; ++n) acc[a][b][m][n] = (f32x4){0.f, 0.f, 0.f, 0.f};
    bf16x8 At[4][2], B0[2][2], B1[2][2];
    unsigned vo0[2], vo1[2];
    PG8_AOFFS(cur);
    const char* cB = (const char*)Btg + (size_t)cur.pn * tstep;
    PG8_STAGE(PG8_SB(0, 0), cB, voffB); PG8_STAGE(PG8_SB(0, 1), cB + hstep, voffB); PG8_STAGE(PG8_SA(0, 0), Ab, vo0); PG8_STAGE(PG8_SA(0, 1), Ab, vo1);
    if (wr == 1) PG8_BAR;
    PG8_WAIT_V(2); PG8_BAR;
    PG8_STAGE(PG8_SB(1, 0), cB + kstep, voffB); PG8_STAGE(PG8_SA(1, 0), Ab + kstep, vo0); PG8_STAGE(PG8_SB(1, 1), cB + hstep + kstep, voffB);
    PG8_WAIT_V(6); PG8_BAR;
    for (;;) {
        const bool has_next = S.next(ui + 1, nxt);
        const char* nB = has_next ? (const char*)Btg + (size_t)nxt.pn * tstep : cB;
        for (int t = 0; t < nt; t += 2) {
            const bool last = (t == nt - 2);
            if constexpr (Epi::MIDSCALE) { if (t == nt / 2) { int _t = tid; asm volatile("" : "+v"(_t)); const int _l = _t & 63; E.midscale(acc, cur, wr, wc, _l & 15, _l >> 4); } }
            const size_t k1 = (size_t)(t + 1) * kstep, k2 = last ? (size_t)0 : (size_t)(t + 2) * kstep, k3 = k2 + kstep;
            const char* b2 = last ? nB : cB + (size_t)(t + 2) * kstep; const char* b3 = b2 + kstep;
            PG8_LDB(B0, 0, 0); PG8_LDB(B1, 0, 1); PG8_SCHED; PG8_LDA(At, 0, 0); PG8_STAGE(PG8_SA(1, 1), Ab + k1, vo1);
            PG8_WAIT_V(8); PG8_WAIT_L(0); PG8_BAR; PG8_MMA(0, 0, At, B0); PG8_MMA(0, 1, At, B1); PG8_BAR; PG8_SCHED;
            if (last && has_next) { PG8_AOFFS(nxt); }
            PG8_LDA(At, 0, 1); PG8_STAGE(PG8_SB(0, 0), b2, voffB); PG8_STAGE(PG8_SB(0, 1), b2 + hstep, voffB); PG8_STAGE(PG8_SA(0, 0), Ab + k2, vo0);
            PG8_WAIT_V(8); PG8_WAIT_L(0); PG8_BAR; PG8_MMA(1, 0, At, B0); PG8_MMA(1, 1, At, B1); PG8_BAR; PG8_SCHED;
            PG8_LDB(B0, 1, 0); PG8_LDB(B1, 1, 1); PG8_SCHED; PG8_LDA(At, 1, 0); PG8_STAGE(PG8_SA(0, 1), Ab + k2, vo1);
            PG8_WAIT_V(8); PG8_WAIT_L(0); PG8_BAR; PG8_MMA(0, 0, At, B0); PG8_MMA(0, 1, At, B1); PG8_BAR; PG8_SCHED;
            PG8_LDA(At, 1, 1); PG8_STAGE(PG8_SB(1, 0), b3, voffB); PG8_STAGE(PG8_SB(1, 1), b3 + hstep, voffB); PG8_STAGE(PG8_SA(1, 0), Ab + k3, vo0);
            PG8_WAIT_V(8); PG8_WAIT_L(0); PG8_BAR; PG8_MMA(1, 0, At, B0); PG8_MMA(1, 1, At, B1); PG8_BAR; PG8_SCHED;
        }
        if constexpr (ALIGN_EPI) { if (wr == 0) PG8_BAR; }
        { int _t = tid; asm volatile("" : "+v"(_t)); const int _l = _t & 63; E(acc, cur, wr, wc, _l & 15, _l >> 4); }
        if (!has_next) break;
#pragma unroll
        for (int a = 0; a < 2; ++a)
#pragma unroll
            for (int b = 0; b < 2; ++b)
#pragma unroll
                for (int m = 0; m < 4; ++m)
#pragma unroll
                    for (int n = 0; n < 2; ++n) acc[a][b][m][n] = (f32x4){0.f, 0.f, 0.f, 0.f};
        cur = nxt; cB = nB; ++ui;
        if constexpr (ALIGN_EPI) { if (wr == 1) PG8_BAR; }
    }
    PG8_WAIT_V(0);
    if constexpr (!ALIGN_EPI) { if (wr == 0) PG8_BAR; }
    PG8_BAR;
#undef PG8_AOFFS
#undef PG8_SA
#undef PG8_SB
#undef PG8_STAGE
#undef PG8_LDA
#undef PG8_LDB
#undef PG8_MMA
#undef PG8_WAIT_V
#undef PG8_WAIT_L
#undef PG8_BAR
#undef PG8_SCHED
}
}

#ifndef FAST_MASK
#define FAST_MASK 0x6A
#endif


#define XB_TMO      128
#define XB_XCNT(j)  (256  + 64 * (j))
#define XB_XSUB(j)  (1280 + 64 * (j))
#define XB_XGEN(j)  (2304 + 64 * (j))
#define XB_TOP      3328
#define XB_TOPGEN   3392
#define XCD_BAR_WORDS 3456
#define XB_SPIN_CAP (1u << 18)
__device__ __forceinline__ unsigned xb_ld(unsigned* p)              { return __hip_atomic_load(p, __ATOMIC_RELAXED, __HIP_MEMORY_SCOPE_AGENT); }
__device__ __forceinline__ unsigned xb_add(unsigned* p, unsigned v) { return __hip_atomic_fetch_add(p, v, __ATOMIC_RELAXED, __HIP_MEMORY_SCOPE_AGENT); }
__device__ __forceinline__ unsigned xb_xcc_id() { return (unsigned)__builtin_amdgcn_s_getreg((3 << 11) | 20) & 0xFu; }
#define XB_SPIN(cond, bar) do { unsigned _sp = 0; while (cond) { __builtin_amdgcn_s_sleep(1); \
    if ((++_sp & 255u) == 0u) { if (xb_ld(&(bar)[XB_TMO])) break; if (_sp > XB_SPIN_CAP) { atomicAdd(&(bar)[XB_TMO], 1u); break; } } } } while (0)
struct XcdBarrier { unsigned* bar; unsigned x; volatile PG8_LAS unsigned* st; };
__device__ __forceinline__ XcdBarrier xcd_barrier_post(unsigned* bar, volatile PG8_LAS unsigned* st) {
    XcdBarrier b; b.bar = bar; b.x = xb_xcc_id(); b.st = st;
    if (threadIdx.x == 0) (void)xb_add(&bar[XB_XCNT(b.x)], 1u);
    return b;
}
__device__ __forceinline__ void xcd_barrier_complete(unsigned* bar, unsigned x, unsigned& nloc, unsigned& nx) {
    const unsigned G = gridDim.x * gridDim.y * gridDim.z;
    unsigned sum, cnt, mine, sp = 0u;
    for (;;) {
        sum = 0u; cnt = 0u; mine = 0u;
#pragma unroll
        for (unsigned j = 0; j < 16; ++j) { const unsigned c = xb_ld(&bar[XB_XCNT(j)]); sum += c; cnt += (c > 0u) ? 1u : 0u; mine = (j == x) ? c : mine; }
        if (sum == G) break;
        __builtin_amdgcn_s_sleep(1);
        if ((++sp & 255u) == 0u) { if (xb_ld(&bar[XB_TMO])) break; if (sp > XB_SPIN_CAP) { atomicAdd(&bar[XB_TMO], 1u); break; } }
    }
    nloc = mine > 0u ? mine : 1u; nx = cnt > 0u ? cnt : 1u;
}
__device__ __forceinline__ void xcd_barrier(const XcdBarrier& b) {
    asm volatile("s_waitcnt vmcnt(0)" ::: "memory");
    __syncthreads();
    if (threadIdx.x == 0) {
        unsigned* bar = b.bar;
        __builtin_amdgcn_s_waitcnt(0);
        unsigned nloc = b.st[0], nx = b.st[1];
        if (nloc == 0u) { xcd_barrier_complete(bar, b.x, nloc, nx); b.st[0] = nloc; b.st[1] = nx; }
        const unsigned old = xb_add(&bar[XB_XSUB(b.x)], 1u);
        const unsigned gen = old / nloc;
        if (old + 1u == (gen + 1u) * nloc) {
            __builtin_amdgcn_fence(__ATOMIC_RELEASE, "agent");
            asm volatile("s_waitcnt vmcnt(0)" ::: "memory");
            const unsigned og = xb_add(&bar[XB_TOP], 1u);
            const unsigned tg = og / nx;
            if (og + 1u == (tg + 1u) * nx) xb_add(&bar[XB_TOPGEN], 1u);
            else XB_SPIN(xb_ld(&bar[XB_TOPGEN]) == tg, bar);
            __builtin_amdgcn_fence(__ATOMIC_ACQUIRE, "agent");
            xb_add(&bar[XB_XGEN(b.x)], 1u);
            asm volatile("s_waitcnt vmcnt(0)" ::: "memory");
        } else {
            XB_SPIN(xb_ld(&bar[XB_XGEN(b.x)]) == gen, bar);
            __builtin_amdgcn_fence(__ATOMIC_ACQUIRE, "agent");
            asm volatile("s_waitcnt vmcnt(0)" ::: "memory");
        }
    }
    __syncthreads();
}

__device__ __forceinline__ void transpose_tile(float* lt, const float* src, int ldsrc, int r0, int c0, bf16_t* dst, int lddst, int dr0, const float* sA, const float* sB, int split) {
    const int tid = opaque_tid();
    { const int r = tid >> 3, cc = (tid & 7) * 8;
      const float* s = src + (size_t)(r0 + r) * ldsrc + c0 + cc;
      const f32x4 v0 = *(const f32x4*)s, v1 = *(const f32x4*)(s + 4);
      float sc = 1.f; if (sA) { const int rr = r0 + r; sc = rr < split ? sA[rr] : sB[rr - split]; }
#pragma unroll
      for (int q = 0; q < 4; ++q) { lt[r * 65 + cc + q] = v0[q] * sc; lt[r * 65 + cc + 4 + q] = v1[q] * sc; } }
    __syncthreads();
    { const int c = tid >> 3, rr = (tid & 7) * 8;
      float v[8];
#pragma unroll
      for (int q = 0; q < 8; ++q) v[q] = lt[(rr + q) * 65 + c];
      u32x4 w; w.x = cvt_pk_bf16(v[0], v[1]); w.y = cvt_pk_bf16(v[2], v[3]); w.z = cvt_pk_bf16(v[4], v[5]); w.w = cvt_pk_bf16(v[6], v[7]);
      *(u32x4*)(dst + (size_t)(dr0 + c) * lddst + r0 + rr) = w; }
    __syncthreads();
}
__device__ __forceinline__ void phase0(const Params& p, unsigned char* lds) {
    const int tid = opaque_tid(), nb = gridDim.x, bid = blockIdx.x, wid = tid >> 6, lane = tid & 63;
    { float* z = (float*)(p.ws + OFF_SSQ);
      for (int i = bid * NTHR + tid; i < 3 * T_ + 64; i += nb * NTHR) z[i] = 0.f;
      if (DUP_PHASE >= 2 && DUP_PHASE <= 4) { float* zd = (float*)(p.ws + OFF_SSQ + (OFF_DUMMY - OFF_SSQ)); for (int i = bid * NTHR + tid; i < 3 * T_ + 64; i += nb * NTHR) zd[i] = 0.f; } }
    { bf16_t* wrt = (bf16_t*)(p.ws + OFF_WR);
      for (int i = bid * NTHR + tid; i < 48 * D_; i += nb * NTHR) {
          const int o = i >> 11, k = i & 2047; float v = 0.f;
          if (o < 4) v = p.rgw[k * 4 + o]; else if (o < 36) v = p.rew[k * 32 + (o - 4)];
          wrt[i] = (bf16_t)(cvt_pk_bf16(v * p.g_ffn[k], 0.f) & 0xffffu); } }
    { bf16_t* xn = (bf16_t*)(p.ws + OFF_B);
      for (int row = bid * 8 + wid; row < T_; row += nb * 8) {
          const float* xr = p.x + (size_t)row * D_;
          f32x4 v[8]; float s = 0.f;
#pragma unroll
          for (int i = 0; i < 8; ++i) { v[i] = *(const f32x4*)(xr + i * 256 + lane * 4); s += (v[i][0] * v[i][0] + v[i][1] * v[i][1]) + (v[i][2] * v[i][2] + v[i][3] * v[i][3]); }
          const float rstd = rsqrtf(wave_sum(s) * (1.f / D_) + EPS);
#pragma unroll
          for (int i = 0; i < 8; ++i) { const f32x4 g = *(const f32x4*)(p.norm_mix_g + i * 256 + lane * 4); const f32x4 o = v[i] * rstd * g;
              u32x2 w; w.x = cvt_pk_bf16(o[0], o[1]); w.y = cvt_pk_bf16(o[2], o[3]); *(u32x2*)(xn + (size_t)row * D_ + i * 256 + lane * 4) = w; } } }
    float* lt = (float*)lds;
    constexpr int N_IN = 32 * 80, N_OUT = 32 * 32, N_G = 32 * 256, N_TOT = N_IN + N_OUT + 3 * N_G;
    for (int tile = bid; tile < N_TOT; tile += nb) {
        int q = tile;
        if (q < N_IN) { const int tr = q / 80, tc = q % 80; transpose_tile(lt, p.w_in, DIN, tr * 64, tc * 64, (bf16_t*)(p.ws + OFF_WIN), D_, tc * 64, nullptr, nullptr, 0); continue; } q -= N_IN;
        if (q < N_OUT) { const int tr = q / 32, tc = q % 32; transpose_tile(lt, p.w_out, D_, tr * 64, tc * 64, (bf16_t*)(p.ws + OFF_WOUT), D_, tc * 64, p.g_a, p.g_b, 1024); continue; } q -= N_OUT;
        if (q < 2 * N_G) { const int up = q >= N_G; if (up) q -= N_G; const int e = q >> 8, rem = q & 255, tr = rem >> 3, tc = rem & 7; const int c0 = tc * 64;
            transpose_tile(lt, (up ? p.ewu : p.ewg) + (size_t)e * D_ * DE, DE, tr * 64, c0, (bf16_t*)(p.ws + OFF_WGU) + (size_t)e * 1024 * D_, D_, (c0 >> 7) * 256 + (up ? 128 : 0) + (c0 & 127), p.g_ffn, p.g_ffn, 1 << 30); continue; } q -= 2 * N_G;
        { const int e = q >> 8, rem = q & 255, tr = rem >> 5, tc = rem & 31;
          transpose_tile(lt, p.ewd + (size_t)e * DE * D_, D_, tr * 64, tc * 64, (bf16_t*)(p.ws + OFF_WD) + (size_t)e * D_ * DE, DE, tc * 64, nullptr, nullptr, 0); }
    }
}

__device__ __forceinline__ void phase1(const Params& p, unsigned char* lds) {
    const ASrcDirect AS{(const bf16_t*)(p.ws + OFF_B), D_}; const Epi1 E{(bf16_t*)(p.ws + OFF_A)};
    const bf16_t* Bt = (const bf16_t*)(p.ws + OFF_WIN);
    if (FAST_MASK & 2) { pg8::StaticOrder S; S.init(T_, DIN, gridDim.x, blockIdx.x); const pg8::AOffDirect AO{D_};
        pg8::gemm_phase<Epi1, pg8::StaticOrder, pg8::AOffDirect, true>((PG8_LAS unsigned char*)lds, AS.A, Bt, D_, S, AO, E); return; }
    for (int L = blockIdx.x; L < 64 * 20; L += gridDim.x) { Unit u; u.pm = L / 20; u.pn = L % 20; u.e = 0; u.r0 = 0; u.pnl = u.pn;
        gemm_simple_unit(lds, AS, Bt + (size_t)u.pn * 256 * D_, D_, E, u); }
}

__device__ __forceinline__ void mixer_gmlp_item(const Params& p, unsigned char* lds, int item, size_t so) {
    const int tid = opaque_tid(), wid = tid >> 6, lane = tid & 63, fr = lane & 15, fq = lane >> 4;
    const int h = item & 7, t0 = (item >> 3) * 128;
    const bf16_t* P = (const bf16_t*)(p.ws + OFF_A); bf16_t* Y = (bf16_t*)(p.ws + OFF_B); float* ssq_a = (float*)(p.ws + OFF_SSQ + so);
    bf16_t* Vt = (bf16_t*)lds;
    bf16_t* Wl = Vt + 128 * 136;
    float* rs = (float*)(Wl + 128 * 136);
    { const int j = tid >> 2, dc = (tid & 3) * 32;
      const u32x4* src = (const u32x4*)(P + (size_t)(t0 + j) * DIN + 1024 + h * 128 + dc);
      u32x4 v[4]; float s = 0.f;
#pragma unroll
      for (int q = 0; q < 4; ++q) { v[q] = src[q];
#pragma unroll
          for (int w = 0; w < 4; ++w) { const float lo = bflo(v[q][w]), hi = bfhi(v[q][w]); s += lo * lo + hi * hi; } }
      s += __shfl_xor(s, 1); s += __shfl_xor(s, 2);
      if ((tid & 3) == 0) rs[j] = rsqrtf(s * (1.f / 128.f) + EPS);
#pragma unroll
      for (int q = 0; q < 4; ++q)
#pragma unroll
          for (int w = 0; w < 4; ++w) { const int d = dc + q * 8 + w * 2; Vt[d * 136 + j] = (bf16_t)(v[q][w] & 0xffffu); Vt[(d + 1) * 136 + j] = (bf16_t)(v[q][w] >> 16); } }
    __syncthreads();
    { const int i = tid >> 2, jc = (tid & 3) * 32;
      const f32x4* src = (const f32x4*)(p.gmlp_ws + (size_t)h * 16384 + i * 128 + jc);
      const bool live = (i >> 6) >= (jc >> 6);
#pragma unroll
      for (int q = 0; q < 4; ++q) { f32x4 w0 = src[2 * q], w1 = src[2 * q + 1];
          const f32x4 r0 = *(const f32x4*)(rs + jc + 8 * q), r1 = *(const f32x4*)(rs + jc + 8 * q + 4);
          w0 = live ? w0 * r0 : (f32x4){0.f, 0.f, 0.f, 0.f}; w1 = live ? w1 * r1 : (f32x4){0.f, 0.f, 0.f, 0.f};
          u32x4 o; o.x = cvt_pk_bf16(w0[0], w0[1]); o.y = cvt_pk_bf16(w0[2], w0[3]); o.z = cvt_pk_bf16(w1[0], w1[1]); o.w = cvt_pk_bf16(w1[2], w1[3]);
          *(u32x4*)(Wl + i * 136 + jc + 8 * q) = o; } }
    __syncthreads();
    f32x4 acc[8];
#pragma unroll
    for (int n = 0; n < 8; ++n) acc[n] = (f32x4){0.f, 0.f, 0.f, 0.f};
    const int ksteps = (wid < 4) ? 2 : 4;
    for (int ks = 0; ks < ksteps; ++ks) {
        const bf16x8 bw = *(const bf16x8*)(Wl + (16 * wid + fr) * 136 + ks * 32 + fq * 8);
#pragma unroll
        for (int n = 0; n < 8; ++n) { const bf16x8 av = *(const bf16x8*)(Vt + (16 * n + fr) * 136 + ks * 32 + fq * 8);
            acc[n] = __builtin_amdgcn_mfma_f32_16x16x32_bf16(av, bw, acc[n], 0, 0, 0); }
    }
    { const int i = 16 * wid + fr, t = t0 + i; const float bias = p.gmlp_bs[h * 128 + i]; float ss = 0.f;
#pragma unroll
      for (int n = 0; n < 8; ++n) { const int c = h * 128 + 16 * n + 4 * fq;
          const f32x4 g = *(const f32x4*)(p.v_norm_g + c); const u32x2 uu = *(const u32x2*)(P + (size_t)t * DIN + c);
          const float y0 = bflo(uu.x) * (acc[n][0] * g[0] + bias), y1 = bfhi(uu.x) * (acc[n][1] * g[1] + bias), y2 = bflo(uu.y) * (acc[n][2] * g[2] + bias), y3 = bfhi(uu.y) * (acc[n][3] * g[3] + bias);
          ss += (y0 * y0 + y1 * y1) + (y2 * y2 + y3 * y3);
          u32x2 w; w.x = cvt_pk_bf16(y0, y1); w.y = cvt_pk_bf16(y2, y3); *(u32x2*)(Y + (size_t)t * D_ + c) = w; }
      ss += __shfl_xor(ss, 16); ss += __shfl_xor(ss, 32);
      if (fq == 0) atomicAdd(ssq_a + t, ss); }
    __syncthreads();
}
__device__ __forceinline__ void mixer_conv_item(const Params& p, int item, size_t so) {
    const int tid = opaque_tid(), cl = tid & 31, ts = tid >> 5;
    const int c = (item & 3) * 256 + cl * 8, tbeg = (item >> 2) * 128 + ts * 8;
    const bf16_t* P = (const bf16_t*)(p.ws + OFF_A); bf16_t* Y = (bf16_t*)(p.ws + OFF_B); float* ssq_b = (float*)(p.ws + OFF_SSQ + so) + T_;
    float w0[8], w1[8], w2[8], z1[8], z2[8];
    { const f32x4 a0 = *(const f32x4*)(p.conv_w + c), a1 = *(const f32x4*)(p.conv_w + c + 4), b0 = *(const f32x4*)(p.conv_w + 1024 + c), b1 = *(const f32x4*)(p.conv_w + 1024 + c + 4),
                  c0 = *(const f32x4*)(p.conv_w + 2048 + c), c1 = *(const f32x4*)(p.conv_w + 2048 + c + 4);
#pragma unroll
      for (int q = 0; q < 4; ++q) { w0[q] = a0[q]; w0[4 + q] = a1[q]; w1[q] = b0[q]; w1[4 + q] = b1[q]; w2[q] = c0[q]; w2[4 + q] = c1[q]; } }
#pragma unroll
    for (int q = 0; q < 8; ++q) { z1[q] = 0.f; z2[q] = 0.f; }
    if ((tbeg % SEQ) != 0) {
        const u32x4 ca = *(const u32x4*)(P + (size_t)(tbeg - 1) * DIN + 3072 + c), ha = *(const u32x4*)(P + (size_t)(tbeg - 1) * DIN + 4096 + c);
        const u32x4 cb = *(const u32x4*)(P + (size_t)(tbeg - 2) * DIN + 3072 + c), hb2 = *(const u32x4*)(P + (size_t)(tbeg - 2) * DIN + 4096 + c);
#pragma unroll
        for (int q = 0; q < 4; ++q) { z1[2 * q] = bflo(ca[q]) * bflo(ha[q]); z1[2 * q + 1] = bfhi(ca[q]) * bfhi(ha[q]); z2[2 * q] = bflo(cb[q]) * bflo(hb2[q]); z2[2 * q + 1] = bfhi(cb[q]) * bfhi(hb2[q]); }
    }
    u32x4 bgA[8], cgA[8], hvA[8];
#pragma unroll
    for (int tt = 0; tt < 8; ++tt) { const bf16_t* pr = P + (size_t)(tbeg + tt) * DIN + c; bgA[tt] = *(const u32x4*)(pr + 2048); cgA[tt] = *(const u32x4*)(pr + 3072); hvA[tt] = *(const u32x4*)(pr + 4096); }
#pragma unroll
    for (int tt = 0; tt < 8; ++tt) {
        const int t = tbeg + tt;
        const u32x4 bg = bgA[tt], cgv = cgA[tt], hv = hvA[tt];
        float z[8], y[8], ss = 0.f;
#pragma unroll
        for (int q = 0; q < 4; ++q) { z[2 * q] = bflo(cgv[q]) * bflo(hv[q]); z[2 * q + 1] = bfhi(cgv[q]) * bfhi(hv[q]); }
#pragma unroll
        for (int q = 0; q < 4; ++q) {
            y[2 * q] = bflo(bg[q]) * (w0[2 * q] * z2[2 * q] + w1[2 * q] * z1[2 * q] + w2[2 * q] * z[2 * q]);
            y[2 * q + 1] = bfhi(bg[q]) * (w0[2 * q + 1] * z2[2 * q + 1] + w1[2 * q + 1] * z1[2 * q + 1] + w2[2 * q + 1] * z[2 * q + 1]); }
#pragma unroll
        for (int q = 0; q < 8; ++q) { ss += y[q] * y[q]; z2[q] = z1[q]; z1[q] = z[q]; }
        u32x4 w; w.x = cvt_pk_bf16(y[0], y[1]); w.y = cvt_pk_bf16(y[2], y[3]); w.z = cvt_pk_bf16(y[4], y[5]); w.w = cvt_pk_bf16(y[6], y[7]);
        *(u32x4*)(Y + (size_t)t * D_ + 1024 + c) = w;
        ss += __shfl_xor(ss, 1); ss += __shfl_xor(ss, 2); ss += __shfl_xor(ss, 4); ss += __shfl_xor(ss, 8); ss += __shfl_xor(ss, 16);
        if (cl == 0) atomicAdd(ssq_b + t, ss);
    }
}
__device__ __forceinline__ void phase2(const Params& p, unsigned char* lds, size_t so = 0) {
    for (int it = blockIdx.x; it < 512 + 1024; it += gridDim.x) { if (it < 512) mixer_conv_item(p, it, so); else mixer_gmlp_item(p, lds, it - 512, so); }
}

__device__ __forceinline__ void phase3(const Params& p, unsigned char* lds, size_t so = 0) {
    const ASrcDirect AS{(const bf16_t*)(p.ws + OFF_B), D_};
    float* ssq = (float*)(p.ws + OFF_SSQ);
    const Epi2 E{p.x, (bf16_t*)(p.ws + OFF_HB), ssq, ssq + T_, (float*)(p.ws + OFF_SSQ + so) + 2 * T_};
    const bf16_t* Bt = (const bf16_t*)(p.ws + OFF_WOUT);
    if (FAST_MASK & 8) { pg8::StaticOrder S; S.init(T_, D_, gridDim.x, blockIdx.x); const pg8::AOffDirect AO{D_};
        pg8::gemm_phase<Epi2, pg8::StaticOrder, pg8::AOffDirect, true>((PG8_LAS unsigned char*)lds, AS.A, Bt, D_, S, AO, E); return; }
    for (int L = blockIdx.x; L < 64 * 8; L += gridDim.x) { Unit u; u.pm = L / 8; u.pn = L % 8; u.e = 0; u.r0 = 0; u.pnl = u.pn;
        gemm_simple_unit(lds, AS, Bt + (size_t)u.pn * 256 * D_, D_, E, u); }
}

__device__ __forceinline__ void route_item(const Params& p, unsigned char* lds, int item, size_t so) {
    const int tid = opaque_tid(), wid = tid >> 6, lane = tid & 63, fr = lane & 15, fq = lane >> 4;
    float* lg = (float*)lds;
    int* lcnt = (int*)(lg + 2 * 64 * 48); int* lbase = lcnt + 32;
    const bf16_t* hb = (const bf16_t*)(p.ws + OFF_HB); const bf16_t* wrt = (const bf16_t*)(p.ws + OFF_WR);
    const float* ssq_h = (const float*)(p.ws + OFF_SSQ) + 2 * T_;
    int* cnt = (int*)(p.ws + OFF_CNT + so); int* rinfo = (int*)(p.ws + OFF_RINFO + so); float* rw = (float*)(p.ws + OFF_RW + so);
    const int tg = wid & 3, kh = wid >> 2, t0 = item * 64;
    if (tid < 32) lcnt[tid] = 0;
    f32x4 acc[3];
#pragma unroll
    for (int n = 0; n < 3; ++n) acc[n] = (f32x4){0.f, 0.f, 0.f, 0.f};
    const bf16_t* ap = hb + (size_t)(t0 + tg * 16 + fr) * D_ + kh * 1024 + fq * 8; const bf16_t* bp = wrt + (size_t)fr * D_ + kh * 1024 + fq * 8;
#pragma unroll 8
    for (int ks = 0; ks < 32; ++ks) { const bf16x8 a = *(const bf16x8*)(ap + ks * 32);
#pragma unroll
        for (int n = 0; n < 3; ++n) { const bf16x8 b = *(const bf16x8*)(bp + (size_t)n * 16 * D_ + ks * 32); acc[n] = __builtin_amdgcn_mfma_f32_16x16x32_bf16(a, b, acc[n], 0, 0, 0); } }
#pragma unroll
    for (int n = 0; n < 3; ++n)
#pragma unroll
        for (int j = 0; j < 4; ++j) lg[(kh * 64 + tg * 16 + 4 * fq + j) * 48 + 16 * n + fr] = acc[n][j];
    __syncthreads();
    int e0 = 0, e1 = 0, r0 = 0, r1 = 0; float g0 = 0.f, g1 = 0.f; const int t = t0 + tid;
    if (tid < 64) {
        const float* l0 = lg + tid * 48; const float* l1 = l0 + 64 * 48; const float rstd = rsqrtf(ssq_h[t] * (1.f / D_) + EPS);
        float gm = -3.0e38f; int gi = 0; float gl[4];
#pragma unroll
        for (int o = 0; o < 4; ++o) { gl[o] = (l0[o] + l1[o]) * rstd + p.rgb[o]; if (gl[o] > gm) { gm = gl[o]; gi = o; } }
        float gs = 0.f;
#pragma unroll
        for (int o = 0; o < 4; ++o) gs += __expf(gl[o] - gm);
        const float pg = 1.f / gs;
        float b1 = -3.0e38f, b2 = -3.0e38f; int i1 = 0, i2 = 0;
        for (int q = 0; q < 8; ++q) { const float v = (l0[4 + gi * 8 + q] + l1[4 + gi * 8 + q]) * rstd + p.reb[gi * 8 + q];
            if (v > b1) { b2 = b1; i2 = i1; b1 = v; i1 = q; } else if (v > b2) { b2 = v; i2 = q; } }
        const float wa = 1.f / (1.f + __expf(b2 - b1));
        e0 = gi * 8 + i1; e1 = gi * 8 + i2; g0 = pg * wa; g1 = pg * (1.f - wa);
        r0 = atomicAdd(&lcnt[e0], 1); r1 = atomicAdd(&lcnt[e1], 1);
    }
    __syncthreads();
    if (tid < 32) lbase[tid] = atomicAdd(cnt + tid, lcnt[tid]);
    __syncthreads();
    if (tid < 64) { const int i0 = lbase[e0] + r0, i1 = lbase[e1] + r1;
        rinfo[e0 * LCAP + i0] = 2 * t; rw[e0 * LCAP + i0] = g0; rinfo[e1 * LCAP + i1] = 2 * t + 1; rw[e1 * LCAP + i1] = g1; }
    __syncthreads();
}
__device__ __forceinline__ void phase4(const Params& p, unsigned char* lds, size_t so = 0) { for (int it = blockIdx.x; it < T_ / 64; it += gridDim.x) route_item(p, lds, it, so); }

__device__ __forceinline__ void phase5(const Params& p, unsigned char* lds) {
    const int* cnt = (const int*)(p.ws + OFF_CNT); const int* rinfo = (const int*)(p.ws + OFF_RINFO);
    const ASrcGather AS{(const bf16_t*)(p.ws + OFF_HB), rinfo, cnt};
    const Epi5 E{(bf16_t*)(p.ws + OFF_B), (const float*)(p.ws + OFF_SSQ) + 2 * T_, rinfo, cnt};
    const bf16_t* Bt = (const bf16_t*)(p.ws + OFF_WGU);
    if (FAST_MASK & 32) { PG8_LAS int* lc = (PG8_LAS int*)((PG8_LAS unsigned char*)lds + LCNT_OFF);
        if (threadIdx.x < NE) lc[threadIdx.x] = __hip_atomic_load(cnt + threadIdx.x, __ATOMIC_RELAXED, __HIP_MEMORY_SCOPE_AGENT);
        __syncthreads();
        const pg8::MoeOrder S{lc, 4, (int)gridDim.x, (int)blockIdx.x}; const pg8::AOffGather AO{rinfo, lc};
        pg8::gemm_phase<Epi5, pg8::MoeOrder, pg8::AOffGather, true>((PG8_LAS unsigned char*)lds, AS.A, Bt, D_, S, AO, E); return; }
    for (int L = blockIdx.x;; L += gridDim.x) { Unit u; if (!moe_unit(cnt, 4, L, u)) break; gemm_simple_unit(lds, AS, Bt + (size_t)u.pn * 256 * D_, D_, E, u); }
}
__device__ __forceinline__ void phase6(const Params& p, unsigned char* lds) {
    const int* cnt = (const int*)(p.ws + OFF_CNT); const int* rinfo = (const int*)(p.ws + OFF_RINFO);
    const ASrcDirect AS{(const bf16_t*)(p.ws + OFF_B), DE};
    const Epi6 E{(bf16_t*)(p.ws + OFF_A), rinfo, (const float*)(p.ws + OFF_RW), cnt};
    const bf16_t* Bt = (const bf16_t*)(p.ws + OFF_WD);
    if (FAST_MASK & 64) { PG8_LAS int* lc = (PG8_LAS int*)((PG8_LAS unsigned char*)lds + LCNT_OFF);
        if (threadIdx.x < NE) lc[threadIdx.x] = __hip_atomic_load(cnt + threadIdx.x, __ATOMIC_RELAXED, __HIP_MEMORY_SCOPE_AGENT);
        __syncthreads();
        const pg8::MoeOrder S{lc, 8, (int)gridDim.x, (int)blockIdx.x}; const pg8::AOffDirect AO{DE};
        pg8::gemm_phase<Epi6, pg8::MoeOrder, pg8::AOffDirect, true>((PG8_LAS unsigned char*)lds, AS.A, Bt, DE, S, AO, E); return; }
    for (int L = blockIdx.x;; L += gridDim.x) { Unit u; if (!moe_unit(cnt, 8, L, u)) break; gemm_simple_unit(lds, AS, Bt + (size_t)u.pn * 256 * DE, DE, E, u); }
}
__device__ __forceinline__ void phase7(const Params& p) {
    const int tid = opaque_tid(), wid = tid >> 6, lane = tid & 63;
    const bf16_t* hb = (const bf16_t*)(p.ws + OFF_HB); const bf16_t* ys2 = (const bf16_t*)(p.ws + OFF_A);
    for (int t = blockIdx.x * 8 + wid; t < T_; t += gridDim.x * 8) {
        float v[4][8]; float s = 0.f;
#pragma unroll
        for (int i = 0; i < 4; ++i) { const int c = i * 512 + lane * 8;
            const u32x4 a = *(const u32x4*)(hb + (size_t)t * D_ + c), b = *(const u32x4*)(ys2 + (size_t)(2 * t) * D_ + c), d = *(const u32x4*)(ys2 + (size_t)(2 * t + 1) * D_ + c);
#pragma unroll
            for (int q = 0; q < 4; ++q) { v[i][2 * q] = bflo(a[q]) + bflo(b[q]) + bflo(d[q]); v[i][2 * q + 1] = bfhi(a[q]) + bfhi(b[q]) + bfhi(d[q]); s += v[i][2 * q] * v[i][2 * q] + v[i][2 * q + 1] * v[i][2 * q + 1]; } }
        const float rstd = rsqrtf(wave_sum(s) * (1.f / D_) + EPS);
#pragma unroll
        for (int i = 0; i < 4; ++i) { const int c = i * 512 + lane * 8;
            const f32x4 g0 = *(const f32x4*)(p.g_final + c), g1 = *(const f32x4*)(p.g_final + c + 4);
            f32x4 o0, o1;
#pragma unroll
            for (int q = 0; q < 4; ++q) { o0[q] = v[i][q] * rstd * g0[q]; o1[q] = v[i][4 + q] * rstd * g1[q]; }
            *(f32x4*)(p.out + (size_t)t * D_ + c) = o0; *(f32x4*)(p.out + (size_t)t * D_ + c + 4) = o1; }
    }
}

#ifndef ONE_LAUNCH
#define ONE_LAUNCH 1
#endif
template <int PH> __global__ void __launch_bounds__(NTHR, 2) k_phase(Params p) {
    extern __shared__ __attribute__((aligned(16))) unsigned char lds[];
    if (PH == 0) phase0(p, lds);
    if (PH == 1) phase1(p, lds);
    if (PH == 2) phase2(p, lds);
    if (PH == 3) phase3(p, lds);
    if (PH == 4) phase4(p, lds);
    if (PH == 5) phase5(p, lds);
    if (PH == 6) phase6(p, lds);
    if (PH == 7) phase7(p);
}
__global__ void __launch_bounds__(NTHR, 2) k_mega(Params p) {
    extern __shared__ __attribute__((aligned(16))) unsigned char lds[];
    cg::grid_group grid = cg::this_grid();
    volatile PG8_LAS unsigned* bst = (volatile PG8_LAS unsigned*)((PG8_LAS unsigned char*)lds + LBAR_OFF);
    if (threadIdx.x < 2) bst[threadIdx.x] = 0u;
    __syncthreads();
    const XcdBarrier bar = xcd_barrier_post((unsigned*)(p.ws + OFF_BAR), bst);
    if (DUP_PHASE == 0) { phase0(p, lds); xcd_barrier(bar); }
    phase0(p, lds); grid.sync();
    if (DUP_PHASE == 1) { phase1(p, lds); xcd_barrier(bar); }
    phase1(p, lds); xcd_barrier(bar);
    if (DUP_PHASE == 2) { phase2(p, lds, OFF_DUMMY - OFF_SSQ); xcd_barrier(bar); }
    phase2(p, lds); xcd_barrier(bar);
    if (DUP_PHASE == 3) { phase3(p, lds, OFF_DUMMY - OFF_SSQ); xcd_barrier(bar); }
    phase3(p, lds); xcd_barrier(bar);
    if (DUP_PHASE == 4) { phase4(p, lds, OFF_DUMMY - OFF_SSQ); xcd_barrier(bar); }
    phase4(p, lds); xcd_barrier(bar);
    if (DUP_PHASE == 5) { phase5(p, lds); xcd_barrier(bar); }
    phase5(p, lds); xcd_barrier(bar);
    if (DUP_PHASE == 6) { phase6(p, lds); xcd_barrier(bar); }
    phase6(p, lds); xcd_barrier(bar);
    if (DUP_PHASE == 7) { phase7(p); xcd_barrier(bar); }
    phase7(p);
}

extern "C" void kernel_launch(void* const* d_in, const int* in_sizes, int n_in, void* d_out, int out_size, void* d_ws, size_t ws_size, hipStream_t stream) {
    static int grid = 0;
    if (grid == 0) {
        if (n_in != 19 || in_sizes[0] != T_ * D_ || out_size != T_ * D_ || ws_size < WS_END + (DUP_PHASE >= 2 && DUP_PHASE <= 4 ? DUMMY_BYTES : 0)) { fprintf(stderr, "kernel_launch: unexpected shapes (n_in %d, in0 %d, out %d, ws %zu < %zu); nothing launched\n", n_in, n_in > 0 ? in_sizes[0] : -1, out_size, ws_size, (size_t)WS_END); grid = -1; return; }
        int dev = 0, cus = 0, per_cu = 0;
        if (hipGetDevice(&dev) != hipSuccess || hipDeviceGetAttribute(&cus, hipDeviceAttributeMultiprocessorCount, dev) != hipSuccess) { grid = -1; return; }
#if ONE_LAUNCH
        if (hipFuncSetAttribute((const void*)k_mega, hipFuncAttributeMaxDynamicSharedMemorySize, LDS_BYTES) != hipSuccess) { fprintf(stderr, "kernel_launch: hipFuncSetAttribute failed\n"); grid = -1; return; }
        if (hipOccupancyMaxActiveBlocksPerMultiprocessor(&per_cu, (const void*)k_mega, NTHR, LDS_BYTES) != hipSuccess || per_cu < 1) { fprintf(stderr, "kernel_launch: occupancy query says %d blocks per CU\n", per_cu); grid = -1; return; }
        grid = cus * per_cu;
#else
        (void)hipFuncSetAttribute((const void*)k_phase<0>, hipFuncAttributeMaxDynamicSharedMemorySize, LDS_BYTES);
        (void)hipFuncSetAttribute((const void*)k_phase<1>, hipFuncAttributeMaxDynamicSharedMemorySize, LDS_BYTES);
        (void)hipFuncSetAttribute((const void*)k_phase<2>, hipFuncAttributeMaxDynamicSharedMemorySize, LDS_BYTES);
        (void)hipFuncSetAttribute((const void*)k_phase<3>, hipFuncAttributeMaxDynamicSharedMemorySize, LDS_BYTES);
        (void)hipFuncSetAttribute((const void*)k_phase<4>, hipFuncAttributeMaxDynamicSharedMemorySize, LDS_BYTES);
        (void)hipFuncSetAttribute((const void*)k_phase<5>, hipFuncAttributeMaxDynamicSharedMemorySize, LDS_BYTES);
        (void)hipFuncSetAttribute((const void*)k_phase<6>, hipFuncAttributeMaxDynamicSharedMemorySize, LDS_BYTES);
        (void)hipFuncSetAttribute((const void*)k_phase<7>, hipFuncAttributeMaxDynamicSharedMemorySize, LDS_BYTES);
        grid = cus > 0 ? cus : 256;
#endif
    }
    if (grid < 0) return;
    Params p{};
    const float** f = (const float**)&p;
    for (int i = 0; i < 19; ++i) f[i] = (const float*)d_in[i];
    p.out = (float*)d_out; p.ws = (unsigned char*)d_ws;
#if ONE_LAUNCH
    if (hipMemsetAsync((unsigned char*)d_ws + OFF_BAR, 0, BAR_BYTES, stream) != hipSuccess) { fprintf(stderr, "kernel_launch: memset of the barrier words failed\n"); return; }
    void* args[] = {&p};
    const hipError_t e = hipLaunchCooperativeKernel((const void*)k_mega, dim3(grid), dim3(NTHR), args, LDS_BYTES, stream);
    if (e != hipSuccess) fprintf(stderr, "kernel_launch: cooperative launch failed: %s (grid %d)\n", hipGetErrorString(e), grid);
#else
    hipLaunchKernelGGL(k_phase<0>, dim3(grid), dim3(NTHR), LDS_BYTES, stream, p);
    hipLaunchKernelGGL(k_phase<1>, dim3(grid), dim3(NTHR), LDS_BYTES, stream, p);
    hipLaunchKernelGGL(k_phase<2>, dim3(grid), dim3(NTHR), LDS_BYTES, stream, p);
    hipLaunchKernelGGL(k_phase<3>, dim3(grid), dim3(NTHR), LDS_BYTES, stream, p);
    hipLaunchKernelGGL(k_phase<4>, dim3(grid), dim3(NTHR), LDS_BYTES, stream, p);
    hipLaunchKernelGGL(k_phase<5>, dim3(grid), dim3(NTHR), LDS_BYTES, stream, p);
    hipLaunchKernelGGL(k_phase<6>, dim3(grid), dim3(NTHR), LDS_BYTES, stream, p);
    hipLaunchKernelGGL(k_phase<7>, dim3(grid), dim3(NTHR), LDS_BYTES, stream, p);
#endif
}
```

```cpp
#include <hip/hip_runtime.h>
#include <hip/hip_cooperative_groups.h>
#include <cstdio>
namespace cg = cooperative_groups;

typedef unsigned short bf16_t;
typedef float f32x4 __attribute__((ext_vector_type(4)));
typedef unsigned u32x4 __attribute__((ext_vector_type(4)));
typedef unsigned u32x2 __attribute__((ext_vector_type(2)));
typedef short bf16x8 __attribute__((ext_vector_type(8)));
typedef int v4i __attribute__((ext_vector_type(4)));
typedef int v8i __attribute__((ext_vector_type(8)));

constexpr int T_ = 16384, D_ = 2048, DIN = 5120, NE = 32, DE = 512, SEQ = 4096, LCAP = 16384;
constexpr float EPS = 1e-6f;
#ifndef DUP_PHASE
#define DUP_PHASE -1
#endif
constexpr int NTHR = 512;
constexpr int LDS_BYTES = 147456;
constexpr int LCNT_OFF = 131072, LBAR_OFF = 131072 + 2048;

constexpr size_t SZ_A = (size_t)T_ * DIN * 2;
constexpr size_t SZ_B = (size_t)T_ * D_ * 2;
constexpr size_t OFF_A = 0;
constexpr size_t OFF_B = OFF_A + SZ_A;
constexpr size_t OFF_HB = OFF_B + SZ_B;
constexpr size_t OFF_H8 = OFF_A + (size_t)2 * T_ * D_ * 2;
constexpr float WGU_SCALE = 32.f, WD_SCALE = 16.f;
constexpr size_t OFF_WIN = OFF_HB + SZ_B;
constexpr size_t OFF_WOUT = OFF_WIN + (size_t)DIN * D_ * 2;
constexpr size_t OFF_WGU = OFF_WOUT + (size_t)D_ * D_ * 2;
constexpr size_t OFF_WD = OFF_WGU + (size_t)NE * 1024 * D_ * 2;
constexpr size_t OFF_WR = OFF_WD + (size_t)NE * D_ * DE * 2;
constexpr size_t OFF_SSQ = OFF_WR + (size_t)48 * D_ * 2;
constexpr size_t OFF_CNT = OFF_SSQ + (size_t)3 * T_ * 4;
constexpr size_t OFF_RINFO = OFF_CNT + 256;
constexpr size_t OFF_RW = OFF_RINFO + (size_t)NE * LCAP * 4;
constexpr size_t OFF_BAR = OFF_RW + (size_t)NE * LCAP * 4;
constexpr size_t BAR_BYTES = 16384;
constexpr size_t WS_END = OFF_BAR + BAR_BYTES;
constexpr size_t OFF_DUMMY = WS_END;
constexpr size_t DUMMY_BYTES = (OFF_BAR - OFF_SSQ);

struct Params {
    const float *x, *norm_mix_g, *w_in, *v_norm_g, *gmlp_ws, *gmlp_bs, *conv_w, *g_a, *g_b, *w_out, *g_ffn, *rgw, *rgb, *rew, *reb, *ewg, *ewu, *ewd, *g_final;
    float* out; unsigned char* ws;
};

__device__ __forceinline__ unsigned cvt_pk_bf16(float lo, float hi) { unsigned r; asm volatile("v_cvt_pk_bf16_f32 %0, %1, %2" : "=v"(r) : "v"(lo), "v"(hi)); return r; }
__device__ __forceinline__ unsigned char* opaque_ws(unsigned char* w) { asm volatile("" : "+s"(w)); return w; }
__device__ __forceinline__ int opaque_tid() { int t = threadIdx.x; asm volatile("" : "+v"(t)); return t; }
__device__ __forceinline__ unsigned pk4_fp8(float a, float b, float c, float d) { int w = 0; w = __builtin_amdgcn_cvt_pk_fp8_f32(a, b, w, false); w = __builtin_amdgcn_cvt_pk_fp8_f32(c, d, w, true); return (unsigned)w; }
__device__ __forceinline__ float bflo(unsigned w) { return __uint_as_float(w << 16); }
__device__ __forceinline__ float bfhi(unsigned w) { return __uint_as_float(w & 0xffff0000u); }
__device__ __forceinline__ float wave_sum(float v) {
#pragma unroll
    for (int o = 1; o < 64; o <<= 1) v += __shfl_xor(v, o);
    return v;
}
__device__ __forceinline__ float gelu_t(float x) {
    const float u = x * (0.7978845608f + 0.0356774081f * x * x);
    return x * __builtin_amdgcn_rcpf(1.f + __builtin_amdgcn_exp2f(-2.885390082f * u));
}
__device__ __forceinline__ float silu_f(float x) { return x * __builtin_amdgcn_rcpf(1.f + __builtin_amdgcn_exp2f(-1.442695041f * x)); }

#define PG8_LAS __attribute__((address_space(3)))
struct Unit { int pm, pn, e, r0, pnl; };

constexpr int MT_CNT = 0, MT_PST = 32, MT_NT = 65, MT_T2E = 66, MT_WORDS = 66 + 192;
typedef const PG8_LAS int* lcnt_t;
__device__ __forceinline__ bool moe_unit(lcnt_t tb, int NT, int L, Unit& u) {
    const int pt = L / NT;
    if (pt >= tb[MT_NT]) return false;
    const int e = tb[MT_T2E + pt], mt = pt - tb[MT_PST + e], j = L - pt * NT;
    u.e = e; u.pm = pt; u.r0 = mt * 256; u.pnl = j; u.pn = e * NT + j; return true;
}

struct Epi1 {
    static constexpr bool PERM = true, MIDSCALE = false;
    unsigned char* ws;
    __device__ __forceinline__ void operator()(f32x4 (&acc)[2][2][4][2], const Unit& u, int wr, int wc, int fr, int fq) const {
        bf16_t* P = (bf16_t*)(opaque_ws(ws) + OFF_A);
        const bool act = u.pn < 8;
#pragma unroll
        for (int ai = 0; ai < 2; ++ai)
#pragma unroll
            for (int m = 0; m < 4; ++m) {
                const int row = u.pm * 256 + ai * 128 + wr * 64 + m * 16 + fr;
                bf16_t* rowp = P + (size_t)row * DIN + u.pn * 256 + wc * 32 + 8 * fq;
#pragma unroll
                for (int bj = 0; bj < 2; ++bj) {
                    f32x4 v0 = acc[ai][bj][m][0], v1 = acc[ai][bj][m][1];
                    if (act) {
#pragma unroll
                        for (int j = 0; j < 4; ++j) { v0[j] = gelu_t(v0[j]); v1[j] = gelu_t(v1[j]); }
                    }
                    u32x4 w; w.x = cvt_pk_bf16(v0[0], v0[1]); w.y = cvt_pk_bf16(v0[2], v0[3]); w.z = cvt_pk_bf16(v1[0], v1[1]); w.w = cvt_pk_bf16(v1[2], v1[3]);
                    *(u32x4*)(rowp + bj * 128) = w;
                }
            }
    }
};
struct Epi2 {
    static constexpr bool PERM = true, MIDSCALE = true;
    const float* x; unsigned char* ws; size_t so;
    __device__ __forceinline__ void midscale(f32x4 (&acc)[2][2][4][2], const Unit& u, int wr, int wc, int fr, int fq) const {
        int rowb = u.pm * 256 + wr * 64 + fr; asm volatile("" : "+v"(rowb));
        const float* ssq_a = (const float*)(opaque_ws(ws) + OFF_SSQ);
        const float* pa = ssq_a + rowb; const float* pb = ssq_a + T_ + rowb;
#pragma unroll
        for (int ai = 0; ai < 2; ++ai)
#pragma unroll
            for (int m = 0; m < 4; ++m) {
                const float s = __builtin_amdgcn_sqrtf((pb[ai * 128 + m * 16] * (1.f / 1024.f) + EPS) * __builtin_amdgcn_rcpf(pa[ai * 128 + m * 16] * (1.f / 1024.f) + EPS));
#pragma unroll
                for (int bj = 0; bj < 2; ++bj)
#pragma unroll
                    for (int n = 0; n < 2; ++n) acc[ai][bj][m][n] *= s;
                if (m & 1) asm volatile("" ::: "memory");
            }
    }
    __device__ __forceinline__ void operator()(f32x4 (&acc)[2][2][4][2], const Unit& u, int wr, int wc, int fr, int fq) const {
        unsigned char* w_ = opaque_ws(ws);
        bf16_t* hb = (bf16_t*)(w_ + OFF_HB); unsigned char* h8 = w_ + OFF_H8; const float* ssq_b = (const float*)(w_ + OFF_SSQ) + T_; float* ssq_h = (float*)(w_ + OFF_SSQ + so) + 2 * T_;
#pragma unroll
        for (int ai = 0; ai < 2; ++ai)
#pragma unroll
            for (int m = 0; m < 4; ++m) {
                const int row = u.pm * 256 + ai * 128 + wr * 64 + m * 16 + fr;
                const float rb = rsqrtf(ssq_b[row] * (1.f / 1024.f) + EPS);
                const size_t off = (size_t)row * D_ + u.pn * 256 + wc * 32 + 8 * fq;
                float ss = 0.f;
#pragma unroll
                for (int bj = 0; bj < 2; ++bj) {
                    const f32x4 x0 = *(const f32x4*)(x + off + bj * 128), x1 = *(const f32x4*)(x + off + bj * 128 + 4);
                    const f32x4 h0 = x0 + acc[ai][bj][m][0] * rb, h1 = x1 + acc[ai][bj][m][1] * rb;
                    ss += (h0[0] * h0[0] + h0[1] * h0[1]) + (h0[2] * h0[2] + h0[3] * h0[3]) + (h1[0] * h1[0] + h1[1] * h1[1]) + (h1[2] * h1[2] + h1[3] * h1[3]);
                    u32x4 w; w.x = cvt_pk_bf16(h0[0], h0[1]); w.y = cvt_pk_bf16(h0[2], h0[3]); w.z = cvt_pk_bf16(h1[0], h1[1]); w.w = cvt_pk_bf16(h1[2], h1[3]);
                    *(u32x4*)(hb + off + bj * 128) = w;
                    u32x2 w8; w8.x = pk4_fp8(h0[0], h0[1], h0[2], h0[3]); w8.y = pk4_fp8(h1[0], h1[1], h1[2], h1[3]);
                    *(u32x2*)(h8 + off + bj * 128) = w8;
                }
                ss += __shfl_xor(ss, 16); ss += __shfl_xor(ss, 32);
                if (fq == 0) atomicAdd(ssq_h + row, ss);
                if (m == 3) asm volatile("" ::: "memory");
            }
    }
};
struct Epi5 {
    static constexpr bool PERM = true, MIDSCALE = false;
    unsigned char* ws; lcnt_t cnt;
    __device__ __forceinline__ void operator()(f32x4 (&acc)[2][2][4][2], const Unit& u, int wr, int wc, int fr, int fq) const {
        unsigned char* w_ = opaque_ws(ws);
        unsigned char* hbuf = w_ + OFF_B; const float* ssq_h = (const float*)(w_ + OFF_SSQ) + 2 * T_; const int* rinfo = (const int*)(w_ + OFF_RINFO);
        const int ce = cnt[u.e];
#pragma unroll
        for (int ai = 0; ai < 2; ++ai)
#pragma unroll
            for (int m = 0; m < 4; ++m) {
                const int r = ai * 128 + wr * 64 + m * 16 + fr, i = u.r0 + r;
                const int tok = (i < ce) ? (rinfo[u.e * LCAP + i] >> 1) : 0;
                const float rs = rsqrtf(ssq_h[tok] * (1.f / 2048.f) + EPS) * (1.f / WGU_SCALE);
                float o[8];
#pragma unroll
                for (int n = 0; n < 2; ++n)
#pragma unroll
                    for (int j = 0; j < 4; ++j) o[4 * n + j] = silu_f(acc[ai][0][m][n][j] * rs) * (acc[ai][1][m][n][j] * rs);
                u32x2 w; w.x = pk4_fp8(o[0], o[1], o[2], o[3]); w.y = pk4_fp8(o[4], o[5], o[6], o[7]);
                *(u32x2*)(hbuf + (size_t)(u.pm * 256 + r) * DE + u.pnl * 128 + wc * 32 + 8 * fq) = w;
            }
    }
};
struct Epi6 {
    static constexpr bool PERM = true, MIDSCALE = false;
    unsigned char* ws; lcnt_t cnt;
    __device__ __forceinline__ void operator()(f32x4 (&acc)[2][2][4][2], const Unit& u, int wr, int wc, int fr, int fq) const {
        unsigned char* w_ = opaque_ws(ws);
        bf16_t* ys2 = (bf16_t*)(w_ + OFF_A); const int* rinfo = (const int*)(w_ + OFF_RINFO); const float* rw = (const float*)(w_ + OFF_RW);
        const int ce = cnt[u.e];
#pragma unroll
        for (int ai = 0; ai < 2; ++ai)
#pragma unroll
            for (int m = 0; m < 4; ++m) {
                const int r = ai * 128 + wr * 64 + m * 16 + fr, i = u.r0 + r;
                if (i < ce) {
                    const int info = rinfo[u.e * LCAP + i]; const float g = rw[u.e * LCAP + i] * (1.f / WD_SCALE);
                    bf16_t* dst = ys2 + (size_t)info * D_ + u.pnl * 256 + wc * 32 + 8 * fq;
#pragma unroll
                    for (int bj = 0; bj < 2; ++bj) {
                        const f32x4 v0 = acc[ai][bj][m][0] * g, v1 = acc[ai][bj][m][1] * g;
                        u32x4 w; w.x = cvt_pk_bf16(v0[0], v0[1]); w.y = cvt_pk_bf16(v0[2], v0[3]); w.z = cvt_pk_bf16(v1[0], v1[1]); w.w = cvt_pk_bf16(v1[2], v1[3]);
                        *(u32x4*)(dst + bj * 128) = w;
                    }
                }
            }
    }
};

namespace pg8 {
constexpr int BM = 256, BK = 64, HALF = 128, HTB = HALF * BK * 2, STAGE_BYTES = 8 * HTB, NXCD = 8, WGM = 8;
__host__ __device__ __forceinline__ int lds_byte(int r, int c) { const int st = (r >> 4) * 2 + (c >> 5), rr = r & 15, cc = c & 31, ob = rr * 64 + cc * 2; return st * 1024 + (ob ^ (((ob >> 9) & 1) << 5)); }
__host__ __device__ __forceinline__ void stage_rc(int b, int& R, int& C) { const int st = b / 1024, sb = b % 1024, swz = sb ^ (((sb >> 9) & 1) << 5); R = (st >> 1) * 16 + swz / 64; C = (st & 1) * 32 + (swz % 64) / 2; }
__host__ __device__ __forceinline__ int perm32(int rho) { const int n = rho >> 4, i = rho & 15; return 8 * (i >> 2) + 4 * n + (i & 3); }

struct StaticOrder {
    int nM, nN, nwg, G, c;
    __device__ void init(int M, int N, int G_, int c_) { nM = M / BM; nN = N / BM; nwg = nM * nN; G = G_; c = c_; }
    __device__ bool next(int i, Unit& u) const {
        const long L = (long)i * G + c; if (L >= nwg) return false;
        int wgid = (int)L; { const int q = nwg / NXCD, r = nwg % NXCD, xcd = wgid % NXCD, off = wgid / NXCD; wgid = (xcd < r ? xcd * (q + 1) : r * (q + 1) + (xcd - r) * q) + off; }
        const int nig = WGM * nN, gid = wgid / nig, fm = gid * WGM, gsz = (nM - fm) < WGM ? (nM - fm) : WGM;
        u.pm = fm + ((wgid % nig) % gsz); u.pn = (wgid % nig) / gsz; u.e = 0; u.r0 = 0; u.pnl = u.pn; return true;
    }
};
struct MoeOrder {
    lcnt_t cnt; int NT, G, c;
    __device__ __forceinline__ bool next(int i, Unit& u) const { return moe_unit(cnt, NT, i * G + c, u); }
};
struct AOffDirect { int K; __device__ __forceinline__ unsigned operator()(const Unit& u, int h, int R, int C) const { return (unsigned)(((u.pm * 256 + h * 128 + R) * K + C) * 2); } };
struct AOffGather { unsigned char* ws; lcnt_t cnt; int K;
    __device__ __forceinline__ unsigned operator()(const Unit& u, int h, int R, int C) const { const int* rinfo = (const int*)(opaque_ws(ws) + OFF_RINFO); const int i = u.r0 + h * 128 + R; const int tok = (i < cnt[u.e]) ? (rinfo[u.e * LCAP + i] >> 1) : 0; return (unsigned)((tok * K + C) * 2); } };

template <class Epi, class Sched, class AOff, bool ALIGN_EPI, bool FP8 = false>
__device__ __forceinline__ void gemm_phase(PG8_LAS unsigned char* lds, const bf16_t* Ag, const bf16_t* Btg, const int K, const Sched& S, const AOff& AO, const Epi& E) {
    const int tid = opaque_tid(), wid = __builtin_amdgcn_readfirstlane(tid >> 6), lane = tid & 63, wr = wid >> 2, wc = wid & 3, fr = lane & 15, fq = lane >> 4;
    int nt = K / BK; asm volatile("" : "+s"(nt));
    unsigned voffB[2];
#pragma unroll
    for (int i = 0; i < 2; ++i) { int R, C; stage_rc(tid * 16 + i * 8192, R, C); const int Rb = Epi::PERM ? ((R & ~31) + perm32(R & 31)) : R; voffB[i] = (unsigned)(Rb * K + C) * 2u; }
#define PG8_AOFFS(u) do { int _t = tid; asm volatile("" : "+v"(_t)); _Pragma("unroll") for (int _i = 0; _i < 2; ++_i) { int _R, _C; stage_rc(_t * 16 + _i * 8192, _R, _C); vo0[_i] = AO(u, 0, _R, _C); vo1[_i] = AO(u, 1, _R, _C); } } while (0)
    const unsigned kstep = (unsigned)(BK * 2), hstep = (unsigned)HALF * (unsigned)K * 2u, tstep = 2u * hstep;
    const unsigned ldsw = (unsigned)wid * 1024u;
    const int aoff = lds_byte(wr * 64 + fr, fq * 8), boff = lds_byte(wc * 32 + fr, fq * 8);
    const char* const Ab = (const char*)Ag; const char* const Bb = (const char*)Btg;
#define PG8_SA(b, h) (((b) * 2 + (h)) * HTB)
#define PG8_SB(b, h) ((4 + (b) * 2 + (h)) * HTB)
#define PG8_STAGE(bufoff, gbase, uoff, voff) do { _Pragma("unroll") for (int _i = 0; _i < 2; ++_i) \
        __builtin_amdgcn_global_load_lds((const unsigned*)((gbase) + (size_t)(unsigned)((uoff) + (voff)[_i])), (PG8_LAS unsigned*)(lds + (bufoff) + ldsw + _i * 8192), 16, 0, 0); } while (0)
#define PG8_LD32(base) __builtin_shufflevector(*(const PG8_LAS v4i*)(base), *(const PG8_LAS v4i*)((base) + 1024), 0, 1, 2, 3, 4, 5, 6, 7)
#define PG8_LDA(dst, b, h) do { _Pragma("unroll") for (int m = 0; m < 4; ++m) dst[m] = PG8_LD32(lds + PG8_SA(b, h) + aoff + m * 2048); } while (0)
#define PG8_LDB(dst, b, h) do { _Pragma("unroll") for (int n = 0; n < 2; ++n) dst[n] = PG8_LD32(lds + PG8_SB(b, h) + boff + n * 2048); } while (0)
#define PG8_LO(x) __builtin_bit_cast(bf16x8, __builtin_shufflevector((x), (x), 0, 1, 2, 3))
#define PG8_HI(x) __builtin_bit_cast(bf16x8, __builtin_shufflevector((x), (x), 4, 5, 6, 7))
#define PG8_MMA(ai, bj, At, Bt) do { __builtin_amdgcn_s_setprio(1); _Pragma("unroll") for (int m = 0; m < 4; ++m) _Pragma("unroll") for (int n = 0; n < 2; ++n) { \
        if constexpr (FP8) acc[ai][bj][m][n] = __builtin_amdgcn_mfma_scale_f32_16x16x128_f8f6f4(Bt[n], At[m], acc[ai][bj][m][n], 0, 0, 0, 0, 0, 0);   \
        else { acc[ai][bj][m][n] = __builtin_amdgcn_mfma_f32_16x16x32_bf16(PG8_LO(Bt[n]), PG8_LO(At[m]), acc[ai][bj][m][n], 0, 0, 0); \
               acc[ai][bj][m][n] = __builtin_amdgcn_mfma_f32_16x16x32_bf16(PG8_HI(Bt[n]), PG8_HI(At[m]), acc[ai][bj][m][n], 0, 0, 0); } } \
        __builtin_amdgcn_s_setprio(0); } while (0)
#define PG8_WAIT_V(n) asm volatile("s_waitcnt vmcnt(" #n ")" ::: "memory")
#define PG8_WAIT_L(n) asm volatile("s_waitcnt lgkmcnt(" #n ")" ::: "memory")
#define PG8_BAR __builtin_amdgcn_s_barrier()
#define PG8_SCHED __builtin_amdgcn_sched_barrier(0)
    Unit cur, nxt; int ui = 0;
    if (!S.next(0, cur)) return;
    f32x4 acc[2][2][4][2];
#pragma unroll
    for (int a = 0; a < 2; ++a)
#pragma unroll
        for (int b = 0; b < 2; ++b)
#pragma unroll
            for (int m = 0; m < 4; ++m)
#pragma unroll
                for (int n = 0; n < 2; ++n) acc[a][b][m][n] = (f32x4){0.f, 0.f, 0.f, 0.f};
    v8i At[4], B0[2], B1[2];
    unsigned vo0[2], vo1[2];
    PG8_AOFFS(cur);
    unsigned cB = (unsigned)cur.pn * tstep;
    PG8_STAGE(PG8_SB(0, 0), Bb, cB, voffB); PG8_STAGE(PG8_SB(0, 1), Bb, cB + hstep, voffB); PG8_STAGE(PG8_SA(0, 0), Ab, 0u, vo0); PG8_STAGE(PG8_SA(0, 1), Ab, 0u, vo1);
    if (wr == 1) PG8_BAR;
    PG8_WAIT_V(2); PG8_BAR;
    PG8_STAGE(PG8_SB(1, 0), Bb, cB + kstep, voffB); PG8_STAGE(PG8_SA(1, 0), Ab, kstep, vo0); PG8_STAGE(PG8_SB(1, 1), Bb, cB + hstep + kstep, voffB);
    PG8_WAIT_V(6); PG8_BAR;
    for (;;) {
        const bool has_next = S.next(ui + 1, nxt);
        const unsigned nB = has_next ? (unsigned)nxt.pn * tstep : cB;
#pragma clang loop unroll(disable)
        for (int t = 0; t < nt; t += 2) {
            const bool last = (t == nt - 2);
            if constexpr (Epi::MIDSCALE) { if (t == nt / 2) { int _t = tid; asm volatile("" : "+v"(_t)); const int _l = _t & 63; E.midscale(acc, cur, wr, wc, _l & 15, _l >> 4); } }
            const unsigned k1 = (unsigned)(t + 1) * kstep, k2 = last ? 0u : (unsigned)(t + 2) * kstep, k3 = k2 + kstep;
            const unsigned b2 = last ? nB : cB + (unsigned)(t + 2) * kstep, b3 = b2 + kstep;
            PG8_LDB(B0, 0, 0); PG8_LDB(B1, 0, 1); PG8_SCHED; PG8_LDA(At, 0, 0); PG8_STAGE(PG8_SA(1, 1), Ab, k1, vo1);
            PG8_WAIT_V(8); PG8_WAIT_L(0); PG8_BAR; PG8_MMA(0, 0, At, B0); PG8_MMA(0, 1, At, B1); PG8_BAR; PG8_SCHED;
            if (last && has_next) { PG8_AOFFS(nxt); }
            PG8_LDA(At, 0, 1); PG8_STAGE(PG8_SB(0, 0), Bb, b2, voffB); PG8_STAGE(PG8_SB(0, 1), Bb, b2 + hstep, voffB); PG8_STAGE(PG8_SA(0, 0), Ab, k2, vo0);
            PG8_WAIT_V(8); PG8_WAIT_L(0); PG8_BAR; PG8_MMA(1, 0, At, B0); PG8_MMA(1, 1, At, B1); PG8_BAR; PG8_SCHED;
            PG8_LDB(B0, 1, 0); PG8_LDB(B1, 1, 1); PG8_SCHED; PG8_LDA(At, 1, 0); PG8_STAGE(PG8_SA(0, 1), Ab, k2, vo1);
            PG8_WAIT_V(8); PG8_WAIT_L(0); PG8_BAR; PG8_MMA(0, 0, At, B0); PG8_MMA(0, 1, At, B1); PG8_BAR; PG8_SCHED;
            PG8_LDA(At, 1, 1); PG8_STAGE(PG8_SB(1, 0), Bb, b3, voffB); PG8_STAGE(PG8_SB(1, 1), Bb, b3 + hstep, voffB); PG8_STAGE(PG8_SA(1, 0), Ab, k3, vo0);
            PG8_WAIT_V(8); PG8_WAIT_L(0); PG8_BAR; PG8_MMA(1, 0, At, B0); PG8_MMA(1, 1, At, B1); PG8_BAR; PG8_SCHED;
        }
        if constexpr (ALIGN_EPI) { if (wr == 0) PG8_BAR; }
        { int _t = tid; asm volatile("" : "+v"(_t)); const int _l = _t & 63; E(acc, cur, wr, wc, _l & 15, _l >> 4); }
        if (!has_next) break;
#pragma unroll
        for (int a = 0; a < 2; ++a)
#pragma unroll
            for (int b = 0; b < 2; ++b)
#pragma unroll
                for (int m = 0; m < 4; ++m)
#pragma unroll
                    for (int n = 0; n < 2; ++n) acc[a][b][m][n] = (f32x4){0.f, 0.f, 0.f, 0.f};
        cur = nxt; cB = nB; ++ui;
        if constexpr (ALIGN_EPI) { if (wr == 1) PG8_BAR; }
    }
    PG8_WAIT_V(0);
    if constexpr (!ALIGN_EPI) { if (wr == 0) PG8_BAR; }
    PG8_BAR;
#undef PG8_AOFFS
#undef PG8_SA
#undef PG8_SB
#undef PG8_STAGE
#undef PG8_LDA
#undef PG8_LDB
#undef PG8_MMA
#undef PG8_LO
#undef PG8_HI
#undef PG8_LD32
#undef PG8_WAIT_V
#undef PG8_WAIT_L
#undef PG8_BAR
#undef PG8_SCHED
}
}


#define XB_TMO      128
#define XB_XCNT(j)  (256  + 64 * (j))
#define XB_XSUB(j)  (1280 + 64 * (j))
#define XB_XGEN(j)  (2304 + 64 * (j))
#define XB_TOP      3328
#define XB_TOPGEN   3392
#define XCD_BAR_WORDS 3456
#define XB_SPIN_CAP (1u << 18)
__device__ __forceinline__ unsigned xb_ld(unsigned* p)              { return __hip_atomic_load(p, __ATOMIC_RELAXED, __HIP_MEMORY_SCOPE_AGENT); }
__device__ __forceinline__ unsigned xb_add(unsigned* p, unsigned v) { return __hip_atomic_fetch_add(p, v, __ATOMIC_RELAXED, __HIP_MEMORY_SCOPE_AGENT); }
__device__ __forceinline__ unsigned xb_xcc_id() { return (unsigned)__builtin_amdgcn_s_getreg((3 << 11) | 20) & 0xFu; }
#define XB_SPIN(cond, bar) do { unsigned _sp = 0; while (cond) { __builtin_amdgcn_s_sleep(1); \
    if ((++_sp & 255u) == 0u) { if (xb_ld(&(bar)[XB_TMO])) break; if (_sp > XB_SPIN_CAP) { atomicAdd(&(bar)[XB_TMO], 1u); break; } } } } while (0)
struct XcdBarrier { unsigned* bar; unsigned x; volatile PG8_LAS unsigned* st; };
__device__ __forceinline__ XcdBarrier xcd_barrier_post(unsigned* bar, volatile PG8_LAS unsigned* st) {
    XcdBarrier b; b.bar = bar; b.x = xb_xcc_id(); b.st = st;
    if (threadIdx.x == 0) (void)xb_add(&bar[XB_XCNT(b.x)], 1u);
    return b;
}
__device__ __forceinline__ void xcd_barrier_complete(unsigned* bar, unsigned x, unsigned& nloc, unsigned& nx) {
    const unsigned G = gridDim.x * gridDim.y * gridDim.z;
    unsigned sum, cnt, mine, sp = 0u;
    for (;;) {
        sum = 0u; cnt = 0u; mine = 0u;
#pragma unroll
        for (unsigned j = 0; j < 16; ++j) { const unsigned c = xb_ld(&bar[XB_XCNT(j)]); sum += c; cnt += (c > 0u) ? 1u : 0u; mine = (j == x) ? c : mine; }
        if (sum == G) break;
        __builtin_amdgcn_s_sleep(1);
        if ((++sp & 255u) == 0u) { if (xb_ld(&bar[XB_TMO])) break; if (sp > XB_SPIN_CAP) { atomicAdd(&bar[XB_TMO], 1u); break; } }
    }
    nloc = mine > 0u ? mine : 1u; nx = cnt > 0u ? cnt : 1u;
}
__device__ __forceinline__ void xcd_barrier(const XcdBarrier& b) {
    asm volatile("s_waitcnt vmcnt(0)" ::: "memory");
    __syncthreads();
    if (threadIdx.x == 0) {
        unsigned* bar = b.bar;
        __builtin_amdgcn_s_waitcnt(0);
        unsigned nloc = b.st[0], nx = b.st[1];
        if (nloc == 0u) { xcd_barrier_complete(bar, b.x, nloc, nx); b.st[0] = nloc; b.st[1] = nx; }
        const unsigned old = xb_add(&bar[XB_XSUB(b.x)], 1u);
        const unsigned gen = old / nloc;
        if (old + 1u == (gen + 1u) * nloc) {
            __builtin_amdgcn_fence(__ATOMIC_RELEASE, "agent");
            asm volatile("s_waitcnt vmcnt(0)" ::: "memory");
            const unsigned og = xb_add(&bar[XB_TOP], 1u);
            const unsigned tg = og / nx;
            if (og + 1u == (tg + 1u) * nx) xb_add(&bar[XB_TOPGEN], 1u);
            else XB_SPIN(xb_ld(&bar[XB_TOPGEN]) == tg, bar);
            __builtin_amdgcn_fence(__ATOMIC_ACQUIRE, "agent");
            xb_add(&bar[XB_XGEN(b.x)], 1u);
            asm volatile("s_waitcnt vmcnt(0)" ::: "memory");
        } else {
            XB_SPIN(xb_ld(&bar[XB_XGEN(b.x)]) == gen, bar);
            __builtin_amdgcn_fence(__ATOMIC_ACQUIRE, "agent");
            asm volatile("s_waitcnt vmcnt(0)" ::: "memory");
        }
    }
    __syncthreads();
}

__device__ __forceinline__ void transpose_tile(float* lt, const float* src, int ldsrc, int r0, int c0, bf16_t* dst, int lddst, int dr0, const float* sA, const float* sB, int split) {
    const int tid = opaque_tid();
    { const int r = tid >> 3, cc = (tid & 7) * 8;
      const float* s = src + (size_t)(r0 + r) * ldsrc + c0 + cc;
      const f32x4 v0 = *(const f32x4*)s, v1 = *(const f32x4*)(s + 4);
      float sc = 1.f; if (sA) { const int rr = r0 + r; sc = rr < split ? sA[rr] : sB[rr - split]; }
#pragma unroll
      for (int q = 0; q < 4; ++q) { lt[r * 65 + cc + q] = v0[q] * sc; lt[r * 65 + cc + 4 + q] = v1[q] * sc; } }
    __syncthreads();
    { const int c = tid >> 3, rr = (tid & 7) * 8;
      float v[8];
#pragma unroll
      for (int q = 0; q < 8; ++q) v[q] = lt[(rr + q) * 65 + c];
      u32x4 w; w.x = cvt_pk_bf16(v[0], v[1]); w.y = cvt_pk_bf16(v[2], v[3]); w.z = cvt_pk_bf16(v[4], v[5]); w.w = cvt_pk_bf16(v[6], v[7]);
      *(u32x4*)(dst + (size_t)(dr0 + c) * lddst + r0 + rr) = w; }
    __syncthreads();
}
__device__ __forceinline__ void transpose_tile8(float* lt, const float* src, int ldsrc, int r0, int c0, unsigned char* dst, int lddst, int dr0, const float* sk, float sc) {
    const int tid = opaque_tid();
    { const int r = tid >> 2, cc = (tid & 3) * 16;
      const float* sp = src + (size_t)(r0 + r) * ldsrc + c0 + cc;
      const float f = sk ? sc * sk[r0 + r] : sc;
#pragma unroll
      for (int q = 0; q < 4; ++q) { const f32x4 v = *(const f32x4*)(sp + 4 * q);
#pragma unroll
          for (int j = 0; j < 4; ++j) lt[r * 65 + cc + 4 * q + j] = v[j] * f; } }
    __syncthreads();
    { const int c = tid >> 3, rr = (tid & 7) * 16;
      float v[16];
#pragma unroll
      for (int q = 0; q < 16; ++q) v[q] = lt[(rr + q) * 65 + c];
      u32x4 w; w.x = pk4_fp8(v[0], v[1], v[2], v[3]); w.y = pk4_fp8(v[4], v[5], v[6], v[7]); w.z = pk4_fp8(v[8], v[9], v[10], v[11]); w.w = pk4_fp8(v[12], v[13], v[14], v[15]);
      *(u32x4*)(dst + (size_t)(dr0 + c) * lddst + r0 + rr) = w; }
    __syncthreads();
}
__device__ __forceinline__ void phase0(const Params& p, unsigned char* lds) {
    const int tid = opaque_tid(), nb = gridDim.x, bid = blockIdx.x, wid = tid >> 6, lane = tid & 63;
    { float* z = (float*)(p.ws + OFF_SSQ);
      for (int i = bid * NTHR + tid; i < 3 * T_ + 64; i += nb * NTHR) z[i] = 0.f;
      if (DUP_PHASE >= 2 && DUP_PHASE <= 4) { float* zd = (float*)(p.ws + OFF_SSQ + (OFF_DUMMY - OFF_SSQ)); for (int i = bid * NTHR + tid; i < 3 * T_ + 64; i += nb * NTHR) zd[i] = 0.f; } }
    { bf16_t* wrt = (bf16_t*)(p.ws + OFF_WR);
      for (int i = bid * NTHR + tid; i < 48 * D_; i += nb * NTHR) {
          const int o = i >> 11, k = i & 2047; float v = 0.f;
          if (o < 4) v = p.rgw[k * 4 + o]; else if (o < 36) v = p.rew[k * 32 + (o - 4)];
          wrt[i] = (bf16_t)(cvt_pk_bf16(v * p.g_ffn[k], 0.f) & 0xffffu); } }
    { bf16_t* xn = (bf16_t*)(p.ws + OFF_B);
      for (int row = bid * 8 + wid; row < T_; row += nb * 8) {
          const float* xr = p.x + (size_t)row * D_;
          f32x4 v[8]; float s = 0.f;
#pragma unroll
          for (int i = 0; i < 8; ++i) { v[i] = *(const f32x4*)(xr + i * 256 + lane * 4); s += (v[i][0] * v[i][0] + v[i][1] * v[i][1]) + (v[i][2] * v[i][2] + v[i][3] * v[i][3]); }
          const float rstd = rsqrtf(wave_sum(s) * (1.f / D_) + EPS);
#pragma unroll
          for (int i = 0; i < 8; ++i) { const f32x4 g = *(const f32x4*)(p.norm_mix_g + i * 256 + lane * 4); const f32x4 o = v[i] * rstd * g;
              u32x2 w; w.x = cvt_pk_bf16(o[0], o[1]); w.y = cvt_pk_bf16(o[2], o[3]); *(u32x2*)(xn + (size_t)row * D_ + i * 256 + lane * 4) = w; } } }
    float* lt = (float*)lds;
    constexpr int N_IN = 32 * 80, N_OUT = 32 * 32, N_G = 32 * 128, N_TOT = N_IN + N_OUT + 3 * N_G;
    for (int tile = bid; tile < N_TOT; tile += nb) {
        int q = tile;
        if (q < N_IN) { const int tr = q / 80, tc = q % 80; transpose_tile(lt, p.w_in, DIN, tr * 64, tc * 64, (bf16_t*)(p.ws + OFF_WIN), D_, tc * 64, nullptr, nullptr, 0); continue; } q -= N_IN;
        if (q < N_OUT) { const int tr = q / 32, tc = q % 32; transpose_tile(lt, p.w_out, D_, tr * 64, tc * 64, (bf16_t*)(p.ws + OFF_WOUT), D_, tc * 64, p.g_a, p.g_b, 1024); continue; } q -= N_OUT;
        if (q < 2 * N_G) { const int up = q >= N_G; if (up) q -= N_G; const int e = q >> 7, rem = q & 127, tr = rem >> 3, tc = rem & 7; const int c0 = tc * 64;
            transpose_tile8(lt, (up ? p.ewu : p.ewg) + (size_t)e * D_ * DE, DE, tr * 128, c0, p.ws + OFF_WGU + (size_t)e * 1024 * D_, D_, (c0 >> 7) * 256 + (up ? 128 : 0) + (c0 & 127), p.g_ffn, WGU_SCALE); continue; } q -= 2 * N_G;
        { const int e = q >> 7, rem = q & 127, tr = rem >> 5, tc = rem & 31;
          transpose_tile8(lt, p.ewd + (size_t)e * DE * D_, D_, tr * 128, tc * 64, p.ws + OFF_WD + (size_t)e * D_ * DE, DE, tc * 64, nullptr, WD_SCALE); }
    }
}

__device__ __forceinline__ void phase1(const Params& p, unsigned char* lds) {
    const Epi1 E{p.ws};
    pg8::StaticOrder S; S.init(T_, DIN, gridDim.x, blockIdx.x); const pg8::AOffDirect AO{D_};
    pg8::gemm_phase<Epi1, pg8::StaticOrder, pg8::AOffDirect, true>((PG8_LAS unsigned char*)lds, (const bf16_t*)(p.ws + OFF_B), (const bf16_t*)(p.ws + OFF_WIN), D_, S, AO, E);
}

__device__ __forceinline__ void mixer_gmlp_item(const Params& p, unsigned char* lds, int item, size_t so) {
    const int tid = opaque_tid(), wid = tid >> 6, lane = tid & 63, fr = lane & 15, fq = lane >> 4;
    const int h = item & 7, t0 = (item >> 3) * 128;
    const bf16_t* P = (const bf16_t*)(p.ws + OFF_A); bf16_t* Y = (bf16_t*)(p.ws + OFF_B); float* ssq_a = (float*)(p.ws + OFF_SSQ + so);
    bf16_t* Vt = (bf16_t*)lds;
    bf16_t* Wl = Vt + 128 * 136;
    float* rs = (float*)(Wl + 128 * 136);
    { const int j = tid >> 2, dc = (tid & 3) * 32;
      const u32x4* src = (const u32x4*)(P + (size_t)(t0 + j) * DIN + 1024 + h * 128 + dc);
      u32x4 v[4]; float s = 0.f;
#pragma unroll
      for (int q = 0; q < 4; ++q) { v[q] = src[q];
#pragma unroll
          for (int w = 0; w < 4; ++w) { const float lo = bflo(v[q][w]), hi = bfhi(v[q][w]); s += lo * lo + hi * hi; } }
      s += __shfl_xor(s, 1); s += __shfl_xor(s, 2);
      if ((tid & 3) == 0) rs[j] = rsqrtf(s * (1.f / 128.f) + EPS);
#pragma unroll
      for (int q = 0; q < 4; ++q)
#pragma unroll
          for (int w = 0; w < 4; ++w) { const int d = dc + q * 8 + w * 2; Vt[d * 136 + j] = (bf16_t)(v[q][w] & 0xffffu); Vt[(d + 1) * 136 + j] = (bf16_t)(v[q][w] >> 16); } }
    __syncthreads();
    { const int i = tid >> 2, jc = (tid & 3) * 32;
      const f32x4* src = (const f32x4*)(p.gmlp_ws + (size_t)h * 16384 + i * 128 + jc);
      const bool live = (i >> 6) >= (jc >> 6);
#pragma unroll
      for (int q = 0; q < 4; ++q) { f32x4 w0 = src[2 * q], w1 = src[2 * q + 1];
          const f32x4 r0 = *(const f32x4*)(rs + jc + 8 * q), r1 = *(const f32x4*)(rs + jc + 8 * q + 4);
          w0 = live ? w0 * r0 : (f32x4){0.f, 0.f, 0.f, 0.f}; w1 = live ? w1 * r1 : (f32x4){0.f, 0.f, 0.f, 0.f};
          u32x4 o; o.x = cvt_pk_bf16(w0[0], w0[1]); o.y = cvt_pk_bf16(w0[2], w0[3]); o.z = cvt_pk_bf16(w1[0], w1[1]); o.w = cvt_pk_bf16(w1[2], w1[3]);
          *(u32x4*)(Wl + i * 136 + jc + 8 * q) = o; } }
    __syncthreads();
    f32x4 acc[8];
#pragma unroll
    for (int n = 0; n < 8; ++n) acc[n] = (f32x4){0.f, 0.f, 0.f, 0.f};
    const int ksteps = (wid < 4) ? 2 : 4;
    for (int ks = 0; ks < ksteps; ++ks) {
        const bf16x8 bw = *(const bf16x8*)(Wl + (16 * wid + fr) * 136 + ks * 32 + fq * 8);
#pragma unroll
        for (int n = 0; n < 8; ++n) { const bf16x8 av = *(const bf16x8*)(Vt + (16 * n + fr) * 136 + ks * 32 + fq * 8);
            acc[n] = __builtin_amdgcn_mfma_f32_16x16x32_bf16(av, bw, acc[n], 0, 0, 0); }
    }
    { const int i = 16 * wid + fr, t = t0 + i; const float bias = p.gmlp_bs[h * 128 + i]; float ss = 0.f;
#pragma unroll
      for (int n = 0; n < 8; ++n) { const int c = h * 128 + 16 * n + 4 * fq;
          const f32x4 g = *(const f32x4*)(p.v_norm_g + c); const u32x2 uu = *(const u32x2*)(P + (size_t)t * DIN + c);
          const float y0 = bflo(uu.x) * (acc[n][0] * g[0] + bias), y1 = bfhi(uu.x) * (acc[n][1] * g[1] + bias), y2 = bflo(uu.y) * (acc[n][2] * g[2] + bias), y3 = bfhi(uu.y) * (acc[n][3] * g[3] + bias);
          ss += (y0 * y0 + y1 * y1) + (y2 * y2 + y3 * y3);
          u32x2 w; w.x = cvt_pk_bf16(y0, y1); w.y = cvt_pk_bf16(y2, y3); *(u32x2*)(Y + (size_t)t * D_ + c) = w; }
      ss += __shfl_xor(ss, 16); ss += __shfl_xor(ss, 32);
      if (fq == 0) atomicAdd(ssq_a + t, ss); }
    __syncthreads();
}
__device__ __forceinline__ void mixer_conv_item(const Params& p, int item, size_t so) {
    const int tid = opaque_tid(), cl = tid & 31, ts = tid >> 5;
    const int c = (item & 3) * 256 + cl * 8, tbeg = (item >> 2) * 128 + ts * 8;
    const bf16_t* P = (const bf16_t*)(p.ws + OFF_A); bf16_t* Y = (bf16_t*)(p.ws + OFF_B); float* ssq_b = (float*)(p.ws + OFF_SSQ + so) + T_;
    float w0[8], w1[8], w2[8], z1[8], z2[8];
    { const f32x4 a0 = *(const f32x4*)(p.conv_w + c), a1 = *(const f32x4*)(p.conv_w + c + 4), b0 = *(const f32x4*)(p.conv_w + 1024 + c), b1 = *(const f32x4*)(p.conv_w + 1024 + c + 4),
                  c0 = *(const f32x4*)(p.conv_w + 2048 + c), c1 = *(const f32x4*)(p.conv_w + 2048 + c + 4);
#pragma unroll
      for (int q = 0; q < 4; ++q) { w0[q] = a0[q]; w0[4 + q] = a1[q]; w1[q] = b0[q]; w1[4 + q] = b1[q]; w2[q] = c0[q]; w2[4 + q] = c1[q]; } }
#pragma unroll
    for (int q = 0; q < 8; ++q) { z1[q] = 0.f; z2[q] = 0.f; }
    if ((tbeg % SEQ) != 0) {
        const u32x4 ca = *(const u32x4*)(P + (size_t)(tbeg - 1) * DIN + 3072 + c), ha = *(const u32x4*)(P + (size_t)(tbeg - 1) * DIN + 4096 + c);
        const u32x4 cb = *(const u32x4*)(P + (size_t)(tbeg - 2) * DIN + 3072 + c), hb2 = *(const u32x4*)(P + (size_t)(tbeg - 2) * DIN + 4096 + c);
#pragma unroll
        for (int q = 0; q < 4; ++q) { z1[2 * q] = bflo(ca[q]) * bflo(ha[q]); z1[2 * q + 1] = bfhi(ca[q]) * bfhi(ha[q]); z2[2 * q] = bflo(cb[q]) * bflo(hb2[q]); z2[2 * q + 1] = bfhi(cb[q]) * bfhi(hb2[q]); }
    }
    u32x4 bgA[8], cgA[8], hvA[8];
#pragma unroll
    for (int tt = 0; tt < 8; ++tt) { const bf16_t* pr = P + (size_t)(tbeg + tt) * DIN + c; bgA[tt] = *(const u32x4*)(pr + 2048); cgA[tt] = *(const u32x4*)(pr + 3072); hvA[tt] = *(const u32x4*)(pr + 4096); }
#pragma unroll
    for (int tt = 0; tt < 8; ++tt) {
        const int t = tbeg + tt;
        const u32x4 bg = bgA[tt], cgv = cgA[tt], hv = hvA[tt];
        float z[8], y[8], ss = 0.f;
#pragma unroll
        for (int q = 0; q < 4; ++q) { z[2 * q] = bflo(cgv[q]) * bflo(hv[q]); z[2 * q + 1] = bfhi(cgv[q]) * bfhi(hv[q]); }
#pragma unroll
        for (int q = 0; q < 4; ++q) {
            y[2 * q] = bflo(bg[q]) * (w0[2 * q] * z2[2 * q] + w1[2 * q] * z1[2 * q] + w2[2 * q] * z[2 * q]);
            y[2 * q + 1] = bfhi(bg[q]) * (w0[2 * q + 1] * z2[2 * q + 1] + w1[2 * q + 1] * z1[2 * q + 1] + w2[2 * q + 1] * z[2 * q + 1]); }
#pragma unroll
        for (int q = 0; q < 8; ++q) { ss += y[q] * y[q]; z2[q] = z1[q]; z1[q] = z[q]; }
        u32x4 w; w.x = cvt_pk_bf16(y[0], y[1]); w.y = cvt_pk_bf16(y[2], y[3]); w.z = cvt_pk_bf16(y[4], y[5]); w.w = cvt_pk_bf16(y[6], y[7]);
        *(u32x4*)(Y + (size_t)t * D_ + 1024 + c) = w;
        ss += __shfl_xor(ss, 1); ss += __shfl_xor(ss, 2); ss += __shfl_xor(ss, 4); ss += __shfl_xor(ss, 8); ss += __shfl_xor(ss, 16);
        if (cl == 0) atomicAdd(ssq_b + t, ss);
    }
}
__device__ __forceinline__ void phase2(const Params& p, unsigned char* lds, size_t so = 0) {
    for (int it = blockIdx.x; it < 512 + 1024; it += gridDim.x) { if (it < 512) mixer_conv_item(p, it, so); else mixer_gmlp_item(p, lds, it - 512, so); }
}

__device__ __forceinline__ void phase3(const Params& p, unsigned char* lds, size_t so = 0) {
    const Epi2 E{p.x, p.ws, so};
    pg8::StaticOrder S; S.init(T_, D_, gridDim.x, blockIdx.x); const pg8::AOffDirect AO{D_};
    pg8::gemm_phase<Epi2, pg8::StaticOrder, pg8::AOffDirect, true>((PG8_LAS unsigned char*)lds, (const bf16_t*)(p.ws + OFF_B), (const bf16_t*)(p.ws + OFF_WOUT), D_, S, AO, E);
}

__device__ __forceinline__ void route_item(const Params& p, unsigned char* lds, int item, size_t so) {
    const int tid = opaque_tid(), wid = tid >> 6, lane = tid & 63, fr = lane & 15, fq = lane >> 4;
    float* lg = (float*)lds;
    int* lcnt = (int*)(lg + 2 * 64 * 48); int* lbase = lcnt + 32;
    const bf16_t* hb = (const bf16_t*)(p.ws + OFF_HB); const bf16_t* wrt = (const bf16_t*)(p.ws + OFF_WR);
    const float* ssq_h = (const float*)(p.ws + OFF_SSQ) + 2 * T_;
    int* cnt = (int*)(p.ws + OFF_CNT + so); int* rinfo = (int*)(p.ws + OFF_RINFO + so); float* rw = (float*)(p.ws + OFF_RW + so);
    const int tg = wid & 3, kh = wid >> 2, t0 = item * 64;
    if (tid < 32) lcnt[tid] = 0;
    f32x4 acc[3];
#pragma unroll
    for (int n = 0; n < 3; ++n) acc[n] = (f32x4){0.f, 0.f, 0.f, 0.f};
    const bf16_t* ap = hb + (size_t)(t0 + tg * 16 + fr) * D_ + kh * 1024 + fq * 8; const bf16_t* bp = wrt + (size_t)fr * D_ + kh * 1024 + fq * 8;
#pragma unroll 8
    for (int ks = 0; ks < 32; ++ks) { const bf16x8 a = *(const bf16x8*)(ap + ks * 32);
#pragma unroll
        for (int n = 0; n < 3; ++n) { const bf16x8 b = *(const bf16x8*)(bp + (size_t)n * 16 * D_ + ks * 32); acc[n] = __builtin_amdgcn_mfma_f32_16x16x32_bf16(a, b, acc[n], 0, 0, 0); } }
#pragma unroll
    for (int n = 0; n < 3; ++n)
#pragma unroll
        for (int j = 0; j < 4; ++j) lg[(kh * 64 + tg * 16 + 4 * fq + j) * 48 + 16 * n + fr] = acc[n][j];
    __syncthreads();
    int e0 = 0, e1 = 0, r0 = 0, r1 = 0; float g0 = 0.f, g1 = 0.f; const int t = t0 + tid;
    if (tid < 64) {
        const float* l0 = lg + tid * 48; const float* l1 = l0 + 64 * 48; const float rstd = rsqrtf(ssq_h[t] * (1.f / D_) + EPS);
        float gm = -3.0e38f; int gi = 0; float gl[4];
#pragma unroll
        for (int o = 0; o < 4; ++o) { gl[o] = (l0[o] + l1[o]) * rstd + p.rgb[o]; if (gl[o] > gm) { gm = gl[o]; gi = o; } }
        float gs = 0.f;
#pragma unroll
        for (int o = 0; o < 4; ++o) gs += __expf(gl[o] - gm);
        const float pg = 1.f / gs;
        float b1 = -3.0e38f, b2 = -3.0e38f; int i1 = 0, i2 = 0;
        for (int q = 0; q < 8; ++q) { const float v = (l0[4 + gi * 8 + q] + l1[4 + gi * 8 + q]) * rstd + p.reb[gi * 8 + q];
            if (v > b1) { b2 = b1; i2 = i1; b1 = v; i1 = q; } else if (v > b2) { b2 = v; i2 = q; } }
        const float wa = 1.f / (1.f + __expf(b2 - b1));
        e0 = gi * 8 + i1; e1 = gi * 8 + i2; g0 = pg * wa; g1 = pg * (1.f - wa);
        r0 = atomicAdd(&lcnt[e0], 1); r1 = atomicAdd(&lcnt[e1], 1);
    }
    __syncthreads();
    if (tid < 32) lbase[tid] = atomicAdd(cnt + tid, lcnt[tid]);
    __syncthreads();
    if (tid < 64) { const int i0 = lbase[e0] + r0, i1 = lbase[e1] + r1;
        rinfo[e0 * LCAP + i0] = 2 * t; rw[e0 * LCAP + i0] = g0; rinfo[e1 * LCAP + i1] = 2 * t + 1; rw[e1 * LCAP + i1] = g1; }
    __syncthreads();
}
__device__ __forceinline__ void phase4(const Params& p, unsigned char* lds, size_t so = 0) { for (int it = blockIdx.x; it < T_ / 64; it += gridDim.x) route_item(p, lds, it, so); }

__device__ __forceinline__ PG8_LAS int* moe_tables_to_lds(const Params& p, unsigned char* lds) {
    PG8_LAS int* tb = (PG8_LAS int*)((PG8_LAS unsigned char*)lds + LCNT_OFF); const int* cnt = (const int*)(p.ws + OFF_CNT);
    if (threadIdx.x < NE) tb[MT_CNT + threadIdx.x] = __hip_atomic_load(cnt + threadIdx.x, __ATOMIC_RELAXED, __HIP_MEMORY_SCOPE_AGENT);
    __syncthreads();
    if (threadIdx.x == 0) { int pt = 0;
        for (int e = 0; e < NE; ++e) { const int nt = (tb[MT_CNT + e] + 255) >> 8; tb[MT_PST + e] = pt; for (int i = 0; i < nt; ++i) tb[MT_T2E + pt + i] = e; pt += nt; }
        tb[MT_PST + NE] = pt; tb[MT_NT] = pt; }
    __syncthreads();
    return tb;
}
__device__ __forceinline__ void phase5(const Params& p, unsigned char* lds) {
    PG8_LAS int* lc = moe_tables_to_lds(p, lds);
    const Epi5 E{p.ws, lc};
    const pg8::MoeOrder S{lc, 4, (int)gridDim.x, (int)blockIdx.x}; const pg8::AOffGather AO{p.ws, lc, D_ / 2};
    pg8::gemm_phase<Epi5, pg8::MoeOrder, pg8::AOffGather, true, true>((PG8_LAS unsigned char*)lds, (const bf16_t*)(p.ws + OFF_H8), (const bf16_t*)(p.ws + OFF_WGU), D_ / 2, S, AO, E);
}
__device__ __forceinline__ void phase6(const Params& p, unsigned char* lds) {
    PG8_LAS int* lc = moe_tables_to_lds(p, lds);
    const Epi6 E{p.ws, lc};
    const pg8::MoeOrder S{lc, 8, (int)gridDim.x, (int)blockIdx.x}; const pg8::AOffDirect AO{DE / 2};
    pg8::gemm_phase<Epi6, pg8::MoeOrder, pg8::AOffDirect, true, true>((PG8_LAS unsigned char*)lds, (const bf16_t*)(p.ws + OFF_B), (const bf16_t*)(p.ws + OFF_WD), DE / 2, S, AO, E);
}
__device__ __forceinline__ void phase7(const Params& p) {
    const int tid = opaque_tid(), wid = tid >> 6, lane = tid & 63;
    const bf16_t* hb = (const bf16_t*)(p.ws + OFF_HB); const bf16_t* ys2 = (const bf16_t*)(p.ws + OFF_A);
    for (int t = blockIdx.x * 8 + wid; t < T_; t += gridDim.x * 8) {
        float v[4][8]; float s = 0.f;
#pragma unroll
        for (int i = 0; i < 4; ++i) { const int c = i * 512 + lane * 8;
            const u32x4 a = *(const u32x4*)(hb + (size_t)t * D_ + c), b = *(const u32x4*)(ys2 + (size_t)(2 * t) * D_ + c), d = *(const u32x4*)(ys2 + (size_t)(2 * t + 1) * D_ + c);
#pragma unroll
            for (int q = 0; q < 4; ++q) { v[i][2 * q] = bflo(a[q]) + bflo(b[q]) + bflo(d[q]); v[i][2 * q + 1] = bfhi(a[q]) + bfhi(b[q]) + bfhi(d[q]); s += v[i][2 * q] * v[i][2 * q] + v[i][2 * q + 1] * v[i][2 * q + 1]; } }
        const float rstd = rsqrtf(wave_sum(s) * (1.f / D_) + EPS);
#pragma unroll
        for (int i = 0; i < 4; ++i) { const int c = i * 512 + lane * 8;
            const f32x4 g0 = *(const f32x4*)(p.g_final + c), g1 = *(const f32x4*)(p.g_final + c + 4);
            f32x4 o0, o1;
#pragma unroll
            for (int q = 0; q < 4; ++q) { o0[q] = v[i][q] * rstd * g0[q]; o1[q] = v[i][4 + q] * rstd * g1[q]; }
            *(f32x4*)(p.out + (size_t)t * D_ + c) = o0; *(f32x4*)(p.out + (size_t)t * D_ + c + 4) = o1; }
    }
}

#ifndef ONE_LAUNCH
#define ONE_LAUNCH 1
#endif
template <int PH> __global__ void __launch_bounds__(NTHR, 2) k_phase(Params p) {
    extern __shared__ __attribute__((aligned(16))) unsigned char lds[];
    if (PH == 0) phase0(p, lds);
    if (PH == 1) phase1(p, lds);
    if (PH == 2) phase2(p, lds);
    if (PH == 3) phase3(p, lds);
    if (PH == 4) phase4(p, lds);
    if (PH == 5) phase5(p, lds);
    if (PH == 6) phase6(p, lds);
    if (PH == 7) phase7(p);
}
__global__ void __launch_bounds__(NTHR, 2) k_mega(Params p) {
    extern __shared__ __attribute__((aligned(16))) unsigned char lds[];
    cg::grid_group grid = cg::this_grid();
    volatile PG8_LAS unsigned* bst = (volatile PG8_LAS unsigned*)((PG8_LAS unsigned char*)lds + LBAR_OFF);
    if (threadIdx.x < 2) bst[threadIdx.x] = 0u;
    __syncthreads();
    (void)xcd_barrier_post((unsigned*)(p.ws + OFF_BAR), bst);
#define GRID_BAR() do { XcdBarrier b_; b_.bar = (unsigned*)(opaque_ws(p.ws) + OFF_BAR); b_.x = xb_xcc_id(); b_.st = bst; xcd_barrier(b_); } while (0)
    if (DUP_PHASE == 0) { phase0(p, lds); GRID_BAR(); }
    phase0(p, lds); grid.sync();
    if (DUP_PHASE == 1) { phase1(p, lds); GRID_BAR(); }
    phase1(p, lds); GRID_BAR();
    if (DUP_PHASE == 2) { phase2(p, lds, OFF_DUMMY - OFF_SSQ); GRID_BAR(); }
    phase2(p, lds); GRID_BAR();
    if (DUP_PHASE == 3) { phase3(p, lds, OFF_DUMMY - OFF_SSQ); GRID_BAR(); }
    phase3(p, lds); GRID_BAR();
    if (DUP_PHASE == 4) { phase4(p, lds, OFF_DUMMY - OFF_SSQ); GRID_BAR(); }
    phase4(p, lds); GRID_BAR();
    if (DUP_PHASE == 5) { phase5(p, lds); GRID_BAR(); }
    phase5(p, lds); GRID_BAR();
    if (DUP_PHASE == 6) { phase6(p, lds); GRID_BAR(); }
    phase6(p, lds); GRID_BAR();
    if (DUP_PHASE == 8) { for (int i = 0; i < 10; ++i) GRID_BAR(); }
    if (DUP_PHASE == 9) { grid.sync(); grid.sync(); }
    if (DUP_PHASE == 7) { phase7(p); GRID_BAR(); }
    phase7(p);
}

extern "C" void kernel_launch(void* const* d_in, const int* in_sizes, int n_in, void* d_out, int out_size, void* d_ws, size_t ws_size, hipStream_t stream) {
    static int grid = 0;
    if (grid == 0) {
        if (n_in != 19 || in_sizes[0] != T_ * D_ || out_size != T_ * D_ || ws_size < WS_END + (DUP_PHASE >= 2 && DUP_PHASE <= 4 ? DUMMY_BYTES : 0)) { fprintf(stderr, "kernel_launch: unexpected shapes (n_in %d, in0 %d, out %d, ws %zu < %zu); nothing launched\n", n_in, n_in > 0 ? in_sizes[0] : -1, out_size, ws_size, (size_t)WS_END); grid = -1; return; }
        int dev = 0, cus = 0, per_cu = 0;
        if (hipGetDevice(&dev) != hipSuccess || hipDeviceGetAttribute(&cus, hipDeviceAttributeMultiprocessorCount, dev) != hipSuccess) { grid = -1; return; }
#if ONE_LAUNCH
        if (hipFuncSetAttribute((const void*)k_mega, hipFuncAttributeMaxDynamicSharedMemorySize, LDS_BYTES) != hipSuccess) { fprintf(stderr, "kernel_launch: hipFuncSetAttribute failed\n"); grid = -1; return; }
        if (hipOccupancyMaxActiveBlocksPerMultiprocessor(&per_cu, (const void*)k_mega, NTHR, LDS_BYTES) != hipSuccess || per_cu < 1) { fprintf(stderr, "kernel_launch: occupancy query says %d blocks per CU\n", per_cu); grid = -1; return; }
        grid = cus * per_cu;
#else
        (void)hipFuncSetAttribute((const void*)k_phase<0>, hipFuncAttributeMaxDynamicSharedMemorySize, LDS_BYTES);
        (void)hipFuncSetAttribute((const void*)k_phase<1>, hipFuncAttributeMaxDynamicSharedMemorySize, LDS_BYTES);
        (void)hipFuncSetAttribute((const void*)k_phase<2>, hipFuncAttributeMaxDynamicSharedMemorySize, LDS_BYTES);
        (void)hipFuncSetAttribute((const void*)k_phase<3>, hipFuncAttributeMaxDynamicSharedMemorySize, LDS_BYTES);
        (void)hipFuncSetAttribute((const void*)k_phase<4>, hipFuncAttributeMaxDynamicSharedMemorySize, LDS_BYTES);
        (void)hipFuncSetAttribute((const void*)k_phase<5>, hipFuncAttributeMaxDynamicSharedMemorySize, LDS_BYTES);
        (void)hipFuncSetAttribute((const void*)k_phase<6>, hipFuncAttributeMaxDynamicSharedMemorySize, LDS_BYTES);
        (void)hipFuncSetAttribute((const void*)k_phase<7>, hipFuncAttributeMaxDynamicSharedMemorySize, LDS_BYTES);
        grid = cus > 0 ? cus : 256;
#endif
    }
    if (grid < 0) return;
    Params p{};
    const float** f = (const float**)&p;
    for (int i = 0; i < 19; ++i) f[i] = (const float*)d_in[i];
    p.out = (float*)d_out; p.ws = (unsigned char*)d_ws;
#if ONE_LAUNCH
    if (hipMemsetAsync((unsigned char*)d_ws + OFF_BAR, 0, BAR_BYTES, stream) != hipSuccess) { fprintf(stderr, "kernel_launch: memset of the barrier words failed\n"); return; }
    void* args[] = {&p};
    const hipError_t e = hipLaunchCooperativeKernel((const void*)k_mega, dim3(grid), dim3(NTHR), args, LDS_BYTES, stream);
    if (e != hipSuccess) fprintf(stderr, "kernel_launch: cooperative launch failed: %s (grid %d)\n", hipGetErrorString(e), grid);
#else
    hipLaunchKernelGGL(k_phase<0>, dim3(grid), dim3(NTHR), LDS_BYTES, stream, p);
    hipLaunchKernelGGL(k_phase<1>, dim3(grid), dim3(NTHR), LDS_BYTES, stream, p);
    hipLaunchKernelGGL(k_phase<2>, dim3(grid), dim3(NTHR), LDS_BYTES, stream, p);
    hipLaunchKernelGGL(k_phase<3>, dim3(grid), dim3(NTHR), LDS_BYTES, stream, p);
    hipLaunchKernelGGL(k_phase<4>, dim3(grid), dim3(NTHR), LDS_BYTES, stream, p);
    hipLaunchKernelGGL(k_phase<5>, dim3(grid), dim3(NTHR), LDS_BYTES, stream, p);
    hipLaunchKernelGGL(k_phase<6>, dim3(grid), dim3(NTHR), LDS_BYTES, stream, p);
    hipLaunchKernelGGL(k_phase<7>, dim3(grid), dim3(NTHR), LDS_BYTES, stream, p);
#endif
}
```

```cpp
#include <hip/hip_runtime.h>
#include <hip/hip_cooperative_groups.h>
#include <cstdio>
namespace cg = cooperative_groups;

typedef unsigned short bf16_t;
typedef float f32x4 __attribute__((ext_vector_type(4)));
typedef unsigned u32x4 __attribute__((ext_vector_type(4)));
typedef unsigned u32x2 __attribute__((ext_vector_type(2)));
typedef short bf16x8 __attribute__((ext_vector_type(8)));
typedef int v4i __attribute__((ext_vector_type(4)));
typedef int v8i __attribute__((ext_vector_type(8)));

constexpr int T_ = 16384, D_ = 2048, DIN = 5120, NE = 32, DE = 512, SEQ = 4096, LCAP = 16384;
constexpr float EPS = 1e-6f;
#ifndef DUP_PHASE
#define DUP_PHASE -1
#endif
constexpr int NTHR = 512;
constexpr int LDS_BYTES = 147456;
constexpr int LCNT_OFF = 131072, LBAR_OFF = 131072 + 2048;

constexpr size_t SZ_A = (size_t)T_ * DIN * 2;
constexpr size_t SZ_B = (size_t)T_ * D_ * 2;
constexpr size_t OFF_A = 0;
constexpr size_t OFF_B = OFF_A + SZ_A;
constexpr size_t OFF_HB = OFF_B + SZ_B;
constexpr size_t OFF_H8 = OFF_A + (size_t)2 * T_ * D_ * 2;
constexpr float WGU_SCALE = 32.f, WD_SCALE = 16.f, YS_SCALE = 16.f;
constexpr size_t OFF_WIN = OFF_HB + SZ_B;
constexpr size_t OFF_WOUT = OFF_WIN + (size_t)DIN * D_ * 2;
constexpr size_t OFF_WGU = OFF_WOUT + (size_t)D_ * D_ * 2;
constexpr size_t OFF_WD = OFF_WGU + (size_t)NE * 1024 * D_ * 2;
constexpr size_t OFF_WR = OFF_WD + (size_t)NE * D_ * DE * 2;
constexpr size_t OFF_SSQ = OFF_WR + (size_t)48 * D_ * 2;
constexpr size_t OFF_CNT = OFF_SSQ + (size_t)3 * T_ * 4;
constexpr size_t OFF_RINFO = OFF_CNT + 256;
constexpr size_t OFF_RW = OFF_RINFO + (size_t)NE * LCAP * 4;
constexpr size_t OFF_BAR = OFF_RW + (size_t)NE * LCAP * 4;
constexpr size_t BAR_BYTES = 16384;
constexpr size_t WS_END = OFF_BAR + BAR_BYTES;
constexpr size_t OFF_DUMMY = WS_END;
constexpr size_t DUMMY_BYTES = (OFF_BAR - OFF_SSQ);

struct Params {
    const float *x, *norm_mix_g, *w_in, *v_norm_g, *gmlp_ws, *gmlp_bs, *conv_w, *g_a, *g_b, *w_out, *g_ffn, *rgw, *rgb, *rew, *reb, *ewg, *ewu, *ewd, *g_final;
    float* out; unsigned char* ws;
};

__device__ __forceinline__ unsigned cvt_pk_bf16(float lo, float hi) { unsigned r; asm volatile("v_cvt_pk_bf16_f32 %0, %1, %2" : "=v"(r) : "v"(lo), "v"(hi)); return r; }
__device__ __forceinline__ unsigned char* opaque_ws(unsigned char* w) { asm volatile("" : "+s"(w)); return w; }
__device__ __forceinline__ int opaque_tid() { int t = threadIdx.x; asm volatile("" : "+v"(t)); return t; }
__device__ __forceinline__ unsigned pk4_fp8(float a, float b, float c, float d) { int w = 0; w = __builtin_amdgcn_cvt_pk_fp8_f32(a, b, w, false); w = __builtin_amdgcn_cvt_pk_fp8_f32(c, d, w, true); return (unsigned)w; }
__device__ __forceinline__ void up4_fp8(unsigned w, float& a, float& b, float& c, float& d) {
    const auto lo = __builtin_amdgcn_cvt_pk_f32_fp8((int)w, false), hi = __builtin_amdgcn_cvt_pk_f32_fp8((int)w, true); a = lo[0]; b = lo[1]; c = hi[0]; d = hi[1]; }
__device__ __forceinline__ float bflo(unsigned w) { return __uint_as_float(w << 16); }
__device__ __forceinline__ float bfhi(unsigned w) { return __uint_as_float(w & 0xffff0000u); }
__device__ __forceinline__ float wave_sum(float v) {
#pragma unroll
    for (int o = 1; o < 64; o <<= 1) v += __shfl_xor(v, o);
    return v;
}
__device__ __forceinline__ float gelu_t(float x) {
    const float u = x * (0.7978845608f + 0.0356774081f * x * x);
    return x * __builtin_amdgcn_rcpf(1.f + __builtin_amdgcn_exp2f(-2.885390082f * u));
}
__device__ __forceinline__ float silu_f(float x) { return x * __builtin_amdgcn_rcpf(1.f + __builtin_amdgcn_exp2f(-1.442695041f * x)); }

#define PG8_LAS __attribute__((address_space(3)))
struct Unit { int pm, pn, e, r0, pnl; };

constexpr int MT_CNT = 0, MT_PST = 32, MT_NT = 65, MT_T2E = 66, MT_WORDS = 66 + 192;
typedef const PG8_LAS int* lcnt_t;
__device__ __forceinline__ bool moe_unit(lcnt_t tb, int NT, int L, Unit& u) {
    const int pt = L / NT;
    if (pt >= tb[MT_NT]) return false;
    const int e = tb[MT_T2E + pt], mt = pt - tb[MT_PST + e], j = L - pt * NT;
    u.e = e; u.pm = pt; u.r0 = mt * 256; u.pnl = j; u.pn = e * NT + j; return true;
}

struct Epi1 {
    static constexpr bool PERM = true, MIDSCALE = false;
    unsigned char* ws;
    __device__ __forceinline__ void operator()(f32x4 (&acc)[2][2][4][2], const Unit& u, int wr, int wc, int fr, int fq) const {
        bf16_t* P = (bf16_t*)(opaque_ws(ws) + OFF_A);
        const bool act = u.pn < 8;
#pragma unroll
        for (int ai = 0; ai < 2; ++ai)
#pragma unroll
            for (int m = 0; m < 4; ++m) {
                const int row = u.pm * 256 + ai * 128 + wr * 64 + m * 16 + fr;
                bf16_t* rowp = P + (size_t)row * DIN + u.pn * 256 + wc * 32 + 8 * fq;
#pragma unroll
                for (int bj = 0; bj < 2; ++bj) {
                    f32x4 v0 = acc[ai][bj][m][0], v1 = acc[ai][bj][m][1];
                    if (act) {
#pragma unroll
                        for (int j = 0; j < 4; ++j) { v0[j] = gelu_t(v0[j]); v1[j] = gelu_t(v1[j]); }
                    }
                    u32x4 w; w.x = cvt_pk_bf16(v0[0], v0[1]); w.y = cvt_pk_bf16(v0[2], v0[3]); w.z = cvt_pk_bf16(v1[0], v1[1]); w.w = cvt_pk_bf16(v1[2], v1[3]);
                    *(u32x4*)(rowp + bj * 128) = w;
                }
            }
    }
};
struct Epi2 {
    static constexpr bool PERM = true, MIDSCALE = true;
    const float* x; unsigned char* ws; size_t so;
    __device__ __forceinline__ void midscale(f32x4 (&acc)[2][2][4][2], const Unit& u, int wr, int wc, int fr, int fq) const {
        int rowb = u.pm * 256 + wr * 64 + fr; asm volatile("" : "+v"(rowb));
        const float* ssq_a = (const float*)(opaque_ws(ws) + OFF_SSQ);
        const float* pa = ssq_a + rowb; const float* pb = ssq_a + T_ + rowb;
#pragma unroll
        for (int ai = 0; ai < 2; ++ai)
#pragma unroll
            for (int m = 0; m < 4; ++m) {
                const float s = __builtin_amdgcn_sqrtf((pb[ai * 128 + m * 16] * (1.f / 1024.f) + EPS) * __builtin_amdgcn_rcpf(pa[ai * 128 + m * 16] * (1.f / 1024.f) + EPS));
#pragma unroll
                for (int bj = 0; bj < 2; ++bj)
#pragma unroll
                    for (int n = 0; n < 2; ++n) acc[ai][bj][m][n] *= s;
                if (m & 1) asm volatile("" ::: "memory");
            }
    }
    __device__ __forceinline__ void operator()(f32x4 (&acc)[2][2][4][2], const Unit& u, int wr, int wc, int fr, int fq) const {
        unsigned char* w_ = opaque_ws(ws);
        bf16_t* hb = (bf16_t*)(w_ + OFF_HB); unsigned char* h8 = w_ + OFF_H8; const float* ssq_b = (const float*)(w_ + OFF_SSQ) + T_; float* ssq_h = (float*)(w_ + OFF_SSQ + so) + 2 * T_;
#pragma unroll
        for (int ai = 0; ai < 2; ++ai)
#pragma unroll
            for (int m = 0; m < 4; ++m) {
                const int row = u.pm * 256 + ai * 128 + wr * 64 + m * 16 + fr;
                const float rb = rsqrtf(ssq_b[row] * (1.f / 1024.f) + EPS);
                const size_t off = (size_t)row * D_ + u.pn * 256 + wc * 32 + 8 * fq;
                float ss = 0.f;
#pragma unroll
                for (int bj = 0; bj < 2; ++bj) {
                    const f32x4 x0 = *(const f32x4*)(x + off + bj * 128), x1 = *(const f32x4*)(x + off + bj * 128 + 4);
                    const f32x4 h0 = x0 + acc[ai][bj][m][0] * rb, h1 = x1 + acc[ai][bj][m][1] * rb;
                    ss += (h0[0] * h0[0] + h0[1] * h0[1]) + (h0[2] * h0[2] + h0[3] * h0[3]) + (h1[0] * h1[0] + h1[1] * h1[1]) + (h1[2] * h1[2] + h1[3] * h1[3]);
                    u32x4 w; w.x = cvt_pk_bf16(h0[0], h0[1]); w.y = cvt_pk_bf16(h0[2], h0[3]); w.z = cvt_pk_bf16(h1[0], h1[1]); w.w = cvt_pk_bf16(h1[2], h1[3]);
                    *(u32x4*)(hb + off + bj * 128) = w;
                    u32x2 w8; w8.x = pk4_fp8(h0[0], h0[1], h0[2], h0[3]); w8.y = pk4_fp8(h1[0], h1[1], h1[2], h1[3]);
                    *(u32x2*)(h8 + off + bj * 128) = w8;
                }
                ss += __shfl_xor(ss, 16); ss += __shfl_xor(ss, 32);
                if (fq == 0) atomicAdd(ssq_h + row, ss);
                if (m == 3) asm volatile("" ::: "memory");
            }
    }
};
struct Epi5 {
    static constexpr bool PERM = true, MIDSCALE = false;
    unsigned char* ws; lcnt_t cnt;
    __device__ __forceinline__ void operator()(f32x4 (&acc)[2][2][4][2], const Unit& u, int wr, int wc, int fr, int fq) const {
        unsigned char* w_ = opaque_ws(ws);
        unsigned char* hbuf = w_ + OFF_B; const float* ssq_h = (const float*)(w_ + OFF_SSQ) + 2 * T_; const int* rinfo = (const int*)(w_ + OFF_RINFO);
        const int ce = cnt[u.e];
#pragma unroll
        for (int ai = 0; ai < 2; ++ai)
#pragma unroll
            for (int m = 0; m < 4; ++m) {
                const int r = ai * 128 + wr * 64 + m * 16 + fr, i = u.r0 + r;
                const int tok = (i < ce) ? (rinfo[u.e * LCAP + i] >> 1) : 0;
                const float rs = rsqrtf(ssq_h[tok] * (1.f / 2048.f) + EPS) * (1.f / WGU_SCALE);
                float o[8];
#pragma unroll
                for (int n = 0; n < 2; ++n)
#pragma unroll
                    for (int j = 0; j < 4; ++j) o[4 * n + j] = silu_f(acc[ai][0][m][n][j] * rs) * (acc[ai][1][m][n][j] * rs);
                u32x2 w; w.x = pk4_fp8(o[0], o[1], o[2], o[3]); w.y = pk4_fp8(o[4], o[5], o[6], o[7]);
                *(u32x2*)(hbuf + (size_t)(u.pm * 256 + r) * DE + u.pnl * 128 + wc * 32 + 8 * fq) = w;
            }
    }
};
struct Epi6 {
    static constexpr bool PERM = true, MIDSCALE = false;
    unsigned char* ws; lcnt_t cnt;
    __device__ __forceinline__ void operator()(f32x4 (&acc)[2][2][4][2], const Unit& u, int wr, int wc, int fr, int fq) const {
        unsigned char* w_ = opaque_ws(ws);
        unsigned char* ys2 = w_ + OFF_A; const int* rinfo = (const int*)(w_ + OFF_RINFO); const float* rw = (const float*)(w_ + OFF_RW);
        const int ce = cnt[u.e];
#pragma unroll
        for (int ai = 0; ai < 2; ++ai)
#pragma unroll
            for (int m = 0; m < 4; ++m) {
                const int r = ai * 128 + wr * 64 + m * 16 + fr, i = u.r0 + r;
                if (i < ce) {
                    const int info = rinfo[u.e * LCAP + i]; const float g = rw[u.e * LCAP + i] * (YS_SCALE / WD_SCALE);
                    unsigned char* dst = ys2 + (size_t)info * D_ + u.pnl * 256 + wc * 32 + 8 * fq;
#pragma unroll
                    for (int bj = 0; bj < 2; ++bj) {
                        const f32x4 v0 = acc[ai][bj][m][0] * g, v1 = acc[ai][bj][m][1] * g;
                        u32x2 w; w.x = pk4_fp8(v0[0], v0[1], v0[2], v0[3]); w.y = pk4_fp8(v1[0], v1[1], v1[2], v1[3]);
                        *(u32x2*)(dst + bj * 128) = w;
                    }
                }
            }
    }
};

namespace pg8 {
constexpr int BM = 256, BK = 64, HALF = 128, HTB = HALF * BK * 2, STAGE_BYTES = 8 * HTB, NXCD = 8, WGM = 8;
__host__ __device__ __forceinline__ int lds_byte(int r, int c) { const int st = (r >> 4) * 2 + (c >> 5), rr = r & 15, cc = c & 31, ob = rr * 64 + cc * 2; return st * 1024 + (ob ^ (((ob >> 9) & 1) << 5)); }
__host__ __device__ __forceinline__ void stage_rc(int b, int& R, int& C) { const int st = b / 1024, sb = b % 1024, swz = sb ^ (((sb >> 9) & 1) << 5); R = (st >> 1) * 16 + swz / 64; C = (st & 1) * 32 + (swz % 64) / 2; }
__host__ __device__ __forceinline__ int perm32(int rho) { const int n = rho >> 4, i = rho & 15; return 8 * (i >> 2) + 4 * n + (i & 3); }

struct StaticOrder {
    int nM, nN, nwg, G, c;
    __device__ void init(int M, int N, int G_, int c_) { nM = M / BM; nN = N / BM; nwg = nM * nN; G = G_; c = c_; }
    __device__ bool next(int i, Unit& u) const {
        const long L = (long)i * G + c; if (L >= nwg) return false;
        int wgid = (int)L; { const int q = nwg / NXCD, r = nwg % NXCD, xcd = wgid % NXCD, off = wgid / NXCD; wgid = (xcd < r ? xcd * (q + 1) : r * (q + 1) + (xcd - r) * q) + off; }
        const int nig = WGM * nN, gid = wgid / nig, fm = gid * WGM, gsz = (nM - fm) < WGM ? (nM - fm) : WGM;
        u.pm = fm + ((wgid % nig) % gsz); u.pn = (wgid % nig) / gsz; u.e = 0; u.r0 = 0; u.pnl = u.pn; return true;
    }
};
struct MoeOrder {
    lcnt_t cnt; int NT, G, c;
    __device__ __forceinline__ bool next(int i, Unit& u) const { return moe_unit(cnt, NT, i * G + c, u); }
};
struct AOffDirect { int K; __device__ __forceinline__ unsigned operator()(const Unit& u, int h, int R, int C) const { return (unsigned)(((u.pm * 256 + h * 128 + R) * K + C) * 2); } };
struct AOffGather { unsigned char* ws; lcnt_t cnt; int K;
    __device__ __forceinline__ unsigned operator()(const Unit& u, int h, int R, int C) const { const int* rinfo = (const int*)(opaque_ws(ws) + OFF_RINFO); const int i = u.r0 + h * 128 + R; const int tok = (i < cnt[u.e]) ? (rinfo[u.e * LCAP + i] >> 1) : 0; return (unsigned)((tok * K + C) * 2); } };

template <class Epi, class Sched, class AOff, bool ALIGN_EPI, bool FP8 = false>
__device__ __forceinline__ void gemm_phase(PG8_LAS unsigned char* lds, const bf16_t* Ag, const bf16_t* Btg, const int K, const Sched& S, const AOff& AO, const Epi& E) {
    const int tid = opaque_tid(), wid = __builtin_amdgcn_readfirstlane(tid >> 6), lane = tid & 63, wr = wid >> 2, wc = wid & 3, fr = lane & 15, fq = lane >> 4;
    int nt = K / BK; asm volatile("" : "+s"(nt));
    unsigned voffB[2];
#pragma unroll
    for (int i = 0; i < 2; ++i) { int R, C; stage_rc(tid * 16 + i * 8192, R, C); const int Rb = Epi::PERM ? ((R & ~31) + perm32(R & 31)) : R; voffB[i] = (unsigned)(Rb * K + C) * 2u; }
#define PG8_AOFFS(u) do { int _t = tid; asm volatile("" : "+v"(_t)); _Pragma("unroll") for (int _i = 0; _i < 2; ++_i) { int _R, _C; stage_rc(_t * 16 + _i * 8192, _R, _C); vo0[_i] = AO(u, 0, _R, _C); vo1[_i] = AO(u, 1, _R, _C); } } while (0)
    const unsigned kstep = (unsigned)(BK * 2), hstep = (unsigned)HALF * (unsigned)K * 2u, tstep = 2u * hstep;
    const unsigned ldsw = (unsigned)wid * 1024u;
    const int aoff = lds_byte(wr * 64 + fr, fq * 8), boff = lds_byte(wc * 32 + fr, fq * 8);
    const char* const Ab = (const char*)Ag; const char* const Bb = (const char*)Btg;
#define PG8_SA(b, h) (((b) * 2 + (h)) * HTB)
#define PG8_SB(b, h) ((4 + (b) * 2 + (h)) * HTB)
#define PG8_STAGE(bufoff, gbase, uoff, voff) do { _Pragma("unroll") for (int _i = 0; _i < 2; ++_i) \
        __builtin_amdgcn_global_load_lds((const unsigned*)((gbase) + (size_t)(unsigned)((uoff) + (voff)[_i])), (PG8_LAS unsigned*)(lds + (bufoff) + ldsw + _i * 8192), 16, 0, 0); } while (0)
#define PG8_LD32(base) __builtin_shufflevector(*(const PG8_LAS v4i*)(base), *(const PG8_LAS v4i*)((base) + 1024), 0, 1, 2, 3, 4, 5, 6, 7)
#define PG8_LDA(dst, b, h) do { _Pragma("unroll") for (int m = 0; m < 4; ++m) dst[m] = PG8_LD32(lds + PG8_SA(b, h) + aoff + m * 2048); } while (0)
#define PG8_LDB(dst, b, h) do { _Pragma("unroll") for (int n = 0; n < 2; ++n) dst[n] = PG8_LD32(lds + PG8_SB(b, h) + boff + n * 2048); } while (0)
#define PG8_LO(x) __builtin_bit_cast(bf16x8, __builtin_shufflevector((x), (x), 0, 1, 2, 3))
#define PG8_HI(x) __builtin_bit_cast(bf16x8, __builtin_shufflevector((x), (x), 4, 5, 6, 7))
#define PG8_MMA(ai, bj, At, Bt) do { __builtin_amdgcn_s_setprio(1); _Pragma("unroll") for (int m = 0; m < 4; ++m) _Pragma("unroll") for (int n = 0; n < 2; ++n) { \
        if constexpr (FP8) acc[ai][bj][m][n] = __builtin_amdgcn_mfma_scale_f32_16x16x128_f8f6f4(Bt[n], At[m], acc[ai][bj][m][n], 0, 0, 0, 0, 0, 0);   \
        else { acc[ai][bj][m][n] = __builtin_amdgcn_mfma_f32_16x16x32_bf16(PG8_LO(Bt[n]), PG8_LO(At[m]), acc[ai][bj][m][n], 0, 0, 0); \
               acc[ai][bj][m][n] = __builtin_amdgcn_mfma_f32_16x16x32_bf16(PG8_HI(Bt[n]), PG8_HI(At[m]), acc[ai][bj][m][n], 0, 0, 0); } } \
        __builtin_amdgcn_s_setprio(0); } while (0)
#define PG8_WAIT_V(n) asm volatile("s_waitcnt vmcnt(" #n ")" ::: "memory")
#define PG8_WAIT_L(n) asm volatile("s_waitcnt lgkmcnt(" #n ")" ::: "memory")
#define PG8_BAR __builtin_amdgcn_s_barrier()
#define PG8_SCHED __builtin_amdgcn_sched_barrier(0)
    Unit cur, nxt; int ui = 0;
    if (!S.next(0, cur)) return;
    f32x4 acc[2][2][4][2];
#pragma unroll
    for (int a = 0; a < 2; ++a)
#pragma unroll
        for (int b = 0; b < 2; ++b)
#pragma unroll
            for (int m = 0; m < 4; ++m)
#pragma unroll
                for (int n = 0; n < 2; ++n) acc[a][b][m][n] = (f32x4){0.f, 0.f, 0.f, 0.f};
    v8i At[4], B0[2], B1[2];
    unsigned vo0[2], vo1[2];
    PG8_AOFFS(cur);
    unsigned cB = (unsigned)cur.pn * tstep;
    PG8_STAGE(PG8_SB(0, 0), Bb, cB, voffB); PG8_STAGE(PG8_SB(0, 1), Bb, cB + hstep, voffB); PG8_STAGE(PG8_SA(0, 0), Ab, 0u, vo0); PG8_STAGE(PG8_SA(0, 1), Ab, 0u, vo1);
    if (wr == 1) PG8_BAR;
    PG8_WAIT_V(2); PG8_BAR;
    PG8_STAGE(PG8_SB(1, 0), Bb, cB + kstep, voffB); PG8_STAGE(PG8_SA(1, 0), Ab, kstep, vo0); PG8_STAGE(PG8_SB(1, 1), Bb, cB + hstep + kstep, voffB);
    PG8_WAIT_V(6); PG8_BAR;
    for (;;) {
        const bool has_next = S.next(ui + 1, nxt);
        const unsigned nB = has_next ? (unsigned)nxt.pn * tstep : cB;
#pragma clang loop unroll(disable)
        for (int t = 0; t < nt; t += 2) {
            const bool last = (t == nt - 2);
            if constexpr (Epi::MIDSCALE) { if (t == nt / 2) { int _t = tid; asm volatile("" : "+v"(_t)); const int _l = _t & 63; E.midscale(acc, cur, wr, wc, _l & 15, _l >> 4); } }
            const unsigned k1 = (unsigned)(t + 1) * kstep, k2 = last ? 0u : (unsigned)(t + 2) * kstep, k3 = k2 + kstep;
            const unsigned b2 = last ? nB : cB + (unsigned)(t + 2) * kstep, b3 = b2 + kstep;
            PG8_LDB(B0, 0, 0); PG8_LDB(B1, 0, 1); PG8_SCHED; PG8_LDA(At, 0, 0); PG8_STAGE(PG8_SA(1, 1), Ab, k1, vo1);
            PG8_WAIT_V(8); PG8_WAIT_L(0); PG8_BAR; PG8_MMA(0, 0, At, B0); PG8_MMA(0, 1, At, B1); PG8_BAR; PG8_SCHED;
            if (last && has_next) { PG8_AOFFS(nxt); }
            PG8_LDA(At, 0, 1); PG8_STAGE(PG8_SB(0, 0), Bb, b2, voffB); PG8_STAGE(PG8_SB(0, 1), Bb, b2 + hstep, voffB); PG8_STAGE(PG8_SA(0, 0), Ab, k2, vo0);
            PG8_WAIT_V(8); PG8_WAIT_L(0); PG8_BAR; PG8_MMA(1, 0, At, B0); PG8_MMA(1, 1, At, B1); PG8_BAR; PG8_SCHED;
            PG8_LDB(B0, 1, 0); PG8_LDB(B1, 1, 1); PG8_SCHED; PG8_LDA(At, 1, 0); PG8_STAGE(PG8_SA(0, 1), Ab, k2, vo1);
            PG8_WAIT_V(8); PG8_WAIT_L(0); PG8_BAR; PG8_MMA(0, 0, At, B0); PG8_MMA(0, 1, At, B1); PG8_BAR; PG8_SCHED;
            PG8_LDA(At, 1, 1); PG8_STAGE(PG8_SB(1, 0), Bb, b3, voffB); PG8_STAGE(PG8_SB(1, 1), Bb, b3 + hstep, voffB); PG8_STAGE(PG8_SA(1, 0), Ab, k3, vo0);
            PG8_WAIT_V(8); PG8_WAIT_L(0); PG8_BAR; PG8_MMA(1, 0, At, B0); PG8_MMA(1, 1, At, B1); PG8_BAR; PG8_SCHED;
        }
        if constexpr (ALIGN_EPI) { if (wr == 0) PG8_BAR; }
        { int _t = tid; asm volatile("" : "+v"(_t)); const int _l = _t & 63; E(acc, cur, wr, wc, _l & 15, _l >> 4); }
        if (!has_next) break;
#pragma unroll
        for (int a = 0; a < 2; ++a)
#pragma unroll
            for (int b = 0; b < 2; ++b)
#pragma unroll
                for (int m = 0; m < 4; ++m)
#pragma unroll
                    for (int n = 0; n < 2; ++n) acc[a][b][m][n] = (f32x4){0.f, 0.f, 0.f, 0.f};
        cur = nxt; cB = nB; ++ui;
        if constexpr (ALIGN_EPI) { if (wr == 1) PG8_BAR; }
    }
    PG8_WAIT_V(0);
    if constexpr (!ALIGN_EPI) { if (wr == 0) PG8_BAR; }
    PG8_BAR;
#undef PG8_AOFFS
#undef PG8_SA
#undef PG8_SB
#undef PG8_STAGE
#undef PG8_LDA
#undef PG8_LDB
#undef PG8_MMA
#undef PG8_LO
#undef PG8_HI
#undef PG8_LD32
#undef PG8_WAIT_V
#undef PG8_WAIT_L
#undef PG8_BAR
#undef PG8_SCHED
}
}


#define XB_TMO      128
#define XB_XCNT(j)  (256  + 64 * (j))
#define XB_XSUB(j)  (1280 + 64 * (j))
#define XB_XGEN(j)  (2304 + 64 * (j))
#define XB_TOP      3328
#define XB_TOPGEN   3392
#define XCD_BAR_WORDS 3456
#define XB_SPIN_CAP (1u << 18)
__device__ __forceinline__ unsigned xb_ld(unsigned* p)              { return __hip_atomic_load(p, __ATOMIC_RELAXED, __HIP_MEMORY_SCOPE_AGENT); }
__device__ __forceinline__ unsigned xb_add(unsigned* p, unsigned v) { return __hip_atomic_fetch_add(p, v, __ATOMIC_RELAXED, __HIP_MEMORY_SCOPE_AGENT); }
__device__ __forceinline__ unsigned xb_xcc_id() { return (unsigned)__builtin_amdgcn_s_getreg((3 << 11) | 20) & 0xFu; }
#define XB_SPIN(cond, bar) do { unsigned _sp = 0; while (cond) { __builtin_amdgcn_s_sleep(1); \
    if ((++_sp & 255u) == 0u) { if (xb_ld(&(bar)[XB_TMO])) break; if (_sp > XB_SPIN_CAP) { atomicAdd(&(bar)[XB_TMO], 1u); break; } } } } while (0)
struct XcdBarrier { unsigned* bar; unsigned x; volatile PG8_LAS unsigned* st; };
__device__ __forceinline__ XcdBarrier xcd_barrier_post(unsigned* bar, volatile PG8_LAS unsigned* st) {
    XcdBarrier b; b.bar = bar; b.x = xb_xcc_id(); b.st = st;
    if (threadIdx.x == 0) (void)xb_add(&bar[XB_XCNT(b.x)], 1u);
    return b;
}
__device__ __forceinline__ void xcd_barrier_complete(unsigned* bar, unsigned x, unsigned& nloc, unsigned& nx) {
    const unsigned G = gridDim.x * gridDim.y * gridDim.z;
    unsigned sum, cnt, mine, sp = 0u;
    for (;;) {
        sum = 0u; cnt = 0u; mine = 0u;
#pragma unroll
        for (unsigned j = 0; j < 16; ++j) { const unsigned c = xb_ld(&bar[XB_XCNT(j)]); sum += c; cnt += (c > 0u) ? 1u : 0u; mine = (j == x) ? c : mine; }
        if (sum == G) break;
        __builtin_amdgcn_s_sleep(1);
        if ((++sp & 255u) == 0u) { if (xb_ld(&bar[XB_TMO])) break; if (sp > XB_SPIN_CAP) { atomicAdd(&bar[XB_TMO], 1u); break; } }
    }
    nloc = mine > 0u ? mine : 1u; nx = cnt > 0u ? cnt : 1u;
}
__device__ __forceinline__ void xcd_barrier(const XcdBarrier& b) {
    asm volatile("s_waitcnt vmcnt(0)" ::: "memory");
    __syncthreads();
    if (threadIdx.x == 0) {
        unsigned* bar = b.bar;
        __builtin_amdgcn_s_waitcnt(0);
        unsigned nloc = b.st[0], nx = b.st[1];
        if (nloc == 0u) { xcd_barrier_complete(bar, b.x, nloc, nx); b.st[0] = nloc; b.st[1] = nx; }
        const unsigned old = xb_add(&bar[XB_XSUB(b.x)], 1u);
        const unsigned gen = old / nloc;
        if (old + 1u == (gen + 1u) * nloc) {
            __builtin_amdgcn_fence(__ATOMIC_RELEASE, "agent");
            asm volatile("s_waitcnt vmcnt(0)" ::: "memory");
            const unsigned og = xb_add(&bar[XB_TOP], 1u);
            const unsigned tg = og / nx;
            if (og + 1u == (tg + 1u) * nx) xb_add(&bar[XB_TOPGEN], 1u);
            else XB_SPIN(xb_ld(&bar[XB_TOPGEN]) == tg, bar);
            __builtin_amdgcn_fence(__ATOMIC_ACQUIRE, "agent");
            xb_add(&bar[XB_XGEN(b.x)], 1u);
            asm volatile("s_waitcnt vmcnt(0)" ::: "memory");
        } else {
            XB_SPIN(xb_ld(&bar[XB_XGEN(b.x)]) == gen, bar);
            __builtin_amdgcn_fence(__ATOMIC_ACQUIRE, "agent");
            asm volatile("s_waitcnt vmcnt(0)" ::: "memory");
        }
    }
    __syncthreads();
}

__device__ __forceinline__ void transpose_tile(float* lt, const float* src, int ldsrc, int r0, int c0, bf16_t* dst, int lddst, int dr0, const float* sA, const float* sB, int split) {
    const int tid = opaque_tid();
    { const int r = tid >> 3, cc = (tid & 7) * 8;
      const float* s = src + (size_t)(r0 + r) * ldsrc + c0 + cc;
      const f32x4 v0 = *(const f32x4*)s, v1 = *(const f32x4*)(s + 4);
      float sc = 1.f; if (sA) { const int rr = r0 + r; sc = rr < split ? sA[rr] : sB[rr - split]; }
#pragma unroll
      for (int q = 0; q < 4; ++q) { lt[r * 65 + cc + q] = v0[q] * sc; lt[r * 65 + cc + 4 + q] = v1[q] * sc; } }
    __syncthreads();
    { const int c = tid >> 3, rr = (tid & 7) * 8;
      float v[8];
#pragma unroll
      for (int q = 0; q < 8; ++q) v[q] = lt[(rr + q) * 65 + c];
      u32x4 w; w.x = cvt_pk_bf16(v[0], v[1]); w.y = cvt_pk_bf16(v[2], v[3]); w.z = cvt_pk_bf16(v[4], v[5]); w.w = cvt_pk_bf16(v[6], v[7]);
      *(u32x4*)(dst + (size_t)(dr0 + c) * lddst + r0 + rr) = w; }
    __syncthreads();
}
__device__ __forceinline__ void transpose_tile8(float* lt, const float* src, int ldsrc, int r0, int c0, unsigned char* dst, int lddst, int dr0, const float* sk, float sc) {
    const int tid = opaque_tid();
    { const int r = tid >> 2, cc = (tid & 3) * 16;
      const float* sp = src + (size_t)(r0 + r) * ldsrc + c0 + cc;
      const float f = sk ? sc * sk[r0 + r] : sc;
#pragma unroll
      for (int q = 0; q < 4; ++q) { const f32x4 v = *(const f32x4*)(sp + 4 * q);
#pragma unroll
          for (int j = 0; j < 4; ++j) lt[r * 65 + cc + 4 * q + j] = v[j] * f; } }
    __syncthreads();
    { const int c = tid >> 3, rr = (tid & 7) * 16;
      float v[16];
#pragma unroll
      for (int q = 0; q < 16; ++q) v[q] = lt[(rr + q) * 65 + c];
      u32x4 w; w.x = pk4_fp8(v[0], v[1], v[2], v[3]); w.y = pk4_fp8(v[4], v[5], v[6], v[7]); w.z = pk4_fp8(v[8], v[9], v[10], v[11]); w.w = pk4_fp8(v[12], v[13], v[14], v[15]);
      *(u32x4*)(dst + (size_t)(dr0 + c) * lddst + r0 + rr) = w; }
    __syncthreads();
}
__device__ __forceinline__ void phase0(const Params& p, unsigned char* lds) {
    const int tid = opaque_tid(), nb = gridDim.x, bid = blockIdx.x, wid = tid >> 6, lane = tid & 63;
    { float* z = (float*)(p.ws + OFF_SSQ);
      for (int i = bid * NTHR + tid; i < 3 * T_ + 64; i += nb * NTHR) z[i] = 0.f;
      if (DUP_PHASE >= 2 && DUP_PHASE <= 4) { float* zd = (float*)(p.ws + OFF_SSQ + (OFF_DUMMY - OFF_SSQ)); for (int i = bid * NTHR + tid; i < 3 * T_ + 64; i += nb * NTHR) zd[i] = 0.f; } }
    { bf16_t* wrt = (bf16_t*)(p.ws + OFF_WR);
      for (int i = bid * NTHR + tid; i < 48 * D_; i += nb * NTHR) {
          const int o = i >> 11, k = i & 2047; float v = 0.f;
          if (o < 4) v = p.rgw[k * 4 + o]; else if (o < 36) v = p.rew[k * 32 + (o - 4)];
          wrt[i] = (bf16_t)(cvt_pk_bf16(v * p.g_ffn[k], 0.f) & 0xffffu); } }
    { bf16_t* xn = (bf16_t*)(p.ws + OFF_B);
      for (int row = bid * 8 + wid; row < T_; row += nb * 8) {
          const float* xr = p.x + (size_t)row * D_;
          f32x4 v[8]; float s = 0.f;
#pragma unroll
          for (int i = 0; i < 8; ++i) { v[i] = *(const f32x4*)(xr + i * 256 + lane * 4); s += (v[i][0] * v[i][0] + v[i][1] * v[i][1]) + (v[i][2] * v[i][2] + v[i][3] * v[i][3]); }
          const float rstd = rsqrtf(wave_sum(s) * (1.f / D_) + EPS);
#pragma unroll
          for (int i = 0; i < 8; ++i) { const f32x4 g = *(const f32x4*)(p.norm_mix_g + i * 256 + lane * 4); const f32x4 o = v[i] * rstd * g;
              u32x2 w; w.x = cvt_pk_bf16(o[0], o[1]); w.y = cvt_pk_bf16(o[2], o[3]); *(u32x2*)(xn + (size_t)row * D_ + i * 256 + lane * 4) = w; } } }
    float* lt = (float*)lds;
    constexpr int N_IN = 32 * 80, N_OUT = 32 * 32, N_G = 32 * 128, N_TOT = N_IN + N_OUT + 3 * N_G;
    for (int tile = bid; tile < N_TOT; tile += nb) {
        int q = tile;
        if (q < N_IN) { const int tr = q / 80, tc = q % 80; transpose_tile(lt, p.w_in, DIN, tr * 64, tc * 64, (bf16_t*)(p.ws + OFF_WIN), D_, tc * 64, nullptr, nullptr, 0); continue; } q -= N_IN;
        if (q < N_OUT) { const int tr = q / 32, tc = q % 32; transpose_tile(lt, p.w_out, D_, tr * 64, tc * 64, (bf16_t*)(p.ws + OFF_WOUT), D_, tc * 64, p.g_a, p.g_b, 1024); continue; } q -= N_OUT;
        if (q < 2 * N_G) { const int up = q >= N_G; if (up) q -= N_G; const int e = q >> 7, rem = q & 127, tr = rem >> 3, tc = rem & 7; const int c0 = tc * 64;
            transpose_tile8(lt, (up ? p.ewu : p.ewg) + (size_t)e * D_ * DE, DE, tr * 128, c0, p.ws + OFF_WGU + (size_t)e * 1024 * D_, D_, (c0 >> 7) * 256 + (up ? 128 : 0) + (c0 & 127), p.g_ffn, WGU_SCALE); continue; } q -= 2 * N_G;
        { const int e = q >> 7, rem = q & 127, tr = rem >> 5, tc = rem & 31;
          transpose_tile8(lt, p.ewd + (size_t)e * DE * D_, D_, tr * 128, tc * 64, p.ws + OFF_WD + (size_t)e * D_ * DE, DE, tc * 64, nullptr, WD_SCALE); }
    }
}

__device__ __forceinline__ void phase1(const Params& p, unsigned char* lds) {
    const Epi1 E{p.ws};
    pg8::StaticOrder S; S.init(T_, DIN, gridDim.x, blockIdx.x); const pg8::AOffDirect AO{D_};
    pg8::gemm_phase<Epi1, pg8::StaticOrder, pg8::AOffDirect, true>((PG8_LAS unsigned char*)lds, (const bf16_t*)(p.ws + OFF_B), (const bf16_t*)(p.ws + OFF_WIN), D_, S, AO, E);
}

__device__ __forceinline__ void mixer_gmlp_item(const Params& p, unsigned char* lds, int item, size_t so) {
    const int tid = opaque_tid(), wid = tid >> 6, lane = tid & 63, fr = lane & 15, fq = lane >> 4;
    const int h = item & 7, t0 = (item >> 3) * 128;
    const bf16_t* P = (const bf16_t*)(p.ws + OFF_A); bf16_t* Y = (bf16_t*)(p.ws + OFF_B); float* ssq_a = (float*)(p.ws + OFF_SSQ + so);
    bf16_t* Vt = (bf16_t*)lds;
    bf16_t* Wl = Vt + 128 * 136;
    float* rs = (float*)(Wl + 128 * 136);
    { const int j = tid >> 2, dc = (tid & 3) * 32;
      const u32x4* src = (const u32x4*)(P + (size_t)(t0 + j) * DIN + 1024 + h * 128 + dc);
      u32x4 v[4]; float s = 0.f;
#pragma unroll
      for (int q = 0; q < 4; ++q) { v[q] = src[q];
#pragma unroll
          for (int w = 0; w < 4; ++w) { const float lo = bflo(v[q][w]), hi = bfhi(v[q][w]); s += lo * lo + hi * hi; } }
      s += __shfl_xor(s, 1); s += __shfl_xor(s, 2);
      if ((tid & 3) == 0) rs[j] = rsqrtf(s * (1.f / 128.f) + EPS);
#pragma unroll
      for (int q = 0; q < 4; ++q)
#pragma unroll
          for (int w = 0; w < 4; ++w) { const int d = dc + q * 8 + w * 2; Vt[d * 136 + j] = (bf16_t)(v[q][w] & 0xffffu); Vt[(d + 1) * 136 + j] = (bf16_t)(v[q][w] >> 16); } }
    __syncthreads();
    { const int i = tid >> 2, jc = (tid & 3) * 32;
      const f32x4* src = (const f32x4*)(p.gmlp_ws + (size_t)h * 16384 + i * 128 + jc);
      const bool live = (i >> 6) >= (jc >> 6);
#pragma unroll
      for (int q = 0; q < 4; ++q) { f32x4 w0 = src[2 * q], w1 = src[2 * q + 1];
          const f32x4 r0 = *(const f32x4*)(rs + jc + 8 * q), r1 = *(const f32x4*)(rs + jc + 8 * q + 4);
          w0 = live ? w0 * r0 : (f32x4){0.f, 0.f, 0.f, 0.f}; w1 = live ? w1 * r1 : (f32x4){0.f, 0.f, 0.f, 0.f};
          u32x4 o; o.x = cvt_pk_bf16(w0[0], w0[1]); o.y = cvt_pk_bf16(w0[2], w0[3]); o.z = cvt_pk_bf16(w1[0], w1[1]); o.w = cvt_pk_bf16(w1[2], w1[3]);
          *(u32x4*)(Wl + i * 136 + jc + 8 * q) = o; } }
    __syncthreads();
    f32x4 acc[8];
#pragma unroll
    for (int n = 0; n < 8; ++n) acc[n] = (f32x4){0.f, 0.f, 0.f, 0.f};
    const int ksteps = (wid < 4) ? 2 : 4;
    for (int ks = 0; ks < ksteps; ++ks) {
        const bf16x8 bw = *(const bf16x8*)(Wl + (16 * wid + fr) * 136 + ks * 32 + fq * 8);
#pragma unroll
        for (int n = 0; n < 8; ++n) { const bf16x8 av = *(const bf16x8*)(Vt + (16 * n + fr) * 136 + ks * 32 + fq * 8);
            acc[n] = __builtin_amdgcn_mfma_f32_16x16x32_bf16(av, bw, acc[n], 0, 0, 0); }
    }
    { const int i = 16 * wid + fr, t = t0 + i; const float bias = p.gmlp_bs[h * 128 + i]; float ss = 0.f;
#pragma unroll
      for (int n = 0; n < 8; ++n) { const int c = h * 128 + 16 * n + 4 * fq;
          const f32x4 g = *(const f32x4*)(p.v_norm_g + c); const u32x2 uu = *(const u32x2*)(P + (size_t)t * DIN + c);
          const float y0 = bflo(uu.x) * (acc[n][0] * g[0] + bias), y1 = bfhi(uu.x) * (acc[n][1] * g[1] + bias), y2 = bflo(uu.y) * (acc[n][2] * g[2] + bias), y3 = bfhi(uu.y) * (acc[n][3] * g[3] + bias);
          ss += (y0 * y0 + y1 * y1) + (y2 * y2 + y3 * y3);
          u32x2 w; w.x = cvt_pk_bf16(y0, y1); w.y = cvt_pk_bf16(y2, y3); *(u32x2*)(Y + (size_t)t * D_ + c) = w; }
      ss += __shfl_xor(ss, 16); ss += __shfl_xor(ss, 32);
      if (fq == 0) atomicAdd(ssq_a + t, ss); }
    __syncthreads();
}
__device__ __forceinline__ void mixer_conv_item(const Params& p, int item, size_t so) {
    const int tid = opaque_tid(), cl = tid & 31, ts = tid >> 5;
    const int c = (item & 3) * 256 + cl * 8, tbeg = (item >> 2) * 128 + ts * 8;
    const bf16_t* P = (const bf16_t*)(p.ws + OFF_A); bf16_t* Y = (bf16_t*)(p.ws + OFF_B); float* ssq_b = (float*)(p.ws + OFF_SSQ + so) + T_;
    float w0[8], w1[8], w2[8], z1[8], z2[8];
    { const f32x4 a0 = *(const f32x4*)(p.conv_w + c), a1 = *(const f32x4*)(p.conv_w + c + 4), b0 = *(const f32x4*)(p.conv_w + 1024 + c), b1 = *(const f32x4*)(p.conv_w + 1024 + c + 4),
                  c0 = *(const f32x4*)(p.conv_w + 2048 + c), c1 = *(const f32x4*)(p.conv_w + 2048 + c + 4);
#pragma unroll
      for (int q = 0; q < 4; ++q) { w0[q] = a0[q]; w0[4 + q] = a1[q]; w1[q] = b0[q]; w1[4 + q] = b1[q]; w2[q] = c0[q]; w2[4 + q] = c1[q]; } }
#pragma unroll
    for (int q = 0; q < 8; ++q) { z1[q] = 0.f; z2[q] = 0.f; }
    if ((tbeg % SEQ) != 0) {
        const u32x4 ca = *(const u32x4*)(P + (size_t)(tbeg - 1) * DIN + 3072 + c), ha = *(const u32x4*)(P + (size_t)(tbeg - 1) * DIN + 4096 + c);
        const u32x4 cb = *(const u32x4*)(P + (size_t)(tbeg - 2) * DIN + 3072 + c), hb2 = *(const u32x4*)(P + (size_t)(tbeg - 2) * DIN + 4096 + c);
#pragma unroll
        for (int q = 0; q < 4; ++q) { z1[2 * q] = bflo(ca[q]) * bflo(ha[q]); z1[2 * q + 1] = bfhi(ca[q]) * bfhi(ha[q]); z2[2 * q] = bflo(cb[q]) * bflo(hb2[q]); z2[2 * q + 1] = bfhi(cb[q]) * bfhi(hb2[q]); }
    }
    u32x4 bgA[8], cgA[8], hvA[8];
#pragma unroll
    for (int tt = 0; tt < 8; ++tt) { const bf16_t* pr = P + (size_t)(tbeg + tt) * DIN + c; bgA[tt] = *(const u32x4*)(pr + 2048); cgA[tt] = *(const u32x4*)(pr + 3072); hvA[tt] = *(const u32x4*)(pr + 4096); }
#pragma unroll
    for (int tt = 0; tt < 8; ++tt) {
        const int t = tbeg + tt;
        const u32x4 bg = bgA[tt], cgv = cgA[tt], hv = hvA[tt];
        float z[8], y[8], ss = 0.f;
#pragma unroll
        for (int q = 0; q < 4; ++q) { z[2 * q] = bflo(cgv[q]) * bflo(hv[q]); z[2 * q + 1] = bfhi(cgv[q]) * bfhi(hv[q]); }
#pragma unroll
        for (int q = 0; q < 4; ++q) {
            y[2 * q] = bflo(bg[q]) * (w0[2 * q] * z2[2 * q] + w1[2 * q] * z1[2 * q] + w2[2 * q] * z[2 * q]);
            y[2 * q + 1] = bfhi(bg[q]) * (w0[2 * q + 1] * z2[2 * q + 1] + w1[2 * q + 1] * z1[2 * q + 1] + w2[2 * q + 1] * z[2 * q + 1]); }
#pragma unroll
        for (int q = 0; q < 8; ++q) { ss += y[q] * y[q]; z2[q] = z1[q]; z1[q] = z[q]; }
        u32x4 w; w.x = cvt_pk_bf16(y[0], y[1]); w.y = cvt_pk_bf16(y[2], y[3]); w.z = cvt_pk_bf16(y[4], y[5]); w.w = cvt_pk_bf16(y[6], y[7]);
        *(u32x4*)(Y + (size_t)t * D_ + 1024 + c) = w;
        ss += __shfl_xor(ss, 1); ss += __shfl_xor(ss, 2); ss += __shfl_xor(ss, 4); ss += __shfl_xor(ss, 8); ss += __shfl_xor(ss, 16);
        if (cl == 0) atomicAdd(ssq_b + t, ss);
    }
}
__device__ __forceinline__ void phase2(const Params& p, unsigned char* lds, size_t so = 0) {
    for (int it = blockIdx.x; it < 512 + 1024; it += gridDim.x) { if (it < 512) mixer_conv_item(p, it, so); else mixer_gmlp_item(p, lds, it - 512, so); }
}

__device__ __forceinline__ void phase3(const Params& p, unsigned char* lds, size_t so = 0) {
    const Epi2 E{p.x, p.ws, so};
    pg8::StaticOrder S; S.init(T_, D_, gridDim.x, blockIdx.x); const pg8::AOffDirect AO{D_};
    pg8::gemm_phase<Epi2, pg8::StaticOrder, pg8::AOffDirect, true>((PG8_LAS unsigned char*)lds, (const bf16_t*)(p.ws + OFF_B), (const bf16_t*)(p.ws + OFF_WOUT), D_, S, AO, E);
}

__device__ __forceinline__ void route_item(const Params& p, unsigned char* lds, int item, size_t so) {
    const int tid = opaque_tid(), wid = tid >> 6, lane = tid & 63, fr = lane & 15, fq = lane >> 4;
    float* lg = (float*)lds;
    int* lcnt = (int*)(lg + 2 * 64 * 48); int* lbase = lcnt + 32;
    const bf16_t* hb = (const bf16_t*)(p.ws + OFF_HB); const bf16_t* wrt = (const bf16_t*)(p.ws + OFF_WR);
    const float* ssq_h = (const float*)(p.ws + OFF_SSQ) + 2 * T_;
    int* cnt = (int*)(p.ws + OFF_CNT + so); int* rinfo = (int*)(p.ws + OFF_RINFO + so); float* rw = (float*)(p.ws + OFF_RW + so);
    const int tg = wid & 3, kh = wid >> 2, t0 = item * 64;
    if (tid < 32) lcnt[tid] = 0;
    f32x4 acc[3];
#pragma unroll
    for (int n = 0; n < 3; ++n) acc[n] = (f32x4){0.f, 0.f, 0.f, 0.f};
    const bf16_t* ap = hb + (size_t)(t0 + tg * 16 + fr) * D_ + kh * 1024 + fq * 8; const bf16_t* bp = wrt + (size_t)fr * D_ + kh * 1024 + fq * 8;
#pragma unroll 8
    for (int ks = 0; ks < 32; ++ks) { const bf16x8 a = *(const bf16x8*)(ap + ks * 32);
#pragma unroll
        for (int n = 0; n < 3; ++n) { const bf16x8 b = *(const bf16x8*)(bp + (size_t)n * 16 * D_ + ks * 32); acc[n] = __builtin_amdgcn_mfma_f32_16x16x32_bf16(a, b, acc[n], 0, 0, 0); } }
#pragma unroll
    for (int n = 0; n < 3; ++n)
#pragma unroll
        for (int j = 0; j < 4; ++j) lg[(kh * 64 + tg * 16 + 4 * fq + j) * 48 + 16 * n + fr] = acc[n][j];
    __syncthreads();
    int e0 = 0, e1 = 0, r0 = 0, r1 = 0; float g0 = 0.f, g1 = 0.f; const int t = t0 + tid;
    if (tid < 64) {
        const float* l0 = lg + tid * 48; const float* l1 = l0 + 64 * 48; const float rstd = rsqrtf(ssq_h[t] * (1.f / D_) + EPS);
        float gm = -3.0e38f; int gi = 0; float gl[4];
#pragma unroll
        for (int o = 0; o < 4; ++o) { gl[o] = (l0[o] + l1[o]) * rstd + p.rgb[o]; if (gl[o] > gm) { gm = gl[o]; gi = o; } }
        float gs = 0.f;
#pragma unroll
        for (int o = 0; o < 4; ++o) gs += __expf(gl[o] - gm);
        const float pg = 1.f / gs;
        float b1 = -3.0e38f, b2 = -3.0e38f; int i1 = 0, i2 = 0;
        for (int q = 0; q < 8; ++q) { const float v = (l0[4 + gi * 8 + q] + l1[4 + gi * 8 + q]) * rstd + p.reb[gi * 8 + q];
            if (v > b1) { b2 = b1; i2 = i1; b1 = v; i1 = q; } else if (v > b2) { b2 = v; i2 = q; } }
        const float wa = 1.f / (1.f + __expf(b2 - b1));
        e0 = gi * 8 + i1; e1 = gi * 8 + i2; g0 = pg * wa; g1 = pg * (1.f - wa);
        r0 = atomicAdd(&lcnt[e0], 1); r1 = atomicAdd(&lcnt[e1], 1);
    }
    __syncthreads();
    if (tid < 32) lbase[tid] = atomicAdd(cnt + tid, lcnt[tid]);
    __syncthreads();
    if (tid < 64) { const int i0 = lbase[e0] + r0, i1 = lbase[e1] + r1;
        rinfo[e0 * LCAP + i0] = 2 * t; rw[e0 * LCAP + i0] = g0; rinfo[e1 * LCAP + i1] = 2 * t + 1; rw[e1 * LCAP + i1] = g1; }
    __syncthreads();
}
__device__ __forceinline__ void phase4(const Params& p, unsigned char* lds, size_t so = 0) { for (int it = blockIdx.x; it < T_ / 64; it += gridDim.x) route_item(p, lds, it, so); }

__device__ __forceinline__ PG8_LAS int* moe_tables_to_lds(const Params& p, unsigned char* lds) {
    PG8_LAS int* tb = (PG8_LAS int*)((PG8_LAS unsigned char*)lds + LCNT_OFF); const int* cnt = (const int*)(p.ws + OFF_CNT);
    if (threadIdx.x < NE) tb[MT_CNT + threadIdx.x] = __hip_atomic_load(cnt + threadIdx.x, __ATOMIC_RELAXED, __HIP_MEMORY_SCOPE_AGENT);
    __syncthreads();
    if (threadIdx.x == 0) { int pt = 0;
        for (int e = 0; e < NE; ++e) { const int nt = (tb[MT_CNT + e] + 255) >> 8; tb[MT_PST + e] = pt; for (int i = 0; i < nt; ++i) tb[MT_T2E + pt + i] = e; pt += nt; }
        tb[MT_PST + NE] = pt; tb[MT_NT] = pt; }
    __syncthreads();
    return tb;
}
__device__ __forceinline__ void phase5(const Params& p, unsigned char* lds) {
    PG8_LAS int* lc = moe_tables_to_lds(p, lds);
    const Epi5 E{p.ws, lc};
    const pg8::MoeOrder S{lc, 4, (int)gridDim.x, (int)blockIdx.x}; const pg8::AOffGather AO{p.ws, lc, D_ / 2};
    pg8::gemm_phase<Epi5, pg8::MoeOrder, pg8::AOffGather, true, true>((PG8_LAS unsigned char*)lds, (const bf16_t*)(p.ws + OFF_H8), (const bf16_t*)(p.ws + OFF_WGU), D_ / 2, S, AO, E);
}
__device__ __forceinline__ void phase6(const Params& p, unsigned char* lds) {
    PG8_LAS int* lc = moe_tables_to_lds(p, lds);
    const Epi6 E{p.ws, lc};
    const pg8::MoeOrder S{lc, 8, (int)gridDim.x, (int)blockIdx.x}; const pg8::AOffDirect AO{DE / 2};
    pg8::gemm_phase<Epi6, pg8::MoeOrder, pg8::AOffDirect, true, true>((PG8_LAS unsigned char*)lds, (const bf16_t*)(p.ws + OFF_B), (const bf16_t*)(p.ws + OFF_WD), DE / 2, S, AO, E);
}
__device__ __forceinline__ void phase7(const Params& p) {
    const int tid = opaque_tid(), wid = tid >> 6, lane = tid & 63;
    const bf16_t* hb = (const bf16_t*)(p.ws + OFF_HB); const unsigned char* ys2 = p.ws + OFF_A;
    for (int t = blockIdx.x * 8 + wid; t < T_; t += gridDim.x * 8) {
        float v[4][8]; float s = 0.f;
#pragma unroll
        for (int i = 0; i < 4; ++i) { const int c = i * 512 + lane * 8;
            const u32x4 a = *(const u32x4*)(hb + (size_t)t * D_ + c); const u32x2 b = *(const u32x2*)(ys2 + (size_t)(2 * t) * D_ + c), d = *(const u32x2*)(ys2 + (size_t)(2 * t + 1) * D_ + c);
            float y0[8], y1[8];
            up4_fp8(b.x, y0[0], y0[1], y0[2], y0[3]); up4_fp8(b.y, y0[4], y0[5], y0[6], y0[7]); up4_fp8(d.x, y1[0], y1[1], y1[2], y1[3]); up4_fp8(d.y, y1[4], y1[5], y1[6], y1[7]);
#pragma unroll
            for (int q = 0; q < 4; ++q) { v[i][2 * q] = bflo(a[q]) + (y0[2 * q] + y1[2 * q]) * (1.f / YS_SCALE); v[i][2 * q + 1] = bfhi(a[q]) + (y0[2 * q + 1] + y1[2 * q + 1]) * (1.f / YS_SCALE);
                s += v[i][2 * q] * v[i][2 * q] + v[i][2 * q + 1] * v[i][2 * q + 1]; } }
        const float rstd = rsqrtf(wave_sum(s) * (1.f / D_) + EPS);
#pragma unroll
        for (int i = 0; i < 4; ++i) { const int c = i * 512 + lane * 8;
            const f32x4 g0 = *(const f32x4*)(p.g_final + c), g1 = *(const f32x4*)(p.g_final + c + 4);
            f32x4 o0, o1;
#pragma unroll
            for (int q = 0; q < 4; ++q) { o0[q] = v[i][q] * rstd * g0[q]; o1[q] = v[i][4 + q] * rstd * g1[q]; }
            *(f32x4*)(p.out + (size_t)t * D_ + c) = o0; *(f32x4*)(p.out + (size_t)t * D_ + c + 4) = o1; }
    }
}

#ifndef ONE_LAUNCH
#define ONE_LAUNCH 1
#endif
template <int PH> __global__ void __launch_bounds__(NTHR, 2) k_phase(Params p) {
    extern __shared__ __attribute__((aligned(16))) unsigned char lds[];
    if (PH == 0) phase0(p, lds);
    if (PH == 1) phase1(p, lds);
    if (PH == 2) phase2(p, lds);
    if (PH == 3) phase3(p, lds);
    if (PH == 4) phase4(p, lds);
    if (PH == 5) phase5(p, lds);
    if (PH == 6) phase6(p, lds);
    if (PH == 7) phase7(p);
}
__global__ void __launch_bounds__(NTHR, 2) k_mega(Params p) {
    extern __shared__ __attribute__((aligned(16))) unsigned char lds[];
    cg::grid_group grid = cg::this_grid();
    volatile PG8_LAS unsigned* bst = (volatile PG8_LAS unsigned*)((PG8_LAS unsigned char*)lds + LBAR_OFF);
    if (threadIdx.x < 2) bst[threadIdx.x] = 0u;
    __syncthreads();
    (void)xcd_barrier_post((unsigned*)(p.ws + OFF_BAR), bst);
#define GRID_BAR() do { XcdBarrier b_; b_.bar = (unsigned*)(opaque_ws(p.ws) + OFF_BAR); b_.x = xb_xcc_id(); b_.st = bst; xcd_barrier(b_); } while (0)
    if (DUP_PHASE == 0) { phase0(p, lds); GRID_BAR(); }
    if (p.ws == nullptr) grid.sync();
    phase0(p, lds); GRID_BAR();
    if (DUP_PHASE == 1) { phase1(p, lds); GRID_BAR(); }
    phase1(p, lds); GRID_BAR();
    if (DUP_PHASE == 2) { phase2(p, lds, OFF_DUMMY - OFF_SSQ); GRID_BAR(); }
    phase2(p, lds); GRID_BAR();
    if (DUP_PHASE == 3) { phase3(p, lds, OFF_DUMMY - OFF_SSQ); GRID_BAR(); }
    phase3(p, lds); GRID_BAR();
    if (DUP_PHASE == 4) { phase4(p, lds, OFF_DUMMY - OFF_SSQ); GRID_BAR(); }
    phase4(p, lds); GRID_BAR();
    if (DUP_PHASE == 5) { phase5(p, lds); GRID_BAR(); }
    phase5(p, lds); GRID_BAR();
    if (DUP_PHASE == 6) { phase6(p, lds); GRID_BAR(); }
    phase6(p, lds); GRID_BAR();
    if (DUP_PHASE == 8) { for (int i = 0; i < 10; ++i) GRID_BAR(); }
    if (DUP_PHASE == 9) { grid.sync(); grid.sync(); }
    if (DUP_PHASE == 7) { phase7(p); GRID_BAR(); }
    phase7(p);
}

extern "C" void kernel_launch(void* const* d_in, const int* in_sizes, int n_in, void* d_out, int out_size, void* d_ws, size_t ws_size, hipStream_t stream) {
    static int grid = 0;
    if (grid == 0) {
        if (n_in != 19 || in_sizes[0] != T_ * D_ || out_size != T_ * D_ || ws_size < WS_END + (DUP_PHASE >= 2 && DUP_PHASE <= 4 ? DUMMY_BYTES : 0)) { fprintf(stderr, "kernel_launch: unexpected shapes (n_in %d, in0 %d, out %d, ws %zu < %zu); nothing launched\n", n_in, n_in > 0 ? in_sizes[0] : -1, out_size, ws_size, (size_t)WS_END); grid = -1; return; }
        int dev = 0, cus = 0, per_cu = 0;
        if (hipGetDevice(&dev) != hipSuccess || hipDeviceGetAttribute(&cus, hipDeviceAttributeMultiprocessorCount, dev) != hipSuccess) { grid = -1; return; }
#if ONE_LAUNCH
        if (hipFuncSetAttribute((const void*)k_mega, hipFuncAttributeMaxDynamicSharedMemorySize, LDS_BYTES) != hipSuccess) { fprintf(stderr, "kernel_launch: hipFuncSetAttribute failed\n"); grid = -1; return; }
        if (hipOccupancyMaxActiveBlocksPerMultiprocessor(&per_cu, (const void*)k_mega, NTHR, LDS_BYTES) != hipSuccess || per_cu < 1) { fprintf(stderr, "kernel_launch: occupancy query says %d blocks per CU\n", per_cu); grid = -1; return; }
        grid = cus * per_cu;
#else
        (void)hipFuncSetAttribute((const void*)k_phase<0>, hipFuncAttributeMaxDynamicSharedMemorySize, LDS_BYTES);
        (void)hipFuncSetAttribute((const void*)k_phase<1>, hipFuncAttributeMaxDynamicSharedMemorySize, LDS_BYTES);
        (void)hipFuncSetAttribute((const void*)k_phase<2>, hipFuncAttributeMaxDynamicSharedMemorySize, LDS_BYTES);
        (void)hipFuncSetAttribute((const void*)k_phase<3>, hipFuncAttributeMaxDynamicSharedMemorySize, LDS_BYTES);
        (void)hipFuncSetAttribute((const void*)k_phase<4>, hipFuncAttributeMaxDynamicSharedMemorySize, LDS_BYTES);
        (void)hipFuncSetAttribute((const void*)k_phase<5>, hipFuncAttributeMaxDynamicSharedMemorySize, LDS_BYTES);
        (void)hipFuncSetAttribute((const void*)k_phase<6>, hipFuncAttributeMaxDynamicSharedMemorySize, LDS_BYTES);
        (void)hipFuncSetAttribute((const void*)k_phase<7>, hipFuncAttributeMaxDynamicSharedMemorySize, LDS_BYTES);
        grid = cus > 0 ? cus : 256;
#endif
    }
    if (grid < 0) return;
    Params p{};
    const float** f = (const float**)&p;
    for (int i = 0; i < 19; ++i) f[i] = (const float*)d_in[i];
    p.out = (float*)d_out; p.ws = (unsigned char*)d_ws;
#if ONE_LAUNCH
    if (hipMemsetAsync((unsigned char*)d_ws + OFF_BAR, 0, BAR_BYTES, stream) != hipSuccess) { fprintf(stderr, "kernel_launch: memset of the barrier words failed\n"); return; }
    void* args[] = {&p};
    const hipError_t e = hipLaunchCooperativeKernel((const void*)k_mega, dim3(grid), dim3(NTHR), args, LDS_BYTES, stream);
    if (e != hipSuccess) fprintf(stderr, "kernel_launch: cooperative launch failed: %s (grid %d)\n", hipGetErrorString(e), grid);
#else
    hipLaunchKernelGGL(k_phase<0>, dim3(grid), dim3(NTHR), LDS_BYTES, stream, p);
    hipLaunchKernelGGL(k_phase<1>, dim3(grid), dim3(NTHR), LDS_BYTES, stream, p);
    hipLaunchKernelGGL(k_phase<2>, dim3(grid), dim3(NTHR), LDS_BYTES, stream, p);
    hipLaunchKernelGGL(k_phase<3>, dim3(grid), dim3(NTHR), LDS_BYTES, stream, p);
    hipLaunchKernelGGL(k_phase<4>, dim3(grid), dim3(NTHR), LDS_BYTES, stream, p);
    hipLaunchKernelGGL(k_phase<5>, dim3(grid), dim3(NTHR), LDS_BYTES, stream, p);
    hipLaunchKernelGGL(k_phase<6>, dim3(grid), dim3(NTHR), LDS_BYTES, stream, p);
    hipLaunchKernelGGL(k_phase<7>, dim3(grid), dim3(NTHR), LDS_BYTES, stream, p);
#endif
}
```

```cpp
#include <hip/hip_runtime.h>
#include <hip/hip_cooperative_groups.h>
#include <cstdio>
namespace cg = cooperative_groups;

typedef unsigned short bf16_t;
typedef float f32x4 __attribute__((ext_vector_type(4)));
typedef unsigned u32x4 __attribute__((ext_vector_type(4)));
typedef unsigned u32x2 __attribute__((ext_vector_type(2)));
typedef short bf16x8 __attribute__((ext_vector_type(8)));
typedef int v4i __attribute__((ext_vector_type(4)));
typedef int v8i __attribute__((ext_vector_type(8)));

constexpr int T_ = 16384, D_ = 2048, DIN = 5120, NE = 32, DE = 512, SEQ = 4096, LCAP = 16384;
constexpr float EPS = 1e-6f;
#ifndef DUP_PHASE
#define DUP_PHASE -1
#endif
constexpr int NTHR = 512;
constexpr int LDS_BYTES = 163840;
constexpr int LCNT_OFF = 131072, LBAR_OFF = 131072 + 2048, XS_OFF = 131072 + 4096, XM_OFF = XS_OFF + 8192;
static_assert(XM_OFF + 512 * 32 <= LDS_BYTES, "LDS map");

constexpr size_t SZ_A = (size_t)T_ * DIN * 2;
constexpr size_t SZ_B = (size_t)T_ * D_ * 2;
constexpr size_t OFF_A = 0;
constexpr size_t OFF_B = OFF_A + SZ_A;
constexpr size_t OFF_HB = OFF_B + SZ_B;
constexpr size_t OFF_H8 = OFF_A + (size_t)2 * T_ * D_ * 2;
constexpr float WGU_SCALE = 32.f, WD_SCALE = 16.f, YS_SCALE = 16.f;
constexpr size_t OFF_WIN = OFF_HB + SZ_B;
constexpr size_t OFF_WOUT = OFF_WIN + (size_t)DIN * D_ * 2;
constexpr size_t OFF_WGU = OFF_WOUT + (size_t)D_ * D_ * 2;
constexpr size_t OFF_WD = OFF_WGU + (size_t)NE * 1024 * D_ * 2;
constexpr size_t OFF_WR = OFF_WD + (size_t)NE * D_ * DE * 2;
constexpr size_t OFF_SSQ = OFF_WR + (size_t)48 * D_ * 2;
constexpr size_t OFF_CNT = OFF_SSQ + (size_t)3 * T_ * 4;
constexpr size_t OFF_RINFO = OFF_CNT + 256;
constexpr size_t OFF_RW = OFF_RINFO + (size_t)NE * LCAP * 4;
constexpr size_t OFF_BAR = OFF_RW + (size_t)NE * LCAP * 4;
constexpr size_t BAR_BYTES = 16384;
constexpr size_t WS_END = OFF_BAR + BAR_BYTES;
constexpr size_t OFF_DUMMY = WS_END;
constexpr size_t DUMMY_BYTES = (OFF_BAR - OFF_SSQ);

struct Params {
    const float *x, *norm_mix_g, *w_in, *v_norm_g, *gmlp_ws, *gmlp_bs, *conv_w, *g_a, *g_b, *w_out, *g_ffn, *rgw, *rgb, *rew, *reb, *ewg, *ewu, *ewd, *g_final;
    float* out; unsigned char* ws;
};

__device__ __forceinline__ unsigned cvt_pk_bf16(float lo, float hi) { unsigned r; asm volatile("v_cvt_pk_bf16_f32 %0, %1, %2" : "=v"(r) : "v"(lo), "v"(hi)); return r; }
#define GAS __attribute__((address_space(1)))
typedef GAS unsigned char gbyte;
__device__ __forceinline__ gbyte* opaque_ws(unsigned char* w) { gbyte* g = (gbyte*)w; asm volatile("" : "+s"(g)); return g; }
__device__ __forceinline__ int opaque_tid() { int t = threadIdx.x; asm volatile("" : "+v"(t)); return t; }
__device__ __forceinline__ unsigned pk4_fp8(float a, float b, float c, float d) { int w = 0; w = __builtin_amdgcn_cvt_pk_fp8_f32(a, b, w, false); w = __builtin_amdgcn_cvt_pk_fp8_f32(c, d, w, true); return (unsigned)w; }
__device__ __forceinline__ void up4_fp8(unsigned w, float& a, float& b, float& c, float& d) {
    const auto lo = __builtin_amdgcn_cvt_pk_f32_fp8((int)w, false), hi = __builtin_amdgcn_cvt_pk_f32_fp8((int)w, true); a = lo[0]; b = lo[1]; c = hi[0]; d = hi[1]; }
__device__ __forceinline__ float bflo(unsigned w) { return __uint_as_float(w << 16); }
__device__ __forceinline__ float bfhi(unsigned w) { return __uint_as_float(w & 0xffff0000u); }
__device__ __forceinline__ float wave_sum(float v) {
#pragma unroll
    for (int o = 1; o < 64; o <<= 1) v += __shfl_xor(v, o);
    return v;
}
__device__ __forceinline__ float gelu_t(float x) {
    const float u = x * (0.7978845608f + 0.0356774081f * x * x);
    return x * __builtin_amdgcn_rcpf(1.f + __builtin_amdgcn_exp2f(-2.885390082f * u));
}
__device__ __forceinline__ float silu_f(float x) { return x * __builtin_amdgcn_rcpf(1.f + __builtin_amdgcn_exp2f(-1.442695041f * x)); }

#define PG8_LAS __attribute__((address_space(3)))
struct Unit { int pm, pn, e, r0, pnl; };

constexpr int MT_CNT = 0, MT_PST = 32, MT_NT = 65, MT_T2E = 66, MT_WORDS = 66 + 192;
typedef const PG8_LAS int* lcnt_t;
__device__ __forceinline__ bool moe_unit(lcnt_t tb, int NT, int L, Unit& u) {
    const int pt = L / NT;
    if (pt >= __builtin_amdgcn_readfirstlane(tb[MT_NT])) return false;
    const int e = __builtin_amdgcn_readfirstlane(tb[MT_T2E + pt]), mt = pt - __builtin_amdgcn_readfirstlane(tb[MT_PST + e]), j = L - pt * NT;
    u.e = e; u.pm = pt; u.r0 = mt * 256; u.pnl = j; u.pn = e * NT + j; return true;
}

struct NoMeta {};
struct Meta8 { u32x4 lo, hi; };
struct Epi1 {
    static constexpr bool PERM = true, MIDSCALE = false;
    typedef NoMeta Meta;
    unsigned char* ws;
    __device__ __forceinline__ Meta meta_load(const Unit&, int, int) const { return Meta{}; }
    __device__ __forceinline__ void operator()(f32x4 (&acc)[2][2][4][2], const Unit& u, int wr, int wc, int fr, int fq, const Meta&) const {
        GAS bf16_t* P = (GAS bf16_t*)(opaque_ws(ws) + OFF_A);
        const bool act = u.pn < 8;
#pragma unroll
        for (int ai = 0; ai < 2; ++ai)
#pragma unroll
            for (int m = 0; m < 4; ++m) {
                const int row = u.pm * 256 + ai * 128 + wr * 64 + m * 16 + fr;
                GAS bf16_t* rowp = P + (size_t)row * DIN + u.pn * 256 + wc * 32 + 8 * fq;
#pragma unroll
                for (int bj = 0; bj < 2; ++bj) {
                    f32x4 v0 = acc[ai][bj][m][0], v1 = acc[ai][bj][m][1];
                    if (act) {
#pragma unroll
                        for (int j = 0; j < 4; ++j) { v0[j] = gelu_t(v0[j]); v1[j] = gelu_t(v1[j]); }
                    }
                    u32x4 w; w.x = cvt_pk_bf16(v0[0], v0[1]); w.y = cvt_pk_bf16(v0[2], v0[3]); w.z = cvt_pk_bf16(v1[0], v1[1]); w.w = cvt_pk_bf16(v1[2], v1[3]);
                    *(GAS u32x4*)(rowp + bj * 128) = w;
                }
            }
    }
};
struct Epi2 {
    static constexpr bool PERM = true, MIDSCALE = true;
    const float* x; unsigned char* ws; size_t so;
    __device__ __forceinline__ void midscale(f32x4 (&acc)[2][2][4][2], const Unit& u, int wr, int wc, int fr, int fq) const {
        int rowb = u.pm * 256 + wr * 64 + fr; asm volatile("" : "+v"(rowb));
        const GAS float* ssq_a = (const GAS float*)(opaque_ws(ws) + OFF_SSQ);
        const GAS float* pa = ssq_a + rowb; const GAS float* pb = ssq_a + T_ + rowb;
#pragma unroll
        for (int ai = 0; ai < 2; ++ai)
#pragma unroll
            for (int m = 0; m < 4; ++m) {
                const float s = __builtin_amdgcn_sqrtf((pb[ai * 128 + m * 16] * (1.f / 1024.f) + EPS) * __builtin_amdgcn_rcpf(pa[ai * 128 + m * 16] * (1.f / 1024.f) + EPS));
#pragma unroll
                for (int bj = 0; bj < 2; ++bj)
#pragma unroll
                    for (int n = 0; n < 2; ++n) acc[ai][bj][m][n] *= s;
                if (m & 1) asm volatile("" ::: "memory");
            }
    }
    typedef NoMeta Meta;
    __device__ __forceinline__ Meta meta_load(const Unit&, int, int) const { return Meta{}; }
    __device__ __forceinline__ void operator()(f32x4 (&acc)[2][2][4][2], const Unit& u, int wr, int wc, int fr, int fq, const Meta&) const {
        gbyte* w_ = opaque_ws(ws);
        GAS bf16_t* hb = (GAS bf16_t*)(w_ + OFF_HB); gbyte* h8 = w_ + OFF_H8; const GAS float* ssq_b = (const GAS float*)(w_ + OFF_SSQ) + T_; float* ssq_h = (float*)(ws + OFF_SSQ + so) + 2 * T_;
#pragma unroll
        for (int ai = 0; ai < 2; ++ai)
#pragma unroll
            for (int m = 0; m < 4; ++m) {
                const int row = u.pm * 256 + ai * 128 + wr * 64 + m * 16 + fr;
                const float rb = rsqrtf(ssq_b[row] * (1.f / 1024.f) + EPS);
                const size_t off = (size_t)row * D_ + u.pn * 256 + wc * 32 + 8 * fq;
                float ss = 0.f;
#pragma unroll
                for (int bj = 0; bj < 2; ++bj) {
                    const f32x4 x0 = *(const f32x4*)(x + off + bj * 128), x1 = *(const f32x4*)(x + off + bj * 128 + 4);
                    const f32x4 h0 = x0 + acc[ai][bj][m][0] * rb, h1 = x1 + acc[ai][bj][m][1] * rb;
                    ss += (h0[0] * h0[0] + h0[1] * h0[1]) + (h0[2] * h0[2] + h0[3] * h0[3]) + (h1[0] * h1[0] + h1[1] * h1[1]) + (h1[2] * h1[2] + h1[3] * h1[3]);
                    u32x4 w; w.x = cvt_pk_bf16(h0[0], h0[1]); w.y = cvt_pk_bf16(h0[2], h0[3]); w.z = cvt_pk_bf16(h1[0], h1[1]); w.w = cvt_pk_bf16(h1[2], h1[3]);
                    *(GAS u32x4*)(hb + off + bj * 128) = w;
                    u32x2 w8; w8.x = pk4_fp8(h0[0], h0[1], h0[2], h0[3]); w8.y = pk4_fp8(h1[0], h1[1], h1[2], h1[3]);
                    *(GAS u32x2*)(h8 + off + bj * 128) = w8;
                }
                ss += __shfl_xor(ss, 16); ss += __shfl_xor(ss, 32);
                if (fq == 0) atomicAdd(ssq_h + row, ss);
                if (m == 3) asm volatile("" ::: "memory");
            }
    }
};
struct Epi5 {
    static constexpr bool PERM = true, MIDSCALE = false;
    typedef Meta8 Meta;
    unsigned char* ws; lcnt_t cnt;
    __device__ __forceinline__ Meta meta_load(const Unit& u, int wr, int fr) const {
        const GAS unsigned* rrs = (const GAS unsigned*)(opaque_ws(ws) + OFF_RW) + u.e * LCAP; const int ce = __builtin_amdgcn_readfirstlane(cnt[u.e]); Meta mt;
#pragma unroll
        for (int q = 0; q < 4; ++q) { const int i0 = u.r0 + wr * 64 + q * 16 + fr, i1 = i0 + 128;
            const unsigned a = rrs[min(i0, ce - 1)], b = rrs[min(i1, ce - 1)]; mt.lo[q] = (i0 < ce) ? a : 0u; mt.hi[q] = (i1 < ce) ? b : 0u; }
        return mt;
    }
    __device__ __forceinline__ void operator()(f32x4 (&acc)[2][2][4][2], const Unit& u, int wr, int wc, int fr, int fq, const Meta& mt) const {
        gbyte* hbuf = opaque_ws(ws) + OFF_B;
#pragma unroll
        for (int ai = 0; ai < 2; ++ai)
#pragma unroll
            for (int m = 0; m < 4; ++m) {
                const int r = ai * 128 + wr * 64 + m * 16 + fr;
                const float rs = __uint_as_float(ai ? mt.hi[m] : mt.lo[m]);
                float o[8];
#pragma unroll
                for (int n = 0; n < 2; ++n)
#pragma unroll
                    for (int j = 0; j < 4; ++j) o[4 * n + j] = silu_f(acc[ai][0][m][n][j] * rs) * (acc[ai][1][m][n][j] * rs);
                u32x2 w; w.x = pk4_fp8(o[0], o[1], o[2], o[3]); w.y = pk4_fp8(o[4], o[5], o[6], o[7]);
                *(GAS u32x2*)(hbuf + (size_t)(u.pm * 256 + r) * DE + u.pnl * 128 + wc * 32 + 8 * fq) = w;
                if (m & 1) asm volatile("" ::: "memory");
            }
    }
};
struct Epi6 {
    static constexpr bool PERM = true, MIDSCALE = false;
    typedef Meta8 Meta;
    unsigned char* ws; lcnt_t cnt;
    __device__ __forceinline__ Meta meta_load(const Unit& u, int wr, int fr) const {
        const GAS unsigned* rpk = (const GAS unsigned*)(opaque_ws(ws) + OFF_RINFO) + u.e * LCAP; const int ce = __builtin_amdgcn_readfirstlane(cnt[u.e]); Meta mt;
#pragma unroll
        for (int q = 0; q < 4; ++q) { const int i0 = u.r0 + wr * 64 + q * 16 + fr, i1 = i0 + 128;
            const unsigned a = rpk[min(i0, ce - 1)], b = rpk[min(i1, ce - 1)]; mt.lo[q] = (i0 < ce) ? a : 0xFFFFFFFFu; mt.hi[q] = (i1 < ce) ? b : 0xFFFFFFFFu; }
        return mt;
    }
    __device__ __forceinline__ void operator()(f32x4 (&acc)[2][2][4][2], const Unit& u, int wr, int wc, int fr, int fq, const Meta& mt) const {
        gbyte* ys2 = opaque_ws(ws) + OFF_A;
#pragma unroll
        for (int ai = 0; ai < 2; ++ai)
#pragma unroll
            for (int m = 0; m < 4; ++m) {
                const unsigned pk = ai ? mt.hi[m] : mt.lo[m]; const unsigned info = pk & 0xFFFFu;
                if (info < 2u * T_) {
                    const float g = __uint_as_float(pk & 0xFFFF0000u) * (YS_SCALE / WD_SCALE);
                    gbyte* dst = ys2 + (size_t)info * D_ + u.pnl * 256 + wc * 32 + 8 * fq;
#pragma unroll
                    for (int bj = 0; bj < 2; ++bj) {
                        const f32x4 v0 = acc[ai][bj][m][0] * g, v1 = acc[ai][bj][m][1] * g;
                        u32x2 w; w.x = pk4_fp8(v0[0], v0[1], v0[2], v0[3]); w.y = pk4_fp8(v1[0], v1[1], v1[2], v1[3]);
                        *(GAS u32x2*)(dst + bj * 128) = w;
                    }
                }
            }
    }
};

namespace pg8 {
constexpr int BM = 256, BK = 64, HALF = 128, HTB = HALF * BK * 2, STAGE_BYTES = 8 * HTB, NXCD = 8, WGM = 8;
__host__ __device__ __forceinline__ int lds_byte(int r, int c) { const int st = (r >> 4) * 2 + (c >> 5), rr = r & 15, cc = c & 31, ob = rr * 64 + cc * 2; return st * 1024 + (ob ^ (((ob >> 9) & 1) << 5)); }
__host__ __device__ __forceinline__ void stage_rc(int b, int& R, int& C) { const int st = b / 1024, sb = b % 1024, swz = sb ^ (((sb >> 9) & 1) << 5); R = (st >> 1) * 16 + swz / 64; C = (st & 1) * 32 + (swz % 64) / 2; }
__host__ __device__ __forceinline__ int perm32(int rho) { const int n = rho >> 4, i = rho & 15; return 8 * (i >> 2) + 4 * n + (i & 3); }

struct StaticOrder {
    int nM, nN, nwg, G, c;
    __device__ void init(int M, int N, int G_, int c_) { nM = M / BM; nN = N / BM; nwg = nM * nN; G = G_; c = c_; }
    __device__ bool next(int i, Unit& u) const {
        const long L = (long)i * G + c; if (L >= nwg) return false;
        int wgid = (int)L; { const int q = nwg / NXCD, r = nwg % NXCD, xcd = wgid % NXCD, off = wgid / NXCD; wgid = (xcd < r ? xcd * (q + 1) : r * (q + 1) + (xcd - r) * q) + off; }
        const int nig = WGM * nN, gid = wgid / nig, fm = gid * WGM, gsz = (nM - fm) < WGM ? (nM - fm) : WGM;
        u.pm = fm + ((wgid % nig) % gsz); u.pn = (wgid % nig) / gsz; u.e = 0; u.r0 = 0; u.pnl = u.pn; return true;
    }
};
struct MoeOrder {
    lcnt_t cnt; int NT, G, c;
    __device__ __forceinline__ bool next(int i, Unit& u) const { return moe_unit(cnt, NT, i * G + c, u); }
};
struct AOffDirect { int K; struct Pre {};
    __device__ __forceinline__ Pre pre(const Unit&, int, int) const { return Pre{}; }
    __device__ __forceinline__ unsigned fin(const Pre&, const Unit& u, int h, int i, int R, int C) const { return (unsigned)(((u.pm * 256 + h * 128 + R) * K + C) * 2); } };
struct AOffGather { unsigned char* ws; lcnt_t cnt; int K;
    struct Pre { unsigned pk[2][2]; };
    __device__ __forceinline__ Pre pre(const Unit& u, int R0, int R1) const {
        const GAS unsigned* rpk = (const GAS unsigned*)(opaque_ws(ws) + OFF_RINFO) + u.e * LCAP; const int ce = __builtin_amdgcn_readfirstlane(cnt[u.e]); Pre p;
#pragma unroll
        for (int h = 0; h < 2; ++h) { const int i0 = u.r0 + h * 128 + R0, i1 = u.r0 + h * 128 + R1;
            p.pk[h][0] = rpk[min(i0, ce - 1)]; p.pk[h][1] = rpk[min(i1, ce - 1)]; }
        return p;
    }
    __device__ __forceinline__ unsigned fin(const Pre& p, const Unit&, int h, int i, int, int C) const { const int tok = (int)((p.pk[h][i] & 0xFFFFu) >> 1); return (unsigned)((tok * K + C) * 2); } };

template <class Epi, class Sched, class AOff, bool ALIGN_EPI, bool FP8 = false>
__device__ __forceinline__ void gemm_phase(PG8_LAS unsigned char* lds, const bf16_t* Ag, const bf16_t* Btg, const int K, const Sched& S, const AOff& AO, const Epi& E) {
    const int tid = opaque_tid(), wid = __builtin_amdgcn_readfirstlane(tid >> 6), lane = tid & 63, wr = wid >> 2, wc = wid & 3, fr = lane & 15, fq = lane >> 4;
    int nt = K / BK; asm volatile("" : "+s"(nt));
    unsigned voffB[2];
#pragma unroll
    for (int i = 0; i < 2; ++i) { int R, C; stage_rc(tid * 16 + i * 8192, R, C); const int Rb = Epi::PERM ? ((R & ~31) + perm32(R & 31)) : R; voffB[i] = (unsigned)(Rb * K + C) * 2u; }
#define PG8_APRE(u, pv_) do { int _t = tid; asm volatile("" : "+v"(_t)); int _R0, _R1, _C; stage_rc(_t * 16, _R0, _C); stage_rc(_t * 16 + 8192, _R1, _C); pv_ = AO.pre(u, _R0, _R1); } while (0)
#define PG8_AFIN(u, pv_, d0, d1) do { int _t = tid; asm volatile("" : "+v"(_t)); _Pragma("unroll") for (int _i = 0; _i < 2; ++_i) { int _R, _C; stage_rc(_t * 16 + _i * 8192, _R, _C); d0[_i] = AO.fin(pv_, u, 0, _i, _R, _C); d1[_i] = AO.fin(pv_, u, 1, _i, _R, _C); } } while (0)
#define PG8_LANE(fr_, fq_) int fr_, fq_; { int _t = tid; asm volatile("" : "+v"(_t)); fr_ = _t & 15; fq_ = (_t & 63) >> 4; }
    const unsigned kstep = (unsigned)(BK * 2), hstep = (unsigned)HALF * (unsigned)K * 2u, tstep = 2u * hstep;
    const unsigned ldsw = (unsigned)wid * 1024u;
    const int aoff = lds_byte(wr * 64 + fr, fq * 8), boff = lds_byte(wc * 32 + fr, fq * 8);
    const char* const Ab = (const char*)Ag; const char* const Bb = (const char*)Btg;
#define PG8_SA(b, h) (((b) * 2 + (h)) * HTB)
#define PG8_SB(b, h) ((4 + (b) * 2 + (h)) * HTB)
#define PG8_STAGE(bufoff, gbase, uoff, voff) do { _Pragma("unroll") for (int _i = 0; _i < 2; ++_i) \
        __builtin_amdgcn_global_load_lds((const unsigned*)((gbase) + (size_t)(unsigned)((uoff) + (voff)[_i])), (PG8_LAS unsigned*)(lds + (bufoff) + ldsw + _i * 8192), 16, 0, 0); } while (0)
#define PG8_LD32(base) __builtin_shufflevector(*(const PG8_LAS v4i*)(base), *(const PG8_LAS v4i*)((base) + 1024), 0, 1, 2, 3, 4, 5, 6, 7)
#define PG8_LDA(dst, b, h) do { _Pragma("unroll") for (int m = 0; m < 4; ++m) dst[m] = PG8_LD32(lds + PG8_SA(b, h) + aoff + m * 2048); } while (0)
#define PG8_LDB(dst, b, h) do { _Pragma("unroll") for (int n = 0; n < 2; ++n) dst[n] = PG8_LD32(lds + PG8_SB(b, h) + boff + n * 2048); } while (0)
#define PG8_LO(x) __builtin_bit_cast(bf16x8, __builtin_shufflevector((x), (x), 0, 1, 2, 3))
#define PG8_HI(x) __builtin_bit_cast(bf16x8, __builtin_shufflevector((x), (x), 4, 5, 6, 7))
#define PG8_MMA(ai, bj, At, Bt) do { __builtin_amdgcn_s_setprio(1); _Pragma("unroll") for (int m = 0; m < 4; ++m) _Pragma("unroll") for (int n = 0; n < 2; ++n) { \
        if constexpr (FP8) acc[ai][bj][m][n] = __builtin_amdgcn_mfma_scale_f32_16x16x128_f8f6f4(Bt[n], At[m], acc[ai][bj][m][n], 0, 0, 0, 0, 0, 0);   \
        else { acc[ai][bj][m][n] = __builtin_amdgcn_mfma_f32_16x16x32_bf16(PG8_LO(Bt[n]), PG8_LO(At[m]), acc[ai][bj][m][n], 0, 0, 0); \
               acc[ai][bj][m][n] = __builtin_amdgcn_mfma_f32_16x16x32_bf16(PG8_HI(Bt[n]), PG8_HI(At[m]), acc[ai][bj][m][n], 0, 0, 0); } } \
        __builtin_amdgcn_s_setprio(0); } while (0)
#define PG8_WAIT_V(n) asm volatile("s_waitcnt vmcnt(" #n ")" ::: "memory")
#define PG8_WAIT_L(n) asm volatile("s_waitcnt lgkmcnt(" #n ")" ::: "memory")
#define PG8_BAR __builtin_amdgcn_s_barrier()
#define PG8_SCHED __builtin_amdgcn_sched_barrier(0)
    Unit cur, nxt; int ui = 0;
    if (!S.next(0, cur)) return;
    f32x4 acc[2][2][4][2];
#pragma unroll
    for (int a = 0; a < 2; ++a)
#pragma unroll
        for (int b = 0; b < 2; ++b)
#pragma unroll
            for (int m = 0; m < 4; ++m)
#pragma unroll
                for (int n = 0; n < 2; ++n) acc[a][b][m][n] = (f32x4){0.f, 0.f, 0.f, 0.f};
    v8i At[4], B0[2], B1[2];
    unsigned vo0[2], vo1[2];
    PG8_LAS u32x4* const svn = (PG8_LAS u32x4*)(lds + XS_OFF) + tid;
    PG8_LAS u32x4* const smeta = (PG8_LAS u32x4*)(lds + XM_OFF + tid * 32);
    constexpr bool HAS_META = sizeof(typename Epi::Meta) > 1;
    bool has_next = S.next(1, nxt);
    { typename AOff::Pre pc; PG8_APRE(cur, pc); PG8_AFIN(cur, pc, vo0, vo1);
      unsigned vn0[2], vn1[2];
      if (has_next) { typename AOff::Pre pn; PG8_APRE(nxt, pn); PG8_AFIN(nxt, pn, vn0, vn1); } else { vn0[0] = vo0[0]; vn0[1] = vo0[1]; vn1[0] = vo1[0]; vn1[1] = vo1[1]; }
      *svn = (u32x4){vn0[0], vn0[1], vn1[0], vn1[1]}; }
    if constexpr (HAS_META) { PG8_LANE(fr_, fq_); (void)fq_; const typename Epi::Meta m0 = E.meta_load(cur, wr, fr_); smeta[0] = m0.lo; smeta[1] = m0.hi; }
    unsigned cB = (unsigned)cur.pn * tstep;
    PG8_STAGE(PG8_SB(0, 0), Bb, cB, voffB); PG8_STAGE(PG8_SB(0, 1), Bb, cB + hstep, voffB); PG8_STAGE(PG8_SA(0, 0), Ab, 0u, vo0); PG8_STAGE(PG8_SA(0, 1), Ab, 0u, vo1);
    if (wr == 1) PG8_BAR;
    PG8_WAIT_V(2); PG8_BAR;
    PG8_STAGE(PG8_SB(1, 0), Bb, cB + kstep, voffB); PG8_STAGE(PG8_SA(1, 0), Ab, kstep, vo0); PG8_STAGE(PG8_SB(1, 1), Bb, cB + hstep + kstep, voffB);
    PG8_WAIT_V(6); PG8_BAR;
    for (;;) {
        const unsigned nB = has_next ? (unsigned)nxt.pn * tstep : cB;
#pragma clang loop unroll(disable)
        for (int t = 0; t < nt; t += 2) {
            const bool last = (t == nt - 2);
            if constexpr (Epi::MIDSCALE) { if (t == nt / 2) { PG8_LANE(fr_, fq_); E.midscale(acc, cur, wr, wc, fr_, fq_); } }
            const unsigned k1 = (unsigned)(t + 1) * kstep, k2 = last ? 0u : (unsigned)(t + 2) * kstep, k3 = k2 + kstep;
            const unsigned b2 = last ? nB : cB + (unsigned)(t + 2) * kstep, b3 = b2 + kstep;
            PG8_LDB(B0, 0, 0); PG8_LDB(B1, 0, 1); PG8_SCHED; PG8_LDA(At, 0, 0); PG8_STAGE(PG8_SA(1, 1), Ab, k1, vo1);
            PG8_WAIT_V(8); PG8_WAIT_L(0); PG8_BAR; PG8_MMA(0, 0, At, B0); PG8_MMA(0, 1, At, B1); PG8_BAR; PG8_SCHED;
            if (last) { PG8_LAS u32x4* sp_ = svn; asm volatile("" : "+v"(sp_));
                const u32x4 v = *sp_; vo0[0] = v.x; vo0[1] = v.y; vo1[0] = v.z; vo1[1] = v.w; }
            PG8_LDA(At, 0, 1); PG8_STAGE(PG8_SB(0, 0), Bb, b2, voffB); PG8_STAGE(PG8_SB(0, 1), Bb, b2 + hstep, voffB); PG8_STAGE(PG8_SA(0, 0), Ab, k2, vo0);
            PG8_WAIT_V(8); PG8_WAIT_L(0); PG8_BAR; PG8_MMA(1, 0, At, B0); PG8_MMA(1, 1, At, B1); PG8_BAR; PG8_SCHED;
            PG8_LDB(B0, 1, 0); PG8_LDB(B1, 1, 1); PG8_SCHED; PG8_LDA(At, 1, 0); PG8_STAGE(PG8_SA(0, 1), Ab, k2, vo1);
            PG8_WAIT_V(8); PG8_WAIT_L(0); PG8_BAR; PG8_MMA(0, 0, At, B0); PG8_MMA(0, 1, At, B1); PG8_BAR; PG8_SCHED;
            PG8_LDA(At, 1, 1); PG8_STAGE(PG8_SB(1, 0), Bb, b3, voffB); PG8_STAGE(PG8_SB(1, 1), Bb, b3 + hstep, voffB); PG8_STAGE(PG8_SA(1, 0), Ab, k3, vo0);
            PG8_WAIT_V(8); PG8_WAIT_L(0); PG8_BAR; PG8_MMA(1, 0, At, B0); PG8_MMA(1, 1, At, B1); PG8_BAR; PG8_SCHED;
        }
        if constexpr (ALIGN_EPI) { if (wr == 0) PG8_BAR; }
        Unit nn; const bool has2 = has_next && S.next(ui + 2, nn);
        typename Epi::Meta mnext;
        { PG8_LANE(fr_, fq_);
          typename Epi::Meta meta; if constexpr (HAS_META) { PG8_LAS u32x4* sp_ = smeta; asm volatile("" : "+v"(sp_)); meta.lo = sp_[0]; meta.hi = sp_[1]; }
          if (has_next) mnext = E.meta_load(nxt, wr, fr_);
          if (has2) { typename AOff::Pre pnn; PG8_APRE(nn, pnn); unsigned vn0[2], vn1[2]; PG8_AFIN(nn, pnn, vn0, vn1); *svn = (u32x4){vn0[0], vn0[1], vn1[0], vn1[1]}; }
          E(acc, cur, wr, wc, fr_, fq_, meta); }
        if (!has_next) break;
        if constexpr (HAS_META) { smeta[0] = mnext.lo; smeta[1] = mnext.hi; }
#pragma unroll
        for (int a = 0; a < 2; ++a)
#pragma unroll
            for (int b = 0; b < 2; ++b)
#pragma unroll
                for (int m = 0; m < 4; ++m)
#pragma unroll
                    for (int n = 0; n < 2; ++n) acc[a][b][m][n] = (f32x4){0.f, 0.f, 0.f, 0.f};
        cur = nxt; nxt = nn; has_next = has2; cB = nB; ++ui;
        if constexpr (ALIGN_EPI) { if (wr == 1) PG8_BAR; }
    }
    PG8_WAIT_V(0);
    if constexpr (!ALIGN_EPI) { if (wr == 0) PG8_BAR; }
    PG8_BAR;
#undef PG8_APRE
#undef PG8_AFIN
#undef PG8_LANE
#undef PG8_SA
#undef PG8_SB
#undef PG8_STAGE
#undef PG8_LDA
#undef PG8_LDB
#undef PG8_MMA
#undef PG8_LO
#undef PG8_HI
#undef PG8_LD32
#undef PG8_WAIT_V
#undef PG8_WAIT_L
#undef PG8_BAR
#undef PG8_SCHED
}
}


#define XB_TMO      128
#define XB_XCNT(j)  (256  + 64 * (j))
#define XB_XSUB(j)  (1280 + 64 * (j))
#define XB_XGEN(j)  (2304 + 64 * (j))
#define XB_TOP      3328
#define XB_TOPGEN   3392
#define XCD_BAR_WORDS 3456
#define XB_SPIN_CAP (1u << 18)
__device__ __forceinline__ unsigned xb_ld(unsigned* p)              { return __hip_atomic_load(p, __ATOMIC_RELAXED, __HIP_MEMORY_SCOPE_AGENT); }
__device__ __forceinline__ unsigned xb_add(unsigned* p, unsigned v) { return __hip_atomic_fetch_add(p, v, __ATOMIC_RELAXED, __HIP_MEMORY_SCOPE_AGENT); }
__device__ __forceinline__ unsigned xb_xcc_id() { return (unsigned)__builtin_amdgcn_s_getreg((3 << 11) | 20) & 0xFu; }
#define XB_SPIN(cond, bar) do { unsigned _sp = 0; while (cond) { __builtin_amdgcn_s_sleep(1); \
    if ((++_sp & 255u) == 0u) { if (xb_ld(&(bar)[XB_TMO])) break; if (_sp > XB_SPIN_CAP) { atomicAdd(&(bar)[XB_TMO], 1u); break; } } } } while (0)
struct XcdBarrier { unsigned* bar; unsigned x; volatile PG8_LAS unsigned* st; };
__device__ __forceinline__ XcdBarrier xcd_barrier_post(unsigned* bar, volatile PG8_LAS unsigned* st) {
    XcdBarrier b; b.bar = bar; b.x = xb_xcc_id(); b.st = st;
    if (threadIdx.x == 0) (void)xb_add(&bar[XB_XCNT(b.x)], 1u);
    return b;
}
__device__ __forceinline__ void xcd_barrier_complete(unsigned* bar, unsigned x, unsigned& nloc, unsigned& nx) {
    const unsigned G = gridDim.x * gridDim.y * gridDim.z;
    unsigned sum, cnt, mine, sp = 0u;
    for (;;) {
        sum = 0u; cnt = 0u; mine = 0u;
#pragma unroll
        for (unsigned j = 0; j < 16; ++j) { const unsigned c = xb_ld(&bar[XB_XCNT(j)]); sum += c; cnt += (c > 0u) ? 1u : 0u; mine = (j == x) ? c : mine; }
        if (sum == G) break;
        __builtin_amdgcn_s_sleep(1);
        if ((++sp & 255u) == 0u) { if (xb_ld(&bar[XB_TMO])) break; if (sp > XB_SPIN_CAP) { atomicAdd(&bar[XB_TMO], 1u); break; } }
    }
    nloc = mine > 0u ? mine : 1u; nx = cnt > 0u ? cnt : 1u;
}
__device__ __forceinline__ void xcd_barrier(const XcdBarrier& b) {
    asm volatile("s_waitcnt vmcnt(0)" ::: "memory");
    __syncthreads();
    if (threadIdx.x == 0) {
        unsigned* bar = b.bar;
        __builtin_amdgcn_s_waitcnt(0);
        unsigned nloc = b.st[0], nx = b.st[1];
        if (nloc == 0u) { xcd_barrier_complete(bar, b.x, nloc, nx); b.st[0] = nloc; b.st[1] = nx; }
        const unsigned old = xb_add(&bar[XB_XSUB(b.x)], 1u);
        const unsigned gen = old / nloc;
        if (old + 1u == (gen + 1u) * nloc) {
            __builtin_amdgcn_fence(__ATOMIC_RELEASE, "agent");
            asm volatile("s_waitcnt vmcnt(0)" ::: "memory");
            const unsigned og = xb_add(&bar[XB_TOP], 1u);
            const unsigned tg = og / nx;
            if (og + 1u == (tg + 1u) * nx) xb_add(&bar[XB_TOPGEN], 1u);
            else XB_SPIN(xb_ld(&bar[XB_TOPGEN]) == tg, bar);
            __builtin_amdgcn_fence(__ATOMIC_ACQUIRE, "agent");
            xb_add(&bar[XB_XGEN(b.x)], 1u);
            asm volatile("s_waitcnt vmcnt(0)" ::: "memory");
        } else {
            XB_SPIN(xb_ld(&bar[XB_XGEN(b.x)]) == gen, bar);
            __builtin_amdgcn_fence(__ATOMIC_ACQUIRE, "agent");
            asm volatile("s_waitcnt vmcnt(0)" ::: "memory");
        }
    }
    __syncthreads();
}

__device__ __forceinline__ void transpose_tile(float* lt, const float* src, int ldsrc, int r0, int c0, bf16_t* dst, int lddst, int dr0, const float* sA, const float* sB, int split) {
    const int tid = opaque_tid();
    { const int r = tid >> 3, cc = (tid & 7) * 8;
      const float* s = src + (size_t)(r0 + r) * ldsrc + c0 + cc;
      const f32x4 v0 = *(const f32x4*)s, v1 = *(const f32x4*)(s + 4);
      float sc = 1.f; if (sA) { const int rr = r0 + r; sc = rr < split ? sA[rr] : sB[rr - split]; }
#pragma unroll
      for (int q = 0; q < 4; ++q) { lt[r * 65 + cc + q] = v0[q] * sc; lt[r * 65 + cc + 4 + q] = v1[q] * sc; } }
    __syncthreads();
    { const int c = tid >> 3, rr = (tid & 7) * 8;
      float v[8];
#pragma unroll
      for (int q = 0; q < 8; ++q) v[q] = lt[(rr + q) * 65 + c];
      u32x4 w; w.x = cvt_pk_bf16(v[0], v[1]); w.y = cvt_pk_bf16(v[2], v[3]); w.z = cvt_pk_bf16(v[4], v[5]); w.w = cvt_pk_bf16(v[6], v[7]);
      *(u32x4*)(dst + (size_t)(dr0 + c) * lddst + r0 + rr) = w; }
    __syncthreads();
}
__device__ __forceinline__ void transpose_tile8(float* lt, const float* src, int ldsrc, int r0, int c0, unsigned char* dst, int lddst, int dr0, const float* sk, float sc) {
    const int tid = opaque_tid();
    { const int r = tid >> 2, cc = (tid & 3) * 16;
      const float* sp = src + (size_t)(r0 + r) * ldsrc + c0 + cc;
      const float f = sk ? sc * sk[r0 + r] : sc;
#pragma unroll
      for (int q = 0; q < 4; ++q) { const f32x4 v = *(const f32x4*)(sp + 4 * q);
#pragma unroll
          for (int j = 0; j < 4; ++j) lt[r * 65 + cc + 4 * q + j] = v[j] * f; } }
    __syncthreads();
    { const int c = tid >> 3, rr = (tid & 7) * 16;
      float v[16];
#pragma unroll
      for (int q = 0; q < 16; ++q) v[q] = lt[(rr + q) * 65 + c];
      u32x4 w; w.x = pk4_fp8(v[0], v[1], v[2], v[3]); w.y = pk4_fp8(v[4], v[5], v[6], v[7]); w.z = pk4_fp8(v[8], v[9], v[10], v[11]); w.w = pk4_fp8(v[12], v[13], v[14], v[15]);
      *(u32x4*)(dst + (size_t)(dr0 + c) * lddst + r0 + rr) = w; }
    __syncthreads();
}
__device__ __forceinline__ void phase0(const Params& p, unsigned char* lds) {
    const int tid = opaque_tid(), nb = gridDim.x, bid = blockIdx.x, wid = tid >> 6, lane = tid & 63;
    { float* z = (float*)(p.ws + OFF_SSQ);
      for (int i = bid * NTHR + tid; i < 3 * T_ + 64; i += nb * NTHR) z[i] = 0.f;
      if (DUP_PHASE >= 2 && DUP_PHASE <= 4) { float* zd = (float*)(p.ws + OFF_SSQ + (OFF_DUMMY - OFF_SSQ)); for (int i = bid * NTHR + tid; i < 3 * T_ + 64; i += nb * NTHR) zd[i] = 0.f; } }
    { bf16_t* wrt = (bf16_t*)(p.ws + OFF_WR);
      for (int i = bid * NTHR + tid; i < 48 * D_; i += nb * NTHR) {
          const int o = i >> 11, k = i & 2047; float v = 0.f;
          if (o < 4) v = p.rgw[k * 4 + o]; else if (o < 36) v = p.rew[k * 32 + (o - 4)];
          wrt[i] = (bf16_t)(cvt_pk_bf16(v * p.g_ffn[k], 0.f) & 0xffffu); } }
    { bf16_t* xn = (bf16_t*)(p.ws + OFF_B);
      for (int row = bid * 8 + wid; row < T_; row += nb * 8) {
          const float* xr = p.x + (size_t)row * D_;
          f32x4 v[8]; float s = 0.f;
#pragma unroll
          for (int i = 0; i < 8; ++i) { v[i] = *(const f32x4*)(xr + i * 256 + lane * 4); s += (v[i][0] * v[i][0] + v[i][1] * v[i][1]) + (v[i][2] * v[i][2] + v[i][3] * v[i][3]); }
          const float rstd = rsqrtf(wave_sum(s) * (1.f / D_) + EPS);
#pragma unroll
          for (int i = 0; i < 8; ++i) { const f32x4 g = *(const f32x4*)(p.norm_mix_g + i * 256 + lane * 4); const f32x4 o = v[i] * rstd * g;
              u32x2 w; w.x = cvt_pk_bf16(o[0], o[1]); w.y = cvt_pk_bf16(o[2], o[3]); *(u32x2*)(xn + (size_t)row * D_ + i * 256 + lane * 4) = w; } } }
    float* lt = (float*)lds;
    constexpr int N_IN = 32 * 80, N_OUT = 32 * 32, N_G = 32 * 128, N_TOT = N_IN + N_OUT + 3 * N_G;
    for (int tile = bid; tile < N_TOT; tile += nb) {
        int q = tile;
        if (q < N_IN) { const int tr = q / 80, tc = q % 80; transpose_tile(lt, p.w_in, DIN, tr * 64, tc * 64, (bf16_t*)(p.ws + OFF_WIN), D_, tc * 64, nullptr, nullptr, 0); continue; } q -= N_IN;
        if (q < N_OUT) { const int tr = q / 32, tc = q % 32; transpose_tile(lt, p.w_out, D_, tr * 64, tc * 64, (bf16_t*)(p.ws + OFF_WOUT), D_, tc * 64, p.g_a, p.g_b, 1024); continue; } q -= N_OUT;
        if (q < 2 * N_G) { const int up = q >= N_G; if (up) q -= N_G; const int e = q >> 7, rem = q & 127, tr = rem >> 3, tc = rem & 7; const int c0 = tc * 64;
            transpose_tile8(lt, (up ? p.ewu : p.ewg) + (size_t)e * D_ * DE, DE, tr * 128, c0, p.ws + OFF_WGU + (size_t)e * 1024 * D_, D_, (c0 >> 7) * 256 + (up ? 128 : 0) + (c0 & 127), p.g_ffn, WGU_SCALE); continue; } q -= 2 * N_G;
        { const int e = q >> 7, rem = q & 127, tr = rem >> 5, tc = rem & 31;
          transpose_tile8(lt, p.ewd + (size_t)e * DE * D_, D_, tr * 128, tc * 64, p.ws + OFF_WD + (size_t)e * D_ * DE, DE, tc * 64, nullptr, WD_SCALE); }
    }
}

__device__ __forceinline__ void phase1(const Params& p, unsigned char* lds) {
    const Epi1 E{p.ws};
    pg8::StaticOrder S; S.init(T_, DIN, gridDim.x, blockIdx.x); const pg8::AOffDirect AO{D_};
    pg8::gemm_phase<Epi1, pg8::StaticOrder, pg8::AOffDirect, true>((PG8_LAS unsigned char*)lds, (const bf16_t*)(p.ws + OFF_B), (const bf16_t*)(p.ws + OFF_WIN), D_, S, AO, E);
}

__device__ __forceinline__ void mixer_gmlp_item(const Params& p, unsigned char* lds, int item, size_t so) {
    const int tid = opaque_tid(), wid = tid >> 6, lane = tid & 63, fr = lane & 15, fq = lane >> 4;
    const int h = item & 7, t0 = (item >> 3) * 128;
    const bf16_t* P = (const bf16_t*)(p.ws + OFF_A); bf16_t* Y = (bf16_t*)(p.ws + OFF_B); float* ssq_a = (float*)(p.ws + OFF_SSQ + so);
    bf16_t* Vt = (bf16_t*)lds;
    bf16_t* Wl = Vt + 128 * 136;
    float* rs = (float*)(Wl + 128 * 136);
    { const int j = tid >> 2, dc = (tid & 3) * 32;
      const u32x4* src = (const u32x4*)(P + (size_t)(t0 + j) * DIN + 1024 + h * 128 + dc);
      u32x4 v[4]; float s = 0.f;
#pragma unroll
      for (int q = 0; q < 4; ++q) { v[q] = src[q];
#pragma unroll
          for (int w = 0; w < 4; ++w) { const float lo = bflo(v[q][w]), hi = bfhi(v[q][w]); s += lo * lo + hi * hi; } }
      s += __shfl_xor(s, 1); s += __shfl_xor(s, 2);
      if ((tid & 3) == 0) rs[j] = rsqrtf(s * (1.f / 128.f) + EPS);
#pragma unroll
      for (int q = 0; q < 4; ++q)
#pragma unroll
          for (int w = 0; w < 4; ++w) { const int d = dc + q * 8 + w * 2; Vt[d * 136 + j] = (bf16_t)(v[q][w] & 0xffffu); Vt[(d + 1) * 136 + j] = (bf16_t)(v[q][w] >> 16); } }
    __syncthreads();
    { const int i = tid >> 2, jc = (tid & 3) * 32;
      const f32x4* src = (const f32x4*)(p.gmlp_ws + (size_t)h * 16384 + i * 128 + jc);
      const bool live = (i >> 6) >= (jc >> 6);
#pragma unroll
      for (int q = 0; q < 4; ++q) { f32x4 w0 = src[2 * q], w1 = src[2 * q + 1];
          const f32x4 r0 = *(const f32x4*)(rs + jc + 8 * q), r1 = *(const f32x4*)(rs + jc + 8 * q + 4);
          w0 = live ? w0 * r0 : (f32x4){0.f, 0.f, 0.f, 0.f}; w1 = live ? w1 * r1 : (f32x4){0.f, 0.f, 0.f, 0.f};
          u32x4 o; o.x = cvt_pk_bf16(w0[0], w0[1]); o.y = cvt_pk_bf16(w0[2], w0[3]); o.z = cvt_pk_bf16(w1[0], w1[1]); o.w = cvt_pk_bf16(w1[2], w1[3]);
          *(u32x4*)(Wl + i * 136 + jc + 8 * q) = o; } }
    __syncthreads();
    f32x4 acc[8];
#pragma unroll
    for (int n = 0; n < 8; ++n) acc[n] = (f32x4){0.f, 0.f, 0.f, 0.f};
    const int ksteps = (wid < 4) ? 2 : 4;
    for (int ks = 0; ks < ksteps; ++ks) {
        const bf16x8 bw = *(const bf16x8*)(Wl + (16 * wid + fr) * 136 + ks * 32 + fq * 8);
#pragma unroll
        for (int n = 0; n < 8; ++n) { const bf16x8 av = *(const bf16x8*)(Vt + (16 * n + fr) * 136 + ks * 32 + fq * 8);
            acc[n] = __builtin_amdgcn_mfma_f32_16x16x32_bf16(av, bw, acc[n], 0, 0, 0); }
    }
    { const int i = 16 * wid + fr, t = t0 + i; const float bias = p.gmlp_bs[h * 128 + i]; float ss = 0.f;
#pragma unroll
      for (int n = 0; n < 8; ++n) { const int c = h * 128 + 16 * n + 4 * fq;
          const f32x4 g = *(const f32x4*)(p.v_norm_g + c); const u32x2 uu = *(const u32x2*)(P + (size_t)t * DIN + c);
          const float y0 = bflo(uu.x) * (acc[n][0] * g[0] + bias), y1 = bfhi(uu.x) * (acc[n][1] * g[1] + bias), y2 = bflo(uu.y) * (acc[n][2] * g[2] + bias), y3 = bfhi(uu.y) * (acc[n][3] * g[3] + bias);
          ss += (y0 * y0 + y1 * y1) + (y2 * y2 + y3 * y3);
          u32x2 w; w.x = cvt_pk_bf16(y0, y1); w.y = cvt_pk_bf16(y2, y3); *(u32x2*)(Y + (size_t)t * D_ + c) = w; }
      ss += __shfl_xor(ss, 16); ss += __shfl_xor(ss, 32);
      if (fq == 0) atomicAdd(ssq_a + t, ss); }
    __syncthreads();
}
__device__ __forceinline__ void mixer_conv_item(const Params& p, int item, size_t so) {
    const int tid = opaque_tid(), cl = tid & 31, ts = tid >> 5;
    const int c = (item & 3) * 256 + cl * 8, tbeg = (item >> 2) * 128 + ts * 8;
    const bf16_t* P = (const bf16_t*)(p.ws + OFF_A); bf16_t* Y = (bf16_t*)(p.ws + OFF_B); float* ssq_b = (float*)(p.ws + OFF_SSQ + so) + T_;
    float w0[8], w1[8], w2[8], z1[8], z2[8];
    { const f32x4 a0 = *(const f32x4*)(p.conv_w + c), a1 = *(const f32x4*)(p.conv_w + c + 4), b0 = *(const f32x4*)(p.conv_w + 1024 + c), b1 = *(const f32x4*)(p.conv_w + 1024 + c + 4),
                  c0 = *(const f32x4*)(p.conv_w + 2048 + c), c1 = *(const f32x4*)(p.conv_w + 2048 + c + 4);
#pragma unroll
      for (int q = 0; q < 4; ++q) { w0[q] = a0[q]; w0[4 + q] = a1[q]; w1[q] = b0[q]; w1[4 + q] = b1[q]; w2[q] = c0[q]; w2[4 + q] = c1[q]; } }
#pragma unroll
    for (int q = 0; q < 8; ++q) { z1[q] = 0.f; z2[q] = 0.f; }
    if ((tbeg % SEQ) != 0) {
        const u32x4 ca = *(const u32x4*)(P + (size_t)(tbeg - 1) * DIN + 3072 + c), ha = *(const u32x4*)(P + (size_t)(tbeg - 1) * DIN + 4096 + c);
        const u32x4 cb = *(const u32x4*)(P + (size_t)(tbeg - 2) * DIN + 3072 + c), hb2 = *(const u32x4*)(P + (size_t)(tbeg - 2) * DIN + 4096 + c);
#pragma unroll
        for (int q = 0; q < 4; ++q) { z1[2 * q] = bflo(ca[q]) * bflo(ha[q]); z1[2 * q + 1] = bfhi(ca[q]) * bfhi(ha[q]); z2[2 * q] = bflo(cb[q]) * bflo(hb2[q]); z2[2 * q + 1] = bfhi(cb[q]) * bfhi(hb2[q]); }
    }
    u32x4 bgA[8], cgA[8], hvA[8];
#pragma unroll
    for (int tt = 0; tt < 8; ++tt) { const bf16_t* pr = P + (size_t)(tbeg + tt) * DIN + c; bgA[tt] = *(const u32x4*)(pr + 2048); cgA[tt] = *(const u32x4*)(pr + 3072); hvA[tt] = *(const u32x4*)(pr + 4096); }
#pragma unroll
    for (int tt = 0; tt < 8; ++tt) {
        const int t = tbeg + tt;
        const u32x4 bg = bgA[tt], cgv = cgA[tt], hv = hvA[tt];
        float z[8], y[8], ss = 0.f;
#pragma unroll
        for (int q = 0; q < 4; ++q) { z[2 * q] = bflo(cgv[q]) * bflo(hv[q]); z[2 * q + 1] = bfhi(cgv[q]) * bfhi(hv[q]); }
#pragma unroll
        for (int q = 0; q < 4; ++q) {
            y[2 * q] = bflo(bg[q]) * (w0[2 * q] * z2[2 * q] + w1[2 * q] * z1[2 * q] + w2[2 * q] * z[2 * q]);
            y[2 * q + 1] = bfhi(bg[q]) * (w0[2 * q + 1] * z2[2 * q + 1] + w1[2 * q + 1] * z1[2 * q + 1] + w2[2 * q + 1] * z[2 * q + 1]); }
#pragma unroll
        for (int q = 0; q < 8; ++q) { ss += y[q] * y[q]; z2[q] = z1[q]; z1[q] = z[q]; }
        u32x4 w; w.x = cvt_pk_bf16(y[0], y[1]); w.y = cvt_pk_bf16(y[2], y[3]); w.z = cvt_pk_bf16(y[4], y[5]); w.w = cvt_pk_bf16(y[6], y[7]);
        *(u32x4*)(Y + (size_t)t * D_ + 1024 + c) = w;
        ss += __shfl_xor(ss, 1); ss += __shfl_xor(ss, 2); ss += __shfl_xor(ss, 4); ss += __shfl_xor(ss, 8); ss += __shfl_xor(ss, 16);
        if (cl == 0) atomicAdd(ssq_b + t, ss);
    }
}
__device__ __forceinline__ void phase2(const Params& p, unsigned char* lds, size_t so = 0) {
    for (int it = blockIdx.x; it < 512 + 1024; it += gridDim.x) { if (it < 512) mixer_conv_item(p, it, so); else mixer_gmlp_item(p, lds, it - 512, so); }
}

__device__ __forceinline__ void phase3(const Params& p, unsigned char* lds, size_t so = 0) {
    const Epi2 E{p.x, p.ws, so};
    pg8::StaticOrder S; S.init(T_, D_, gridDim.x, blockIdx.x); const pg8::AOffDirect AO{D_};
    pg8::gemm_phase<Epi2, pg8::StaticOrder, pg8::AOffDirect, true>((PG8_LAS unsigned char*)lds, (const bf16_t*)(p.ws + OFF_B), (const bf16_t*)(p.ws + OFF_WOUT), D_, S, AO, E);
}

__device__ __forceinline__ void route_item(const Params& p, unsigned char* lds, int item, size_t so) {
    const int tid = opaque_tid(), wid = tid >> 6, lane = tid & 63, fr = lane & 15, fq = lane >> 4;
    float* lg = (float*)lds;
    int* lcnt = (int*)(lg + 2 * 64 * 48); int* lbase = lcnt + 32;
    const bf16_t* hb = (const bf16_t*)(p.ws + OFF_HB); const bf16_t* wrt = (const bf16_t*)(p.ws + OFF_WR);
    const float* ssq_h = (const float*)(p.ws + OFF_SSQ) + 2 * T_;
    int* cnt = (int*)(p.ws + OFF_CNT + so); int* rinfo = (int*)(p.ws + OFF_RINFO + so); float* rw = (float*)(p.ws + OFF_RW + so);
    const int tg = wid & 3, kh = wid >> 2, t0 = item * 64;
    if (tid < 32) lcnt[tid] = 0;
    f32x4 acc[3];
#pragma unroll
    for (int n = 0; n < 3; ++n) acc[n] = (f32x4){0.f, 0.f, 0.f, 0.f};
    const bf16_t* ap = hb + (size_t)(t0 + tg * 16 + fr) * D_ + kh * 1024 + fq * 8; const bf16_t* bp = wrt + (size_t)fr * D_ + kh * 1024 + fq * 8;
#pragma unroll 8
    for (int ks = 0; ks < 32; ++ks) { const bf16x8 a = *(const bf16x8*)(ap + ks * 32);
#pragma unroll
        for (int n = 0; n < 3; ++n) { const bf16x8 b = *(const bf16x8*)(bp + (size_t)n * 16 * D_ + ks * 32); acc[n] = __builtin_amdgcn_mfma_f32_16x16x32_bf16(a, b, acc[n], 0, 0, 0); } }
#pragma unroll
    for (int n = 0; n < 3; ++n)
#pragma unroll
        for (int j = 0; j < 4; ++j) lg[(kh * 64 + tg * 16 + 4 * fq + j) * 48 + 16 * n + fr] = acc[n][j];
    __syncthreads();
    int e0 = 0, e1 = 0, r0 = 0, r1 = 0; float g0 = 0.f, g1 = 0.f, rsc = 0.f; const int t = t0 + tid;
    if (tid < 64) {
        const float* l0 = lg + tid * 48; const float* l1 = l0 + 64 * 48; const float rstd = rsqrtf(ssq_h[t] * (1.f / D_) + EPS); rsc = rstd * (1.f / WGU_SCALE);
        float gm = -3.0e38f; int gi = 0; float gl[4];
#pragma unroll
        for (int o = 0; o < 4; ++o) { gl[o] = (l0[o] + l1[o]) * rstd + p.rgb[o]; if (gl[o] > gm) { gm = gl[o]; gi = o; } }
        float gs = 0.f;
#pragma unroll
        for (int o = 0; o < 4; ++o) gs += __expf(gl[o] - gm);
        const float pg = 1.f / gs;
        float b1 = -3.0e38f, b2 = -3.0e38f; int i1 = 0, i2 = 0;
        for (int q = 0; q < 8; ++q) { const float v = (l0[4 + gi * 8 + q] + l1[4 + gi * 8 + q]) * rstd + p.reb[gi * 8 + q];
            if (v > b1) { b2 = b1; i2 = i1; b1 = v; i1 = q; } else if (v > b2) { b2 = v; i2 = q; } }
        const float wa = 1.f / (1.f + __expf(b2 - b1));
        e0 = gi * 8 + i1; e1 = gi * 8 + i2; g0 = pg * wa; g1 = pg * (1.f - wa);
        r0 = atomicAdd(&lcnt[e0], 1); r1 = atomicAdd(&lcnt[e1], 1);
    }
    __syncthreads();
    if (tid < 32) lbase[tid] = atomicAdd(cnt + tid, lcnt[tid]);
    __syncthreads();
    if (tid < 64) { const int i0 = lbase[e0] + r0, i1 = lbase[e1] + r1;
        rinfo[e0 * LCAP + i0] = (int)((cvt_pk_bf16(g0, 0.f) << 16) | (unsigned)(2 * t)); rinfo[e1 * LCAP + i1] = (int)((cvt_pk_bf16(g1, 0.f) << 16) | (unsigned)(2 * t + 1));
        rw[e0 * LCAP + i0] = rsc; rw[e1 * LCAP + i1] = rsc; }
    __syncthreads();
}
__device__ __forceinline__ void phase4(const Params& p, unsigned char* lds, size_t so = 0) { for (int it = blockIdx.x; it < T_ / 64; it += gridDim.x) route_item(p, lds, it, so); }

__device__ __forceinline__ PG8_LAS int* moe_tables_to_lds(const Params& p, unsigned char* lds) {
    PG8_LAS int* tb = (PG8_LAS int*)((PG8_LAS unsigned char*)lds + LCNT_OFF); const int* cnt = (const int*)(p.ws + OFF_CNT);
    if (threadIdx.x < NE) tb[MT_CNT + threadIdx.x] = __hip_atomic_load(cnt + threadIdx.x, __ATOMIC_RELAXED, __HIP_MEMORY_SCOPE_AGENT);
    __syncthreads();
    if (threadIdx.x == 0) { int pt = 0;
        for (int e = 0; e < NE; ++e) { const int nt = (tb[MT_CNT + e] + 255) >> 8; tb[MT_PST + e] = pt; for (int i = 0; i < nt; ++i) tb[MT_T2E + pt + i] = e; pt += nt; }
        tb[MT_PST + NE] = pt; tb[MT_NT] = pt; }
    __syncthreads();
    return tb;
}
__device__ __forceinline__ void phase5(const Params& p, unsigned char* lds) {
    PG8_LAS int* lc = moe_tables_to_lds(p, lds);
    const Epi5 E{p.ws, lc};
    const pg8::MoeOrder S{lc, 4, (int)gridDim.x, (int)blockIdx.x}; const pg8::AOffGather AO{p.ws, lc, D_ / 2};
    pg8::gemm_phase<Epi5, pg8::MoeOrder, pg8::AOffGather, true, true>((PG8_LAS unsigned char*)lds, (const bf16_t*)(p.ws + OFF_H8), (const bf16_t*)(p.ws + OFF_WGU), D_ / 2, S, AO, E);
}
__device__ __forceinline__ void phase6(const Params& p, unsigned char* lds) {
    PG8_LAS int* lc = moe_tables_to_lds(p, lds);
    const Epi6 E{p.ws, lc};
    const pg8::MoeOrder S{lc, 8, (int)gridDim.x, (int)blockIdx.x}; const pg8::AOffDirect AO{DE / 2};
    pg8::gemm_phase<Epi6, pg8::MoeOrder, pg8::AOffDirect, true, true>((PG8_LAS unsigned char*)lds, (const bf16_t*)(p.ws + OFF_B), (const bf16_t*)(p.ws + OFF_WD), DE / 2, S, AO, E);
}
__device__ __forceinline__ void phase7(const Params& p) {
    const int tid = opaque_tid(), wid = tid >> 6, lane = tid & 63;
    const bf16_t* hb = (const bf16_t*)(p.ws + OFF_HB); const unsigned char* ys2 = p.ws + OFF_A;
    for (int t = blockIdx.x * 8 + wid; t < T_; t += gridDim.x * 8) {
        float v[4][8]; float s = 0.f;
#pragma unroll
        for (int i = 0; i < 4; ++i) { const int c = i * 512 + lane * 8;
            const u32x4 a = *(const u32x4*)(hb + (size_t)t * D_ + c); const u32x2 b = *(const u32x2*)(ys2 + (size_t)(2 * t) * D_ + c), d = *(const u32x2*)(ys2 + (size_t)(2 * t + 1) * D_ + c);
            float y0[8], y1[8];
            up4_fp8(b.x, y0[0], y0[1], y0[2], y0[3]); up4_fp8(b.y, y0[4], y0[5], y0[6], y0[7]); up4_fp8(d.x, y1[0], y1[1], y1[2], y1[3]); up4_fp8(d.y, y1[4], y1[5], y1[6], y1[7]);
#pragma unroll
            for (int q = 0; q < 4; ++q) { v[i][2 * q] = bflo(a[q]) + (y0[2 * q] + y1[2 * q]) * (1.f / YS_SCALE); v[i][2 * q + 1] = bfhi(a[q]) + (y0[2 * q + 1] + y1[2 * q + 1]) * (1.f / YS_SCALE);
                s += v[i][2 * q] * v[i][2 * q] + v[i][2 * q + 1] * v[i][2 * q + 1]; } }
        const float rstd = rsqrtf(wave_sum(s) * (1.f / D_) + EPS);
#pragma unroll
        for (int i = 0; i < 4; ++i) { const int c = i * 512 + lane * 8;
            const f32x4 g0 = *(const f32x4*)(p.g_final + c), g1 = *(const f32x4*)(p.g_final + c + 4);
            f32x4 o0, o1;
#pragma unroll
            for (int q = 0; q < 4; ++q) { o0[q] = v[i][q] * rstd * g0[q]; o1[q] = v[i][4 + q] * rstd * g1[q]; }
            *(f32x4*)(p.out + (size_t)t * D_ + c) = o0; *(f32x4*)(p.out + (size_t)t * D_ + c + 4) = o1; }
    }
}

#ifndef ONE_LAUNCH
#define ONE_LAUNCH 1
#endif
template <int PH> __global__ void __launch_bounds__(NTHR, 2) k_phase(Params p) {
    extern __shared__ __attribute__((aligned(16))) unsigned char lds[];
    if (PH == 0) phase0(p, lds);
    if (PH == 1) phase1(p, lds);
    if (PH == 2) phase2(p, lds);
    if (PH == 3) phase3(p, lds);
    if (PH == 4) phase4(p, lds);
    if (PH == 5) phase5(p, lds);
    if (PH == 6) phase6(p, lds);
    if (PH == 7) phase7(p);
}
__global__ void __launch_bounds__(NTHR, 2) k_mega(Params p) {
    extern __shared__ __attribute__((aligned(16))) unsigned char lds[];
    cg::grid_group grid = cg::this_grid();
    volatile PG8_LAS unsigned* bst = (volatile PG8_LAS unsigned*)((PG8_LAS unsigned char*)lds + LBAR_OFF);
    if (threadIdx.x < 2) bst[threadIdx.x] = 0u;
    __syncthreads();
    (void)xcd_barrier_post((unsigned*)(p.ws + OFF_BAR), bst);
#define GRID_BAR() do { XcdBarrier b_; b_.bar = (unsigned*)(opaque_ws(p.ws) + OFF_BAR); b_.x = xb_xcc_id(); b_.st = bst; xcd_barrier(b_); } while (0)
    if (DUP_PHASE == 0) { phase0(p, lds); GRID_BAR(); }
    if (p.ws == nullptr) grid.sync();
    phase0(p, lds); GRID_BAR();
    if (DUP_PHASE == 1) { phase1(p, lds); GRID_BAR(); }
    phase1(p, lds); GRID_BAR();
    if (DUP_PHASE == 2) { phase2(p, lds, OFF_DUMMY - OFF_SSQ); GRID_BAR(); }
    phase2(p, lds); GRID_BAR();
    if (DUP_PHASE == 3) { phase3(p, lds, OFF_DUMMY - OFF_SSQ); GRID_BAR(); }
    phase3(p, lds); GRID_BAR();
    if (DUP_PHASE == 4) { phase4(p, lds, OFF_DUMMY - OFF_SSQ); GRID_BAR(); }
    phase4(p, lds); GRID_BAR();
    if (DUP_PHASE == 5) { phase5(p, lds); GRID_BAR(); }
    phase5(p, lds); GRID_BAR();
    if (DUP_PHASE == 6) { phase6(p, lds); GRID_BAR(); }
    phase6(p, lds); GRID_BAR();
    if (DUP_PHASE == 8) { for (int i = 0; i < 10; ++i) GRID_BAR(); }
    if (DUP_PHASE == 9) { grid.sync(); grid.sync(); }
    if (DUP_PHASE == 7) { phase7(p); GRID_BAR(); }
    phase7(p);
}

extern "C" void kernel_launch(void* const* d_in, const int* in_sizes, int n_in, void* d_out, int out_size, void* d_ws, size_t ws_size, hipStream_t stream) {
    static int grid = 0;
    if (grid == 0) {
        if (n_in != 19 || in_sizes[0] != T_ * D_ || out_size != T_ * D_ || ws_size < WS_END + (DUP_PHASE >= 2 && DUP_PHASE <= 4 ? DUMMY_BYTES : 0)) { fprintf(stderr, "kernel_launch: unexpected shapes (n_in %d, in0 %d, out %d, ws %zu < %zu); nothing launched\n", n_in, n_in > 0 ? in_sizes[0] : -1, out_size, ws_size, (size_t)WS_END); grid = -1; return; }
        int dev = 0, cus = 0, per_cu = 0;
        if (hipGetDevice(&dev) != hipSuccess || hipDeviceGetAttribute(&cus, hipDeviceAttributeMultiprocessorCount, dev) != hipSuccess) { grid = -1; return; }
#if ONE_LAUNCH
        if (hipFuncSetAttribute((const void*)k_mega, hipFuncAttributeMaxDynamicSharedMemorySize, LDS_BYTES) != hipSuccess) { fprintf(stderr, "kernel_launch: hipFuncSetAttribute failed\n"); grid = -1; return; }
        if (hipOccupancyMaxActiveBlocksPerMultiprocessor(&per_cu, (const void*)k_mega, NTHR, LDS_BYTES) != hipSuccess || per_cu < 1) { fprintf(stderr, "kernel_launch: occupancy query says %d blocks per CU\n", per_cu); grid = -1; return; }
        grid = cus * per_cu;
#else
        (void)hipFuncSetAttribute((const void*)k_phase<0>, hipFuncAttributeMaxDynamicSharedMemorySize, LDS_BYTES);
        (void)hipFuncSetAttribute((const void*)k_phase<1>, hipFuncAttributeMaxDynamicSharedMemorySize, LDS_BYTES);
        (void)hipFuncSetAttribute((const void*)k_phase<2>, hipFuncAttributeMaxDynamicSharedMemorySize, LDS_BYTES);
        (void)hipFuncSetAttribute((const void*)k_phase<3>, hipFuncAttributeMaxDynamicSharedMemorySize, LDS_BYTES);
        (void)hipFuncSetAttribute((const void*)k_phase<4>, hipFuncAttributeMaxDynamicSharedMemorySize, LDS_BYTES);
        (void)hipFuncSetAttribute((const void*)k_phase<5>, hipFuncAttributeMaxDynamicSharedMemorySize, LDS_BYTES);
        (void)hipFuncSetAttribute((const void*)k_phase<6>, hipFuncAttributeMaxDynamicSharedMemorySize, LDS_BYTES);
        (void)hipFuncSetAttribute((const void*)k_phase<7>, hipFuncAttributeMaxDynamicSharedMemorySize, LDS_BYTES);
        grid = cus > 0 ? cus : 256;
#endif
    }
    if (grid < 0) return;
    Params p{};
    const float** f = (const float**)&p;
    for (int i = 0; i < 19; ++i) f[i] = (const float*)d_in[i];
    p.out = (float*)d_out; p.ws = (unsigned char*)d_ws;
#if ONE_LAUNCH
    if (hipMemsetAsync((unsigned char*)d_ws + OFF_BAR, 0, BAR_BYTES, stream) != hipSuccess) { fprintf(stderr, "kernel_launch: memset of the barrier words failed\n"); return; }
    void* args[] = {&p};
    const hipError_t e = hipLaunchCooperativeKernel((const void*)k_mega, dim3(grid), dim3(NTHR), args, LDS_BYTES, stream);
    if (e != hipSuccess) fprintf(stderr, "kernel_launch: cooperative launch failed: %s (grid %d)\n", hipGetErrorString(e), grid);
#else
    hipLaunchKernelGGL(k_phase<0>, dim3(grid), dim3(NTHR), LDS_BYTES, stream, p);
    hipLaunchKernelGGL(k_phase<1>, dim3(grid), dim3(NTHR), LDS_BYTES, stream, p);
    hipLaunchKernelGGL(k_phase<2>, dim3(grid), dim3(NTHR), LDS_BYTES, stream, p);
    hipLaunchKernelGGL(k_phase<3>, dim3(grid), dim3(NTHR), LDS_BYTES, stream, p);
    hipLaunchKernelGGL(k_phase<4>, dim3(grid), dim3(NTHR), LDS_BYTES, stream, p);
    hipLaunchKernelGGL(k_phase<5>, dim3(grid), dim3(NTHR), LDS_BYTES, stream, p);
    hipLaunchKernelGGL(k_phase<6>, dim3(grid), dim3(NTHR), LDS_BYTES, stream, p);
    hipLaunchKernelGGL(k_phase<7>, dim3(grid), dim3(NTHR), LDS_BYTES, stream, p);
#endif
}
```

```cpp
#include <hip/hip_runtime.h>
#include <hip/hip_cooperative_groups.h>
#include <cstdio>
namespace cg = cooperative_groups;

typedef unsigned short bf16_t;
typedef float f32x4 __attribute__((ext_vector_type(4)));
typedef unsigned u32x4 __attribute__((ext_vector_type(4)));
typedef unsigned u32x2 __attribute__((ext_vector_type(2)));
typedef short bf16x8 __attribute__((ext_vector_type(8)));
typedef int v4i __attribute__((ext_vector_type(4)));
typedef int v8i __attribute__((ext_vector_type(8)));

constexpr int T_ = 16384, D_ = 2048, DIN = 5120, NE = 32, DE = 512, SEQ = 4096, LCAP = 16384;
constexpr float EPS = 1e-6f;
#ifndef DUP_PHASE
#define DUP_PHASE -1
#endif
constexpr int NTHR = 512;
constexpr int LDS_BYTES = 163840;
constexpr int LCNT_OFF = 131072, LBAR_OFF = 131072 + 2048, XS_OFF = 131072 + 4096, XM_OFF = XS_OFF + 8192, RS_OFF = XM_OFF;
constexpr int RS_UNITS = 4;
static_assert(XM_OFF + 512 * 32 <= LDS_BYTES && RS_UNITS * 256 * 8 <= 512 * 32, "LDS map");

constexpr size_t SZ_A = (size_t)T_ * DIN * 2;
constexpr size_t SZ_B = (size_t)T_ * D_ * 2;
constexpr size_t OFF_A = 0;
constexpr size_t OFF_B = OFF_A + SZ_A;
constexpr size_t OFF_HB = OFF_B + SZ_B;
constexpr size_t OFF_H8 = OFF_A + (size_t)2 * T_ * D_ * 2;
constexpr float WGU_SCALE = 32.f, WD_SCALE = 16.f, YS_SCALE = 16.f;
constexpr size_t OFF_WIN = OFF_HB + SZ_B;
constexpr size_t OFF_WOUT = OFF_WIN + (size_t)DIN * D_ * 2;
constexpr size_t OFF_WGU = OFF_WOUT + (size_t)D_ * D_ * 2;
constexpr size_t OFF_WD = OFF_WGU + (size_t)NE * 1024 * D_ * 2;
constexpr size_t OFF_WR = OFF_WD + (size_t)NE * D_ * DE * 2;
constexpr size_t OFF_SSQ = OFF_WR + (size_t)48 * D_ * 2;
constexpr size_t OFF_CNT = OFF_SSQ + (size_t)3 * T_ * 4;
constexpr size_t OFF_RINFO = OFF_CNT + 256;
constexpr size_t OFF_RW = OFF_RINFO + (size_t)NE * LCAP * 4;
constexpr size_t OFF_BAR = OFF_RW + (size_t)NE * LCAP * 4;
constexpr size_t BAR_BYTES = 16384;
constexpr size_t WS_END = OFF_BAR + BAR_BYTES;
constexpr size_t OFF_DUMMY = WS_END;
constexpr size_t DUMMY_BYTES = (OFF_BAR - OFF_SSQ);

struct Params {
    const float *x, *norm_mix_g, *w_in, *v_norm_g, *gmlp_ws, *gmlp_bs, *conv_w, *g_a, *g_b, *w_out, *g_ffn, *rgw, *rgb, *rew, *reb, *ewg, *ewu, *ewd, *g_final;
    float* out; unsigned char* ws;
};

__device__ __forceinline__ unsigned cvt_pk_bf16(float lo, float hi) { unsigned r; asm volatile("v_cvt_pk_bf16_f32 %0, %1, %2" : "=v"(r) : "v"(lo), "v"(hi)); return r; }
#define GAS __attribute__((address_space(1)))
typedef GAS unsigned char gbyte;
__device__ __forceinline__ gbyte* opaque_ws(unsigned char* w) { gbyte* g = (gbyte*)w; asm volatile("" : "+s"(g)); return g; }
__device__ __forceinline__ int opaque_tid() { int t = threadIdx.x; asm volatile("" : "+v"(t)); return t; }
__device__ __forceinline__ unsigned pk4_fp8(float a, float b, float c, float d) { int w = 0; w = __builtin_amdgcn_cvt_pk_fp8_f32(a, b, w, false); w = __builtin_amdgcn_cvt_pk_fp8_f32(c, d, w, true); return (unsigned)w; }
__device__ __forceinline__ void up4_fp8(unsigned w, float& a, float& b, float& c, float& d) {
    const auto lo = __builtin_amdgcn_cvt_pk_f32_fp8((int)w, false), hi = __builtin_amdgcn_cvt_pk_f32_fp8((int)w, true); a = lo[0]; b = lo[1]; c = hi[0]; d = hi[1]; }
__device__ __forceinline__ float bflo(unsigned w) { return __uint_as_float(w << 16); }
__device__ __forceinline__ float bfhi(unsigned w) { return __uint_as_float(w & 0xffff0000u); }
__device__ __forceinline__ float wave_sum(float v) {
#pragma unroll
    for (int o = 1; o < 64; o <<= 1) v += __shfl_xor(v, o);
    return v;
}
__device__ __forceinline__ float gelu_t(float x) {
    const float u = x * (0.7978845608f + 0.0356774081f * x * x);
    return x * __builtin_amdgcn_rcpf(1.f + __builtin_amdgcn_exp2f(-2.885390082f * u));
}
__device__ __forceinline__ float silu_f(float x) { return x * __builtin_amdgcn_rcpf(1.f + __builtin_amdgcn_exp2f(-1.442695041f * x)); }

#define PG8_LAS __attribute__((address_space(3)))
struct Unit { int pm, pn, e, r0, pnl; };

constexpr int MT_CNT = 0, MT_PST = 32, MT_NT = 65, MT_T2E = 66, MT_WORDS = 66 + 192;
typedef const PG8_LAS int* lcnt_t;
__device__ __forceinline__ bool moe_unit(lcnt_t tb, int NT, int L, Unit& u) {
    const int pt = L / NT;
    if (pt >= __builtin_amdgcn_readfirstlane(tb[MT_NT])) return false;
    const int e = __builtin_amdgcn_readfirstlane(tb[MT_T2E + pt]), mt = pt - __builtin_amdgcn_readfirstlane(tb[MT_PST + e]), j = L - pt * NT;
    u.e = e; u.pm = pt; u.r0 = mt * 256; u.pnl = j; u.pn = e * NT + j; return true;
}

struct NoMeta {};
struct Meta8 { u32x4 lo, hi; };
struct Epi1 {
    static constexpr bool PERM = true, MIDSCALE = false;
    typedef NoMeta Meta;
    unsigned char* ws;
    __device__ __forceinline__ Meta meta_load(const Unit&, int, int) const { return Meta{}; }
    __device__ __forceinline__ void operator()(f32x4 (&acc)[2][2][4][2], const Unit& u, int wr, int wc, int fr, int fq, const Meta&) const {
        GAS bf16_t* P = (GAS bf16_t*)(opaque_ws(ws) + OFF_A);
        const bool act = u.pn < 8;
#pragma unroll
        for (int ai = 0; ai < 2; ++ai)
#pragma unroll
            for (int m = 0; m < 4; ++m) {
                const int row = u.pm * 256 + ai * 128 + wr * 64 + m * 16 + fr;
                GAS bf16_t* rowp = P + (size_t)row * DIN + u.pn * 256 + wc * 32 + 8 * fq;
#pragma unroll
                for (int bj = 0; bj < 2; ++bj) {
                    f32x4 v0 = acc[ai][bj][m][0], v1 = acc[ai][bj][m][1];
                    if (act) {
#pragma unroll
                        for (int j = 0; j < 4; ++j) { v0[j] = gelu_t(v0[j]); v1[j] = gelu_t(v1[j]); }
                    }
                    u32x4 w; w.x = cvt_pk_bf16(v0[0], v0[1]); w.y = cvt_pk_bf16(v0[2], v0[3]); w.z = cvt_pk_bf16(v1[0], v1[1]); w.w = cvt_pk_bf16(v1[2], v1[3]);
                    *(GAS u32x4*)(rowp + bj * 128) = w;
                }
            }
    }
};
struct Epi2 {
    static constexpr bool PERM = true, MIDSCALE = true;
    const float* x; unsigned char* ws; size_t so;
    const PG8_LAS float* rsl;
    __device__ __forceinline__ void midscale(f32x4 (&acc)[2][2][4][2], const Unit& u, int wr, int wc, int fr, int fq) const {
        const PG8_LAS float* pr = rsl + (u.e * 256 + wr * 64 + fr) * 2;
#pragma unroll
        for (int ai = 0; ai < 2; ++ai)
#pragma unroll
            for (int m = 0; m < 4; ++m) {
                const float s = pr[(ai * 128 + m * 16) * 2];
#pragma unroll
                for (int bj = 0; bj < 2; ++bj)
#pragma unroll
                    for (int n = 0; n < 2; ++n) acc[ai][bj][m][n] *= s;
            }
    }
    typedef NoMeta Meta;
    __device__ __forceinline__ Meta meta_load(const Unit&, int, int) const { return Meta{}; }
    __device__ __forceinline__ void operator()(f32x4 (&acc)[2][2][4][2], const Unit& u, int wr, int wc, int fr, int fq, const Meta&) const {
        gbyte* w_ = opaque_ws(ws);
        GAS bf16_t* hb = (GAS bf16_t*)(w_ + OFF_HB); gbyte* h8 = w_ + OFF_H8; float* ssq_h = (float*)(ws + OFF_SSQ + so) + 2 * T_;
#pragma unroll
        for (int ai = 0; ai < 2; ++ai)
#pragma unroll
            for (int m = 0; m < 4; ++m) {
                const int row = u.pm * 256 + ai * 128 + wr * 64 + m * 16 + fr;
                const float rb = rsl[(u.e * 256 + ai * 128 + wr * 64 + m * 16 + fr) * 2 + 1];
                const size_t off = (size_t)row * D_ + u.pn * 256 + wc * 32 + 8 * fq;
                float ss = 0.f;
#pragma unroll
                for (int bj = 0; bj < 2; ++bj) {
                    const f32x4 x0 = *(const f32x4*)(x + off + bj * 128), x1 = *(const f32x4*)(x + off + bj * 128 + 4);
                    const f32x4 h0 = x0 + acc[ai][bj][m][0] * rb, h1 = x1 + acc[ai][bj][m][1] * rb;
                    ss += (h0[0] * h0[0] + h0[1] * h0[1]) + (h0[2] * h0[2] + h0[3] * h0[3]) + (h1[0] * h1[0] + h1[1] * h1[1]) + (h1[2] * h1[2] + h1[3] * h1[3]);
                    u32x4 w; w.x = cvt_pk_bf16(h0[0], h0[1]); w.y = cvt_pk_bf16(h0[2], h0[3]); w.z = cvt_pk_bf16(h1[0], h1[1]); w.w = cvt_pk_bf16(h1[2], h1[3]);
                    *(GAS u32x4*)(hb + off + bj * 128) = w;
                    u32x2 w8; w8.x = pk4_fp8(h0[0], h0[1], h0[2], h0[3]); w8.y = pk4_fp8(h1[0], h1[1], h1[2], h1[3]);
                    *(GAS u32x2*)(h8 + off + bj * 128) = w8;
                }
                ss += __shfl_xor(ss, 16); ss += __shfl_xor(ss, 32);
                if (fq == 0) atomicAdd(ssq_h + row, ss);
                if (m == 3) asm volatile("" ::: "memory");
            }
    }
};
struct Epi5 {
    static constexpr bool PERM = true, MIDSCALE = false;
    typedef Meta8 Meta;
    unsigned char* ws; lcnt_t cnt;
    __device__ __forceinline__ Meta meta_load(const Unit& u, int wr, int fr) const {
        const GAS unsigned* rrs = (const GAS unsigned*)(opaque_ws(ws) + OFF_RW) + u.e * LCAP; const int ce = __builtin_amdgcn_readfirstlane(cnt[u.e]); Meta mt;
#pragma unroll
        for (int q = 0; q < 4; ++q) { const int i0 = u.r0 + wr * 64 + q * 16 + fr, i1 = i0 + 128;
            const unsigned a = rrs[min(i0, ce - 1)], b = rrs[min(i1, ce - 1)]; mt.lo[q] = (i0 < ce) ? a : 0u; mt.hi[q] = (i1 < ce) ? b : 0u; }
        return mt;
    }
    __device__ __forceinline__ void operator()(f32x4 (&acc)[2][2][4][2], const Unit& u, int wr, int wc, int fr, int fq, const Meta& mt) const {
        gbyte* hbuf = opaque_ws(ws) + OFF_B;
#pragma unroll
        for (int ai = 0; ai < 2; ++ai)
#pragma unroll
            for (int m = 0; m < 4; ++m) {
                const int r = ai * 128 + wr * 64 + m * 16 + fr;
                const float rs = __uint_as_float(ai ? mt.hi[m] : mt.lo[m]);
                float o[8];
#pragma unroll
                for (int n = 0; n < 2; ++n)
#pragma unroll
                    for (int j = 0; j < 4; ++j) o[4 * n + j] = silu_f(acc[ai][0][m][n][j] * rs) * (acc[ai][1][m][n][j] * rs);
                u32x2 w; w.x = pk4_fp8(o[0], o[1], o[2], o[3]); w.y = pk4_fp8(o[4], o[5], o[6], o[7]);
                *(GAS u32x2*)(hbuf + (size_t)(u.pm * 256 + r) * DE + u.pnl * 128 + wc * 32 + 8 * fq) = w;
                if (m & 1) asm volatile("" ::: "memory");
            }
    }
};
struct Epi6 {
    static constexpr bool PERM = true, MIDSCALE = false;
    typedef Meta8 Meta;
    unsigned char* ws; lcnt_t cnt;
    __device__ __forceinline__ Meta meta_load(const Unit& u, int wr, int fr) const {
        const GAS unsigned* rpk = (const GAS unsigned*)(opaque_ws(ws) + OFF_RINFO) + u.e * LCAP; const int ce = __builtin_amdgcn_readfirstlane(cnt[u.e]); Meta mt;
#pragma unroll
        for (int q = 0; q < 4; ++q) { const int i0 = u.r0 + wr * 64 + q * 16 + fr, i1 = i0 + 128;
            const unsigned a = rpk[min(i0, ce - 1)], b = rpk[min(i1, ce - 1)]; mt.lo[q] = (i0 < ce) ? a : 0xFFFFFFFFu; mt.hi[q] = (i1 < ce) ? b : 0xFFFFFFFFu; }
        return mt;
    }
    __device__ __forceinline__ void operator()(f32x4 (&acc)[2][2][4][2], const Unit& u, int wr, int wc, int fr, int fq, const Meta& mt) const {
        gbyte* ys2 = opaque_ws(ws) + OFF_A;
#pragma unroll
        for (int ai = 0; ai < 2; ++ai)
#pragma unroll
            for (int m = 0; m < 4; ++m) {
                const unsigned pk = ai ? mt.hi[m] : mt.lo[m]; const unsigned info = pk & 0xFFFFu;
                if (info < 2u * T_) {
                    const float g = __uint_as_float(pk & 0xFFFF0000u) * (YS_SCALE / WD_SCALE);
                    gbyte* dst = ys2 + (size_t)info * D_ + u.pnl * 256 + wc * 32 + 8 * fq;
#pragma unroll
                    for (int bj = 0; bj < 2; ++bj) {
                        const f32x4 v0 = acc[ai][bj][m][0] * g, v1 = acc[ai][bj][m][1] * g;
                        u32x2 w; w.x = pk4_fp8(v0[0], v0[1], v0[2], v0[3]); w.y = pk4_fp8(v1[0], v1[1], v1[2], v1[3]);
                        *(GAS u32x2*)(dst + bj * 128) = w;
                    }
                }
            }
    }
};

namespace pg8 {
constexpr int BM = 256, BK = 64, HALF = 128, HTB = HALF * BK * 2, STAGE_BYTES = 8 * HTB, NXCD = 8, WGM = 8;
__host__ __device__ __forceinline__ int lds_byte(int r, int c) { const int st = (r >> 4) * 2 + (c >> 5), rr = r & 15, cc = c & 31, ob = rr * 64 + cc * 2; return st * 1024 + (ob ^ (((ob >> 9) & 1) << 5)); }
__host__ __device__ __forceinline__ void stage_rc(int b, int& R, int& C) { const int st = b / 1024, sb = b % 1024, swz = sb ^ (((sb >> 9) & 1) << 5); R = (st >> 1) * 16 + swz / 64; C = (st & 1) * 32 + (swz % 64) / 2; }
__host__ __device__ __forceinline__ int perm32(int rho) { const int n = rho >> 4, i = rho & 15; return 8 * (i >> 2) + 4 * n + (i & 3); }

struct StaticOrder {
    int nM, nN, nwg, G, c;
    __device__ void init(int M, int N, int G_, int c_) { nM = M / BM; nN = N / BM; nwg = nM * nN; G = G_; c = c_; }
    __device__ bool next(int i, Unit& u) const {
        const long L = (long)i * G + c; if (L >= nwg) return false;
        int wgid = (int)L; { const int q = nwg / NXCD, r = nwg % NXCD, xcd = wgid % NXCD, off = wgid / NXCD; wgid = (xcd < r ? xcd * (q + 1) : r * (q + 1) + (xcd - r) * q) + off; }
        const int nig = WGM * nN, gid = wgid / nig, fm = gid * WGM, gsz = (nM - fm) < WGM ? (nM - fm) : WGM;
        u.pm = fm + ((wgid % nig) % gsz); u.pn = (wgid % nig) / gsz; u.e = i; u.r0 = 0; u.pnl = u.pn; return true;
    }
};
struct MoeOrder {
    lcnt_t cnt; int NT, G, c;
    __device__ __forceinline__ bool next(int i, Unit& u) const { return moe_unit(cnt, NT, i * G + c, u); }
};
struct AOffDirect { int K; struct Pre {};
    __device__ __forceinline__ Pre pre(const Unit&, int, int) const { return Pre{}; }
    __device__ __forceinline__ unsigned fin(const Pre&, const Unit& u, int h, int i, int R, int C) const { return (unsigned)(((u.pm * 256 + h * 128 + R) * K + C) * 2); } };
struct AOffGather { unsigned char* ws; lcnt_t cnt; int K;
    struct Pre { unsigned pk[2][2]; };
    __device__ __forceinline__ Pre pre(const Unit& u, int R0, int R1) const {
        const GAS unsigned* rpk = (const GAS unsigned*)(opaque_ws(ws) + OFF_RINFO) + u.e * LCAP; const int ce = __builtin_amdgcn_readfirstlane(cnt[u.e]); Pre p;
#pragma unroll
        for (int h = 0; h < 2; ++h) { const int i0 = u.r0 + h * 128 + R0, i1 = u.r0 + h * 128 + R1;
            p.pk[h][0] = rpk[min(i0, ce - 1)]; p.pk[h][1] = rpk[min(i1, ce - 1)]; }
        return p;
    }
    __device__ __forceinline__ unsigned fin(const Pre& p, const Unit&, int h, int i, int, int C) const { const int tok = (int)((p.pk[h][i] & 0xFFFFu) >> 1); return (unsigned)((tok * K + C) * 2); } };

template <class Epi, class Sched, class AOff, bool ALIGN_EPI, bool FP8 = false>
__device__ __forceinline__ void gemm_phase(PG8_LAS unsigned char* lds, const bf16_t* Ag, const bf16_t* Btg, const int K, const Sched& S, const AOff& AO, const Epi& E) {
    const int tid = opaque_tid(), wid = __builtin_amdgcn_readfirstlane(tid >> 6), lane = tid & 63, wr = wid >> 2, wc = wid & 3, fr = lane & 15, fq = lane >> 4;
    int nt = K / BK; asm volatile("" : "+s"(nt));
    unsigned voffB[2];
#pragma unroll
    for (int i = 0; i < 2; ++i) { int R, C; stage_rc(tid * 16 + i * 8192, R, C); const int Rb = Epi::PERM ? ((R & ~31) + perm32(R & 31)) : R; voffB[i] = (unsigned)(Rb * K + C) * 2u; }
#define PG8_APRE(u, pv_) do { int _t = tid; asm volatile("" : "+v"(_t)); int _R0, _R1, _C; stage_rc(_t * 16, _R0, _C); stage_rc(_t * 16 + 8192, _R1, _C); pv_ = AO.pre(u, _R0, _R1); } while (0)
#define PG8_AFIN(u, pv_, d0, d1) do { int _t = tid; asm volatile("" : "+v"(_t)); _Pragma("unroll") for (int _i = 0; _i < 2; ++_i) { int _R, _C; stage_rc(_t * 16 + _i * 8192, _R, _C); d0[_i] = AO.fin(pv_, u, 0, _i, _R, _C); d1[_i] = AO.fin(pv_, u, 1, _i, _R, _C); } } while (0)
#define PG8_LANE(fr_, fq_) int fr_, fq_; { int _t = tid; asm volatile("" : "+v"(_t)); fr_ = _t & 15; fq_ = (_t & 63) >> 4; }
    const unsigned kstep = (unsigned)(BK * 2), hstep = (unsigned)HALF * (unsigned)K * 2u, tstep = 2u * hstep;
    const unsigned ldsw = (unsigned)wid * 1024u;
    const int aoff = lds_byte(wr * 64 + fr, fq * 8), boff = lds_byte(wc * 32 + fr, fq * 8);
    const char* const Ab = (const char*)Ag; const char* const Bb = (const char*)Btg;
#define PG8_SA(b, h) (((b) * 2 + (h)) * HTB)
#define PG8_SB(b, h) ((4 + (b) * 2 + (h)) * HTB)
#define PG8_STAGE(bufoff, gbase, uoff, voff) do { _Pragma("unroll") for (int _i = 0; _i < 2; ++_i) \
        __builtin_amdgcn_global_load_lds((const unsigned*)((gbase) + (size_t)(unsigned)((uoff) + (voff)[_i])), (PG8_LAS unsigned*)(lds + (bufoff) + ldsw + _i * 8192), 16, 0, 0); } while (0)
#define PG8_LD32(base) __builtin_shufflevector(*(const PG8_LAS v4i*)(base), *(const PG8_LAS v4i*)((base) + 1024), 0, 1, 2, 3, 4, 5, 6, 7)
#define PG8_LDA(dst, b, h) do { _Pragma("unroll") for (int m = 0; m < 4; ++m) dst[m] = PG8_LD32(lds + PG8_SA(b, h) + aoff + m * 2048); } while (0)
#define PG8_LDB(dst, b, h) do { _Pragma("unroll") for (int n = 0; n < 2; ++n) dst[n] = PG8_LD32(lds + PG8_SB(b, h) + boff + n * 2048); } while (0)
#define PG8_LO(x) __builtin_bit_cast(bf16x8, __builtin_shufflevector((x), (x), 0, 1, 2, 3))
#define PG8_HI(x) __builtin_bit_cast(bf16x8, __builtin_shufflevector((x), (x), 4, 5, 6, 7))
#define PG8_MMA(ai, bj, At, Bt) do { __builtin_amdgcn_s_setprio(1); _Pragma("unroll") for (int m = 0; m < 4; ++m) _Pragma("unroll") for (int n = 0; n < 2; ++n) { \
        if constexpr (FP8) acc[ai][bj][m][n] = __builtin_amdgcn_mfma_scale_f32_16x16x128_f8f6f4(Bt[n], At[m], acc[ai][bj][m][n], 0, 0, 0, 0, 0, 0);   \
        else { acc[ai][bj][m][n] = __builtin_amdgcn_mfma_f32_16x16x32_bf16(PG8_LO(Bt[n]), PG8_LO(At[m]), acc[ai][bj][m][n], 0, 0, 0); \
               acc[ai][bj][m][n] = __builtin_amdgcn_mfma_f32_16x16x32_bf16(PG8_HI(Bt[n]), PG8_HI(At[m]), acc[ai][bj][m][n], 0, 0, 0); } } \
        __builtin_amdgcn_s_setprio(0); } while (0)
#define PG8_WAIT_V(n) asm volatile("s_waitcnt vmcnt(" #n ")" ::: "memory")
#define PG8_WAIT_L(n) asm volatile("s_waitcnt lgkmcnt(" #n ")" ::: "memory")
#define PG8_BAR __builtin_amdgcn_s_barrier()
#define PG8_SCHED __builtin_amdgcn_sched_barrier(0)
    Unit cur, nxt; int ui = 0;
    if (!S.next(0, cur)) return;
    f32x4 acc[2][2][4][2];
#pragma unroll
    for (int a = 0; a < 2; ++a)
#pragma unroll
        for (int b = 0; b < 2; ++b)
#pragma unroll
            for (int m = 0; m < 4; ++m)
#pragma unroll
                for (int n = 0; n < 2; ++n) acc[a][b][m][n] = (f32x4){0.f, 0.f, 0.f, 0.f};
    v8i At[4], B0[2], B1[2];
    unsigned vo0[2], vo1[2];
    PG8_LAS u32x4* const svn = (PG8_LAS u32x4*)(lds + XS_OFF) + tid;
    PG8_LAS u32x4* const smeta = (PG8_LAS u32x4*)(lds + XM_OFF + tid * 32);
    constexpr bool HAS_META = sizeof(typename Epi::Meta) > 1;
    bool has_next = S.next(1, nxt);
    { typename AOff::Pre pc; PG8_APRE(cur, pc); PG8_AFIN(cur, pc, vo0, vo1);
      unsigned vn0[2], vn1[2];
      if (has_next) { typename AOff::Pre pn; PG8_APRE(nxt, pn); PG8_AFIN(nxt, pn, vn0, vn1); } else { vn0[0] = vo0[0]; vn0[1] = vo0[1]; vn1[0] = vo1[0]; vn1[1] = vo1[1]; }
      *svn = (u32x4){vn0[0], vn0[1], vn1[0], vn1[1]}; }
    if constexpr (HAS_META) { PG8_LANE(fr_, fq_); (void)fq_; const typename Epi::Meta m0 = E.meta_load(cur, wr, fr_); smeta[0] = m0.lo; smeta[1] = m0.hi; }
    unsigned cB = (unsigned)cur.pn * tstep;
    PG8_STAGE(PG8_SB(0, 0), Bb, cB, voffB); PG8_STAGE(PG8_SB(0, 1), Bb, cB + hstep, voffB); PG8_STAGE(PG8_SA(0, 0), Ab, 0u, vo0); PG8_STAGE(PG8_SA(0, 1), Ab, 0u, vo1);
    if (wr == 1) PG8_BAR;
    PG8_WAIT_V(2); PG8_BAR;
    PG8_STAGE(PG8_SB(1, 0), Bb, cB + kstep, voffB); PG8_STAGE(PG8_SA(1, 0), Ab, kstep, vo0); PG8_STAGE(PG8_SB(1, 1), Bb, cB + hstep + kstep, voffB);
    PG8_WAIT_V(6); PG8_BAR;
    for (;;) {
        const unsigned nB = has_next ? (unsigned)nxt.pn * tstep : cB;
#pragma clang loop unroll(disable)
        for (int t = 0; t < nt; t += 2) {
            const bool last = (t == nt - 2);
            if constexpr (Epi::MIDSCALE) { if (t == nt / 2) { PG8_LANE(fr_, fq_); E.midscale(acc, cur, wr, wc, fr_, fq_); } }
            const unsigned k1 = (unsigned)(t + 1) * kstep, k2 = last ? 0u : (unsigned)(t + 2) * kstep, k3 = k2 + kstep;
            const unsigned b2 = last ? nB : cB + (unsigned)(t + 2) * kstep, b3 = b2 + kstep;
            PG8_LDB(B0, 0, 0); PG8_LDB(B1, 0, 1); PG8_SCHED; PG8_LDA(At, 0, 0); PG8_STAGE(PG8_SA(1, 1), Ab, k1, vo1);
            PG8_WAIT_V(8); PG8_WAIT_L(0); PG8_BAR; PG8_MMA(0, 0, At, B0); PG8_MMA(0, 1, At, B1); PG8_BAR; PG8_SCHED;
            if (last) { PG8_LAS u32x4* sp_ = svn; asm volatile("" : "+v"(sp_));
                const u32x4 v = *sp_; vo0[0] = v.x; vo0[1] = v.y; vo1[0] = v.z; vo1[1] = v.w; }
            PG8_LDA(At, 0, 1); PG8_STAGE(PG8_SB(0, 0), Bb, b2, voffB); PG8_STAGE(PG8_SB(0, 1), Bb, b2 + hstep, voffB); PG8_STAGE(PG8_SA(0, 0), Ab, k2, vo0);
            PG8_WAIT_V(8); PG8_WAIT_L(0); PG8_BAR; PG8_MMA(1, 0, At, B0); PG8_MMA(1, 1, At, B1); PG8_BAR; PG8_SCHED;
            PG8_LDB(B0, 1, 0); PG8_LDB(B1, 1, 1); PG8_SCHED; PG8_LDA(At, 1, 0); PG8_STAGE(PG8_SA(0, 1), Ab, k2, vo1);
            PG8_WAIT_V(8); PG8_WAIT_L(0); PG8_BAR; PG8_MMA(0, 0, At, B0); PG8_MMA(0, 1, At, B1); PG8_BAR; PG8_SCHED;
            PG8_LDA(At, 1, 1); PG8_STAGE(PG8_SB(1, 0), Bb, b3, voffB); PG8_STAGE(PG8_SB(1, 1), Bb, b3 + hstep, voffB); PG8_STAGE(PG8_SA(1, 0), Ab, k3, vo0);
            PG8_WAIT_V(8); PG8_WAIT_L(0); PG8_BAR; PG8_MMA(1, 0, At, B0); PG8_MMA(1, 1, At, B1); PG8_BAR; PG8_SCHED;
        }
        if constexpr (ALIGN_EPI) { if (wr == 0) PG8_BAR; }
        Unit nn; const bool has2 = has_next && S.next(ui + 2, nn);
        typename Epi::Meta mnext;
        { PG8_LANE(fr_, fq_);
          typename Epi::Meta meta; if constexpr (HAS_META) { PG8_LAS u32x4* sp_ = smeta; asm volatile("" : "+v"(sp_)); meta.lo = sp_[0]; meta.hi = sp_[1]; }
          if (has_next) mnext = E.meta_load(nxt, wr, fr_);
          if (has2) { typename AOff::Pre pnn; PG8_APRE(nn, pnn); unsigned vn0[2], vn1[2]; PG8_AFIN(nn, pnn, vn0, vn1); *svn = (u32x4){vn0[0], vn0[1], vn1[0], vn1[1]}; }
          E(acc, cur, wr, wc, fr_, fq_, meta); }
        if (!has_next) break;
        if constexpr (HAS_META) { smeta[0] = mnext.lo; smeta[1] = mnext.hi; }
#pragma unroll
        for (int a = 0; a < 2; ++a)
#pragma unroll
            for (int b = 0; b < 2; ++b)
#pragma unroll
                for (int m = 0; m < 4; ++m)
#pragma unroll
                    for (int n = 0; n < 2; ++n) acc[a][b][m][n] = (f32x4){0.f, 0.f, 0.f, 0.f};
        cur = nxt; nxt = nn; has_next = has2; cB = nB; ++ui;
        if constexpr (ALIGN_EPI) { if (wr == 1) PG8_BAR; }
    }
    PG8_WAIT_V(0);
    if constexpr (!ALIGN_EPI) { if (wr == 0) PG8_BAR; }
    PG8_BAR;
#undef PG8_APRE
#undef PG8_AFIN
#undef PG8_LANE
#undef PG8_SA
#undef PG8_SB
#undef PG8_STAGE
#undef PG8_LDA
#undef PG8_LDB
#undef PG8_MMA
#undef PG8_LO
#undef PG8_HI
#undef PG8_LD32
#undef PG8_WAIT_V
#undef PG8_WAIT_L
#undef PG8_BAR
#undef PG8_SCHED
}
}


#define XB_TMO      128
#define XB_XCNT(j)  (256  + 64 * (j))
#define XB_XSUB(j)  (1280 + 64 * (j))
#define XB_XGEN(j)  (2304 + 64 * (j))
#define XB_TOP      3328
#define XB_TOPGEN   3392
#define XCD_BAR_WORDS 3456
#define XB_SPIN_CAP (1u << 18)
__device__ __forceinline__ unsigned xb_ld(unsigned* p)              { return __hip_atomic_load(p, __ATOMIC_RELAXED, __HIP_MEMORY_SCOPE_AGENT); }
__device__ __forceinline__ unsigned xb_add(unsigned* p, unsigned v) { return __hip_atomic_fetch_add(p, v, __ATOMIC_RELAXED, __HIP_MEMORY_SCOPE_AGENT); }
__device__ __forceinline__ unsigned xb_xcc_id() { return (unsigned)__builtin_amdgcn_s_getreg((3 << 11) | 20) & 0xFu; }
#define XB_SPIN(cond, bar) do { unsigned _sp = 0; while (cond) { __builtin_amdgcn_s_sleep(1); \
    if ((++_sp & 255u) == 0u) { if (xb_ld(&(bar)[XB_TMO])) break; if (_sp > XB_SPIN_CAP) { atomicAdd(&(bar)[XB_TMO], 1u); break; } } } } while (0)
struct XcdBarrier { unsigned* bar; unsigned x; volatile PG8_LAS unsigned* st; };
__device__ __forceinline__ XcdBarrier xcd_barrier_post(unsigned* bar, volatile PG8_LAS unsigned* st) {
    XcdBarrier b; b.bar = bar; b.x = xb_xcc_id(); b.st = st;
    if (threadIdx.x == 0) (void)xb_add(&bar[XB_XCNT(b.x)], 1u);
    return b;
}
__device__ __forceinline__ void xcd_barrier_complete(unsigned* bar, unsigned x, unsigned& nloc, unsigned& nx) {
    const unsigned G = gridDim.x * gridDim.y * gridDim.z;
    unsigned sum, cnt, mine, sp = 0u;
    for (;;) {
        sum = 0u; cnt = 0u; mine = 0u;
#pragma unroll
        for (unsigned j = 0; j < 16; ++j) { const unsigned c = xb_ld(&bar[XB_XCNT(j)]); sum += c; cnt += (c > 0u) ? 1u : 0u; mine = (j == x) ? c : mine; }
        if (sum == G) break;
        __builtin_amdgcn_s_sleep(1);
        if ((++sp & 255u) == 0u) { if (xb_ld(&bar[XB_TMO])) break; if (sp > XB_SPIN_CAP) { atomicAdd(&bar[XB_TMO], 1u); break; } }
    }
    nloc = mine > 0u ? mine : 1u; nx = cnt > 0u ? cnt : 1u;
}
__device__ __forceinline__ void xcd_barrier(const XcdBarrier& b) {
    asm volatile("s_waitcnt vmcnt(0)" ::: "memory");
    __syncthreads();
    if (threadIdx.x == 0) {
        unsigned* bar = b.bar;
        __builtin_amdgcn_s_waitcnt(0);
        unsigned nloc = b.st[0], nx = b.st[1];
        if (nloc == 0u) { xcd_barrier_complete(bar, b.x, nloc, nx); b.st[0] = nloc; b.st[1] = nx; }
        const unsigned old = xb_add(&bar[XB_XSUB(b.x)], 1u);
        const unsigned gen = old / nloc;
        if (old + 1u == (gen + 1u) * nloc) {
            __builtin_amdgcn_fence(__ATOMIC_RELEASE, "agent");
            asm volatile("s_waitcnt vmcnt(0)" ::: "memory");
            const unsigned og = xb_add(&bar[XB_TOP], 1u);
            const unsigned tg = og / nx;
            if (og + 1u == (tg + 1u) * nx) xb_add(&bar[XB_TOPGEN], 1u);
            else XB_SPIN(xb_ld(&bar[XB_TOPGEN]) == tg, bar);
            __builtin_amdgcn_fence(__ATOMIC_ACQUIRE, "agent");
            xb_add(&bar[XB_XGEN(b.x)], 1u);
            asm volatile("s_waitcnt vmcnt(0)" ::: "memory");
        } else {
            XB_SPIN(xb_ld(&bar[XB_XGEN(b.x)]) == gen, bar);
            __builtin_amdgcn_fence(__ATOMIC_ACQUIRE, "agent");
            asm volatile("s_waitcnt vmcnt(0)" ::: "memory");
        }
    }
    __syncthreads();
}

struct TJob { const float* src; int ld; unsigned char* dst; int lddst; float sc; const float* sk; int fp8; };
__device__ __forceinline__ bool tjob_decode(const Params& p, int q, TJob& j) {
    constexpr int N_IN = 16 * 80, N_OUT = 16 * 32, N_G = 32 * 128;
    if (q < N_IN) { const int tr = q / 80, tc = q % 80; j.src = p.w_in + (size_t)tr * 128 * DIN + tc * 64; j.ld = DIN; j.dst = p.ws + OFF_WIN + ((size_t)tc * 64 * D_ + tr * 128) * 2; j.lddst = D_ * 2; j.sc = 1.f; j.sk = nullptr; j.fp8 = 0; return true; } q -= N_IN;
    if (q < N_OUT) { const int tr = q / 32, tc = q % 32; j.src = p.w_out + (size_t)tr * 128 * D_ + tc * 64; j.ld = D_; j.dst = p.ws + OFF_WOUT + ((size_t)tc * 64 * D_ + tr * 128) * 2; j.lddst = D_ * 2; j.sc = 1.f;
        j.sk = (tr < 8 ? p.g_a + tr * 128 : p.g_b + (tr - 8) * 128); j.fp8 = 0; return true; } q -= N_OUT;
    if (q < 2 * N_G) { const int up = q >= N_G; if (up) q -= N_G; const int e = q >> 7, rem = q & 127, tr = rem >> 3, tc = rem & 7, c0 = tc * 64;
        j.src = (up ? p.ewu : p.ewg) + (size_t)e * D_ * DE + (size_t)tr * 128 * DE + c0; j.ld = DE;
        j.dst = p.ws + OFF_WGU + (size_t)e * 1024 * D_ + (size_t)((c0 >> 7) * 256 + (up ? 128 : 0) + (c0 & 127)) * D_ + tr * 128; j.lddst = D_; j.sc = WGU_SCALE; j.sk = p.g_ffn + tr * 128; j.fp8 = 1; return true; } q -= 2 * N_G;
    if (q < N_G) { const int e = q >> 7, rem = q & 127, tr = rem >> 5, tc = rem & 31;
        j.src = p.ewd + (size_t)e * DE * D_ + (size_t)tr * 128 * D_ + tc * 64; j.ld = D_; j.dst = p.ws + OFF_WD + (size_t)e * D_ * DE + (size_t)tc * 64 * DE + tr * 128; j.lddst = DE; j.sc = WD_SCALE; j.sk = nullptr; j.fp8 = 1; return true; }
    return false;
}
constexpr int N_TJOBS = 16 * 80 + 16 * 32 + 3 * 32 * 128;
struct TRegs { f32x4 v[4]; };
__device__ __forceinline__ void tjob_load(const TJob& j, int tid, TRegs& r) {
    const float* sp = j.src + (size_t)(tid >> 2) * j.ld + (tid & 3) * 16;
#pragma unroll
    for (int q = 0; q < 4; ++q) r.v[q] = *(const f32x4*)(sp + 4 * q);
}
__device__ __forceinline__ void tjob_finish(const TJob& j, int tid, const TRegs& r, float* lt) {
    { const int rr = tid >> 2, cc = (tid & 3) * 16; const float f = j.sk ? j.sc * j.sk[rr] : j.sc;
#pragma unroll
      for (int q = 0; q < 4; ++q)
#pragma unroll
          for (int e = 0; e < 4; ++e) lt[rr * 65 + cc + 4 * q + e] = r.v[q][e] * f; }
    __syncthreads();
    { const int c = tid >> 3, rr = (tid & 7) * 16; float v[16];
#pragma unroll
      for (int q = 0; q < 16; ++q) v[q] = lt[(rr + q) * 65 + c];
      unsigned char* d = j.dst + (size_t)c * j.lddst;
      if (j.fp8) { u32x4 w; w.x = pk4_fp8(v[0], v[1], v[2], v[3]); w.y = pk4_fp8(v[4], v[5], v[6], v[7]); w.z = pk4_fp8(v[8], v[9], v[10], v[11]); w.w = pk4_fp8(v[12], v[13], v[14], v[15]);
          *(u32x4*)(d + rr) = w; }
      else { u32x4 w0, w1; w0.x = cvt_pk_bf16(v[0], v[1]); w0.y = cvt_pk_bf16(v[2], v[3]); w0.z = cvt_pk_bf16(v[4], v[5]); w0.w = cvt_pk_bf16(v[6], v[7]);
          w1.x = cvt_pk_bf16(v[8], v[9]); w1.y = cvt_pk_bf16(v[10], v[11]); w1.z = cvt_pk_bf16(v[12], v[13]); w1.w = cvt_pk_bf16(v[14], v[15]);
          *(u32x4*)(d + rr * 2) = w0; *(u32x4*)(d + rr * 2 + 16) = w1; } }
}
__device__ __forceinline__ void phase0(const Params& p, unsigned char* lds) {
    const int tid = opaque_tid(), nb = gridDim.x, bid = blockIdx.x, wid = tid >> 6, lane = tid & 63;
    { float* z = (float*)(p.ws + OFF_SSQ);
      for (int i = bid * NTHR + tid; i < 3 * T_ + 64; i += nb * NTHR) z[i] = 0.f;
      if (DUP_PHASE >= 2 && DUP_PHASE <= 4) { float* zd = (float*)(p.ws + OFF_SSQ + (OFF_DUMMY - OFF_SSQ)); for (int i = bid * NTHR + tid; i < 3 * T_ + 64; i += nb * NTHR) zd[i] = 0.f; } }
    { bf16_t* wrt = (bf16_t*)(p.ws + OFF_WR);
      for (int i = bid * NTHR + tid; i < 48 * D_; i += nb * NTHR) {
          const int o = i >> 11, k = i & 2047; float v = 0.f;
          if (o < 4) v = p.rgw[k * 4 + o]; else if (o < 36) v = p.rew[k * 32 + (o - 4)];
          wrt[i] = (bf16_t)(cvt_pk_bf16(v * p.g_ffn[k], 0.f) & 0xffffu); } }
    { bf16_t* xn = (bf16_t*)(p.ws + OFF_B);
      for (int row = bid * 8 + wid; row < T_; row += nb * 8) {
          const float* xr = p.x + (size_t)row * D_;
          f32x4 v[8]; float s = 0.f;
#pragma unroll
          for (int i = 0; i < 8; ++i) { v[i] = *(const f32x4*)(xr + i * 256 + lane * 4); s += (v[i][0] * v[i][0] + v[i][1] * v[i][1]) + (v[i][2] * v[i][2] + v[i][3] * v[i][3]); }
          const float rstd = rsqrtf(wave_sum(s) * (1.f / D_) + EPS);
#pragma unroll
          for (int i = 0; i < 8; ++i) { const f32x4 g = *(const f32x4*)(p.norm_mix_g + i * 256 + lane * 4); const f32x4 o = v[i] * rstd * g;
              u32x2 w; w.x = cvt_pk_bf16(o[0], o[1]); w.y = cvt_pk_bf16(o[2], o[3]); *(u32x2*)(xn + (size_t)row * D_ + i * 256 + lane * 4) = w; } } }
    float* lt0 = (float*)lds; float* lt1 = lt0 + 128 * 65;
    TJob j0, j1, j2; TRegs r0, r1, r2;
    int q = bid; bool h0 = tjob_decode(p, q, j0), h1 = tjob_decode(p, q + nb, j1), h2 = tjob_decode(p, q + 2 * nb, j2);
    if (h0) tjob_load(j0, tid, r0); if (h1) tjob_load(j1, tid, r1); if (h2) tjob_load(j2, tid, r2);
    while (h0) {
        tjob_finish(j0, tid, r0, lt0); q += 3 * nb; h0 = tjob_decode(p, q, j0); if (h0) tjob_load(j0, tid, r0);
        if (!h1) break;
        tjob_finish(j1, tid, r1, lt1); h1 = tjob_decode(p, q + nb, j1); if (h1) tjob_load(j1, tid, r1);
        if (!h2) break;
        tjob_finish(j2, tid, r2, lt0); h2 = tjob_decode(p, q + 2 * nb, j2); if (h2) tjob_load(j2, tid, r2);
        if (!h0) break;
        tjob_finish(j0, tid, r0, lt1); q += 3 * nb; h0 = tjob_decode(p, q, j0); if (h0) tjob_load(j0, tid, r0);
        if (!h1) break;
        tjob_finish(j1, tid, r1, lt0); h1 = tjob_decode(p, q + nb, j1); if (h1) tjob_load(j1, tid, r1);
        if (!h2) break;
        tjob_finish(j2, tid, r2, lt1); h2 = tjob_decode(p, q + 2 * nb, j2); if (h2) tjob_load(j2, tid, r2);
    }
    __syncthreads();
}

__device__ __forceinline__ void phase1(const Params& p, unsigned char* lds) {
    const Epi1 E{p.ws};
    pg8::StaticOrder S; S.init(T_, DIN, gridDim.x, blockIdx.x); const pg8::AOffDirect AO{D_};
    pg8::gemm_phase<Epi1, pg8::StaticOrder, pg8::AOffDirect, true>((PG8_LAS unsigned char*)lds, (const bf16_t*)(p.ws + OFF_B), (const bf16_t*)(p.ws + OFF_WIN), D_, S, AO, E);
}

__device__ __forceinline__ void mixer_gmlp_item(const Params& p, unsigned char* lds, int item, size_t so) {
    const int tid = opaque_tid(), wid = tid >> 6, lane = tid & 63, fr = lane & 15, fq = lane >> 4;
    const int h = item & 7, t0 = (item >> 3) * 128;
    const bf16_t* P = (const bf16_t*)(p.ws + OFF_A); bf16_t* Y = (bf16_t*)(p.ws + OFF_B); float* ssq_a = (float*)(p.ws + OFF_SSQ + so);
    bf16_t* Vt = (bf16_t*)lds;
    bf16_t* Wl = Vt + 128 * 136;
    float* rs = (float*)(Wl + 128 * 136);
    { const int j = tid >> 2, dc = (tid & 3) * 32;
      const u32x4* src = (const u32x4*)(P + (size_t)(t0 + j) * DIN + 1024 + h * 128 + dc);
      u32x4 v[4]; float s = 0.f;
#pragma unroll
      for (int q = 0; q < 4; ++q) { v[q] = src[q];
#pragma unroll
          for (int w = 0; w < 4; ++w) { const float lo = bflo(v[q][w]), hi = bfhi(v[q][w]); s += lo * lo + hi * hi; } }
      s += __shfl_xor(s, 1); s += __shfl_xor(s, 2);
      if ((tid & 3) == 0) rs[j] = rsqrtf(s * (1.f / 128.f) + EPS);
#pragma unroll
      for (int q = 0; q < 4; ++q)
#pragma unroll
          for (int w = 0; w < 4; ++w) { const int d = dc + q * 8 + w * 2; Vt[d * 136 + j] = (bf16_t)(v[q][w] & 0xffffu); Vt[(d + 1) * 136 + j] = (bf16_t)(v[q][w] >> 16); } }
    __syncthreads();
    { const int i = tid >> 2, jc = (tid & 3) * 32;
      const f32x4* src = (const f32x4*)(p.gmlp_ws + (size_t)h * 16384 + i * 128 + jc);
      const bool live = (i >> 6) >= (jc >> 6);
#pragma unroll
      for (int q = 0; q < 4; ++q) { f32x4 w0 = src[2 * q], w1 = src[2 * q + 1];
          const f32x4 r0 = *(const f32x4*)(rs + jc + 8 * q), r1 = *(const f32x4*)(rs + jc + 8 * q + 4);
          w0 = live ? w0 * r0 : (f32x4){0.f, 0.f, 0.f, 0.f}; w1 = live ? w1 * r1 : (f32x4){0.f, 0.f, 0.f, 0.f};
          u32x4 o; o.x = cvt_pk_bf16(w0[0], w0[1]); o.y = cvt_pk_bf16(w0[2], w0[3]); o.z = cvt_pk_bf16(w1[0], w1[1]); o.w = cvt_pk_bf16(w1[2], w1[3]);
          *(u32x4*)(Wl + i * 136 + jc + 8 * q) = o; } }
    __syncthreads();
    f32x4 acc[8];
#pragma unroll
    for (int n = 0; n < 8; ++n) acc[n] = (f32x4){0.f, 0.f, 0.f, 0.f};
    const int ksteps = (wid < 4) ? 2 : 4;
    for (int ks = 0; ks < ksteps; ++ks) {
        const bf16x8 bw = *(const bf16x8*)(Wl + (16 * wid + fr) * 136 + ks * 32 + fq * 8);
#pragma unroll
        for (int n = 0; n < 8; ++n) { const bf16x8 av = *(const bf16x8*)(Vt + (16 * n + fr) * 136 + ks * 32 + fq * 8);
            acc[n] = __builtin_amdgcn_mfma_f32_16x16x32_bf16(av, bw, acc[n], 0, 0, 0); }
    }
    { const int i = 16 * wid + fr, t = t0 + i; const float bias = p.gmlp_bs[h * 128 + i]; float ss = 0.f;
#pragma unroll
      for (int n = 0; n < 8; ++n) { const int c = h * 128 + 16 * n + 4 * fq;
          const f32x4 g = *(const f32x4*)(p.v_norm_g + c); const u32x2 uu = *(const u32x2*)(P + (size_t)t * DIN + c);
          const float y0 = bflo(uu.x) * (acc[n][0] * g[0] + bias), y1 = bfhi(uu.x) * (acc[n][1] * g[1] + bias), y2 = bflo(uu.y) * (acc[n][2] * g[2] + bias), y3 = bfhi(uu.y) * (acc[n][3] * g[3] + bias);
          ss += (y0 * y0 + y1 * y1) + (y2 * y2 + y3 * y3);
          u32x2 w; w.x = cvt_pk_bf16(y0, y1); w.y = cvt_pk_bf16(y2, y3); *(u32x2*)(Y + (size_t)t * D_ + c) = w; }
      ss += __shfl_xor(ss, 16); ss += __shfl_xor(ss, 32);
      if (fq == 0) atomicAdd(ssq_a + t, ss); }
    __syncthreads();
}
__device__ __forceinline__ void mixer_conv_item(const Params& p, int item, size_t so) {
    const int tid = opaque_tid(), cl = tid & 31, ts = tid >> 5;
    const int c = (item & 3) * 256 + cl * 8, tbeg = (item >> 2) * 128 + ts * 8;
    const bf16_t* P = (const bf16_t*)(p.ws + OFF_A); bf16_t* Y = (bf16_t*)(p.ws + OFF_B); float* ssq_b = (float*)(p.ws + OFF_SSQ + so) + T_;
    float w0[8], w1[8], w2[8], z1[8], z2[8];
    { const f32x4 a0 = *(const f32x4*)(p.conv_w + c), a1 = *(const f32x4*)(p.conv_w + c + 4), b0 = *(const f32x4*)(p.conv_w + 1024 + c), b1 = *(const f32x4*)(p.conv_w + 1024 + c + 4),
                  c0 = *(const f32x4*)(p.conv_w + 2048 + c), c1 = *(const f32x4*)(p.conv_w + 2048 + c + 4);
#pragma unroll
      for (int q = 0; q < 4; ++q) { w0[q] = a0[q]; w0[4 + q] = a1[q]; w1[q] = b0[q]; w1[4 + q] = b1[q]; w2[q] = c0[q]; w2[4 + q] = c1[q]; } }
#pragma unroll
    for (int q = 0; q < 8; ++q) { z1[q] = 0.f; z2[q] = 0.f; }
    if ((tbeg % SEQ) != 0) {
        const u32x4 ca = *(const u32x4*)(P + (size_t)(tbeg - 1) * DIN + 3072 + c), ha = *(const u32x4*)(P + (size_t)(tbeg - 1) * DIN + 4096 + c);
        const u32x4 cb = *(const u32x4*)(P + (size_t)(tbeg - 2) * DIN + 3072 + c), hb2 = *(const u32x4*)(P + (size_t)(tbeg - 2) * DIN + 4096 + c);
#pragma unroll
        for (int q = 0; q < 4; ++q) { z1[2 * q] = bflo(ca[q]) * bflo(ha[q]); z1[2 * q + 1] = bfhi(ca[q]) * bfhi(ha[q]); z2[2 * q] = bflo(cb[q]) * bflo(hb2[q]); z2[2 * q + 1] = bfhi(cb[q]) * bfhi(hb2[q]); }
    }
    u32x4 bgA[8], cgA[8], hvA[8];
#pragma unroll
    for (int tt = 0; tt < 8; ++tt) { const bf16_t* pr = P + (size_t)(tbeg + tt) * DIN + c; bgA[tt] = *(const u32x4*)(pr + 2048); cgA[tt] = *(const u32x4*)(pr + 3072); hvA[tt] = *(const u32x4*)(pr + 4096); }
#pragma unroll
    for (int tt = 0; tt < 8; ++tt) {
        const int t = tbeg + tt;
        const u32x4 bg = bgA[tt], cgv = cgA[tt], hv = hvA[tt];
        float z[8], y[8], ss = 0.f;
#pragma unroll
        for (int q = 0; q < 4; ++q) { z[2 * q] = bflo(cgv[q]) * bflo(hv[q]); z[2 * q + 1] = bfhi(cgv[q]) * bfhi(hv[q]); }
#pragma unroll
        for (int q = 0; q < 4; ++q) {
            y[2 * q] = bflo(bg[q]) * (w0[2 * q] * z2[2 * q] + w1[2 * q] * z1[2 * q] + w2[2 * q] * z[2 * q]);
            y[2 * q + 1] = bfhi(bg[q]) * (w0[2 * q + 1] * z2[2 * q + 1] + w1[2 * q + 1] * z1[2 * q + 1] + w2[2 * q + 1] * z[2 * q + 1]); }
#pragma unroll
        for (int q = 0; q < 8; ++q) { ss += y[q] * y[q]; z2[q] = z1[q]; z1[q] = z[q]; }
        u32x4 w; w.x = cvt_pk_bf16(y[0], y[1]); w.y = cvt_pk_bf16(y[2], y[3]); w.z = cvt_pk_bf16(y[4], y[5]); w.w = cvt_pk_bf16(y[6], y[7]);
        *(u32x4*)(Y + (size_t)t * D_ + 1024 + c) = w;
        ss += __shfl_xor(ss, 1); ss += __shfl_xor(ss, 2); ss += __shfl_xor(ss, 4); ss += __shfl_xor(ss, 8); ss += __shfl_xor(ss, 16);
        if (cl == 0) atomicAdd(ssq_b + t, ss);
    }
}
__device__ __forceinline__ void phase2(const Params& p, unsigned char* lds, size_t so = 0) {
    for (int it = blockIdx.x; it < 512 + 1024; it += gridDim.x) { if (it < 512) mixer_conv_item(p, it, so); else mixer_gmlp_item(p, lds, it - 512, so); }
}

__device__ __forceinline__ void phase3(const Params& p, unsigned char* lds, size_t so = 0) {
    pg8::StaticOrder S; S.init(T_, D_, gridDim.x, blockIdx.x); const pg8::AOffDirect AO{D_};
    PG8_LAS float* rsl = (PG8_LAS float*)((PG8_LAS unsigned char*)lds + RS_OFF);
    { const float* ssq = (const float*)(p.ws + OFF_SSQ); const int tid = opaque_tid();
      for (int i = 0; i < RS_UNITS; ++i) { Unit u; if (!S.next(i, u)) break;
          if (tid < 256) { const int row = u.pm * 256 + tid; const float va = ssq[row] * (1.f / 1024.f) + EPS, vb = ssq[T_ + row] * (1.f / 1024.f) + EPS;
              rsl[(i * 256 + tid) * 2] = __builtin_amdgcn_sqrtf(vb * __builtin_amdgcn_rcpf(va)); rsl[(i * 256 + tid) * 2 + 1] = __builtin_amdgcn_rsqf(vb); } }
      __syncthreads(); }
    const Epi2 E{p.x, p.ws, so, rsl};
    pg8::gemm_phase<Epi2, pg8::StaticOrder, pg8::AOffDirect, true>((PG8_LAS unsigned char*)lds, (const bf16_t*)(p.ws + OFF_B), (const bf16_t*)(p.ws + OFF_WOUT), D_, S, AO, E);
}

__device__ __forceinline__ void route_item(const Params& p, unsigned char* lds, int item, size_t so) {
    const int tid = opaque_tid(), wid = tid >> 6, lane = tid & 63, fr = lane & 15, fq = lane >> 4;
    float* lg = (float*)lds;
    float* ls = lg + 8 * 64 * 48;
    int* lcnt = (int*)(ls + 64 * 48); int* lbase = lcnt + 32;
    const bf16_t* hb = (const bf16_t*)(p.ws + OFF_HB); const bf16_t* wrt = (const bf16_t*)(p.ws + OFF_WR);
    const float* ssq_h = (const float*)(p.ws + OFF_SSQ) + 2 * T_;
    int* cnt = (int*)(p.ws + OFF_CNT + so); int* rinfo = (int*)(p.ws + OFF_RINFO + so); float* rw = (float*)(p.ws + OFF_RW + so);
    const int t0 = item * 64;
    if (tid < 32) lcnt[tid] = 0;
    f32x4 acc[4][3];
#pragma unroll
    for (int m = 0; m < 4; ++m)
#pragma unroll
        for (int n = 0; n < 3; ++n) acc[m][n] = (f32x4){0.f, 0.f, 0.f, 0.f};
    const bf16_t* ap = hb + (size_t)(t0 + fr) * D_ + wid * 256 + fq * 8; const bf16_t* bp = wrt + (size_t)fr * D_ + wid * 256 + fq * 8;
#pragma unroll 4
    for (int ks = 0; ks < 8; ++ks) {
        bf16x8 a[4], b[3];
#pragma unroll
        for (int m = 0; m < 4; ++m) a[m] = *(const bf16x8*)(ap + (size_t)m * 16 * D_ + ks * 32);
#pragma unroll
        for (int n = 0; n < 3; ++n) b[n] = *(const bf16x8*)(bp + (size_t)n * 16 * D_ + ks * 32);
#pragma unroll
        for (int m = 0; m < 4; ++m)
#pragma unroll
            for (int n = 0; n < 3; ++n) acc[m][n] = __builtin_amdgcn_mfma_f32_16x16x32_bf16(a[m], b[n], acc[m][n], 0, 0, 0);
    }
#pragma unroll
    for (int m = 0; m < 4; ++m)
#pragma unroll
        for (int n = 0; n < 3; ++n)
#pragma unroll
            for (int j = 0; j < 4; ++j) lg[(wid * 64 + m * 16 + 4 * fq + j) * 48 + 16 * n + fr] = acc[m][n][j];
    __syncthreads();
    for (int i = tid; i < 64 * 48; i += NTHR) { float v = 0.f;
#pragma unroll
        for (int w = 0; w < 8; ++w) v += lg[w * 64 * 48 + i];
        ls[i] = v; }
    __syncthreads();
    int e0 = 0, e1 = 0, r0 = 0, r1 = 0; float g0 = 0.f, g1 = 0.f, rsc = 0.f; const int t = t0 + tid;
    if (tid < 64) {
        const float* l0 = ls + tid * 48; const float rstd = rsqrtf(ssq_h[t] * (1.f / D_) + EPS); rsc = rstd * (1.f / WGU_SCALE);
        float gm = -3.0e38f; int gi = 0; float gl[4];
#pragma unroll
        for (int o = 0; o < 4; ++o) { gl[o] = l0[o] * rstd + p.rgb[o]; if (gl[o] > gm) { gm = gl[o]; gi = o; } }
        float gs = 0.f;
#pragma unroll
        for (int o = 0; o < 4; ++o) gs += __expf(gl[o] - gm);
        const float pg = 1.f / gs;
        float b1 = -3.0e38f, b2 = -3.0e38f; int i1 = 0, i2 = 0;
        for (int q = 0; q < 8; ++q) { const float v = l0[4 + gi * 8 + q] * rstd + p.reb[gi * 8 + q];
            if (v > b1) { b2 = b1; i2 = i1; b1 = v; i1 = q; } else if (v > b2) { b2 = v; i2 = q; } }
        const float wa = 1.f / (1.f + __expf(b2 - b1));
        e0 = gi * 8 + i1; e1 = gi * 8 + i2; g0 = pg * wa; g1 = pg * (1.f - wa);
        r0 = atomicAdd(&lcnt[e0], 1); r1 = atomicAdd(&lcnt[e1], 1);
    }
    __syncthreads();
    if (tid < 32) lbase[tid] = atomicAdd(cnt + tid, lcnt[tid]);
    __syncthreads();
    if (tid < 64) { const int i0 = lbase[e0] + r0, i1 = lbase[e1] + r1;
        rinfo[e0 * LCAP + i0] = (int)((cvt_pk_bf16(g0, 0.f) << 16) | (unsigned)(2 * t)); rinfo[e1 * LCAP + i1] = (int)((cvt_pk_bf16(g1, 0.f) << 16) | (unsigned)(2 * t + 1));
        rw[e0 * LCAP + i0] = rsc; rw[e1 * LCAP + i1] = rsc; }
    __syncthreads();
}
__device__ __forceinline__ void phase4(const Params& p, unsigned char* lds, size_t so = 0) { for (int it = blockIdx.x; it < T_ / 64; it += gridDim.x) route_item(p, lds, it, so); }

__device__ __forceinline__ PG8_LAS int* moe_tables_to_lds(const Params& p, unsigned char* lds) {
    PG8_LAS int* tb = (PG8_LAS int*)((PG8_LAS unsigned char*)lds + LCNT_OFF); const int* cnt = (const int*)(p.ws + OFF_CNT);
    if (threadIdx.x < NE) tb[MT_CNT + threadIdx.x] = __hip_atomic_load(cnt + threadIdx.x, __ATOMIC_RELAXED, __HIP_MEMORY_SCOPE_AGENT);
    __syncthreads();
    if (threadIdx.x == 0) { int pt = 0;
        for (int e = 0; e < NE; ++e) { const int nt = (tb[MT_CNT + e] + 255) >> 8; tb[MT_PST + e] = pt; for (int i = 0; i < nt; ++i) tb[MT_T2E + pt + i] = e; pt += nt; }
        tb[MT_PST + NE] = pt; tb[MT_NT] = pt; }
    __syncthreads();
    return tb;
}
__device__ __forceinline__ void phase5(const Params& p, unsigned char* lds) {
    PG8_LAS int* lc = moe_tables_to_lds(p, lds);
    const Epi5 E{p.ws, lc};
    const pg8::MoeOrder S{lc, 4, (int)gridDim.x, (int)blockIdx.x}; const pg8::AOffGather AO{p.ws, lc, D_ / 2};
    pg8::gemm_phase<Epi5, pg8::MoeOrder, pg8::AOffGather, true, true>((PG8_LAS unsigned char*)lds, (const bf16_t*)(p.ws + OFF_H8), (const bf16_t*)(p.ws + OFF_WGU), D_ / 2, S, AO, E);
}
__device__ __forceinline__ void phase6(const Params& p, unsigned char* lds) {
    PG8_LAS int* lc = moe_tables_to_lds(p, lds);
    const Epi6 E{p.ws, lc};
    const pg8::MoeOrder S{lc, 8, (int)gridDim.x, (int)blockIdx.x}; const pg8::AOffDirect AO{DE / 2};
    pg8::gemm_phase<Epi6, pg8::MoeOrder, pg8::AOffDirect, true, true>((PG8_LAS unsigned char*)lds, (const bf16_t*)(p.ws + OFF_B), (const bf16_t*)(p.ws + OFF_WD), DE / 2, S, AO, E);
}
__device__ __forceinline__ void phase7(const Params& p) {
    const int tid = opaque_tid(), wid = tid >> 6, lane = tid & 63;
    const bf16_t* hb = (const bf16_t*)(p.ws + OFF_HB); const unsigned char* ys2 = p.ws + OFF_A;
    for (int t = blockIdx.x * 8 + wid; t < T_; t += gridDim.x * 8) {
        float v[4][8]; float s = 0.f;
#pragma unroll
        for (int i = 0; i < 4; ++i) { const int c = i * 512 + lane * 8;
            const u32x4 a = *(const u32x4*)(hb + (size_t)t * D_ + c); const u32x2 b = *(const u32x2*)(ys2 + (size_t)(2 * t) * D_ + c), d = *(const u32x2*)(ys2 + (size_t)(2 * t + 1) * D_ + c);
            float y0[8], y1[8];
            up4_fp8(b.x, y0[0], y0[1], y0[2], y0[3]); up4_fp8(b.y, y0[4], y0[5], y0[6], y0[7]); up4_fp8(d.x, y1[0], y1[1], y1[2], y1[3]); up4_fp8(d.y, y1[4], y1[5], y1[6], y1[7]);
#pragma unroll
            for (int q = 0; q < 4; ++q) { v[i][2 * q] = bflo(a[q]) + (y0[2 * q] + y1[2 * q]) * (1.f / YS_SCALE); v[i][2 * q + 1] = bfhi(a[q]) + (y0[2 * q + 1] + y1[2 * q + 1]) * (1.f / YS_SCALE);
                s += v[i][2 * q] * v[i][2 * q] + v[i][2 * q + 1] * v[i][2 * q + 1]; } }
        const float rstd = rsqrtf(wave_sum(s) * (1.f / D_) + EPS);
#pragma unroll
        for (int i = 0; i < 4; ++i) { const int c = i * 512 + lane * 8;
            const f32x4 g0 = *(const f32x4*)(p.g_final + c), g1 = *(const f32x4*)(p.g_final + c + 4);
            f32x4 o0, o1;
#pragma unroll
            for (int q = 0; q < 4; ++q) { o0[q] = v[i][q] * rstd * g0[q]; o1[q] = v[i][4 + q] * rstd * g1[q]; }
            *(f32x4*)(p.out + (size_t)t * D_ + c) = o0; *(f32x4*)(p.out + (size_t)t * D_ + c + 4) = o1; }
    }
}

#ifndef ONE_LAUNCH
#define ONE_LAUNCH 1
#endif
template <int PH> __global__ void __launch_bounds__(NTHR, 2) k_phase(Params p) {
    extern __shared__ __attribute__((aligned(16))) unsigned char lds[];
    if (PH == 0) phase0(p, lds);
    if (PH == 1) phase1(p, lds);
    if (PH == 2) phase2(p, lds);
    if (PH == 3) phase3(p, lds);
    if (PH == 4) phase4(p, lds);
    if (PH == 5) phase5(p, lds);
    if (PH == 6) phase6(p, lds);
    if (PH == 7) phase7(p);
}
__global__ void __launch_bounds__(NTHR, 2) k_mega(Params p) {
    extern __shared__ __attribute__((aligned(16))) unsigned char lds[];
    cg::grid_group grid = cg::this_grid();
    volatile PG8_LAS unsigned* bst = (volatile PG8_LAS unsigned*)((PG8_LAS unsigned char*)lds + LBAR_OFF);
    if (threadIdx.x < 2) bst[threadIdx.x] = 0u;
    __syncthreads();
    (void)xcd_barrier_post((unsigned*)(p.ws + OFF_BAR), bst);
#define GRID_BAR() do { XcdBarrier b_; b_.bar = (unsigned*)(opaque_ws(p.ws) + OFF_BAR); b_.x = xb_xcc_id(); b_.st = bst; xcd_barrier(b_); } while (0)
    if (DUP_PHASE == 0) { phase0(p, lds); GRID_BAR(); }
    if (p.ws == nullptr) grid.sync();
    phase0(p, lds); GRID_BAR();
    if (DUP_PHASE == 1) { phase1(p, lds); GRID_BAR(); }
    phase1(p, lds); GRID_BAR();
    if (DUP_PHASE == 2) { phase2(p, lds, OFF_DUMMY - OFF_SSQ); GRID_BAR(); }
    phase2(p, lds); GRID_BAR();
    if (DUP_PHASE == 3) { phase3(p, lds, OFF_DUMMY - OFF_SSQ); GRID_BAR(); }
    phase3(p, lds); GRID_BAR();
    if (DUP_PHASE == 4) { phase4(p, lds, OFF_DUMMY - OFF_SSQ); GRID_BAR(); }
    phase4(p, lds); GRID_BAR();
    if (DUP_PHASE == 5) { phase5(p, lds); GRID_BAR(); }
    phase5(p, lds); GRID_BAR();
    if (DUP_PHASE == 6) { phase6(p, lds); GRID_BAR(); }
    phase6(p, lds); GRID_BAR();
    if (DUP_PHASE == 8) { for (int i = 0; i < 10; ++i) GRID_BAR(); }
    if (DUP_PHASE == 9) { grid.sync(); grid.sync(); }
    if (DUP_PHASE == 7) { phase7(p); GRID_BAR(); }
    phase7(p);
}

extern "C" void kernel_launch(void* const* d_in, const int* in_sizes, int n_in, void* d_out, int out_size, void* d_ws, size_t ws_size, hipStream_t stream) {
    static int grid = 0;
    if (grid == 0) {
        if (n_in != 19 || in_sizes[0] != T_ * D_ || out_size != T_ * D_ || ws_size < WS_END + (DUP_PHASE >= 2 && DUP_PHASE <= 4 ? DUMMY_BYTES : 0)) { fprintf(stderr, "kernel_launch: unexpected shapes (n_in %d, in0 %d, out %d, ws %zu < %zu); nothing launched\n", n_in, n_in > 0 ? in_sizes[0] : -1, out_size, ws_size, (size_t)WS_END); grid = -1; return; }
        int dev = 0, cus = 0, per_cu = 0;
        if (hipGetDevice(&dev) != hipSuccess || hipDeviceGetAttribute(&cus, hipDeviceAttributeMultiprocessorCount, dev) != hipSuccess) { grid = -1; return; }
#if ONE_LAUNCH
        if (hipFuncSetAttribute((const void*)k_mega, hipFuncAttributeMaxDynamicSharedMemorySize, LDS_BYTES) != hipSuccess) { fprintf(stderr, "kernel_launch: hipFuncSetAttribute failed\n"); grid = -1; return; }
        if (hipOccupancyMaxActiveBlocksPerMultiprocessor(&per_cu, (const void*)k_mega, NTHR, LDS_BYTES) != hipSuccess || per_cu < 1) { fprintf(stderr, "kernel_launch: occupancy query says %d blocks per CU\n", per_cu); grid = -1; return; }
        grid = cus * per_cu;
#else
        (void)hipFuncSetAttribute((const void*)k_phase<0>, hipFuncAttributeMaxDynamicSharedMemorySize, LDS_BYTES);
        (void)hipFuncSetAttribute((const void*)k_phase<1>, hipFuncAttributeMaxDynamicSharedMemorySize, LDS_BYTES);
        (void)hipFuncSetAttribute((const void*)k_phase<2>, hipFuncAttributeMaxDynamicSharedMemorySize, LDS_BYTES);
        (void)hipFuncSetAttribute((const void*)k_phase<3>, hipFuncAttributeMaxDynamicSharedMemorySize, LDS_BYTES);
        (void)hipFuncSetAttribute((const void*)k_phase<4>, hipFuncAttributeMaxDynamicSharedMemorySize, LDS_BYTES);
        (void)hipFuncSetAttribute((const void*)k_phase<5>, hipFuncAttributeMaxDynamicSharedMemorySize, LDS_BYTES);
        (void)hipFuncSetAttribute((const void*)k_phase<6>, hipFuncAttributeMaxDynamicSharedMemorySize, LDS_BYTES);
        (void)hipFuncSetAttribute((const void*)k_phase<7>, hipFuncAttributeMaxDynamicSharedMemorySize, LDS_BYTES);
        grid = cus > 0 ? cus : 256;
#endif
    }
    if (grid < 0) return;
    Params p{};
    const float** f = (const float**)&p;
    for (int i = 0; i < 19; ++i) f[i] = (const float*)d_in[i];
    p.out = (float*)d_out; p.ws = (unsigned char*)d_ws;
#if ONE_LAUNCH
    if (hipMemsetAsync((unsigned char*)d_ws + OFF_BAR, 0, BAR_BYTES, stream) != hipSuccess) { fprintf(stderr, "kernel_launch: memset of the barrier words failed\n"); return; }
    void* args[] = {&p};
    const hipError_t e = hipLaunchCooperativeKernel((const void*)k_mega, dim3(grid), dim3(NTHR), args, LDS_BYTES, stream);
    if (e != hipSuccess) fprintf(stderr, "kernel_launch: cooperative launch failed: %s (grid %d)\n", hipGetErrorString(e), grid);
#else
    hipLaunchKernelGGL(k_phase<0>, dim3(grid), dim3(NTHR), LDS_BYTES, stream, p);
    hipLaunchKernelGGL(k_phase<1>, dim3(grid), dim3(NTHR), LDS_BYTES, stream, p);
    hipLaunchKernelGGL(k_phase<2>, dim3(grid), dim3(NTHR), LDS_BYTES, stream, p);
    hipLaunchKernelGGL(k_phase<3>, dim3(grid), dim3(NTHR), LDS_BYTES, stream, p);
    hipLaunchKernelGGL(k_phase<4>, dim3(grid), dim3(NTHR), LDS_BYTES, stream, p);
    hipLaunchKernelGGL(k_phase<5>, dim3(grid), dim3(NTHR), LDS_BYTES, stream, p);
    hipLaunchKernelGGL(k_phase<6>, dim3(grid), dim3(NTHR), LDS_BYTES, stream, p);
    hipLaunchKernelGGL(k_phase<7>, dim3(grid), dim3(NTHR), LDS_BYTES, stream, p);
#endif
}
```

```cpp
#include <hip/hip_runtime.h>
#include <hip/hip_cooperative_groups.h>
#include <cstdio>
namespace cg = cooperative_groups;

typedef unsigned short bf16_t;
typedef float f32x4 __attribute__((ext_vector_type(4)));
typedef unsigned u32x4 __attribute__((ext_vector_type(4)));
typedef unsigned u32x2 __attribute__((ext_vector_type(2)));
typedef short bf16x8 __attribute__((ext_vector_type(8)));
typedef int v4i __attribute__((ext_vector_type(4)));
typedef int v8i __attribute__((ext_vector_type(8)));

constexpr int T_ = 16384, D_ = 2048, DIN = 5120, NE = 32, DE = 512, SEQ = 4096, LCAP = 16384;
constexpr float EPS = 1e-6f;
#ifndef DUP_PHASE
#define DUP_PHASE -1
#endif
constexpr int NTHR = 512;
constexpr int LDS_BYTES = 163840;
constexpr int LCNT_OFF = 131072, LBAR_OFF = 131072 + 2048, XS_OFF = 131072 + 4096, XM_OFF = XS_OFF + 8192, RS_OFF = XM_OFF;
constexpr int RS_UNITS = 4;
static_assert(XM_OFF + 512 * 32 <= LDS_BYTES && RS_UNITS * 256 * 8 <= 512 * 32, "LDS map");

constexpr size_t SZ_A = (size_t)T_ * DIN * 2;
constexpr size_t SZ_B = (size_t)T_ * D_ * 2;
constexpr size_t OFF_A = 0;
constexpr size_t OFF_B = OFF_A + SZ_A;
constexpr size_t OFF_HB = OFF_B + SZ_B;
constexpr size_t OFF_H8 = OFF_A + (size_t)2 * T_ * D_ * 2;
constexpr float WGU_SCALE = 32.f, WD_SCALE = 16.f, YS_SCALE = 16.f;
constexpr size_t OFF_WIN = OFF_HB + SZ_B;
constexpr size_t OFF_WOUT = OFF_WIN + (size_t)DIN * D_ * 2;
constexpr size_t OFF_WGU = OFF_WOUT + (size_t)D_ * D_ * 2;
constexpr size_t OFF_WD = OFF_WGU + (size_t)NE * 1024 * D_ * 2;
constexpr size_t OFF_WR = OFF_WD + (size_t)NE * D_ * DE * 2;
constexpr size_t OFF_SSQ = OFF_WR + (size_t)48 * D_ * 2;
constexpr size_t OFF_CNT = OFF_SSQ + (size_t)3 * T_ * 4;
constexpr size_t OFF_RINFO = OFF_CNT + 256;
constexpr size_t OFF_RW = OFF_RINFO + (size_t)NE * LCAP * 4;
constexpr size_t OFF_BAR = OFF_RW + (size_t)NE * LCAP * 4;
constexpr size_t BAR_BYTES = 16384;
constexpr size_t WS_END = OFF_BAR + BAR_BYTES;
constexpr size_t OFF_DUMMY = WS_END;
constexpr size_t DUMMY_BYTES = (OFF_BAR - OFF_SSQ);

struct Params {
    const float *x, *norm_mix_g, *w_in, *v_norm_g, *gmlp_ws, *gmlp_bs, *conv_w, *g_a, *g_b, *w_out, *g_ffn, *rgw, *rgb, *rew, *reb, *ewg, *ewu, *ewd, *g_final;
    float* out; unsigned char* ws;
};

__device__ __forceinline__ unsigned cvt_pk_bf16(float lo, float hi) { unsigned r; asm volatile("v_cvt_pk_bf16_f32 %0, %1, %2" : "=v"(r) : "v"(lo), "v"(hi)); return r; }
#define GAS __attribute__((address_space(1)))
typedef GAS unsigned char gbyte;
__device__ __forceinline__ gbyte* opaque_ws(unsigned char* w) { gbyte* g = (gbyte*)w; asm volatile("" : "+s"(g)); return g; }
__device__ __forceinline__ int opaque_tid() { int t = threadIdx.x; asm volatile("" : "+v"(t)); return t; }
__device__ __forceinline__ unsigned pk4_fp8(float a, float b, float c, float d) { int w = 0; w = __builtin_amdgcn_cvt_pk_fp8_f32(a, b, w, false); w = __builtin_amdgcn_cvt_pk_fp8_f32(c, d, w, true); return (unsigned)w; }
__device__ __forceinline__ void up4_fp8(unsigned w, float& a, float& b, float& c, float& d) {
    const auto lo = __builtin_amdgcn_cvt_pk_f32_fp8((int)w, false), hi = __builtin_amdgcn_cvt_pk_f32_fp8((int)w, true); a = lo[0]; b = lo[1]; c = hi[0]; d = hi[1]; }
__device__ __forceinline__ float bflo(unsigned w) { return __uint_as_float(w << 16); }
__device__ __forceinline__ float bfhi(unsigned w) { return __uint_as_float(w & 0xffff0000u); }
__device__ __forceinline__ float wave_sum(float v) {
#pragma unroll
    for (int o = 1; o < 64; o <<= 1) v += __shfl_xor(v, o);
    return v;
}
__device__ __forceinline__ float gelu_t(float x) {
    const float u = x * (0.7978845608f + 0.0356774081f * x * x);
    return x * __builtin_amdgcn_rcpf(1.f + __builtin_amdgcn_exp2f(-2.885390082f * u));
}
__device__ __forceinline__ float silu_f(float x) { return x * __builtin_amdgcn_rcpf(1.f + __builtin_amdgcn_exp2f(-1.442695041f * x)); }

#define PG8_LAS __attribute__((address_space(3)))
struct Unit { int pm, pn, e, r0, pnl; };

constexpr int MT_CNT = 0, MT_PST = 32, MT_NT = 65, MT_T2E = 66, MT_WORDS = 66 + 192;
typedef const PG8_LAS int* lcnt_t;
__device__ __forceinline__ bool moe_unit(lcnt_t tb, int NT, int L, Unit& u) {
    const int pt = L / NT;
    if (pt >= __builtin_amdgcn_readfirstlane(tb[MT_NT])) return false;
    const int e = __builtin_amdgcn_readfirstlane(tb[MT_T2E + pt]), mt = pt - __builtin_amdgcn_readfirstlane(tb[MT_PST + e]), j = L - pt * NT;
    u.e = e; u.pm = pt; u.r0 = mt * 256; u.pnl = j; u.pn = e * NT + j; return true;
}

struct NoMeta {};
struct Meta8 { u32x4 lo, hi; };
struct Epi1 {
    static constexpr bool PERM = true, MIDSCALE = false;
    typedef NoMeta Meta;
    unsigned char* ws;
    __device__ __forceinline__ Meta meta_load(const Unit&, int, int) const { return Meta{}; }
    __device__ __forceinline__ void operator()(f32x4 (&acc)[2][2][4][2], const Unit& u, int wr, int wc, int fr, int fq, const Meta&) const {
        GAS bf16_t* P = (GAS bf16_t*)(opaque_ws(ws) + OFF_A);
        const bool act = u.pn < 8;
#pragma unroll
        for (int ai = 0; ai < 2; ++ai)
#pragma unroll
            for (int m = 0; m < 4; ++m) {
                const int row = u.pm * 256 + ai * 128 + wr * 64 + m * 16 + fr;
                GAS bf16_t* rowp = P + (size_t)row * DIN + u.pn * 256 + wc * 32 + 8 * fq;
#pragma unroll
                for (int bj = 0; bj < 2; ++bj) {
                    f32x4 v0 = acc[ai][bj][m][0], v1 = acc[ai][bj][m][1];
                    if (act) {
#pragma unroll
                        for (int j = 0; j < 4; ++j) { v0[j] = gelu_t(v0[j]); v1[j] = gelu_t(v1[j]); }
                    }
                    u32x4 w; w.x = cvt_pk_bf16(v0[0], v0[1]); w.y = cvt_pk_bf16(v0[2], v0[3]); w.z = cvt_pk_bf16(v1[0], v1[1]); w.w = cvt_pk_bf16(v1[2], v1[3]);
                    *(GAS u32x4*)(rowp + bj * 128) = w;
                }
            }
    }
};
struct Epi2 {
    static constexpr bool PERM = true, MIDSCALE = true;
    const float* x; unsigned char* ws; size_t so;
    const PG8_LAS float* rsl;
    __device__ __forceinline__ void midscale(f32x4 (&acc)[2][2][4][2], const Unit& u, int wr, int wc, int fr, int fq) const {
        const PG8_LAS float* pr = rsl + (u.e * 256 + wr * 64 + fr) * 2;
#pragma unroll
        for (int ai = 0; ai < 2; ++ai)
#pragma unroll
            for (int m = 0; m < 4; ++m) {
                const float s = pr[(ai * 128 + m * 16) * 2];
#pragma unroll
                for (int bj = 0; bj < 2; ++bj)
#pragma unroll
                    for (int n = 0; n < 2; ++n) acc[ai][bj][m][n] *= s;
            }
    }
    typedef NoMeta Meta;
    __device__ __forceinline__ Meta meta_load(const Unit&, int, int) const { return Meta{}; }
    __device__ __forceinline__ void operator()(f32x4 (&acc)[2][2][4][2], const Unit& u, int wr, int wc, int fr, int fq, const Meta&) const {
        gbyte* w_ = opaque_ws(ws);
        GAS bf16_t* hb = (GAS bf16_t*)(w_ + OFF_HB); gbyte* h8 = w_ + OFF_H8; float* ssq_h = (float*)(ws + OFF_SSQ + so) + 2 * T_;
#pragma unroll
        for (int ai = 0; ai < 2; ++ai)
#pragma unroll
            for (int m = 0; m < 4; ++m) {
                const int row = u.pm * 256 + ai * 128 + wr * 64 + m * 16 + fr;
                const float rb = rsl[(u.e * 256 + ai * 128 + wr * 64 + m * 16 + fr) * 2 + 1];
                const size_t off = (size_t)row * D_ + u.pn * 256 + wc * 32 + 8 * fq;
                float ss = 0.f;
#pragma unroll
                for (int bj = 0; bj < 2; ++bj) {
                    const f32x4 x0 = *(const f32x4*)(x + off + bj * 128), x1 = *(const f32x4*)(x + off + bj * 128 + 4);
                    const f32x4 h0 = x0 + acc[ai][bj][m][0] * rb, h1 = x1 + acc[ai][bj][m][1] * rb;
                    ss += (h0[0] * h0[0] + h0[1] * h0[1]) + (h0[2] * h0[2] + h0[3] * h0[3]) + (h1[0] * h1[0] + h1[1] * h1[1]) + (h1[2] * h1[2] + h1[3] * h1[3]);
                    u32x4 w; w.x = cvt_pk_bf16(h0[0], h0[1]); w.y = cvt_pk_bf16(h0[2], h0[3]); w.z = cvt_pk_bf16(h1[0], h1[1]); w.w = cvt_pk_bf16(h1[2], h1[3]);
                    *(GAS u32x4*)(hb + off + bj * 128) = w;
                    u32x2 w8; w8.x = pk4_fp8(h0[0], h0[1], h0[2], h0[3]); w8.y = pk4_fp8(h1[0], h1[1], h1[2], h1[3]);
                    *(GAS u32x2*)(h8 + off + bj * 128) = w8;
                }
                ss += __shfl_xor(ss, 16); ss += __shfl_xor(ss, 32);
                if (fq == 0) atomicAdd(ssq_h + row, ss);
                if (m == 3) asm volatile("" ::: "memory");
            }
    }
};
struct Epi5 {
    static constexpr bool PERM = true, MIDSCALE = false;
    typedef Meta8 Meta;
    unsigned char* ws; lcnt_t cnt;
    __device__ __forceinline__ Meta meta_load(const Unit& u, int wr, int fr) const {
        const GAS unsigned* rrs = (const GAS unsigned*)(opaque_ws(ws) + OFF_RW) + u.e * LCAP; const int ce = __builtin_amdgcn_readfirstlane(cnt[u.e]); Meta mt;
#pragma unroll
        for (int q = 0; q < 4; ++q) { const int i0 = u.r0 + wr * 64 + q * 16 + fr, i1 = i0 + 128;
            const unsigned a = rrs[min(i0, ce - 1)], b = rrs[min(i1, ce - 1)]; mt.lo[q] = (i0 < ce) ? a : 0u; mt.hi[q] = (i1 < ce) ? b : 0u; }
        return mt;
    }
    __device__ __forceinline__ void operator()(f32x4 (&acc)[2][2][4][2], const Unit& u, int wr, int wc, int fr, int fq, const Meta& mt) const {
        gbyte* hbuf = opaque_ws(ws) + OFF_B;
#pragma unroll
        for (int ai = 0; ai < 2; ++ai)
#pragma unroll
            for (int m = 0; m < 4; ++m) {
                const int r = ai * 128 + wr * 64 + m * 16 + fr;
                const float rs = __uint_as_float(ai ? mt.hi[m] : mt.lo[m]);
                float o[8];
#pragma unroll
                for (int n = 0; n < 2; ++n)
#pragma unroll
                    for (int j = 0; j < 4; ++j) o[4 * n + j] = silu_f(acc[ai][0][m][n][j] * rs) * (acc[ai][1][m][n][j] * rs);
                u32x2 w; w.x = pk4_fp8(o[0], o[1], o[2], o[3]); w.y = pk4_fp8(o[4], o[5], o[6], o[7]);
                *(GAS u32x2*)(hbuf + (size_t)(u.pm * 256 + r) * DE + u.pnl * 128 + wc * 32 + 8 * fq) = w;
                if (m & 1) asm volatile("" ::: "memory");
            }
    }
};
struct Epi6 {
    static constexpr bool PERM = true, MIDSCALE = false;
    typedef Meta8 Meta;
    unsigned char* ws; lcnt_t cnt;
    __device__ __forceinline__ Meta meta_load(const Unit& u, int wr, int fr) const {
        const GAS unsigned* rpk = (const GAS unsigned*)(opaque_ws(ws) + OFF_RINFO) + u.e * LCAP; const int ce = __builtin_amdgcn_readfirstlane(cnt[u.e]); Meta mt;
#pragma unroll
        for (int q = 0; q < 4; ++q) { const int i0 = u.r0 + wr * 64 + q * 16 + fr, i1 = i0 + 128;
            const unsigned a = rpk[min(i0, ce - 1)], b = rpk[min(i1, ce - 1)]; mt.lo[q] = (i0 < ce) ? a : 0xFFFFFFFFu; mt.hi[q] = (i1 < ce) ? b : 0xFFFFFFFFu; }
        return mt;
    }
    __device__ __forceinline__ void operator()(f32x4 (&acc)[2][2][4][2], const Unit& u, int wr, int wc, int fr, int fq, const Meta& mt) const {
        gbyte* ys2 = opaque_ws(ws) + OFF_A;
#pragma unroll
        for (int ai = 0; ai < 2; ++ai)
#pragma unroll
            for (int m = 0; m < 4; ++m) {
                const unsigned pk = ai ? mt.hi[m] : mt.lo[m]; const unsigned info = pk & 0xFFFFu;
                if (info < 2u * T_) {
                    const float g = __uint_as_float(pk & 0xFFFF0000u) * (YS_SCALE / WD_SCALE);
                    gbyte* dst = ys2 + (size_t)info * D_ + u.pnl * 256 + wc * 32 + 8 * fq;
#pragma unroll
                    for (int bj = 0; bj < 2; ++bj) {
                        const f32x4 v0 = acc[ai][bj][m][0] * g, v1 = acc[ai][bj][m][1] * g;
                        u32x2 w; w.x = pk4_fp8(v0[0], v0[1], v0[2], v0[3]); w.y = pk4_fp8(v1[0], v1[1], v1[2], v1[3]);
                        *(GAS u32x2*)(dst + bj * 128) = w;
                    }
                }
            }
    }
};

namespace pg8 {
constexpr int BM = 256, BK = 64, HALF = 128, HTB = HALF * BK * 2, STAGE_BYTES = 8 * HTB, NXCD = 8, WGM = 8;
__host__ __device__ __forceinline__ int lds_byte(int r, int c) { const int st = (r >> 4) * 2 + (c >> 5), rr = r & 15, cc = c & 31, ob = rr * 64 + cc * 2; return st * 1024 + (ob ^ (((ob >> 9) & 1) << 5)); }
__host__ __device__ __forceinline__ void stage_rc(int b, int& R, int& C) { const int st = b / 1024, sb = b % 1024, swz = sb ^ (((sb >> 9) & 1) << 5); R = (st >> 1) * 16 + swz / 64; C = (st & 1) * 32 + (swz % 64) / 2; }
__host__ __device__ __forceinline__ int perm32(int rho) { const int n = rho >> 4, i = rho & 15; return 8 * (i >> 2) + 4 * n + (i & 3); }

struct StaticOrder {
    int nM, nN, nwg, G, c, i0, i1;
    __device__ void init(int M, int N, int G_, int c_) { nM = M / BM; nN = N / BM; nwg = nM * nN; G = G_; c = c_; i0 = 0; i1 = 1 << 30; }
    __device__ int count() const { return (nwg - c + G - 1) / G; }
    __device__ bool next(int ii, Unit& u) const {
        const int i = ii + i0; if (i >= i1) return false;
        const long L = (long)i * G + c; if (L >= nwg) return false;
        int wgid = (int)L; { const int q = nwg / NXCD, r = nwg % NXCD, xcd = wgid % NXCD, off = wgid / NXCD; wgid = (xcd < r ? xcd * (q + 1) : r * (q + 1) + (xcd - r) * q) + off; }
        const int nig = WGM * nN, gid = wgid / nig, fm = gid * WGM, gsz = (nM - fm) < WGM ? (nM - fm) : WGM;
        u.pm = fm + ((wgid % nig) % gsz); u.pn = (wgid % nig) / gsz; u.e = i; u.r0 = 0; u.pnl = u.pn; return true;
    }
};
struct MoeOrder {
    lcnt_t cnt; int NT, G, c;
    __device__ __forceinline__ bool next(int i, Unit& u) const { return moe_unit(cnt, NT, i * G + c, u); }
};
struct AOffDirect { int K; struct Pre {};
    __device__ __forceinline__ Pre pre(const Unit&, int, int) const { return Pre{}; }
    __device__ __forceinline__ unsigned fin(const Pre&, const Unit& u, int h, int i, int R, int C) const { return (unsigned)(((u.pm * 256 + h * 128 + R) * K + C) * 2); } };
struct AOffGather { unsigned char* ws; lcnt_t cnt; int K;
    struct Pre { unsigned pk[2][2]; };
    __device__ __forceinline__ Pre pre(const Unit& u, int R0, int R1) const {
        const GAS unsigned* rpk = (const GAS unsigned*)(opaque_ws(ws) + OFF_RINFO) + u.e * LCAP; const int ce = __builtin_amdgcn_readfirstlane(cnt[u.e]); Pre p;
#pragma unroll
        for (int h = 0; h < 2; ++h) { const int i0 = u.r0 + h * 128 + R0, i1 = u.r0 + h * 128 + R1;
            p.pk[h][0] = rpk[min(i0, ce - 1)]; p.pk[h][1] = rpk[min(i1, ce - 1)]; }
        return p;
    }
    __device__ __forceinline__ unsigned fin(const Pre& p, const Unit&, int h, int i, int, int C) const { const int tok = (int)((p.pk[h][i] & 0xFFFFu) >> 1); return (unsigned)((tok * K + C) * 2); } };

template <class Epi, class Sched, class AOff, bool ALIGN_EPI, bool FP8 = false>
__device__ __forceinline__ void gemm_phase(PG8_LAS unsigned char* lds, const bf16_t* Ag, const bf16_t* Btg, const int K, const Sched& S, const AOff& AO, const Epi& E) {
    const int tid = opaque_tid(), wid = __builtin_amdgcn_readfirstlane(tid >> 6), lane = tid & 63, wr = wid >> 2, wc = wid & 3, fr = lane & 15, fq = lane >> 4;
    int nt = K / BK; asm volatile("" : "+s"(nt));
    unsigned voffB[2];
#pragma unroll
    for (int i = 0; i < 2; ++i) { int R, C; stage_rc(tid * 16 + i * 8192, R, C); const int Rb = Epi::PERM ? ((R & ~31) + perm32(R & 31)) : R; voffB[i] = (unsigned)(Rb * K + C) * 2u; }
#define PG8_APRE(u, pv_) do { int _t = tid; asm volatile("" : "+v"(_t)); int _R0, _R1, _C; stage_rc(_t * 16, _R0, _C); stage_rc(_t * 16 + 8192, _R1, _C); pv_ = AO.pre(u, _R0, _R1); } while (0)
#define PG8_AFIN(u, pv_, d0, d1) do { int _t = tid; asm volatile("" : "+v"(_t)); _Pragma("unroll") for (int _i = 0; _i < 2; ++_i) { int _R, _C; stage_rc(_t * 16 + _i * 8192, _R, _C); d0[_i] = AO.fin(pv_, u, 0, _i, _R, _C); d1[_i] = AO.fin(pv_, u, 1, _i, _R, _C); } } while (0)
#define PG8_LANE(fr_, fq_) int fr_, fq_; { int _t = tid; asm volatile("" : "+v"(_t)); fr_ = _t & 15; fq_ = (_t & 63) >> 4; }
    const unsigned kstep = (unsigned)(BK * 2), hstep = (unsigned)HALF * (unsigned)K * 2u, tstep = 2u * hstep;
    const unsigned ldsw = (unsigned)wid * 1024u;
    const int aoff = lds_byte(wr * 64 + fr, fq * 8), boff = lds_byte(wc * 32 + fr, fq * 8);
    const char* const Ab = (const char*)Ag; const char* const Bb = (const char*)Btg;
#define PG8_SA(b, h) (((b) * 2 + (h)) * HTB)
#define PG8_SB(b, h) ((4 + (b) * 2 + (h)) * HTB)
#define PG8_STAGE(bufoff, gbase, uoff, voff) do { _Pragma("unroll") for (int _i = 0; _i < 2; ++_i) \
        __builtin_amdgcn_global_load_lds((const unsigned*)((gbase) + (size_t)(unsigned)((uoff) + (voff)[_i])), (PG8_LAS unsigned*)(lds + (bufoff) + ldsw + _i * 8192), 16, 0, 0); } while (0)
#define PG8_LD32(base) __builtin_shufflevector(*(const PG8_LAS v4i*)(base), *(const PG8_LAS v4i*)((base) + 1024), 0, 1, 2, 3, 4, 5, 6, 7)
#define PG8_LDA(dst, b, h) do { _Pragma("unroll") for (int m = 0; m < 4; ++m) dst[m] = PG8_LD32(lds + PG8_SA(b, h) + aoff + m * 2048); } while (0)
#define PG8_LDB(dst, b, h) do { _Pragma("unroll") for (int n = 0; n < 2; ++n) dst[n] = PG8_LD32(lds + PG8_SB(b, h) + boff + n * 2048); } while (0)
#define PG8_LO(x) __builtin_bit_cast(bf16x8, __builtin_shufflevector((x), (x), 0, 1, 2, 3))
#define PG8_HI(x) __builtin_bit_cast(bf16x8, __builtin_shufflevector((x), (x), 4, 5, 6, 7))
#define PG8_MMA(ai, bj, At, Bt) do { __builtin_amdgcn_s_setprio(1); _Pragma("unroll") for (int m = 0; m < 4; ++m) _Pragma("unroll") for (int n = 0; n < 2; ++n) { \
        if constexpr (FP8) acc[ai][bj][m][n] = __builtin_amdgcn_mfma_scale_f32_16x16x128_f8f6f4(Bt[n], At[m], acc[ai][bj][m][n], 0, 0, 0, 0, 0, 0);   \
        else { acc[ai][bj][m][n] = __builtin_amdgcn_mfma_f32_16x16x32_bf16(PG8_LO(Bt[n]), PG8_LO(At[m]), acc[ai][bj][m][n], 0, 0, 0); \
               acc[ai][bj][m][n] = __builtin_amdgcn_mfma_f32_16x16x32_bf16(PG8_HI(Bt[n]), PG8_HI(At[m]), acc[ai][bj][m][n], 0, 0, 0); } } \
        __builtin_amdgcn_s_setprio(0); } while (0)
#define PG8_WAIT_V(n) asm volatile("s_waitcnt vmcnt(" #n ")" ::: "memory")
#define PG8_WAIT_L(n) asm volatile("s_waitcnt lgkmcnt(" #n ")" ::: "memory")
#define PG8_BAR __builtin_amdgcn_s_barrier()
#define PG8_SCHED __builtin_amdgcn_sched_barrier(0)
    Unit cur, nxt; int ui = 0;
    if (!S.next(0, cur)) return;
    f32x4 acc[2][2][4][2];
#pragma unroll
    for (int a = 0; a < 2; ++a)
#pragma unroll
        for (int b = 0; b < 2; ++b)
#pragma unroll
            for (int m = 0; m < 4; ++m)
#pragma unroll
                for (int n = 0; n < 2; ++n) acc[a][b][m][n] = (f32x4){0.f, 0.f, 0.f, 0.f};
    v8i At[4], B0[2], B1[2];
    unsigned vo0[2], vo1[2];
    PG8_LAS u32x4* const svn = (PG8_LAS u32x4*)(lds + XS_OFF) + tid;
    PG8_LAS u32x4* const smeta = (PG8_LAS u32x4*)(lds + XM_OFF + tid * 32);
    constexpr bool HAS_META = sizeof(typename Epi::Meta) > 1;
    bool has_next = S.next(1, nxt);
    { typename AOff::Pre pc; PG8_APRE(cur, pc); PG8_AFIN(cur, pc, vo0, vo1);
      unsigned vn0[2], vn1[2];
      if (has_next) { typename AOff::Pre pn; PG8_APRE(nxt, pn); PG8_AFIN(nxt, pn, vn0, vn1); } else { vn0[0] = vo0[0]; vn0[1] = vo0[1]; vn1[0] = vo1[0]; vn1[1] = vo1[1]; }
      *svn = (u32x4){vn0[0], vn0[1], vn1[0], vn1[1]}; }
    if constexpr (HAS_META) { PG8_LANE(fr_, fq_); (void)fq_; const typename Epi::Meta m0 = E.meta_load(cur, wr, fr_); smeta[0] = m0.lo; smeta[1] = m0.hi; }
    unsigned cB = (unsigned)cur.pn * tstep;
    PG8_STAGE(PG8_SB(0, 0), Bb, cB, voffB); PG8_STAGE(PG8_SB(0, 1), Bb, cB + hstep, voffB); PG8_STAGE(PG8_SA(0, 0), Ab, 0u, vo0); PG8_STAGE(PG8_SA(0, 1), Ab, 0u, vo1);
    if (wr == 1) PG8_BAR;
    PG8_WAIT_V(2); PG8_BAR;
    PG8_STAGE(PG8_SB(1, 0), Bb, cB + kstep, voffB); PG8_STAGE(PG8_SA(1, 0), Ab, kstep, vo0); PG8_STAGE(PG8_SB(1, 1), Bb, cB + hstep + kstep, voffB);
    PG8_WAIT_V(6); PG8_BAR;
    for (;;) {
        const unsigned nB = has_next ? (unsigned)nxt.pn * tstep : cB;
#pragma clang loop unroll(disable)
        for (int t = 0; t < nt; t += 2) {
            const bool last = (t == nt - 2);
            if constexpr (Epi::MIDSCALE) { if (t == nt / 2) { PG8_LANE(fr_, fq_); E.midscale(acc, cur, wr, wc, fr_, fq_); } }
            const unsigned k1 = (unsigned)(t + 1) * kstep, k2 = last ? 0u : (unsigned)(t + 2) * kstep, k3 = k2 + kstep;
            const unsigned b2 = last ? nB : cB + (unsigned)(t + 2) * kstep, b3 = b2 + kstep;
            PG8_LDB(B0, 0, 0); PG8_LDB(B1, 0, 1); PG8_SCHED; PG8_LDA(At, 0, 0); PG8_STAGE(PG8_SA(1, 1), Ab, k1, vo1);
            PG8_WAIT_V(8); PG8_WAIT_L(0); PG8_BAR; PG8_MMA(0, 0, At, B0); PG8_MMA(0, 1, At, B1); PG8_BAR; PG8_SCHED;
            if (last) { PG8_LAS u32x4* sp_ = svn; asm volatile("" : "+v"(sp_));
                const u32x4 v = *sp_; vo0[0] = v.x; vo0[1] = v.y; vo1[0] = v.z; vo1[1] = v.w; }
            PG8_LDA(At, 0, 1); PG8_STAGE(PG8_SB(0, 0), Bb, b2, voffB); PG8_STAGE(PG8_SB(0, 1), Bb, b2 + hstep, voffB); PG8_STAGE(PG8_SA(0, 0), Ab, k2, vo0);
            PG8_WAIT_V(8); PG8_WAIT_L(0); PG8_BAR; PG8_MMA(1, 0, At, B0); PG8_MMA(1, 1, At, B1); PG8_BAR; PG8_SCHED;
            PG8_LDB(B0, 1, 0); PG8_LDB(B1, 1, 1); PG8_SCHED; PG8_LDA(At, 1, 0); PG8_STAGE(PG8_SA(0, 1), Ab, k2, vo1);
            PG8_WAIT_V(8); PG8_WAIT_L(0); PG8_BAR; PG8_MMA(0, 0, At, B0); PG8_MMA(0, 1, At, B1); PG8_BAR; PG8_SCHED;
            PG8_LDA(At, 1, 1); PG8_STAGE(PG8_SB(1, 0), Bb, b3, voffB); PG8_STAGE(PG8_SB(1, 1), Bb, b3 + hstep, voffB); PG8_STAGE(PG8_SA(1, 0), Ab, k3, vo0);
            PG8_WAIT_V(8); PG8_WAIT_L(0); PG8_BAR; PG8_MMA(1, 0, At, B0); PG8_MMA(1, 1, At, B1); PG8_BAR; PG8_SCHED;
        }
        if constexpr (ALIGN_EPI) { if (wr == 0) PG8_BAR; }
        Unit nn; const bool has2 = has_next && S.next(ui + 2, nn);
        typename Epi::Meta mnext;
        { PG8_LANE(fr_, fq_);
          typename Epi::Meta meta; if constexpr (HAS_META) { PG8_LAS u32x4* sp_ = smeta; asm volatile("" : "+v"(sp_)); meta.lo = sp_[0]; meta.hi = sp_[1]; }
          if (has_next) mnext = E.meta_load(nxt, wr, fr_);
          if (has2) { typename AOff::Pre pnn; PG8_APRE(nn, pnn); unsigned vn0[2], vn1[2]; PG8_AFIN(nn, pnn, vn0, vn1); *svn = (u32x4){vn0[0], vn0[1], vn1[0], vn1[1]}; }
          E(acc, cur, wr, wc, fr_, fq_, meta); }
        if (!has_next) break;
        if constexpr (HAS_META) { smeta[0] = mnext.lo; smeta[1] = mnext.hi; }
#pragma unroll
        for (int a = 0; a < 2; ++a)
#pragma unroll
            for (int b = 0; b < 2; ++b)
#pragma unroll
                for (int m = 0; m < 4; ++m)
#pragma unroll
                    for (int n = 0; n < 2; ++n) acc[a][b][m][n] = (f32x4){0.f, 0.f, 0.f, 0.f};
        cur = nxt; nxt = nn; has_next = has2; cB = nB; ++ui;
        if constexpr (ALIGN_EPI) { if (wr == 1) PG8_BAR; }
    }
    PG8_WAIT_V(0);
    if constexpr (!ALIGN_EPI) { if (wr == 0) PG8_BAR; }
    PG8_BAR;
#undef PG8_APRE
#undef PG8_AFIN
#undef PG8_LANE
#undef PG8_SA
#undef PG8_SB
#undef PG8_STAGE
#undef PG8_LDA
#undef PG8_LDB
#undef PG8_MMA
#undef PG8_LO
#undef PG8_HI
#undef PG8_LD32
#undef PG8_WAIT_V
#undef PG8_WAIT_L
#undef PG8_BAR
#undef PG8_SCHED
}
}


#define XB_TMO      128
#define XB_XCNT(j)  (256  + 64 * (j))
#define XB_XSUB(j)  (1280 + 64 * (j))
#define XB_XGEN(j)  (2304 + 64 * (j))
#define XB_TOP      3328
#define XB_TOPGEN   3392
#define XCD_BAR_WORDS 3456
#define XB_SPIN_CAP (1u << 18)
__device__ __forceinline__ unsigned xb_ld(unsigned* p)              { return __hip_atomic_load(p, __ATOMIC_RELAXED, __HIP_MEMORY_SCOPE_AGENT); }
__device__ __forceinline__ unsigned xb_add(unsigned* p, unsigned v) { return __hip_atomic_fetch_add(p, v, __ATOMIC_RELAXED, __HIP_MEMORY_SCOPE_AGENT); }
__device__ __forceinline__ unsigned xb_xcc_id() { return (unsigned)__builtin_amdgcn_s_getreg((3 << 11) | 20) & 0xFu; }
#define XB_SPIN(cond, bar) do { unsigned _sp = 0; while (cond) { __builtin_amdgcn_s_sleep(1); \
    if ((++_sp & 255u) == 0u) { if (xb_ld(&(bar)[XB_TMO])) break; if (_sp > XB_SPIN_CAP) { atomicAdd(&(bar)[XB_TMO], 1u); break; } } } } while (0)
struct XcdBarrier { unsigned* bar; unsigned x; volatile PG8_LAS unsigned* st; };
__device__ __forceinline__ XcdBarrier xcd_barrier_post(unsigned* bar, volatile PG8_LAS unsigned* st) {
    XcdBarrier b; b.bar = bar; b.x = xb_xcc_id(); b.st = st;
    if (threadIdx.x == 0) (void)xb_add(&bar[XB_XCNT(b.x)], 1u);
    return b;
}
__device__ __forceinline__ void xcd_barrier_complete(unsigned* bar, unsigned x, unsigned& nloc, unsigned& nx) {
    const unsigned G = gridDim.x * gridDim.y * gridDim.z;
    unsigned sum, cnt, mine, sp = 0u;
    for (;;) {
        sum = 0u; cnt = 0u; mine = 0u;
#pragma unroll
        for (unsigned j = 0; j < 16; ++j) { const unsigned c = xb_ld(&bar[XB_XCNT(j)]); sum += c; cnt += (c > 0u) ? 1u : 0u; mine = (j == x) ? c : mine; }
        if (sum == G) break;
        __builtin_amdgcn_s_sleep(1);
        if ((++sp & 255u) == 0u) { if (xb_ld(&bar[XB_TMO])) break; if (sp > XB_SPIN_CAP) { atomicAdd(&bar[XB_TMO], 1u); break; } }
    }
    nloc = mine > 0u ? mine : 1u; nx = cnt > 0u ? cnt : 1u;
}
__device__ __forceinline__ void xcd_barrier(const XcdBarrier& b) {
    asm volatile("s_waitcnt vmcnt(0)" ::: "memory");
    __syncthreads();
    if (threadIdx.x == 0) {
        unsigned* bar = b.bar;
        __builtin_amdgcn_s_waitcnt(0);
        unsigned nloc = b.st[0], nx = b.st[1];
        if (nloc == 0u) { xcd_barrier_complete(bar, b.x, nloc, nx); b.st[0] = nloc; b.st[1] = nx; }
        const unsigned old = xb_add(&bar[XB_XSUB(b.x)], 1u);
        const unsigned gen = old / nloc;
        if (old + 1u == (gen + 1u) * nloc) {
            __builtin_amdgcn_fence(__ATOMIC_RELEASE, "agent");
            asm volatile("s_waitcnt vmcnt(0)" ::: "memory");
            const unsigned og = xb_add(&bar[XB_TOP], 1u);
            const unsigned tg = og / nx;
            if (og + 1u == (tg + 1u) * nx) xb_add(&bar[XB_TOPGEN], 1u);
            else XB_SPIN(xb_ld(&bar[XB_TOPGEN]) == tg, bar);
            __builtin_amdgcn_fence(__ATOMIC_ACQUIRE, "agent");
            xb_add(&bar[XB_XGEN(b.x)], 1u);
            asm volatile("s_waitcnt vmcnt(0)" ::: "memory");
        } else {
            XB_SPIN(xb_ld(&bar[XB_XGEN(b.x)]) == gen, bar);
            __builtin_amdgcn_fence(__ATOMIC_ACQUIRE, "agent");
            asm volatile("s_waitcnt vmcnt(0)" ::: "memory");
        }
    }
    __syncthreads();
}

struct TJob { const float* src; int ld; unsigned char* dst; int lddst; float sc; const float* sk; int fp8; };
__device__ __forceinline__ bool tjob_decode(const Params& p, int q, TJob& j) {
    constexpr int N_IN = 16 * 80, N_OUT = 16 * 32, N_G = 32 * 128;
    if (q < N_IN) { const int tr = q / 80, tc = q % 80; j.src = p.w_in + (size_t)tr * 128 * DIN + tc * 64; j.ld = DIN; j.dst = p.ws + OFF_WIN + ((size_t)tc * 64 * D_ + tr * 128) * 2; j.lddst = D_ * 2; j.sc = 1.f; j.sk = nullptr; j.fp8 = 0; return true; } q -= N_IN;
    if (q < N_OUT) { const int tr = q / 32, tc = q % 32; j.src = p.w_out + (size_t)tr * 128 * D_ + tc * 64; j.ld = D_; j.dst = p.ws + OFF_WOUT + ((size_t)tc * 64 * D_ + tr * 128) * 2; j.lddst = D_ * 2; j.sc = 1.f;
        j.sk = (tr < 8 ? p.g_a + tr * 128 : p.g_b + (tr - 8) * 128); j.fp8 = 0; return true; } q -= N_OUT;
    if (q < 2 * N_G) { const int up = q >= N_G; if (up) q -= N_G; const int e = q >> 7, rem = q & 127, tr = rem >> 3, tc = rem & 7, c0 = tc * 64;
        j.src = (up ? p.ewu : p.ewg) + (size_t)e * D_ * DE + (size_t)tr * 128 * DE + c0; j.ld = DE;
        j.dst = p.ws + OFF_WGU + (size_t)e * 1024 * D_ + (size_t)((c0 >> 7) * 256 + (up ? 128 : 0) + (c0 & 127)) * D_ + tr * 128; j.lddst = D_; j.sc = WGU_SCALE; j.sk = p.g_ffn + tr * 128; j.fp8 = 1; return true; } q -= 2 * N_G;
    if (q < N_G) { const int e = q >> 7, rem = q & 127, tr = rem >> 5, tc = rem & 31;
        j.src = p.ewd + (size_t)e * DE * D_ + (size_t)tr * 128 * D_ + tc * 64; j.ld = D_; j.dst = p.ws + OFF_WD + (size_t)e * D_ * DE + (size_t)tc * 64 * DE + tr * 128; j.lddst = DE; j.sc = WD_SCALE; j.sk = nullptr; j.fp8 = 1; return true; }
    return false;
}
constexpr int N_TJOBS_DENSE = 16 * 80 + 16 * 32, N_TJOBS = N_TJOBS_DENSE + 3 * 32 * 128;
struct TRegs { f32x4 v[4]; };
__device__ __forceinline__ void tjob_load(const TJob& j, int tid, TRegs& r) {
    const float* sp = j.src + (size_t)(tid >> 2) * j.ld + (tid & 3) * 16;
#pragma unroll
    for (int q = 0; q < 4; ++q) r.v[q] = *(const f32x4*)(sp + 4 * q);
}
__device__ __forceinline__ void tjob_finish(const TJob& j, int tid, const TRegs& r, float* lt) {
    { const int rr = tid >> 2, cc = (tid & 3) * 16; const float f = j.sk ? j.sc * j.sk[rr] : j.sc;
#pragma unroll
      for (int q = 0; q < 4; ++q)
#pragma unroll
          for (int e = 0; e < 4; ++e) lt[rr * 65 + cc + 4 * q + e] = r.v[q][e] * f; }
    __syncthreads();
    { const int c = tid >> 3, rr = (tid & 7) * 16; float v[16];
#pragma unroll
      for (int q = 0; q < 16; ++q) v[q] = lt[(rr + q) * 65 + c];
      unsigned char* d = j.dst + (size_t)c * j.lddst;
      if (j.fp8) { u32x4 w; w.x = pk4_fp8(v[0], v[1], v[2], v[3]); w.y = pk4_fp8(v[4], v[5], v[6], v[7]); w.z = pk4_fp8(v[8], v[9], v[10], v[11]); w.w = pk4_fp8(v[12], v[13], v[14], v[15]);
          *(u32x4*)(d + rr) = w; }
      else { u32x4 w0, w1; w0.x = cvt_pk_bf16(v[0], v[1]); w0.y = cvt_pk_bf16(v[2], v[3]); w0.z = cvt_pk_bf16(v[4], v[5]); w0.w = cvt_pk_bf16(v[6], v[7]);
          w1.x = cvt_pk_bf16(v[8], v[9]); w1.y = cvt_pk_bf16(v[10], v[11]); w1.z = cvt_pk_bf16(v[12], v[13]); w1.w = cvt_pk_bf16(v[14], v[15]);
          *(u32x4*)(d + rr * 2) = w0; *(u32x4*)(d + rr * 2 + 16) = w1; } }
}
__device__ __forceinline__ void run_tjobs(const Params& p, unsigned char* lds, int qlo, int qhi, int k0 = 0, int k1 = 1 << 20) {
    const int tid = opaque_tid(), nb = gridDim.x;
    float* lt0 = (float*)lds; float* lt1 = lt0 + 128 * 65;
    TJob j0, j1, j2; TRegs r0, r1, r2;
    int k = k0; const int qb = qlo + blockIdx.x;
#define TJ_OK(kk, jj) ((kk) < k1 && qb + (kk) * nb < qhi && tjob_decode(p, qb + (kk) * nb, jj))
    bool h0 = TJ_OK(k, j0), h1 = TJ_OK(k + 1, j1), h2 = TJ_OK(k + 2, j2);
    if (h0) tjob_load(j0, tid, r0); if (h1) tjob_load(j1, tid, r1); if (h2) tjob_load(j2, tid, r2);
    while (h0) {
        tjob_finish(j0, tid, r0, lt0); k += 3; h0 = TJ_OK(k, j0); if (h0) tjob_load(j0, tid, r0);
        if (!h1) break;
        tjob_finish(j1, tid, r1, lt1); h1 = TJ_OK(k + 1, j1); if (h1) tjob_load(j1, tid, r1);
        if (!h2) break;
        tjob_finish(j2, tid, r2, lt0); h2 = TJ_OK(k + 2, j2); if (h2) tjob_load(j2, tid, r2);
        if (!h0) break;
        tjob_finish(j0, tid, r0, lt1); k += 3; h0 = TJ_OK(k, j0); if (h0) tjob_load(j0, tid, r0);
        if (!h1) break;
        tjob_finish(j1, tid, r1, lt0); h1 = TJ_OK(k + 1, j1); if (h1) tjob_load(j1, tid, r1);
        if (!h2) break;
        tjob_finish(j2, tid, r2, lt1); h2 = TJ_OK(k + 2, j2); if (h2) tjob_load(j2, tid, r2);
    }
#undef TJ_OK
    __syncthreads();
}
__device__ __forceinline__ void phase0(const Params& p, unsigned char* lds) {
    const int tid = opaque_tid(), nb = gridDim.x, bid = blockIdx.x, wid = tid >> 6, lane = tid & 63;
    { float* z = (float*)(p.ws + OFF_SSQ);
      for (int i = bid * NTHR + tid; i < 3 * T_ + 64; i += nb * NTHR) z[i] = 0.f;
      if (DUP_PHASE >= 2 && DUP_PHASE <= 4) { float* zd = (float*)(p.ws + OFF_SSQ + (OFF_DUMMY - OFF_SSQ)); for (int i = bid * NTHR + tid; i < 3 * T_ + 64; i += nb * NTHR) zd[i] = 0.f; } }
    { bf16_t* wrt = (bf16_t*)(p.ws + OFF_WR);
      for (int i = bid * NTHR + tid; i < 48 * D_; i += nb * NTHR) {
          const int o = i >> 11, k = i & 2047; float v = 0.f;
          if (o < 4) v = p.rgw[k * 4 + o]; else if (o < 36) v = p.rew[k * 32 + (o - 4)];
          wrt[i] = (bf16_t)(cvt_pk_bf16(v * p.g_ffn[k], 0.f) & 0xffffu); } }
    { bf16_t* xn = (bf16_t*)(p.ws + OFF_B);
      for (int row = bid * 8 + wid; row < T_; row += nb * 8) {
          const float* xr = p.x + (size_t)row * D_;
          f32x4 v[8]; float s = 0.f;
#pragma unroll
          for (int i = 0; i < 8; ++i) { v[i] = *(const f32x4*)(xr + i * 256 + lane * 4); s += (v[i][0] * v[i][0] + v[i][1] * v[i][1]) + (v[i][2] * v[i][2] + v[i][3] * v[i][3]); }
          const float rstd = rsqrtf(wave_sum(s) * (1.f / D_) + EPS);
#pragma unroll
          for (int i = 0; i < 8; ++i) { const f32x4 g = *(const f32x4*)(p.norm_mix_g + i * 256 + lane * 4); const f32x4 o = v[i] * rstd * g;
              u32x2 w; w.x = cvt_pk_bf16(o[0], o[1]); w.y = cvt_pk_bf16(o[2], o[3]); *(u32x2*)(xn + (size_t)row * D_ + i * 256 + lane * 4) = w; } } }
    run_tjobs(p, lds, 0, N_TJOBS_DENSE);
}

__device__ __forceinline__ int side_rounds(int nb) { return (N_TJOBS - N_TJOBS_DENSE + nb - 1) / nb; }
__device__ __forceinline__ void phase1(const Params& p, unsigned char* lds) {
    const Epi1 E{p.ws};
    pg8::StaticOrder S; S.init(T_, DIN, gridDim.x, blockIdx.x); const pg8::AOffDirect AO{D_};
    const int nu = S.count(), col = blockIdx.x & 3, split = col == 0 ? 0 : col == 1 ? (2 * nu) / 5 : col == 2 ? (3 * nu) / 5 : nu;
    const int kr = side_rounds(gridDim.x), k1 = (2 * kr) / 3;
    S.i0 = 0; S.i1 = split;
    pg8::gemm_phase<Epi1, pg8::StaticOrder, pg8::AOffDirect, true>((PG8_LAS unsigned char*)lds, (const bf16_t*)(p.ws + OFF_B), (const bf16_t*)(p.ws + OFF_WIN), D_, S, AO, E);
    run_tjobs(p, lds, N_TJOBS_DENSE, N_TJOBS, 0, k1);
    S.i0 = split; S.i1 = nu;
    pg8::gemm_phase<Epi1, pg8::StaticOrder, pg8::AOffDirect, true>((PG8_LAS unsigned char*)lds, (const bf16_t*)(p.ws + OFF_B), (const bf16_t*)(p.ws + OFF_WIN), D_, S, AO, E);
}

__device__ __forceinline__ void mixer_gmlp_item(const Params& p, unsigned char* lds, int item, size_t so) {
    const int tid = opaque_tid(), wid = tid >> 6, lane = tid & 63, fr = lane & 15, fq = lane >> 4;
    const int h = item & 7, t0 = (item >> 3) * 128;
    const bf16_t* P = (const bf16_t*)(p.ws + OFF_A); bf16_t* Y = (bf16_t*)(p.ws + OFF_B); float* ssq_a = (float*)(p.ws + OFF_SSQ + so);
    bf16_t* Vt = (bf16_t*)lds;
    bf16_t* Wl = Vt + 128 * 136;
    float* rs = (float*)(Wl + 128 * 136);
    { const int j = tid >> 2, dc = (tid & 3) * 32;
      const u32x4* src = (const u32x4*)(P + (size_t)(t0 + j) * DIN + 1024 + h * 128 + dc);
      u32x4 v[4]; float s = 0.f;
#pragma unroll
      for (int q = 0; q < 4; ++q) { v[q] = src[q];
#pragma unroll
          for (int w = 0; w < 4; ++w) { const float lo = bflo(v[q][w]), hi = bfhi(v[q][w]); s += lo * lo + hi * hi; } }
      s += __shfl_xor(s, 1); s += __shfl_xor(s, 2);
      if ((tid & 3) == 0) rs[j] = rsqrtf(s * (1.f / 128.f) + EPS);
#pragma unroll
      for (int q = 0; q < 4; ++q)
#pragma unroll
          for (int w = 0; w < 4; ++w) { const int d = dc + q * 8 + w * 2; Vt[d * 136 + j] = (bf16_t)(v[q][w] & 0xffffu); Vt[(d + 1) * 136 + j] = (bf16_t)(v[q][w] >> 16); } }
    __syncthreads();
    { const int i = tid >> 2, jc = (tid & 3) * 32;
      const f32x4* src = (const f32x4*)(p.gmlp_ws + (size_t)h * 16384 + i * 128 + jc);
      const bool live = (i >> 6) >= (jc >> 6);
#pragma unroll
      for (int q = 0; q < 4; ++q) { f32x4 w0 = src[2 * q], w1 = src[2 * q + 1];
          const f32x4 r0 = *(const f32x4*)(rs + jc + 8 * q), r1 = *(const f32x4*)(rs + jc + 8 * q + 4);
          w0 = live ? w0 * r0 : (f32x4){0.f, 0.f, 0.f, 0.f}; w1 = live ? w1 * r1 : (f32x4){0.f, 0.f, 0.f, 0.f};
          u32x4 o; o.x = cvt_pk_bf16(w0[0], w0[1]); o.y = cvt_pk_bf16(w0[2], w0[3]); o.z = cvt_pk_bf16(w1[0], w1[1]); o.w = cvt_pk_bf16(w1[2], w1[3]);
          *(u32x4*)(Wl + i * 136 + jc + 8 * q) = o; } }
    __syncthreads();
    f32x4 acc[8];
#pragma unroll
    for (int n = 0; n < 8; ++n) acc[n] = (f32x4){0.f, 0.f, 0.f, 0.f};
    const int ksteps = (wid < 4) ? 2 : 4;
    for (int ks = 0; ks < ksteps; ++ks) {
        const bf16x8 bw = *(const bf16x8*)(Wl + (16 * wid + fr) * 136 + ks * 32 + fq * 8);
#pragma unroll
        for (int n = 0; n < 8; ++n) { const bf16x8 av = *(const bf16x8*)(Vt + (16 * n + fr) * 136 + ks * 32 + fq * 8);
            acc[n] = __builtin_amdgcn_mfma_f32_16x16x32_bf16(av, bw, acc[n], 0, 0, 0); }
    }
    { const int i = 16 * wid + fr, t = t0 + i; const float bias = p.gmlp_bs[h * 128 + i]; float ss = 0.f;
#pragma unroll
      for (int n = 0; n < 8; ++n) { const int c = h * 128 + 16 * n + 4 * fq;
          const f32x4 g = *(const f32x4*)(p.v_norm_g + c); const u32x2 uu = *(const u32x2*)(P + (size_t)t * DIN + c);
          const float y0 = bflo(uu.x) * (acc[n][0] * g[0] + bias), y1 = bfhi(uu.x) * (acc[n][1] * g[1] + bias), y2 = bflo(uu.y) * (acc[n][2] * g[2] + bias), y3 = bfhi(uu.y) * (acc[n][3] * g[3] + bias);
          ss += (y0 * y0 + y1 * y1) + (y2 * y2 + y3 * y3);
          u32x2 w; w.x = cvt_pk_bf16(y0, y1); w.y = cvt_pk_bf16(y2, y3); *(u32x2*)(Y + (size_t)t * D_ + c) = w; }
      ss += __shfl_xor(ss, 16); ss += __shfl_xor(ss, 32);
      if (fq == 0) atomicAdd(ssq_a + t, ss); }
    __syncthreads();
}
__device__ __forceinline__ void mixer_conv_item(const Params& p, int item, size_t so) {
    const int tid = opaque_tid(), cl = tid & 31, ts = tid >> 5;
    const int c = (item & 3) * 256 + cl * 8, tbeg = (item >> 2) * 128 + ts * 8;
    const bf16_t* P = (const bf16_t*)(p.ws + OFF_A); bf16_t* Y = (bf16_t*)(p.ws + OFF_B); float* ssq_b = (float*)(p.ws + OFF_SSQ + so) + T_;
    float w0[8], w1[8], w2[8], z1[8], z2[8];
    { const f32x4 a0 = *(const f32x4*)(p.conv_w + c), a1 = *(const f32x4*)(p.conv_w + c + 4), b0 = *(const f32x4*)(p.conv_w + 1024 + c), b1 = *(const f32x4*)(p.conv_w + 1024 + c + 4),
                  c0 = *(const f32x4*)(p.conv_w + 2048 + c), c1 = *(const f32x4*)(p.conv_w + 2048 + c + 4);
#pragma unroll
      for (int q = 0; q < 4; ++q) { w0[q] = a0[q]; w0[4 + q] = a1[q]; w1[q] = b0[q]; w1[4 + q] = b1[q]; w2[q] = c0[q]; w2[4 + q] = c1[q]; } }
#pragma unroll
    for (int q = 0; q < 8; ++q) { z1[q] = 0.f; z2[q] = 0.f; }
    if ((tbeg % SEQ) != 0) {
        const u32x4 ca = *(const u32x4*)(P + (size_t)(tbeg - 1) * DIN + 3072 + c), ha = *(const u32x4*)(P + (size_t)(tbeg - 1) * DIN + 4096 + c);
        const u32x4 cb = *(const u32x4*)(P + (size_t)(tbeg - 2) * DIN + 3072 + c), hb2 = *(const u32x4*)(P + (size_t)(tbeg - 2) * DIN + 4096 + c);
#pragma unroll
        for (int q = 0; q < 4; ++q) { z1[2 * q] = bflo(ca[q]) * bflo(ha[q]); z1[2 * q + 1] = bfhi(ca[q]) * bfhi(ha[q]); z2[2 * q] = bflo(cb[q]) * bflo(hb2[q]); z2[2 * q + 1] = bfhi(cb[q]) * bfhi(hb2[q]); }
    }
    u32x4 bgA[8], cgA[8], hvA[8];
#pragma unroll
    for (int tt = 0; tt < 8; ++tt) { const bf16_t* pr = P + (size_t)(tbeg + tt) * DIN + c; bgA[tt] = *(const u32x4*)(pr + 2048); cgA[tt] = *(const u32x4*)(pr + 3072); hvA[tt] = *(const u32x4*)(pr + 4096); }
#pragma unroll
    for (int tt = 0; tt < 8; ++tt) {
        const int t = tbeg + tt;
        const u32x4 bg = bgA[tt], cgv = cgA[tt], hv = hvA[tt];
        float z[8], y[8], ss = 0.f;
#pragma unroll
        for (int q = 0; q < 4; ++q) { z[2 * q] = bflo(cgv[q]) * bflo(hv[q]); z[2 * q + 1] = bfhi(cgv[q]) * bfhi(hv[q]); }
#pragma unroll
        for (int q = 0; q < 4; ++q) {
            y[2 * q] = bflo(bg[q]) * (w0[2 * q] * z2[2 * q] + w1[2 * q] * z1[2 * q] + w2[2 * q] * z[2 * q]);
            y[2 * q + 1] = bfhi(bg[q]) * (w0[2 * q + 1] * z2[2 * q + 1] + w1[2 * q + 1] * z1[2 * q + 1] + w2[2 * q + 1] * z[2 * q + 1]); }
#pragma unroll
        for (int q = 0; q < 8; ++q) { ss += y[q] * y[q]; z2[q] = z1[q]; z1[q] = z[q]; }
        u32x4 w; w.x = cvt_pk_bf16(y[0], y[1]); w.y = cvt_pk_bf16(y[2], y[3]); w.z = cvt_pk_bf16(y[4], y[5]); w.w = cvt_pk_bf16(y[6], y[7]);
        *(u32x4*)(Y + (size_t)t * D_ + 1024 + c) = w;
        ss += __shfl_xor(ss, 1); ss += __shfl_xor(ss, 2); ss += __shfl_xor(ss, 4); ss += __shfl_xor(ss, 8); ss += __shfl_xor(ss, 16);
        if (cl == 0) atomicAdd(ssq_b + t, ss);
    }
}
__device__ __forceinline__ void phase2(const Params& p, unsigned char* lds, size_t so = 0) {
    for (int it = blockIdx.x; it < 512 + 1024; it += gridDim.x) { if (it < 512) mixer_conv_item(p, it, so); else mixer_gmlp_item(p, lds, it - 512, so); }
}

__device__ __forceinline__ void phase3(const Params& p, unsigned char* lds, size_t so = 0) {
    pg8::StaticOrder S; S.init(T_, D_, gridDim.x, blockIdx.x); const pg8::AOffDirect AO{D_};
    PG8_LAS float* rsl = (PG8_LAS float*)((PG8_LAS unsigned char*)lds + RS_OFF);
    { const float* ssq = (const float*)(p.ws + OFF_SSQ); const int tid = opaque_tid();
      for (int i = 0; i < RS_UNITS; ++i) { Unit u; if (!S.next(i, u)) break;
          if (tid < 256) { const int row = u.pm * 256 + tid; const float va = ssq[row] * (1.f / 1024.f) + EPS, vb = ssq[T_ + row] * (1.f / 1024.f) + EPS;
              rsl[(i * 256 + tid) * 2] = __builtin_amdgcn_sqrtf(vb * __builtin_amdgcn_rcpf(va)); rsl[(i * 256 + tid) * 2 + 1] = __builtin_amdgcn_rsqf(vb); } }
      __syncthreads(); }
    const Epi2 E{p.x, p.ws, so, rsl};
    const int kr = side_rounds(gridDim.x), k0 = (2 * kr) / 3; const bool side = (so == 0);
    if (side && !(blockIdx.x & 1)) run_tjobs(p, lds, N_TJOBS_DENSE, N_TJOBS, k0, kr);
    pg8::gemm_phase<Epi2, pg8::StaticOrder, pg8::AOffDirect, true>((PG8_LAS unsigned char*)lds, (const bf16_t*)(p.ws + OFF_B), (const bf16_t*)(p.ws + OFF_WOUT), D_, S, AO, E);
    if (side && (blockIdx.x & 1)) run_tjobs(p, lds, N_TJOBS_DENSE, N_TJOBS, k0, kr);
}

__device__ __forceinline__ void route_item(const Params& p, unsigned char* lds, int item, size_t so) {
    const int tid = opaque_tid(), wid = tid >> 6, lane = tid & 63, fr = lane & 15, fq = lane >> 4;
    float* lg = (float*)lds;
    float* ls = lg + 8 * 64 * 48;
    int* lcnt = (int*)(ls + 64 * 48); int* lbase = lcnt + 32;
    const bf16_t* hb = (const bf16_t*)(p.ws + OFF_HB); const bf16_t* wrt = (const bf16_t*)(p.ws + OFF_WR);
    const float* ssq_h = (const float*)(p.ws + OFF_SSQ) + 2 * T_;
    int* cnt = (int*)(p.ws + OFF_CNT + so); int* rinfo = (int*)(p.ws + OFF_RINFO + so); float* rw = (float*)(p.ws + OFF_RW + so);
    const int t0 = item * 64;
    if (tid < 32) lcnt[tid] = 0;
    f32x4 acc[4][3];
#pragma unroll
    for (int m = 0; m < 4; ++m)
#pragma unroll
        for (int n = 0; n < 3; ++n) acc[m][n] = (f32x4){0.f, 0.f, 0.f, 0.f};
    const bf16_t* ap = hb + (size_t)(t0 + fr) * D_ + wid * 256 + fq * 8; const bf16_t* bp = wrt + (size_t)fr * D_ + wid * 256 + fq * 8;
#pragma unroll 4
    for (int ks = 0; ks < 8; ++ks) {
        bf16x8 a[4], b[3];
#pragma unroll
        for (int m = 0; m < 4; ++m) a[m] = *(const bf16x8*)(ap + (size_t)m * 16 * D_ + ks * 32);
#pragma unroll
        for (int n = 0; n < 3; ++n) b[n] = *(const bf16x8*)(bp + (size_t)n * 16 * D_ + ks * 32);
#pragma unroll
        for (int m = 0; m < 4; ++m)
#pragma unroll
            for (int n = 0; n < 3; ++n) acc[m][n] = __builtin_amdgcn_mfma_f32_16x16x32_bf16(a[m], b[n], acc[m][n], 0, 0, 0);
    }
#pragma unroll
    for (int m = 0; m < 4; ++m)
#pragma unroll
        for (int n = 0; n < 3; ++n)
#pragma unroll
            for (int j = 0; j < 4; ++j) lg[(wid * 64 + m * 16 + 4 * fq + j) * 48 + 16 * n + fr] = acc[m][n][j];
    __syncthreads();
    for (int i = tid; i < 64 * 48; i += NTHR) { float v = 0.f;
#pragma unroll
        for (int w = 0; w < 8; ++w) v += lg[w * 64 * 48 + i];
        ls[i] = v; }
    __syncthreads();
    int e0 = 0, e1 = 0, r0 = 0, r1 = 0; float g0 = 0.f, g1 = 0.f, rsc = 0.f; const int t = t0 + tid;
    if (tid < 64) {
        const float* l0 = ls + tid * 48; const float rstd = rsqrtf(ssq_h[t] * (1.f / D_) + EPS); rsc = rstd * (1.f / WGU_SCALE);
        float gm = -3.0e38f; int gi = 0; float gl[4];
#pragma unroll
        for (int o = 0; o < 4; ++o) { gl[o] = l0[o] * rstd + p.rgb[o]; if (gl[o] > gm) { gm = gl[o]; gi = o; } }
        float gs = 0.f;
#pragma unroll
        for (int o = 0; o < 4; ++o) gs += __expf(gl[o] - gm);
        const float pg = 1.f / gs;
        float b1 = -3.0e38f, b2 = -3.0e38f; int i1 = 0, i2 = 0;
        for (int q = 0; q < 8; ++q) { const float v = l0[4 + gi * 8 + q] * rstd + p.reb[gi * 8 + q];
            if (v > b1) { b2 = b1; i2 = i1; b1 = v; i1 = q; } else if (v > b2) { b2 = v; i2 = q; } }
        const float wa = 1.f / (1.f + __expf(b2 - b1));
        e0 = gi * 8 + i1; e1 = gi * 8 + i2; g0 = pg * wa; g1 = pg * (1.f - wa);
        r0 = atomicAdd(&lcnt[e0], 1); r1 = atomicAdd(&lcnt[e1], 1);
    }
    __syncthreads();
    if (tid < 32) lbase[tid] = atomicAdd(cnt + tid, lcnt[tid]);
    __syncthreads();
    if (tid < 64) { const int i0 = lbase[e0] + r0, i1 = lbase[e1] + r1;
        rinfo[e0 * LCAP + i0] = (int)((cvt_pk_bf16(g0, 0.f) << 16) | (unsigned)(2 * t)); rinfo[e1 * LCAP + i1] = (int)((cvt_pk_bf16(g1, 0.f) << 16) | (unsigned)(2 * t + 1));
        rw[e0 * LCAP + i0] = rsc; rw[e1 * LCAP + i1] = rsc; }
    __syncthreads();
}
__device__ __forceinline__ void phase4(const Params& p, unsigned char* lds, size_t so = 0) { for (int it = blockIdx.x; it < T_ / 64; it += gridDim.x) route_item(p, lds, it, so); }

__device__ __forceinline__ PG8_LAS int* moe_tables_to_lds(const Params& p, unsigned char* lds) {
    PG8_LAS int* tb = (PG8_LAS int*)((PG8_LAS unsigned char*)lds + LCNT_OFF); const int* cnt = (const int*)(p.ws + OFF_CNT);
    if (threadIdx.x < NE) tb[MT_CNT + threadIdx.x] = __hip_atomic_load(cnt + threadIdx.x, __ATOMIC_RELAXED, __HIP_MEMORY_SCOPE_AGENT);
    __syncthreads();
    if (threadIdx.x == 0) { int pt = 0;
        for (int e = 0; e < NE; ++e) { const int nt = (tb[MT_CNT + e] + 255) >> 8; tb[MT_PST + e] = pt; for (int i = 0; i < nt; ++i) tb[MT_T2E + pt + i] = e; pt += nt; }
        tb[MT_PST + NE] = pt; tb[MT_NT] = pt; }
    __syncthreads();
    return tb;
}
__device__ __forceinline__ void phase5(const Params& p, unsigned char* lds) {
    PG8_LAS int* lc = moe_tables_to_lds(p, lds);
    const Epi5 E{p.ws, lc};
    const pg8::MoeOrder S{lc, 4, (int)gridDim.x, (int)blockIdx.x}; const pg8::AOffGather AO{p.ws, lc, D_ / 2};
    pg8::gemm_phase<Epi5, pg8::MoeOrder, pg8::AOffGather, true, true>((PG8_LAS unsigned char*)lds, (const bf16_t*)(p.ws + OFF_H8), (const bf16_t*)(p.ws + OFF_WGU), D_ / 2, S, AO, E);
}
__device__ __forceinline__ void phase6(const Params& p, unsigned char* lds) {
    PG8_LAS int* lc = moe_tables_to_lds(p, lds);
    const Epi6 E{p.ws, lc};
    const pg8::MoeOrder S{lc, 8, (int)gridDim.x, (int)blockIdx.x}; const pg8::AOffDirect AO{DE / 2};
    pg8::gemm_phase<Epi6, pg8::MoeOrder, pg8::AOffDirect, true, true>((PG8_LAS unsigned char*)lds, (const bf16_t*)(p.ws + OFF_B), (const bf16_t*)(p.ws + OFF_WD), DE / 2, S, AO, E);
}
__device__ __forceinline__ void phase7(const Params& p) {
    const int tid = opaque_tid(), wid = tid >> 6, lane = tid & 63;
    const bf16_t* hb = (const bf16_t*)(p.ws + OFF_HB); const unsigned char* ys2 = p.ws + OFF_A;
    for (int t = blockIdx.x * 8 + wid; t < T_; t += gridDim.x * 8) {
        float v[4][8]; float s = 0.f;
#pragma unroll
        for (int i = 0; i < 4; ++i) { const int c = i * 512 + lane * 8;
            const u32x4 a = *(const u32x4*)(hb + (size_t)t * D_ + c); const u32x2 b = *(const u32x2*)(ys2 + (size_t)(2 * t) * D_ + c), d = *(const u32x2*)(ys2 + (size_t)(2 * t + 1) * D_ + c);
            float y0[8], y1[8];
            up4_fp8(b.x, y0[0], y0[1], y0[2], y0[3]); up4_fp8(b.y, y0[4], y0[5], y0[6], y0[7]); up4_fp8(d.x, y1[0], y1[1], y1[2], y1[3]); up4_fp8(d.y, y1[4], y1[5], y1[6], y1[7]);
#pragma unroll
            for (int q = 0; q < 4; ++q) { v[i][2 * q] = bflo(a[q]) + (y0[2 * q] + y1[2 * q]) * (1.f / YS_SCALE); v[i][2 * q + 1] = bfhi(a[q]) + (y0[2 * q + 1] + y1[2 * q + 1]) * (1.f / YS_SCALE);
                s += v[i][2 * q] * v[i][2 * q] + v[i][2 * q + 1] * v[i][2 * q + 1]; } }
        const float rstd = rsqrtf(wave_sum(s) * (1.f / D_) + EPS);
#pragma unroll
        for (int i = 0; i < 4; ++i) { const int c = i * 512 + lane * 8;
            const f32x4 g0 = *(const f32x4*)(p.g_final + c), g1 = *(const f32x4*)(p.g_final + c + 4);
            f32x4 o0, o1;
#pragma unroll
            for (int q = 0; q < 4; ++q) { o0[q] = v[i][q] * rstd * g0[q]; o1[q] = v[i][4 + q] * rstd * g1[q]; }
            *(f32x4*)(p.out + (size_t)t * D_ + c) = o0; *(f32x4*)(p.out + (size_t)t * D_ + c + 4) = o1; }
    }
}

#ifndef ONE_LAUNCH
#define ONE_LAUNCH 1
#endif
template <int PH> __global__ void __launch_bounds__(NTHR, 2) k_phase(Params p) {
    extern __shared__ __attribute__((aligned(16))) unsigned char lds[];
    if (PH == 0) phase0(p, lds);
    if (PH == 1) phase1(p, lds);
    if (PH == 2) phase2(p, lds);
    if (PH == 3) phase3(p, lds);
    if (PH == 4) phase4(p, lds);
    if (PH == 5) phase5(p, lds);
    if (PH == 6) phase6(p, lds);
    if (PH == 7) phase7(p);
}
__global__ void __launch_bounds__(NTHR, 2) k_mega(Params p) {
    extern __shared__ __attribute__((aligned(16))) unsigned char lds[];
    cg::grid_group grid = cg::this_grid();
    volatile PG8_LAS unsigned* bst = (volatile PG8_LAS unsigned*)((PG8_LAS unsigned char*)lds + LBAR_OFF);
    if (threadIdx.x < 2) bst[threadIdx.x] = 0u;
    __syncthreads();
    (void)xcd_barrier_post((unsigned*)(p.ws + OFF_BAR), bst);
#define GRID_BAR() do { XcdBarrier b_; b_.bar = (unsigned*)(opaque_ws(p.ws) + OFF_BAR); b_.x = xb_xcc_id(); b_.st = bst; xcd_barrier(b_); } while (0)
    if (DUP_PHASE == 0) { phase0(p, lds); GRID_BAR(); }
    if (p.ws == nullptr) grid.sync();
    phase0(p, lds); GRID_BAR();
    if (DUP_PHASE == 1) { phase1(p, lds); GRID_BAR(); }
    phase1(p, lds); GRID_BAR();
    if (DUP_PHASE == 2) { phase2(p, lds, OFF_DUMMY - OFF_SSQ); GRID_BAR(); }
    phase2(p, lds); GRID_BAR();
    if (DUP_PHASE == 3) { phase3(p, lds, OFF_DUMMY - OFF_SSQ); GRID_BAR(); }
    phase3(p, lds); GRID_BAR();
    if (DUP_PHASE == 4) { phase4(p, lds, OFF_DUMMY - OFF_SSQ); GRID_BAR(); }
    phase4(p, lds); GRID_BAR();
    if (DUP_PHASE == 5) { phase5(p, lds); GRID_BAR(); }
    phase5(p, lds); GRID_BAR();
    if (DUP_PHASE == 6) { phase6(p, lds); GRID_BAR(); }
    phase6(p, lds); GRID_BAR();
    if (DUP_PHASE == 8) { for (int i = 0; i < 10; ++i) GRID_BAR(); }
    if (DUP_PHASE == 9) { grid.sync(); grid.sync(); }
    if (DUP_PHASE == 7) { phase7(p); GRID_BAR(); }
    phase7(p);
}

extern "C" void kernel_launch(void* const* d_in, const int* in_sizes, int n_in, void* d_out, int out_size, void* d_ws, size_t ws_size, hipStream_t stream) {
    static int grid = 0;
    if (grid == 0) {
        if (n_in != 19 || in_sizes[0] != T_ * D_ || out_size != T_ * D_ || ws_size < WS_END + (DUP_PHASE >= 2 && DUP_PHASE <= 4 ? DUMMY_BYTES : 0)) { fprintf(stderr, "kernel_launch: unexpected shapes (n_in %d, in0 %d, out %d, ws %zu < %zu); nothing launched\n", n_in, n_in > 0 ? in_sizes[0] : -1, out_size, ws_size, (size_t)WS_END); grid = -1; return; }
        int dev = 0, cus = 0, per_cu = 0;
        if (hipGetDevice(&dev) != hipSuccess || hipDeviceGetAttribute(&cus, hipDeviceAttributeMultiprocessorCount, dev) != hipSuccess) { grid = -1; return; }
#if ONE_LAUNCH
        if (hipFuncSetAttribute((const void*)k_mega, hipFuncAttributeMaxDynamicSharedMemorySize, LDS_BYTES) != hipSuccess) { fprintf(stderr, "kernel_launch: hipFuncSetAttribute failed\n"); grid = -1; return; }
        if (hipOccupancyMaxActiveBlocksPerMultiprocessor(&per_cu, (const void*)k_mega, NTHR, LDS_BYTES) != hipSuccess || per_cu < 1) { fprintf(stderr, "kernel_launch: occupancy query says %d blocks per CU\n", per_cu); grid = -1; return; }
        grid = cus * per_cu;
#else
        (void)hipFuncSetAttribute((const void*)k_phase<0>, hipFuncAttributeMaxDynamicSharedMemorySize, LDS_BYTES);
        (void)hipFuncSetAttribute((const void*)k_phase<1>, hipFuncAttributeMaxDynamicSharedMemorySize, LDS_BYTES);
        (void)hipFuncSetAttribute((const void*)k_phase<2>, hipFuncAttributeMaxDynamicSharedMemorySize, LDS_BYTES);
        (void)hipFuncSetAttribute((const void*)k_phase<3>, hipFuncAttributeMaxDynamicSharedMemorySize, LDS_BYTES);
        (void)hipFuncSetAttribute((const void*)k_phase<4>, hipFuncAttributeMaxDynamicSharedMemorySize, LDS_BYTES);
        (void)hipFuncSetAttribute((const void*)k_phase<5>, hipFuncAttributeMaxDynamicSharedMemorySize, LDS_BYTES);
        (void)hipFuncSetAttribute((const void*)k_phase<6>, hipFuncAttributeMaxDynamicSharedMemorySize, LDS_BYTES);
        (void)hipFuncSetAttribute((const void*)k_phase<7>, hipFuncAttributeMaxDynamicSharedMemorySize, LDS_BYTES);
        grid = cus > 0 ? cus : 256;
#endif
    }
    if (grid < 0) return;
    Params p{};
    const float** f = (const float**)&p;
    for (int i = 0; i < 19; ++i) f[i] = (const float*)d_in[i];
    p.out = (float*)d_out; p.ws = (unsigned char*)d_ws;
#if ONE_LAUNCH
    if (hipMemsetAsync((unsigned char*)d_ws + OFF_BAR, 0, BAR_BYTES, stream) != hipSuccess) { fprintf(stderr, "kernel_launch: memset of the barrier words failed\n"); return; }
    void* args[] = {&p};
    const hipError_t e = hipLaunchCooperativeKernel((const void*)k_mega, dim3(grid), dim3(NTHR), args, LDS_BYTES, stream);
    if (e != hipSuccess) fprintf(stderr, "kernel_launch: cooperative launch failed: %s (grid %d)\n", hipGetErrorString(e), grid);
#else
    hipLaunchKernelGGL(k_phase<0>, dim3(grid), dim3(NTHR), LDS_BYTES, stream, p);
    hipLaunchKernelGGL(k_phase<1>, dim3(grid), dim3(NTHR), LDS_BYTES, stream, p);
    hipLaunchKernelGGL(k_phase<2>, dim3(grid), dim3(NTHR), LDS_BYTES, stream, p);
    hipLaunchKernelGGL(k_phase<3>, dim3(grid), dim3(NTHR), LDS_BYTES, stream, p);
    hipLaunchKernelGGL(k_phase<4>, dim3(grid), dim3(NTHR), LDS_BYTES, stream, p);
    hipLaunchKernelGGL(k_phase<5>, dim3(grid), dim3(NTHR), LDS_BYTES, stream, p);
    hipLaunchKernelGGL(k_phase<6>, dim3(grid), dim3(NTHR), LDS_BYTES, stream, p);
    hipLaunchKernelGGL(k_phase<7>, dim3(grid), dim3(NTHR), LDS_BYTES, stream, p);
#endif
}
```

```cpp
#include <hip/hip_runtime.h>
#include <hip/hip_cooperative_groups.h>
#include <cstdio>
namespace cg = cooperative_groups;

typedef unsigned short bf16_t;
typedef float f32x4 __attribute__((ext_vector_type(4)));
typedef unsigned u32x4 __attribute__((ext_vector_type(4)));
typedef unsigned u32x2 __attribute__((ext_vector_type(2)));
typedef short bf16x8 __attribute__((ext_vector_type(8)));
typedef int v4i __attribute__((ext_vector_type(4)));
typedef int v8i __attribute__((ext_vector_type(8)));

constexpr int T_ = 16384, D_ = 2048, DIN = 5120, NE = 32, DE = 512, SEQ = 4096, LCAP = 16384;
constexpr float EPS = 1e-6f;
#ifndef DUP_PHASE
#define DUP_PHASE -1
#endif
constexpr int NTHR = 512;
constexpr int LDS_BYTES = 163840;
constexpr int LCNT_OFF = 131072, LBAR_OFF = 131072 + 2048, XS_OFF = 131072 + 4096, XM_OFF = XS_OFF + 8192, RS_OFF = XM_OFF;
constexpr int RS_UNITS = 4;
static_assert(XM_OFF + 512 * 32 <= LDS_BYTES && RS_UNITS * 256 * 8 <= 512 * 32, "LDS map");

constexpr size_t SZ_A = (size_t)T_ * DIN * 2;
constexpr size_t SZ_B = (size_t)T_ * D_ * 2;
constexpr size_t OFF_A = 0;
constexpr size_t OFF_B = OFF_A + SZ_A;
constexpr size_t OFF_HB = OFF_B + SZ_B;
constexpr size_t OFF_H8 = OFF_A + (size_t)2 * T_ * D_ * 2;
constexpr float WGU_SCALE = 32.f, WD_SCALE = 16.f, YS_SCALE = 16.f;
constexpr size_t OFF_WIN = OFF_HB + SZ_B;
constexpr size_t OFF_WOUT = OFF_WIN + (size_t)DIN * D_ * 2;
constexpr size_t OFF_WGU = OFF_WOUT + (size_t)D_ * D_ * 2;
constexpr size_t OFF_WD = OFF_WGU + (size_t)NE * 1024 * D_ * 2;
constexpr size_t OFF_WR = OFF_WD + (size_t)NE * D_ * DE * 2;
constexpr size_t OFF_SSQ = OFF_WR + (size_t)48 * D_ * 2;
constexpr size_t OFF_CNT = OFF_SSQ + (size_t)3 * T_ * 4;
constexpr size_t OFF_RINFO = OFF_CNT + 256;
constexpr size_t OFF_RW = OFF_RINFO + (size_t)NE * LCAP * 4;
constexpr size_t OFF_BAR = OFF_RW + (size_t)NE * LCAP * 4;
constexpr size_t BAR_BYTES = 16384;
constexpr size_t WS_END = OFF_BAR + BAR_BYTES;
constexpr size_t OFF_DUMMY = WS_END;
constexpr size_t DUMMY_BYTES = (OFF_BAR - OFF_SSQ);

struct Params {
    const float *x, *norm_mix_g, *w_in, *v_norm_g, *gmlp_ws, *gmlp_bs, *conv_w, *g_a, *g_b, *w_out, *g_ffn, *rgw, *rgb, *rew, *reb, *ewg, *ewu, *ewd, *g_final;
    float* out; unsigned char* ws;
};

__device__ __forceinline__ unsigned cvt_pk_bf16(float lo, float hi) { unsigned r; asm volatile("v_cvt_pk_bf16_f32 %0, %1, %2" : "=v"(r) : "v"(lo), "v"(hi)); return r; }
#define GAS __attribute__((address_space(1)))
typedef GAS unsigned char gbyte;
__device__ __forceinline__ gbyte* opaque_ws(unsigned char* w) { gbyte* g = (gbyte*)w; asm volatile("" : "+s"(g)); return g; }
__device__ __forceinline__ int opaque_tid() { int t = threadIdx.x; asm volatile("" : "+v"(t)); return t; }
__device__ __forceinline__ unsigned pk4_fp8(float a, float b, float c, float d) { int w = 0; w = __builtin_amdgcn_cvt_pk_fp8_f32(a, b, w, false); w = __builtin_amdgcn_cvt_pk_fp8_f32(c, d, w, true); return (unsigned)w; }
__device__ __forceinline__ void up4_fp8(unsigned w, float& a, float& b, float& c, float& d) {
    const auto lo = __builtin_amdgcn_cvt_pk_f32_fp8((int)w, false), hi = __builtin_amdgcn_cvt_pk_f32_fp8((int)w, true); a = lo[0]; b = lo[1]; c = hi[0]; d = hi[1]; }
__device__ __forceinline__ float bflo(unsigned w) { return __uint_as_float(w << 16); }
__device__ __forceinline__ float bfhi(unsigned w) { return __uint_as_float(w & 0xffff0000u); }
__device__ __forceinline__ float wave_sum(float v) {
#pragma unroll
    for (int o = 1; o < 64; o <<= 1) v += __shfl_xor(v, o);
    return v;
}
__device__ __forceinline__ float gelu_t(float x) {
    const float u = x * (0.7978845608f + 0.0356774081f * x * x);
    return x * __builtin_amdgcn_rcpf(1.f + __builtin_amdgcn_exp2f(-2.885390082f * u));
}
__device__ __forceinline__ float silu_f(float x) { return x * __builtin_amdgcn_rcpf(1.f + __builtin_amdgcn_exp2f(-1.442695041f * x)); }

#define PG8_LAS __attribute__((address_space(3)))
struct Unit { int pm, pn, e, r0, pnl; };

constexpr int MT_CNT = 0, MT_PST = 32, MT_NT = 65, MT_T2E = 66, MT_WORDS = 66 + 192;
typedef const PG8_LAS int* lcnt_t;
__device__ __forceinline__ bool moe_unit(lcnt_t tb, int NT, int L, Unit& u) {
    const int pt = L / NT;
    if (pt >= __builtin_amdgcn_readfirstlane(tb[MT_NT])) return false;
    const int e = __builtin_amdgcn_readfirstlane(tb[MT_T2E + pt]), mt = pt - __builtin_amdgcn_readfirstlane(tb[MT_PST + e]), j = L - pt * NT;
    u.e = e; u.pm = pt; u.r0 = mt * 256; u.pnl = j; u.pn = e * NT + j; return true;
}

struct NoMeta {};
struct Meta8 { u32x4 lo, hi; };
struct Epi1 {
    static constexpr bool PERM = true, MIDSCALE = false;
    typedef NoMeta Meta;
    unsigned char* ws;
    __device__ __forceinline__ Meta meta_load(const Unit&, int, int) const { return Meta{}; }
    __device__ __forceinline__ void operator()(f32x4 (&acc)[2][2][4][2], const Unit& u, int wr, int wc, int fr, int fq, const Meta&) const {
        GAS bf16_t* P = (GAS bf16_t*)(opaque_ws(ws) + OFF_A);
        const bool act = u.pn < 8;
#pragma unroll
        for (int ai = 0; ai < 2; ++ai)
#pragma unroll
            for (int m = 0; m < 4; ++m) {
                const int row = u.pm * 256 + ai * 128 + wr * 64 + m * 16 + fr;
                GAS bf16_t* rowp = P + (size_t)row * DIN + u.pn * 256 + wc * 32 + 8 * fq;
#pragma unroll
                for (int bj = 0; bj < 2; ++bj) {
                    f32x4 v0 = acc[ai][bj][m][0], v1 = acc[ai][bj][m][1];
                    if (act) {
#pragma unroll
                        for (int j = 0; j < 4; ++j) { v0[j] = gelu_t(v0[j]); v1[j] = gelu_t(v1[j]); }
                    }
                    u32x4 w; w.x = cvt_pk_bf16(v0[0], v0[1]); w.y = cvt_pk_bf16(v0[2], v0[3]); w.z = cvt_pk_bf16(v1[0], v1[1]); w.w = cvt_pk_bf16(v1[2], v1[3]);
                    *(GAS u32x4*)(rowp + bj * 128) = w;
                }
            }
    }
};
struct Epi2 {
    static constexpr bool PERM = true, MIDSCALE = true;
    const float* x; unsigned char* ws; size_t so;
    const PG8_LAS float* rsl;
    __device__ __forceinline__ void midscale(f32x4 (&acc)[2][2][4][2], const Unit& u, int wr, int wc, int fr, int fq) const {
        const PG8_LAS float* pr = rsl + (u.e * 256 + wr * 64 + fr) * 2;
#pragma unroll
        for (int ai = 0; ai < 2; ++ai)
#pragma unroll
            for (int m = 0; m < 4; ++m) {
                const float s = pr[(ai * 128 + m * 16) * 2];
#pragma unroll
                for (int bj = 0; bj < 2; ++bj)
#pragma unroll
                    for (int n = 0; n < 2; ++n) acc[ai][bj][m][n] *= s;
            }
    }
    typedef NoMeta Meta;
    __device__ __forceinline__ Meta meta_load(const Unit&, int, int) const { return Meta{}; }
    __device__ __forceinline__ void operator()(f32x4 (&acc)[2][2][4][2], const Unit& u, int wr, int wc, int fr, int fq, const Meta&) const {
        gbyte* w_ = opaque_ws(ws);
        GAS bf16_t* hb = (GAS bf16_t*)(w_ + OFF_HB); gbyte* h8 = w_ + OFF_H8; float* ssq_h = (float*)(ws + OFF_SSQ + so) + 2 * T_;
#pragma unroll
        for (int ai = 0; ai < 2; ++ai)
#pragma unroll
            for (int m = 0; m < 4; ++m) {
                const int row = u.pm * 256 + ai * 128 + wr * 64 + m * 16 + fr;
                const float rb = rsl[(u.e * 256 + ai * 128 + wr * 64 + m * 16 + fr) * 2 + 1];
                const size_t off = (size_t)row * D_ + u.pn * 256 + wc * 32 + 8 * fq;
                float ss = 0.f;
#pragma unroll
                for (int bj = 0; bj < 2; ++bj) {
                    const f32x4 x0 = *(const f32x4*)(x + off + bj * 128), x1 = *(const f32x4*)(x + off + bj * 128 + 4);
                    const f32x4 h0 = x0 + acc[ai][bj][m][0] * rb, h1 = x1 + acc[ai][bj][m][1] * rb;
                    ss += (h0[0] * h0[0] + h0[1] * h0[1]) + (h0[2] * h0[2] + h0[3] * h0[3]) + (h1[0] * h1[0] + h1[1] * h1[1]) + (h1[2] * h1[2] + h1[3] * h1[3]);
                    u32x4 w; w.x = cvt_pk_bf16(h0[0], h0[1]); w.y = cvt_pk_bf16(h0[2], h0[3]); w.z = cvt_pk_bf16(h1[0], h1[1]); w.w = cvt_pk_bf16(h1[2], h1[3]);
                    *(GAS u32x4*)(hb + off + bj * 128) = w;
                    u32x2 w8; w8.x = pk4_fp8(h0[0], h0[1], h0[2], h0[3]); w8.y = pk4_fp8(h1[0], h1[1], h1[2], h1[3]);
                    *(GAS u32x2*)(h8 + off + bj * 128) = w8;
                }
                ss += __shfl_xor(ss, 16); ss += __shfl_xor(ss, 32);
                if (fq == 0) atomicAdd(ssq_h + row, ss);
                if (m == 3) asm volatile("" ::: "memory");
            }
    }
};
struct Epi5 {
    static constexpr bool PERM = true, MIDSCALE = false;
    typedef Meta8 Meta;
    unsigned char* ws; lcnt_t cnt;
    __device__ __forceinline__ Meta meta_load(const Unit& u, int wr, int fr) const {
        const GAS unsigned* rrs = (const GAS unsigned*)(opaque_ws(ws) + OFF_RW) + u.e * LCAP; const int ce = __builtin_amdgcn_readfirstlane(cnt[u.e]); Meta mt;
#pragma unroll
        for (int q = 0; q < 4; ++q) { const int i0 = u.r0 + wr * 64 + q * 16 + fr, i1 = i0 + 128;
            const unsigned a = rrs[min(i0, ce - 1)], b = rrs[min(i1, ce - 1)]; mt.lo[q] = (i0 < ce) ? a : 0u; mt.hi[q] = (i1 < ce) ? b : 0u; }
        return mt;
    }
    __device__ __forceinline__ void operator()(f32x4 (&acc)[2][2][4][2], const Unit& u, int wr, int wc, int fr, int fq, const Meta& mt) const {
        gbyte* hbuf = opaque_ws(ws) + OFF_B;
#pragma unroll
        for (int ai = 0; ai < 2; ++ai)
#pragma unroll
            for (int m = 0; m < 4; ++m) {
                const int r = ai * 128 + wr * 64 + m * 16 + fr;
                const float rs = __uint_as_float(ai ? mt.hi[m] : mt.lo[m]);
                float o[8];
#pragma unroll
                for (int n = 0; n < 2; ++n)
#pragma unroll
                    for (int j = 0; j < 4; ++j) o[4 * n + j] = silu_f(acc[ai][0][m][n][j] * rs) * (acc[ai][1][m][n][j] * rs);
                u32x2 w; w.x = pk4_fp8(o[0], o[1], o[2], o[3]); w.y = pk4_fp8(o[4], o[5], o[6], o[7]);
                *(GAS u32x2*)(hbuf + (size_t)(u.pm * 256 + r) * DE + u.pnl * 128 + wc * 32 + 8 * fq) = w;
                if (m & 1) asm volatile("" ::: "memory");
            }
    }
};
struct Epi6 {
    static constexpr bool PERM = true, MIDSCALE = false;
    typedef Meta8 Meta;
    unsigned char* ws; lcnt_t cnt;
    __device__ __forceinline__ Meta meta_load(const Unit& u, int wr, int fr) const {
        const GAS unsigned* rpk = (const GAS unsigned*)(opaque_ws(ws) + OFF_RINFO) + u.e * LCAP; const int ce = __builtin_amdgcn_readfirstlane(cnt[u.e]); Meta mt;
#pragma unroll
        for (int q = 0; q < 4; ++q) { const int i0 = u.r0 + wr * 64 + q * 16 + fr, i1 = i0 + 128;
            const unsigned a = rpk[min(i0, ce - 1)], b = rpk[min(i1, ce - 1)]; mt.lo[q] = (i0 < ce) ? a : 0xFFFFFFFFu; mt.hi[q] = (i1 < ce) ? b : 0xFFFFFFFFu; }
        return mt;
    }
    __device__ __forceinline__ void operator()(f32x4 (&acc)[2][2][4][2], const Unit& u, int wr, int wc, int fr, int fq, const Meta& mt) const {
        gbyte* ys2 = opaque_ws(ws) + OFF_A;
#pragma unroll
        for (int ai = 0; ai < 2; ++ai)
#pragma unroll
            for (int m = 0; m < 4; ++m) {
                const unsigned pk = ai ? mt.hi[m] : mt.lo[m]; const unsigned info = pk & 0xFFFFu;
                if (info < 2u * T_) {
                    const float g = __uint_as_float(pk & 0xFFFF0000u) * (YS_SCALE / WD_SCALE);
                    gbyte* dst = ys2 + (size_t)info * D_ + u.pnl * 256 + wc * 32 + 8 * fq;
#pragma unroll
                    for (int bj = 0; bj < 2; ++bj) {
                        const f32x4 v0 = acc[ai][bj][m][0] * g, v1 = acc[ai][bj][m][1] * g;
                        u32x2 w; w.x = pk4_fp8(v0[0], v0[1], v0[2], v0[3]); w.y = pk4_fp8(v1[0], v1[1], v1[2], v1[3]);
                        *(GAS u32x2*)(dst + bj * 128) = w;
                    }
                }
            }
    }
};

namespace pg8 {
constexpr int BM = 256, BK = 64, HALF = 128, HTB = HALF * BK * 2, STAGE_BYTES = 8 * HTB, NXCD = 8, WGM = 8;
__host__ __device__ __forceinline__ int lds_byte(int r, int c) { const int st = (r >> 4) * 2 + (c >> 5), rr = r & 15, cc = c & 31, ob = rr * 64 + cc * 2; return st * 1024 + (ob ^ (((ob >> 9) & 1) << 5)); }
__host__ __device__ __forceinline__ void stage_rc(int b, int& R, int& C) { const int st = b / 1024, sb = b % 1024, swz = sb ^ (((sb >> 9) & 1) << 5); R = (st >> 1) * 16 + swz / 64; C = (st & 1) * 32 + (swz % 64) / 2; }
__host__ __device__ __forceinline__ int perm32(int rho) { const int n = rho >> 4, i = rho & 15; return 8 * (i >> 2) + 4 * n + (i & 3); }

struct StaticOrder {
    int nM, nN, nwg, G, c, i0, i1;
    __device__ void init(int M, int N, int G_, int c_) { nM = M / BM; nN = N / BM; nwg = nM * nN; G = G_; c = c_; i0 = 0; i1 = 1 << 30; }
    __device__ int count() const { return (nwg - c + G - 1) / G; }
    __device__ bool next(int ii, Unit& u) const {
        const int i = ii + i0; if (i >= i1) return false;
        const long L = (long)i * G + c; if (L >= nwg) return false;
        int wgid = (int)L; { const int q = nwg / NXCD, r = nwg % NXCD, xcd = wgid % NXCD, off = wgid / NXCD; wgid = (xcd < r ? xcd * (q + 1) : r * (q + 1) + (xcd - r) * q) + off; }
        const int nig = WGM * nN, gid = wgid / nig, fm = gid * WGM, gsz = (nM - fm) < WGM ? (nM - fm) : WGM;
        u.pm = fm + ((wgid % nig) % gsz); u.pn = (wgid % nig) / gsz; u.e = i; u.r0 = 0; u.pnl = u.pn; return true;
    }
};
struct MoeOrder {
    lcnt_t cnt; int NT, G, c;
    __device__ __forceinline__ bool next(int i, Unit& u) const { return moe_unit(cnt, NT, i * G + c, u); }
};
struct AOffDirect { int K; struct Pre {};
    __device__ __forceinline__ Pre pre(const Unit&, int, int) const { return Pre{}; }
    __device__ __forceinline__ unsigned fin(const Pre&, const Unit& u, int h, int i, int R, int C) const { return (unsigned)(((u.pm * 256 + h * 128 + R) * K + C) * 2); } };
struct AOffGather { unsigned char* ws; lcnt_t cnt; int K;
    struct Pre { unsigned pk[2][2]; };
    __device__ __forceinline__ Pre pre(const Unit& u, int R0, int R1) const {
        const GAS unsigned* rpk = (const GAS unsigned*)(opaque_ws(ws) + OFF_RINFO) + u.e * LCAP; const int ce = __builtin_amdgcn_readfirstlane(cnt[u.e]); Pre p;
#pragma unroll
        for (int h = 0; h < 2; ++h) { const int i0 = u.r0 + h * 128 + R0, i1 = u.r0 + h * 128 + R1;
            p.pk[h][0] = rpk[min(i0, ce - 1)]; p.pk[h][1] = rpk[min(i1, ce - 1)]; }
        return p;
    }
    __device__ __forceinline__ unsigned fin(const Pre& p, const Unit&, int h, int i, int, int C) const { const int tok = (int)((p.pk[h][i] & 0xFFFFu) >> 1); return (unsigned)((tok * K + C) * 2); } };

template <class Epi, class Sched, class AOff, bool ALIGN_EPI, bool FP8 = false>
__device__ __forceinline__ void gemm_phase(PG8_LAS unsigned char* lds, const bf16_t* Ag, const bf16_t* Btg, const int K, const Sched& S, const AOff& AO, const Epi& E) {
    const int tid = opaque_tid(), wid = __builtin_amdgcn_readfirstlane(tid >> 6), lane = tid & 63, wr = wid >> 2, wc = wid & 3, fr = lane & 15, fq = lane >> 4;
    int nt = K / BK; asm volatile("" : "+s"(nt));
    unsigned voffB[2];
#pragma unroll
    for (int i = 0; i < 2; ++i) { int R, C; stage_rc(tid * 16 + i * 8192, R, C); const int Rb = Epi::PERM ? ((R & ~31) + perm32(R & 31)) : R; voffB[i] = (unsigned)(Rb * K + C) * 2u; }
#define PG8_APRE(u, pv_) do { int _t = tid; asm volatile("" : "+v"(_t)); int _R0, _R1, _C; stage_rc(_t * 16, _R0, _C); stage_rc(_t * 16 + 8192, _R1, _C); pv_ = AO.pre(u, _R0, _R1); } while (0)
#define PG8_AFIN(u, pv_, d0, d1) do { int _t = tid; asm volatile("" : "+v"(_t)); _Pragma("unroll") for (int _i = 0; _i < 2; ++_i) { int _R, _C; stage_rc(_t * 16 + _i * 8192, _R, _C); d0[_i] = AO.fin(pv_, u, 0, _i, _R, _C); d1[_i] = AO.fin(pv_, u, 1, _i, _R, _C); } } while (0)
#define PG8_LANE(fr_, fq_) int fr_, fq_; { int _t = tid; asm volatile("" : "+v"(_t)); fr_ = _t & 15; fq_ = (_t & 63) >> 4; }
    const unsigned kstep = (unsigned)(BK * 2), hstep = (unsigned)HALF * (unsigned)K * 2u, tstep = 2u * hstep;
    const unsigned ldsw = (unsigned)wid * 1024u;
    const int aoff = lds_byte(wr * 64 + fr, fq * 8), boff = lds_byte(wc * 32 + fr, fq * 8);
    const char* const Ab = (const char*)Ag; const char* const Bb = (const char*)Btg;
#define PG8_SA(b, h) (((b) * 2 + (h)) * HTB)
#define PG8_SB(b, h) ((4 + (b) * 2 + (h)) * HTB)
#define PG8_STAGE(bufoff, gbase, uoff, voff) do { _Pragma("unroll") for (int _i = 0; _i < 2; ++_i) \
        __builtin_amdgcn_global_load_lds((const unsigned*)((gbase) + (size_t)(unsigned)((uoff) + (voff)[_i])), (PG8_LAS unsigned*)(lds + (bufoff) + ldsw + _i * 8192), 16, 0, 0); } while (0)
#define PG8_LD32(base) __builtin_shufflevector(*(const PG8_LAS v4i*)(base), *(const PG8_LAS v4i*)((base) + 1024), 0, 1, 2, 3, 4, 5, 6, 7)
#define PG8_LDA(dst, b, h) do { _Pragma("unroll") for (int m = 0; m < 4; ++m) dst[m] = PG8_LD32(lds + PG8_SA(b, h) + aoff + m * 2048); } while (0)
#define PG8_LDB(dst, b, h) do { _Pragma("unroll") for (int n = 0; n < 2; ++n) dst[n] = PG8_LD32(lds + PG8_SB(b, h) + boff + n * 2048); } while (0)
#define PG8_LO(x) __builtin_bit_cast(bf16x8, __builtin_shufflevector((x), (x), 0, 1, 2, 3))
#define PG8_HI(x) __builtin_bit_cast(bf16x8, __builtin_shufflevector((x), (x), 4, 5, 6, 7))
#define PG8_MMA(ai, bj, At, Bt) do { __builtin_amdgcn_s_setprio(1); _Pragma("unroll") for (int m = 0; m < 4; ++m) _Pragma("unroll") for (int n = 0; n < 2; ++n) { \
        if constexpr (FP8) acc[ai][bj][m][n] = __builtin_amdgcn_mfma_scale_f32_16x16x128_f8f6f4(Bt[n], At[m], acc[ai][bj][m][n], 0, 0, 0, 0, 0, 0);   \
        else { acc[ai][bj][m][n] = __builtin_amdgcn_mfma_f32_16x16x32_bf16(PG8_LO(Bt[n]), PG8_LO(At[m]), acc[ai][bj][m][n], 0, 0, 0); \
               acc[ai][bj][m][n] = __builtin_amdgcn_mfma_f32_16x16x32_bf16(PG8_HI(Bt[n]), PG8_HI(At[m]), acc[ai][bj][m][n], 0, 0, 0); } } \
        __builtin_amdgcn_s_setprio(0); } while (0)
#define PG8_WAIT_V(n) asm volatile("s_waitcnt vmcnt(" #n ")" ::: "memory")
#define PG8_WAIT_L(n) asm volatile("s_waitcnt lgkmcnt(" #n ")" ::: "memory")
#define PG8_BAR __builtin_amdgcn_s_barrier()
#define PG8_SCHED __builtin_amdgcn_sched_barrier(0)
    Unit cur, nxt; int ui = 0;
    if (!S.next(0, cur)) return;
    f32x4 acc[2][2][4][2];
#pragma unroll
    for (int a = 0; a < 2; ++a)
#pragma unroll
        for (int b = 0; b < 2; ++b)
#pragma unroll
            for (int m = 0; m < 4; ++m)
#pragma unroll
                for (int n = 0; n < 2; ++n) acc[a][b][m][n] = (f32x4){0.f, 0.f, 0.f, 0.f};
    v8i At[4], B0[2], B1[2];
    unsigned vo0[2], vo1[2];
    PG8_LAS u32x4* const svn = (PG8_LAS u32x4*)(lds + XS_OFF) + tid;
    PG8_LAS u32x4* const smeta = (PG8_LAS u32x4*)(lds + XM_OFF + tid * 32);
    constexpr bool HAS_META = sizeof(typename Epi::Meta) > 1;
    bool has_next = S.next(1, nxt);
    { typename AOff::Pre pc; PG8_APRE(cur, pc); PG8_AFIN(cur, pc, vo0, vo1);
      unsigned vn0[2], vn1[2];
      if (has_next) { typename AOff::Pre pn; PG8_APRE(nxt, pn); PG8_AFIN(nxt, pn, vn0, vn1); } else { vn0[0] = vo0[0]; vn0[1] = vo0[1]; vn1[0] = vo1[0]; vn1[1] = vo1[1]; }
      *svn = (u32x4){vn0[0], vn0[1], vn1[0], vn1[1]}; }
    if constexpr (HAS_META) { PG8_LANE(fr_, fq_); (void)fq_; const typename Epi::Meta m0 = E.meta_load(cur, wr, fr_); smeta[0] = m0.lo; smeta[1] = m0.hi; }
    unsigned cB = (unsigned)cur.pn * tstep;
    PG8_STAGE(PG8_SB(0, 0), Bb, cB, voffB); PG8_STAGE(PG8_SB(0, 1), Bb, cB + hstep, voffB); PG8_STAGE(PG8_SA(0, 0), Ab, 0u, vo0); PG8_STAGE(PG8_SA(0, 1), Ab, 0u, vo1);
    if (wr == 1) PG8_BAR;
    PG8_WAIT_V(2); PG8_BAR;
    PG8_STAGE(PG8_SB(1, 0), Bb, cB + kstep, voffB); PG8_STAGE(PG8_SA(1, 0), Ab, kstep, vo0); PG8_STAGE(PG8_SB(1, 1), Bb, cB + hstep + kstep, voffB);
    PG8_WAIT_V(6); PG8_BAR;
    for (;;) {
        const unsigned nB = has_next ? (unsigned)nxt.pn * tstep : cB;
#pragma clang loop unroll(disable)
        for (int t = 0; t < nt; t += 2) {
            const bool last = (t == nt - 2);
            if constexpr (Epi::MIDSCALE) { if (t == nt / 2) { PG8_LANE(fr_, fq_); E.midscale(acc, cur, wr, wc, fr_, fq_); } }
            const unsigned k1 = (unsigned)(t + 1) * kstep, k2 = last ? 0u : (unsigned)(t + 2) * kstep, k3 = k2 + kstep;
            const unsigned b2 = last ? nB : cB + (unsigned)(t + 2) * kstep, b3 = b2 + kstep;
            PG8_LDB(B0, 0, 0); PG8_LDB(B1, 0, 1); PG8_SCHED; PG8_LDA(At, 0, 0); PG8_STAGE(PG8_SA(1, 1), Ab, k1, vo1);
            PG8_WAIT_V(8); PG8_WAIT_L(0); PG8_BAR; PG8_MMA(0, 0, At, B0); PG8_MMA(0, 1, At, B1); PG8_BAR; PG8_SCHED;
            if (last) { PG8_LAS u32x4* sp_ = svn; asm volatile("" : "+v"(sp_));
                const u32x4 v = *sp_; vo0[0] = v.x; vo0[1] = v.y; vo1[0] = v.z; vo1[1] = v.w; }
            PG8_LDA(At, 0, 1); PG8_STAGE(PG8_SB(0, 0), Bb, b2, voffB); PG8_STAGE(PG8_SB(0, 1), Bb, b2 + hstep, voffB); PG8_STAGE(PG8_SA(0, 0), Ab, k2, vo0);
            PG8_WAIT_V(8); PG8_WAIT_L(0); PG8_BAR; PG8_MMA(1, 0, At, B0); PG8_MMA(1, 1, At, B1); PG8_BAR; PG8_SCHED;
            PG8_LDB(B0, 1, 0); PG8_LDB(B1, 1, 1); PG8_SCHED; PG8_LDA(At, 1, 0); PG8_STAGE(PG8_SA(0, 1), Ab, k2, vo1);
            PG8_WAIT_V(8); PG8_WAIT_L(0); PG8_BAR; PG8_MMA(0, 0, At, B0); PG8_MMA(0, 1, At, B1); PG8_BAR; PG8_SCHED;
            PG8_LDA(At, 1, 1); PG8_STAGE(PG8_SB(1, 0), Bb, b3, voffB); PG8_STAGE(PG8_SB(1, 1), Bb, b3 + hstep, voffB); PG8_STAGE(PG8_SA(1, 0), Ab, k3, vo0);
            PG8_WAIT_V(8); PG8_WAIT_L(0); PG8_BAR; PG8_MMA(1, 0, At, B0); PG8_MMA(1, 1, At, B1); PG8_BAR; PG8_SCHED;
        }
        if constexpr (ALIGN_EPI) { if (wr == 0) PG8_BAR; }
        Unit nn; const bool has2 = has_next && S.next(ui + 2, nn);
        typename Epi::Meta mnext;
        { PG8_LANE(fr_, fq_);
          typename Epi::Meta meta; if constexpr (HAS_META) { PG8_LAS u32x4* sp_ = smeta; asm volatile("" : "+v"(sp_)); meta.lo = sp_[0]; meta.hi = sp_[1]; }
          if (has_next) mnext = E.meta_load(nxt, wr, fr_);
          if (has2) { typename AOff::Pre pnn; PG8_APRE(nn, pnn); unsigned vn0[2], vn1[2]; PG8_AFIN(nn, pnn, vn0, vn1); *svn = (u32x4){vn0[0], vn0[1], vn1[0], vn1[1]}; }
          E(acc, cur, wr, wc, fr_, fq_, meta); }
        if (!has_next) break;
        if constexpr (HAS_META) { smeta[0] = mnext.lo; smeta[1] = mnext.hi; }
#pragma unroll
        for (int a = 0; a < 2; ++a)
#pragma unroll
            for (int b = 0; b < 2; ++b)
#pragma unroll
                for (int m = 0; m < 4; ++m)
#pragma unroll
                    for (int n = 0; n < 2; ++n) acc[a][b][m][n] = (f32x4){0.f, 0.f, 0.f, 0.f};
        cur = nxt; nxt = nn; has_next = has2; cB = nB; ++ui;
        if constexpr (ALIGN_EPI) { if (wr == 1) PG8_BAR; }
    }
    PG8_WAIT_V(0);
    if constexpr (!ALIGN_EPI) { if (wr == 0) PG8_BAR; }
    PG8_BAR;
#undef PG8_APRE
#undef PG8_AFIN
#undef PG8_LANE
#undef PG8_SA
#undef PG8_SB
#undef PG8_STAGE
#undef PG8_LDA
#undef PG8_LDB
#undef PG8_MMA
#undef PG8_LO
#undef PG8_HI
#undef PG8_LD32
#undef PG8_WAIT_V
#undef PG8_WAIT_L
#undef PG8_BAR
#undef PG8_SCHED
}
}


#define XB_TMO      128
#define XB_XCNT(j)  (256  + 64 * (j))
#define XB_XSUB(j)  (1280 + 64 * (j))
#define XB_XGEN(j)  (2304 + 64 * (j))
#define XB_TOP      3328
#define XB_TOPGEN   3392
#define XCD_BAR_WORDS 3456
#define XB_SPIN_CAP (1u << 18)
__device__ __forceinline__ unsigned xb_ld(unsigned* p)              { return __hip_atomic_load(p, __ATOMIC_RELAXED, __HIP_MEMORY_SCOPE_AGENT); }
__device__ __forceinline__ unsigned xb_add(unsigned* p, unsigned v) { return __hip_atomic_fetch_add(p, v, __ATOMIC_RELAXED, __HIP_MEMORY_SCOPE_AGENT); }
__device__ __forceinline__ unsigned xb_xcc_id() { return (unsigned)__builtin_amdgcn_s_getreg((3 << 11) | 20) & 0xFu; }
#define XB_SPIN(cond, bar) do { unsigned _sp = 0; while (cond) { __builtin_amdgcn_s_sleep(1); \
    if ((++_sp & 255u) == 0u) { if (xb_ld(&(bar)[XB_TMO])) break; if (_sp > XB_SPIN_CAP) { atomicAdd(&(bar)[XB_TMO], 1u); break; } } } } while (0)
struct XcdBarrier { unsigned* bar; unsigned x; volatile PG8_LAS unsigned* st; };
__device__ __forceinline__ XcdBarrier xcd_barrier_post(unsigned* bar, volatile PG8_LAS unsigned* st) {
    XcdBarrier b; b.bar = bar; b.x = xb_xcc_id(); b.st = st;
    if (threadIdx.x == 0) (void)xb_add(&bar[XB_XCNT(b.x)], 1u);
    return b;
}
__device__ __forceinline__ void xcd_barrier_complete(unsigned* bar, unsigned x, unsigned& nloc, unsigned& nx) {
    const unsigned G = gridDim.x * gridDim.y * gridDim.z;
    unsigned sum, cnt, mine, sp = 0u;
    for (;;) {
        sum = 0u; cnt = 0u; mine = 0u;
#pragma unroll
        for (unsigned j = 0; j < 16; ++j) { const unsigned c = xb_ld(&bar[XB_XCNT(j)]); sum += c; cnt += (c > 0u) ? 1u : 0u; mine = (j == x) ? c : mine; }
        if (sum == G) break;
        __builtin_amdgcn_s_sleep(1);
        if ((++sp & 255u) == 0u) { if (xb_ld(&bar[XB_TMO])) break; if (sp > XB_SPIN_CAP) { atomicAdd(&bar[XB_TMO], 1u); break; } }
    }
    nloc = mine > 0u ? mine : 1u; nx = cnt > 0u ? cnt : 1u;
}
__device__ __forceinline__ void xcd_barrier(const XcdBarrier& b) {
    asm volatile("s_waitcnt vmcnt(0)" ::: "memory");
    __syncthreads();
    if (threadIdx.x == 0) {
        unsigned* bar = b.bar;
        __builtin_amdgcn_s_waitcnt(0);
        unsigned nloc = b.st[0], nx = b.st[1];
        if (nloc == 0u) { xcd_barrier_complete(bar, b.x, nloc, nx); b.st[0] = nloc; b.st[1] = nx; }
        const unsigned old = xb_add(&bar[XB_XSUB(b.x)], 1u);
        const unsigned gen = old / nloc;
        if (old + 1u == (gen + 1u) * nloc) {
            __builtin_amdgcn_fence(__ATOMIC_RELEASE, "agent");
            asm volatile("s_waitcnt vmcnt(0)" ::: "memory");
            const unsigned og = xb_add(&bar[XB_TOP], 1u);
            const unsigned tg = og / nx;
            if (og + 1u == (tg + 1u) * nx) xb_add(&bar[XB_TOPGEN], 1u);
            else XB_SPIN(xb_ld(&bar[XB_TOPGEN]) == tg, bar);
            __builtin_amdgcn_fence(__ATOMIC_ACQUIRE, "agent");
            xb_add(&bar[XB_XGEN(b.x)], 1u);
            asm volatile("s_waitcnt vmcnt(0)" ::: "memory");
        } else {
            XB_SPIN(xb_ld(&bar[XB_XGEN(b.x)]) == gen, bar);
            __builtin_amdgcn_fence(__ATOMIC_ACQUIRE, "agent");
            asm volatile("s_waitcnt vmcnt(0)" ::: "memory");
        }
    }
    __syncthreads();
}

struct TJob { const float* src; int ld; unsigned char* dst; int lddst; float sc; const float* sk; int fp8; };
__device__ __forceinline__ bool tjob_decode(const Params& p, int q, TJob& j) {
    constexpr int N_IN = 16 * 80, N_OUT = 16 * 32, N_G = 32 * 128;
    if (q < N_IN) { const int tr = q / 80, tc = q % 80; j.src = p.w_in + (size_t)tr * 128 * DIN + tc * 64; j.ld = DIN; j.dst = p.ws + OFF_WIN + ((size_t)tc * 64 * D_ + tr * 128) * 2; j.lddst = D_ * 2; j.sc = 1.f; j.sk = nullptr; j.fp8 = 0; return true; } q -= N_IN;
    if (q < N_OUT) { const int tr = q / 32, tc = q % 32; j.src = p.w_out + (size_t)tr * 128 * D_ + tc * 64; j.ld = D_; j.dst = p.ws + OFF_WOUT + ((size_t)tc * 64 * D_ + tr * 128) * 2; j.lddst = D_ * 2; j.sc = 1.f;
        j.sk = (tr < 8 ? p.g_a + tr * 128 : p.g_b + (tr - 8) * 128); j.fp8 = 0; return true; } q -= N_OUT;
    if (q < 2 * N_G) { const int up = q >= N_G; if (up) q -= N_G; const int e = q >> 7, rem = q & 127, tr = rem >> 3, tc = rem & 7, c0 = tc * 64;
        j.src = (up ? p.ewu : p.ewg) + (size_t)e * D_ * DE + (size_t)tr * 128 * DE + c0; j.ld = DE;
        j.dst = p.ws + OFF_WGU + (size_t)e * 1024 * D_ + (size_t)((c0 >> 7) * 256 + (up ? 128 : 0) + (c0 & 127)) * D_ + tr * 128; j.lddst = D_; j.sc = WGU_SCALE; j.sk = p.g_ffn + tr * 128; j.fp8 = 1; return true; } q -= 2 * N_G;
    if (q < N_G) { const int e = q >> 7, rem = q & 127, tr = rem >> 5, tc = rem & 31;
        j.src = p.ewd + (size_t)e * DE * D_ + (size_t)tr * 128 * D_ + tc * 64; j.ld = D_; j.dst = p.ws + OFF_WD + (size_t)e * D_ * DE + (size_t)tc * 64 * DE + tr * 128; j.lddst = DE; j.sc = WD_SCALE; j.sk = nullptr; j.fp8 = 1; return true; }
    return false;
}
constexpr int N_TJOBS_DENSE = 16 * 80 + 16 * 32, N_TJOBS_GU = N_TJOBS_DENSE + 2 * 32 * 128, N_TJOBS = N_TJOBS_GU + 32 * 128;
struct TRegs { f32x4 v[4]; };
__device__ __forceinline__ void tjob_load(const TJob& j, int tid, TRegs& r) {
    const float* sp = j.src + (size_t)(tid >> 2) * j.ld + (tid & 3) * 16;
#pragma unroll
    for (int q = 0; q < 4; ++q) r.v[q] = *(const f32x4*)(sp + 4 * q);
}
__device__ __forceinline__ void tjob_finish(const TJob& j, int tid, const TRegs& r, float* lt) {
    { const int rr = tid >> 2, cc = (tid & 3) * 16; const float f = j.sk ? j.sc * j.sk[rr] : j.sc;
#pragma unroll
      for (int q = 0; q < 4; ++q)
#pragma unroll
          for (int e = 0; e < 4; ++e) lt[rr * 65 + cc + 4 * q + e] = r.v[q][e] * f; }
    __syncthreads();
    { const int c = tid >> 3, rr = (tid & 7) * 16; float v[16];
#pragma unroll
      for (int q = 0; q < 16; ++q) v[q] = lt[(rr + q) * 65 + c];
      unsigned char* d = j.dst + (size_t)c * j.lddst;
      if (j.fp8) { u32x4 w; w.x = pk4_fp8(v[0], v[1], v[2], v[3]); w.y = pk4_fp8(v[4], v[5], v[6], v[7]); w.z = pk4_fp8(v[8], v[9], v[10], v[11]); w.w = pk4_fp8(v[12], v[13], v[14], v[15]);
          *(u32x4*)(d + rr) = w; }
      else { u32x4 w0, w1; w0.x = cvt_pk_bf16(v[0], v[1]); w0.y = cvt_pk_bf16(v[2], v[3]); w0.z = cvt_pk_bf16(v[4], v[5]); w0.w = cvt_pk_bf16(v[6], v[7]);
          w1.x = cvt_pk_bf16(v[8], v[9]); w1.y = cvt_pk_bf16(v[10], v[11]); w1.z = cvt_pk_bf16(v[12], v[13]); w1.w = cvt_pk_bf16(v[14], v[15]);
          *(u32x4*)(d + rr * 2) = w0; *(u32x4*)(d + rr * 2 + 16) = w1; } }
}
__device__ __forceinline__ void run_tjobs(const Params& p, unsigned char* lds, int qlo, int qhi, int k0 = 0, int k1 = 1 << 20, int first = -1, int stride = 0) {
    const int tid = opaque_tid(), nb = stride > 0 ? stride : (int)gridDim.x;
    float* lt0 = (float*)lds; float* lt1 = lt0 + 128 * 65;
    TJob j0, j1, j2; TRegs r0, r1, r2;
    int k = k0; const int qb = qlo + (first >= 0 ? first : (int)blockIdx.x);
#define TJ_OK(kk, jj) ((kk) < k1 && qb + (kk) * nb < qhi && tjob_decode(p, qb + (kk) * nb, jj))
    bool h0 = TJ_OK(k, j0), h1 = TJ_OK(k + 1, j1), h2 = TJ_OK(k + 2, j2);
    if (h0) tjob_load(j0, tid, r0); if (h1) tjob_load(j1, tid, r1); if (h2) tjob_load(j2, tid, r2);
    while (h0) {
        tjob_finish(j0, tid, r0, lt0); k += 3; h0 = TJ_OK(k, j0); if (h0) tjob_load(j0, tid, r0);
        if (!h1) break;
        tjob_finish(j1, tid, r1, lt1); h1 = TJ_OK(k + 1, j1); if (h1) tjob_load(j1, tid, r1);
        if (!h2) break;
        tjob_finish(j2, tid, r2, lt0); h2 = TJ_OK(k + 2, j2); if (h2) tjob_load(j2, tid, r2);
        if (!h0) break;
        tjob_finish(j0, tid, r0, lt1); k += 3; h0 = TJ_OK(k, j0); if (h0) tjob_load(j0, tid, r0);
        if (!h1) break;
        tjob_finish(j1, tid, r1, lt0); h1 = TJ_OK(k + 1, j1); if (h1) tjob_load(j1, tid, r1);
        if (!h2) break;
        tjob_finish(j2, tid, r2, lt1); h2 = TJ_OK(k + 2, j2); if (h2) tjob_load(j2, tid, r2);
    }
#undef TJ_OK
    __syncthreads();
}
__device__ __forceinline__ void phase0(const Params& p, unsigned char* lds) {
    const int tid = opaque_tid(), nb = gridDim.x, bid = blockIdx.x, wid = tid >> 6, lane = tid & 63;
    { float* z = (float*)(p.ws + OFF_SSQ);
      for (int i = bid * NTHR + tid; i < 3 * T_ + 64; i += nb * NTHR) z[i] = 0.f;
      if (DUP_PHASE >= 2 && DUP_PHASE <= 4) { float* zd = (float*)(p.ws + OFF_SSQ + (OFF_DUMMY - OFF_SSQ)); for (int i = bid * NTHR + tid; i < 3 * T_ + 64; i += nb * NTHR) zd[i] = 0.f; } }
    { bf16_t* wrt = (bf16_t*)(p.ws + OFF_WR);
      for (int i = bid * NTHR + tid; i < 48 * D_; i += nb * NTHR) {
          const int o = i >> 11, k = i & 2047; float v = 0.f;
          if (o < 4) v = p.rgw[k * 4 + o]; else if (o < 36) v = p.rew[k * 32 + (o - 4)];
          wrt[i] = (bf16_t)(cvt_pk_bf16(v * p.g_ffn[k], 0.f) & 0xffffu); } }
    { bf16_t* xn = (bf16_t*)(p.ws + OFF_B);
      for (int row = bid * 8 + wid; row < T_; row += nb * 8) {
          const float* xr = p.x + (size_t)row * D_;
          f32x4 v[8]; float s = 0.f;
#pragma unroll
          for (int i = 0; i < 8; ++i) { v[i] = *(const f32x4*)(xr + i * 256 + lane * 4); s += (v[i][0] * v[i][0] + v[i][1] * v[i][1]) + (v[i][2] * v[i][2] + v[i][3] * v[i][3]); }
          const float rstd = rsqrtf(wave_sum(s) * (1.f / D_) + EPS);
#pragma unroll
          for (int i = 0; i < 8; ++i) { const f32x4 g = *(const f32x4*)(p.norm_mix_g + i * 256 + lane * 4); const f32x4 o = v[i] * rstd * g;
              u32x2 w; w.x = cvt_pk_bf16(o[0], o[1]); w.y = cvt_pk_bf16(o[2], o[3]); *(u32x2*)(xn + (size_t)row * D_ + i * 256 + lane * 4) = w; } } }
    run_tjobs(p, lds, 0, N_TJOBS_DENSE);
}

__device__ __forceinline__ int side_rounds(int nb) { return (N_TJOBS_GU - N_TJOBS_DENSE + nb - 1) / nb; }
__device__ __forceinline__ void phase1(const Params& p, unsigned char* lds) {
    const Epi1 E{p.ws};
    pg8::StaticOrder S; S.init(T_, DIN, gridDim.x, blockIdx.x); const pg8::AOffDirect AO{D_};
    const int nu = S.count(), col = blockIdx.x & 3, split = col == 0 ? 0 : col == 1 ? (2 * nu) / 5 : col == 2 ? (3 * nu) / 5 : nu;
    const int kr = side_rounds(gridDim.x), k1 = (2 * kr) / 3;
    S.i0 = 0; S.i1 = split;
    pg8::gemm_phase<Epi1, pg8::StaticOrder, pg8::AOffDirect, true>((PG8_LAS unsigned char*)lds, (const bf16_t*)(p.ws + OFF_B), (const bf16_t*)(p.ws + OFF_WIN), D_, S, AO, E);
    run_tjobs(p, lds, N_TJOBS_DENSE, N_TJOBS_GU, 0, k1);
    S.i0 = split; S.i1 = nu;
    pg8::gemm_phase<Epi1, pg8::StaticOrder, pg8::AOffDirect, true>((PG8_LAS unsigned char*)lds, (const bf16_t*)(p.ws + OFF_B), (const bf16_t*)(p.ws + OFF_WIN), D_, S, AO, E);
}

__device__ __forceinline__ void mixer_gmlp_item(const Params& p, unsigned char* lds, int item, size_t so) {
    const int tid = opaque_tid(), wid = tid >> 6, lane = tid & 63, fr = lane & 15, fq = lane >> 4;
    const int h = item & 7, t0 = (item >> 3) * 128;
    const bf16_t* P = (const bf16_t*)(p.ws + OFF_A); bf16_t* Y = (bf16_t*)(p.ws + OFF_B); float* ssq_a = (float*)(p.ws + OFF_SSQ + so);
    bf16_t* Vt = (bf16_t*)lds;
    bf16_t* Wl = Vt + 128 * 136;
    float* rs = (float*)(Wl + 128 * 136);
    { const int j = tid >> 2, dc = (tid & 3) * 32;
      const u32x4* src = (const u32x4*)(P + (size_t)(t0 + j) * DIN + 1024 + h * 128 + dc);
      u32x4 v[4]; float s = 0.f;
#pragma unroll
      for (int q = 0; q < 4; ++q) { v[q] = src[q];
#pragma unroll
          for (int w = 0; w < 4; ++w) { const float lo = bflo(v[q][w]), hi = bfhi(v[q][w]); s += lo * lo + hi * hi; } }
      s += __shfl_xor(s, 1); s += __shfl_xor(s, 2);
      if ((tid & 3) == 0) rs[j] = rsqrtf(s * (1.f / 128.f) + EPS);
#pragma unroll
      for (int q = 0; q < 4; ++q)
#pragma unroll
          for (int w = 0; w < 4; ++w) { const int d = dc + q * 8 + w * 2; Vt[d * 136 + j] = (bf16_t)(v[q][w] & 0xffffu); Vt[(d + 1) * 136 + j] = (bf16_t)(v[q][w] >> 16); } }
    __syncthreads();
    { const int i = tid >> 2, jc = (tid & 3) * 32;
      const f32x4* src = (const f32x4*)(p.gmlp_ws + (size_t)h * 16384 + i * 128 + jc);
      const bool live = (i >> 6) >= (jc >> 6);
#pragma unroll
      for (int q = 0; q < 4; ++q) { f32x4 w0 = src[2 * q], w1 = src[2 * q + 1];
          const f32x4 r0 = *(const f32x4*)(rs + jc + 8 * q), r1 = *(const f32x4*)(rs + jc + 8 * q + 4);
          w0 = live ? w0 * r0 : (f32x4){0.f, 0.f, 0.f, 0.f}; w1 = live ? w1 * r1 : (f32x4){0.f, 0.f, 0.f, 0.f};
          u32x4 o; o.x = cvt_pk_bf16(w0[0], w0[1]); o.y = cvt_pk_bf16(w0[2], w0[3]); o.z = cvt_pk_bf16(w1[0], w1[1]); o.w = cvt_pk_bf16(w1[2], w1[3]);
          *(u32x4*)(Wl + i * 136 + jc + 8 * q) = o; } }
    __syncthreads();
    f32x4 acc[8];
#pragma unroll
    for (int n = 0; n < 8; ++n) acc[n] = (f32x4){0.f, 0.f, 0.f, 0.f};
    const int ksteps = (wid < 4) ? 2 : 4;
    for (int ks = 0; ks < ksteps; ++ks) {
        const bf16x8 bw = *(const bf16x8*)(Wl + (16 * wid + fr) * 136 + ks * 32 + fq * 8);
#pragma unroll
        for (int n = 0; n < 8; ++n) { const bf16x8 av = *(const bf16x8*)(Vt + (16 * n + fr) * 136 + ks * 32 + fq * 8);
            acc[n] = __builtin_amdgcn_mfma_f32_16x16x32_bf16(av, bw, acc[n], 0, 0, 0); }
    }
    { const int i = 16 * wid + fr, t = t0 + i; const float bias = p.gmlp_bs[h * 128 + i]; float ss = 0.f;
#pragma unroll
      for (int n = 0; n < 8; ++n) { const int c = h * 128 + 16 * n + 4 * fq;
          const f32x4 g = *(const f32x4*)(p.v_norm_g + c); const u32x2 uu = *(const u32x2*)(P + (size_t)t * DIN + c);
          const float y0 = bflo(uu.x) * (acc[n][0] * g[0] + bias), y1 = bfhi(uu.x) * (acc[n][1] * g[1] + bias), y2 = bflo(uu.y) * (acc[n][2] * g[2] + bias), y3 = bfhi(uu.y) * (acc[n][3] * g[3] + bias);
          ss += (y0 * y0 + y1 * y1) + (y2 * y2 + y3 * y3);
          u32x2 w; w.x = cvt_pk_bf16(y0, y1); w.y = cvt_pk_bf16(y2, y3); *(u32x2*)(Y + (size_t)t * D_ + c) = w; }
      ss += __shfl_xor(ss, 16); ss += __shfl_xor(ss, 32);
      if (fq == 0) atomicAdd(ssq_a + t, ss); }
    __syncthreads();
}
__device__ __forceinline__ void mixer_conv_item(const Params& p, int item, size_t so) {
    const int tid = opaque_tid(), cl = tid & 31, ts = tid >> 5;
    const int c = (item & 3) * 256 + cl * 8, tbeg = (item >> 2) * 128 + ts * 8;
    const bf16_t* P = (const bf16_t*)(p.ws + OFF_A); bf16_t* Y = (bf16_t*)(p.ws + OFF_B); float* ssq_b = (float*)(p.ws + OFF_SSQ + so) + T_;
    float w0[8], w1[8], w2[8], z1[8], z2[8];
    { const f32x4 a0 = *(const f32x4*)(p.conv_w + c), a1 = *(const f32x4*)(p.conv_w + c + 4), b0 = *(const f32x4*)(p.conv_w + 1024 + c), b1 = *(const f32x4*)(p.conv_w + 1024 + c + 4),
                  c0 = *(const f32x4*)(p.conv_w + 2048 + c), c1 = *(const f32x4*)(p.conv_w + 2048 + c + 4);
#pragma unroll
      for (int q = 0; q < 4; ++q) { w0[q] = a0[q]; w0[4 + q] = a1[q]; w1[q] = b0[q]; w1[4 + q] = b1[q]; w2[q] = c0[q]; w2[4 + q] = c1[q]; } }
#pragma unroll
    for (int q = 0; q < 8; ++q) { z1[q] = 0.f; z2[q] = 0.f; }
    if ((tbeg % SEQ) != 0) {
        const u32x4 ca = *(const u32x4*)(P + (size_t)(tbeg - 1) * DIN + 3072 + c), ha = *(const u32x4*)(P + (size_t)(tbeg - 1) * DIN + 4096 + c);
        const u32x4 cb = *(const u32x4*)(P + (size_t)(tbeg - 2) * DIN + 3072 + c), hb2 = *(const u32x4*)(P + (size_t)(tbeg - 2) * DIN + 4096 + c);
#pragma unroll
        for (int q = 0; q < 4; ++q) { z1[2 * q] = bflo(ca[q]) * bflo(ha[q]); z1[2 * q + 1] = bfhi(ca[q]) * bfhi(ha[q]); z2[2 * q] = bflo(cb[q]) * bflo(hb2[q]); z2[2 * q + 1] = bfhi(cb[q]) * bfhi(hb2[q]); }
    }
    u32x4 bgA[8], cgA[8], hvA[8];
#pragma unroll
    for (int tt = 0; tt < 8; ++tt) { const bf16_t* pr = P + (size_t)(tbeg + tt) * DIN + c; bgA[tt] = *(const u32x4*)(pr + 2048); cgA[tt] = *(const u32x4*)(pr + 3072); hvA[tt] = *(const u32x4*)(pr + 4096); }
#pragma unroll
    for (int tt = 0; tt < 8; ++tt) {
        const int t = tbeg + tt;
        const u32x4 bg = bgA[tt], cgv = cgA[tt], hv = hvA[tt];
        float z[8], y[8], ss = 0.f;
#pragma unroll
        for (int q = 0; q < 4; ++q) { z[2 * q] = bflo(cgv[q]) * bflo(hv[q]); z[2 * q + 1] = bfhi(cgv[q]) * bfhi(hv[q]); }
#pragma unroll
        for (int q = 0; q < 4; ++q) {
            y[2 * q] = bflo(bg[q]) * (w0[2 * q] * z2[2 * q] + w1[2 * q] * z1[2 * q] + w2[2 * q] * z[2 * q]);
            y[2 * q + 1] = bfhi(bg[q]) * (w0[2 * q + 1] * z2[2 * q + 1] + w1[2 * q + 1] * z1[2 * q + 1] + w2[2 * q + 1] * z[2 * q + 1]); }
#pragma unroll
        for (int q = 0; q < 8; ++q) { ss += y[q] * y[q]; z2[q] = z1[q]; z1[q] = z[q]; }
        u32x4 w; w.x = cvt_pk_bf16(y[0], y[1]); w.y = cvt_pk_bf16(y[2], y[3]); w.z = cvt_pk_bf16(y[4], y[5]); w.w = cvt_pk_bf16(y[6], y[7]);
        *(u32x4*)(Y + (size_t)t * D_ + 1024 + c) = w;
        ss += __shfl_xor(ss, 1); ss += __shfl_xor(ss, 2); ss += __shfl_xor(ss, 4); ss += __shfl_xor(ss, 8); ss += __shfl_xor(ss, 16);
        if (cl == 0) atomicAdd(ssq_b + t, ss);
    }
}
__device__ __forceinline__ void phase2(const Params& p, unsigned char* lds, size_t so = 0) {
    for (int it = blockIdx.x; it < 512 + 1024; it += gridDim.x) { if (it < 512) mixer_conv_item(p, it, so); else mixer_gmlp_item(p, lds, it - 512, so); }
}

__device__ __forceinline__ void phase3(const Params& p, unsigned char* lds, size_t so = 0) {
    pg8::StaticOrder S; S.init(T_, D_, gridDim.x, blockIdx.x); const pg8::AOffDirect AO{D_};
    PG8_LAS float* rsl = (PG8_LAS float*)((PG8_LAS unsigned char*)lds + RS_OFF);
    { const float* ssq = (const float*)(p.ws + OFF_SSQ); const int tid = opaque_tid();
      for (int i = 0; i < RS_UNITS; ++i) { Unit u; if (!S.next(i, u)) break;
          if (tid < 256) { const int row = u.pm * 256 + tid; const float va = ssq[row] * (1.f / 1024.f) + EPS, vb = ssq[T_ + row] * (1.f / 1024.f) + EPS;
              rsl[(i * 256 + tid) * 2] = __builtin_amdgcn_sqrtf(vb * __builtin_amdgcn_rcpf(va)); rsl[(i * 256 + tid) * 2 + 1] = __builtin_amdgcn_rsqf(vb); } }
      __syncthreads(); }
    const Epi2 E{p.x, p.ws, so, rsl};
    const int kr = side_rounds(gridDim.x), k0 = (2 * kr) / 3; const bool side = (so == 0);
    if (side && !(blockIdx.x & 1)) run_tjobs(p, lds, N_TJOBS_DENSE, N_TJOBS_GU, k0, kr);
    pg8::gemm_phase<Epi2, pg8::StaticOrder, pg8::AOffDirect, true>((PG8_LAS unsigned char*)lds, (const bf16_t*)(p.ws + OFF_B), (const bf16_t*)(p.ws + OFF_WOUT), D_, S, AO, E);
    if (side && (blockIdx.x & 1)) run_tjobs(p, lds, N_TJOBS_DENSE, N_TJOBS_GU, k0, kr);
}

__device__ __forceinline__ void route_item(const Params& p, unsigned char* lds, int item, size_t so) {
    const int tid = opaque_tid(), wid = tid >> 6, lane = tid & 63, fr = lane & 15, fq = lane >> 4;
    float* lg = (float*)lds;
    float* ls = lg + 8 * 64 * 48;
    int* lcnt = (int*)(ls + 64 * 48); int* lbase = lcnt + 32;
    const bf16_t* hb = (const bf16_t*)(p.ws + OFF_HB); const bf16_t* wrt = (const bf16_t*)(p.ws + OFF_WR);
    const float* ssq_h = (const float*)(p.ws + OFF_SSQ) + 2 * T_;
    int* cnt = (int*)(p.ws + OFF_CNT + so); int* rinfo = (int*)(p.ws + OFF_RINFO + so); float* rw = (float*)(p.ws + OFF_RW + so);
    const int t0 = item * 64;
    if (tid < 32) lcnt[tid] = 0;
    f32x4 acc[4][3];
#pragma unroll
    for (int m = 0; m < 4; ++m)
#pragma unroll
        for (int n = 0; n < 3; ++n) acc[m][n] = (f32x4){0.f, 0.f, 0.f, 0.f};
    const bf16_t* ap = hb + (size_t)(t0 + fr) * D_ + wid * 256 + fq * 8; const bf16_t* bp = wrt + (size_t)fr * D_ + wid * 256 + fq * 8;
#pragma unroll 4
    for (int ks = 0; ks < 8; ++ks) {
        bf16x8 a[4], b[3];
#pragma unroll
        for (int m = 0; m < 4; ++m) a[m] = *(const bf16x8*)(ap + (size_t)m * 16 * D_ + ks * 32);
#pragma unroll
        for (int n = 0; n < 3; ++n) b[n] = *(const bf16x8*)(bp + (size_t)n * 16 * D_ + ks * 32);
#pragma unroll
        for (int m = 0; m < 4; ++m)
#pragma unroll
            for (int n = 0; n < 3; ++n) acc[m][n] = __builtin_amdgcn_mfma_f32_16x16x32_bf16(a[m], b[n], acc[m][n], 0, 0, 0);
    }
#pragma unroll
    for (int m = 0; m < 4; ++m)
#pragma unroll
        for (int n = 0; n < 3; ++n)
#pragma unroll
            for (int j = 0; j < 4; ++j) lg[(wid * 64 + m * 16 + 4 * fq + j) * 48 + 16 * n + fr] = acc[m][n][j];
    __syncthreads();
    for (int i = tid; i < 64 * 48; i += NTHR) { float v = 0.f;
#pragma unroll
        for (int w = 0; w < 8; ++w) v += lg[w * 64 * 48 + i];
        ls[i] = v; }
    __syncthreads();
    int e0 = 0, e1 = 0, r0 = 0, r1 = 0; float g0 = 0.f, g1 = 0.f, rsc = 0.f; const int t = t0 + tid;
    if (tid < 64) {
        const float* l0 = ls + tid * 48; const float rstd = rsqrtf(ssq_h[t] * (1.f / D_) + EPS); rsc = rstd * (1.f / WGU_SCALE);
        float gm = -3.0e38f; int gi = 0; float gl[4];
#pragma unroll
        for (int o = 0; o < 4; ++o) { gl[o] = l0[o] * rstd + p.rgb[o]; if (gl[o] > gm) { gm = gl[o]; gi = o; } }
        float gs = 0.f;
#pragma unroll
        for (int o = 0; o < 4; ++o) gs += __expf(gl[o] - gm);
        const float pg = 1.f / gs;
        float b1 = -3.0e38f, b2 = -3.0e38f; int i1 = 0, i2 = 0;
        for (int q = 0; q < 8; ++q) { const float v = l0[4 + gi * 8 + q] * rstd + p.reb[gi * 8 + q];
            if (v > b1) { b2 = b1; i2 = i1; b1 = v; i1 = q; } else if (v > b2) { b2 = v; i2 = q; } }
        const float wa = 1.f / (1.f + __expf(b2 - b1));
        e0 = gi * 8 + i1; e1 = gi * 8 + i2; g0 = pg * wa; g1 = pg * (1.f - wa);
        r0 = atomicAdd(&lcnt[e0], 1); r1 = atomicAdd(&lcnt[e1], 1);
    }
    __syncthreads();
    if (tid < 32) lbase[tid] = atomicAdd(cnt + tid, lcnt[tid]);
    __syncthreads();
    if (tid < 64) { const int i0 = lbase[e0] + r0, i1 = lbase[e1] + r1;
        rinfo[e0 * LCAP + i0] = (int)((cvt_pk_bf16(g0, 0.f) << 16) | (unsigned)(2 * t)); rinfo[e1 * LCAP + i1] = (int)((cvt_pk_bf16(g1, 0.f) << 16) | (unsigned)(2 * t + 1));
        rw[e0 * LCAP + i0] = rsc; rw[e1 * LCAP + i1] = rsc; }
    __syncthreads();
}
__device__ __forceinline__ void phase4(const Params& p, unsigned char* lds, size_t so = 0) { for (int it = blockIdx.x; it < T_ / 64; it += gridDim.x) route_item(p, lds, it, so); }

__device__ __forceinline__ PG8_LAS int* moe_tables_to_lds(const Params& p, unsigned char* lds) {
    PG8_LAS int* tb = (PG8_LAS int*)((PG8_LAS unsigned char*)lds + LCNT_OFF); const int* cnt = (const int*)(p.ws + OFF_CNT);
    if (threadIdx.x < NE) tb[MT_CNT + threadIdx.x] = __hip_atomic_load(cnt + threadIdx.x, __ATOMIC_RELAXED, __HIP_MEMORY_SCOPE_AGENT);
    __syncthreads();
    if (threadIdx.x == 0) { int pt = 0;
        for (int e = 0; e < NE; ++e) { const int nt = (tb[MT_CNT + e] + 255) >> 8; tb[MT_PST + e] = pt; for (int i = 0; i < nt; ++i) tb[MT_T2E + pt + i] = e; pt += nt; }
        tb[MT_PST + NE] = pt; tb[MT_NT] = pt; }
    __syncthreads();
    return tb;
}
__device__ __forceinline__ void phase5(const Params& p, unsigned char* lds) {
    PG8_LAS int* lc = moe_tables_to_lds(p, lds);
    const Epi5 E{p.ws, lc};
    const pg8::MoeOrder S{lc, 4, (int)gridDim.x, (int)blockIdx.x}; const pg8::AOffGather AO{p.ws, lc, D_ / 2};
    pg8::gemm_phase<Epi5, pg8::MoeOrder, pg8::AOffGather, true, true>((PG8_LAS unsigned char*)lds, (const bf16_t*)(p.ws + OFF_H8), (const bf16_t*)(p.ws + OFF_WGU), D_ / 2, S, AO, E);
    { const int G = gridDim.x, c = blockIdx.x, U = 4 * __builtin_amdgcn_readfirstlane(lc[MT_NT]), rem = U % G;
      if (rem == 0) run_tjobs(p, lds, N_TJOBS_GU, N_TJOBS, 0, 1 << 20, c, G);
      else if (c >= rem) run_tjobs(p, lds, N_TJOBS_GU, N_TJOBS, 0, 1 << 20, c - rem, G - rem); }
}
__device__ __forceinline__ void phase6(const Params& p, unsigned char* lds) {
    PG8_LAS int* lc = moe_tables_to_lds(p, lds);
    const Epi6 E{p.ws, lc};
    const pg8::MoeOrder S{lc, 8, (int)gridDim.x, (int)blockIdx.x}; const pg8::AOffDirect AO{DE / 2};
    pg8::gemm_phase<Epi6, pg8::MoeOrder, pg8::AOffDirect, true, true>((PG8_LAS unsigned char*)lds, (const bf16_t*)(p.ws + OFF_B), (const bf16_t*)(p.ws + OFF_WD), DE / 2, S, AO, E);
}
__device__ __forceinline__ void phase7(const Params& p) {
    const int tid = opaque_tid(), wid = tid >> 6, lane = tid & 63;
    const bf16_t* hb = (const bf16_t*)(p.ws + OFF_HB); const unsigned char* ys2 = p.ws + OFF_A;
    for (int t = blockIdx.x * 8 + wid; t < T_; t += gridDim.x * 8) {
        float v[4][8]; float s = 0.f;
#pragma unroll
        for (int i = 0; i < 4; ++i) { const int c = i * 512 + lane * 8;
            const u32x4 a = *(const u32x4*)(hb + (size_t)t * D_ + c); const u32x2 b = *(const u32x2*)(ys2 + (size_t)(2 * t) * D_ + c), d = *(const u32x2*)(ys2 + (size_t)(2 * t + 1) * D_ + c);
            float y0[8], y1[8];
            up4_fp8(b.x, y0[0], y0[1], y0[2], y0[3]); up4_fp8(b.y, y0[4], y0[5], y0[6], y0[7]); up4_fp8(d.x, y1[0], y1[1], y1[2], y1[3]); up4_fp8(d.y, y1[4], y1[5], y1[6], y1[7]);
#pragma unroll
            for (int q = 0; q < 4; ++q) { v[i][2 * q] = bflo(a[q]) + (y0[2 * q] + y1[2 * q]) * (1.f / YS_SCALE); v[i][2 * q + 1] = bfhi(a[q]) + (y0[2 * q + 1] + y1[2 * q + 1]) * (1.f / YS_SCALE);
                s += v[i][2 * q] * v[i][2 * q] + v[i][2 * q + 1] * v[i][2 * q + 1]; } }
        const float rstd = rsqrtf(wave_sum(s) * (1.f / D_) + EPS);
#pragma unroll
        for (int i = 0; i < 4; ++i) { const int c = i * 512 + lane * 8;
            const f32x4 g0 = *(const f32x4*)(p.g_final + c), g1 = *(const f32x4*)(p.g_final + c + 4);
            f32x4 o0, o1;
#pragma unroll
            for (int q = 0; q < 4; ++q) { o0[q] = v[i][q] * rstd * g0[q]; o1[q] = v[i][4 + q] * rstd * g1[q]; }
            *(f32x4*)(p.out + (size_t)t * D_ + c) = o0; *(f32x4*)(p.out + (size_t)t * D_ + c + 4) = o1; }
    }
}

#ifndef ONE_LAUNCH
#define ONE_LAUNCH 1
#endif
template <int PH> __global__ void __launch_bounds__(NTHR, 2) k_phase(Params p) {
    extern __shared__ __attribute__((aligned(16))) unsigned char lds[];
    if (PH == 0) phase0(p, lds);
    if (PH == 1) phase1(p, lds);
    if (PH == 2) phase2(p, lds);
    if (PH == 3) phase3(p, lds);
    if (PH == 4) phase4(p, lds);
    if (PH == 5) phase5(p, lds);
    if (PH == 6) phase6(p, lds);
    if (PH == 7) phase7(p);
}
__global__ void __launch_bounds__(NTHR, 2) k_mega(Params p) {
    extern __shared__ __attribute__((aligned(16))) unsigned char lds[];
    cg::grid_group grid = cg::this_grid();
    volatile PG8_LAS unsigned* bst = (volatile PG8_LAS unsigned*)((PG8_LAS unsigned char*)lds + LBAR_OFF);
    if (threadIdx.x < 2) bst[threadIdx.x] = 0u;
    __syncthreads();
    (void)xcd_barrier_post((unsigned*)(p.ws + OFF_BAR), bst);
#define GRID_BAR() do { XcdBarrier b_; b_.bar = (unsigned*)(opaque_ws(p.ws) + OFF_BAR); b_.x = xb_xcc_id(); b_.st = bst; xcd_barrier(b_); } while (0)
    if (DUP_PHASE == 0) { phase0(p, lds); GRID_BAR(); }
    if (p.ws == nullptr) grid.sync();
    phase0(p, lds); GRID_BAR();
    if (DUP_PHASE == 1) { phase1(p, lds); GRID_BAR(); }
    phase1(p, lds); GRID_BAR();
    if (DUP_PHASE == 2) { phase2(p, lds, OFF_DUMMY - OFF_SSQ); GRID_BAR(); }
    phase2(p, lds); GRID_BAR();
    if (DUP_PHASE == 3) { phase3(p, lds, OFF_DUMMY - OFF_SSQ); GRID_BAR(); }
    phase3(p, lds); GRID_BAR();
    if (DUP_PHASE == 4) { phase4(p, lds, OFF_DUMMY - OFF_SSQ); GRID_BAR(); }
    phase4(p, lds); GRID_BAR();
    if (DUP_PHASE == 5) { phase5(p, lds); GRID_BAR(); }
    phase5(p, lds); GRID_BAR();
    if (DUP_PHASE == 6) { phase6(p, lds); GRID_BAR(); }
    phase6(p, lds); GRID_BAR();
    if (DUP_PHASE == 8) { for (int i = 0; i < 10; ++i) GRID_BAR(); }
    if (DUP_PHASE == 9) { grid.sync(); grid.sync(); }
    if (DUP_PHASE == 7) { phase7(p); GRID_BAR(); }
    phase7(p);
}

extern "C" void kernel_launch(void* const* d_in, const int* in_sizes, int n_in, void* d_out, int out_size, void* d_ws, size_t ws_size, hipStream_t stream) {
    static int grid = 0;
    if (grid == 0) {
        if (n_in != 19 || in_sizes[0] != T_ * D_ || out_size != T_ * D_ || ws_size < WS_END + (DUP_PHASE >= 2 && DUP_PHASE <= 4 ? DUMMY_BYTES : 0)) { fprintf(stderr, "kernel_launch: unexpected shapes (n_in %d, in0 %d, out %d, ws %zu < %zu); nothing launched\n", n_in, n_in > 0 ? in_sizes[0] : -1, out_size, ws_size, (size_t)WS_END); grid = -1; return; }
        int dev = 0, cus = 0, per_cu = 0;
        if (hipGetDevice(&dev) != hipSuccess || hipDeviceGetAttribute(&cus, hipDeviceAttributeMultiprocessorCount, dev) != hipSuccess) { grid = -1; return; }
#if ONE_LAUNCH
        if (hipFuncSetAttribute((const void*)k_mega, hipFuncAttributeMaxDynamicSharedMemorySize, LDS_BYTES) != hipSuccess) { fprintf(stderr, "kernel_launch: hipFuncSetAttribute failed\n"); grid = -1; return; }
        if (hipOccupancyMaxActiveBlocksPerMultiprocessor(&per_cu, (const void*)k_mega, NTHR, LDS_BYTES) != hipSuccess || per_cu < 1) { fprintf(stderr, "kernel_launch: occupancy query says %d blocks per CU\n", per_cu); grid = -1; return; }
        grid = cus * per_cu;
#else
        (void)hipFuncSetAttribute((const void*)k_phase<0>, hipFuncAttributeMaxDynamicSharedMemorySize, LDS_BYTES);
        (void)hipFuncSetAttribute((const void*)k_phase<1>, hipFuncAttributeMaxDynamicSharedMemorySize, LDS_BYTES);
        (void)hipFuncSetAttribute((const void*)k_phase<2>, hipFuncAttributeMaxDynamicSharedMemorySize, LDS_BYTES);
        (void)hipFuncSetAttribute((const void*)k_phase<3>, hipFuncAttributeMaxDynamicSharedMemorySize, LDS_BYTES);
        (void)hipFuncSetAttribute((const void*)k_phase<4>, hipFuncAttributeMaxDynamicSharedMemorySize, LDS_BYTES);
        (void)hipFuncSetAttribute((const void*)k_phase<5>, hipFuncAttributeMaxDynamicSharedMemorySize, LDS_BYTES);
        (void)hipFuncSetAttribute((const void*)k_phase<6>, hipFuncAttributeMaxDynamicSharedMemorySize, LDS_BYTES);
        (void)hipFuncSetAttribute((const void*)k_phase<7>, hipFuncAttributeMaxDynamicSharedMemorySize, LDS_BYTES);
        grid = cus > 0 ? cus : 256;
#endif
    }
    if (grid < 0) return;
    Params p{};
    const float** f = (const float**)&p;
    for (int i = 0; i < 19; ++i) f[i] = (const float*)d_in[i];
    p.out = (float*)d_out; p.ws = (unsigned char*)d_ws;
#if ONE_LAUNCH
    if (hipMemsetAsync((unsigned char*)d_ws + OFF_BAR, 0, BAR_BYTES, stream) != hipSuccess) { fprintf(stderr, "kernel_launch: memset of the barrier words failed\n"); return; }
    void* args[] = {&p};
    const hipError_t e = hipLaunchCooperativeKernel((const void*)k_mega, dim3(grid), dim3(NTHR), args, LDS_BYTES, stream);
    if (e != hipSuccess) fprintf(stderr, "kernel_launch: cooperative launch failed: %s (grid %d)\n", hipGetErrorString(e), grid);
#else
    hipLaunchKernelGGL(k_phase<0>, dim3(grid), dim3(NTHR), LDS_BYTES, stream, p);
    hipLaunchKernelGGL(k_phase<1>, dim3(grid), dim3(NTHR), LDS_BYTES, stream, p);
    hipLaunchKernelGGL(k_phase<2>, dim3(grid), dim3(NTHR), LDS_BYTES, stream, p);
    hipLaunchKernelGGL(k_phase<3>, dim3(grid), dim3(NTHR), LDS_BYTES, stream, p);
    hipLaunchKernelGGL(k_phase<4>, dim3(grid), dim3(NTHR), LDS_BYTES, stream, p);
    hipLaunchKernelGGL(k_phase<5>, dim3(grid), dim3(NTHR), LDS_BYTES, stream, p);
    hipLaunchKernelGGL(k_phase<6>, dim3(grid), dim3(NTHR), LDS_BYTES, stream, p);
    hipLaunchKernelGGL(k_phase<7>, dim3(grid), dim3(NTHR), LDS_BYTES, stream, p);
#endif
}
```

```cpp
#include <hip/hip_runtime.h>
#include <hip/hip_cooperative_groups.h>
#include <cstdio>
namespace cg = cooperative_groups;

typedef unsigned short bf16_t;
typedef float f32x4 __attribute__((ext_vector_type(4)));
typedef unsigned u32x4 __attribute__((ext_vector_type(4)));
typedef unsigned u32x2 __attribute__((ext_vector_type(2)));
typedef short bf16x8 __attribute__((ext_vector_type(8)));
typedef int v4i __attribute__((ext_vector_type(4)));
typedef int v8i __attribute__((ext_vector_type(8)));

constexpr int T_ = 16384, D_ = 2048, DIN = 5120, NE = 32, DE = 512, SEQ = 4096, LCAP = 16384;
constexpr float EPS = 1e-6f;
#ifndef DUP_PHASE
#define DUP_PHASE -1
#endif
constexpr int NTHR = 512;
constexpr int LDS_BYTES = 163840;
constexpr int LCNT_OFF = 131072, LBAR_OFF = 131072 + 2048, XS_OFF = 131072 + 4096, XM_OFF = XS_OFF + 8192, RS_OFF = XM_OFF;
constexpr int RS_UNITS = 4;
static_assert(XM_OFF + 512 * 32 <= LDS_BYTES && RS_UNITS * 256 * 8 <= 512 * 32, "LDS map");

constexpr size_t SZ_A = (size_t)T_ * DIN * 2;
constexpr size_t SZ_B = (size_t)T_ * D_ * 2;
constexpr size_t OFF_A = 0;
constexpr size_t OFF_B = OFF_A + SZ_A;
constexpr size_t OFF_HB = OFF_B + SZ_B;
constexpr size_t OFF_H8 = OFF_A + (size_t)2 * T_ * D_ * 2;
constexpr float WGU_SCALE = 32.f, WD_SCALE = 16.f, YS_SCALE = 16.f;
constexpr size_t OFF_WIN = OFF_HB + SZ_B;
constexpr size_t OFF_WOUT = OFF_WIN + (size_t)DIN * D_ * 2;
constexpr size_t OFF_WGU = OFF_WOUT + (size_t)D_ * D_ * 2;
constexpr size_t OFF_WD = OFF_WGU + (size_t)NE * 1024 * D_ * 2;
constexpr size_t OFF_WR = OFF_WD + (size_t)NE * D_ * DE * 2;
constexpr size_t OFF_SSQ = OFF_WR + (size_t)48 * D_ * 2;
constexpr size_t OFF_CNT = OFF_SSQ + (size_t)3 * T_ * 4;
constexpr size_t OFF_RINFO = OFF_CNT + 256;
constexpr size_t OFF_RW = OFF_RINFO + (size_t)NE * LCAP * 4;
constexpr size_t OFF_BAR = OFF_RW + (size_t)NE * LCAP * 4;
constexpr size_t BAR_BYTES = 16384;
constexpr size_t WS_END = OFF_BAR + BAR_BYTES;
constexpr size_t OFF_DUMMY = WS_END;
constexpr size_t DUMMY_BYTES = (OFF_BAR - OFF_SSQ);

struct Params {
    const float *x, *norm_mix_g, *w_in, *v_norm_g, *gmlp_ws, *gmlp_bs, *conv_w, *g_a, *g_b, *w_out, *g_ffn, *rgw, *rgb, *rew, *reb, *ewg, *ewu, *ewd, *g_final;
    float* out; unsigned char* ws;
};

__device__ __forceinline__ unsigned cvt_pk_bf16(float lo, float hi) { unsigned r; asm volatile("v_cvt_pk_bf16_f32 %0, %1, %2" : "=v"(r) : "v"(lo), "v"(hi)); return r; }
#define GAS __attribute__((address_space(1)))
typedef GAS unsigned char gbyte;
__device__ __forceinline__ gbyte* opaque_ws(unsigned char* w) { gbyte* g = (gbyte*)w; asm volatile("" : "+s"(g)); return g; }
__device__ __forceinline__ int opaque_tid() { int t = threadIdx.x; asm volatile("" : "+v"(t)); return t; }
__device__ __forceinline__ unsigned pk4_fp8(float a, float b, float c, float d) { int w = 0; w = __builtin_amdgcn_cvt_pk_fp8_f32(a, b, w, false); w = __builtin_amdgcn_cvt_pk_fp8_f32(c, d, w, true); return (unsigned)w; }
__device__ __forceinline__ void up4_fp8(unsigned w, float& a, float& b, float& c, float& d) {
    const auto lo = __builtin_amdgcn_cvt_pk_f32_fp8((int)w, false), hi = __builtin_amdgcn_cvt_pk_f32_fp8((int)w, true); a = lo[0]; b = lo[1]; c = hi[0]; d = hi[1]; }
__device__ __forceinline__ float bflo(unsigned w) { return __uint_as_float(w << 16); }
__device__ __forceinline__ float bfhi(unsigned w) { return __uint_as_float(w & 0xffff0000u); }
__device__ __forceinline__ float wave_sum(float v) {
#pragma unroll
    for (int o = 1; o < 64; o <<= 1) v += __shfl_xor(v, o);
    return v;
}
__device__ __forceinline__ float gelu_t(float x) {
    const float u = x * (0.7978845608f + 0.0356774081f * x * x);
    return x * __builtin_amdgcn_rcpf(1.f + __builtin_amdgcn_exp2f(-2.885390082f * u));
}
__device__ __forceinline__ float silu_f(float x) { return x * __builtin_amdgcn_rcpf(1.f + __builtin_amdgcn_exp2f(-1.442695041f * x)); }

#define PG8_LAS __attribute__((address_space(3)))
struct Unit { int pm, pn, e, r0, pnl; };

constexpr int MT_CNT = 0, MT_PST = 32, MT_NT = 65, MT_T2E = 66, MT_WORDS = 66 + 192;
typedef const PG8_LAS int* lcnt_t;
__device__ __forceinline__ bool moe_unit(lcnt_t tb, int NT, int L, Unit& u) {
    const int pt = L / NT;
    if (pt >= __builtin_amdgcn_readfirstlane(tb[MT_NT])) return false;
    const int e = __builtin_amdgcn_readfirstlane(tb[MT_T2E + pt]), mt = pt - __builtin_amdgcn_readfirstlane(tb[MT_PST + e]), j = L - pt * NT;
    u.e = e; u.pm = pt; u.r0 = mt * 256; u.pnl = j; u.pn = e * NT + j; return true;
}

struct NoMeta {};
struct Meta8 { u32x4 lo, hi; };
struct Epi1 {
    static constexpr bool PERM = true, MIDSCALE = false;
    typedef NoMeta Meta;
    unsigned char* ws;
    __device__ __forceinline__ Meta meta_load(const Unit&, int, int) const { return Meta{}; }
    __device__ __forceinline__ void operator()(f32x4 (&acc)[2][2][4][2], const Unit& u, int wr, int wc, int fr, int fq, const Meta&) const {
        GAS bf16_t* P = (GAS bf16_t*)(opaque_ws(ws) + OFF_A);
        const bool act = u.pn < 8;
#pragma unroll
        for (int ai = 0; ai < 2; ++ai)
#pragma unroll
            for (int m = 0; m < 4; ++m) {
                const int row = u.pm * 256 + ai * 128 + wr * 64 + m * 16 + fr;
                GAS bf16_t* rowp = P + (size_t)row * DIN + u.pn * 256 + wc * 32 + 8 * fq;
#pragma unroll
                for (int bj = 0; bj < 2; ++bj) {
                    f32x4 v0 = acc[ai][bj][m][0], v1 = acc[ai][bj][m][1];
                    if (act) {
#pragma unroll
                        for (int j = 0; j < 4; ++j) { v0[j] = gelu_t(v0[j]); v1[j] = gelu_t(v1[j]); }
                    }
                    u32x4 w; w.x = cvt_pk_bf16(v0[0], v0[1]); w.y = cvt_pk_bf16(v0[2], v0[3]); w.z = cvt_pk_bf16(v1[0], v1[1]); w.w = cvt_pk_bf16(v1[2], v1[3]);
                    *(GAS u32x4*)(rowp + bj * 128) = w;
                }
            }
    }
};
struct Epi2 {
    static constexpr bool PERM = true, MIDSCALE = true;
    const float* x; unsigned char* ws; size_t so;
    const PG8_LAS float* rsl;
    __device__ __forceinline__ void midscale(f32x4 (&acc)[2][2][4][2], const Unit& u, int wr, int wc, int fr, int fq) const {
        const PG8_LAS float* pr = rsl + (u.e * 256 + wr * 64 + fr) * 2;
#pragma unroll
        for (int ai = 0; ai < 2; ++ai)
#pragma unroll
            for (int m = 0; m < 4; ++m) {
                const float s = pr[(ai * 128 + m * 16) * 2];
#pragma unroll
                for (int bj = 0; bj < 2; ++bj)
#pragma unroll
                    for (int n = 0; n < 2; ++n) acc[ai][bj][m][n] *= s;
            }
    }
    typedef NoMeta Meta;
    __device__ __forceinline__ Meta meta_load(const Unit&, int, int) const { return Meta{}; }
    __device__ __forceinline__ void operator()(f32x4 (&acc)[2][2][4][2], const Unit& u, int wr, int wc, int fr, int fq, const Meta&) const {
        gbyte* w_ = opaque_ws(ws);
        GAS bf16_t* hb = (GAS bf16_t*)(w_ + OFF_HB); gbyte* h8 = w_ + OFF_H8; float* ssq_h = (float*)(ws + OFF_SSQ + so) + 2 * T_;
#pragma unroll
        for (int ai = 0; ai < 2; ++ai)
#pragma unroll
            for (int m = 0; m < 4; ++m) {
                const int row = u.pm * 256 + ai * 128 + wr * 64 + m * 16 + fr;
                const float rb = rsl[(u.e * 256 + ai * 128 + wr * 64 + m * 16 + fr) * 2 + 1];
                const size_t off = (size_t)row * D_ + u.pn * 256 + wc * 32 + 8 * fq;
                float ss = 0.f;
#pragma unroll
                for (int bj = 0; bj < 2; ++bj) {
                    const f32x4 x0 = *(const f32x4*)(x + off + bj * 128), x1 = *(const f32x4*)(x + off + bj * 128 + 4);
                    const f32x4 h0 = x0 + acc[ai][bj][m][0] * rb, h1 = x1 + acc[ai][bj][m][1] * rb;
                    ss += (h0[0] * h0[0] + h0[1] * h0[1]) + (h0[2] * h0[2] + h0[3] * h0[3]) + (h1[0] * h1[0] + h1[1] * h1[1]) + (h1[2] * h1[2] + h1[3] * h1[3]);
                    u32x4 w; w.x = cvt_pk_bf16(h0[0], h0[1]); w.y = cvt_pk_bf16(h0[2], h0[3]); w.z = cvt_pk_bf16(h1[0], h1[1]); w.w = cvt_pk_bf16(h1[2], h1[3]);
                    *(GAS u32x4*)(hb + off + bj * 128) = w;
                    u32x2 w8; w8.x = pk4_fp8(h0[0], h0[1], h0[2], h0[3]); w8.y = pk4_fp8(h1[0], h1[1], h1[2], h1[3]);
                    *(GAS u32x2*)(h8 + off + bj * 128) = w8;
                }
                ss += __shfl_xor(ss, 16); ss += __shfl_xor(ss, 32);
                if (fq == 0) atomicAdd(ssq_h + row, ss);
                if (m == 3) asm volatile("" ::: "memory");
            }
    }
};
struct Epi5 {
    static constexpr bool PERM = true, MIDSCALE = false;
    typedef Meta8 Meta;
    unsigned char* ws; lcnt_t cnt;
    __device__ __forceinline__ Meta meta_load(const Unit& u, int wr, int fr) const {
        const GAS unsigned* rrs = (const GAS unsigned*)(opaque_ws(ws) + OFF_RW) + u.e * LCAP; const int ce = __builtin_amdgcn_readfirstlane(cnt[u.e]); Meta mt;
#pragma unroll
        for (int q = 0; q < 4; ++q) { const int i0 = u.r0 + wr * 64 + q * 16 + fr, i1 = i0 + 128;
            const unsigned a = rrs[min(i0, ce - 1)], b = rrs[min(i1, ce - 1)]; mt.lo[q] = (i0 < ce) ? a : 0u; mt.hi[q] = (i1 < ce) ? b : 0u; }
        return mt;
    }
    __device__ __forceinline__ void operator()(f32x4 (&acc)[2][2][4][2], const Unit& u, int wr, int wc, int fr, int fq, const Meta& mt) const {
        gbyte* hbuf = opaque_ws(ws) + OFF_B;
#pragma unroll
        for (int ai = 0; ai < 2; ++ai)
#pragma unroll
            for (int m = 0; m < 4; ++m) {
                const int r = ai * 128 + wr * 64 + m * 16 + fr;
                const float rs = __uint_as_float(ai ? mt.hi[m] : mt.lo[m]);
                float o[8];
#pragma unroll
                for (int n = 0; n < 2; ++n)
#pragma unroll
                    for (int j = 0; j < 4; ++j) o[4 * n + j] = silu_f(acc[ai][0][m][n][j] * rs) * (acc[ai][1][m][n][j] * rs);
                u32x2 w; w.x = pk4_fp8(o[0], o[1], o[2], o[3]); w.y = pk4_fp8(o[4], o[5], o[6], o[7]);
                *(GAS u32x2*)(hbuf + (size_t)(u.pm * 256 + r) * DE + u.pnl * 128 + wc * 32 + 8 * fq) = w;
                if (m & 1) asm volatile("" ::: "memory");
            }
    }
};
struct Epi6 {
    static constexpr bool PERM = true, MIDSCALE = false;
    typedef Meta8 Meta;
    unsigned char* ws; lcnt_t cnt;
    __device__ __forceinline__ Meta meta_load(const Unit& u, int wr, int fr) const {
        const GAS unsigned* rpk = (const GAS unsigned*)(opaque_ws(ws) + OFF_RINFO) + u.e * LCAP; const int ce = __builtin_amdgcn_readfirstlane(cnt[u.e]); Meta mt;
#pragma unroll
        for (int q = 0; q < 4; ++q) { const int i0 = u.r0 + wr * 64 + q * 16 + fr, i1 = i0 + 128;
            const unsigned a = rpk[min(i0, ce - 1)], b = rpk[min(i1, ce - 1)]; mt.lo[q] = (i0 < ce) ? a : 0xFFFFFFFFu; mt.hi[q] = (i1 < ce) ? b : 0xFFFFFFFFu; }
        return mt;
    }
    __device__ __forceinline__ void operator()(f32x4 (&acc)[2][2][4][2], const Unit& u, int wr, int wc, int fr, int fq, const Meta& mt) const {
        gbyte* ys2 = opaque_ws(ws) + OFF_A;
#pragma unroll
        for (int ai = 0; ai < 2; ++ai)
#pragma unroll
            for (int m = 0; m < 4; ++m) {
                const unsigned pk = ai ? mt.hi[m] : mt.lo[m]; const unsigned info = pk & 0xFFFFu;
                if (info < 2u * T_) {
                    const float g = __uint_as_float(pk & 0xFFFF0000u) * (YS_SCALE / WD_SCALE);
                    gbyte* dst = ys2 + (size_t)info * D_ + u.pnl * 256 + wc * 32 + 8 * fq;
#pragma unroll
                    for (int bj = 0; bj < 2; ++bj) {
                        const f32x4 v0 = acc[ai][bj][m][0] * g, v1 = acc[ai][bj][m][1] * g;
                        u32x2 w; w.x = pk4_fp8(v0[0], v0[1], v0[2], v0[3]); w.y = pk4_fp8(v1[0], v1[1], v1[2], v1[3]);
                        *(GAS u32x2*)(dst + bj * 128) = w;
                    }
                }
            }
    }
};

namespace pg8 {
constexpr int BM = 256, BK = 64, HALF = 128, HTB = HALF * BK * 2, STAGE_BYTES = 8 * HTB, NXCD = 8, WGM = 8;
__host__ __device__ __forceinline__ int lds_byte(int r, int c) { const int st = (r >> 4) * 2 + (c >> 5), rr = r & 15, cc = c & 31, ob = rr * 64 + cc * 2; return st * 1024 + (ob ^ (((ob >> 9) & 1) << 5)); }
__host__ __device__ __forceinline__ void stage_rc(int b, int& R, int& C) { const int st = b / 1024, sb = b % 1024, swz = sb ^ (((sb >> 9) & 1) << 5); R = (st >> 1) * 16 + swz / 64; C = (st & 1) * 32 + (swz % 64) / 2; }
__host__ __device__ __forceinline__ int perm32(int rho) { const int n = rho >> 4, i = rho & 15; return 8 * (i >> 2) + 4 * n + (i & 3); }

struct StaticOrder {
    int nM, nN, nwg, G, c, i0, i1;
    __device__ void init(int M, int N, int G_, int c_) { nM = M / BM; nN = N / BM; nwg = nM * nN; G = G_; c = c_; i0 = 0; i1 = 1 << 30; }
    __device__ int count() const { return (nwg - c + G - 1) / G; }
    __device__ bool next(int ii, Unit& u) const {
        const int i = ii + i0; if (i >= i1) return false;
        const long L = (long)i * G + c; if (L >= nwg) return false;
        int wgid = (int)L; { const int q = nwg / NXCD, r = nwg % NXCD, xcd = wgid % NXCD, off = wgid / NXCD; wgid = (xcd < r ? xcd * (q + 1) : r * (q + 1) + (xcd - r) * q) + off; }
        const int nig = WGM * nN, gid = wgid / nig, fm = gid * WGM, gsz = (nM - fm) < WGM ? (nM - fm) : WGM;
        u.pm = fm + ((wgid % nig) % gsz); u.pn = (wgid % nig) / gsz; u.e = i; u.r0 = 0; u.pnl = u.pn; return true;
    }
};
struct MoeOrder {
    lcnt_t cnt; int NT, G, c;
    __device__ __forceinline__ bool next(int i, Unit& u) const { return moe_unit(cnt, NT, i * G + c, u); }
};
struct AOffDirect { int K; struct Pre {};
    __device__ __forceinline__ Pre pre(const Unit&, int, int) const { return Pre{}; }
    __device__ __forceinline__ unsigned fin(const Pre&, const Unit& u, int h, int i, int R, int C) const { return (unsigned)(((u.pm * 256 + h * 128 + R) * K + C) * 2); } };
struct AOffGather { unsigned char* ws; lcnt_t cnt; int K;
    struct Pre { unsigned pk[2][2]; };
    __device__ __forceinline__ Pre pre(const Unit& u, int R0, int R1) const {
        const GAS unsigned* rpk = (const GAS unsigned*)(opaque_ws(ws) + OFF_RINFO) + u.e * LCAP; const int ce = __builtin_amdgcn_readfirstlane(cnt[u.e]); Pre p;
#pragma unroll
        for (int h = 0; h < 2; ++h) { const int i0 = u.r0 + h * 128 + R0, i1 = u.r0 + h * 128 + R1;
            p.pk[h][0] = rpk[min(i0, ce - 1)]; p.pk[h][1] = rpk[min(i1, ce - 1)]; }
        return p;
    }
    __device__ __forceinline__ unsigned fin(const Pre& p, const Unit&, int h, int i, int, int C) const { const int tok = (int)((p.pk[h][i] & 0xFFFFu) >> 1); return (unsigned)((tok * K + C) * 2); } };

template <class Epi, class Sched, class AOff, bool ALIGN_EPI, bool FP8 = false>
__device__ __forceinline__ void gemm_phase(PG8_LAS unsigned char* lds, const bf16_t* Ag, const bf16_t* Btg, const int K, const Sched& S, const AOff& AO, const Epi& E) {
    const int tid = opaque_tid(), wid = __builtin_amdgcn_readfirstlane(tid >> 6), lane = tid & 63, wr = wid >> 2, wc = wid & 3, fr = lane & 15, fq = lane >> 4;
    int nt = K / BK; asm volatile("" : "+s"(nt));
    unsigned voffB[2];
#pragma unroll
    for (int i = 0; i < 2; ++i) { int R, C; stage_rc(tid * 16 + i * 8192, R, C); const int Rb = Epi::PERM ? ((R & ~31) + perm32(R & 31)) : R; voffB[i] = (unsigned)(Rb * K + C) * 2u; }
#define PG8_APRE(u, pv_) do { int _t = tid; asm volatile("" : "+v"(_t)); int _R0, _R1, _C; stage_rc(_t * 16, _R0, _C); stage_rc(_t * 16 + 8192, _R1, _C); pv_ = AO.pre(u, _R0, _R1); } while (0)
#define PG8_AFIN(u, pv_, d0, d1) do { int _t = tid; asm volatile("" : "+v"(_t)); _Pragma("unroll") for (int _i = 0; _i < 2; ++_i) { int _R, _C; stage_rc(_t * 16 + _i * 8192, _R, _C); d0[_i] = AO.fin(pv_, u, 0, _i, _R, _C); d1[_i] = AO.fin(pv_, u, 1, _i, _R, _C); } } while (0)
#define PG8_LANE(fr_, fq_) int fr_, fq_; { int _t = tid; asm volatile("" : "+v"(_t)); fr_ = _t & 15; fq_ = (_t & 63) >> 4; }
    const unsigned kstep = (unsigned)(BK * 2), hstep = (unsigned)HALF * (unsigned)K * 2u, tstep = 2u * hstep;
    const unsigned ldsw = (unsigned)wid * 1024u;
    const int aoff = lds_byte(wr * 64 + fr, fq * 8), boff = lds_byte(wc * 32 + fr, fq * 8);
    const char* const Ab = (const char*)Ag; const char* const Bb = (const char*)Btg;
#define PG8_SA(b, h) (((b) * 2 + (h)) * HTB)
#define PG8_SB(b, h) ((4 + (b) * 2 + (h)) * HTB)
#define PG8_STAGE(bufoff, gbase, uoff, voff) do { _Pragma("unroll") for (int _i = 0; _i < 2; ++_i) \
        __builtin_amdgcn_global_load_lds((const unsigned*)((gbase) + (size_t)(unsigned)((uoff) + (voff)[_i])), (PG8_LAS unsigned*)(lds + (bufoff) + ldsw + _i * 8192), 16, 0, 0); } while (0)
#define PG8_LD32(base) __builtin_shufflevector(*(const PG8_LAS v4i*)(base), *(const PG8_LAS v4i*)((base) + 1024), 0, 1, 2, 3, 4, 5, 6, 7)
#define PG8_LDA(dst, b, h) do { _Pragma("unroll") for (int m = 0; m < 4; ++m) dst[m] = PG8_LD32(lds + PG8_SA(b, h) + aoff + m * 2048); } while (0)
#define PG8_LDB(dst, b, h) do { _Pragma("unroll") for (int n = 0; n < 2; ++n) dst[n] = PG8_LD32(lds + PG8_SB(b, h) + boff + n * 2048); } while (0)
#define PG8_LO(x) __builtin_bit_cast(bf16x8, __builtin_shufflevector((x), (x), 0, 1, 2, 3))
#define PG8_HI(x) __builtin_bit_cast(bf16x8, __builtin_shufflevector((x), (x), 4, 5, 6, 7))
#define PG8_MMA(ai, bj, At, Bt) do { __builtin_amdgcn_s_setprio(1); _Pragma("unroll") for (int m = 0; m < 4; ++m) _Pragma("unroll") for (int n = 0; n < 2; ++n) { \
        if constexpr (FP8) acc[ai][bj][m][n] = __builtin_amdgcn_mfma_scale_f32_16x16x128_f8f6f4(Bt[n], At[m], acc[ai][bj][m][n], 0, 0, 0, 0, 0, 0);   \
        else { acc[ai][bj][m][n] = __builtin_amdgcn_mfma_f32_16x16x32_bf16(PG8_LO(Bt[n]), PG8_LO(At[m]), acc[ai][bj][m][n], 0, 0, 0); \
               acc[ai][bj][m][n] = __builtin_amdgcn_mfma_f32_16x16x32_bf16(PG8_HI(Bt[n]), PG8_HI(At[m]), acc[ai][bj][m][n], 0, 0, 0); } } \
        __builtin_amdgcn_s_setprio(0); } while (0)
#define PG8_WAIT_V(n) asm volatile("s_waitcnt vmcnt(" #n ")" ::: "memory")
#define PG8_WAIT_L(n) asm volatile("s_waitcnt lgkmcnt(" #n ")" ::: "memory")
#define PG8_BAR __builtin_amdgcn_s_barrier()
#define PG8_SCHED __builtin_amdgcn_sched_barrier(0)
    Unit cur, nxt; int ui = 0;
    if (!S.next(0, cur)) return;
    f32x4 acc[2][2][4][2];
#pragma unroll
    for (int a = 0; a < 2; ++a)
#pragma unroll
        for (int b = 0; b < 2; ++b)
#pragma unroll
            for (int m = 0; m < 4; ++m)
#pragma unroll
                for (int n = 0; n < 2; ++n) acc[a][b][m][n] = (f32x4){0.f, 0.f, 0.f, 0.f};
    v8i At[4], B0[2], B1[2];
    unsigned vo0[2], vo1[2];
    PG8_LAS u32x4* const svn = (PG8_LAS u32x4*)(lds + XS_OFF) + tid;
    PG8_LAS u32x4* const smeta = (PG8_LAS u32x4*)(lds + XM_OFF + tid * 32);
    constexpr bool HAS_META = sizeof(typename Epi::Meta) > 1;
    bool has_next = S.next(1, nxt);
    { typename AOff::Pre pc; PG8_APRE(cur, pc); PG8_AFIN(cur, pc, vo0, vo1);
      unsigned vn0[2], vn1[2];
      if (has_next) { typename AOff::Pre pn; PG8_APRE(nxt, pn); PG8_AFIN(nxt, pn, vn0, vn1); } else { vn0[0] = vo0[0]; vn0[1] = vo0[1]; vn1[0] = vo1[0]; vn1[1] = vo1[1]; }
      *svn = (u32x4){vn0[0], vn0[1], vn1[0], vn1[1]}; }
    if constexpr (HAS_META) { PG8_LANE(fr_, fq_); (void)fq_; const typename Epi::Meta m0 = E.meta_load(cur, wr, fr_); smeta[0] = m0.lo; smeta[1] = m0.hi; }
    unsigned cB = (unsigned)cur.pn * tstep;
    PG8_STAGE(PG8_SB(0, 0), Bb, cB, voffB); PG8_STAGE(PG8_SB(0, 1), Bb, cB + hstep, voffB); PG8_STAGE(PG8_SA(0, 0), Ab, 0u, vo0); PG8_STAGE(PG8_SA(0, 1), Ab, 0u, vo1);
    if (wr == 1) PG8_BAR;
    PG8_WAIT_V(2); PG8_BAR;
    PG8_STAGE(PG8_SB(1, 0), Bb, cB + kstep, voffB); PG8_STAGE(PG8_SA(1, 0), Ab, kstep, vo0); PG8_STAGE(PG8_SB(1, 1), Bb, cB + hstep + kstep, voffB);
    PG8_WAIT_V(6); PG8_BAR;
    for (;;) {
        const unsigned nB = has_next ? (unsigned)nxt.pn * tstep : cB;
#pragma clang loop unroll(disable)
        for (int t = 0; t < nt; t += 2) {
            const bool last = (t == nt - 2);
            if constexpr (Epi::MIDSCALE) { if (t == nt / 2) { PG8_LANE(fr_, fq_); E.midscale(acc, cur, wr, wc, fr_, fq_); } }
            const unsigned k1 = (unsigned)(t + 1) * kstep, k2 = last ? 0u : (unsigned)(t + 2) * kstep, k3 = k2 + kstep;
            const unsigned b2 = last ? nB : cB + (unsigned)(t + 2) * kstep, b3 = b2 + kstep;
            PG8_LDB(B0, 0, 0); PG8_LDB(B1, 0, 1); PG8_SCHED; PG8_LDA(At, 0, 0); PG8_STAGE(PG8_SA(1, 1), Ab, k1, vo1);
            PG8_WAIT_V(8); PG8_WAIT_L(0); PG8_BAR; PG8_MMA(0, 0, At, B0); PG8_MMA(0, 1, At, B1); PG8_BAR; PG8_SCHED;
            if (last) { PG8_LAS u32x4* sp_ = svn; asm volatile("" : "+v"(sp_));
                const u32x4 v = *sp_; vo0[0] = v.x; vo0[1] = v.y; vo1[0] = v.z; vo1[1] = v.w; }
            PG8_LDA(At, 0, 1); PG8_STAGE(PG8_SB(0, 0), Bb, b2, voffB); PG8_STAGE(PG8_SB(0, 1), Bb, b2 + hstep, voffB); PG8_STAGE(PG8_SA(0, 0), Ab, k2, vo0);
            PG8_WAIT_V(8); PG8_WAIT_L(0); PG8_BAR; PG8_MMA(1, 0, At, B0); PG8_MMA(1, 1, At, B1); PG8_BAR; PG8_SCHED;
            PG8_LDB(B0, 1, 0); PG8_LDB(B1, 1, 1); PG8_SCHED; PG8_LDA(At, 1, 0); PG8_STAGE(PG8_SA(0, 1), Ab, k2, vo1);
            PG8_WAIT_V(8); PG8_WAIT_L(0); PG8_BAR; PG8_MMA(0, 0, At, B0); PG8_MMA(0, 1, At, B1); PG8_BAR; PG8_SCHED;
            PG8_LDA(At, 1, 1); PG8_STAGE(PG8_SB(1, 0), Bb, b3, voffB); PG8_STAGE(PG8_SB(1, 1), Bb, b3 + hstep, voffB); PG8_STAGE(PG8_SA(1, 0), Ab, k3, vo0);
            PG8_WAIT_V(8); PG8_WAIT_L(0); PG8_BAR; PG8_MMA(1, 0, At, B0); PG8_MMA(1, 1, At, B1); PG8_BAR; PG8_SCHED;
        }
        if constexpr (ALIGN_EPI) { if (wr == 0) PG8_BAR; }
        Unit nn; const bool has2 = has_next && S.next(ui + 2, nn);
        typename Epi::Meta mnext;
        { PG8_LANE(fr_, fq_);
          typename Epi::Meta meta; if constexpr (HAS_META) { PG8_LAS u32x4* sp_ = smeta; asm volatile("" : "+v"(sp_)); meta.lo = sp_[0]; meta.hi = sp_[1]; }
          if (has_next) mnext = E.meta_load(nxt, wr, fr_);
          if (has2) { typename AOff::Pre pnn; PG8_APRE(nn, pnn); unsigned vn0[2], vn1[2]; PG8_AFIN(nn, pnn, vn0, vn1); *svn = (u32x4){vn0[0], vn0[1], vn1[0], vn1[1]}; }
          E(acc, cur, wr, wc, fr_, fq_, meta); }
        if (!has_next) break;
        if constexpr (HAS_META) { smeta[0] = mnext.lo; smeta[1] = mnext.hi; }
#pragma unroll
        for (int a = 0; a < 2; ++a)
#pragma unroll
            for (int b = 0; b < 2; ++b)
#pragma unroll
                for (int m = 0; m < 4; ++m)
#pragma unroll
                    for (int n = 0; n < 2; ++n) acc[a][b][m][n] = (f32x4){0.f, 0.f, 0.f, 0.f};
        cur = nxt; nxt = nn; has_next = has2; cB = nB; ++ui;
        if constexpr (ALIGN_EPI) { if (wr == 1) PG8_BAR; }
    }
    PG8_WAIT_V(0);
    if constexpr (!ALIGN_EPI) { if (wr == 0) PG8_BAR; }
    PG8_BAR;
#undef PG8_APRE
#undef PG8_AFIN
#undef PG8_LANE
#undef PG8_SA
#undef PG8_SB
#undef PG8_STAGE
#undef PG8_LDA
#undef PG8_LDB
#undef PG8_MMA
#undef PG8_LO
#undef PG8_HI
#undef PG8_LD32
#undef PG8_WAIT_V
#undef PG8_WAIT_L
#undef PG8_BAR
#undef PG8_SCHED
}
}


#define XB_TMO      128
#define XB_XCNT(j)  (256  + 64 * (j))
#define XB_XSUB(j)  (1280 + 64 * (j))
#define XB_XGEN(j)  (2304 + 64 * (j))
#define XB_TOP      3328
#define XB_TOPGEN   3392
#define XCD_BAR_WORDS 3456
#define XB_SPIN_CAP (1u << 18)
__device__ __forceinline__ unsigned xb_ld(unsigned* p)              { return __hip_atomic_load(p, __ATOMIC_RELAXED, __HIP_MEMORY_SCOPE_AGENT); }
__device__ __forceinline__ unsigned xb_add(unsigned* p, unsigned v) { return __hip_atomic_fetch_add(p, v, __ATOMIC_RELAXED, __HIP_MEMORY_SCOPE_AGENT); }
__device__ __forceinline__ unsigned xb_xcc_id() { return (unsigned)__builtin_amdgcn_s_getreg((3 << 11) | 20) & 0xFu; }
#define XB_SPIN(cond, bar) do { unsigned _sp = 0; while (cond) { __builtin_amdgcn_s_sleep(1); \
    if ((++_sp & 255u) == 0u) { if (xb_ld(&(bar)[XB_TMO])) break; if (_sp > XB_SPIN_CAP) { atomicAdd(&(bar)[XB_TMO], 1u); break; } } } } while (0)
struct XcdBarrier { unsigned* bar; unsigned x; volatile PG8_LAS unsigned* st; };
__device__ __forceinline__ XcdBarrier xcd_barrier_post(unsigned* bar, volatile PG8_LAS unsigned* st) {
    XcdBarrier b; b.bar = bar; b.x = xb_xcc_id(); b.st = st;
    if (threadIdx.x == 0) (void)xb_add(&bar[XB_XCNT(b.x)], 1u);
    return b;
}
__device__ __forceinline__ void xcd_barrier_complete(unsigned* bar, unsigned x, unsigned& nloc, unsigned& nx) {
    const unsigned G = gridDim.x * gridDim.y * gridDim.z;
    unsigned sum, cnt, mine, sp = 0u;
    for (;;) {
        sum = 0u; cnt = 0u; mine = 0u;
#pragma unroll
        for (unsigned j = 0; j < 16; ++j) { const unsigned c = xb_ld(&bar[XB_XCNT(j)]); sum += c; cnt += (c > 0u) ? 1u : 0u; mine = (j == x) ? c : mine; }
        if (sum == G) break;
        __builtin_amdgcn_s_sleep(1);
        if ((++sp & 255u) == 0u) { if (xb_ld(&bar[XB_TMO])) break; if (sp > XB_SPIN_CAP) { atomicAdd(&bar[XB_TMO], 1u); break; } }
    }
    nloc = mine > 0u ? mine : 1u; nx = cnt > 0u ? cnt : 1u;
}
__device__ __forceinline__ void xcd_barrier(const XcdBarrier& b) {
    asm volatile("s_waitcnt vmcnt(0)" ::: "memory");
    __syncthreads();
    if (threadIdx.x == 0) {
        unsigned* bar = b.bar;
        __builtin_amdgcn_s_waitcnt(0);
        unsigned nloc = b.st[0], nx = b.st[1];
        if (nloc == 0u) { xcd_barrier_complete(bar, b.x, nloc, nx); b.st[0] = nloc; b.st[1] = nx; }
        const unsigned old = xb_add(&bar[XB_XSUB(b.x)], 1u);
        const unsigned gen = old / nloc;
        if (old + 1u == (gen + 1u) * nloc) {
            __builtin_amdgcn_fence(__ATOMIC_RELEASE, "agent");
            asm volatile("s_waitcnt vmcnt(0)" ::: "memory");
            const unsigned og = xb_add(&bar[XB_TOP], 1u);
            const unsigned tg = og / nx;
            if (og + 1u == (tg + 1u) * nx) xb_add(&bar[XB_TOPGEN], 1u);
            else XB_SPIN(xb_ld(&bar[XB_TOPGEN]) == tg, bar);
            __builtin_amdgcn_fence(__ATOMIC_ACQUIRE, "agent");
            xb_add(&bar[XB_XGEN(b.x)], 1u);
            asm volatile("s_waitcnt vmcnt(0)" ::: "memory");
        } else {
            XB_SPIN(xb_ld(&bar[XB_XGEN(b.x)]) == gen, bar);
            __builtin_amdgcn_fence(__ATOMIC_ACQUIRE, "agent");
            asm volatile("s_waitcnt vmcnt(0)" ::: "memory");
        }
    }
    __syncthreads();
}

struct TJob { const float* src; int ld; unsigned char* dst; int lddst; float sc; const float* sk; int fp8; };
__device__ __forceinline__ bool tjob_decode(const Params& p, int q, TJob& j) {
    constexpr int N_IN = 16 * 80, N_OUT = 16 * 32, N_G = 32 * 128;
    if (q < N_IN) { const int tr = q / 80, tc = q % 80; j.src = p.w_in + (size_t)tr * 128 * DIN + tc * 64; j.ld = DIN; j.dst = p.ws + OFF_WIN + ((size_t)tc * 64 * D_ + tr * 128) * 2; j.lddst = D_ * 2; j.sc = 1.f; j.sk = nullptr; j.fp8 = 0; return true; } q -= N_IN;
    if (q < N_OUT) { const int tr = q / 32, tc = q % 32; j.src = p.w_out + (size_t)tr * 128 * D_ + tc * 64; j.ld = D_; j.dst = p.ws + OFF_WOUT + ((size_t)tc * 64 * D_ + tr * 128) * 2; j.lddst = D_ * 2; j.sc = 1.f;
        j.sk = (tr < 8 ? p.g_a + tr * 128 : p.g_b + (tr - 8) * 128); j.fp8 = 0; return true; } q -= N_OUT;
    if (q < 2 * N_G) { const int up = q >= N_G; if (up) q -= N_G; const int e = q >> 7, rem = q & 127, tr = rem >> 3, tc = rem & 7, c0 = tc * 64;
        j.src = (up ? p.ewu : p.ewg) + (size_t)e * D_ * DE + (size_t)tr * 128 * DE + c0; j.ld = DE;
        j.dst = p.ws + OFF_WGU + (size_t)e * 1024 * D_ + (size_t)((c0 >> 7) * 256 + (up ? 128 : 0) + (c0 & 127)) * D_ + tr * 128; j.lddst = D_; j.sc = WGU_SCALE; j.sk = p.g_ffn + tr * 128; j.fp8 = 1; return true; } q -= 2 * N_G;
    if (q < N_G) { const int e = q >> 7, rem = q & 127, tr = rem >> 5, tc = rem & 31;
        j.src = p.ewd + (size_t)e * DE * D_ + (size_t)tr * 128 * D_ + tc * 64; j.ld = D_; j.dst = p.ws + OFF_WD + (size_t)e * D_ * DE + (size_t)tc * 64 * DE + tr * 128; j.lddst = DE; j.sc = WD_SCALE; j.sk = nullptr; j.fp8 = 1; return true; }
    return false;
}
constexpr int N_TJOBS_DENSE = 16 * 80 + 16 * 32, N_TJOBS_GU = N_TJOBS_DENSE + 2 * 32 * 128, N_TJOBS = N_TJOBS_GU + 32 * 128;
struct TRegs { f32x4 v[4]; };
__device__ __forceinline__ void tjob_load(const TJob& j, int tid, TRegs& r) {
    const float* sp = j.src + (size_t)(tid >> 2) * j.ld + (tid & 3) * 16;
#pragma unroll
    for (int q = 0; q < 4; ++q) r.v[q] = *(const f32x4*)(sp + 4 * q);
}
__device__ __forceinline__ void tjob_finish(const TJob& j, int tid, const TRegs& r, float* lt) {
    { const int rr = tid >> 2, cc = (tid & 3) * 16; const float f = j.sk ? j.sc * j.sk[rr] : j.sc;
#pragma unroll
      for (int q = 0; q < 4; ++q)
#pragma unroll
          for (int e = 0; e < 4; ++e) lt[rr * 65 + cc + 4 * q + e] = r.v[q][e] * f; }
    __syncthreads();
    { const int c = tid >> 3, rr = (tid & 7) * 16; float v[16];
#pragma unroll
      for (int q = 0; q < 16; ++q) v[q] = lt[(rr + q) * 65 + c];
      unsigned char* d = j.dst + (size_t)c * j.lddst;
      if (j.fp8) { u32x4 w; w.x = pk4_fp8(v[0], v[1], v[2], v[3]); w.y = pk4_fp8(v[4], v[5], v[6], v[7]); w.z = pk4_fp8(v[8], v[9], v[10], v[11]); w.w = pk4_fp8(v[12], v[13], v[14], v[15]);
          *(u32x4*)(d + rr) = w; }
      else { u32x4 w0, w1; w0.x = cvt_pk_bf16(v[0], v[1]); w0.y = cvt_pk_bf16(v[2], v[3]); w0.z = cvt_pk_bf16(v[4], v[5]); w0.w = cvt_pk_bf16(v[6], v[7]);
          w1.x = cvt_pk_bf16(v[8], v[9]); w1.y = cvt_pk_bf16(v[10], v[11]); w1.z = cvt_pk_bf16(v[12], v[13]); w1.w = cvt_pk_bf16(v[14], v[15]);
          *(u32x4*)(d + rr * 2) = w0; *(u32x4*)(d + rr * 2 + 16) = w1; } }
}
__device__ __forceinline__ void run_tjobs(const Params& p, unsigned char* lds, int qlo, int qhi, int k0 = 0, int k1 = 1 << 20, int first = -1, int stride = 0) {
    const int tid = opaque_tid(), nb = stride > 0 ? stride : (int)gridDim.x;
    float* lt0 = (float*)lds; float* lt1 = lt0 + 128 * 65;
    TJob j0, j1, j2; TRegs r0, r1, r2;
    int k = k0; const int qb = qlo + (first >= 0 ? first : (int)blockIdx.x);
#define TJ_OK(kk, jj) ((kk) < k1 && qb + (kk) * nb < qhi && tjob_decode(p, qb + (kk) * nb, jj))
    bool h0 = TJ_OK(k, j0), h1 = TJ_OK(k + 1, j1), h2 = TJ_OK(k + 2, j2);
    if (h0) tjob_load(j0, tid, r0); if (h1) tjob_load(j1, tid, r1); if (h2) tjob_load(j2, tid, r2);
    while (h0) {
        tjob_finish(j0, tid, r0, lt0); k += 3; h0 = TJ_OK(k, j0); if (h0) tjob_load(j0, tid, r0);
        if (!h1) break;
        tjob_finish(j1, tid, r1, lt1); h1 = TJ_OK(k + 1, j1); if (h1) tjob_load(j1, tid, r1);
        if (!h2) break;
        tjob_finish(j2, tid, r2, lt0); h2 = TJ_OK(k + 2, j2); if (h2) tjob_load(j2, tid, r2);
        if (!h0) break;
        tjob_finish(j0, tid, r0, lt1); k += 3; h0 = TJ_OK(k, j0); if (h0) tjob_load(j0, tid, r0);
        if (!h1) break;
        tjob_finish(j1, tid, r1, lt0); h1 = TJ_OK(k + 1, j1); if (h1) tjob_load(j1, tid, r1);
        if (!h2) break;
        tjob_finish(j2, tid, r2, lt1); h2 = TJ_OK(k + 2, j2); if (h2) tjob_load(j2, tid, r2);
    }
#undef TJ_OK
    __syncthreads();
}
__device__ __forceinline__ void phase0(const Params& p, unsigned char* lds) {
    const int tid = opaque_tid(), nb = gridDim.x, bid = blockIdx.x, wid = tid >> 6, lane = tid & 63;
    { float* z = (float*)(p.ws + OFF_SSQ);
      for (int i = bid * NTHR + tid; i < 3 * T_ + 64; i += nb * NTHR) z[i] = 0.f;
      if (DUP_PHASE >= 2 && DUP_PHASE <= 4) { float* zd = (float*)(p.ws + OFF_SSQ + (OFF_DUMMY - OFF_SSQ)); for (int i = bid * NTHR + tid; i < 3 * T_ + 64; i += nb * NTHR) zd[i] = 0.f; } }
    { bf16_t* wrt = (bf16_t*)(p.ws + OFF_WR);
      for (int i = bid * NTHR + tid; i < 48 * D_; i += nb * NTHR) {
          const int o = i >> 11, k = i & 2047; float v = 0.f;
          if (o < 4) v = p.rgw[k * 4 + o]; else if (o < 36) v = p.rew[k * 32 + (o - 4)];
          wrt[i] = (bf16_t)(cvt_pk_bf16(v * p.g_ffn[k], 0.f) & 0xffffu); } }
    { bf16_t* xn = (bf16_t*)(p.ws + OFF_B);
      for (int row = bid * 8 + wid; row < T_; row += nb * 8) {
          const float* xr = p.x + (size_t)row * D_;
          f32x4 v[8]; float s = 0.f;
#pragma unroll
          for (int i = 0; i < 8; ++i) { v[i] = *(const f32x4*)(xr + i * 256 + lane * 4); s += (v[i][0] * v[i][0] + v[i][1] * v[i][1]) + (v[i][2] * v[i][2] + v[i][3] * v[i][3]); }
          const float rstd = rsqrtf(wave_sum(s) * (1.f / D_) + EPS);
#pragma unroll
          for (int i = 0; i < 8; ++i) { const f32x4 g = *(const f32x4*)(p.norm_mix_g + i * 256 + lane * 4); const f32x4 o = v[i] * rstd * g;
              u32x2 w; w.x = cvt_pk_bf16(o[0], o[1]); w.y = cvt_pk_bf16(o[2], o[3]); *(u32x2*)(xn + (size_t)row * D_ + i * 256 + lane * 4) = w; } } }
    run_tjobs(p, lds, 0, N_TJOBS_DENSE);
}

__device__ __forceinline__ int side_rounds(int nb) { return (N_TJOBS_GU - N_TJOBS_DENSE + nb - 1) / nb; }
__device__ __forceinline__ void phase1(const Params& p, unsigned char* lds) {
    const Epi1 E{p.ws};
    pg8::StaticOrder S; S.init(T_, DIN, gridDim.x, blockIdx.x); const pg8::AOffDirect AO{D_};
    const int nu = S.count(), col = blockIdx.x & 3, split = col == 0 ? 0 : col == 1 ? (2 * nu) / 5 : col == 2 ? (3 * nu) / 5 : nu;
    const int kr = side_rounds(gridDim.x), k1 = (2 * kr) / 3;
    S.i0 = 0; S.i1 = split;
    pg8::gemm_phase<Epi1, pg8::StaticOrder, pg8::AOffDirect, true>((PG8_LAS unsigned char*)lds, (const bf16_t*)(p.ws + OFF_B), (const bf16_t*)(p.ws + OFF_WIN), D_, S, AO, E);
    run_tjobs(p, lds, N_TJOBS_DENSE, N_TJOBS_GU, 0, k1);
    S.i0 = split; S.i1 = nu;
    pg8::gemm_phase<Epi1, pg8::StaticOrder, pg8::AOffDirect, true>((PG8_LAS unsigned char*)lds, (const bf16_t*)(p.ws + OFF_B), (const bf16_t*)(p.ws + OFF_WIN), D_, S, AO, E);
}

__device__ __forceinline__ void mixer_gmlp_item(const Params& p, unsigned char* lds, int item, size_t so) {
    const int tid = opaque_tid(), wid = tid >> 6, lane = tid & 63, fr = lane & 15, fq = lane >> 4;
    const int h = item & 7, t0 = (item >> 3) * 128;
    const bf16_t* P = (const bf16_t*)(p.ws + OFF_A); bf16_t* Y = (bf16_t*)(p.ws + OFF_B); float* ssq_a = (float*)(p.ws + OFF_SSQ + so);
    bf16_t* Vt = (bf16_t*)lds;
    bf16_t* Wl = Vt + 128 * 136;
    float* rs = (float*)(Wl + 128 * 136);
    { const int j = tid >> 2, dc = (tid & 3) * 32;
      const u32x4* src = (const u32x4*)(P + (size_t)(t0 + j) * DIN + 1024 + h * 128 + dc);
      u32x4 v[4]; float s = 0.f;
#pragma unroll
      for (int q = 0; q < 4; ++q) { v[q] = src[q];
#pragma unroll
          for (int w = 0; w < 4; ++w) { const float lo = bflo(v[q][w]), hi = bfhi(v[q][w]); s += lo * lo + hi * hi; } }
      s += __shfl_xor(s, 1); s += __shfl_xor(s, 2);
      if ((tid & 3) == 0) rs[j] = rsqrtf(s * (1.f / 128.f) + EPS);
#pragma unroll
      for (int q = 0; q < 4; ++q)
#pragma unroll
          for (int w = 0; w < 4; ++w) { const int d = dc + q * 8 + w * 2; Vt[d * 136 + j] = (bf16_t)(v[q][w] & 0xffffu); Vt[(d + 1) * 136 + j] = (bf16_t)(v[q][w] >> 16); } }
    __syncthreads();
    { const int i = tid >> 2, jc = (tid & 3) * 32;
      const f32x4* src = (const f32x4*)(p.gmlp_ws + (size_t)h * 16384 + i * 128 + jc);
      const bool live = (i >> 6) >= (jc >> 6);
#pragma unroll
      for (int q = 0; q < 4; ++q) { f32x4 w0 = src[2 * q], w1 = src[2 * q + 1];
          const f32x4 r0 = *(const f32x4*)(rs + jc + 8 * q), r1 = *(const f32x4*)(rs + jc + 8 * q + 4);
          w0 = live ? w0 * r0 : (f32x4){0.f, 0.f, 0.f, 0.f}; w1 = live ? w1 * r1 : (f32x4){0.f, 0.f, 0.f, 0.f};
          u32x4 o; o.x = cvt_pk_bf16(w0[0], w0[1]); o.y = cvt_pk_bf16(w0[2], w0[3]); o.z = cvt_pk_bf16(w1[0], w1[1]); o.w = cvt_pk_bf16(w1[2], w1[3]);
          *(u32x4*)(Wl + i * 136 + jc + 8 * q) = o; } }
    __syncthreads();
    f32x4 acc[8];
#pragma unroll
    for (int n = 0; n < 8; ++n) acc[n] = (f32x4){0.f, 0.f, 0.f, 0.f};
    const int ksteps = (wid < 4) ? 2 : 4;
    for (int ks = 0; ks < ksteps; ++ks) {
        const bf16x8 bw = *(const bf16x8*)(Wl + (16 * wid + fr) * 136 + ks * 32 + fq * 8);
#pragma unroll
        for (int n = 0; n < 8; ++n) { const bf16x8 av = *(const bf16x8*)(Vt + (16 * n + fr) * 136 + ks * 32 + fq * 8);
            acc[n] = __builtin_amdgcn_mfma_f32_16x16x32_bf16(av, bw, acc[n], 0, 0, 0); }
    }
    { const int i = 16 * wid + fr, t = t0 + i; const float bias = p.gmlp_bs[h * 128 + i]; float ss = 0.f;
#pragma unroll
      for (int n = 0; n < 8; ++n) { const int c = h * 128 + 16 * n + 4 * fq;
          const f32x4 g = *(const f32x4*)(p.v_norm_g + c); const u32x2 uu = *(const u32x2*)(P + (size_t)t * DIN + c);
          const float y0 = bflo(uu.x) * (acc[n][0] * g[0] + bias), y1 = bfhi(uu.x) * (acc[n][1] * g[1] + bias), y2 = bflo(uu.y) * (acc[n][2] * g[2] + bias), y3 = bfhi(uu.y) * (acc[n][3] * g[3] + bias);
          ss += (y0 * y0 + y1 * y1) + (y2 * y2 + y3 * y3);
          u32x2 w; w.x = cvt_pk_bf16(y0, y1); w.y = cvt_pk_bf16(y2, y3); *(u32x2*)(Y + (size_t)t * D_ + c) = w; }
      ss += __shfl_xor(ss, 16); ss += __shfl_xor(ss, 32);
      if (fq == 0) atomicAdd(ssq_a + t, ss); }
    __syncthreads();
}
__device__ __forceinline__ void mixer_conv_item(const Params& p, int item, size_t so) {
    const int tid = opaque_tid(), cl = tid & 31, ts = tid >> 5;
    const int c = (item & 3) * 256 + cl * 8, tbeg = (item >> 2) * 128 + ts * 8;
    const bf16_t* P = (const bf16_t*)(p.ws + OFF_A); bf16_t* Y = (bf16_t*)(p.ws + OFF_B); float* ssq_b = (float*)(p.ws + OFF_SSQ + so) + T_;
    float w0[8], w1[8], w2[8], z1[8], z2[8];
    { const f32x4 a0 = *(const f32x4*)(p.conv_w + c), a1 = *(const f32x4*)(p.conv_w + c + 4), b0 = *(const f32x4*)(p.conv_w + 1024 + c), b1 = *(const f32x4*)(p.conv_w + 1024 + c + 4),
                  c0 = *(const f32x4*)(p.conv_w + 2048 + c), c1 = *(const f32x4*)(p.conv_w + 2048 + c + 4);
#pragma unroll
      for (int q = 0; q < 4; ++q) { w0[q] = a0[q]; w0[4 + q] = a1[q]; w1[q] = b0[q]; w1[4 + q] = b1[q]; w2[q] = c0[q]; w2[4 + q] = c1[q]; } }
#pragma unroll
    for (int q = 0; q < 8; ++q) { z1[q] = 0.f; z2[q] = 0.f; }
    if ((tbeg % SEQ) != 0) {
        const u32x4 ca = *(const u32x4*)(P + (size_t)(tbeg - 1) * DIN + 3072 + c), ha = *(const u32x4*)(P + (size_t)(tbeg - 1) * DIN + 4096 + c);
        const u32x4 cb = *(const u32x4*)(P + (size_t)(tbeg - 2) * DIN + 3072 + c), hb2 = *(const u32x4*)(P + (size_t)(tbeg - 2) * DIN + 4096 + c);
#pragma unroll
        for (int q = 0; q < 4; ++q) { z1[2 * q] = bflo(ca[q]) * bflo(ha[q]); z1[2 * q + 1] = bfhi(ca[q]) * bfhi(ha[q]); z2[2 * q] = bflo(cb[q]) * bflo(hb2[q]); z2[2 * q + 1] = bfhi(cb[q]) * bfhi(hb2[q]); }
    }
    u32x4 bgA[8], cgA[8], hvA[8];
#pragma unroll
    for (int tt = 0; tt < 8; ++tt) { const bf16_t* pr = P + (size_t)(tbeg + tt) * DIN + c; bgA[tt] = *(const u32x4*)(pr + 2048); cgA[tt] = *(const u32x4*)(pr + 3072); hvA[tt] = *(const u32x4*)(pr + 4096); }
#pragma unroll
    for (int tt = 0; tt < 8; ++tt) {
        const int t = tbeg + tt;
        const u32x4 bg = bgA[tt], cgv = cgA[tt], hv = hvA[tt];
        float z[8], y[8], ss = 0.f;
#pragma unroll
        for (int q = 0; q < 4; ++q) { z[2 * q] = bflo(cgv[q]) * bflo(hv[q]); z[2 * q + 1] = bfhi(cgv[q]) * bfhi(hv[q]); }
#pragma unroll
        for (int q = 0; q < 4; ++q) {
            y[2 * q] = bflo(bg[q]) * (w0[2 * q] * z2[2 * q] + w1[2 * q] * z1[2 * q] + w2[2 * q] * z[2 * q]);
            y[2 * q + 1] = bfhi(bg[q]) * (w0[2 * q + 1] * z2[2 * q + 1] + w1[2 * q + 1] * z1[2 * q + 1] + w2[2 * q + 1] * z[2 * q + 1]); }
#pragma unroll
        for (int q = 0; q < 8; ++q) { ss += y[q] * y[q]; z2[q] = z1[q]; z1[q] = z[q]; }
        u32x4 w; w.x = cvt_pk_bf16(y[0], y[1]); w.y = cvt_pk_bf16(y[2], y[3]); w.z = cvt_pk_bf16(y[4], y[5]); w.w = cvt_pk_bf16(y[6], y[7]);
        *(u32x4*)(Y + (size_t)t * D_ + 1024 + c) = w;
        ss += __shfl_xor(ss, 1); ss += __shfl_xor(ss, 2); ss += __shfl_xor(ss, 4); ss += __shfl_xor(ss, 8); ss += __shfl_xor(ss, 16);
        if (cl == 0) atomicAdd(ssq_b + t, ss);
    }
}
__device__ __forceinline__ void phase2(const Params& p, unsigned char* lds, size_t so = 0) {
    for (int it = blockIdx.x; it < 512 + 1024; it += gridDim.x) { if (it < 512) mixer_conv_item(p, it, so); else mixer_gmlp_item(p, lds, it - 512, so); }
}

__device__ __forceinline__ void phase3(const Params& p, unsigned char* lds, size_t so = 0) {
    pg8::StaticOrder S; S.init(T_, D_, gridDim.x, blockIdx.x); const pg8::AOffDirect AO{D_};
    PG8_LAS float* rsl = (PG8_LAS float*)((PG8_LAS unsigned char*)lds + RS_OFF);
    { const float* ssq = (const float*)(p.ws + OFF_SSQ); const int tid = opaque_tid();
      for (int i = 0; i < RS_UNITS; ++i) { Unit u; if (!S.next(i, u)) break;
          if (tid < 256) { const int row = u.pm * 256 + tid; const float va = ssq[row] * (1.f / 1024.f) + EPS, vb = ssq[T_ + row] * (1.f / 1024.f) + EPS;
              rsl[(i * 256 + tid) * 2] = __builtin_amdgcn_sqrtf(vb * __builtin_amdgcn_rcpf(va)); rsl[(i * 256 + tid) * 2 + 1] = __builtin_amdgcn_rsqf(vb); } }
      __syncthreads(); }
    const Epi2 E{p.x, p.ws, so, rsl};
    const int kr = side_rounds(gridDim.x), k0 = (2 * kr) / 3; const bool side = (so == 0);
    const int col = blockIdx.x & 3, km = k0 + ((kr - k0) * col + 1) / 3;
    if (side) run_tjobs(p, lds, N_TJOBS_DENSE, N_TJOBS_GU, k0, km);
    pg8::gemm_phase<Epi2, pg8::StaticOrder, pg8::AOffDirect, true>((PG8_LAS unsigned char*)lds, (const bf16_t*)(p.ws + OFF_B), (const bf16_t*)(p.ws + OFF_WOUT), D_, S, AO, E);
    if (side) run_tjobs(p, lds, N_TJOBS_DENSE, N_TJOBS_GU, km, kr);
}

__device__ __forceinline__ void route_item(const Params& p, unsigned char* lds, int item, size_t so) {
    const int tid = opaque_tid(), wid = tid >> 6, lane = tid & 63, fr = lane & 15, fq = lane >> 4;
    float* lg = (float*)lds;
    float* ls = lg + 8 * 64 * 48;
    int* lcnt = (int*)(ls + 64 * 48); int* lbase = lcnt + 32;
    const bf16_t* hb = (const bf16_t*)(p.ws + OFF_HB); const bf16_t* wrt = (const bf16_t*)(p.ws + OFF_WR);
    const float* ssq_h = (const float*)(p.ws + OFF_SSQ) + 2 * T_;
    int* cnt = (int*)(p.ws + OFF_CNT + so); int* rinfo = (int*)(p.ws + OFF_RINFO + so); float* rw = (float*)(p.ws + OFF_RW + so);
    const int t0 = item * 64;
    if (tid < 32) lcnt[tid] = 0;
    f32x4 acc[4][3];
#pragma unroll
    for (int m = 0; m < 4; ++m)
#pragma unroll
        for (int n = 0; n < 3; ++n) acc[m][n] = (f32x4){0.f, 0.f, 0.f, 0.f};
    const bf16_t* ap = hb + (size_t)(t0 + fr) * D_ + wid * 256 + fq * 8; const bf16_t* bp = wrt + (size_t)fr * D_ + wid * 256 + fq * 8;
#pragma unroll 4
    for (int ks = 0; ks < 8; ++ks) {
        bf16x8 a[4], b[3];
#pragma unroll
        for (int m = 0; m < 4; ++m) a[m] = *(const bf16x8*)(ap + (size_t)m * 16 * D_ + ks * 32);
#pragma unroll
        for (int n = 0; n < 3; ++n) b[n] = *(const bf16x8*)(bp + (size_t)n * 16 * D_ + ks * 32);
#pragma unroll
        for (int m = 0; m < 4; ++m)
#pragma unroll
            for (int n = 0; n < 3; ++n) acc[m][n] = __builtin_amdgcn_mfma_f32_16x16x32_bf16(a[m], b[n], acc[m][n], 0, 0, 0);
    }
#pragma unroll
    for (int m = 0; m < 4; ++m)
#pragma unroll
        for (int n = 0; n < 3; ++n)
#pragma unroll
            for (int j = 0; j < 4; ++j) lg[(wid * 64 + m * 16 + 4 * fq + j) * 48 + 16 * n + fr] = acc[m][n][j];
    __syncthreads();
    for (int i = tid; i < 64 * 48; i += NTHR) { float v = 0.f;
#pragma unroll
        for (int w = 0; w < 8; ++w) v += lg[w * 64 * 48 + i];
        ls[i] = v; }
    __syncthreads();
    int e0 = 0, e1 = 0, r0 = 0, r1 = 0; float g0 = 0.f, g1 = 0.f, rsc = 0.f; const int t = t0 + tid;
    if (tid < 64) {
        const float* l0 = ls + tid * 48; const float rstd = rsqrtf(ssq_h[t] * (1.f / D_) + EPS); rsc = rstd * (1.f / WGU_SCALE);
        float gm = -3.0e38f; int gi = 0; float gl[4];
#pragma unroll
        for (int o = 0; o < 4; ++o) { gl[o] = l0[o] * rstd + p.rgb[o]; if (gl[o] > gm) { gm = gl[o]; gi = o; } }
        float gs = 0.f;
#pragma unroll
        for (int o = 0; o < 4; ++o) gs += __expf(gl[o] - gm);
        const float pg = 1.f / gs;
        float b1 = -3.0e38f, b2 = -3.0e38f; int i1 = 0, i2 = 0;
        for (int q = 0; q < 8; ++q) { const float v = l0[4 + gi * 8 + q] * rstd + p.reb[gi * 8 + q];
            if (v > b1) { b2 = b1; i2 = i1; b1 = v; i1 = q; } else if (v > b2) { b2 = v; i2 = q; } }
        const float wa = 1.f / (1.f + __expf(b2 - b1));
        e0 = gi * 8 + i1; e1 = gi * 8 + i2; g0 = pg * wa; g1 = pg * (1.f - wa);
        r0 = atomicAdd(&lcnt[e0], 1); r1 = atomicAdd(&lcnt[e1], 1);
    }
    __syncthreads();
    if (tid < 32) lbase[tid] = atomicAdd(cnt + tid, lcnt[tid]);
    __syncthreads();
    if (tid < 64) { const int i0 = lbase[e0] + r0, i1 = lbase[e1] + r1;
        rinfo[e0 * LCAP + i0] = (int)((cvt_pk_bf16(g0, 0.f) << 16) | (unsigned)(2 * t)); rinfo[e1 * LCAP + i1] = (int)((cvt_pk_bf16(g1, 0.f) << 16) | (unsigned)(2 * t + 1));
        rw[e0 * LCAP + i0] = rsc; rw[e1 * LCAP + i1] = rsc; }
    __syncthreads();
}
__device__ __forceinline__ void phase4(const Params& p, unsigned char* lds, size_t so = 0) { for (int it = blockIdx.x; it < T_ / 64; it += gridDim.x) route_item(p, lds, it, so); }

__device__ __forceinline__ PG8_LAS int* moe_tables_to_lds(const Params& p, unsigned char* lds) {
    PG8_LAS int* tb = (PG8_LAS int*)((PG8_LAS unsigned char*)lds + LCNT_OFF); const int* cnt = (const int*)(p.ws + OFF_CNT);
    if (threadIdx.x < NE) tb[MT_CNT + threadIdx.x] = __hip_atomic_load(cnt + threadIdx.x, __ATOMIC_RELAXED, __HIP_MEMORY_SCOPE_AGENT);
    __syncthreads();
    if (threadIdx.x == 0) { int pt = 0;
#pragma clang loop unroll(disable)
        for (int e = 0; e < NE; ++e) { const int nt = (tb[MT_CNT + e] + 255) >> 8; tb[MT_PST + e] = pt;
#pragma clang loop unroll(disable)
            for (int i = 0; i < nt; ++i) tb[MT_T2E + pt + i] = e;
            pt += nt; }
        tb[MT_PST + NE] = pt; tb[MT_NT] = pt; }
    __syncthreads();
    return tb;
}
__device__ __forceinline__ void phase5(const Params& p, unsigned char* lds) {
    PG8_LAS int* lc = moe_tables_to_lds(p, lds);
    const Epi5 E{p.ws, lc};
    const pg8::MoeOrder S{lc, 4, (int)gridDim.x, (int)blockIdx.x}; const pg8::AOffGather AO{p.ws, lc, D_ / 2};
    pg8::gemm_phase<Epi5, pg8::MoeOrder, pg8::AOffGather, true, true>((PG8_LAS unsigned char*)lds, (const bf16_t*)(p.ws + OFF_H8), (const bf16_t*)(p.ws + OFF_WGU), D_ / 2, S, AO, E);
    { const int G = gridDim.x, c = blockIdx.x, U = 4 * __builtin_amdgcn_readfirstlane(lc[MT_NT]), rem = U % G;
      if (rem == 0) run_tjobs(p, lds, N_TJOBS_GU, N_TJOBS, 0, 1 << 20, c, G);
      else if (c >= rem) run_tjobs(p, lds, N_TJOBS_GU, N_TJOBS, 0, 1 << 20, c - rem, G - rem); }
}
__device__ __forceinline__ void phase6(const Params& p, unsigned char* lds) {
    PG8_LAS int* lc = moe_tables_to_lds(p, lds);
    const Epi6 E{p.ws, lc};
    const pg8::MoeOrder S{lc, 8, (int)gridDim.x, (int)blockIdx.x}; const pg8::AOffDirect AO{DE / 2};
    pg8::gemm_phase<Epi6, pg8::MoeOrder, pg8::AOffDirect, true, true>((PG8_LAS unsigned char*)lds, (const bf16_t*)(p.ws + OFF_B), (const bf16_t*)(p.ws + OFF_WD), DE / 2, S, AO, E);
}
__device__ __forceinline__ void phase7(const Params& p) {
    const int tid = opaque_tid(), wid = tid >> 6, lane = tid & 63;
    const bf16_t* hb = (const bf16_t*)(p.ws + OFF_HB); const unsigned char* ys2 = p.ws + OFF_A;
    for (int t = blockIdx.x * 8 + wid; t < T_; t += gridDim.x * 8) {
        float v[4][8]; float s = 0.f;
#pragma unroll
        for (int i = 0; i < 4; ++i) { const int c = i * 512 + lane * 8;
            const u32x4 a = *(const u32x4*)(hb + (size_t)t * D_ + c); const u32x2 b = *(const u32x2*)(ys2 + (size_t)(2 * t) * D_ + c), d = *(const u32x2*)(ys2 + (size_t)(2 * t + 1) * D_ + c);
            float y0[8], y1[8];
            up4_fp8(b.x, y0[0], y0[1], y0[2], y0[3]); up4_fp8(b.y, y0[4], y0[5], y0[6], y0[7]); up4_fp8(d.x, y1[0], y1[1], y1[2], y1[3]); up4_fp8(d.y, y1[4], y1[5], y1[6], y1[7]);
#pragma unroll
            for (int q = 0; q < 4; ++q) { v[i][2 * q] = bflo(a[q]) + (y0[2 * q] + y1[2 * q]) * (1.f / YS_SCALE); v[i][2 * q + 1] = bfhi(a[q]) + (y0[2 * q + 1] + y1[2 * q + 1]) * (1.f / YS_SCALE);
                s += v[i][2 * q] * v[i][2 * q] + v[i][2 * q + 1] * v[i][2 * q + 1]; } }
        const float rstd = rsqrtf(wave_sum(s) * (1.f / D_) + EPS);
#pragma unroll
        for (int i = 0; i < 4; ++i) { const int c = i * 512 + lane * 8;
            const f32x4 g0 = *(const f32x4*)(p.g_final + c), g1 = *(const f32x4*)(p.g_final + c + 4);
            f32x4 o0, o1;
#pragma unroll
            for (int q = 0; q < 4; ++q) { o0[q] = v[i][q] * rstd * g0[q]; o1[q] = v[i][4 + q] * rstd * g1[q]; }
            *(f32x4*)(p.out + (size_t)t * D_ + c) = o0; *(f32x4*)(p.out + (size_t)t * D_ + c + 4) = o1; }
    }
}

#ifndef ONE_LAUNCH
#define ONE_LAUNCH 1
#endif
template <int PH> __global__ void __launch_bounds__(NTHR, 2) k_phase(Params p) {
    extern __shared__ __attribute__((aligned(16))) unsigned char lds[];
    if (PH == 0) phase0(p, lds);
    if (PH == 1) phase1(p, lds);
    if (PH == 2) phase2(p, lds);
    if (PH == 3) phase3(p, lds);
    if (PH == 4) phase4(p, lds);
    if (PH == 5) phase5(p, lds);
    if (PH == 6) phase6(p, lds);
    if (PH == 7) phase7(p);
}
__global__ void __launch_bounds__(NTHR, 2) k_mega(Params p) {
    extern __shared__ __attribute__((aligned(16))) unsigned char lds[];
    cg::grid_group grid = cg::this_grid();
    volatile PG8_LAS unsigned* bst = (volatile PG8_LAS unsigned*)((PG8_LAS unsigned char*)lds + LBAR_OFF);
    if (threadIdx.x < 2) bst[threadIdx.x] = 0u;
    __syncthreads();
    (void)xcd_barrier_post((unsigned*)(p.ws + OFF_BAR), bst);
#define GRID_BAR() do { XcdBarrier b_; b_.bar = (unsigned*)(opaque_ws(p.ws) + OFF_BAR); b_.x = xb_xcc_id(); b_.st = bst; xcd_barrier(b_); } while (0)
    if (DUP_PHASE == 0) { phase0(p, lds); GRID_BAR(); }
    if (p.ws == nullptr) grid.sync();
    phase0(p, lds); GRID_BAR();
    if (DUP_PHASE == 1) { phase1(p, lds); GRID_BAR(); }
    phase1(p, lds); GRID_BAR();
    if (DUP_PHASE == 2) { phase2(p, lds, OFF_DUMMY - OFF_SSQ); GRID_BAR(); }
    phase2(p, lds); GRID_BAR();
    if (DUP_PHASE == 3) { phase3(p, lds, OFF_DUMMY - OFF_SSQ); GRID_BAR(); }
    phase3(p, lds); GRID_BAR();
    if (DUP_PHASE == 4) { phase4(p, lds, OFF_DUMMY - OFF_SSQ); GRID_BAR(); }
    phase4(p, lds); GRID_BAR();
    if (DUP_PHASE == 5) { phase5(p, lds); GRID_BAR(); }
    phase5(p, lds); GRID_BAR();
    if (DUP_PHASE == 6) { phase6(p, lds); GRID_BAR(); }
    phase6(p, lds); GRID_BAR();
    if (DUP_PHASE == 8) { for (int i = 0; i < 10; ++i) GRID_BAR(); }
    if (DUP_PHASE == 9) { grid.sync(); grid.sync(); }
    if (DUP_PHASE == 7) { phase7(p); GRID_BAR(); }
    phase7(p);
}

extern "C" void kernel_launch(void* const* d_in, const int* in_sizes, int n_in, void* d_out, int out_size, void* d_ws, size_t ws_size, hipStream_t stream) {
    static int grid = 0;
    if (grid == 0) {
        if (n_in != 19 || in_sizes[0] != T_ * D_ || out_size != T_ * D_ || ws_size < WS_END + (DUP_PHASE >= 2 && DUP_PHASE <= 4 ? DUMMY_BYTES : 0)) { fprintf(stderr, "kernel_launch: unexpected shapes (n_in %d, in0 %d, out %d, ws %zu < %zu); nothing launched\n", n_in, n_in > 0 ? in_sizes[0] : -1, out_size, ws_size, (size_t)WS_END); grid = -1; return; }
        int dev = 0, cus = 0, per_cu = 0;
        if (hipGetDevice(&dev) != hipSuccess || hipDeviceGetAttribute(&cus, hipDeviceAttributeMultiprocessorCount, dev) != hipSuccess) { grid = -1; return; }
#if ONE_LAUNCH
        if (hipFuncSetAttribute((const void*)k_mega, hipFuncAttributeMaxDynamicSharedMemorySize, LDS_BYTES) != hipSuccess) { fprintf(stderr, "kernel_launch: hipFuncSetAttribute failed\n"); grid = -1; return; }
        if (hipOccupancyMaxActiveBlocksPerMultiprocessor(&per_cu, (const void*)k_mega, NTHR, LDS_BYTES) != hipSuccess || per_cu < 1) { fprintf(stderr, "kernel_launch: occupancy query says %d blocks per CU\n", per_cu); grid = -1; return; }
        grid = cus * per_cu;
#else
        (void)hipFuncSetAttribute((const void*)k_phase<0>, hipFuncAttributeMaxDynamicSharedMemorySize, LDS_BYTES);
        (void)hipFuncSetAttribute((const void*)k_phase<1>, hipFuncAttributeMaxDynamicSharedMemorySize, LDS_BYTES);
        (void)hipFuncSetAttribute((const void*)k_phase<2>, hipFuncAttributeMaxDynamicSharedMemorySize, LDS_BYTES);
        (void)hipFuncSetAttribute((const void*)k_phase<3>, hipFuncAttributeMaxDynamicSharedMemorySize, LDS_BYTES);
        (void)hipFuncSetAttribute((const void*)k_phase<4>, hipFuncAttributeMaxDynamicSharedMemorySize, LDS_BYTES);
        (void)hipFuncSetAttribute((const void*)k_phase<5>, hipFuncAttributeMaxDynamicSharedMemorySize, LDS_BYTES);
        (void)hipFuncSetAttribute((const void*)k_phase<6>, hipFuncAttributeMaxDynamicSharedMemorySize, LDS_BYTES);
        (void)hipFuncSetAttribute((const void*)k_phase<7>, hipFuncAttributeMaxDynamicSharedMemorySize, LDS_BYTES);
        grid = cus > 0 ? cus : 256;
#endif
    }
    if (grid < 0) return;
    Params p{};
    const float** f = (const float**)&p;
    for (int i = 0; i < 19; ++i) f[i] = (const float*)d_in[i];
    p.out = (float*)d_out; p.ws = (unsigned char*)d_ws;
#if ONE_LAUNCH
    if (hipMemsetAsync((unsigned char*)d_ws + OFF_BAR, 0, BAR_BYTES, stream) != hipSuccess) { fprintf(stderr, "kernel_launch: memset of the barrier words failed\n"); return; }
    void* args[] = {&p};
    const hipError_t e = hipLaunchCooperativeKernel((const void*)k_mega, dim3(grid), dim3(NTHR), args, LDS_BYTES, stream);
    if (e != hipSuccess) fprintf(stderr, "kernel_launch: cooperative launch failed: %s (grid %d)\n", hipGetErrorString(e), grid);
#else
    hipLaunchKernelGGL(k_phase<0>, dim3(grid), dim3(NTHR), LDS_BYTES, stream, p);
    hipLaunchKernelGGL(k_phase<1>, dim3(grid), dim3(NTHR), LDS_BYTES, stream, p);
    hipLaunchKernelGGL(k_phase<2>, dim3(grid), dim3(NTHR), LDS_BYTES, stream, p);
    hipLaunchKernelGGL(k_phase<3>, dim3(grid), dim3(NTHR), LDS_BYTES, stream, p);
    hipLaunchKernelGGL(k_phase<4>, dim3(grid), dim3(NTHR), LDS_BYTES, stream, p);
    hipLaunchKernelGGL(k_phase<5>, dim3(grid), dim3(NTHR), LDS_BYTES, stream, p);
    hipLaunchKernelGGL(k_phase<6>, dim3(grid), dim3(NTHR), LDS_BYTES, stream, p);
    hipLaunchKernelGGL(k_phase<7>, dim3(grid), dim3(NTHR), LDS_BYTES, stream, p);
#endif
}
```

```cpp
#include <hip/hip_runtime.h>
#include <hip/hip_cooperative_groups.h>
#include <cstdio>
namespace cg = cooperative_groups;

typedef unsigned short bf16_t;
typedef float f32x4 __attribute__((ext_vector_type(4)));
typedef unsigned u32x4 __attribute__((ext_vector_type(4)));
typedef unsigned u32x2 __attribute__((ext_vector_type(2)));
typedef short bf16x8 __attribute__((ext_vector_type(8)));
typedef int v4i __attribute__((ext_vector_type(4)));
typedef int v8i __attribute__((ext_vector_type(8)));

constexpr int T_ = 16384, D_ = 2048, DIN = 5120, DP = 4096, NE = 32, DE = 512, SEQ = 4096, LCAP = 16384;
constexpr float EPS = 1e-6f;
#ifndef DUP_PHASE
#define DUP_PHASE -1
#endif
constexpr int NTHR = 512;
constexpr int LDS_BYTES = 163840;
constexpr int LCNT_OFF = 131072, LBAR_OFF = 131072 + 2048, XS_OFF = 131072 + 4096, XM_OFF = XS_OFF + 8192, RS_OFF = XM_OFF;
constexpr int RS_UNITS = 4;
static_assert(XM_OFF + 512 * 32 <= LDS_BYTES && RS_UNITS * 256 * 8 <= 512 * 32, "LDS map");

constexpr size_t SZ_A = (size_t)T_ * DIN * 2;
constexpr size_t SZ_B = (size_t)T_ * D_ * 2;
constexpr size_t OFF_A = 0;
constexpr size_t OFF_B = OFF_A + SZ_A;
constexpr size_t OFF_HB = OFF_B + SZ_B;
constexpr size_t OFF_H8 = OFF_A + (size_t)2 * T_ * D_ * 2;
constexpr float WGU_SCALE = 32.f, WD_SCALE = 16.f, YS_SCALE = 16.f;
constexpr size_t OFF_WIN = OFF_HB + SZ_B;
constexpr size_t OFF_WOUT = OFF_WIN + (size_t)DIN * D_ * 2;
constexpr size_t OFF_WGU = OFF_WOUT + (size_t)D_ * D_ * 2;
constexpr size_t OFF_WD = OFF_WGU + (size_t)NE * 1024 * D_ * 2;
constexpr size_t OFF_WR = OFF_WD + (size_t)NE * D_ * DE * 2;
constexpr size_t OFF_SSQ = OFF_WR + (size_t)48 * D_ * 2;
constexpr size_t OFF_CNT = OFF_SSQ + (size_t)3 * T_ * 4;
constexpr size_t OFF_RINFO = OFF_CNT + 256;
constexpr size_t OFF_RW = OFF_RINFO + (size_t)NE * LCAP * 4;
constexpr size_t OFF_BAR = OFF_RW + (size_t)NE * LCAP * 4;
constexpr size_t BAR_BYTES = 16384;
constexpr size_t WS_END = OFF_BAR + BAR_BYTES;
constexpr size_t OFF_DUMMY = WS_END;
constexpr size_t DUMMY_BYTES = (OFF_BAR - OFF_SSQ);

struct Params {
    const float *x, *norm_mix_g, *w_in, *v_norm_g, *gmlp_ws, *gmlp_bs, *conv_w, *g_a, *g_b, *w_out, *g_ffn, *rgw, *rgb, *rew, *reb, *ewg, *ewu, *ewd, *g_final;
    float* out; unsigned char* ws;
};

__device__ __forceinline__ unsigned cvt_pk_bf16(float lo, float hi) { unsigned r; asm volatile("v_cvt_pk_bf16_f32 %0, %1, %2" : "=v"(r) : "v"(lo), "v"(hi)); return r; }
#define GAS __attribute__((address_space(1)))
typedef GAS unsigned char gbyte;
__device__ __forceinline__ gbyte* opaque_ws(unsigned char* w) { gbyte* g = (gbyte*)w; asm volatile("" : "+s"(g)); return g; }
__device__ __forceinline__ int opaque_tid() { int t = threadIdx.x; asm volatile("" : "+v"(t)); return t; }
__device__ __forceinline__ unsigned pk4_fp8(float a, float b, float c, float d) { int w = 0; w = __builtin_amdgcn_cvt_pk_fp8_f32(a, b, w, false); w = __builtin_amdgcn_cvt_pk_fp8_f32(c, d, w, true); return (unsigned)w; }
__device__ __forceinline__ void up4_fp8(unsigned w, float& a, float& b, float& c, float& d) {
    const auto lo = __builtin_amdgcn_cvt_pk_f32_fp8((int)w, false), hi = __builtin_amdgcn_cvt_pk_f32_fp8((int)w, true); a = lo[0]; b = lo[1]; c = hi[0]; d = hi[1]; }
__device__ __forceinline__ float bflo(unsigned w) { return __uint_as_float(w << 16); }
__device__ __forceinline__ float bfhi(unsigned w) { return __uint_as_float(w & 0xffff0000u); }
__device__ __forceinline__ float wave_sum(float v) {
#pragma unroll
    for (int o = 1; o < 64; o <<= 1) v += __shfl_xor(v, o);
    return v;
}
__device__ __forceinline__ float gelu_t(float x) {
    const float u = x * (0.7978845608f + 0.0356774081f * x * x);
    return x * __builtin_amdgcn_rcpf(1.f + __builtin_amdgcn_exp2f(-2.885390082f * u));
}
__device__ __forceinline__ float silu_f(float x) { return x * __builtin_amdgcn_rcpf(1.f + __builtin_amdgcn_exp2f(-1.442695041f * x)); }

#define PG8_LAS __attribute__((address_space(3)))
struct Unit { int pm, pn, e, r0, pnl; };

constexpr int MT_CNT = 0, MT_PST = 32, MT_NT = 65, MT_T2E = 66, MT_WORDS = 66 + 192;
typedef const PG8_LAS int* lcnt_t;
__device__ __forceinline__ bool moe_unit(lcnt_t tb, int NT, int L, Unit& u) {
    const int pt = L / NT;
    if (pt >= __builtin_amdgcn_readfirstlane(tb[MT_NT])) return false;
    const int e = __builtin_amdgcn_readfirstlane(tb[MT_T2E + pt]), mt = pt - __builtin_amdgcn_readfirstlane(tb[MT_PST + e]), j = L - pt * NT;
    u.e = e; u.pm = pt; u.r0 = mt * 256; u.pnl = j; u.pn = e * NT + j; return true;
}

struct NoMeta {};
struct Meta8 { u32x4 lo, hi; };
struct Epi1 {
    static constexpr bool PERM = true, MIDSCALE = false;
    typedef NoMeta Meta;
    unsigned char* ws;
    __device__ __forceinline__ Meta meta_load(const Unit&, int, int) const { return Meta{}; }
    __device__ __forceinline__ void operator()(f32x4 (&acc)[2][2][4][2], const Unit& u, int wr, int wc, int fr, int fq, const Meta&) const {
        GAS bf16_t* P = (GAS bf16_t*)(opaque_ws(ws) + OFF_A);
        if (u.pn >= 12) {
#pragma unroll
            for (int ai = 0; ai < 2; ++ai)
#pragma unroll
                for (int m = 0; m < 4; ++m) {
                    const int row = u.pm * 256 + ai * 128 + wr * 64 + m * 16 + fr;
                    GAS bf16_t* rowp = P + (size_t)row * DP + 3072 + (u.pn - 12) * 128 + wc * 16 + 4 * fq;
#pragma unroll
                    for (int bj = 0; bj < 2; ++bj) { const f32x4 z = acc[ai][bj][m][0] * acc[ai][bj][m][1];
                        u32x2 w; w.x = cvt_pk_bf16(z[0], z[1]); w.y = cvt_pk_bf16(z[2], z[3]); *(GAS u32x2*)(rowp + bj * 64) = w; }
                }
            return;
        }
        const bool act = u.pn < 8;
#pragma unroll
        for (int ai = 0; ai < 2; ++ai)
#pragma unroll
            for (int m = 0; m < 4; ++m) {
                const int row = u.pm * 256 + ai * 128 + wr * 64 + m * 16 + fr;
                GAS bf16_t* rowp = P + (size_t)row * DP + u.pn * 256 + wc * 32 + 8 * fq;
#pragma unroll
                for (int bj = 0; bj < 2; ++bj) {
                    f32x4 v0 = acc[ai][bj][m][0], v1 = acc[ai][bj][m][1];
                    if (act) {
#pragma unroll
                        for (int j = 0; j < 4; ++j) { v0[j] = gelu_t(v0[j]); v1[j] = gelu_t(v1[j]); }
                    }
                    u32x4 w; w.x = cvt_pk_bf16(v0[0], v0[1]); w.y = cvt_pk_bf16(v0[2], v0[3]); w.z = cvt_pk_bf16(v1[0], v1[1]); w.w = cvt_pk_bf16(v1[2], v1[3]);
                    *(GAS u32x4*)(rowp + bj * 128) = w;
                }
            }
    }
};
struct Epi2 {
    static constexpr bool PERM = true, MIDSCALE = true;
    const float* x; unsigned char* ws; size_t so;
    const PG8_LAS float* rsl;
    __device__ __forceinline__ void midscale(f32x4 (&acc)[2][2][4][2], const Unit& u, int wr, int wc, int fr, int fq) const {
        const PG8_LAS float* pr = rsl + (u.e * 256 + wr * 64 + fr) * 2;
#pragma unroll
        for (int ai = 0; ai < 2; ++ai)
#pragma unroll
            for (int m = 0; m < 4; ++m) {
                const float s = pr[(ai * 128 + m * 16) * 2];
#pragma unroll
                for (int bj = 0; bj < 2; ++bj)
#pragma unroll
                    for (int n = 0; n < 2; ++n) acc[ai][bj][m][n] *= s;
            }
    }
    typedef NoMeta Meta;
    __device__ __forceinline__ Meta meta_load(const Unit&, int, int) const { return Meta{}; }
    __device__ __forceinline__ void operator()(f32x4 (&acc)[2][2][4][2], const Unit& u, int wr, int wc, int fr, int fq, const Meta&) const {
        gbyte* w_ = opaque_ws(ws);
        GAS bf16_t* hb = (GAS bf16_t*)(w_ + OFF_HB); gbyte* h8 = w_ + OFF_H8; float* ssq_h = (float*)(ws + OFF_SSQ + so) + 2 * T_;
#pragma unroll
        for (int ai = 0; ai < 2; ++ai)
#pragma unroll
            for (int m = 0; m < 4; ++m) {
                const int row = u.pm * 256 + ai * 128 + wr * 64 + m * 16 + fr;
                const float rb = rsl[(u.e * 256 + ai * 128 + wr * 64 + m * 16 + fr) * 2 + 1];
                const size_t off = (size_t)row * D_ + u.pn * 256 + wc * 32 + 8 * fq;
                float ss = 0.f;
#pragma unroll
                for (int bj = 0; bj < 2; ++bj) {
                    const f32x4 x0 = *(const f32x4*)(x + off + bj * 128), x1 = *(const f32x4*)(x + off + bj * 128 + 4);
                    const f32x4 h0 = x0 + acc[ai][bj][m][0] * rb, h1 = x1 + acc[ai][bj][m][1] * rb;
                    ss += (h0[0] * h0[0] + h0[1] * h0[1]) + (h0[2] * h0[2] + h0[3] * h0[3]) + (h1[0] * h1[0] + h1[1] * h1[1]) + (h1[2] * h1[2] + h1[3] * h1[3]);
                    u32x4 w; w.x = cvt_pk_bf16(h0[0], h0[1]); w.y = cvt_pk_bf16(h0[2], h0[3]); w.z = cvt_pk_bf16(h1[0], h1[1]); w.w = cvt_pk_bf16(h1[2], h1[3]);
                    *(GAS u32x4*)(hb + off + bj * 128) = w;
                    u32x2 w8; w8.x = pk4_fp8(h0[0], h0[1], h0[2], h0[3]); w8.y = pk4_fp8(h1[0], h1[1], h1[2], h1[3]);
                    *(GAS u32x2*)(h8 + off + bj * 128) = w8;
                }
                ss += __shfl_xor(ss, 16); ss += __shfl_xor(ss, 32);
                if (fq == 0) atomicAdd(ssq_h + row, ss);
                if (m == 3) asm volatile("" ::: "memory");
            }
    }
};
struct Epi5 {
    static constexpr bool PERM = true, MIDSCALE = false;
    typedef Meta8 Meta;
    unsigned char* ws; lcnt_t cnt;
    __device__ __forceinline__ Meta meta_load(const Unit& u, int wr, int fr) const {
        const GAS unsigned* rrs = (const GAS unsigned*)(opaque_ws(ws) + OFF_RW) + u.e * LCAP; const int ce = __builtin_amdgcn_readfirstlane(cnt[u.e]); Meta mt;
#pragma unroll
        for (int q = 0; q < 4; ++q) { const int i0 = u.r0 + wr * 64 + q * 16 + fr, i1 = i0 + 128;
            const unsigned a = rrs[min(i0, ce - 1)], b = rrs[min(i1, ce - 1)]; mt.lo[q] = (i0 < ce) ? a : 0u; mt.hi[q] = (i1 < ce) ? b : 0u; }
        return mt;
    }
    __device__ __forceinline__ void operator()(f32x4 (&acc)[2][2][4][2], const Unit& u, int wr, int wc, int fr, int fq, const Meta& mt) const {
        gbyte* hbuf = opaque_ws(ws) + OFF_B;
#pragma unroll
        for (int ai = 0; ai < 2; ++ai)
#pragma unroll
            for (int m = 0; m < 4; ++m) {
                const int r = ai * 128 + wr * 64 + m * 16 + fr;
                const float rs = __uint_as_float(ai ? mt.hi[m] : mt.lo[m]);
                float o[8];
#pragma unroll
                for (int n = 0; n < 2; ++n)
#pragma unroll
                    for (int j = 0; j < 4; ++j) o[4 * n + j] = silu_f(acc[ai][0][m][n][j] * rs) * (acc[ai][1][m][n][j] * rs);
                u32x2 w; w.x = pk4_fp8(o[0], o[1], o[2], o[3]); w.y = pk4_fp8(o[4], o[5], o[6], o[7]);
                *(GAS u32x2*)(hbuf + (size_t)(u.pm * 256 + r) * DE + u.pnl * 128 + wc * 32 + 8 * fq) = w;
                if (m & 1) asm volatile("" ::: "memory");
            }
    }
};
struct Epi6 {
    static constexpr bool PERM = true, MIDSCALE = false;
    typedef Meta8 Meta;
    unsigned char* ws; lcnt_t cnt;
    __device__ __forceinline__ Meta meta_load(const Unit& u, int wr, int fr) const {
        const GAS unsigned* rpk = (const GAS unsigned*)(opaque_ws(ws) + OFF_RINFO) + u.e * LCAP; const int ce = __builtin_amdgcn_readfirstlane(cnt[u.e]); Meta mt;
#pragma unroll
        for (int q = 0; q < 4; ++q) { const int i0 = u.r0 + wr * 64 + q * 16 + fr, i1 = i0 + 128;
            const unsigned a = rpk[min(i0, ce - 1)], b = rpk[min(i1, ce - 1)]; mt.lo[q] = (i0 < ce) ? a : 0xFFFFFFFFu; mt.hi[q] = (i1 < ce) ? b : 0xFFFFFFFFu; }
        return mt;
    }
    __device__ __forceinline__ void operator()(f32x4 (&acc)[2][2][4][2], const Unit& u, int wr, int wc, int fr, int fq, const Meta& mt) const {
        gbyte* ys2 = opaque_ws(ws) + OFF_A;
#pragma unroll
        for (int ai = 0; ai < 2; ++ai)
#pragma unroll
            for (int m = 0; m < 4; ++m) {
                const unsigned pk = ai ? mt.hi[m] : mt.lo[m]; const unsigned info = pk & 0xFFFFu;
                if (info < 2u * T_) {
                    const float g = __uint_as_float(pk & 0xFFFF0000u) * (YS_SCALE / WD_SCALE);
                    gbyte* dst = ys2 + (size_t)info * D_ + u.pnl * 256 + wc * 32 + 8 * fq;
#pragma unroll
                    for (int bj = 0; bj < 2; ++bj) {
                        const f32x4 v0 = acc[ai][bj][m][0] * g, v1 = acc[ai][bj][m][1] * g;
                        u32x2 w; w.x = pk4_fp8(v0[0], v0[1], v0[2], v0[3]); w.y = pk4_fp8(v1[0], v1[1], v1[2], v1[3]);
                        *(GAS u32x2*)(dst + bj * 128) = w;
                    }
                }
            }
    }
};

namespace pg8 {
constexpr int BM = 256, BK = 64, HALF = 128, HTB = HALF * BK * 2, STAGE_BYTES = 8 * HTB, NXCD = 8, WGM = 8;
__host__ __device__ __forceinline__ int lds_byte(int r, int c) { const int st = (r >> 4) * 2 + (c >> 5), rr = r & 15, cc = c & 31, ob = rr * 64 + cc * 2; return st * 1024 + (ob ^ (((ob >> 9) & 1) << 5)); }
__host__ __device__ __forceinline__ void stage_rc(int b, int& R, int& C) { const int st = b / 1024, sb = b % 1024, swz = sb ^ (((sb >> 9) & 1) << 5); R = (st >> 1) * 16 + swz / 64; C = (st & 1) * 32 + (swz % 64) / 2; }
__host__ __device__ __forceinline__ int perm32(int rho) { const int n = rho >> 4, i = rho & 15; return 8 * (i >> 2) + 4 * n + (i & 3); }

struct StaticOrder {
    int nM, nN, nwg, G, c, i0, i1;
    __device__ void init(int M, int N, int G_, int c_) { nM = M / BM; nN = N / BM; nwg = nM * nN; G = G_; c = c_; i0 = 0; i1 = 1 << 30; }
    __device__ int count() const { return (nwg - c + G - 1) / G; }
    __device__ bool next(int ii, Unit& u) const {
        const int i = ii + i0; if (i >= i1) return false;
        const long L = (long)i * G + c; if (L >= nwg) return false;
        int wgid = (int)L; { const int q = nwg / NXCD, r = nwg % NXCD, xcd = wgid % NXCD, off = wgid / NXCD; wgid = (xcd < r ? xcd * (q + 1) : r * (q + 1) + (xcd - r) * q) + off; }
        const int nig = WGM * nN, gid = wgid / nig, fm = gid * WGM, gsz = (nM - fm) < WGM ? (nM - fm) : WGM;
        u.pm = fm + ((wgid % nig) % gsz); u.pn = (wgid % nig) / gsz; u.e = i; u.r0 = 0; u.pnl = u.pn; return true;
    }
};
struct MoeOrder {
    lcnt_t cnt; int NT, G, c;
    __device__ __forceinline__ bool next(int i, Unit& u) const { return moe_unit(cnt, NT, i * G + c, u); }
};
struct AOffDirect { int K; struct Pre {};
    __device__ __forceinline__ Pre pre(const Unit&, int, int) const { return Pre{}; }
    __device__ __forceinline__ unsigned fin(const Pre&, const Unit& u, int h, int i, int R, int C) const { return (unsigned)(((u.pm * 256 + h * 128 + R) * K + C) * 2); } };
struct AOffGather { unsigned char* ws; lcnt_t cnt; int K;
    struct Pre { unsigned pk[2][2]; };
    __device__ __forceinline__ Pre pre(const Unit& u, int R0, int R1) const {
        const GAS unsigned* rpk = (const GAS unsigned*)(opaque_ws(ws) + OFF_RINFO) + u.e * LCAP; const int ce = __builtin_amdgcn_readfirstlane(cnt[u.e]); Pre p;
#pragma unroll
        for (int h = 0; h < 2; ++h) { const int i0 = u.r0 + h * 128 + R0, i1 = u.r0 + h * 128 + R1;
            p.pk[h][0] = rpk[min(i0, ce - 1)]; p.pk[h][1] = rpk[min(i1, ce - 1)]; }
        return p;
    }
    __device__ __forceinline__ unsigned fin(const Pre& p, const Unit&, int h, int i, int, int C) const { const int tok = (int)((p.pk[h][i] & 0xFFFFu) >> 1); return (unsigned)((tok * K + C) * 2); } };

template <class Epi, class Sched, class AOff, bool ALIGN_EPI, bool FP8 = false>
__device__ __forceinline__ void gemm_phase(PG8_LAS unsigned char* lds, const bf16_t* Ag, const bf16_t* Btg, const int K, const Sched& S, const AOff& AO, const Epi& E) {
    const int tid = opaque_tid(), wid = __builtin_amdgcn_readfirstlane(tid >> 6), lane = tid & 63, wr = wid >> 2, wc = wid & 3, fr = lane & 15, fq = lane >> 4;
    int nt = K / BK; asm volatile("" : "+s"(nt));
    unsigned voffB[2];
#pragma unroll
    for (int i = 0; i < 2; ++i) { int R, C; stage_rc(tid * 16 + i * 8192, R, C); const int Rb = Epi::PERM ? ((R & ~31) + perm32(R & 31)) : R; voffB[i] = (unsigned)(Rb * K + C) * 2u; }
#define PG8_APRE(u, pv_) do { int _t = tid; asm volatile("" : "+v"(_t)); int _R0, _R1, _C; stage_rc(_t * 16, _R0, _C); stage_rc(_t * 16 + 8192, _R1, _C); pv_ = AO.pre(u, _R0, _R1); } while (0)
#define PG8_AFIN(u, pv_, d0, d1) do { int _t = tid; asm volatile("" : "+v"(_t)); _Pragma("unroll") for (int _i = 0; _i < 2; ++_i) { int _R, _C; stage_rc(_t * 16 + _i * 8192, _R, _C); d0[_i] = AO.fin(pv_, u, 0, _i, _R, _C); d1[_i] = AO.fin(pv_, u, 1, _i, _R, _C); } } while (0)
#define PG8_LANE(fr_, fq_) int fr_, fq_; { int _t = tid; asm volatile("" : "+v"(_t)); fr_ = _t & 15; fq_ = (_t & 63) >> 4; }
    const unsigned kstep = (unsigned)(BK * 2), hstep = (unsigned)HALF * (unsigned)K * 2u, tstep = 2u * hstep;
    const unsigned ldsw = (unsigned)wid * 1024u;
    const int aoff = lds_byte(wr * 64 + fr, fq * 8), boff = lds_byte(wc * 32 + fr, fq * 8);
    const char* const Ab = (const char*)Ag; const char* const Bb = (const char*)Btg;
#define PG8_SA(b, h) (((b) * 2 + (h)) * HTB)
#define PG8_SB(b, h) ((4 + (b) * 2 + (h)) * HTB)
#define PG8_STAGE(bufoff, gbase, uoff, voff) do { _Pragma("unroll") for (int _i = 0; _i < 2; ++_i) \
        __builtin_amdgcn_global_load_lds((const unsigned*)((gbase) + (size_t)(unsigned)((uoff) + (voff)[_i])), (PG8_LAS unsigned*)(lds + (bufoff) + ldsw + _i * 8192), 16, 0, 0); } while (0)
#define PG8_LD32(base) __builtin_shufflevector(*(const PG8_LAS v4i*)(base), *(const PG8_LAS v4i*)((base) + 1024), 0, 1, 2, 3, 4, 5, 6, 7)
#define PG8_LDA(dst, b, h) do { _Pragma("unroll") for (int m = 0; m < 4; ++m) dst[m] = PG8_LD32(lds + PG8_SA(b, h) + aoff + m * 2048); } while (0)
#define PG8_LDB(dst, b, h) do { _Pragma("unroll") for (int n = 0; n < 2; ++n) dst[n] = PG8_LD32(lds + PG8_SB(b, h) + boff + n * 2048); } while (0)
#define PG8_LO(x) __builtin_bit_cast(bf16x8, __builtin_shufflevector((x), (x), 0, 1, 2, 3))
#define PG8_HI(x) __builtin_bit_cast(bf16x8, __builtin_shufflevector((x), (x), 4, 5, 6, 7))
#define PG8_MMA(ai, bj, At, Bt) do { __builtin_amdgcn_s_setprio(1); _Pragma("unroll") for (int m = 0; m < 4; ++m) _Pragma("unroll") for (int n = 0; n < 2; ++n) { \
        if constexpr (FP8) acc[ai][bj][m][n] = __builtin_amdgcn_mfma_scale_f32_16x16x128_f8f6f4(Bt[n], At[m], acc[ai][bj][m][n], 0, 0, 0, 0, 0, 0);   \
        else { acc[ai][bj][m][n] = __builtin_amdgcn_mfma_f32_16x16x32_bf16(PG8_LO(Bt[n]), PG8_LO(At[m]), acc[ai][bj][m][n], 0, 0, 0); \
               acc[ai][bj][m][n] = __builtin_amdgcn_mfma_f32_16x16x32_bf16(PG8_HI(Bt[n]), PG8_HI(At[m]), acc[ai][bj][m][n], 0, 0, 0); } } \
        __builtin_amdgcn_s_setprio(0); } while (0)
#define PG8_WAIT_V(n) asm volatile("s_waitcnt vmcnt(" #n ")" ::: "memory")
#define PG8_WAIT_L(n) asm volatile("s_waitcnt lgkmcnt(" #n ")" ::: "memory")
#define PG8_BAR __builtin_amdgcn_s_barrier()
#define PG8_SCHED __builtin_amdgcn_sched_barrier(0)
    Unit cur, nxt; int ui = 0;
    if (!S.next(0, cur)) return;
    f32x4 acc[2][2][4][2];
#pragma unroll
    for (int a = 0; a < 2; ++a)
#pragma unroll
        for (int b = 0; b < 2; ++b)
#pragma unroll
            for (int m = 0; m < 4; ++m)
#pragma unroll
                for (int n = 0; n < 2; ++n) acc[a][b][m][n] = (f32x4){0.f, 0.f, 0.f, 0.f};
    v8i At[4], B0[2], B1[2];
    unsigned vo0[2], vo1[2];
    PG8_LAS u32x4* const svn = (PG8_LAS u32x4*)(lds + XS_OFF) + tid;
    PG8_LAS u32x4* const smeta = (PG8_LAS u32x4*)(lds + XM_OFF + tid * 32);
    constexpr bool HAS_META = sizeof(typename Epi::Meta) > 1;
    bool has_next = S.next(1, nxt);
    { typename AOff::Pre pc; PG8_APRE(cur, pc); PG8_AFIN(cur, pc, vo0, vo1);
      unsigned vn0[2], vn1[2];
      if (has_next) { typename AOff::Pre pn; PG8_APRE(nxt, pn); PG8_AFIN(nxt, pn, vn0, vn1); } else { vn0[0] = vo0[0]; vn0[1] = vo0[1]; vn1[0] = vo1[0]; vn1[1] = vo1[1]; }
      *svn = (u32x4){vn0[0], vn0[1], vn1[0], vn1[1]}; }
    if constexpr (HAS_META) { PG8_LANE(fr_, fq_); (void)fq_; const typename Epi::Meta m0 = E.meta_load(cur, wr, fr_); smeta[0] = m0.lo; smeta[1] = m0.hi; }
    unsigned cB = (unsigned)cur.pn * tstep;
    PG8_STAGE(PG8_SB(0, 0), Bb, cB, voffB); PG8_STAGE(PG8_SB(0, 1), Bb, cB + hstep, voffB); PG8_STAGE(PG8_SA(0, 0), Ab, 0u, vo0); PG8_STAGE(PG8_SA(0, 1), Ab, 0u, vo1);
    if (wr == 1) PG8_BAR;
    PG8_WAIT_V(2); PG8_BAR;
    PG8_STAGE(PG8_SB(1, 0), Bb, cB + kstep, voffB); PG8_STAGE(PG8_SA(1, 0), Ab, kstep, vo0); PG8_STAGE(PG8_SB(1, 1), Bb, cB + hstep + kstep, voffB);
    PG8_WAIT_V(6); PG8_BAR;
    for (;;) {
        const unsigned nB = has_next ? (unsigned)nxt.pn * tstep : cB;
#pragma clang loop unroll(disable)
        for (int t = 0; t < nt; t += 2) {
            const bool last = (t == nt - 2);
            if constexpr (Epi::MIDSCALE) { if (t == nt / 2) { PG8_LANE(fr_, fq_); E.midscale(acc, cur, wr, wc, fr_, fq_); } }
            const unsigned k1 = (unsigned)(t + 1) * kstep, k2 = last ? 0u : (unsigned)(t + 2) * kstep, k3 = k2 + kstep;
            const unsigned b2 = last ? nB : cB + (unsigned)(t + 2) * kstep, b3 = b2 + kstep;
            PG8_LDB(B0, 0, 0); PG8_LDB(B1, 0, 1); PG8_SCHED; PG8_LDA(At, 0, 0); PG8_STAGE(PG8_SA(1, 1), Ab, k1, vo1);
            PG8_WAIT_V(8); PG8_WAIT_L(0); PG8_BAR; PG8_MMA(0, 0, At, B0); PG8_MMA(0, 1, At, B1); PG8_BAR; PG8_SCHED;
            if (last) { PG8_LAS u32x4* sp_ = svn; asm volatile("" : "+v"(sp_));
                const u32x4 v = *sp_; vo0[0] = v.x; vo0[1] = v.y; vo1[0] = v.z; vo1[1] = v.w; }
            PG8_LDA(At, 0, 1); PG8_STAGE(PG8_SB(0, 0), Bb, b2, voffB); PG8_STAGE(PG8_SB(0, 1), Bb, b2 + hstep, voffB); PG8_STAGE(PG8_SA(0, 0), Ab, k2, vo0);
            PG8_WAIT_V(8); PG8_WAIT_L(0); PG8_BAR; PG8_MMA(1, 0, At, B0); PG8_MMA(1, 1, At, B1); PG8_BAR; PG8_SCHED;
            PG8_LDB(B0, 1, 0); PG8_LDB(B1, 1, 1); PG8_SCHED; PG8_LDA(At, 1, 0); PG8_STAGE(PG8_SA(0, 1), Ab, k2, vo1);
            PG8_WAIT_V(8); PG8_WAIT_L(0); PG8_BAR; PG8_MMA(0, 0, At, B0); PG8_MMA(0, 1, At, B1); PG8_BAR; PG8_SCHED;
            PG8_LDA(At, 1, 1); PG8_STAGE(PG8_SB(1, 0), Bb, b3, voffB); PG8_STAGE(PG8_SB(1, 1), Bb, b3 + hstep, voffB); PG8_STAGE(PG8_SA(1, 0), Ab, k3, vo0);
            PG8_WAIT_V(8); PG8_WAIT_L(0); PG8_BAR; PG8_MMA(1, 0, At, B0); PG8_MMA(1, 1, At, B1); PG8_BAR; PG8_SCHED;
        }
        if constexpr (ALIGN_EPI) { if (wr == 0) PG8_BAR; }
        Unit nn; const bool has2 = has_next && S.next(ui + 2, nn);
        typename Epi::Meta mnext;
        { PG8_LANE(fr_, fq_);
          typename Epi::Meta meta; if constexpr (HAS_META) { PG8_LAS u32x4* sp_ = smeta; asm volatile("" : "+v"(sp_)); meta.lo = sp_[0]; meta.hi = sp_[1]; }
          if (has_next) mnext = E.meta_load(nxt, wr, fr_);
          if (has2) { typename AOff::Pre pnn; PG8_APRE(nn, pnn); unsigned vn0[2], vn1[2]; PG8_AFIN(nn, pnn, vn0, vn1); *svn = (u32x4){vn0[0], vn0[1], vn1[0], vn1[1]}; }
          E(acc, cur, wr, wc, fr_, fq_, meta); }
        if (!has_next) break;
        if constexpr (HAS_META) { smeta[0] = mnext.lo; smeta[1] = mnext.hi; }
#pragma unroll
        for (int a = 0; a < 2; ++a)
#pragma unroll
            for (int b = 0; b < 2; ++b)
#pragma unroll
                for (int m = 0; m < 4; ++m)
#pragma unroll
                    for (int n = 0; n < 2; ++n) acc[a][b][m][n] = (f32x4){0.f, 0.f, 0.f, 0.f};
        cur = nxt; nxt = nn; has_next = has2; cB = nB; ++ui;
        if constexpr (ALIGN_EPI) { if (wr == 1) PG8_BAR; }
    }
    PG8_WAIT_V(0);
    if constexpr (!ALIGN_EPI) { if (wr == 0) PG8_BAR; }
    PG8_BAR;
#undef PG8_APRE
#undef PG8_AFIN
#undef PG8_LANE
#undef PG8_SA
#undef PG8_SB
#undef PG8_STAGE
#undef PG8_LDA
#undef PG8_LDB
#undef PG8_MMA
#undef PG8_LO
#undef PG8_HI
#undef PG8_LD32
#undef PG8_WAIT_V
#undef PG8_WAIT_L
#undef PG8_BAR
#undef PG8_SCHED
}
}


#define XB_TMO      128
#define XB_XCNT(j)  (256  + 64 * (j))
#define XB_XSUB(j)  (1280 + 64 * (j))
#define XB_XGEN(j)  (2304 + 64 * (j))
#define XB_TOP      3328
#define XB_TOPGEN   3392
#define XCD_BAR_WORDS 3456
#define XB_SPIN_CAP (1u << 18)
__device__ __forceinline__ unsigned xb_ld(unsigned* p)              { return __hip_atomic_load(p, __ATOMIC_RELAXED, __HIP_MEMORY_SCOPE_AGENT); }
__device__ __forceinline__ unsigned xb_add(unsigned* p, unsigned v) { return __hip_atomic_fetch_add(p, v, __ATOMIC_RELAXED, __HIP_MEMORY_SCOPE_AGENT); }
__device__ __forceinline__ unsigned xb_xcc_id() { return (unsigned)__builtin_amdgcn_s_getreg((3 << 11) | 20) & 0xFu; }
#define XB_SPIN(cond, bar) do { unsigned _sp = 0; while (cond) { __builtin_amdgcn_s_sleep(1); \
    if ((++_sp & 255u) == 0u) { if (xb_ld(&(bar)[XB_TMO])) break; if (_sp > XB_SPIN_CAP) { atomicAdd(&(bar)[XB_TMO], 1u); break; } } } } while (0)
struct XcdBarrier { unsigned* bar; unsigned x; volatile PG8_LAS unsigned* st; };
__device__ __forceinline__ XcdBarrier xcd_barrier_post(unsigned* bar, volatile PG8_LAS unsigned* st) {
    XcdBarrier b; b.bar = bar; b.x = xb_xcc_id(); b.st = st;
    if (threadIdx.x == 0) (void)xb_add(&bar[XB_XCNT(b.x)], 1u);
    return b;
}
__device__ __forceinline__ void xcd_barrier_complete(unsigned* bar, unsigned x, unsigned& nloc, unsigned& nx) {
    const unsigned G = gridDim.x * gridDim.y * gridDim.z;
    unsigned sum, cnt, mine, sp = 0u;
    for (;;) {
        sum = 0u; cnt = 0u; mine = 0u;
#pragma unroll
        for (unsigned j = 0; j < 16; ++j) { const unsigned c = xb_ld(&bar[XB_XCNT(j)]); sum += c; cnt += (c > 0u) ? 1u : 0u; mine = (j == x) ? c : mine; }
        if (sum == G) break;
        __builtin_amdgcn_s_sleep(1);
        if ((++sp & 255u) == 0u) { if (xb_ld(&bar[XB_TMO])) break; if (sp > XB_SPIN_CAP) { atomicAdd(&bar[XB_TMO], 1u); break; } }
    }
    nloc = mine > 0u ? mine : 1u; nx = cnt > 0u ? cnt : 1u;
}
__device__ __forceinline__ void xcd_barrier(const XcdBarrier& b) {
    asm volatile("s_waitcnt vmcnt(0)" ::: "memory");
    __syncthreads();
    if (threadIdx.x == 0) {
        unsigned* bar = b.bar;
        __builtin_amdgcn_s_waitcnt(0);
        unsigned nloc = b.st[0], nx = b.st[1];
        if (nloc == 0u) { xcd_barrier_complete(bar, b.x, nloc, nx); b.st[0] = nloc; b.st[1] = nx; }
        const unsigned old = xb_add(&bar[XB_XSUB(b.x)], 1u);
        const unsigned gen = old / nloc;
        if (old + 1u == (gen + 1u) * nloc) {
            __builtin_amdgcn_fence(__ATOMIC_RELEASE, "agent");
            asm volatile("s_waitcnt vmcnt(0)" ::: "memory");
            const unsigned og = xb_add(&bar[XB_TOP], 1u);
            const unsigned tg = og / nx;
            if (og + 1u == (tg + 1u) * nx) xb_add(&bar[XB_TOPGEN], 1u);
            else XB_SPIN(xb_ld(&bar[XB_TOPGEN]) == tg, bar);
            __builtin_amdgcn_fence(__ATOMIC_ACQUIRE, "agent");
            xb_add(&bar[XB_XGEN(b.x)], 1u);
            asm volatile("s_waitcnt vmcnt(0)" ::: "memory");
        } else {
            XB_SPIN(xb_ld(&bar[XB_XGEN(b.x)]) == gen, bar);
            __builtin_amdgcn_fence(__ATOMIC_ACQUIRE, "agent");
            asm volatile("s_waitcnt vmcnt(0)" ::: "memory");
        }
    }
    __syncthreads();
}

struct TJob { const float* src; int ld; unsigned char* dst; int lddst; float sc; const float* sk; int fp8; int rmap; };
__device__ __forceinline__ bool tjob_decode(const Params& p, int q, TJob& j) {
    constexpr int N_IN = 16 * 80, N_OUT = 16 * 32, N_G = 32 * 128;
    if (q < N_IN) { const int tr = q / 80, tc = q % 80; j.src = p.w_in + (size_t)tr * 128 * DIN + tc * 64; j.ld = DIN; j.sc = 1.f; j.sk = nullptr; j.fp8 = 0; j.lddst = D_ * 2; j.rmap = 0;
        if (tc < 48) j.dst = p.ws + OFF_WIN + ((size_t)tc * 64 * D_ + tr * 128) * 2;
        else { const int hsel = tc >= 64, ch0 = (tc - (hsel ? 64 : 48)) * 64; j.rmap = 1 + hsel;
               j.dst = p.ws + OFF_WIN + ((size_t)(3072 + 256 * (ch0 >> 7) + 2 * (ch0 & 127)) * D_ + tr * 128) * 2; }
        return true; } q -= N_IN;
    if (q < N_OUT) { const int tr = q / 32, tc = q % 32; j.src = p.w_out + (size_t)tr * 128 * D_ + tc * 64; j.ld = D_; j.dst = p.ws + OFF_WOUT + ((size_t)tc * 64 * D_ + tr * 128) * 2; j.lddst = D_ * 2; j.sc = 1.f;
        j.sk = (tr < 8 ? p.g_a + tr * 128 : p.g_b + (tr - 8) * 128); j.fp8 = 0; j.rmap = 0; return true; } q -= N_OUT;
    if (q < 2 * N_G) { const int up = q >= N_G; if (up) q -= N_G; const int e = q >> 7, rem = q & 127, tr = rem >> 3, tc = rem & 7, c0 = tc * 64;
        j.src = (up ? p.ewu : p.ewg) + (size_t)e * D_ * DE + (size_t)tr * 128 * DE + c0; j.ld = DE;
        j.dst = p.ws + OFF_WGU + (size_t)e * 1024 * D_ + (size_t)((c0 >> 7) * 256 + (up ? 128 : 0) + (c0 & 127)) * D_ + tr * 128; j.lddst = D_; j.sc = WGU_SCALE; j.sk = p.g_ffn + tr * 128; j.fp8 = 1; j.rmap = 0; return true; } q -= 2 * N_G;
    if (q < N_G) { const int e = q >> 7, rem = q & 127, tr = rem >> 5, tc = rem & 31;
        j.src = p.ewd + (size_t)e * DE * D_ + (size_t)tr * 128 * D_ + tc * 64; j.ld = D_; j.dst = p.ws + OFF_WD + (size_t)e * D_ * DE + (size_t)tc * 64 * DE + tr * 128; j.lddst = DE; j.sc = WD_SCALE; j.sk = nullptr; j.fp8 = 1; j.rmap = 0; return true; }
    return false;
}
constexpr int N_TJOBS_IN = 16 * 80, N_TJOBS_DENSE = 16 * 80 + 16 * 32, N_TJOBS_GU = N_TJOBS_DENSE + 2 * 32 * 128, N_TJOBS = N_TJOBS_GU + 32 * 128;
struct TRegs { f32x4 v[4]; };
__device__ __forceinline__ void tjob_load(const TJob& j, int tid, TRegs& r) {
    const float* sp = j.src + (size_t)(tid >> 2) * j.ld + (tid & 3) * 16;
#pragma unroll
    for (int q = 0; q < 4; ++q) r.v[q] = *(const f32x4*)(sp + 4 * q);
}
__device__ __forceinline__ void tjob_finish(const TJob& j, int tid, const TRegs& r, float* lt) {
    { const int rr = tid >> 2, cc = (tid & 3) * 16; const float f = j.sk ? j.sc * j.sk[rr] : j.sc;
#pragma unroll
      for (int q = 0; q < 4; ++q)
#pragma unroll
          for (int e = 0; e < 4; ++e) lt[rr * 65 + cc + 4 * q + e] = r.v[q][e] * f; }
    __syncthreads();
    { const int c = tid >> 3, rr = (tid & 7) * 16; float v[16];
#pragma unroll
      for (int q = 0; q < 16; ++q) v[q] = lt[(rr + q) * 65 + c];
      const int drow = j.rmap ? 8 * (c >> 2) + 4 * (j.rmap - 1) + (c & 3) : c;
      unsigned char* d = j.dst + (size_t)drow * j.lddst;
      if (j.fp8) { u32x4 w; w.x = pk4_fp8(v[0], v[1], v[2], v[3]); w.y = pk4_fp8(v[4], v[5], v[6], v[7]); w.z = pk4_fp8(v[8], v[9], v[10], v[11]); w.w = pk4_fp8(v[12], v[13], v[14], v[15]);
          *(u32x4*)(d + rr) = w; }
      else { u32x4 w0, w1; w0.x = cvt_pk_bf16(v[0], v[1]); w0.y = cvt_pk_bf16(v[2], v[3]); w0.z = cvt_pk_bf16(v[4], v[5]); w0.w = cvt_pk_bf16(v[6], v[7]);
          w1.x = cvt_pk_bf16(v[8], v[9]); w1.y = cvt_pk_bf16(v[10], v[11]); w1.z = cvt_pk_bf16(v[12], v[13]); w1.w = cvt_pk_bf16(v[14], v[15]);
          *(u32x4*)(d + rr * 2) = w0; *(u32x4*)(d + rr * 2 + 16) = w1; } }
}
__device__ __forceinline__ void run_tjobs(const Params& p, unsigned char* lds, int qlo, int qhi, int k0 = 0, int k1 = 1 << 20, int first = -1, int stride = 0) {
    const int tid = opaque_tid(), nb = stride > 0 ? stride : (int)gridDim.x;
    float* lt0 = (float*)lds; float* lt1 = lt0 + 128 * 65;
    TJob j0, j1, j2; TRegs r0, r1, r2;
    int k = k0; const int qb = qlo + (first >= 0 ? first : (int)blockIdx.x);
#define TJ_OK(kk, jj) ((kk) < k1 && qb + (kk) * nb < qhi && tjob_decode(p, qb + (kk) * nb, jj))
    bool h0 = TJ_OK(k, j0), h1 = TJ_OK(k + 1, j1), h2 = TJ_OK(k + 2, j2);
    if (h0) tjob_load(j0, tid, r0); if (h1) tjob_load(j1, tid, r1); if (h2) tjob_load(j2, tid, r2);
    while (h0) {
        tjob_finish(j0, tid, r0, lt0); k += 3; h0 = TJ_OK(k, j0); if (h0) tjob_load(j0, tid, r0);
        if (!h1) break;
        tjob_finish(j1, tid, r1, lt1); h1 = TJ_OK(k + 1, j1); if (h1) tjob_load(j1, tid, r1);
        if (!h2) break;
        tjob_finish(j2, tid, r2, lt0); h2 = TJ_OK(k + 2, j2); if (h2) tjob_load(j2, tid, r2);
        if (!h0) break;
        tjob_finish(j0, tid, r0, lt1); k += 3; h0 = TJ_OK(k, j0); if (h0) tjob_load(j0, tid, r0);
        if (!h1) break;
        tjob_finish(j1, tid, r1, lt0); h1 = TJ_OK(k + 1, j1); if (h1) tjob_load(j1, tid, r1);
        if (!h2) break;
        tjob_finish(j2, tid, r2, lt1); h2 = TJ_OK(k + 2, j2); if (h2) tjob_load(j2, tid, r2);
    }
#undef TJ_OK
    __syncthreads();
}
__device__ __forceinline__ void phase0(const Params& p, unsigned char* lds) {
    const int tid = opaque_tid(), nb = gridDim.x, bid = blockIdx.x, wid = tid >> 6, lane = tid & 63;
    { float* z = (float*)(p.ws + OFF_SSQ);
      for (int i = bid * NTHR + tid; i < 3 * T_ + 64; i += nb * NTHR) z[i] = 0.f;
      if (DUP_PHASE >= 2 && DUP_PHASE <= 4) { float* zd = (float*)(p.ws + OFF_SSQ + (OFF_DUMMY - OFF_SSQ)); for (int i = bid * NTHR + tid; i < 3 * T_ + 64; i += nb * NTHR) zd[i] = 0.f; } }
    { bf16_t* wrt = (bf16_t*)(p.ws + OFF_WR);
      for (int i = bid * NTHR + tid; i < 48 * D_; i += nb * NTHR) {
          const int o = i >> 11, k = i & 2047; float v = 0.f;
          if (o < 4) v = p.rgw[k * 4 + o]; else if (o < 36) v = p.rew[k * 32 + (o - 4)];
          wrt[i] = (bf16_t)(cvt_pk_bf16(v * p.g_ffn[k], 0.f) & 0xffffu); } }
    { bf16_t* xn = (bf16_t*)(p.ws + OFF_B);
      for (int row = bid * 8 + wid; row < T_; row += nb * 8) {
          const float* xr = p.x + (size_t)row * D_;
          f32x4 v[8]; float s = 0.f;
#pragma unroll
          for (int i = 0; i < 8; ++i) { v[i] = *(const f32x4*)(xr + i * 256 + lane * 4); s += (v[i][0] * v[i][0] + v[i][1] * v[i][1]) + (v[i][2] * v[i][2] + v[i][3] * v[i][3]); }
          const float rstd = rsqrtf(wave_sum(s) * (1.f / D_) + EPS);
#pragma unroll
          for (int i = 0; i < 8; ++i) { const f32x4 g = *(const f32x4*)(p.norm_mix_g + i * 256 + lane * 4); const f32x4 o = v[i] * rstd * g;
              u32x2 w; w.x = cvt_pk_bf16(o[0], o[1]); w.y = cvt_pk_bf16(o[2], o[3]); *(u32x2*)(xn + (size_t)row * D_ + i * 256 + lane * 4) = w; } } }
    run_tjobs(p, lds, 0, N_TJOBS_IN);
}

__device__ __forceinline__ int side_rounds(int nb) { return (N_TJOBS_GU - N_TJOBS_IN + nb - 1) / nb; }
__device__ __forceinline__ void phase1(const Params& p, unsigned char* lds) {
    const Epi1 E{p.ws};
    pg8::StaticOrder S; S.init(T_, DIN, gridDim.x, blockIdx.x); const pg8::AOffDirect AO{D_};
    const int nu = S.count(), col = blockIdx.x & 3, split = col == 0 ? 0 : col == 1 ? (2 * nu) / 5 : col == 2 ? (3 * nu) / 5 : nu;
    const int kr = side_rounds(gridDim.x), k1 = (2 * kr) / 3;
    S.i0 = 0; S.i1 = split;
    pg8::gemm_phase<Epi1, pg8::StaticOrder, pg8::AOffDirect, true>((PG8_LAS unsigned char*)lds, (const bf16_t*)(p.ws + OFF_B), (const bf16_t*)(p.ws + OFF_WIN), D_, S, AO, E);
    run_tjobs(p, lds, N_TJOBS_IN, N_TJOBS_GU, 0, k1);
    S.i0 = split; S.i1 = nu;
    pg8::gemm_phase<Epi1, pg8::StaticOrder, pg8::AOffDirect, true>((PG8_LAS unsigned char*)lds, (const bf16_t*)(p.ws + OFF_B), (const bf16_t*)(p.ws + OFF_WIN), D_, S, AO, E);
}

__device__ __forceinline__ void mixer_gmlp_item(const Params& p, unsigned char* lds, int item, size_t so) {
    const int tid = opaque_tid(), wid = tid >> 6, lane = tid & 63, fr = lane & 15, fq = lane >> 4;
    const int h = item & 7, t0 = (item >> 3) * 128;
    const bf16_t* P = (const bf16_t*)(p.ws + OFF_A); bf16_t* Y = (bf16_t*)(p.ws + OFF_B); float* ssq_a = (float*)(p.ws + OFF_SSQ + so);
    bf16_t* Vt = (bf16_t*)lds;
    bf16_t* Wl = Vt + 128 * 136;
    float* rs = (float*)(Wl + 128 * 136);
    { const int j = tid >> 2, dc = (tid & 3) * 32;
      const u32x4* src = (const u32x4*)(P + (size_t)(t0 + j) * DP + 1024 + h * 128 + dc);
      u32x4 v[4]; float s = 0.f;
#pragma unroll
      for (int q = 0; q < 4; ++q) { v[q] = src[q];
#pragma unroll
          for (int w = 0; w < 4; ++w) { const float lo = bflo(v[q][w]), hi = bfhi(v[q][w]); s += lo * lo + hi * hi; } }
      s += __shfl_xor(s, 1); s += __shfl_xor(s, 2);
      if ((tid & 3) == 0) rs[j] = rsqrtf(s * (1.f / 128.f) + EPS);
#pragma unroll
      for (int q = 0; q < 4; ++q)
#pragma unroll
          for (int w = 0; w < 4; ++w) { const int d = dc + q * 8 + w * 2; Vt[d * 136 + j] = (bf16_t)(v[q][w] & 0xffffu); Vt[(d + 1) * 136 + j] = (bf16_t)(v[q][w] >> 16); } }
    __syncthreads();
    { const int i = tid >> 2, jc = (tid & 3) * 32;
      const f32x4* src = (const f32x4*)(p.gmlp_ws + (size_t)h * 16384 + i * 128 + jc);
      const bool live = (i >> 6) >= (jc >> 6);
#pragma unroll
      for (int q = 0; q < 4; ++q) { f32x4 w0 = src[2 * q], w1 = src[2 * q + 1];
          const f32x4 r0 = *(const f32x4*)(rs + jc + 8 * q), r1 = *(const f32x4*)(rs + jc + 8 * q + 4);
          w0 = live ? w0 * r0 : (f32x4){0.f, 0.f, 0.f, 0.f}; w1 = live ? w1 * r1 : (f32x4){0.f, 0.f, 0.f, 0.f};
          u32x4 o; o.x = cvt_pk_bf16(w0[0], w0[1]); o.y = cvt_pk_bf16(w0[2], w0[3]); o.z = cvt_pk_bf16(w1[0], w1[1]); o.w = cvt_pk_bf16(w1[2], w1[3]);
          *(u32x4*)(Wl + i * 136 + jc + 8 * q) = o; } }
    __syncthreads();
    f32x4 acc[8];
#pragma unroll
    for (int n = 0; n < 8; ++n) acc[n] = (f32x4){0.f, 0.f, 0.f, 0.f};
    const int ksteps = (wid < 4) ? 2 : 4;
    for (int ks = 0; ks < ksteps; ++ks) {
        const bf16x8 bw = *(const bf16x8*)(Wl + (16 * wid + fr) * 136 + ks * 32 + fq * 8);
#pragma unroll
        for (int n = 0; n < 8; ++n) { const bf16x8 av = *(const bf16x8*)(Vt + (16 * n + fr) * 136 + ks * 32 + fq * 8);
            acc[n] = __builtin_amdgcn_mfma_f32_16x16x32_bf16(av, bw, acc[n], 0, 0, 0); }
    }
    { const int i = 16 * wid + fr, t = t0 + i; const float bias = p.gmlp_bs[h * 128 + i]; float ss = 0.f;
#pragma unroll
      for (int n = 0; n < 8; ++n) { const int c = h * 128 + 16 * n + 4 * fq;
          const f32x4 g = *(const f32x4*)(p.v_norm_g + c); const u32x2 uu = *(const u32x2*)(P + (size_t)t * DP + c);
          const float y0 = bflo(uu.x) * (acc[n][0] * g[0] + bias), y1 = bfhi(uu.x) * (acc[n][1] * g[1] + bias), y2 = bflo(uu.y) * (acc[n][2] * g[2] + bias), y3 = bfhi(uu.y) * (acc[n][3] * g[3] + bias);
          ss += (y0 * y0 + y1 * y1) + (y2 * y2 + y3 * y3);
          u32x2 w; w.x = cvt_pk_bf16(y0, y1); w.y = cvt_pk_bf16(y2, y3); *(u32x2*)(Y + (size_t)t * D_ + c) = w; }
      ss += __shfl_xor(ss, 16); ss += __shfl_xor(ss, 32);
      if (fq == 0) atomicAdd(ssq_a + t, ss); }
    __syncthreads();
}
__device__ __forceinline__ void mixer_conv_item(const Params& p, int item, size_t so) {
    const int tid = opaque_tid(), cl = tid & 31, ts = tid >> 5;
    const int c = (item & 3) * 256 + cl * 8, tbeg = (item >> 2) * 128 + ts * 8;
    const bf16_t* P = (const bf16_t*)(p.ws + OFF_A); bf16_t* Y = (bf16_t*)(p.ws + OFF_B); float* ssq_b = (float*)(p.ws + OFF_SSQ + so) + T_;
    float w0[8], w1[8], w2[8], z1[8], z2[8];
    { const f32x4 a0 = *(const f32x4*)(p.conv_w + c), a1 = *(const f32x4*)(p.conv_w + c + 4), b0 = *(const f32x4*)(p.conv_w + 1024 + c), b1 = *(const f32x4*)(p.conv_w + 1024 + c + 4),
                  c0 = *(const f32x4*)(p.conv_w + 2048 + c), c1 = *(const f32x4*)(p.conv_w + 2048 + c + 4);
#pragma unroll
      for (int q = 0; q < 4; ++q) { w0[q] = a0[q]; w0[4 + q] = a1[q]; w1[q] = b0[q]; w1[4 + q] = b1[q]; w2[q] = c0[q]; w2[4 + q] = c1[q]; } }
#pragma unroll
    for (int q = 0; q < 8; ++q) { z1[q] = 0.f; z2[q] = 0.f; }
    if ((tbeg % SEQ) != 0) {
        const u32x4 za = *(const u32x4*)(P + (size_t)(tbeg - 1) * DP + 3072 + c), zb = *(const u32x4*)(P + (size_t)(tbeg - 2) * DP + 3072 + c);
#pragma unroll
        for (int q = 0; q < 4; ++q) { z1[2 * q] = bflo(za[q]); z1[2 * q + 1] = bfhi(za[q]); z2[2 * q] = bflo(zb[q]); z2[2 * q + 1] = bfhi(zb[q]); }
    }
    u32x4 bgA[8], zA[8];
#pragma unroll
    for (int tt = 0; tt < 8; ++tt) { const bf16_t* pr = P + (size_t)(tbeg + tt) * DP + c; bgA[tt] = *(const u32x4*)(pr + 2048); zA[tt] = *(const u32x4*)(pr + 3072); }
#pragma unroll
    for (int tt = 0; tt < 8; ++tt) {
        const int t = tbeg + tt;
        const u32x4 bg = bgA[tt], zv = zA[tt];
        float z[8], y[8], ss = 0.f;
#pragma unroll
        for (int q = 0; q < 4; ++q) { z[2 * q] = bflo(zv[q]); z[2 * q + 1] = bfhi(zv[q]); }
#pragma unroll
        for (int q = 0; q < 4; ++q) {
            y[2 * q] = bflo(bg[q]) * (w0[2 * q] * z2[2 * q] + w1[2 * q] * z1[2 * q] + w2[2 * q] * z[2 * q]);
            y[2 * q + 1] = bfhi(bg[q]) * (w0[2 * q + 1] * z2[2 * q + 1] + w1[2 * q + 1] * z1[2 * q + 1] + w2[2 * q + 1] * z[2 * q + 1]); }
#pragma unroll
        for (int q = 0; q < 8; ++q) { ss += y[q] * y[q]; z2[q] = z1[q]; z1[q] = z[q]; }
        u32x4 w; w.x = cvt_pk_bf16(y[0], y[1]); w.y = cvt_pk_bf16(y[2], y[3]); w.z = cvt_pk_bf16(y[4], y[5]); w.w = cvt_pk_bf16(y[6], y[7]);
        *(u32x4*)(Y + (size_t)t * D_ + 1024 + c) = w;
        ss += __shfl_xor(ss, 1); ss += __shfl_xor(ss, 2); ss += __shfl_xor(ss, 4); ss += __shfl_xor(ss, 8); ss += __shfl_xor(ss, 16);
        if (cl == 0) atomicAdd(ssq_b + t, ss);
    }
}
__device__ __forceinline__ void phase2(const Params& p, unsigned char* lds, size_t so = 0) {
    for (int it = blockIdx.x; it < 512 + 1024; it += gridDim.x) { if (it < 512) mixer_conv_item(p, it, so); else mixer_gmlp_item(p, lds, it - 512, so); }
}

__device__ __forceinline__ void phase3(const Params& p, unsigned char* lds, size_t so = 0) {
    pg8::StaticOrder S; S.init(T_, D_, gridDim.x, blockIdx.x); const pg8::AOffDirect AO{D_};
    PG8_LAS float* rsl = (PG8_LAS float*)((PG8_LAS unsigned char*)lds + RS_OFF);
    { const float* ssq = (const float*)(p.ws + OFF_SSQ); const int tid = opaque_tid();
      for (int i = 0; i < RS_UNITS; ++i) { Unit u; if (!S.next(i, u)) break;
          if (tid < 256) { const int row = u.pm * 256 + tid; const float va = ssq[row] * (1.f / 1024.f) + EPS, vb = ssq[T_ + row] * (1.f / 1024.f) + EPS;
              rsl[(i * 256 + tid) * 2] = __builtin_amdgcn_sqrtf(vb * __builtin_amdgcn_rcpf(va)); rsl[(i * 256 + tid) * 2 + 1] = __builtin_amdgcn_rsqf(vb); } }
      __syncthreads(); }
    const Epi2 E{p.x, p.ws, so, rsl};
    const int kr = side_rounds(gridDim.x), k0 = (2 * kr) / 3; const bool side = (so == 0);
    const int col = blockIdx.x & 3, km = k0 + ((kr - k0) * col + 1) / 3;
    if (side) run_tjobs(p, lds, N_TJOBS_IN, N_TJOBS_GU, k0, km);
    pg8::gemm_phase<Epi2, pg8::StaticOrder, pg8::AOffDirect, true>((PG8_LAS unsigned char*)lds, (const bf16_t*)(p.ws + OFF_B), (const bf16_t*)(p.ws + OFF_WOUT), D_, S, AO, E);
    if (side) run_tjobs(p, lds, N_TJOBS_IN, N_TJOBS_GU, km, kr);
}

__device__ __forceinline__ void route_item(const Params& p, unsigned char* lds, int item, size_t so) {
    const int tid = opaque_tid(), wid = tid >> 6, lane = tid & 63, fr = lane & 15, fq = lane >> 4;
    float* lg = (float*)lds;
    float* ls = lg + 8 * 64 * 48;
    int* lcnt = (int*)(ls + 64 * 48); int* lbase = lcnt + 32;
    const bf16_t* hb = (const bf16_t*)(p.ws + OFF_HB); const bf16_t* wrt = (const bf16_t*)(p.ws + OFF_WR);
    const float* ssq_h = (const float*)(p.ws + OFF_SSQ) + 2 * T_;
    int* cnt = (int*)(p.ws + OFF_CNT + so); int* rinfo = (int*)(p.ws + OFF_RINFO + so); float* rw = (float*)(p.ws + OFF_RW + so);
    const int t0 = item * 64;
    if (tid < 32) lcnt[tid] = 0;
    f32x4 acc[4][3];
#pragma unroll
    for (int m = 0; m < 4; ++m)
#pragma unroll
        for (int n = 0; n < 3; ++n) acc[m][n] = (f32x4){0.f, 0.f, 0.f, 0.f};
    const bf16_t* ap = hb + (size_t)(t0 + fr) * D_ + wid * 256 + fq * 8; const bf16_t* bp = wrt + (size_t)fr * D_ + wid * 256 + fq * 8;
#pragma unroll 4
    for (int ks = 0; ks < 8; ++ks) {
        bf16x8 a[4], b[3];
#pragma unroll
        for (int m = 0; m < 4; ++m) a[m] = *(const bf16x8*)(ap + (size_t)m * 16 * D_ + ks * 32);
#pragma unroll
        for (int n = 0; n < 3; ++n) b[n] = *(const bf16x8*)(bp + (size_t)n * 16 * D_ + ks * 32);
#pragma unroll
        for (int m = 0; m < 4; ++m)
#pragma unroll
            for (int n = 0; n < 3; ++n) acc[m][n] = __builtin_amdgcn_mfma_f32_16x16x32_bf16(a[m], b[n], acc[m][n], 0, 0, 0);
    }
#pragma unroll
    for (int m = 0; m < 4; ++m)
#pragma unroll
        for (int n = 0; n < 3; ++n)
#pragma unroll
            for (int j = 0; j < 4; ++j) lg[(wid * 64 + m * 16 + 4 * fq + j) * 48 + 16 * n + fr] = acc[m][n][j];
    __syncthreads();
    for (int i = tid; i < 64 * 48; i += NTHR) { float v = 0.f;
#pragma unroll
        for (int w = 0; w < 8; ++w) v += lg[w * 64 * 48 + i];
        ls[i] = v; }
    __syncthreads();
    int e0 = 0, e1 = 0, r0 = 0, r1 = 0; float g0 = 0.f, g1 = 0.f, rsc = 0.f; const int t = t0 + tid;
    if (tid < 64) {
        const float* l0 = ls + tid * 48; const float rstd = rsqrtf(ssq_h[t] * (1.f / D_) + EPS); rsc = rstd * (1.f / WGU_SCALE);
        float gm = -3.0e38f; int gi = 0; float gl[4];
#pragma unroll
        for (int o = 0; o < 4; ++o) { gl[o] = l0[o] * rstd + p.rgb[o]; if (gl[o] > gm) { gm = gl[o]; gi = o; } }
        float gs = 0.f;
#pragma unroll
        for (int o = 0; o < 4; ++o) gs += __expf(gl[o] - gm);
        const float pg = 1.f / gs;
        float b1 = -3.0e38f, b2 = -3.0e38f; int i1 = 0, i2 = 0;
        for (int q = 0; q < 8; ++q) { const float v = l0[4 + gi * 8 + q] * rstd + p.reb[gi * 8 + q];
            if (v > b1) { b2 = b1; i2 = i1; b1 = v; i1 = q; } else if (v > b2) { b2 = v; i2 = q; } }
        const float wa = 1.f / (1.f + __expf(b2 - b1));
        e0 = gi * 8 + i1; e1 = gi * 8 + i2; g0 = pg * wa; g1 = pg * (1.f - wa);
        r0 = atomicAdd(&lcnt[e0], 1); r1 = atomicAdd(&lcnt[e1], 1);
    }
    __syncthreads();
    if (tid < 32) lbase[tid] = atomicAdd(cnt + tid, lcnt[tid]);
    __syncthreads();
    if (tid < 64) { const int i0 = lbase[e0] + r0, i1 = lbase[e1] + r1;
        rinfo[e0 * LCAP + i0] = (int)((cvt_pk_bf16(g0, 0.f) << 16) | (unsigned)(2 * t)); rinfo[e1 * LCAP + i1] = (int)((cvt_pk_bf16(g1, 0.f) << 16) | (unsigned)(2 * t + 1));
        rw[e0 * LCAP + i0] = rsc; rw[e1 * LCAP + i1] = rsc; }
    __syncthreads();
}
__device__ __forceinline__ void phase4(const Params& p, unsigned char* lds, size_t so = 0) { for (int it = blockIdx.x; it < T_ / 64; it += gridDim.x) route_item(p, lds, it, so); }

__device__ __forceinline__ PG8_LAS int* moe_tables_to_lds(const Params& p, unsigned char* lds) {
    PG8_LAS int* tb = (PG8_LAS int*)((PG8_LAS unsigned char*)lds + LCNT_OFF); const int* cnt = (const int*)(p.ws + OFF_CNT);
    if (threadIdx.x < NE) tb[MT_CNT + threadIdx.x] = __hip_atomic_load(cnt + threadIdx.x, __ATOMIC_RELAXED, __HIP_MEMORY_SCOPE_AGENT);
    __syncthreads();
    if (threadIdx.x == 0) { int pt = 0;
#pragma clang loop unroll(disable)
        for (int e = 0; e < NE; ++e) { const int nt = (tb[MT_CNT + e] + 255) >> 8; tb[MT_PST + e] = pt;
#pragma clang loop unroll(disable)
            for (int i = 0; i < nt; ++i) tb[MT_T2E + pt + i] = e;
            pt += nt; }
        tb[MT_PST + NE] = pt; tb[MT_NT] = pt; }
    __syncthreads();
    return tb;
}
__device__ __forceinline__ void phase5(const Params& p, unsigned char* lds) {
    PG8_LAS int* lc = moe_tables_to_lds(p, lds);
    const Epi5 E{p.ws, lc};
    const pg8::MoeOrder S{lc, 4, (int)gridDim.x, (int)blockIdx.x}; const pg8::AOffGather AO{p.ws, lc, D_ / 2};
    pg8::gemm_phase<Epi5, pg8::MoeOrder, pg8::AOffGather, true, true>((PG8_LAS unsigned char*)lds, (const bf16_t*)(p.ws + OFF_H8), (const bf16_t*)(p.ws + OFF_WGU), D_ / 2, S, AO, E);
    { const int G = gridDim.x, c = blockIdx.x, U = 4 * __builtin_amdgcn_readfirstlane(lc[MT_NT]), rem = U % G;
      if (rem == 0) run_tjobs(p, lds, N_TJOBS_GU, N_TJOBS, 0, 1 << 20, c, G);
      else if (c >= rem) run_tjobs(p, lds, N_TJOBS_GU, N_TJOBS, 0, 1 << 20, c - rem, G - rem); }
}
__device__ __forceinline__ void phase6(const Params& p, unsigned char* lds) {
    PG8_LAS int* lc = moe_tables_to_lds(p, lds);
    const Epi6 E{p.ws, lc};
    const pg8::MoeOrder S{lc, 8, (int)gridDim.x, (int)blockIdx.x}; const pg8::AOffDirect AO{DE / 2};
    pg8::gemm_phase<Epi6, pg8::MoeOrder, pg8::AOffDirect, true, true>((PG8_LAS unsigned char*)lds, (const bf16_t*)(p.ws + OFF_B), (const bf16_t*)(p.ws + OFF_WD), DE / 2, S, AO, E);
}
__device__ __forceinline__ void phase7(const Params& p) {
    const int tid = opaque_tid(), wid = tid >> 6, lane = tid & 63;
    const bf16_t* hb = (const bf16_t*)(p.ws + OFF_HB); const unsigned char* ys2 = p.ws + OFF_A;
    for (int t = blockIdx.x * 8 + wid; t < T_; t += gridDim.x * 8) {
        float v[4][8]; float s = 0.f;
#pragma unroll
        for (int i = 0; i < 4; ++i) { const int c = i * 512 + lane * 8;
            const u32x4 a = *(const u32x4*)(hb + (size_t)t * D_ + c); const u32x2 b = *(const u32x2*)(ys2 + (size_t)(2 * t) * D_ + c), d = *(const u32x2*)(ys2 + (size_t)(2 * t + 1) * D_ + c);
            float y0[8], y1[8];
            up4_fp8(b.x, y0[0], y0[1], y0[2], y0[3]); up4_fp8(b.y, y0[4], y0[5], y0[6], y0[7]); up4_fp8(d.x, y1[0], y1[1], y1[2], y1[3]); up4_fp8(d.y, y1[4], y1[5], y1[6], y1[7]);
#pragma unroll
            for (int q = 0; q < 4; ++q) { v[i][2 * q] = bflo(a[q]) + (y0[2 * q] + y1[2 * q]) * (1.f / YS_SCALE); v[i][2 * q + 1] = bfhi(a[q]) + (y0[2 * q + 1] + y1[2 * q + 1]) * (1.f / YS_SCALE);
                s += v[i][2 * q] * v[i][2 * q] + v[i][2 * q + 1] * v[i][2 * q + 1]; } }
        const float rstd = rsqrtf(wave_sum(s) * (1.f / D_) + EPS);
#pragma unroll
        for (int i = 0; i < 4; ++i) { const int c = i * 512 + lane * 8;
            const f32x4 g0 = *(const f32x4*)(p.g_final + c), g1 = *(const f32x4*)(p.g_final + c + 4);
            f32x4 o0, o1;
#pragma unroll
            for (int q = 0; q < 4; ++q) { o0[q] = v[i][q] * rstd * g0[q]; o1[q] = v[i][4 + q] * rstd * g1[q]; }
            *(f32x4*)(p.out + (size_t)t * D_ + c) = o0; *(f32x4*)(p.out + (size_t)t * D_ + c + 4) = o1; }
    }
}

#ifndef ONE_LAUNCH
#define ONE_LAUNCH 1
#endif
template <int PH> __global__ void __launch_bounds__(NTHR, 2) k_phase(Params p) {
    extern __shared__ __attribute__((aligned(16))) unsigned char lds[];
    if (PH == 0) phase0(p, lds);
    if (PH == 1) phase1(p, lds);
    if (PH == 2) phase2(p, lds);
    if (PH == 3) phase3(p, lds);
    if (PH == 4) phase4(p, lds);
    if (PH == 5) phase5(p, lds);
    if (PH == 6) phase6(p, lds);
    if (PH == 7) phase7(p);
}
__global__ void __launch_bounds__(NTHR, 2) k_mega(Params p) {
    extern __shared__ __attribute__((aligned(16))) unsigned char lds[];
    cg::grid_group grid = cg::this_grid();
    volatile PG8_LAS unsigned* bst = (volatile PG8_LAS unsigned*)((PG8_LAS unsigned char*)lds + LBAR_OFF);
    if (threadIdx.x < 2) bst[threadIdx.x] = 0u;
    __syncthreads();
    (void)xcd_barrier_post((unsigned*)(p.ws + OFF_BAR), bst);
#define GRID_BAR() do { XcdBarrier b_; b_.bar = (unsigned*)(opaque_ws(p.ws) + OFF_BAR); b_.x = xb_xcc_id(); b_.st = bst; xcd_barrier(b_); } while (0)
    if (DUP_PHASE == 0) { phase0(p, lds); GRID_BAR(); }
    if (p.ws == nullptr) grid.sync();
    phase0(p, lds); GRID_BAR();
    if (DUP_PHASE == 1) { phase1(p, lds); GRID_BAR(); }
    phase1(p, lds); GRID_BAR();
    if (DUP_PHASE == 2) { phase2(p, lds, OFF_DUMMY - OFF_SSQ); GRID_BAR(); }
    phase2(p, lds); GRID_BAR();
    if (DUP_PHASE == 3) { phase3(p, lds, OFF_DUMMY - OFF_SSQ); GRID_BAR(); }
    phase3(p, lds); GRID_BAR();
    if (DUP_PHASE == 4) { phase4(p, lds, OFF_DUMMY - OFF_SSQ); GRID_BAR(); }
    phase4(p, lds); GRID_BAR();
    if (DUP_PHASE == 5) { phase5(p, lds); GRID_BAR(); }
    phase5(p, lds); GRID_BAR();
    if (DUP_PHASE == 6) { phase6(p, lds); GRID_BAR(); }
    phase6(p, lds); GRID_BAR();
    if (DUP_PHASE == 8) { for (int i = 0; i < 10; ++i) GRID_BAR(); }
    if (DUP_PHASE == 9) { grid.sync(); grid.sync(); }
    if (DUP_PHASE == 7) { phase7(p); GRID_BAR(); }
    phase7(p);
}

extern "C" void kernel_launch(void* const* d_in, const int* in_sizes, int n_in, void* d_out, int out_size, void* d_ws, size_t ws_size, hipStream_t stream) {
    static int grid = 0;
    if (grid == 0) {
        if (n_in != 19 || in_sizes[0] != T_ * D_ || out_size != T_ * D_ || ws_size < WS_END + (DUP_PHASE >= 2 && DUP_PHASE <= 4 ? DUMMY_BYTES : 0)) { fprintf(stderr, "kernel_launch: unexpected shapes (n_in %d, in0 %d, out %d, ws %zu < %zu); nothing launched\n", n_in, n_in > 0 ? in_sizes[0] : -1, out_size, ws_size, (size_t)WS_END); grid = -1; return; }
        int dev = 0, cus = 0, per_cu = 0;
        if (hipGetDevice(&dev) != hipSuccess || hipDeviceGetAttribute(&cus, hipDeviceAttributeMultiprocessorCount, dev) != hipSuccess) { grid = -1; return; }
#if ONE_LAUNCH
        if (hipFuncSetAttribute((const void*)k_mega, hipFuncAttributeMaxDynamicSharedMemorySize, LDS_BYTES) != hipSuccess) { fprintf(stderr, "kernel_launch: hipFuncSetAttribute failed\n"); grid = -1; return; }
        if (hipOccupancyMaxActiveBlocksPerMultiprocessor(&per_cu, (const void*)k_mega, NTHR, LDS_BYTES) != hipSuccess || per_cu < 1) { fprintf(stderr, "kernel_launch: occupancy query says %d blocks per CU\n", per_cu); grid = -1; return; }
        grid = cus * per_cu;
#else
        (void)hipFuncSetAttribute((const void*)k_phase<0>, hipFuncAttributeMaxDynamicSharedMemorySize, LDS_BYTES);
        (void)hipFuncSetAttribute((const void*)k_phase<1>, hipFuncAttributeMaxDynamicSharedMemorySize, LDS_BYTES);
        (void)hipFuncSetAttribute((const void*)k_phase<2>, hipFuncAttributeMaxDynamicSharedMemorySize, LDS_BYTES);
        (void)hipFuncSetAttribute((const void*)k_phase<3>, hipFuncAttributeMaxDynamicSharedMemorySize, LDS_BYTES);
        (void)hipFuncSetAttribute((const void*)k_phase<4>, hipFuncAttributeMaxDynamicSharedMemorySize, LDS_BYTES);
        (void)hipFuncSetAttribute((const void*)k_phase<5>, hipFuncAttributeMaxDynamicSharedMemorySize, LDS_BYTES);
        (void)hipFuncSetAttribute((const void*)k_phase<6>, hipFuncAttributeMaxDynamicSharedMemorySize, LDS_BYTES);
        (void)hipFuncSetAttribute((const void*)k_phase<7>, hipFuncAttributeMaxDynamicSharedMemorySize, LDS_BYTES);
        grid = cus > 0 ? cus : 256;
#endif
    }
    if (grid < 0) return;
    Params p{};
    const float** f = (const float**)&p;
    for (int i = 0; i < 19; ++i) f[i] = (const float*)d_in[i];
    p.out = (float*)d_out; p.ws = (unsigned char*)d_ws;
#if ONE_LAUNCH
    if (hipMemsetAsync((unsigned char*)d_ws + OFF_BAR, 0, BAR_BYTES, stream) != hipSuccess) { fprintf(stderr, "kernel_launch: memset of the barrier words failed\n"); return; }
    void* args[] = {&p};
    const hipError_t e = hipLaunchCooperativeKernel((const void*)k_mega, dim3(grid), dim3(NTHR), args, LDS_BYTES, stream);
    if (e != hipSuccess) fprintf(stderr, "kernel_launch: cooperative launch failed: %s (grid %d)\n", hipGetErrorString(e), grid);
#else
    hipLaunchKernelGGL(k_phase<0>, dim3(grid), dim3(NTHR), LDS_BYTES, stream, p);
    hipLaunchKernelGGL(k_phase<1>, dim3(grid), dim3(NTHR), LDS_BYTES, stream, p);
    hipLaunchKernelGGL(k_phase<2>, dim3(grid), dim3(NTHR), LDS_BYTES, stream, p);
    hipLaunchKernelGGL(k_phase<3>, dim3(grid), dim3(NTHR), LDS_BYTES, stream, p);
    hipLaunchKernelGGL(k_phase<4>, dim3(grid), dim3(NTHR), LDS_BYTES, stream, p);
    hipLaunchKernelGGL(k_phase<5>, dim3(grid), dim3(NTHR), LDS_BYTES, stream, p);
    hipLaunchKernelGGL(k_phase<6>, dim3(grid), dim3(NTHR), LDS_BYTES, stream, p);
    hipLaunchKernelGGL(k_phase<7>, dim3(grid), dim3(NTHR), LDS_BYTES, stream, p);
#endif
}
```

```cpp
#include <hip/hip_runtime.h>
#include <hip/hip_cooperative_groups.h>
#include <cstdio>
namespace cg = cooperative_groups;

typedef unsigned short bf16_t;
typedef float f32x4 __attribute__((ext_vector_type(4)));
typedef unsigned u32x4 __attribute__((ext_vector_type(4)));
typedef unsigned u32x2 __attribute__((ext_vector_type(2)));
typedef short bf16x8 __attribute__((ext_vector_type(8)));
typedef int v4i __attribute__((ext_vector_type(4)));
typedef int v8i __attribute__((ext_vector_type(8)));

constexpr int T_ = 16384, D_ = 2048, DIN = 5120, DP = 4096, NE = 32, DE = 512, SEQ = 4096, LCAP = 16384;
constexpr float EPS = 1e-6f;
#ifndef DUP_PHASE
#define DUP_PHASE -1
#endif
constexpr int NTHR = 512;
constexpr int LDS_BYTES = 163840;
constexpr int LCNT_OFF = 131072, LBAR_OFF = 131072 + 2048, XS_OFF = 131072 + 4096, XM_OFF = XS_OFF + 8192, RS_OFF = XM_OFF;
constexpr int RS_UNITS = 4;
static_assert(XM_OFF + 512 * 32 <= LDS_BYTES && RS_UNITS * 256 * 8 <= 512 * 32, "LDS map");

constexpr size_t SZ_A = (size_t)T_ * DIN * 2;
constexpr size_t SZ_B = (size_t)T_ * D_ * 2;
constexpr size_t OFF_A = 0;
constexpr size_t OFF_B = OFF_A + SZ_A;
constexpr size_t OFF_HB = OFF_B + SZ_B;
constexpr size_t OFF_H8 = OFF_A + (size_t)2 * T_ * D_ * 2;
constexpr float WGU_SCALE = 32.f, WD_SCALE = 16.f, YS_SCALE = 16.f;
constexpr size_t OFF_WIN = OFF_HB + SZ_B;
constexpr size_t OFF_WOUT = OFF_WIN + (size_t)DIN * D_ * 2;
constexpr size_t OFF_WGU = OFF_WOUT + (size_t)D_ * D_ * 2;
constexpr size_t OFF_WD = OFF_WGU + (size_t)NE * 1024 * D_ * 2;
constexpr size_t OFF_WR = OFF_WD + (size_t)NE * D_ * DE * 2;
constexpr size_t OFF_WSB = OFF_WR + (size_t)48 * D_ * 2;
constexpr size_t OFF_SSQ = OFF_WSB + (size_t)8 * 128 * 128 * 2;
constexpr size_t OFF_CNT = OFF_SSQ + (size_t)3 * T_ * 4;
constexpr size_t OFF_RINFO = OFF_CNT + 256;
constexpr size_t OFF_RW = OFF_RINFO + (size_t)NE * LCAP * 4;
constexpr size_t OFF_BAR = OFF_RW + (size_t)NE * LCAP * 4;
constexpr size_t BAR_BYTES = 16384;
constexpr size_t WS_END = OFF_BAR + BAR_BYTES;
constexpr size_t OFF_DUMMY = WS_END;
constexpr size_t DUMMY_BYTES = (OFF_BAR - OFF_SSQ);

struct Params {
    const float *x, *norm_mix_g, *w_in, *v_norm_g, *gmlp_ws, *gmlp_bs, *conv_w, *g_a, *g_b, *w_out, *g_ffn, *rgw, *rgb, *rew, *reb, *ewg, *ewu, *ewd, *g_final;
    float* out; unsigned char* ws;
};

__device__ __forceinline__ unsigned cvt_pk_bf16(float lo, float hi) { unsigned r; asm volatile("v_cvt_pk_bf16_f32 %0, %1, %2" : "=v"(r) : "v"(lo), "v"(hi)); return r; }
#define GAS __attribute__((address_space(1)))
typedef GAS unsigned char gbyte;
__device__ __forceinline__ gbyte* opaque_ws(unsigned char* w) { gbyte* g = (gbyte*)w; asm volatile("" : "+s"(g)); return g; }
__device__ __forceinline__ int opaque_tid() { int t = threadIdx.x; asm volatile("" : "+v"(t)); return t; }
__device__ __forceinline__ unsigned pk4_fp8(float a, float b, float c, float d) { int w = 0; w = __builtin_amdgcn_cvt_pk_fp8_f32(a, b, w, false); w = __builtin_amdgcn_cvt_pk_fp8_f32(c, d, w, true); return (unsigned)w; }
__device__ __forceinline__ void up4_fp8(unsigned w, float& a, float& b, float& c, float& d) {
    const auto lo = __builtin_amdgcn_cvt_pk_f32_fp8((int)w, false), hi = __builtin_amdgcn_cvt_pk_f32_fp8((int)w, true); a = lo[0]; b = lo[1]; c = hi[0]; d = hi[1]; }
__device__ __forceinline__ float bflo(unsigned w) { return __uint_as_float(w << 16); }
__device__ __forceinline__ float bfhi(unsigned w) { return __uint_as_float(w & 0xffff0000u); }
__device__ __forceinline__ float wave_sum(float v) {
#pragma unroll
    for (int o = 1; o < 64; o <<= 1) v += __shfl_xor(v, o);
    return v;
}
__device__ __forceinline__ float gelu_t(float x) {
    const float u = x * (0.7978845608f + 0.0356774081f * x * x);
    return x * __builtin_amdgcn_rcpf(1.f + __builtin_amdgcn_exp2f(-2.885390082f * u));
}
__device__ __forceinline__ float silu_f(float x) { return x * __builtin_amdgcn_rcpf(1.f + __builtin_amdgcn_exp2f(-1.442695041f * x)); }

#define PG8_LAS __attribute__((address_space(3)))
struct Unit { int pm, pn, e, r0, pnl; };

constexpr int MT_CNT = 0, MT_PST = 32, MT_NT = 65, MT_T2E = 66, MT_WORDS = 66 + 192;
typedef const PG8_LAS int* lcnt_t;
__device__ __forceinline__ bool moe_unit(lcnt_t tb, int NT, int L, Unit& u) {
    const int pt = L / NT;
    if (pt >= __builtin_amdgcn_readfirstlane(tb[MT_NT])) return false;
    const int e = __builtin_amdgcn_readfirstlane(tb[MT_T2E + pt]), mt = pt - __builtin_amdgcn_readfirstlane(tb[MT_PST + e]), j = L - pt * NT;
    u.e = e; u.pm = pt; u.r0 = mt * 256; u.pnl = j; u.pn = e * NT + j; return true;
}

struct NoMeta {};
struct Meta8 { u32x4 lo, hi; };
struct Epi1 {
    static constexpr bool PERM = true, MIDSCALE = false;
    typedef NoMeta Meta;
    unsigned char* ws;
    __device__ __forceinline__ Meta meta_load(const Unit&, int, int) const { return Meta{}; }
    __device__ __forceinline__ void operator()(f32x4 (&acc)[2][2][4][2], const Unit& u, int wr, int wc, int fr, int fq, const Meta&) const {
        GAS bf16_t* P = (GAS bf16_t*)(opaque_ws(ws) + OFF_A);
        if (u.pn >= 12) {
#pragma unroll
            for (int ai = 0; ai < 2; ++ai)
#pragma unroll
                for (int m = 0; m < 4; ++m) {
                    const int row = u.pm * 256 + ai * 128 + wr * 64 + m * 16 + fr;
                    GAS bf16_t* rowp = P + (size_t)row * DP + 3072 + (u.pn - 12) * 128 + wc * 16 + 4 * fq;
#pragma unroll
                    for (int bj = 0; bj < 2; ++bj) { const f32x4 z = acc[ai][bj][m][0] * acc[ai][bj][m][1];
                        u32x2 w; w.x = cvt_pk_bf16(z[0], z[1]); w.y = cvt_pk_bf16(z[2], z[3]); *(GAS u32x2*)(rowp + bj * 64) = w; }
                }
            return;
        }
        const bool act = u.pn < 8;
#pragma unroll
        for (int ai = 0; ai < 2; ++ai)
#pragma unroll
            for (int m = 0; m < 4; ++m) {
                const int row = u.pm * 256 + ai * 128 + wr * 64 + m * 16 + fr;
                GAS bf16_t* rowp = P + (size_t)row * DP + u.pn * 256 + wc * 32 + 8 * fq;
#pragma unroll
                for (int bj = 0; bj < 2; ++bj) {
                    f32x4 v0 = acc[ai][bj][m][0], v1 = acc[ai][bj][m][1];
                    if (act) {
#pragma unroll
                        for (int j = 0; j < 4; ++j) { v0[j] = gelu_t(v0[j]); v1[j] = gelu_t(v1[j]); }
                    }
                    u32x4 w; w.x = cvt_pk_bf16(v0[0], v0[1]); w.y = cvt_pk_bf16(v0[2], v0[3]); w.z = cvt_pk_bf16(v1[0], v1[1]); w.w = cvt_pk_bf16(v1[2], v1[3]);
                    *(GAS u32x4*)(rowp + bj * 128) = w;
                }
            }
    }
};
struct Epi2 {
    static constexpr bool PERM = true, MIDSCALE = true;
    const float* x; unsigned char* ws; size_t so;
    const PG8_LAS float* rsl;
    __device__ __forceinline__ void midscale(f32x4 (&acc)[2][2][4][2], const Unit& u, int wr, int wc, int fr, int fq) const {
        const PG8_LAS float* pr = rsl + (u.e * 256 + wr * 64 + fr) * 2;
#pragma unroll
        for (int ai = 0; ai < 2; ++ai)
#pragma unroll
            for (int m = 0; m < 4; ++m) {
                const float s = pr[(ai * 128 + m * 16) * 2];
#pragma unroll
                for (int bj = 0; bj < 2; ++bj)
#pragma unroll
                    for (int n = 0; n < 2; ++n) acc[ai][bj][m][n] *= s;
            }
    }
    typedef NoMeta Meta;
    __device__ __forceinline__ Meta meta_load(const Unit&, int, int) const { return Meta{}; }
    __device__ __forceinline__ void operator()(f32x4 (&acc)[2][2][4][2], const Unit& u, int wr, int wc, int fr, int fq, const Meta&) const {
        gbyte* w_ = opaque_ws(ws);
        GAS bf16_t* hb = (GAS bf16_t*)(w_ + OFF_HB); gbyte* h8 = w_ + OFF_H8; float* ssq_h = (float*)(ws + OFF_SSQ + so) + 2 * T_;
#pragma unroll
        for (int ai = 0; ai < 2; ++ai)
#pragma unroll
            for (int m = 0; m < 4; ++m) {
                const int row = u.pm * 256 + ai * 128 + wr * 64 + m * 16 + fr;
                const float rb = rsl[(u.e * 256 + ai * 128 + wr * 64 + m * 16 + fr) * 2 + 1];
                const size_t off = (size_t)row * D_ + u.pn * 256 + wc * 32 + 8 * fq;
                float ss = 0.f;
#pragma unroll
                for (int bj = 0; bj < 2; ++bj) {
                    const f32x4 x0 = *(const f32x4*)(x + off + bj * 128), x1 = *(const f32x4*)(x + off + bj * 128 + 4);
                    const f32x4 h0 = x0 + acc[ai][bj][m][0] * rb, h1 = x1 + acc[ai][bj][m][1] * rb;
                    ss += (h0[0] * h0[0] + h0[1] * h0[1]) + (h0[2] * h0[2] + h0[3] * h0[3]) + (h1[0] * h1[0] + h1[1] * h1[1]) + (h1[2] * h1[2] + h1[3] * h1[3]);
                    u32x4 w; w.x = cvt_pk_bf16(h0[0], h0[1]); w.y = cvt_pk_bf16(h0[2], h0[3]); w.z = cvt_pk_bf16(h1[0], h1[1]); w.w = cvt_pk_bf16(h1[2], h1[3]);
                    *(GAS u32x4*)(hb + off + bj * 128) = w;
                    u32x2 w8; w8.x = pk4_fp8(h0[0], h0[1], h0[2], h0[3]); w8.y = pk4_fp8(h1[0], h1[1], h1[2], h1[3]);
                    *(GAS u32x2*)(h8 + off + bj * 128) = w8;
                }
                ss += __shfl_xor(ss, 16); ss += __shfl_xor(ss, 32);
                if (fq == 0) atomicAdd(ssq_h + row, ss);
                if (m == 3) asm volatile("" ::: "memory");
            }
    }
};
struct Epi5 {
    static constexpr bool PERM = true, MIDSCALE = false;
    typedef Meta8 Meta;
    unsigned char* ws; lcnt_t cnt;
    __device__ __forceinline__ Meta meta_load(const Unit& u, int wr, int fr) const {
        const GAS unsigned* rrs = (const GAS unsigned*)(opaque_ws(ws) + OFF_RW) + u.e * LCAP; const int ce = __builtin_amdgcn_readfirstlane(cnt[u.e]); Meta mt;
#pragma unroll
        for (int q = 0; q < 4; ++q) { const int i0 = u.r0 + wr * 64 + q * 16 + fr, i1 = i0 + 128;
            const unsigned a = rrs[min(i0, ce - 1)], b = rrs[min(i1, ce - 1)]; mt.lo[q] = (i0 < ce) ? a : 0u; mt.hi[q] = (i1 < ce) ? b : 0u; }
        return mt;
    }
    __device__ __forceinline__ void operator()(f32x4 (&acc)[2][2][4][2], const Unit& u, int wr, int wc, int fr, int fq, const Meta& mt) const {
        gbyte* hbuf = opaque_ws(ws) + OFF_B;
#pragma unroll
        for (int ai = 0; ai < 2; ++ai)
#pragma unroll
            for (int m = 0; m < 4; ++m) {
                const int r = ai * 128 + wr * 64 + m * 16 + fr;
                const float rs = __uint_as_float(ai ? mt.hi[m] : mt.lo[m]);
                float o[8];
#pragma unroll
                for (int n = 0; n < 2; ++n)
#pragma unroll
                    for (int j = 0; j < 4; ++j) o[4 * n + j] = silu_f(acc[ai][0][m][n][j] * rs) * (acc[ai][1][m][n][j] * rs);
                u32x2 w; w.x = pk4_fp8(o[0], o[1], o[2], o[3]); w.y = pk4_fp8(o[4], o[5], o[6], o[7]);
                *(GAS u32x2*)(hbuf + (size_t)(u.pm * 256 + r) * DE + u.pnl * 128 + wc * 32 + 8 * fq) = w;
                if (m & 1) asm volatile("" ::: "memory");
            }
    }
};
struct Epi6 {
    static constexpr bool PERM = true, MIDSCALE = false;
    typedef Meta8 Meta;
    unsigned char* ws; lcnt_t cnt;
    __device__ __forceinline__ Meta meta_load(const Unit& u, int wr, int fr) const {
        const GAS unsigned* rpk = (const GAS unsigned*)(opaque_ws(ws) + OFF_RINFO) + u.e * LCAP; const int ce = __builtin_amdgcn_readfirstlane(cnt[u.e]); Meta mt;
#pragma unroll
        for (int q = 0; q < 4; ++q) { const int i0 = u.r0 + wr * 64 + q * 16 + fr, i1 = i0 + 128;
            const unsigned a = rpk[min(i0, ce - 1)], b = rpk[min(i1, ce - 1)]; mt.lo[q] = (i0 < ce) ? a : 0xFFFFFFFFu; mt.hi[q] = (i1 < ce) ? b : 0xFFFFFFFFu; }
        return mt;
    }
    __device__ __forceinline__ void operator()(f32x4 (&acc)[2][2][4][2], const Unit& u, int wr, int wc, int fr, int fq, const Meta& mt) const {
        gbyte* ys2 = opaque_ws(ws) + OFF_A;
#pragma unroll
        for (int ai = 0; ai < 2; ++ai)
#pragma unroll
            for (int m = 0; m < 4; ++m) {
                const unsigned pk = ai ? mt.hi[m] : mt.lo[m]; const unsigned info = pk & 0xFFFFu;
                if (info < 2u * T_) {
                    const float g = __uint_as_float(pk & 0xFFFF0000u) * (YS_SCALE / WD_SCALE);
                    gbyte* dst = ys2 + (size_t)info * D_ + u.pnl * 256 + wc * 32 + 8 * fq;
#pragma unroll
                    for (int bj = 0; bj < 2; ++bj) {
                        const f32x4 v0 = acc[ai][bj][m][0] * g, v1 = acc[ai][bj][m][1] * g;
                        u32x2 w; w.x = pk4_fp8(v0[0], v0[1], v0[2], v0[3]); w.y = pk4_fp8(v1[0], v1[1], v1[2], v1[3]);
                        *(GAS u32x2*)(dst + bj * 128) = w;
                    }
                }
            }
    }
};

namespace pg8 {
constexpr int BM = 256, BK = 64, HALF = 128, HTB = HALF * BK * 2, STAGE_BYTES = 8 * HTB, NXCD = 8, WGM = 8;
__host__ __device__ __forceinline__ int lds_byte(int r, int c) { const int st = (r >> 4) * 2 + (c >> 5), rr = r & 15, cc = c & 31, ob = rr * 64 + cc * 2; return st * 1024 + (ob ^ (((ob >> 9) & 1) << 5)); }
__host__ __device__ __forceinline__ void stage_rc(int b, int& R, int& C) { const int st = b / 1024, sb = b % 1024, swz = sb ^ (((sb >> 9) & 1) << 5); R = (st >> 1) * 16 + swz / 64; C = (st & 1) * 32 + (swz % 64) / 2; }
__host__ __device__ __forceinline__ int perm32(int rho) { const int n = rho >> 4, i = rho & 15; return 8 * (i >> 2) + 4 * n + (i & 3); }

struct StaticOrder {
    int nM, nN, nwg, G, c, i0, i1;
    __device__ void init(int M, int N, int G_, int c_) { nM = M / BM; nN = N / BM; nwg = nM * nN; G = G_; c = c_; i0 = 0; i1 = 1 << 30; }
    __device__ int count() const { return (nwg - c + G - 1) / G; }
    __device__ bool next(int ii, Unit& u) const {
        const int i = ii + i0; if (i >= i1) return false;
        const long L = (long)i * G + c; if (L >= nwg) return false;
        int wgid = (int)L; { const int q = nwg / NXCD, r = nwg % NXCD, xcd = wgid % NXCD, off = wgid / NXCD; wgid = (xcd < r ? xcd * (q + 1) : r * (q + 1) + (xcd - r) * q) + off; }
        const int nig = WGM * nN, gid = wgid / nig, fm = gid * WGM, gsz = (nM - fm) < WGM ? (nM - fm) : WGM;
        u.pm = fm + ((wgid % nig) % gsz); u.pn = (wgid % nig) / gsz; u.e = i; u.r0 = 0; u.pnl = u.pn; return true;
    }
};
struct MoeOrder {
    lcnt_t cnt; int NT, G, c;
    __device__ __forceinline__ bool next(int i, Unit& u) const { return moe_unit(cnt, NT, i * G + c, u); }
};
struct AOffDirect { int K; struct Pre {};
    __device__ __forceinline__ Pre pre(const Unit&, int, int) const { return Pre{}; }
    __device__ __forceinline__ unsigned fin(const Pre&, const Unit& u, int h, int i, int R, int C) const { return (unsigned)(((u.pm * 256 + h * 128 + R) * K + C) * 2); } };
struct AOffGather { unsigned char* ws; lcnt_t cnt; int K;
    struct Pre { unsigned pk[2][2]; };
    __device__ __forceinline__ Pre pre(const Unit& u, int R0, int R1) const {
        const GAS unsigned* rpk = (const GAS unsigned*)(opaque_ws(ws) + OFF_RINFO) + u.e * LCAP; const int ce = __builtin_amdgcn_readfirstlane(cnt[u.e]); Pre p;
#pragma unroll
        for (int h = 0; h < 2; ++h) { const int i0 = u.r0 + h * 128 + R0, i1 = u.r0 + h * 128 + R1;
            p.pk[h][0] = rpk[min(i0, ce - 1)]; p.pk[h][1] = rpk[min(i1, ce - 1)]; }
        return p;
    }
    __device__ __forceinline__ unsigned fin(const Pre& p, const Unit&, int h, int i, int, int C) const { const int tok = (int)((p.pk[h][i] & 0xFFFFu) >> 1); return (unsigned)((tok * K + C) * 2); } };

template <class Epi, class Sched, class AOff, bool ALIGN_EPI, bool FP8 = false>
__device__ __forceinline__ void gemm_phase(PG8_LAS unsigned char* lds, const bf16_t* Ag, const bf16_t* Btg, const int K, const Sched& S, const AOff& AO, const Epi& E) {
    const int tid = opaque_tid(), wid = __builtin_amdgcn_readfirstlane(tid >> 6), lane = tid & 63, wr = wid >> 2, wc = wid & 3, fr = lane & 15, fq = lane >> 4;
    int nt = K / BK; asm volatile("" : "+s"(nt));
    unsigned voffB[2];
#pragma unroll
    for (int i = 0; i < 2; ++i) { int R, C; stage_rc(tid * 16 + i * 8192, R, C); const int Rb = Epi::PERM ? ((R & ~31) + perm32(R & 31)) : R; voffB[i] = (unsigned)(Rb * K + C) * 2u; }
#define PG8_APRE(u, pv_) do { int _t = tid; asm volatile("" : "+v"(_t)); int _R0, _R1, _C; stage_rc(_t * 16, _R0, _C); stage_rc(_t * 16 + 8192, _R1, _C); pv_ = AO.pre(u, _R0, _R1); } while (0)
#define PG8_AFIN(u, pv_, d0, d1) do { int _t = tid; asm volatile("" : "+v"(_t)); _Pragma("unroll") for (int _i = 0; _i < 2; ++_i) { int _R, _C; stage_rc(_t * 16 + _i * 8192, _R, _C); d0[_i] = AO.fin(pv_, u, 0, _i, _R, _C); d1[_i] = AO.fin(pv_, u, 1, _i, _R, _C); } } while (0)
#define PG8_LANE(fr_, fq_) int fr_, fq_; { int _t = tid; asm volatile("" : "+v"(_t)); fr_ = _t & 15; fq_ = (_t & 63) >> 4; }
    const unsigned kstep = (unsigned)(BK * 2), hstep = (unsigned)HALF * (unsigned)K * 2u, tstep = 2u * hstep;
    const unsigned ldsw = (unsigned)wid * 1024u;
    const int aoff = lds_byte(wr * 64 + fr, fq * 8), boff = lds_byte(wc * 32 + fr, fq * 8);
    const char* const Ab = (const char*)Ag; const char* const Bb = (const char*)Btg;
#define PG8_SA(b, h) (((b) * 2 + (h)) * HTB)
#define PG8_SB(b, h) ((4 + (b) * 2 + (h)) * HTB)
#define PG8_STAGE(bufoff, gbase, uoff, voff) do { _Pragma("unroll") for (int _i = 0; _i < 2; ++_i) \
        __builtin_amdgcn_global_load_lds((const unsigned*)((gbase) + (size_t)(unsigned)((uoff) + (voff)[_i])), (PG8_LAS unsigned*)(lds + (bufoff) + ldsw + _i * 8192), 16, 0, 0); } while (0)
#define PG8_LD32(base) __builtin_shufflevector(*(const PG8_LAS v4i*)(base), *(const PG8_LAS v4i*)((base) + 1024), 0, 1, 2, 3, 4, 5, 6, 7)
#define PG8_LDA(dst, b, h) do { _Pragma("unroll") for (int m = 0; m < 4; ++m) dst[m] = PG8_LD32(lds + PG8_SA(b, h) + aoff + m * 2048); } while (0)
#define PG8_LDB(dst, b, h) do { _Pragma("unroll") for (int n = 0; n < 2; ++n) dst[n] = PG8_LD32(lds + PG8_SB(b, h) + boff + n * 2048); } while (0)
#define PG8_LO(x) __builtin_bit_cast(bf16x8, __builtin_shufflevector((x), (x), 0, 1, 2, 3))
#define PG8_HI(x) __builtin_bit_cast(bf16x8, __builtin_shufflevector((x), (x), 4, 5, 6, 7))
#define PG8_MMA(ai, bj, At, Bt) do { __builtin_amdgcn_s_setprio(1); _Pragma("unroll") for (int m = 0; m < 4; ++m) _Pragma("unroll") for (int n = 0; n < 2; ++n) { \
        if constexpr (FP8) acc[ai][bj][m][n] = __builtin_amdgcn_mfma_scale_f32_16x16x128_f8f6f4(Bt[n], At[m], acc[ai][bj][m][n], 0, 0, 0, 0, 0, 0);   \
        else { acc[ai][bj][m][n] = __builtin_amdgcn_mfma_f32_16x16x32_bf16(PG8_LO(Bt[n]), PG8_LO(At[m]), acc[ai][bj][m][n], 0, 0, 0); \
               acc[ai][bj][m][n] = __builtin_amdgcn_mfma_f32_16x16x32_bf16(PG8_HI(Bt[n]), PG8_HI(At[m]), acc[ai][bj][m][n], 0, 0, 0); } } \
        __builtin_amdgcn_s_setprio(0); } while (0)
#define PG8_WAIT_V(n) asm volatile("s_waitcnt vmcnt(" #n ")" ::: "memory")
#define PG8_WAIT_L(n) asm volatile("s_waitcnt lgkmcnt(" #n ")" ::: "memory")
#define PG8_BAR __builtin_amdgcn_s_barrier()
#define PG8_SCHED __builtin_amdgcn_sched_barrier(0)
    Unit cur, nxt; int ui = 0;
    if (!S.next(0, cur)) return;
    f32x4 acc[2][2][4][2];
#pragma unroll
    for (int a = 0; a < 2; ++a)
#pragma unroll
        for (int b = 0; b < 2; ++b)
#pragma unroll
            for (int m = 0; m < 4; ++m)
#pragma unroll
                for (int n = 0; n < 2; ++n) acc[a][b][m][n] = (f32x4){0.f, 0.f, 0.f, 0.f};
    v8i At[4], B0[2], B1[2];
    unsigned vo0[2], vo1[2];
    PG8_LAS u32x4* const svn = (PG8_LAS u32x4*)(lds + XS_OFF) + tid;
    PG8_LAS u32x4* const smeta = (PG8_LAS u32x4*)(lds + XM_OFF + tid * 32);
    constexpr bool HAS_META = sizeof(typename Epi::Meta) > 1;
    bool has_next = S.next(1, nxt);
    { typename AOff::Pre pc; PG8_APRE(cur, pc); PG8_AFIN(cur, pc, vo0, vo1);
      unsigned vn0[2], vn1[2];
      if (has_next) { typename AOff::Pre pn; PG8_APRE(nxt, pn); PG8_AFIN(nxt, pn, vn0, vn1); } else { vn0[0] = vo0[0]; vn0[1] = vo0[1]; vn1[0] = vo1[0]; vn1[1] = vo1[1]; }
      *svn = (u32x4){vn0[0], vn0[1], vn1[0], vn1[1]}; }
    if constexpr (HAS_META) { PG8_LANE(fr_, fq_); (void)fq_; const typename Epi::Meta m0 = E.meta_load(cur, wr, fr_); smeta[0] = m0.lo; smeta[1] = m0.hi; }
    unsigned cB = (unsigned)cur.pn * tstep;
    PG8_STAGE(PG8_SB(0, 0), Bb, cB, voffB); PG8_STAGE(PG8_SB(0, 1), Bb, cB + hstep, voffB); PG8_STAGE(PG8_SA(0, 0), Ab, 0u, vo0); PG8_STAGE(PG8_SA(0, 1), Ab, 0u, vo1);
    if (wr == 1) PG8_BAR;
    PG8_WAIT_V(2); PG8_BAR;
    PG8_STAGE(PG8_SB(1, 0), Bb, cB + kstep, voffB); PG8_STAGE(PG8_SA(1, 0), Ab, kstep, vo0); PG8_STAGE(PG8_SB(1, 1), Bb, cB + hstep + kstep, voffB);
    PG8_WAIT_V(6); PG8_BAR;
    for (;;) {
        const unsigned nB = has_next ? (unsigned)nxt.pn * tstep : cB;
#pragma clang loop unroll(disable)
        for (int t = 0; t < nt; t += 2) {
            const bool last = (t == nt - 2);
            if constexpr (Epi::MIDSCALE) { if (t == nt / 2) { PG8_LANE(fr_, fq_); E.midscale(acc, cur, wr, wc, fr_, fq_); } }
            const unsigned k1 = (unsigned)(t + 1) * kstep, k2 = last ? 0u : (unsigned)(t + 2) * kstep, k3 = k2 + kstep;
            const unsigned b2 = last ? nB : cB + (unsigned)(t + 2) * kstep, b3 = b2 + kstep;
            PG8_LDB(B0, 0, 0); PG8_LDB(B1, 0, 1); PG8_SCHED; PG8_LDA(At, 0, 0); PG8_STAGE(PG8_SA(1, 1), Ab, k1, vo1);
            PG8_WAIT_V(8); PG8_WAIT_L(0); PG8_BAR; PG8_MMA(0, 0, At, B0); PG8_MMA(0, 1, At, B1); PG8_BAR; PG8_SCHED;
            if (last) { PG8_LAS u32x4* sp_ = svn; asm volatile("" : "+v"(sp_));
                const u32x4 v = *sp_; vo0[0] = v.x; vo0[1] = v.y; vo1[0] = v.z; vo1[1] = v.w; }
            PG8_LDA(At, 0, 1); PG8_STAGE(PG8_SB(0, 0), Bb, b2, voffB); PG8_STAGE(PG8_SB(0, 1), Bb, b2 + hstep, voffB); PG8_STAGE(PG8_SA(0, 0), Ab, k2, vo0);
            PG8_WAIT_V(8); PG8_WAIT_L(0); PG8_BAR; PG8_MMA(1, 0, At, B0); PG8_MMA(1, 1, At, B1); PG8_BAR; PG8_SCHED;
            PG8_LDB(B0, 1, 0); PG8_LDB(B1, 1, 1); PG8_SCHED; PG8_LDA(At, 1, 0); PG8_STAGE(PG8_SA(0, 1), Ab, k2, vo1);
            PG8_WAIT_V(8); PG8_WAIT_L(0); PG8_BAR; PG8_MMA(0, 0, At, B0); PG8_MMA(0, 1, At, B1); PG8_BAR; PG8_SCHED;
            PG8_LDA(At, 1, 1); PG8_STAGE(PG8_SB(1, 0), Bb, b3, voffB); PG8_STAGE(PG8_SB(1, 1), Bb, b3 + hstep, voffB); PG8_STAGE(PG8_SA(1, 0), Ab, k3, vo0);
            PG8_WAIT_V(8); PG8_WAIT_L(0); PG8_BAR; PG8_MMA(1, 0, At, B0); PG8_MMA(1, 1, At, B1); PG8_BAR; PG8_SCHED;
        }
        if constexpr (ALIGN_EPI) { if (wr == 0) PG8_BAR; }
        Unit nn; const bool has2 = has_next && S.next(ui + 2, nn);
        typename Epi::Meta mnext;
        { PG8_LANE(fr_, fq_);
          typename Epi::Meta meta; if constexpr (HAS_META) { PG8_LAS u32x4* sp_ = smeta; asm volatile("" : "+v"(sp_)); meta.lo = sp_[0]; meta.hi = sp_[1]; }
          if (has_next) mnext = E.meta_load(nxt, wr, fr_);
          if (has2) { typename AOff::Pre pnn; PG8_APRE(nn, pnn); unsigned vn0[2], vn1[2]; PG8_AFIN(nn, pnn, vn0, vn1); *svn = (u32x4){vn0[0], vn0[1], vn1[0], vn1[1]}; }
          E(acc, cur, wr, wc, fr_, fq_, meta); }
        if (!has_next) break;
        if constexpr (HAS_META) { smeta[0] = mnext.lo; smeta[1] = mnext.hi; }
#pragma unroll
        for (int a = 0; a < 2; ++a)
#pragma unroll
            for (int b = 0; b < 2; ++b)
#pragma unroll
                for (int m = 0; m < 4; ++m)
#pragma unroll
                    for (int n = 0; n < 2; ++n) acc[a][b][m][n] = (f32x4){0.f, 0.f, 0.f, 0.f};
        cur = nxt; nxt = nn; has_next = has2; cB = nB; ++ui;
        if constexpr (ALIGN_EPI) { if (wr == 1) PG8_BAR; }
    }
    PG8_WAIT_V(0);
    if constexpr (!ALIGN_EPI) { if (wr == 0) PG8_BAR; }
    PG8_BAR;
#undef PG8_APRE
#undef PG8_AFIN
#undef PG8_LANE
#undef PG8_SA
#undef PG8_SB
#undef PG8_STAGE
#undef PG8_LDA
#undef PG8_LDB
#undef PG8_MMA
#undef PG8_LO
#undef PG8_HI
#undef PG8_LD32
#undef PG8_WAIT_V
#undef PG8_WAIT_L
#undef PG8_BAR
#undef PG8_SCHED
}
}


#define XB_TMO      128
#define XB_XCNT(j)  (256  + 64 * (j))
#define XB_XSUB(j)  (1280 + 64 * (j))
#define XB_XGEN(j)  (2304 + 64 * (j))
#define XB_TOP      3328
#define XB_TOPGEN   3392
#define XCD_BAR_WORDS 3456
#define XB_SPIN_CAP (1u << 18)
__device__ __forceinline__ unsigned xb_ld(unsigned* p)              { return __hip_atomic_load(p, __ATOMIC_RELAXED, __HIP_MEMORY_SCOPE_AGENT); }
__device__ __forceinline__ unsigned xb_add(unsigned* p, unsigned v) { return __hip_atomic_fetch_add(p, v, __ATOMIC_RELAXED, __HIP_MEMORY_SCOPE_AGENT); }
__device__ __forceinline__ unsigned xb_xcc_id() { return (unsigned)__builtin_amdgcn_s_getreg((3 << 11) | 20) & 0xFu; }
#define XB_SPIN(cond, bar) do { unsigned _sp = 0; while (cond) { __builtin_amdgcn_s_sleep(1); \
    if ((++_sp & 255u) == 0u) { if (xb_ld(&(bar)[XB_TMO])) break; if (_sp > XB_SPIN_CAP) { atomicAdd(&(bar)[XB_TMO], 1u); break; } } } } while (0)
struct XcdBarrier { unsigned* bar; unsigned x; volatile PG8_LAS unsigned* st; };
__device__ __forceinline__ XcdBarrier xcd_barrier_post(unsigned* bar, volatile PG8_LAS unsigned* st) {
    XcdBarrier b; b.bar = bar; b.x = xb_xcc_id(); b.st = st;
    if (threadIdx.x == 0) (void)xb_add(&bar[XB_XCNT(b.x)], 1u);
    return b;
}
__device__ __forceinline__ void xcd_barrier_complete(unsigned* bar, unsigned x, unsigned& nloc, unsigned& nx) {
    const unsigned G = gridDim.x * gridDim.y * gridDim.z;
    unsigned sum, cnt, mine, sp = 0u;
    for (;;) {
        sum = 0u; cnt = 0u; mine = 0u;
#pragma unroll
        for (unsigned j = 0; j < 16; ++j) { const unsigned c = xb_ld(&bar[XB_XCNT(j)]); sum += c; cnt += (c > 0u) ? 1u : 0u; mine = (j == x) ? c : mine; }
        if (sum == G) break;
        __builtin_amdgcn_s_sleep(1);
        if ((++sp & 255u) == 0u) { if (xb_ld(&bar[XB_TMO])) break; if (sp > XB_SPIN_CAP) { atomicAdd(&bar[XB_TMO], 1u); break; } }
    }
    nloc = mine > 0u ? mine : 1u; nx = cnt > 0u ? cnt : 1u;
}
__device__ __forceinline__ void xcd_barrier(const XcdBarrier& b) {
    asm volatile("s_waitcnt vmcnt(0)" ::: "memory");
    __syncthreads();
    if (threadIdx.x == 0) {
        unsigned* bar = b.bar;
        __builtin_amdgcn_s_waitcnt(0);
        unsigned nloc = b.st[0], nx = b.st[1];
        if (nloc == 0u) { xcd_barrier_complete(bar, b.x, nloc, nx); b.st[0] = nloc; b.st[1] = nx; }
        const unsigned old = xb_add(&bar[XB_XSUB(b.x)], 1u);
        const unsigned gen = old / nloc;
        if (old + 1u == (gen + 1u) * nloc) {
            __builtin_amdgcn_fence(__ATOMIC_RELEASE, "agent");
            asm volatile("s_waitcnt vmcnt(0)" ::: "memory");
            const unsigned og = xb_add(&bar[XB_TOP], 1u);
            const unsigned tg = og / nx;
            if (og + 1u == (tg + 1u) * nx) xb_add(&bar[XB_TOPGEN], 1u);
            else XB_SPIN(xb_ld(&bar[XB_TOPGEN]) == tg, bar);
            __builtin_amdgcn_fence(__ATOMIC_ACQUIRE, "agent");
            xb_add(&bar[XB_XGEN(b.x)], 1u);
            asm volatile("s_waitcnt vmcnt(0)" ::: "memory");
        } else {
            XB_SPIN(xb_ld(&bar[XB_XGEN(b.x)]) == gen, bar);
            __builtin_amdgcn_fence(__ATOMIC_ACQUIRE, "agent");
            asm volatile("s_waitcnt vmcnt(0)" ::: "memory");
        }
    }
    __syncthreads();
}

struct TJob { const float* src; int ld; unsigned char* dst; int lddst; float sc; const float* sk; int fp8; int rmap; };
__device__ __forceinline__ bool tjob_decode(const Params& p, int q, TJob& j) {
    constexpr int N_IN = 16 * 80, N_OUT = 16 * 32, N_G = 32 * 128;
    if (q < N_IN) { const int tr = q / 80, tc = q % 80; j.src = p.w_in + (size_t)tr * 128 * DIN + tc * 64; j.ld = DIN; j.sc = 1.f; j.sk = nullptr; j.fp8 = 0; j.lddst = D_ * 2; j.rmap = 0;
        if (tc < 48) j.dst = p.ws + OFF_WIN + ((size_t)tc * 64 * D_ + tr * 128) * 2;
        else { const int hsel = tc >= 64, ch0 = (tc - (hsel ? 64 : 48)) * 64; j.rmap = 1 + hsel;
               j.dst = p.ws + OFF_WIN + ((size_t)(3072 + 256 * (ch0 >> 7) + 2 * (ch0 & 127)) * D_ + tr * 128) * 2; }
        return true; } q -= N_IN;
    if (q < N_OUT) { const int tr = q / 32, tc = q % 32; j.src = p.w_out + (size_t)tr * 128 * D_ + tc * 64; j.ld = D_; j.dst = p.ws + OFF_WOUT + ((size_t)tc * 64 * D_ + tr * 128) * 2; j.lddst = D_ * 2; j.sc = 1.f;
        j.sk = (tr < 8 ? p.g_a + tr * 128 : p.g_b + (tr - 8) * 128); j.fp8 = 0; j.rmap = 0; return true; } q -= N_OUT;
    if (q < 2 * N_G) { const int up = q >= N_G; if (up) q -= N_G; const int e = q >> 7, rem = q & 127, tr = rem >> 3, tc = rem & 7, c0 = tc * 64;
        j.src = (up ? p.ewu : p.ewg) + (size_t)e * D_ * DE + (size_t)tr * 128 * DE + c0; j.ld = DE;
        j.dst = p.ws + OFF_WGU + (size_t)e * 1024 * D_ + (size_t)((c0 >> 7) * 256 + (up ? 128 : 0) + (c0 & 127)) * D_ + tr * 128; j.lddst = D_; j.sc = WGU_SCALE; j.sk = p.g_ffn + tr * 128; j.fp8 = 1; j.rmap = 0; return true; } q -= 2 * N_G;
    if (q < N_G) { const int e = q >> 7, rem = q & 127, tr = rem >> 5, tc = rem & 31;
        j.src = p.ewd + (size_t)e * DE * D_ + (size_t)tr * 128 * D_ + tc * 64; j.ld = D_; j.dst = p.ws + OFF_WD + (size_t)e * D_ * DE + (size_t)tc * 64 * DE + tr * 128; j.lddst = DE; j.sc = WD_SCALE; j.sk = nullptr; j.fp8 = 1; j.rmap = 0; return true; }
    return false;
}
constexpr int N_TJOBS_IN = 16 * 80, N_TJOBS_DENSE = 16 * 80 + 16 * 32, N_TJOBS_GU = N_TJOBS_DENSE + 2 * 32 * 128, N_TJOBS = N_TJOBS_GU + 32 * 128;
struct TRegs { f32x4 v[4]; };
__device__ __forceinline__ void tjob_load(const TJob& j, int tid, TRegs& r) {
    const float* sp = j.src + (size_t)(tid >> 2) * j.ld + (tid & 3) * 16;
#pragma unroll
    for (int q = 0; q < 4; ++q) r.v[q] = *(const f32x4*)(sp + 4 * q);
}
__device__ __forceinline__ void tjob_finish(const TJob& j, int tid, const TRegs& r, float* lt) {
    { const int rr = tid >> 2, cc = (tid & 3) * 16; const float f = j.sk ? j.sc * j.sk[rr] : j.sc;
#pragma unroll
      for (int q = 0; q < 4; ++q)
#pragma unroll
          for (int e = 0; e < 4; ++e) lt[rr * 65 + cc + 4 * q + e] = r.v[q][e] * f; }
    __syncthreads();
    { const int c = tid >> 3, rr = (tid & 7) * 16; float v[16];
#pragma unroll
      for (int q = 0; q < 16; ++q) v[q] = lt[(rr + q) * 65 + c];
      const int drow = j.rmap ? 8 * (c >> 2) + 4 * (j.rmap - 1) + (c & 3) : c;
      unsigned char* d = j.dst + (size_t)drow * j.lddst;
      if (j.fp8) { u32x4 w; w.x = pk4_fp8(v[0], v[1], v[2], v[3]); w.y = pk4_fp8(v[4], v[5], v[6], v[7]); w.z = pk4_fp8(v[8], v[9], v[10], v[11]); w.w = pk4_fp8(v[12], v[13], v[14], v[15]);
          *(u32x4*)(d + rr) = w; }
      else { u32x4 w0, w1; w0.x = cvt_pk_bf16(v[0], v[1]); w0.y = cvt_pk_bf16(v[2], v[3]); w0.z = cvt_pk_bf16(v[4], v[5]); w0.w = cvt_pk_bf16(v[6], v[7]);
          w1.x = cvt_pk_bf16(v[8], v[9]); w1.y = cvt_pk_bf16(v[10], v[11]); w1.z = cvt_pk_bf16(v[12], v[13]); w1.w = cvt_pk_bf16(v[14], v[15]);
          *(u32x4*)(d + rr * 2) = w0; *(u32x4*)(d + rr * 2 + 16) = w1; } }
}
__device__ __forceinline__ void run_tjobs(const Params& p, unsigned char* lds, int qlo, int qhi, int k0 = 0, int k1 = 1 << 20, int first = -1, int stride = 0) {
    const int tid = opaque_tid(), nb = stride > 0 ? stride : (int)gridDim.x;
    float* lt0 = (float*)lds; float* lt1 = lt0 + 128 * 65;
    TJob j0, j1, j2; TRegs r0, r1, r2;
    int k = k0; const int qb = qlo + (first >= 0 ? first : (int)blockIdx.x);
#define TJ_OK(kk, jj) ((kk) < k1 && qb + (kk) * nb < qhi && tjob_decode(p, qb + (kk) * nb, jj))
    bool h0 = TJ_OK(k, j0), h1 = TJ_OK(k + 1, j1), h2 = TJ_OK(k + 2, j2);
    if (h0) tjob_load(j0, tid, r0); if (h1) tjob_load(j1, tid, r1); if (h2) tjob_load(j2, tid, r2);
    while (h0) {
        tjob_finish(j0, tid, r0, lt0); k += 3; h0 = TJ_OK(k, j0); if (h0) tjob_load(j0, tid, r0);
        if (!h1) break;
        tjob_finish(j1, tid, r1, lt1); h1 = TJ_OK(k + 1, j1); if (h1) tjob_load(j1, tid, r1);
        if (!h2) break;
        tjob_finish(j2, tid, r2, lt0); h2 = TJ_OK(k + 2, j2); if (h2) tjob_load(j2, tid, r2);
        if (!h0) break;
        tjob_finish(j0, tid, r0, lt1); k += 3; h0 = TJ_OK(k, j0); if (h0) tjob_load(j0, tid, r0);
        if (!h1) break;
        tjob_finish(j1, tid, r1, lt0); h1 = TJ_OK(k + 1, j1); if (h1) tjob_load(j1, tid, r1);
        if (!h2) break;
        tjob_finish(j2, tid, r2, lt1); h2 = TJ_OK(k + 2, j2); if (h2) tjob_load(j2, tid, r2);
    }
#undef TJ_OK
    __syncthreads();
}
__device__ __forceinline__ void phase0(const Params& p, unsigned char* lds) {
    const int tid = opaque_tid(), nb = gridDim.x, bid = blockIdx.x, wid = tid >> 6, lane = tid & 63;
    { float* z = (float*)(p.ws + OFF_SSQ);
      for (int i = bid * NTHR + tid; i < 3 * T_ + 64; i += nb * NTHR) z[i] = 0.f;
      if (DUP_PHASE >= 2 && DUP_PHASE <= 4) { float* zd = (float*)(p.ws + OFF_SSQ + (OFF_DUMMY - OFF_SSQ)); for (int i = bid * NTHR + tid; i < 3 * T_ + 64; i += nb * NTHR) zd[i] = 0.f; } }
    { bf16_t* wrt = (bf16_t*)(p.ws + OFF_WR);
      for (int i = bid * NTHR + tid; i < 48 * D_; i += nb * NTHR) {
          const int o = i >> 11, k = i & 2047; float v = 0.f;
          if (o < 4) v = p.rgw[k * 4 + o]; else if (o < 36) v = p.rew[k * 32 + (o - 4)];
          wrt[i] = (bf16_t)(cvt_pk_bf16(v * p.g_ffn[k], 0.f) & 0xffffu); } }
    { bf16_t* wsb = (bf16_t*)(p.ws + OFF_WSB);
      for (int i = bid * NTHR + tid; i < 8 * 128 * 128; i += nb * NTHR) { const int r = (i >> 7) & 127, c = i & 127;
          wsb[i] = (bf16_t)(cvt_pk_bf16(((r >> 6) >= (c >> 6)) ? p.gmlp_ws[i] : 0.f, 0.f) & 0xffffu); } }
    { bf16_t* xn = (bf16_t*)(p.ws + OFF_B);
      for (int row = bid * 8 + wid; row < T_; row += nb * 8) {
          const float* xr = p.x + (size_t)row * D_;
          f32x4 v[8]; float s = 0.f;
#pragma unroll
          for (int i = 0; i < 8; ++i) { v[i] = *(const f32x4*)(xr + i * 256 + lane * 4); s += (v[i][0] * v[i][0] + v[i][1] * v[i][1]) + (v[i][2] * v[i][2] + v[i][3] * v[i][3]); }
          const float rstd = rsqrtf(wave_sum(s) * (1.f / D_) + EPS);
#pragma unroll
          for (int i = 0; i < 8; ++i) { const f32x4 g = *(const f32x4*)(p.norm_mix_g + i * 256 + lane * 4); const f32x4 o = v[i] * rstd * g;
              u32x2 w; w.x = cvt_pk_bf16(o[0], o[1]); w.y = cvt_pk_bf16(o[2], o[3]); *(u32x2*)(xn + (size_t)row * D_ + i * 256 + lane * 4) = w; } } }
    run_tjobs(p, lds, 0, N_TJOBS_IN);
}

__device__ __forceinline__ int side_rounds(int nb) { return (N_TJOBS_GU - N_TJOBS_IN + nb - 1) / nb; }
__device__ __forceinline__ void phase1(const Params& p, unsigned char* lds) {
    const Epi1 E{p.ws};
    pg8::StaticOrder S; S.init(T_, DIN, gridDim.x, blockIdx.x); const pg8::AOffDirect AO{D_};
    const int nu = S.count(), col = blockIdx.x & 3, split = col == 0 ? 0 : col == 1 ? (2 * nu) / 5 : col == 2 ? (3 * nu) / 5 : nu;
    const int kr = side_rounds(gridDim.x), k1 = (2 * kr) / 3;
    S.i0 = 0; S.i1 = split;
    pg8::gemm_phase<Epi1, pg8::StaticOrder, pg8::AOffDirect, true>((PG8_LAS unsigned char*)lds, (const bf16_t*)(p.ws + OFF_B), (const bf16_t*)(p.ws + OFF_WIN), D_, S, AO, E);
    run_tjobs(p, lds, N_TJOBS_IN, N_TJOBS_GU, 0, k1);
    S.i0 = split; S.i1 = nu;
    pg8::gemm_phase<Epi1, pg8::StaticOrder, pg8::AOffDirect, true>((PG8_LAS unsigned char*)lds, (const bf16_t*)(p.ws + OFF_B), (const bf16_t*)(p.ws + OFF_WIN), D_, S, AO, E);
}

struct VRegs { u32x4 v[4]; };
__device__ __forceinline__ void gmlp_load_v(const Params& p, int item, int tid, VRegs& r) {
    const int h = item & 7, t0 = (item >> 3) * 128, j = tid >> 2, dc = (tid & 3) * 32;
    const u32x4* src = (const u32x4*)((const bf16_t*)(p.ws + OFF_A) + (size_t)(t0 + j) * DP + 1024 + h * 128 + dc);
#pragma unroll
    for (int q = 0; q < 4; ++q) r.v[q] = src[q];
}
__device__ __forceinline__ void mixer_gmlp_item(const Params& p, bf16_t* Vt, int item, const VRegs& r, size_t so) {
    const int tid = opaque_tid(), wid = tid >> 6, lane = tid & 63, fr = lane & 15, fq = lane >> 4;
    const int h = item & 7, t0 = (item >> 3) * 128;
    const bf16_t* P = (const bf16_t*)(p.ws + OFF_A); bf16_t* Y = (bf16_t*)(p.ws + OFF_B); float* ssq_a = (float*)(p.ws + OFF_SSQ + so);
    const bf16_t* wsb = (const bf16_t*)(p.ws + OFF_WSB) + (size_t)h * 16384;
    { const int j = tid >> 2, dc = (tid & 3) * 32; float s = 0.f;
#pragma unroll
      for (int q = 0; q < 4; ++q)
#pragma unroll
          for (int w = 0; w < 4; ++w) { const float lo = bflo(r.v[q][w]), hi = bfhi(r.v[q][w]); s += lo * lo + hi * hi; }
      s += __shfl_xor(s, 1); s += __shfl_xor(s, 2);
      const float rs = rsqrtf(s * (1.f / 128.f) + EPS);
#pragma unroll
      for (int q = 0; q < 4; ++q)
#pragma unroll
          for (int w = 0; w < 4; ++w) { const int d = dc + q * 8 + w * 2; const unsigned pk = cvt_pk_bf16(bflo(r.v[q][w]) * rs, bfhi(r.v[q][w]) * rs);
              Vt[d * 136 + j] = (bf16_t)(pk & 0xffffu); Vt[(d + 1) * 136 + j] = (bf16_t)(pk >> 16); } }
    const int i = 16 * wid + fr, t = t0 + i; const float bias = p.gmlp_bs[h * 128 + i];
    u32x2 uu[8];
#pragma unroll
    for (int n = 0; n < 8; ++n) uu[n] = *(const u32x2*)(P + (size_t)t * DP + h * 128 + 16 * n + 4 * fq);
    const int ksteps = (wid < 4) ? 2 : 4;
    bf16x8 bw[4];
#pragma unroll
    for (int ks = 0; ks < 4; ++ks) bw[ks] = *(const bf16x8*)(wsb + (16 * wid + fr) * 128 + ks * 32 + fq * 8);
    __syncthreads();
    f32x4 acc[8];
#pragma unroll
    for (int n = 0; n < 8; ++n) acc[n] = (f32x4){0.f, 0.f, 0.f, 0.f};
#pragma unroll
    for (int ks = 0; ks < 4; ++ks) { if (ks < ksteps) {
#pragma unroll
        for (int n = 0; n < 8; ++n) { const bf16x8 av = *(const bf16x8*)(Vt + (16 * n + fr) * 136 + ks * 32 + fq * 8);
            acc[n] = __builtin_amdgcn_mfma_f32_16x16x32_bf16(av, bw[ks], acc[n], 0, 0, 0); } } }
    float ss = 0.f;
#pragma unroll
    for (int n = 0; n < 8; ++n) { const int c = h * 128 + 16 * n + 4 * fq;
        const f32x4 g = *(const f32x4*)(p.v_norm_g + c);
        const float y0 = bflo(uu[n].x) * (acc[n][0] * g[0] + bias), y1 = bfhi(uu[n].x) * (acc[n][1] * g[1] + bias), y2 = bflo(uu[n].y) * (acc[n][2] * g[2] + bias), y3 = bfhi(uu[n].y) * (acc[n][3] * g[3] + bias);
        ss += (y0 * y0 + y1 * y1) + (y2 * y2 + y3 * y3);
        u32x2 w; w.x = cvt_pk_bf16(y0, y1); w.y = cvt_pk_bf16(y2, y3); *(u32x2*)(Y + (size_t)t * D_ + c) = w; }
    ss += __shfl_xor(ss, 16); ss += __shfl_xor(ss, 32);
    if (fq == 0) atomicAdd(ssq_a + t, ss);
}
__device__ __forceinline__ void mixer_conv_item(const Params& p, int item, size_t so) {
    const int tid = opaque_tid(), cl = tid & 31, ts = tid >> 5;
    const int c = (item & 3) * 256 + cl * 8, tbeg = (item >> 2) * 128 + ts * 8;
    const bf16_t* P = (const bf16_t*)(p.ws + OFF_A); bf16_t* Y = (bf16_t*)(p.ws + OFF_B); float* ssq_b = (float*)(p.ws + OFF_SSQ + so) + T_;
    float w0[8], w1[8], w2[8], z1[8], z2[8];
    { const f32x4 a0 = *(const f32x4*)(p.conv_w + c), a1 = *(const f32x4*)(p.conv_w + c + 4), b0 = *(const f32x4*)(p.conv_w + 1024 + c), b1 = *(const f32x4*)(p.conv_w + 1024 + c + 4),
                  c0 = *(const f32x4*)(p.conv_w + 2048 + c), c1 = *(const f32x4*)(p.conv_w + 2048 + c + 4);
#pragma unroll
      for (int q = 0; q < 4; ++q) { w0[q] = a0[q]; w0[4 + q] = a1[q]; w1[q] = b0[q]; w1[4 + q] = b1[q]; w2[q] = c0[q]; w2[4 + q] = c1[q]; } }
#pragma unroll
    for (int q = 0; q < 8; ++q) { z1[q] = 0.f; z2[q] = 0.f; }
    if ((tbeg % SEQ) != 0) {
        const u32x4 za = *(const u32x4*)(P + (size_t)(tbeg - 1) * DP + 3072 + c), zb = *(const u32x4*)(P + (size_t)(tbeg - 2) * DP + 3072 + c);
#pragma unroll
        for (int q = 0; q < 4; ++q) { z1[2 * q] = bflo(za[q]); z1[2 * q + 1] = bfhi(za[q]); z2[2 * q] = bflo(zb[q]); z2[2 * q + 1] = bfhi(zb[q]); }
    }
    u32x4 bgA[8], zA[8];
#pragma unroll
    for (int tt = 0; tt < 8; ++tt) { const bf16_t* pr = P + (size_t)(tbeg + tt) * DP + c; bgA[tt] = *(const u32x4*)(pr + 2048); zA[tt] = *(const u32x4*)(pr + 3072); }
#pragma unroll
    for (int tt = 0; tt < 8; ++tt) {
        const int t = tbeg + tt;
        const u32x4 bg = bgA[tt], zv = zA[tt];
        float z[8], y[8], ss = 0.f;
#pragma unroll
        for (int q = 0; q < 4; ++q) { z[2 * q] = bflo(zv[q]); z[2 * q + 1] = bfhi(zv[q]); }
#pragma unroll
        for (int q = 0; q < 4; ++q) {
            y[2 * q] = bflo(bg[q]) * (w0[2 * q] * z2[2 * q] + w1[2 * q] * z1[2 * q] + w2[2 * q] * z[2 * q]);
            y[2 * q + 1] = bfhi(bg[q]) * (w0[2 * q + 1] * z2[2 * q + 1] + w1[2 * q + 1] * z1[2 * q + 1] + w2[2 * q + 1] * z[2 * q + 1]); }
#pragma unroll
        for (int q = 0; q < 8; ++q) { ss += y[q] * y[q]; z2[q] = z1[q]; z1[q] = z[q]; }
        u32x4 w; w.x = cvt_pk_bf16(y[0], y[1]); w.y = cvt_pk_bf16(y[2], y[3]); w.z = cvt_pk_bf16(y[4], y[5]); w.w = cvt_pk_bf16(y[6], y[7]);
        *(u32x4*)(Y + (size_t)t * D_ + 1024 + c) = w;
        ss += __shfl_xor(ss, 1); ss += __shfl_xor(ss, 2); ss += __shfl_xor(ss, 4); ss += __shfl_xor(ss, 8); ss += __shfl_xor(ss, 16);
        if (cl == 0) atomicAdd(ssq_b + t, ss);
    }
}
__device__ __forceinline__ void phase2(const Params& p, unsigned char* lds, size_t so = 0) {
    const int nb = gridDim.x, bid = blockIdx.x, tid = opaque_tid();
    for (int it = bid; it < 512; it += nb) mixer_conv_item(p, it, so);
    bf16_t* Vt0 = (bf16_t*)lds; bf16_t* Vt1 = Vt0 + 128 * 136;
    VRegs ra, rb; int it = bid; bool ha = it < 1024, hb_ = it + nb < 1024;
    if (ha) gmlp_load_v(p, it, tid, ra);
    while (ha) {
        if (hb_) gmlp_load_v(p, it + nb, tid, rb);
        mixer_gmlp_item(p, Vt0, it, ra, so);
        if (!hb_) break;
        it += 2 * nb; ha = it < 1024;
        if (ha) gmlp_load_v(p, it, tid, ra);
        mixer_gmlp_item(p, Vt1, it - nb, rb, so);
        hb_ = it + nb < 1024;
    }
    __syncthreads();
}

__device__ __forceinline__ void phase3(const Params& p, unsigned char* lds, size_t so = 0) {
    pg8::StaticOrder S; S.init(T_, D_, gridDim.x, blockIdx.x); const pg8::AOffDirect AO{D_};
    PG8_LAS float* rsl = (PG8_LAS float*)((PG8_LAS unsigned char*)lds + RS_OFF);
    { const float* ssq = (const float*)(p.ws + OFF_SSQ); const int tid = opaque_tid();
      for (int i = 0; i < RS_UNITS; ++i) { Unit u; if (!S.next(i, u)) break;
          if (tid < 256) { const int row = u.pm * 256 + tid; const float va = ssq[row] * (1.f / 1024.f) + EPS, vb = ssq[T_ + row] * (1.f / 1024.f) + EPS;
              rsl[(i * 256 + tid) * 2] = __builtin_amdgcn_sqrtf(vb * __builtin_amdgcn_rcpf(va)); rsl[(i * 256 + tid) * 2 + 1] = __builtin_amdgcn_rsqf(vb); } }
      __syncthreads(); }
    const Epi2 E{p.x, p.ws, so, rsl};
    const int kr = side_rounds(gridDim.x), k0 = (2 * kr) / 3; const bool side = (so == 0);
    const int col = blockIdx.x & 3, km = k0 + ((kr - k0) * col + 1) / 3;
    if (side) run_tjobs(p, lds, N_TJOBS_IN, N_TJOBS_GU, k0, km);
    pg8::gemm_phase<Epi2, pg8::StaticOrder, pg8::AOffDirect, true>((PG8_LAS unsigned char*)lds, (const bf16_t*)(p.ws + OFF_B), (const bf16_t*)(p.ws + OFF_WOUT), D_, S, AO, E);
    if (side) run_tjobs(p, lds, N_TJOBS_IN, N_TJOBS_GU, km, kr);
}

__device__ __forceinline__ void route_item(const Params& p, unsigned char* lds, int item, size_t so) {
    const int tid = opaque_tid(), wid = tid >> 6, lane = tid & 63, fr = lane & 15, fq = lane >> 4;
    float* lg = (float*)lds;
    float* ls = lg + 8 * 64 * 48;
    int* lcnt = (int*)(ls + 64 * 48); int* lbase = lcnt + 32;
    const bf16_t* hb = (const bf16_t*)(p.ws + OFF_HB); const bf16_t* wrt = (const bf16_t*)(p.ws + OFF_WR);
    const float* ssq_h = (const float*)(p.ws + OFF_SSQ) + 2 * T_;
    int* cnt = (int*)(p.ws + OFF_CNT + so); int* rinfo = (int*)(p.ws + OFF_RINFO + so); float* rw = (float*)(p.ws + OFF_RW + so);
    const int t0 = item * 64;
    if (tid < 32) lcnt[tid] = 0;
    f32x4 acc[4][3];
#pragma unroll
    for (int m = 0; m < 4; ++m)
#pragma unroll
        for (int n = 0; n < 3; ++n) acc[m][n] = (f32x4){0.f, 0.f, 0.f, 0.f};
    const bf16_t* ap = hb + (size_t)(t0 + fr) * D_ + wid * 256 + fq * 8; const bf16_t* bp = wrt + (size_t)fr * D_ + wid * 256 + fq * 8;
#pragma unroll 4
    for (int ks = 0; ks < 8; ++ks) {
        bf16x8 a[4], b[3];
#pragma unroll
        for (int m = 0; m < 4; ++m) a[m] = *(const bf16x8*)(ap + (size_t)m * 16 * D_ + ks * 32);
#pragma unroll
        for (int n = 0; n < 3; ++n) b[n] = *(const bf16x8*)(bp + (size_t)n * 16 * D_ + ks * 32);
#pragma unroll
        for (int m = 0; m < 4; ++m)
#pragma unroll
            for (int n = 0; n < 3; ++n) acc[m][n] = __builtin_amdgcn_mfma_f32_16x16x32_bf16(a[m], b[n], acc[m][n], 0, 0, 0);
    }
#pragma unroll
    for (int m = 0; m < 4; ++m)
#pragma unroll
        for (int n = 0; n < 3; ++n)
#pragma unroll
            for (int j = 0; j < 4; ++j) lg[(wid * 64 + m * 16 + 4 * fq + j) * 48 + 16 * n + fr] = acc[m][n][j];
    __syncthreads();
    for (int i = tid; i < 64 * 48; i += NTHR) { float v = 0.f;
#pragma unroll
        for (int w = 0; w < 8; ++w) v += lg[w * 64 * 48 + i];
        ls[i] = v; }
    __syncthreads();
    int e0 = 0, e1 = 0, r0 = 0, r1 = 0; float g0 = 0.f, g1 = 0.f, rsc = 0.f; const int t = t0 + tid;
    if (tid < 64) {
        const float* l0 = ls + tid * 48; const float rstd = rsqrtf(ssq_h[t] * (1.f / D_) + EPS); rsc = rstd * (1.f / WGU_SCALE);
        float gm = -3.0e38f; int gi = 0; float gl[4];
#pragma unroll
        for (int o = 0; o < 4; ++o) { gl[o] = l0[o] * rstd + p.rgb[o]; if (gl[o] > gm) { gm = gl[o]; gi = o; } }
        float gs = 0.f;
#pragma unroll
        for (int o = 0; o < 4; ++o) gs += __expf(gl[o] - gm);
        const float pg = 1.f / gs;
        float b1 = -3.0e38f, b2 = -3.0e38f; int i1 = 0, i2 = 0;
        for (int q = 0; q < 8; ++q) { const float v = l0[4 + gi * 8 + q] * rstd + p.reb[gi * 8 + q];
            if (v > b1) { b2 = b1; i2 = i1; b1 = v; i1 = q; } else if (v > b2) { b2 = v; i2 = q; } }
        const float wa = 1.f / (1.f + __expf(b2 - b1));
        e0 = gi * 8 + i1; e1 = gi * 8 + i2; g0 = pg * wa; g1 = pg * (1.f - wa);
        r0 = atomicAdd(&lcnt[e0], 1); r1 = atomicAdd(&lcnt[e1], 1);
    }
    __syncthreads();
    if (tid < 32) lbase[tid] = atomicAdd(cnt + tid, lcnt[tid]);
    __syncthreads();
    if (tid < 64) { const int i0 = lbase[e0] + r0, i1 = lbase[e1] + r1;
        rinfo[e0 * LCAP + i0] = (int)((cvt_pk_bf16(g0, 0.f) << 16) | (unsigned)(2 * t)); rinfo[e1 * LCAP + i1] = (int)((cvt_pk_bf16(g1, 0.f) << 16) | (unsigned)(2 * t + 1));
        rw[e0 * LCAP + i0] = rsc; rw[e1 * LCAP + i1] = rsc; }
    __syncthreads();
}
__device__ __forceinline__ void phase4(const Params& p, unsigned char* lds, size_t so = 0) { for (int it = blockIdx.x; it < T_ / 64; it += gridDim.x) route_item(p, lds, it, so); }

__device__ __forceinline__ PG8_LAS int* moe_tables_to_lds(const Params& p, unsigned char* lds) {
    PG8_LAS int* tb = (PG8_LAS int*)((PG8_LAS unsigned char*)lds + LCNT_OFF); const int* cnt = (const int*)(p.ws + OFF_CNT);
    if (threadIdx.x < NE) tb[MT_CNT + threadIdx.x] = __hip_atomic_load(cnt + threadIdx.x, __ATOMIC_RELAXED, __HIP_MEMORY_SCOPE_AGENT);
    __syncthreads();
    if (threadIdx.x == 0) { int pt = 0;
#pragma clang loop unroll(disable)
        for (int e = 0; e < NE; ++e) { const int nt = (tb[MT_CNT + e] + 255) >> 8; tb[MT_PST + e] = pt;
#pragma clang loop unroll(disable)
            for (int i = 0; i < nt; ++i) tb[MT_T2E + pt + i] = e;
            pt += nt; }
        tb[MT_PST + NE] = pt; tb[MT_NT] = pt; }
    __syncthreads();
    return tb;
}
__device__ __forceinline__ void phase5(const Params& p, unsigned char* lds) {
    PG8_LAS int* lc = moe_tables_to_lds(p, lds);
    const Epi5 E{p.ws, lc};
    const pg8::MoeOrder S{lc, 4, (int)gridDim.x, (int)blockIdx.x}; const pg8::AOffGather AO{p.ws, lc, D_ / 2};
    pg8::gemm_phase<Epi5, pg8::MoeOrder, pg8::AOffGather, true, true>((PG8_LAS unsigned char*)lds, (const bf16_t*)(p.ws + OFF_H8), (const bf16_t*)(p.ws + OFF_WGU), D_ / 2, S, AO, E);
    { const int G = gridDim.x, c = blockIdx.x, U = 4 * __builtin_amdgcn_readfirstlane(lc[MT_NT]), rem = U % G;
      if (rem == 0) run_tjobs(p, lds, N_TJOBS_GU, N_TJOBS, 0, 1 << 20, c, G);
      else if (c >= rem) run_tjobs(p, lds, N_TJOBS_GU, N_TJOBS, 0, 1 << 20, c - rem, G - rem); }
}
__device__ __forceinline__ void phase6(const Params& p, unsigned char* lds) {
    PG8_LAS int* lc = moe_tables_to_lds(p, lds);
    const Epi6 E{p.ws, lc};
    const pg8::MoeOrder S{lc, 8, (int)gridDim.x, (int)blockIdx.x}; const pg8::AOffDirect AO{DE / 2};
    pg8::gemm_phase<Epi6, pg8::MoeOrder, pg8::AOffDirect, true, true>((PG8_LAS unsigned char*)lds, (const bf16_t*)(p.ws + OFF_B), (const bf16_t*)(p.ws + OFF_WD), DE / 2, S, AO, E);
}
__device__ __forceinline__ void phase7(const Params& p) {
    const int tid = opaque_tid(), wid = tid >> 6, lane = tid & 63;
    const bf16_t* hb = (const bf16_t*)(p.ws + OFF_HB); const unsigned char* ys2 = p.ws + OFF_A;
    for (int t = blockIdx.x * 8 + wid; t < T_; t += gridDim.x * 8) {
        float v[4][8]; float s = 0.f;
#pragma unroll
        for (int i = 0; i < 4; ++i) { const int c = i * 512 + lane * 8;
            const u32x4 a = *(const u32x4*)(hb + (size_t)t * D_ + c); const u32x2 b = *(const u32x2*)(ys2 + (size_t)(2 * t) * D_ + c), d = *(const u32x2*)(ys2 + (size_t)(2 * t + 1) * D_ + c);
            float y0[8], y1[8];
            up4_fp8(b.x, y0[0], y0[1], y0[2], y0[3]); up4_fp8(b.y, y0[4], y0[5], y0[6], y0[7]); up4_fp8(d.x, y1[0], y1[1], y1[2], y1[3]); up4_fp8(d.y, y1[4], y1[5], y1[6], y1[7]);
#pragma unroll
            for (int q = 0; q < 4; ++q) { v[i][2 * q] = bflo(a[q]) + (y0[2 * q] + y1[2 * q]) * (1.f / YS_SCALE); v[i][2 * q + 1] = bfhi(a[q]) + (y0[2 * q + 1] + y1[2 * q + 1]) * (1.f / YS_SCALE);
                s += v[i][2 * q] * v[i][2 * q] + v[i][2 * q + 1] * v[i][2 * q + 1]; } }
        const float rstd = rsqrtf(wave_sum(s) * (1.f / D_) + EPS);
#pragma unroll
        for (int i = 0; i < 4; ++i) { const int c = i * 512 + lane * 8;
            const f32x4 g0 = *(const f32x4*)(p.g_final + c), g1 = *(const f32x4*)(p.g_final + c + 4);
            f32x4 o0, o1;
#pragma unroll
            for (int q = 0; q < 4; ++q) { o0[q] = v[i][q] * rstd * g0[q]; o1[q] = v[i][4 + q] * rstd * g1[q]; }
            *(f32x4*)(p.out + (size_t)t * D_ + c) = o0; *(f32x4*)(p.out + (size_t)t * D_ + c + 4) = o1; }
    }
}

#ifndef ONE_LAUNCH
#define ONE_LAUNCH 1
#endif
template <int PH> __global__ void __launch_bounds__(NTHR, 2) k_phase(Params p) {
    extern __shared__ __attribute__((aligned(16))) unsigned char lds[];
    if (PH == 0) phase0(p, lds);
    if (PH == 1) phase1(p, lds);
    if (PH == 2) phase2(p, lds);
    if (PH == 3) phase3(p, lds);
    if (PH == 4) phase4(p, lds);
    if (PH == 5) phase5(p, lds);
    if (PH == 6) phase6(p, lds);
    if (PH == 7) phase7(p);
}
__global__ void __launch_bounds__(NTHR, 2) k_mega(Params p) {
    extern __shared__ __attribute__((aligned(16))) unsigned char lds[];
    cg::grid_group grid = cg::this_grid();
    volatile PG8_LAS unsigned* bst = (volatile PG8_LAS unsigned*)((PG8_LAS unsigned char*)lds + LBAR_OFF);
    if (threadIdx.x < 2) bst[threadIdx.x] = 0u;
    __syncthreads();
    (void)xcd_barrier_post((unsigned*)(p.ws + OFF_BAR), bst);
#define GRID_BAR() do { XcdBarrier b_; b_.bar = (unsigned*)(opaque_ws(p.ws) + OFF_BAR); b_.x = xb_xcc_id(); b_.st = bst; xcd_barrier(b_); } while (0)
    if (DUP_PHASE == 0) { phase0(p, lds); GRID_BAR(); }
    if (p.ws == nullptr) grid.sync();
    phase0(p, lds); GRID_BAR();
    if (DUP_PHASE == 1) { phase1(p, lds); GRID_BAR(); }
    phase1(p, lds); GRID_BAR();
    if (DUP_PHASE == 2) { phase2(p, lds, OFF_DUMMY - OFF_SSQ); GRID_BAR(); }
    phase2(p, lds); GRID_BAR();
    if (DUP_PHASE == 3) { phase3(p, lds, OFF_DUMMY - OFF_SSQ); GRID_BAR(); }
    phase3(p, lds); GRID_BAR();
    if (DUP_PHASE == 4) { phase4(p, lds, OFF_DUMMY - OFF_SSQ); GRID_BAR(); }
    phase4(p, lds); GRID_BAR();
    if (DUP_PHASE == 5) { phase5(p, lds); GRID_BAR(); }
    phase5(p, lds); GRID_BAR();
    if (DUP_PHASE == 6) { phase6(p, lds); GRID_BAR(); }
    phase6(p, lds); GRID_BAR();
    if (DUP_PHASE == 8) { for (int i = 0; i < 10; ++i) GRID_BAR(); }
    if (DUP_PHASE == 9) { grid.sync(); grid.sync(); }
    if (DUP_PHASE == 7) { phase7(p); GRID_BAR(); }
    phase7(p);
}

extern "C" void kernel_launch(void* const* d_in, const int* in_sizes, int n_in, void* d_out, int out_size, void* d_ws, size_t ws_size, hipStream_t stream) {
    static int grid = 0;
    if (grid == 0) {
        if (n_in != 19 || in_sizes[0] != T_ * D_ || out_size != T_ * D_ || ws_size < WS_END + (DUP_PHASE >= 2 && DUP_PHASE <= 4 ? DUMMY_BYTES : 0)) { fprintf(stderr, "kernel_launch: unexpected shapes (n_in %d, in0 %d, out %d, ws %zu < %zu); nothing launched\n", n_in, n_in > 0 ? in_sizes[0] : -1, out_size, ws_size, (size_t)WS_END); grid = -1; return; }
        int dev = 0, cus = 0, per_cu = 0;
        if (hipGetDevice(&dev) != hipSuccess || hipDeviceGetAttribute(&cus, hipDeviceAttributeMultiprocessorCount, dev) != hipSuccess) { grid = -1; return; }
#if ONE_LAUNCH
        if (hipFuncSetAttribute((const void*)k_mega, hipFuncAttributeMaxDynamicSharedMemorySize, LDS_BYTES) != hipSuccess) { fprintf(stderr, "kernel_launch: hipFuncSetAttribute failed\n"); grid = -1; return; }
        if (hipOccupancyMaxActiveBlocksPerMultiprocessor(&per_cu, (const void*)k_mega, NTHR, LDS_BYTES) != hipSuccess || per_cu < 1) { fprintf(stderr, "kernel_launch: occupancy query says %d blocks per CU\n", per_cu); grid = -1; return; }
        grid = cus * per_cu;
#else
        (void)hipFuncSetAttribute((const void*)k_phase<0>, hipFuncAttributeMaxDynamicSharedMemorySize, LDS_BYTES);
        (void)hipFuncSetAttribute((const void*)k_phase<1>, hipFuncAttributeMaxDynamicSharedMemorySize, LDS_BYTES);
        (void)hipFuncSetAttribute((const void*)k_phase<2>, hipFuncAttributeMaxDynamicSharedMemorySize, LDS_BYTES);
        (void)hipFuncSetAttribute((const void*)k_phase<3>, hipFuncAttributeMaxDynamicSharedMemorySize, LDS_BYTES);
        (void)hipFuncSetAttribute((const void*)k_phase<4>, hipFuncAttributeMaxDynamicSharedMemorySize, LDS_BYTES);
        (void)hipFuncSetAttribute((const void*)k_phase<5>, hipFuncAttributeMaxDynamicSharedMemorySize, LDS_BYTES);
        (void)hipFuncSetAttribute((const void*)k_phase<6>, hipFuncAttributeMaxDynamicSharedMemorySize, LDS_BYTES);
        (void)hipFuncSetAttribute((const void*)k_phase<7>, hipFuncAttributeMaxDynamicSharedMemorySize, LDS_BYTES);
        grid = cus > 0 ? cus : 256;
#endif
    }
    if (grid < 0) return;
    Params p{};
    const float** f = (const float**)&p;
    for (int i = 0; i < 19; ++i) f[i] = (const float*)d_in[i];
    p.out = (float*)d_out; p.ws = (unsigned char*)d_ws;
#if ONE_LAUNCH
    if (hipMemsetAsync((unsigned char*)d_ws + OFF_BAR, 0, BAR_BYTES, stream) != hipSuccess) { fprintf(stderr, "kernel_launch: memset of the barrier words failed\n"); return; }
    void* args[] = {&p};
    const hipError_t e = hipLaunchCooperativeKernel((const void*)k_mega, dim3(grid), dim3(NTHR), args, LDS_BYTES, stream);
    if (e != hipSuccess) fprintf(stderr, "kernel_launch: cooperative launch failed: %s (grid %d)\n", hipGetErrorString(e), grid);
#else
    hipLaunchKernelGGL(k_phase<0>, dim3(grid), dim3(NTHR), LDS_BYTES, stream, p);
    hipLaunchKernelGGL(k_phase<1>, dim3(grid), dim3(NTHR), LDS_BYTES, stream, p);
    hipLaunchKernelGGL(k_phase<2>, dim3(grid), dim3(NTHR), LDS_BYTES, stream, p);
    hipLaunchKernelGGL(k_phase<3>, dim3(grid), dim3(NTHR), LDS_BYTES, stream, p);
    hipLaunchKernelGGL(k_phase<4>, dim3(grid), dim3(NTHR), LDS_BYTES, stream, p);
    hipLaunchKernelGGL(k_phase<5>, dim3(grid), dim3(NTHR), LDS_BYTES, stream, p);
    hipLaunchKernelGGL(k_phase<6>, dim3(grid), dim3(NTHR), LDS_BYTES, stream, p);
    hipLaunchKernelGGL(k_phase<7>, dim3(grid), dim3(NTHR), LDS_BYTES, stream, p);
#endif
}
```

```cpp
#include <hip/hip_runtime.h>
#include <hip/hip_cooperative_groups.h>
#include <cstdio>
namespace cg = cooperative_groups;

typedef unsigned short bf16_t;
typedef float f32x4 __attribute__((ext_vector_type(4)));
typedef unsigned u32x4 __attribute__((ext_vector_type(4)));
typedef unsigned u32x2 __attribute__((ext_vector_type(2)));
typedef short bf16x8 __attribute__((ext_vector_type(8)));
typedef int v4i __attribute__((ext_vector_type(4)));
typedef int v8i __attribute__((ext_vector_type(8)));

constexpr int T_ = 16384, D_ = 2048, DIN = 5120, DP = 4096, NE = 32, DE = 512, SEQ = 4096, LCAP = 16384;
constexpr float EPS = 1e-6f;
#ifndef DUP_PHASE
#define DUP_PHASE -1
#endif
constexpr int NTHR = 512;
constexpr int LDS_BYTES = 163840;
constexpr int LCNT_OFF = 131072, LBAR_OFF = 131072 + 2048, XS_OFF = 131072 + 4096, XM_OFF = XS_OFF + 8192, RS_OFF = XM_OFF;
constexpr int RS_UNITS = 4;
static_assert(XM_OFF + 512 * 32 <= LDS_BYTES && RS_UNITS * 256 * 8 <= 512 * 32, "LDS map");

constexpr size_t SZ_A = (size_t)T_ * DIN * 2;
constexpr size_t SZ_B = (size_t)T_ * D_ * 2;
constexpr size_t OFF_A = 0;
constexpr size_t OFF_B = OFF_A + SZ_A;
constexpr size_t OFF_HB = OFF_B + SZ_B;
constexpr size_t OFF_H8 = OFF_A + (size_t)2 * T_ * D_ * 2;
constexpr float WGU_SCALE = 32.f, WD_SCALE = 16.f, YS_SCALE = 16.f;
constexpr size_t OFF_WIN = OFF_HB + SZ_B;
constexpr size_t OFF_WOUT = OFF_WIN + (size_t)DIN * D_ * 2;
constexpr size_t OFF_WGU = OFF_WOUT + (size_t)D_ * D_ * 2;
constexpr size_t OFF_WD = OFF_WGU + (size_t)NE * 1024 * D_ * 2;
constexpr size_t OFF_WR = OFF_WD + (size_t)NE * D_ * DE * 2;
constexpr size_t OFF_WSB = OFF_WR + (size_t)48 * D_ * 2;
constexpr size_t OFF_SSQ = OFF_WSB + (size_t)8 * 128 * 128 * 2;
constexpr size_t OFF_CNT = OFF_SSQ + (size_t)3 * T_ * 4;
constexpr size_t OFF_RINFO = OFF_CNT + 256;
constexpr size_t OFF_RW = OFF_RINFO + (size_t)NE * LCAP * 4;
constexpr size_t OFF_BAR = OFF_RW + (size_t)NE * LCAP * 4;
constexpr size_t BAR_BYTES = 49152;
constexpr size_t OFF_CMAX = OFF_BAR + 16384;
constexpr size_t OFF_SX = OFF_BAR + BAR_BYTES;
constexpr size_t OFF_SW = OFF_SX + (size_t)T_ * 4;
constexpr size_t WS_END = OFF_SW + 32768;
constexpr size_t OFF_DUMMY = WS_END;
constexpr size_t DUMMY_BYTES = (OFF_BAR - OFF_SSQ);

struct Params {
    const float *x, *norm_mix_g, *w_in, *v_norm_g, *gmlp_ws, *gmlp_bs, *conv_w, *g_a, *g_b, *w_out, *g_ffn, *rgw, *rgb, *rew, *reb, *ewg, *ewu, *ewd, *g_final;
    float* out; unsigned char* ws;
};

__device__ __forceinline__ unsigned cvt_pk_bf16(float lo, float hi) { unsigned r; asm volatile("v_cvt_pk_bf16_f32 %0, %1, %2" : "=v"(r) : "v"(lo), "v"(hi)); return r; }
#define GAS __attribute__((address_space(1)))
typedef GAS unsigned char gbyte;
__device__ __forceinline__ gbyte* opaque_ws(unsigned char* w) { gbyte* g = (gbyte*)w; asm volatile("" : "+s"(g)); return g; }
__device__ __forceinline__ int opaque_tid() { int t = threadIdx.x; asm volatile("" : "+v"(t)); return t; }
__device__ __forceinline__ unsigned pk4_fp8(float a, float b, float c, float d) { int w = 0; w = __builtin_amdgcn_cvt_pk_fp8_f32(a, b, w, false); w = __builtin_amdgcn_cvt_pk_fp8_f32(c, d, w, true); return (unsigned)w; }
__device__ __forceinline__ void up4_fp8(unsigned w, float& a, float& b, float& c, float& d) {
    const auto lo = __builtin_amdgcn_cvt_pk_f32_fp8((int)w, false), hi = __builtin_amdgcn_cvt_pk_f32_fp8((int)w, true); a = lo[0]; b = lo[1]; c = hi[0]; d = hi[1]; }
__device__ __forceinline__ float bflo(unsigned w) { return __uint_as_float(w << 16); }
__device__ __forceinline__ float bfhi(unsigned w) { return __uint_as_float(w & 0xffff0000u); }
__device__ __forceinline__ float wave_sum(float v) {
#pragma unroll
    for (int o = 1; o < 64; o <<= 1) v += __shfl_xor(v, o);
    return v;
}
__device__ __forceinline__ float gelu_t(float x) {
    const float u = x * (0.7978845608f + 0.0356774081f * x * x);
    return x * __builtin_amdgcn_rcpf(1.f + __builtin_amdgcn_exp2f(-2.885390082f * u));
}
__device__ __forceinline__ f32x4 gelu_t4(f32x4 x) {
    const f32x4 u = x * (x * x * (-2.885390082f * 0.0356774081f) + (-2.885390082f * 0.7978845608f));
    f32x4 d;
#pragma unroll
    for (int j = 0; j < 4; ++j) d[j] = __builtin_amdgcn_exp2f(u[j]);
    d = d + 1.f;
#pragma unroll
    for (int j = 0; j < 4; ++j) d[j] = __builtin_amdgcn_rcpf(d[j]);
    return x * d;
}
__device__ __forceinline__ float silu_f(float x) { return x * __builtin_amdgcn_rcpf(1.f + __builtin_amdgcn_exp2f(-1.442695041f * x)); }

#define PG8_LAS __attribute__((address_space(3)))
struct Unit { int pm, pn, e, r0, pnl; };

constexpr int MT_CNT = 0, MT_PST = 32, MT_NT = 65, MT_T2E = 66, MT_WORDS = 66 + 192;
typedef const PG8_LAS int* lcnt_t;
__device__ __forceinline__ bool moe_unit(lcnt_t tb, int NT, int L, Unit& u) {
    const int pt = L / NT;
    if (pt >= __builtin_amdgcn_readfirstlane(tb[MT_NT])) return false;
    const int e = __builtin_amdgcn_readfirstlane(tb[MT_T2E + pt]), mt = pt - __builtin_amdgcn_readfirstlane(tb[MT_PST + e]), j = L - pt * NT;
    u.e = e; u.pm = pt; u.r0 = mt * 256; u.pnl = j; u.pn = e * NT + j; return true;
}

struct NoMeta {};
struct Meta8 { u32x4 lo, hi; };
struct Epi1 {
    static constexpr bool PERM = true, PERM2 = false, MIDSCALE = false;
    static constexpr int EMIN = 16;
    typedef Meta8 Meta;
    unsigned char* ws;
    __device__ __forceinline__ Meta meta_load(const Unit& u, int wr, int fr) const {
        const GAS unsigned* sx = (const GAS unsigned*)(opaque_ws(ws) + OFF_SX) + u.pm * 256 + wr * 64 + fr; Meta mt;
#pragma unroll
        for (int q = 0; q < 4; ++q) { mt.lo[q] = sx[q * 16]; mt.hi[q] = sx[128 + q * 16]; }
        return mt;
    }
    __device__ __forceinline__ void operator()(f32x4 (&acc)[2][2][4][2], const Unit& u, int wr, int wc, int fr, int fq, const Meta& mt) const {
        gbyte* w_ = opaque_ws(ws);
        GAS bf16_t* P = (GAS bf16_t*)(w_ + OFF_A);
        const GAS float* sw = (const GAS float*)(w_ + OFF_SW) + u.pn * 256 + wc * 32 + 8 * fq;
        f32x4 cs[2][2];
#pragma unroll
        for (int bj = 0; bj < 2; ++bj) { cs[bj][0] = *(const GAS f32x4*)(sw + bj * 128); cs[bj][1] = *(const GAS f32x4*)(sw + bj * 128 + 4); }
        if (u.pn >= 12) {
#pragma unroll
            for (int ai = 0; ai < 2; ++ai)
#pragma unroll
                for (int m = 0; m < 4; ++m) {
                    const int row = u.pm * 256 + ai * 128 + wr * 64 + m * 16 + fr; const float rs = __uint_as_float(ai ? mt.hi[m] : mt.lo[m]);
                    GAS bf16_t* rowp = P + (size_t)row * DP + 3072 + (u.pn - 12) * 128 + wc * 16 + 4 * fq;
#pragma unroll
                    for (int bj = 0; bj < 2; ++bj) { const f32x4 z = (acc[ai][bj][m][0] * cs[bj][0]) * (acc[ai][bj][m][1] * cs[bj][1]) * (rs * rs);
                        u32x2 w; w.x = cvt_pk_bf16(z[0], z[1]); w.y = cvt_pk_bf16(z[2], z[3]); *(GAS u32x2*)(rowp + bj * 64) = w; }
                }
            return;
        }
        const bool act = u.pn < 8;
#pragma unroll
        for (int ai = 0; ai < 2; ++ai)
#pragma unroll
            for (int m = 0; m < 4; ++m) {
                const int row = u.pm * 256 + ai * 128 + wr * 64 + m * 16 + fr; const float rs = __uint_as_float(ai ? mt.hi[m] : mt.lo[m]);
                GAS bf16_t* rowp = P + (size_t)row * DP + u.pn * 256 + wc * 32 + 8 * fq;
#pragma unroll
                for (int bj = 0; bj < 2; ++bj) {
                    f32x4 v0 = acc[ai][bj][m][0] * cs[bj][0] * rs, v1 = acc[ai][bj][m][1] * cs[bj][1] * rs;
                    if (act) { v0 = gelu_t4(v0); v1 = gelu_t4(v1); }
                    u32x4 w; w.x = cvt_pk_bf16(v0[0], v0[1]); w.y = cvt_pk_bf16(v0[2], v0[3]); w.z = cvt_pk_bf16(v1[0], v1[1]); w.w = cvt_pk_bf16(v1[2], v1[3]);
                    *(GAS u32x4*)(rowp + bj * 128) = w;
                }
            }
    }
};
struct Epi2 {
    static constexpr bool PERM = true, PERM2 = false, MIDSCALE = true;
    static constexpr int EMIN = 48;
    const float* x; unsigned char* ws; size_t so;
    const PG8_LAS float* rsl;
    __device__ __forceinline__ void midscale(f32x4 (&acc)[2][2][4][2], const Unit& u, int wr, int wc, int fr, int fq) const {
        const PG8_LAS float* pr = rsl + (u.e * 256 + wr * 64 + fr) * 2;
#pragma unroll
        for (int ai = 0; ai < 2; ++ai)
#pragma unroll
            for (int m = 0; m < 4; ++m) {
                const float s = pr[(ai * 128 + m * 16) * 2];
#pragma unroll
                for (int bj = 0; bj < 2; ++bj)
#pragma unroll
                    for (int n = 0; n < 2; ++n) acc[ai][bj][m][n] *= s;
            }
    }
    typedef NoMeta Meta;
    __device__ __forceinline__ Meta meta_load(const Unit&, int, int) const { return Meta{}; }
    __device__ __forceinline__ void operator()(f32x4 (&acc)[2][2][4][2], const Unit& u, int wr, int wc, int fr, int fq, const Meta&) const {
        gbyte* w_ = opaque_ws(ws);
        GAS bf16_t* hb = (GAS bf16_t*)(w_ + OFF_HB); gbyte* h8 = w_ + OFF_H8; float* ssq_h = (float*)(ws + OFF_SSQ + so) + 2 * T_;
#pragma unroll
        for (int ai = 0; ai < 2; ++ai) {
            f32x4 xv[4][2][2];
#pragma unroll
            for (int m = 0; m < 4; ++m) { const float* xp = x + (size_t)(u.pm * 256 + ai * 128 + wr * 64 + m * 16 + fr) * D_ + u.pn * 256 + wc * 32 + 8 * fq;
#pragma unroll
                for (int bj = 0; bj < 2; ++bj) { xv[m][bj][0] = *(const f32x4*)(xp + bj * 128); xv[m][bj][1] = *(const f32x4*)(xp + bj * 128 + 4); } }
#pragma unroll
            for (int m = 0; m < 4; ++m) {
                const int row = u.pm * 256 + ai * 128 + wr * 64 + m * 16 + fr;
                const float rb = rsl[(u.e * 256 + ai * 128 + wr * 64 + m * 16 + fr) * 2 + 1];
                const size_t off = (size_t)row * D_ + u.pn * 256 + wc * 32 + 8 * fq;
                float ss = 0.f;
#pragma unroll
                for (int bj = 0; bj < 2; ++bj) {
                    const f32x4 h0 = xv[m][bj][0] + acc[ai][bj][m][0] * rb, h1 = xv[m][bj][1] + acc[ai][bj][m][1] * rb;
                    ss += (h0[0] * h0[0] + h0[1] * h0[1]) + (h0[2] * h0[2] + h0[3] * h0[3]) + (h1[0] * h1[0] + h1[1] * h1[1]) + (h1[2] * h1[2] + h1[3] * h1[3]);
                    u32x4 w; w.x = cvt_pk_bf16(h0[0], h0[1]); w.y = cvt_pk_bf16(h0[2], h0[3]); w.z = cvt_pk_bf16(h1[0], h1[1]); w.w = cvt_pk_bf16(h1[2], h1[3]);
                    *(GAS u32x4*)(hb + off + bj * 128) = w;
                    u32x2 w8; w8.x = pk4_fp8(h0[0], h0[1], h0[2], h0[3]); w8.y = pk4_fp8(h1[0], h1[1], h1[2], h1[3]);
                    *(GAS u32x2*)(h8 + off + bj * 128) = w8;
                }
                ss += __shfl_xor(ss, 16); ss += __shfl_xor(ss, 32);
                if (fq == 0) atomicAdd(ssq_h + row, ss);
            }
            asm volatile("" ::: "memory");
        }
    }
};
struct Epi5 {
    static constexpr bool PERM = true, PERM2 = false, MIDSCALE = false;
    static constexpr int EMIN = 8;
    typedef Meta8 Meta;
    unsigned char* ws; lcnt_t cnt;
    __device__ __forceinline__ Meta meta_load(const Unit& u, int wr, int fr) const {
        const GAS unsigned* rrs = (const GAS unsigned*)(opaque_ws(ws) + OFF_RW) + u.e * LCAP; const int ce = __builtin_amdgcn_readfirstlane(cnt[u.e]); Meta mt;
#pragma unroll
        for (int q = 0; q < 4; ++q) { const int i0 = u.r0 + wr * 64 + q * 16 + fr, i1 = i0 + 128;
            const unsigned a = rrs[min(i0, ce - 1)], b = rrs[min(i1, ce - 1)]; mt.lo[q] = (i0 < ce) ? a : 0u; mt.hi[q] = (i1 < ce) ? b : 0u; }
        return mt;
    }
    __device__ __forceinline__ void operator()(f32x4 (&acc)[2][2][4][2], const Unit& u, int wr, int wc, int fr, int fq, const Meta& mt) const {
        gbyte* hbuf = opaque_ws(ws) + OFF_B;
#pragma unroll
        for (int ai = 0; ai < 2; ++ai)
#pragma unroll
            for (int m = 0; m < 4; ++m) {
                const int r = ai * 128 + wr * 64 + m * 16 + fr;
                const float rs = __uint_as_float(ai ? mt.hi[m] : mt.lo[m]);
                float o[8];
#pragma unroll
                for (int n = 0; n < 2; ++n)
#pragma unroll
                    for (int j = 0; j < 4; ++j) o[4 * n + j] = silu_f(acc[ai][0][m][n][j] * rs) * (acc[ai][1][m][n][j] * rs);
                u32x2 w; w.x = pk4_fp8(o[0], o[1], o[2], o[3]); w.y = pk4_fp8(o[4], o[5], o[6], o[7]);
                *(GAS u32x2*)(hbuf + (size_t)(u.pm * 256 + r) * DE + u.pnl * 128 + wc * 32 + 8 * fq) = w;
                if (m & 1) asm volatile("" ::: "memory");
            }
    }
};
struct Epi6 {
    static constexpr bool PERM = true, PERM2 = true, MIDSCALE = false; static constexpr int EMIN = 16;
    typedef Meta8 Meta;
    unsigned char* ws; lcnt_t cnt;
    __device__ __forceinline__ Meta meta_load(const Unit& u, int wr, int fr) const {
        const GAS unsigned* rpk = (const GAS unsigned*)(opaque_ws(ws) + OFF_RINFO) + u.e * LCAP; const int ce = __builtin_amdgcn_readfirstlane(cnt[u.e]); Meta mt;
#pragma unroll
        for (int q = 0; q < 4; ++q) { const int i0 = u.r0 + wr * 64 + q * 16 + fr, i1 = i0 + 128;
            const unsigned a = rpk[min(i0, ce - 1)], b = rpk[min(i1, ce - 1)]; mt.lo[q] = (i0 < ce) ? a : 0xFFFFFFFFu; mt.hi[q] = (i1 < ce) ? b : 0xFFFFFFFFu; }
        return mt;
    }
    __device__ __forceinline__ void operator()(f32x4 (&acc)[2][2][4][2], const Unit& u, int wr, int wc, int fr, int fq, const Meta& mt) const {
        gbyte* ys2 = opaque_ws(ws) + OFF_A;
#pragma unroll
        for (int ai = 0; ai < 2; ++ai)
#pragma unroll
            for (int m = 0; m < 4; ++m) {
                const unsigned pk = ai ? mt.hi[m] : mt.lo[m]; const unsigned info = min(pk & 0xFFFFu, 2u * T_);
                {
                    const float g = __uint_as_float(pk & 0xFFFF0000u) * (YS_SCALE / WD_SCALE);
                    gbyte* dst = ys2 + (size_t)info * D_ + u.pnl * 256 + wc * 64 + 16 * fq;
                    const f32x4 v0 = acc[ai][0][m][0] * g, v1 = acc[ai][0][m][1] * g, v2 = acc[ai][1][m][0] * g, v3 = acc[ai][1][m][1] * g;
                    u32x4 w; w.x = pk4_fp8(v0[0], v0[1], v0[2], v0[3]); w.y = pk4_fp8(v1[0], v1[1], v1[2], v1[3]); w.z = pk4_fp8(v2[0], v2[1], v2[2], v2[3]); w.w = pk4_fp8(v3[0], v3[1], v3[2], v3[3]);
                    *(GAS u32x4*)dst = w;
                }
            }
    }
};

namespace pg8 {
constexpr int BM = 256, BK = 64, HALF = 128, HTB = HALF * BK * 2, STAGE_BYTES = 8 * HTB, NXCD = 8, WGM = 8;
__host__ __device__ __forceinline__ int lds_byte(int r, int c) { const int st = (r >> 4) * 2 + (c >> 5), rr = r & 15, cc = c & 31, ob = rr * 64 + cc * 2; return st * 1024 + (ob ^ (((ob >> 9) & 1) << 5)); }
__host__ __device__ __forceinline__ void stage_rc(int b, int& R, int& C) { const int st = b / 1024, sb = b % 1024, swz = sb ^ (((sb >> 9) & 1) << 5); R = (st >> 1) * 16 + swz / 64; C = (st & 1) * 32 + (swz % 64) / 2; }
__host__ __device__ __forceinline__ int perm32(int rho) { const int n = rho >> 4, i = rho & 15; return 8 * (i >> 2) + 4 * n + (i & 3); }

struct StaticOrder {
    int nM, nN, nwg, G, c, i0, i1;
    __device__ void init(int M, int N, int G_, int c_) { nM = M / BM; nN = N / BM; nwg = nM * nN; G = G_; c = c_; i0 = 0; i1 = 1 << 30; }
    __device__ int count() const { return (nwg - c + G - 1) / G; }
    __device__ bool next(int ii, Unit& u) const {
        const int i = ii + i0; if (i >= i1) return false;
        const long L = (long)i * G + c; if (L >= nwg) return false;
        int wgid = (int)L; { const int q = nwg / NXCD, r = nwg % NXCD, xcd = wgid % NXCD, off = wgid / NXCD; wgid = (xcd < r ? xcd * (q + 1) : r * (q + 1) + (xcd - r) * q) + off; }
        const int nig = WGM * nN, gid = wgid / nig, fm = gid * WGM, gsz = (nM - fm) < WGM ? (nM - fm) : WGM;
        u.pm = fm + ((wgid % nig) % gsz); u.pn = (wgid % nig) / gsz; u.e = i; u.r0 = 0; u.pnl = u.pn; return true;
    }
};
struct MoeOrder {
    lcnt_t cnt; int NT, G, c;
    __device__ __forceinline__ bool next(int i, Unit& u) const { return moe_unit(cnt, NT, i * G + c, u); }
};
struct AOffDirect { int K; struct Pre {};
    __device__ __forceinline__ Pre pre(const Unit&, int, int) const { return Pre{}; }
    __device__ __forceinline__ unsigned fin(const Pre&, const Unit& u, int h, int i, int R, int C) const { return (unsigned)(((u.pm * 256 + h * 128 + R) * K + C) * 2); } };
struct AOffGather { unsigned char* ws; lcnt_t cnt; int K;
    struct Pre { unsigned pk[2][2]; };
    __device__ __forceinline__ Pre pre(const Unit& u, int R0, int R1) const {
        const GAS unsigned* rpk = (const GAS unsigned*)(opaque_ws(ws) + OFF_RINFO) + u.e * LCAP; const int ce = __builtin_amdgcn_readfirstlane(cnt[u.e]); Pre p;
#pragma unroll
        for (int h = 0; h < 2; ++h) { const int i0 = u.r0 + h * 128 + R0, i1 = u.r0 + h * 128 + R1;
            p.pk[h][0] = rpk[min(i0, ce - 1)]; p.pk[h][1] = rpk[min(i1, ce - 1)]; }
        return p;
    }
    __device__ __forceinline__ unsigned fin(const Pre& p, const Unit&, int h, int i, int, int C) const { const int tok = (int)((p.pk[h][i] & 0xFFFFu) >> 1); return (unsigned)((tok * K + C) * 2); } };

template <class Epi, class Sched, class AOff, bool ALIGN_EPI, int QM = 0>
__device__ __forceinline__ void gemm_phase(PG8_LAS unsigned char* lds, const bf16_t* Ag, const bf16_t* Btg, const int K, const Sched& S, const AOff& AO, const Epi& E) {
    const int tid = opaque_tid(), wid = __builtin_amdgcn_readfirstlane(tid >> 6), lane = tid & 63, wr = wid >> 2, wc = wid & 3, fr = lane & 15, fq = lane >> 4;
    int nt = K / BK; asm volatile("" : "+s"(nt));
    unsigned voffB[2];
#pragma unroll
    for (int i = 0; i < 2; ++i) { int R, C; stage_rc(tid * 16 + i * 8192, R, C);
        const int Rb = Epi::PERM2 ? (64 * (R >> 5) + 16 * ((R >> 2) & 3) + 4 * ((R >> 4) & 1) + (R & 3)) : Epi::PERM ? ((R & ~31) + perm32(R & 31)) : R; voffB[i] = (unsigned)(Rb * K + C) * 2u; }
#define PG8_APRE(u, pv_) do { int _t = tid; asm volatile("" : "+v"(_t)); int _R0, _R1, _C; stage_rc(_t * 16, _R0, _C); stage_rc(_t * 16 + 8192, _R1, _C); pv_ = AO.pre(u, _R0, _R1); } while (0)
#define PG8_AFIN(u, pv_, d0, d1) do { int _t = tid; asm volatile("" : "+v"(_t)); _Pragma("unroll") for (int _i = 0; _i < 2; ++_i) { int _R, _C; stage_rc(_t * 16 + _i * 8192, _R, _C); d0[_i] = AO.fin(pv_, u, 0, _i, _R, _C); d1[_i] = AO.fin(pv_, u, 1, _i, _R, _C); } } while (0)
#define PG8_LANE(fr_, fq_) int fr_, fq_; { int _t = tid; asm volatile("" : "+v"(_t)); fr_ = _t & 15; fq_ = (_t & 63) >> 4; }
    const unsigned kstep = (unsigned)(BK * 2), tstep = 2u * (unsigned)HALF * (unsigned)K * 2u, hstep = Epi::PERM2 ? 8u * (unsigned)K * 2u : tstep / 2u;
    const unsigned ldsw = (unsigned)wid * 1024u;
    const int aoff = lds_byte(wr * 64 + fr, fq * 8), boff = lds_byte(wc * 32 + fr, fq * 8);
    const char* const Ab = (const char*)Ag; const char* const Bb = (const char*)Btg;
#define PG8_SA(b, h) (((b) * 2 + (h)) * HTB)
#define PG8_SB(b, h) ((4 + (b) * 2 + (h)) * HTB)
#define PG8_STAGE(bufoff, gbase, uoff, voff) do { _Pragma("unroll") for (int _i = 0; _i < 2; ++_i) \
        __builtin_amdgcn_global_load_lds((const unsigned*)((gbase) + (size_t)(unsigned)((uoff) + (voff)[_i])), (PG8_LAS unsigned*)(lds + (bufoff) + ldsw + _i * 8192), 16, 0, 0); } while (0)
#define PG8_LD32(base) __builtin_shufflevector(*(const PG8_LAS v4i*)(base), *(const PG8_LAS v4i*)((base) + 1024), 0, 1, 2, 3, 4, 5, 6, 7)
#define PG8_LDA(dst, b, h) do { _Pragma("unroll") for (int m = 0; m < 4; ++m) dst[m] = PG8_LD32(lds + PG8_SA(b, h) + aoff + m * 2048); } while (0)
#define PG8_LDB(dst, b, h) do { _Pragma("unroll") for (int n = 0; n < 2; ++n) dst[n] = PG8_LD32(lds + PG8_SB(b, h) + boff + n * 2048); } while (0)
#define PG8_LO(x) __builtin_bit_cast(bf16x8, __builtin_shufflevector((x), (x), 0, 1, 2, 3))
#define PG8_HI(x) __builtin_bit_cast(bf16x8, __builtin_shufflevector((x), (x), 4, 5, 6, 7))
#define PG8_LOI(x) __builtin_shufflevector((x), (x), 0, 1, 2, 3)
#define PG8_HII(x) __builtin_shufflevector((x), (x), 4, 5, 6, 7)
#define PG8_MMA(ai, bj, At, Bt) do { __builtin_amdgcn_s_setprio(1); _Pragma("unroll") for (int m = 0; m < 4; ++m) _Pragma("unroll") for (int n = 0; n < 2; ++n) { \
        if constexpr (QM == 1) acc[ai][bj][m][n] = __builtin_amdgcn_mfma_scale_f32_16x16x128_f8f6f4(Bt[n], At[m], acc[ai][bj][m][n], 0, 0, 0, 0, 0, 0);   \
        else if constexpr (QM == 2) { v4i c_ = __builtin_bit_cast(v4i, acc[ai][bj][m][n]); c_ = __builtin_amdgcn_mfma_i32_16x16x64_i8(PG8_LOI(Bt[n]), PG8_LOI(At[m]), c_, 0, 0, 0); \
               c_ = __builtin_amdgcn_mfma_i32_16x16x64_i8(PG8_HII(Bt[n]), PG8_HII(At[m]), c_, 0, 0, 0); acc[ai][bj][m][n] = __builtin_bit_cast(f32x4, c_); } \
        else { acc[ai][bj][m][n] = __builtin_amdgcn_mfma_f32_16x16x32_bf16(PG8_LO(Bt[n]), PG8_LO(At[m]), acc[ai][bj][m][n], 0, 0, 0); \
               acc[ai][bj][m][n] = __builtin_amdgcn_mfma_f32_16x16x32_bf16(PG8_HI(Bt[n]), PG8_HI(At[m]), acc[ai][bj][m][n], 0, 0, 0); } } \
        __builtin_amdgcn_s_setprio(0); } while (0)
#define PG8_WAIT_V(n) asm volatile("s_waitcnt vmcnt(" #n ")" ::: "memory")
#define PG8_WAIT_L(n) asm volatile("s_waitcnt lgkmcnt(" #n ")" ::: "memory")
#define PG8_BAR __builtin_amdgcn_s_barrier()
#define PG8_SCHED __builtin_amdgcn_sched_barrier(0)
    Unit cur, nxt; int ui = 0;
    if (!S.next(0, cur)) return;
    f32x4 acc[2][2][4][2];
#pragma unroll
    for (int a = 0; a < 2; ++a)
#pragma unroll
        for (int b = 0; b < 2; ++b)
#pragma unroll
            for (int m = 0; m < 4; ++m)
#pragma unroll
                for (int n = 0; n < 2; ++n) acc[a][b][m][n] = (f32x4){0.f, 0.f, 0.f, 0.f};
    v8i At[4], B0[2], B1[2];
    unsigned vo0[2], vo1[2];
    PG8_LAS u32x4* const svn = (PG8_LAS u32x4*)(lds + XS_OFF) + tid;
    PG8_LAS u32x4* const smeta = (PG8_LAS u32x4*)(lds + XM_OFF + tid * 32);
    constexpr bool HAS_META = sizeof(typename Epi::Meta) > 1;
    bool has_next = S.next(1, nxt);
    { typename AOff::Pre pc; PG8_APRE(cur, pc); PG8_AFIN(cur, pc, vo0, vo1);
      unsigned vn0[2], vn1[2];
      if (has_next) { typename AOff::Pre pn; PG8_APRE(nxt, pn); PG8_AFIN(nxt, pn, vn0, vn1); } else { vn0[0] = vo0[0]; vn0[1] = vo0[1]; vn1[0] = vo1[0]; vn1[1] = vo1[1]; }
      *svn = (u32x4){vn0[0], vn0[1], vn1[0], vn1[1]}; }
    if constexpr (HAS_META) { PG8_LANE(fr_, fq_); (void)fq_; const typename Epi::Meta m0 = E.meta_load(cur, wr, fr_); smeta[0] = m0.lo; smeta[1] = m0.hi; }
    unsigned cB = (unsigned)cur.pn * tstep;
    PG8_STAGE(PG8_SB(0, 0), Bb, cB, voffB); PG8_STAGE(PG8_SB(0, 1), Bb, cB + hstep, voffB); PG8_STAGE(PG8_SA(0, 0), Ab, 0u, vo0); PG8_STAGE(PG8_SA(0, 1), Ab, 0u, vo1);
    if (wr == 1) PG8_BAR;
    PG8_WAIT_V(2); PG8_BAR;
    PG8_STAGE(PG8_SB(1, 0), Bb, cB + kstep, voffB); PG8_STAGE(PG8_SA(1, 0), Ab, kstep, vo0); PG8_STAGE(PG8_SB(1, 1), Bb, cB + hstep + kstep, voffB);
    PG8_WAIT_V(6); PG8_BAR;
    for (;;) {
        const unsigned nB = has_next ? (unsigned)nxt.pn * tstep : cB;
#pragma clang loop unroll(disable)
        for (int t = 0; t < nt; t += 2) {
            const bool last = (t == nt - 2);
            if constexpr (Epi::MIDSCALE) { if (t == nt / 2) { PG8_LANE(fr_, fq_); E.midscale(acc, cur, wr, wc, fr_, fq_); } }
            const unsigned k1 = (unsigned)(t + 1) * kstep, k2 = last ? 0u : (unsigned)(t + 2) * kstep, k3 = k2 + kstep;
            const unsigned b2 = last ? nB : cB + (unsigned)(t + 2) * kstep, b3 = b2 + kstep;
            PG8_LDB(B0, 0, 0); PG8_LDB(B1, 0, 1); PG8_SCHED; PG8_LDA(At, 0, 0); PG8_STAGE(PG8_SA(1, 1), Ab, k1, vo1);
            if (t == 0 && ui > 0) asm volatile("s_waitcnt vmcnt(%0)" :: "n"(8 + Epi::EMIN) : "memory"); else PG8_WAIT_V(8);
            PG8_WAIT_L(0); PG8_BAR; PG8_MMA(0, 0, At, B0); PG8_MMA(0, 1, At, B1); PG8_BAR; PG8_SCHED;
            if (last) { PG8_LAS u32x4* sp_ = svn; asm volatile("" : "+v"(sp_));
                const u32x4 v = *sp_; vo0[0] = v.x; vo0[1] = v.y; vo1[0] = v.z; vo1[1] = v.w; }
            PG8_LDA(At, 0, 1); PG8_STAGE(PG8_SB(0, 0), Bb, b2, voffB); PG8_STAGE(PG8_SB(0, 1), Bb, b2 + hstep, voffB); PG8_STAGE(PG8_SA(0, 0), Ab, k2, vo0);
            if (t == 0 && ui > 0) asm volatile("s_waitcnt vmcnt(%0)" :: "n"(8 + Epi::EMIN) : "memory"); else PG8_WAIT_V(8);
            PG8_WAIT_L(0); PG8_BAR; PG8_MMA(1, 0, At, B0); PG8_MMA(1, 1, At, B1); PG8_BAR; PG8_SCHED;
            PG8_LDB(B0, 1, 0); PG8_LDB(B1, 1, 1); PG8_SCHED; PG8_LDA(At, 1, 0); PG8_STAGE(PG8_SA(0, 1), Ab, k2, vo1);
            PG8_WAIT_V(8); PG8_WAIT_L(0); PG8_BAR; PG8_MMA(0, 0, At, B0); PG8_MMA(0, 1, At, B1); PG8_BAR; PG8_SCHED;
            PG8_LDA(At, 1, 1); PG8_STAGE(PG8_SB(1, 0), Bb, b3, voffB); PG8_STAGE(PG8_SB(1, 1), Bb, b3 + hstep, voffB); PG8_STAGE(PG8_SA(1, 0), Ab, k3, vo0);
            PG8_WAIT_V(8); PG8_WAIT_L(0); PG8_BAR; PG8_MMA(1, 0, At, B0); PG8_MMA(1, 1, At, B1); PG8_BAR; PG8_SCHED;
        }
        if constexpr (ALIGN_EPI) { if (wr == 0) PG8_BAR; }
        Unit nn; const bool has2 = has_next && S.next(ui + 2, nn);
        typename Epi::Meta mnext;
        { PG8_LANE(fr_, fq_);
          typename Epi::Meta meta; if constexpr (HAS_META) { PG8_LAS u32x4* sp_ = smeta; asm volatile("" : "+v"(sp_)); meta.lo = sp_[0]; meta.hi = sp_[1]; }
          if (has_next) mnext = E.meta_load(nxt, wr, fr_);
          if (has2) { typename AOff::Pre pnn; PG8_APRE(nn, pnn); unsigned vn0[2], vn1[2]; PG8_AFIN(nn, pnn, vn0, vn1); *svn = (u32x4){vn0[0], vn0[1], vn1[0], vn1[1]}; }
          if constexpr (QM == 2) {
#pragma unroll
              for (int a = 0; a < 2; ++a)
#pragma unroll
                  for (int b = 0; b < 2; ++b)
#pragma unroll
                      for (int m = 0; m < 4; ++m)
#pragma unroll
                          for (int n = 0; n < 2; ++n) { const v4i c_ = __builtin_bit_cast(v4i, acc[a][b][m][n]); acc[a][b][m][n] = (f32x4){(float)c_[0], (float)c_[1], (float)c_[2], (float)c_[3]}; } }
          E(acc, cur, wr, wc, fr_, fq_, meta); }
        if (!has_next) break;
        if constexpr (HAS_META) { smeta[0] = mnext.lo; smeta[1] = mnext.hi; }
#pragma unroll
        for (int a = 0; a < 2; ++a)
#pragma unroll
            for (int b = 0; b < 2; ++b)
#pragma unroll
                for (int m = 0; m < 4; ++m)
#pragma unroll
                    for (int n = 0; n < 2; ++n) acc[a][b][m][n] = (f32x4){0.f, 0.f, 0.f, 0.f};
        cur = nxt; nxt = nn; has_next = has2; cB = nB; ++ui;
        if constexpr (ALIGN_EPI) { if (wr == 1) PG8_BAR; }
    }
    PG8_WAIT_V(0);
    if constexpr (!ALIGN_EPI) { if (wr == 0) PG8_BAR; }
    PG8_BAR;
#undef PG8_APRE
#undef PG8_AFIN
#undef PG8_LANE
#undef PG8_SA
#undef PG8_SB
#undef PG8_STAGE
#undef PG8_LDA
#undef PG8_LDB
#undef PG8_MMA
#undef PG8_LO
#undef PG8_HI
#undef PG8_LOI
#undef PG8_HII
#undef PG8_LD32
#undef PG8_WAIT_V
#undef PG8_WAIT_L
#undef PG8_BAR
#undef PG8_SCHED
}
}


#define XB_TMO      128
#define XB_XCNT(j)  (256  + 64 * (j))
#define XB_XSUB(j)  (1280 + 64 * (j))
#define XB_XGEN(j)  (2304 + 64 * (j))
#define XB_TOP      3328
#define XB_TOPGEN   3392
#define XCD_BAR_WORDS 3456
#define XB_SPIN_CAP (1u << 18)
__device__ __forceinline__ unsigned xb_ld(unsigned* p)              { return __hip_atomic_load(p, __ATOMIC_RELAXED, __HIP_MEMORY_SCOPE_AGENT); }
__device__ __forceinline__ unsigned xb_add(unsigned* p, unsigned v) { return __hip_atomic_fetch_add(p, v, __ATOMIC_RELAXED, __HIP_MEMORY_SCOPE_AGENT); }
__device__ __forceinline__ unsigned xb_xcc_id() { return (unsigned)__builtin_amdgcn_s_getreg((3 << 11) | 20) & 0xFu; }
#define XB_SPIN(cond, bar) do { unsigned _sp = 0; while (cond) { __builtin_amdgcn_s_sleep(1); \
    if ((++_sp & 255u) == 0u) { if (xb_ld(&(bar)[XB_TMO])) break; if (_sp > XB_SPIN_CAP) { atomicAdd(&(bar)[XB_TMO], 1u); break; } } } } while (0)
struct XcdBarrier { unsigned* bar; unsigned x; volatile PG8_LAS unsigned* st; };
__device__ __forceinline__ XcdBarrier xcd_barrier_post(unsigned* bar, volatile PG8_LAS unsigned* st) {
    XcdBarrier b; b.bar = bar; b.x = xb_xcc_id(); b.st = st;
    if (threadIdx.x == 0) (void)xb_add(&bar[XB_XCNT(b.x)], 1u);
    return b;
}
__device__ __forceinline__ void xcd_barrier_complete(unsigned* bar, unsigned x, unsigned& nloc, unsigned& nx) {
    const unsigned G = gridDim.x * gridDim.y * gridDim.z;
    unsigned sum, cnt, mine, sp = 0u;
    for (;;) {
        sum = 0u; cnt = 0u; mine = 0u;
#pragma unroll
        for (unsigned j = 0; j < 16; ++j) { const unsigned c = xb_ld(&bar[XB_XCNT(j)]); sum += c; cnt += (c > 0u) ? 1u : 0u; mine = (j == x) ? c : mine; }
        if (sum == G) break;
        __builtin_amdgcn_s_sleep(1);
        if ((++sp & 255u) == 0u) { if (xb_ld(&bar[XB_TMO])) break; if (sp > XB_SPIN_CAP) { atomicAdd(&bar[XB_TMO], 1u); break; } }
    }
    nloc = mine > 0u ? mine : 1u; nx = cnt > 0u ? cnt : 1u;
}
__device__ __forceinline__ void xcd_barrier(const XcdBarrier& b) {
    asm volatile("s_waitcnt vmcnt(0)" ::: "memory");
    __syncthreads();
    if (threadIdx.x == 0) {
        unsigned* bar = b.bar;
        __builtin_amdgcn_s_waitcnt(0);
        unsigned nloc = b.st[0], nx = b.st[1];
        if (nloc == 0u) { xcd_barrier_complete(bar, b.x, nloc, nx); b.st[0] = nloc; b.st[1] = nx; }
        const unsigned old = xb_add(&bar[XB_XSUB(b.x)], 1u);
        const unsigned gen = old / nloc;
        if (old + 1u == (gen + 1u) * nloc) {
            __builtin_amdgcn_fence(__ATOMIC_RELEASE, "agent");
            asm volatile("s_waitcnt vmcnt(0)" ::: "memory");
            const unsigned og = xb_add(&bar[XB_TOP], 1u);
            const unsigned tg = og / nx;
            if (og + 1u == (tg + 1u) * nx) xb_add(&bar[XB_TOPGEN], 1u);
            else XB_SPIN(xb_ld(&bar[XB_TOPGEN]) == tg, bar);
            __builtin_amdgcn_fence(__ATOMIC_ACQUIRE, "agent");
            xb_add(&bar[XB_XGEN(b.x)], 1u);
            asm volatile("s_waitcnt vmcnt(0)" ::: "memory");
        } else {
            XB_SPIN(xb_ld(&bar[XB_XGEN(b.x)]) == gen, bar);
            __builtin_amdgcn_fence(__ATOMIC_ACQUIRE, "agent");
            asm volatile("s_waitcnt vmcnt(0)" ::: "memory");
        }
    }
    __syncthreads();
}

struct TJob { const float* src; int ld; unsigned char* dst; int lddst; float sc; const float* sk; int fp8; int rmap; int row0; int tr0; const unsigned* sk2; float* swp; };
__device__ __forceinline__ bool tjob_decode(const Params& p, int q, TJob& j, int w_in_kind = 3) {
    j.rmap = 0; j.row0 = 0; j.tr0 = 0; j.sk2 = (const unsigned*)(p.ws + OFF_CMAX); j.swp = (float*)(p.ws + OFF_SW); j.sk = nullptr; j.sc = 1.f; j.fp8 = 0;
    constexpr int N_IN = 16 * 80, N_OUT = 16 * 32, N_G = 32 * 128;
    if (q < N_IN) { const int tr = q / 80, tc = q % 80; j.src = p.w_in + (size_t)tr * 128 * DIN + tc * 64; j.ld = DIN; j.sc = 1.f; j.sk = nullptr; j.fp8 = w_in_kind; j.lddst = D_; j.rmap = 0;
        if (tc < 48) { j.row0 = tc * 64; }
        else { const int hsel = tc >= 64, ch0 = (tc - (hsel ? 64 : 48)) * 64; j.rmap = 1 + hsel; j.row0 = 3072 + 256 * (ch0 >> 7) + 2 * (ch0 & 127); }
        j.dst = p.ws + OFF_WIN + (size_t)j.row0 * D_ + tr * 128; j.sk2 = (const unsigned*)(p.ws + OFF_CMAX); j.swp = (float*)(p.ws + OFF_SW); j.tr0 = (tr == 0);
        return true; } q -= N_IN;
    if (q < N_OUT) { const int tr = q / 32, tc = q % 32; j.src = p.w_out + (size_t)tr * 128 * D_ + tc * 64; j.ld = D_; j.dst = p.ws + OFF_WOUT + ((size_t)tc * 64 * D_ + tr * 128) * 2; j.lddst = D_ * 2; j.sc = 1.f;
        j.sk = (tr < 8 ? p.g_a + tr * 128 : p.g_b + (tr - 8) * 128); j.fp8 = 0; j.rmap = 0; return true; } q -= N_OUT;
    if (q < 2 * N_G) { const int up = q >= N_G; if (up) q -= N_G; const int e = q >> 7, rem = q & 127, tr = rem >> 3, tc = rem & 7, c0 = tc * 64;
        j.src = (up ? p.ewu : p.ewg) + (size_t)e * D_ * DE + (size_t)tr * 128 * DE + c0; j.ld = DE;
        j.dst = p.ws + OFF_WGU + (size_t)e * 1024 * D_ + (size_t)((c0 >> 7) * 256 + (up ? 128 : 0) + (c0 & 127)) * D_ + tr * 128; j.lddst = D_; j.sc = WGU_SCALE; j.sk = p.g_ffn + tr * 128; j.fp8 = 1; j.rmap = 0; return true; } q -= 2 * N_G;
    if (q < N_G) { const int e = q >> 7, rem = q & 127, tr = rem >> 5, tc = rem & 31;
        j.src = p.ewd + (size_t)e * DE * D_ + (size_t)tr * 128 * D_ + tc * 64; j.ld = D_; j.dst = p.ws + OFF_WD + (size_t)e * D_ * DE + (size_t)tc * 64 * DE + tr * 128; j.lddst = DE; j.sc = WD_SCALE; j.sk = nullptr; j.fp8 = 1; j.rmap = 0; return true; }
    return false;
}
constexpr int N_TJOBS_IN = 16 * 80, N_TJOBS_DENSE = 16 * 80 + 16 * 32, N_TJOBS_GU = N_TJOBS_DENSE + 2 * 32 * 128, N_TJOBS = N_TJOBS_GU + 32 * 128;
__device__ __forceinline__ void tjob_stage(const TJob& j, int tid, unsigned char* lds, int b) {
    PG8_LAS unsigned char* L = (PG8_LAS unsigned char*)lds + b * 32768 + __builtin_amdgcn_readfirstlane(tid >> 6) * 1024;
#pragma unroll
    for (int i = 0; i < 4; ++i) { const int k = i * 32 + (tid >> 4), pn = (tid & 15) ^ ((k >> 4) & 7);
        __builtin_amdgcn_global_load_lds((const unsigned*)(j.src + (size_t)k * j.ld + 4 * pn), (PG8_LAS unsigned*)(L + i * 8192), 16, 0, 2); }
    const float* aux = (j.fp8 == 3) ? (const float*)(j.sk2 + j.row0) : (j.sk ? j.sk : j.src);
    __builtin_amdgcn_global_load_lds((const unsigned*)(aux + (tid & 31) * 4), (PG8_LAS unsigned*)((PG8_LAS unsigned char*)lds + XS_OFF + b * 1024), 16, 0, 0);
}
__device__ __forceinline__ void tjob_finish(const TJob& j, int tid, unsigned char* lds, int b) {
    const int c = tid >> 3, kb = tid & 7, rr = kb * 16; float v[16];
    { const PG8_LAS float* lt = (const PG8_LAS float*)((PG8_LAS unsigned char*)lds + b * 32768) + rr * 64 + 4 * ((c >> 2) ^ kb) + (c & 3);
#pragma unroll
      for (int q = 0; q < 16; ++q) v[q] = lt[q * 64]; }
    const PG8_LAS float* ax = (const PG8_LAS float*)((PG8_LAS unsigned char*)lds + XS_OFF + b * 1024);
    if (j.sk) {
#pragma unroll
        for (int q4 = 0; q4 < 4; ++q4) { const f32x4 f = *(const PG8_LAS f32x4*)(ax + rr + 4 * q4);
#pragma unroll
            for (int e = 0; e < 4; ++e) v[4 * q4 + e] *= j.sc * f[e]; } }
    else {
#pragma unroll
        for (int q = 0; q < 16; ++q) v[q] *= j.sc; }
    const int drow = j.rmap ? 8 * (c >> 2) + 4 * (j.rmap - 1) + (c & 3) : c;
    unsigned char* d = j.dst + (size_t)drow * j.lddst;
    if (j.fp8 == 2) {
        float am = 0.f;
#pragma unroll
        for (int q = 0; q < 16; ++q) am = fmaxf(am, fabsf(v[q]));
        am = fmaxf(am, __shfl_xor(am, 1)); am = fmaxf(am, __shfl_xor(am, 2)); am = fmaxf(am, __shfl_xor(am, 4));
        if ((tid & 7) == 0) atomicMax((unsigned*)(j.sk2) + j.row0 + drow, __float_as_uint(am)); }
    else if (j.fp8 == 3) {
        const float am = fmaxf(ax[drow], 1e-30f), qi = 127.f / am;
        unsigned w[4];
#pragma unroll
        for (int q = 0; q < 4; ++q) { const int a = (int)rintf(v[4 * q] * qi), b2 = (int)rintf(v[4 * q + 1] * qi), c2 = (int)rintf(v[4 * q + 2] * qi), d2 = (int)rintf(v[4 * q + 3] * qi);
            w[q] = (unsigned)(a & 255) | ((unsigned)(b2 & 255) << 8) | ((unsigned)(c2 & 255) << 16) | ((unsigned)(d2 & 255) << 24); }
        *(u32x4*)(d + rr) = (u32x4){w[0], w[1], w[2], w[3]};
        if (rr == 0 && j.tr0) j.swp[j.row0 + drow] = am * (1.f / 127.f); }
    else if (j.fp8) { u32x4 w; w.x = pk4_fp8(v[0], v[1], v[2], v[3]); w.y = pk4_fp8(v[4], v[5], v[6], v[7]); w.z = pk4_fp8(v[8], v[9], v[10], v[11]); w.w = pk4_fp8(v[12], v[13], v[14], v[15]);
        *(u32x4*)(d + rr) = w; }
    else { u32x4 w0, w1; w0.x = cvt_pk_bf16(v[0], v[1]); w0.y = cvt_pk_bf16(v[2], v[3]); w0.z = cvt_pk_bf16(v[4], v[5]); w0.w = cvt_pk_bf16(v[6], v[7]);
        w1.x = cvt_pk_bf16(v[8], v[9]); w1.y = cvt_pk_bf16(v[10], v[11]); w1.z = cvt_pk_bf16(v[12], v[13]); w1.w = cvt_pk_bf16(v[14], v[15]);
        *(u32x4*)(d + rr * 2) = w0; *(u32x4*)(d + rr * 2 + 16) = w1; }
}
__device__ __forceinline__ void run_tjobs(const Params& p, unsigned char* lds, int qlo, int qhi, int k0 = 0, int k1 = 1 << 20, int first = -1, int stride = 0, int w_in_kind = 3) {
    const int tid = opaque_tid(), nb = stride > 0 ? stride : (int)gridDim.x;
    const int qb = qlo + (first >= 0 ? first : (int)blockIdx.x);
#define TJ_OK(kk) ((kk) < k1 && qb + (kk) * nb < qhi)
    asm volatile("s_waitcnt vmcnt(0)" ::: "memory");
#pragma unroll
    for (int i = 0; i < 3; ++i) if (TJ_OK(k0 + i)) { TJob j; tjob_decode(p, qb + (k0 + i) * nb, j, w_in_kind); tjob_stage(j, tid, lds, i); }
    int b = 0;
#pragma clang loop unroll(disable)
    for (int k = k0; TJ_OK(k); ++k) {
        if (TJ_OK(k + 2)) asm volatile("s_waitcnt vmcnt(10)" ::: "memory");
        else if (TJ_OK(k + 1)) asm volatile("s_waitcnt vmcnt(5)" ::: "memory");
        else asm volatile("s_waitcnt vmcnt(0)" ::: "memory");
        __builtin_amdgcn_s_barrier();
        asm volatile("" ::: "memory");
        if (TJ_OK(k + 3)) { TJob jn; tjob_decode(p, qb + (k + 3) * nb, jn, w_in_kind); tjob_stage(jn, tid, lds, (b + 3) & 3); }
        { TJob j; tjob_decode(p, qb + k * nb, j, w_in_kind); tjob_finish(j, tid, lds, b); }
        b = (b + 1) & 3;
    }
#undef TJ_OK
    __syncthreads();
}
__device__ __forceinline__ void phase0(const Params& p, unsigned char* lds) {
    const int tid = opaque_tid(), nb = gridDim.x, bid = blockIdx.x, wid = tid >> 6, lane = tid & 63;
    { float* z = (float*)(p.ws + OFF_SSQ);
      for (int i = bid * NTHR + tid; i < 3 * T_ + 64; i += nb * NTHR) z[i] = 0.f;
      if (DUP_PHASE >= 2 && DUP_PHASE <= 4) { float* zd = (float*)(p.ws + OFF_SSQ + (OFF_DUMMY - OFF_SSQ)); for (int i = bid * NTHR + tid; i < 3 * T_ + 64; i += nb * NTHR) zd[i] = 0.f; } }
    { bf16_t* wrt = (bf16_t*)(p.ws + OFF_WR);
      for (int i = bid * NTHR + tid; i < 48 * D_; i += nb * NTHR) {
          const int o = i >> 11, k = i & 2047; float v = 0.f;
          if (o < 4) v = p.rgw[k * 4 + o]; else if (o < 36) v = p.rew[k * 32 + (o - 4)];
          wrt[i] = (bf16_t)(cvt_pk_bf16(v * p.g_ffn[k], 0.f) & 0xffffu); } }
    { bf16_t* wsb = (bf16_t*)(p.ws + OFF_WSB);
      for (int i = bid * NTHR + tid; i < 8 * 128 * 128; i += nb * NTHR) { const int r = (i >> 7) & 127, c = i & 127;
          wsb[i] = (bf16_t)(cvt_pk_bf16(((r >> 6) >= (c >> 6)) ? p.gmlp_ws[i] : 0.f, 0.f) & 0xffffu); } }
    { unsigned char* xq = p.ws + OFF_B; float* sx = (float*)(p.ws + OFF_SX);
      for (int row = bid * 8 + wid; row < T_; row += nb * 8) {
          const float* xr = p.x + (size_t)row * D_;
          f32x4 v[8]; float s = 0.f;
#pragma unroll
          for (int i = 0; i < 8; ++i) { v[i] = *(const f32x4*)(xr + i * 256 + lane * 4); s += (v[i][0] * v[i][0] + v[i][1] * v[i][1]) + (v[i][2] * v[i][2] + v[i][3] * v[i][3]); }
          const float rstd = rsqrtf(wave_sum(s) * (1.f / D_) + EPS);
          float amax = 0.f;
#pragma unroll
          for (int i = 0; i < 8; ++i) { const f32x4 g = *(const f32x4*)(p.norm_mix_g + i * 256 + lane * 4); v[i] = v[i] * rstd * g;
              amax = fmaxf(amax, fmaxf(fmaxf(fabsf(v[i][0]), fabsf(v[i][1])), fmaxf(fabsf(v[i][2]), fabsf(v[i][3])))); }
#pragma unroll
          for (int o_ = 1; o_ < 64; o_ <<= 1) amax = fmaxf(amax, __shfl_xor(amax, o_));
          amax = fmaxf(amax, 1e-30f); const float qi = 127.f / amax;
          if (lane == 0) sx[row] = amax * (1.f / 127.f);
#pragma unroll
          for (int i = 0; i < 8; ++i) { const int a = (int)rintf(v[i][0] * qi), b = (int)rintf(v[i][1] * qi), c = (int)rintf(v[i][2] * qi), d = (int)rintf(v[i][3] * qi);
              *(unsigned*)(xq + (size_t)row * D_ + i * 256 + lane * 4) = (unsigned)(a & 255) | ((unsigned)(b & 255) << 8) | ((unsigned)(c & 255) << 16) | ((unsigned)(d & 255) << 24); } } }
    run_tjobs(p, lds, 0, N_TJOBS_IN, 0, 1 << 20, -1, 0, 2);
}
__device__ __forceinline__ void phase0b(const Params& p, unsigned char* lds) { run_tjobs(p, lds, 0, N_TJOBS_IN, 0, 1 << 20, -1, 0, 3); }

__device__ __forceinline__ int side_rounds(int nb) { return (N_TJOBS_GU - N_TJOBS_IN + nb - 1) / nb; }
__device__ __forceinline__ void phase1(const Params& p, unsigned char* lds) {
    const Epi1 E{p.ws};
    pg8::StaticOrder S; S.init(T_, DIN, gridDim.x, blockIdx.x); const pg8::AOffDirect AO{D_ / 2};
    const int nu = S.count(), col = blockIdx.x & 3, split = col == 0 ? 0 : col == 1 ? (2 * nu) / 5 : col == 2 ? (3 * nu) / 5 : nu;
    const int kr = side_rounds(gridDim.x), k1 = kr / 2;
    S.i0 = 0; S.i1 = split;
    pg8::gemm_phase<Epi1, pg8::StaticOrder, pg8::AOffDirect, true, 2>((PG8_LAS unsigned char*)lds, (const bf16_t*)(p.ws + OFF_B), (const bf16_t*)(p.ws + OFF_WIN), D_ / 2, S, AO, E);
    run_tjobs(p, lds, N_TJOBS_IN, N_TJOBS_GU, 0, k1);
    S.i0 = split; S.i1 = nu;
    pg8::gemm_phase<Epi1, pg8::StaticOrder, pg8::AOffDirect, true, 2>((PG8_LAS unsigned char*)lds, (const bf16_t*)(p.ws + OFF_B), (const bf16_t*)(p.ws + OFF_WIN), D_ / 2, S, AO, E);
}

struct VRegs { u32x4 v[4]; };
__device__ __forceinline__ void gmlp_load_v(const Params& p, int item, int tid, VRegs& r) {
    const int h = item & 7, t0 = (item >> 3) * 128, j = tid >> 2, dc = (tid & 3) * 32;
    const u32x4* src = (const u32x4*)((const bf16_t*)(p.ws + OFF_A) + (size_t)(t0 + j) * DP + 1024 + h * 128 + dc);
#pragma unroll
    for (int q = 0; q < 4; ++q) r.v[q] = src[q];
}
__device__ __forceinline__ void mixer_gmlp_item(const Params& p, bf16_t* Vt, int item, const VRegs& r, size_t so) {
    const int tid = opaque_tid(), wid = tid >> 6, lane = tid & 63, fr = lane & 15, fq = lane >> 4;
    const int h = item & 7, t0 = (item >> 3) * 128;
    const bf16_t* P = (const bf16_t*)(p.ws + OFF_A); bf16_t* Y = (bf16_t*)(p.ws + OFF_B); float* ssq_a = (float*)(p.ws + OFF_SSQ + so);
    const bf16_t* wsb = (const bf16_t*)(p.ws + OFF_WSB) + (size_t)h * 16384;
    { const int j = tid >> 2, dc = (tid & 3) * 32; float s = 0.f;
#pragma unroll
      for (int q = 0; q < 4; ++q)
#pragma unroll
          for (int w = 0; w < 4; ++w) { const float lo = bflo(r.v[q][w]), hi = bfhi(r.v[q][w]); s += lo * lo + hi * hi; }
      s += __shfl_xor(s, 1); s += __shfl_xor(s, 2);
      const float rs = rsqrtf(s * (1.f / 128.f) + EPS);
#pragma unroll
      for (int q = 0; q < 4; ++q)
#pragma unroll
          for (int w = 0; w < 4; ++w) { const int d = dc + q * 8 + w * 2; const unsigned pk = cvt_pk_bf16(bflo(r.v[q][w]) * rs, bfhi(r.v[q][w]) * rs);
              Vt[d * 136 + j] = (bf16_t)(pk & 0xffffu); Vt[(d + 1) * 136 + j] = (bf16_t)(pk >> 16); } }
    const int i = 16 * wid + fr, t = t0 + i; const float bias = p.gmlp_bs[h * 128 + i];
    u32x2 uu[8];
#pragma unroll
    for (int n = 0; n < 8; ++n) uu[n] = *(const u32x2*)(P + (size_t)t * DP + h * 128 + 16 * n + 4 * fq);
    const int ksteps = (wid < 4) ? 2 : 4;
    bf16x8 bw[4];
#pragma unroll
    for (int ks = 0; ks < 4; ++ks) bw[ks] = *(const bf16x8*)(wsb + (16 * wid + fr) * 128 + ks * 32 + fq * 8);
    __syncthreads();
    f32x4 acc[8];
#pragma unroll
    for (int n = 0; n < 8; ++n) acc[n] = (f32x4){0.f, 0.f, 0.f, 0.f};
#pragma unroll
    for (int ks = 0; ks < 4; ++ks) { if (ks < ksteps) {
#pragma unroll
        for (int n = 0; n < 8; ++n) { const bf16x8 av = *(const bf16x8*)(Vt + (16 * n + fr) * 136 + ks * 32 + fq * 8);
            acc[n] = __builtin_amdgcn_mfma_f32_16x16x32_bf16(av, bw[ks], acc[n], 0, 0, 0); } } }
    float ss = 0.f;
#pragma unroll
    for (int n = 0; n < 8; ++n) { const int c = h * 128 + 16 * n + 4 * fq;
        const f32x4 g = *(const f32x4*)(p.v_norm_g + c);
        const float y0 = bflo(uu[n].x) * (acc[n][0] * g[0] + bias), y1 = bfhi(uu[n].x) * (acc[n][1] * g[1] + bias), y2 = bflo(uu[n].y) * (acc[n][2] * g[2] + bias), y3 = bfhi(uu[n].y) * (acc[n][3] * g[3] + bias);
        ss += (y0 * y0 + y1 * y1) + (y2 * y2 + y3 * y3);
        u32x2 w; w.x = cvt_pk_bf16(y0, y1); w.y = cvt_pk_bf16(y2, y3); *(u32x2*)(Y + (size_t)t * D_ + c) = w; }
    ss += __shfl_xor(ss, 16); ss += __shfl_xor(ss, 32);
    if (fq == 0) atomicAdd(ssq_a + t, ss);
}
__device__ __forceinline__ void mixer_conv_item(const Params& p, int item, size_t so) {
    const int tid = opaque_tid(), cl = tid & 31, ts = tid >> 5;
    const int c = (item & 3) * 256 + cl * 8, tbeg = (item >> 2) * 128 + ts * 8;
    const bf16_t* P = (const bf16_t*)(p.ws + OFF_A); bf16_t* Y = (bf16_t*)(p.ws + OFF_B); float* ssq_b = (float*)(p.ws + OFF_SSQ + so) + T_;
    float w0[8], w1[8], w2[8], z1[8], z2[8];
    { const f32x4 a0 = *(const f32x4*)(p.conv_w + c), a1 = *(const f32x4*)(p.conv_w + c + 4), b0 = *(const f32x4*)(p.conv_w + 1024 + c), b1 = *(const f32x4*)(p.conv_w + 1024 + c + 4),
                  c0 = *(const f32x4*)(p.conv_w + 2048 + c), c1 = *(const f32x4*)(p.conv_w + 2048 + c + 4);
#pragma unroll
      for (int q = 0; q < 4; ++q) { w0[q] = a0[q]; w0[4 + q] = a1[q]; w1[q] = b0[q]; w1[4 + q] = b1[q]; w2[q] = c0[q]; w2[4 + q] = c1[q]; } }
#pragma unroll
    for (int q = 0; q < 8; ++q) { z1[q] = 0.f; z2[q] = 0.f; }
    if ((tbeg % SEQ) != 0) {
        const u32x4 za = *(const u32x4*)(P + (size_t)(tbeg - 1) * DP + 3072 + c), zb = *(const u32x4*)(P + (size_t)(tbeg - 2) * DP + 3072 + c);
#pragma unroll
        for (int q = 0; q < 4; ++q) { z1[2 * q] = bflo(za[q]); z1[2 * q + 1] = bfhi(za[q]); z2[2 * q] = bflo(zb[q]); z2[2 * q + 1] = bfhi(zb[q]); }
    }
    u32x4 bgA[8], zA[8];
#pragma unroll
    for (int tt = 0; tt < 8; ++tt) { const bf16_t* pr = P + (size_t)(tbeg + tt) * DP + c; bgA[tt] = *(const u32x4*)(pr + 2048); zA[tt] = *(const u32x4*)(pr + 3072); }
#pragma unroll
    for (int tt = 0; tt < 8; ++tt) {
        const int t = tbeg + tt;
        const u32x4 bg = bgA[tt], zv = zA[tt];
        float z[8], y[8], ss = 0.f;
#pragma unroll
        for (int q = 0; q < 4; ++q) { z[2 * q] = bflo(zv[q]); z[2 * q + 1] = bfhi(zv[q]); }
#pragma unroll
        for (int q = 0; q < 4; ++q) {
            y[2 * q] = bflo(bg[q]) * (w0[2 * q] * z2[2 * q] + w1[2 * q] * z1[2 * q] + w2[2 * q] * z[2 * q]);
            y[2 * q + 1] = bfhi(bg[q]) * (w0[2 * q + 1] * z2[2 * q + 1] + w1[2 * q + 1] * z1[2 * q + 1] + w2[2 * q + 1] * z[2 * q + 1]); }
#pragma unroll
        for (int q = 0; q < 8; ++q) { ss += y[q] * y[q]; z2[q] = z1[q]; z1[q] = z[q]; }
        u32x4 w; w.x = cvt_pk_bf16(y[0], y[1]); w.y = cvt_pk_bf16(y[2], y[3]); w.z = cvt_pk_bf16(y[4], y[5]); w.w = cvt_pk_bf16(y[6], y[7]);
        *(u32x4*)(Y + (size_t)t * D_ + 1024 + c) = w;
        ss += __shfl_xor(ss, 1); ss += __shfl_xor(ss, 2); ss += __shfl_xor(ss, 4); ss += __shfl_xor(ss, 8); ss += __shfl_xor(ss, 16);
        if (cl == 0) atomicAdd(ssq_b + t, ss);
    }
}
__device__ __forceinline__ void phase2(const Params& p, unsigned char* lds, size_t so = 0) {
    const int nb = gridDim.x, bid = blockIdx.x, tid = opaque_tid();
    for (int it = bid; it < 512; it += nb) mixer_conv_item(p, it, so);
    bf16_t* Vt0 = (bf16_t*)lds; bf16_t* Vt1 = Vt0 + 128 * 136;
    VRegs ra, rb; int it = bid; bool ha = it < 1024, hb_ = it + nb < 1024;
    if (ha) gmlp_load_v(p, it, tid, ra);
    while (ha) {
        if (hb_) gmlp_load_v(p, it + nb, tid, rb);
        mixer_gmlp_item(p, Vt0, it, ra, so);
        if (!hb_) break;
        it += 2 * nb; ha = it < 1024;
        if (ha) gmlp_load_v(p, it, tid, ra);
        mixer_gmlp_item(p, Vt1, it - nb, rb, so);
        hb_ = it + nb < 1024;
    }
    __syncthreads();
}

__device__ __forceinline__ void phase3(const Params& p, unsigned char* lds, size_t so = 0) {
    pg8::StaticOrder S; S.init(T_, D_, gridDim.x, blockIdx.x); const pg8::AOffDirect AO{D_};
    PG8_LAS float* rsl = (PG8_LAS float*)((PG8_LAS unsigned char*)lds + RS_OFF);
    { const float* ssq = (const float*)(p.ws + OFF_SSQ); const int tid = opaque_tid();
      for (int i = 0; i < RS_UNITS; ++i) { Unit u; if (!S.next(i, u)) break;
          if (tid < 256) { const int row = u.pm * 256 + tid; const float va = ssq[row] * (1.f / 1024.f) + EPS, vb = ssq[T_ + row] * (1.f / 1024.f) + EPS;
              rsl[(i * 256 + tid) * 2] = __builtin_amdgcn_sqrtf(vb * __builtin_amdgcn_rcpf(va)); rsl[(i * 256 + tid) * 2 + 1] = __builtin_amdgcn_rsqf(vb); } }
      __syncthreads(); }
    const Epi2 E{p.x, p.ws, so, rsl};
    const int kr = side_rounds(gridDim.x), k0 = kr / 2; const bool side = (so == 0);
    const int col = blockIdx.x & 1, km = col ? kr : k0;
    if (side) run_tjobs(p, lds, N_TJOBS_IN, N_TJOBS_GU, k0, km);
    pg8::gemm_phase<Epi2, pg8::StaticOrder, pg8::AOffDirect, true>((PG8_LAS unsigned char*)lds, (const bf16_t*)(p.ws + OFF_B), (const bf16_t*)(p.ws + OFF_WOUT), D_, S, AO, E);
    if (side) run_tjobs(p, lds, N_TJOBS_IN, N_TJOBS_GU, km, kr);
}

__device__ __forceinline__ void route_item(const Params& p, unsigned char* lds, int item, size_t so) {
    const int tid = opaque_tid(), wid = tid >> 6, lane = tid & 63, fr = lane & 15, fq = lane >> 4;
    float* lg = (float*)lds;
    float* ls = lg + 8 * 64 * 48;
    int* lcnt = (int*)(ls + 64 * 48); int* lbase = lcnt + 32;
    const bf16_t* hb = (const bf16_t*)(p.ws + OFF_HB); const bf16_t* wrt = (const bf16_t*)(p.ws + OFF_WR);
    const float* ssq_h = (const float*)(p.ws + OFF_SSQ) + 2 * T_;
    int* cnt = (int*)(p.ws + OFF_CNT + so); int* rinfo = (int*)(p.ws + OFF_RINFO + so); float* rw = (float*)(p.ws + OFF_RW + so);
    const int t0 = item * 64;
    if (tid < 32) lcnt[tid] = 0;
    f32x4 acc[4][3];
#pragma unroll
    for (int m = 0; m < 4; ++m)
#pragma unroll
        for (int n = 0; n < 3; ++n) acc[m][n] = (f32x4){0.f, 0.f, 0.f, 0.f};
    const bf16_t* ap = hb + (size_t)(t0 + fr) * D_ + wid * 256 + fq * 8; const bf16_t* bp = wrt + (size_t)fr * D_ + wid * 256 + fq * 8;
#pragma unroll 4
    for (int ks = 0; ks < 8; ++ks) {
        bf16x8 a[4], b[3];
#pragma unroll
        for (int m = 0; m < 4; ++m) a[m] = *(const bf16x8*)(ap + (size_t)m * 16 * D_ + ks * 32);
#pragma unroll
        for (int n = 0; n < 3; ++n) b[n] = *(const bf16x8*)(bp + (size_t)n * 16 * D_ + ks * 32);
#pragma unroll
        for (int m = 0; m < 4; ++m)
#pragma unroll
            for (int n = 0; n < 3; ++n) acc[m][n] = __builtin_amdgcn_mfma_f32_16x16x32_bf16(a[m], b[n], acc[m][n], 0, 0, 0);
    }
#pragma unroll
    for (int m = 0; m < 4; ++m)
#pragma unroll
        for (int n = 0; n < 3; ++n)
#pragma unroll
            for (int j = 0; j < 4; ++j) lg[(wid * 64 + m * 16 + 4 * fq + j) * 48 + 16 * n + fr] = acc[m][n][j];
    __syncthreads();
    for (int i = tid; i < 64 * 48; i += NTHR) { float v = 0.f;
#pragma unroll
        for (int w = 0; w < 8; ++w) v += lg[w * 64 * 48 + i];
        ls[i] = v; }
    __syncthreads();
    int e0 = 0, e1 = 0, r0 = 0, r1 = 0; float g0 = 0.f, g1 = 0.f, rsc = 0.f; const int t = t0 + tid;
    if (tid < 64) {
        const float* l0 = ls + tid * 48; const float rstd = rsqrtf(ssq_h[t] * (1.f / D_) + EPS); rsc = rstd * (1.f / WGU_SCALE);
        float gm = -3.0e38f; int gi = 0; float gl[4];
#pragma unroll
        for (int o = 0; o < 4; ++o) { gl[o] = l0[o] * rstd + p.rgb[o]; if (gl[o] > gm) { gm = gl[o]; gi = o; } }
        float gs = 0.f;
#pragma unroll
        for (int o = 0; o < 4; ++o) gs += __expf(gl[o] - gm);
        const float pg = 1.f / gs;
        float b1 = -3.0e38f, b2 = -3.0e38f; int i1 = 0, i2 = 0;
        for (int q = 0; q < 8; ++q) { const float v = l0[4 + gi * 8 + q] * rstd + p.reb[gi * 8 + q];
            if (v > b1) { b2 = b1; i2 = i1; b1 = v; i1 = q; } else if (v > b2) { b2 = v; i2 = q; } }
        const float wa = 1.f / (1.f + __expf(b2 - b1));
        e0 = gi * 8 + i1; e1 = gi * 8 + i2; g0 = pg * wa; g1 = pg * (1.f - wa);
        r0 = atomicAdd(&lcnt[e0], 1); r1 = atomicAdd(&lcnt[e1], 1);
    }
    __syncthreads();
    if (tid < 32) lbase[tid] = atomicAdd(cnt + tid, lcnt[tid]);
    __syncthreads();
    if (tid < 64) { const int i0 = lbase[e0] + r0, i1 = lbase[e1] + r1;
        rinfo[e0 * LCAP + i0] = (int)((cvt_pk_bf16(g0, 0.f) << 16) | (unsigned)(2 * t)); rinfo[e1 * LCAP + i1] = (int)((cvt_pk_bf16(g1, 0.f) << 16) | (unsigned)(2 * t + 1));
        rw[e0 * LCAP + i0] = rsc; rw[e1 * LCAP + i1] = rsc; }
    __syncthreads();
}
__device__ __forceinline__ void phase4(const Params& p, unsigned char* lds, size_t so = 0) { for (int it = blockIdx.x; it < T_ / 64; it += gridDim.x) route_item(p, lds, it, so); }

__device__ __forceinline__ int moe_slot() { const int G = gridDim.x, c = blockIdx.x; return (G & 7) ? c : (c & 7) * (G >> 3) + (c >> 3); }
__device__ __forceinline__ PG8_LAS int* moe_tables_to_lds(const Params& p, unsigned char* lds, bool build) {
    PG8_LAS int* tb = (PG8_LAS int*)((PG8_LAS unsigned char*)lds + LCNT_OFF); const int* cnt = (const int*)(p.ws + OFF_CNT);
    if (!build) return tb;
    if (threadIdx.x < 64) {
        const int e = threadIdx.x, c = (e < NE) ? __hip_atomic_load(cnt + e, __ATOMIC_RELAXED, __HIP_MEMORY_SCOPE_AGENT) : 0, nt = (c + 255) >> 8;
        int inc = nt;
#pragma unroll
        for (int o = 1; o < 64; o <<= 1) { const int v = __shfl_up(inc, o); if (e >= o) inc += v; }
        const int pst = inc - nt;
        if (e < NE) { tb[MT_CNT + e] = c; tb[MT_PST + e] = pst;
#pragma clang loop unroll(disable)
            for (int i = 0; i < nt; ++i) tb[MT_T2E + pst + i] = e; }
        if (e == NE) { tb[MT_PST + NE] = pst; tb[MT_NT] = pst; }
    }
    __syncthreads();
    return tb;
}
__device__ __forceinline__ void phase5(const Params& p, unsigned char* lds) {
    PG8_LAS int* lc = moe_tables_to_lds(p, lds, true);
    const Epi5 E{p.ws, lc};
    const int cx = moe_slot();
    const pg8::MoeOrder S{lc, 4, (int)gridDim.x, cx}; const pg8::AOffGather AO{p.ws, lc, D_ / 2};
    pg8::gemm_phase<Epi5, pg8::MoeOrder, pg8::AOffGather, true, 1>((PG8_LAS unsigned char*)lds, (const bf16_t*)(p.ws + OFF_H8), (const bf16_t*)(p.ws + OFF_WGU), D_ / 2, S, AO, E);
    { const int G = gridDim.x, c = cx, U = 4 * __builtin_amdgcn_readfirstlane(lc[MT_NT]), rem = U % G, idle = G - rem, NJ = N_TJOBS - N_TJOBS_GU;
      const int per = rem == 0 ? 0 : min(32, (NJ + idle - 1) / idle), early = min(NJ, idle * per);
      if (rem != 0 && c >= rem) run_tjobs(p, lds, N_TJOBS_GU, N_TJOBS_GU + early, 0, per, c - rem, idle);
      if (early < NJ) run_tjobs(p, lds, N_TJOBS_GU + early, N_TJOBS, 0, 1 << 20, c, G); }
}
__device__ __forceinline__ void phase6(const Params& p, unsigned char* lds) {
    PG8_LAS int* lc = moe_tables_to_lds(p, lds, DUP_PHASE == 6);
    const Epi6 E{p.ws, lc};
    const pg8::MoeOrder S{lc, 8, (int)gridDim.x, moe_slot()}; const pg8::AOffDirect AO{DE / 2};
    pg8::gemm_phase<Epi6, pg8::MoeOrder, pg8::AOffDirect, true, 1>((PG8_LAS unsigned char*)lds, (const bf16_t*)(p.ws + OFF_B), (const bf16_t*)(p.ws + OFF_WD), DE / 2, S, AO, E);
}
__device__ __forceinline__ void phase7(const Params& p) {
    const int tid = opaque_tid(), wid = tid >> 6, lane = tid & 63;
    const bf16_t* hb = (const bf16_t*)(p.ws + OFF_HB); const unsigned char* ys2 = p.ws + OFF_A;
    for (int t = blockIdx.x * 8 + wid; t < T_; t += gridDim.x * 8) {
        float v[4][8]; float s = 0.f;
#pragma unroll
        for (int i = 0; i < 4; ++i) { const int c = i * 512 + lane * 8;
            const u32x4 a = *(const u32x4*)(hb + (size_t)t * D_ + c); const u32x2 b = *(const u32x2*)(ys2 + (size_t)(2 * t) * D_ + c), d = *(const u32x2*)(ys2 + (size_t)(2 * t + 1) * D_ + c);
            float y0[8], y1[8];
            up4_fp8(b.x, y0[0], y0[1], y0[2], y0[3]); up4_fp8(b.y, y0[4], y0[5], y0[6], y0[7]); up4_fp8(d.x, y1[0], y1[1], y1[2], y1[3]); up4_fp8(d.y, y1[4], y1[5], y1[6], y1[7]);
#pragma unroll
            for (int q = 0; q < 4; ++q) { v[i][2 * q] = bflo(a[q]) + (y0[2 * q] + y1[2 * q]) * (1.f / YS_SCALE); v[i][2 * q + 1] = bfhi(a[q]) + (y0[2 * q + 1] + y1[2 * q + 1]) * (1.f / YS_SCALE);
                s += v[i][2 * q] * v[i][2 * q] + v[i][2 * q + 1] * v[i][2 * q + 1]; } }
        const float rstd = rsqrtf(wave_sum(s) * (1.f / D_) + EPS);
#pragma unroll
        for (int i = 0; i < 4; ++i) { const int c = i * 512 + lane * 8;
            const f32x4 g0 = *(const f32x4*)(p.g_final + c), g1 = *(const f32x4*)(p.g_final + c + 4);
            f32x4 o0, o1;
#pragma unroll
            for (int q = 0; q < 4; ++q) { o0[q] = v[i][q] * rstd * g0[q]; o1[q] = v[i][4 + q] * rstd * g1[q]; }
            *(f32x4*)(p.out + (size_t)t * D_ + c) = o0; *(f32x4*)(p.out + (size_t)t * D_ + c + 4) = o1; }
    }
}

__global__ void __launch_bounds__(NTHR, 2) k_mega(Params p) {
    extern __shared__ __attribute__((aligned(16))) unsigned char lds[];
    cg::grid_group grid = cg::this_grid();
    volatile PG8_LAS unsigned* bst = (volatile PG8_LAS unsigned*)((PG8_LAS unsigned char*)lds + LBAR_OFF);
    if (threadIdx.x < 2) bst[threadIdx.x] = 0u;
    __syncthreads();
    (void)xcd_barrier_post((unsigned*)(p.ws + OFF_BAR), bst);
#define GRID_BAR() do { XcdBarrier b_; b_.bar = (unsigned*)(opaque_ws(p.ws) + OFF_BAR); b_.x = xb_xcc_id(); b_.st = bst; xcd_barrier(b_); } while (0)
    if (DUP_PHASE == 0) { phase0(p, lds); GRID_BAR(); phase0b(p, lds); GRID_BAR(); }
    if (p.ws == nullptr) grid.sync();
    phase0(p, lds); GRID_BAR();
    phase0b(p, lds); GRID_BAR();
    if (DUP_PHASE == 1) { phase1(p, lds); GRID_BAR(); }
    phase1(p, lds); GRID_BAR();
    if (DUP_PHASE == 2) { phase2(p, lds, OFF_DUMMY - OFF_SSQ); GRID_BAR(); }
    phase2(p, lds); GRID_BAR();
    if (DUP_PHASE == 3) { phase3(p, lds, OFF_DUMMY - OFF_SSQ); GRID_BAR(); }
    phase3(p, lds); GRID_BAR();
    if (DUP_PHASE == 4) { phase4(p, lds, OFF_DUMMY - OFF_SSQ); GRID_BAR(); }
    phase4(p, lds); GRID_BAR();
    if (DUP_PHASE == 5) { phase5(p, lds); GRID_BAR(); }
    phase5(p, lds); GRID_BAR();
    if (DUP_PHASE == 6) { phase6(p, lds); GRID_BAR(); }
    phase6(p, lds); GRID_BAR();
    if (DUP_PHASE == 8) { for (int i = 0; i < 10; ++i) GRID_BAR(); }
    if (DUP_PHASE == 9) { grid.sync(); grid.sync(); }
    if (DUP_PHASE == 7) { phase7(p); GRID_BAR(); }
    phase7(p);
}

extern "C" void kernel_launch(void* const* d_in, const int* in_sizes, int n_in, void* d_out, int out_size, void* d_ws, size_t ws_size, hipStream_t stream) {
    static int grid = 0;
    if (grid == 0) {
        if (n_in != 19 || in_sizes[0] != T_ * D_ || out_size != T_ * D_ || ws_size < WS_END + (DUP_PHASE >= 2 && DUP_PHASE <= 4 ? DUMMY_BYTES : 0)) { fprintf(stderr, "kernel_launch: unexpected shapes (n_in %d, in0 %d, out %d, ws %zu < %zu); nothing launched\n", n_in, n_in > 0 ? in_sizes[0] : -1, out_size, ws_size, (size_t)WS_END); grid = -1; return; }
        int dev = 0, cus = 0, per_cu = 0;
        if (hipGetDevice(&dev) != hipSuccess || hipDeviceGetAttribute(&cus, hipDeviceAttributeMultiprocessorCount, dev) != hipSuccess) { grid = -1; return; }
        if (hipFuncSetAttribute((const void*)k_mega, hipFuncAttributeMaxDynamicSharedMemorySize, LDS_BYTES) != hipSuccess) { fprintf(stderr, "kernel_launch: hipFuncSetAttribute failed\n"); grid = -1; return; }
        if (hipOccupancyMaxActiveBlocksPerMultiprocessor(&per_cu, (const void*)k_mega, NTHR, LDS_BYTES) != hipSuccess || per_cu < 1) { fprintf(stderr, "kernel_launch: occupancy query says %d blocks per CU\n", per_cu); grid = -1; return; }
        grid = cus * per_cu;
    }
    if (grid < 0) return;
    Params p{};
    const float** f = (const float**)&p;
    for (int i = 0; i < 19; ++i) f[i] = (const float*)d_in[i];
    p.out = (float*)d_out; p.ws = (unsigned char*)d_ws;
    if (hipMemsetAsync((unsigned char*)d_ws + OFF_BAR, 0, BAR_BYTES, stream) != hipSuccess) { fprintf(stderr, "kernel_launch: memset of the barrier words failed\n"); return; }
    void* args[] = {&p};
    const hipError_t e = hipLaunchCooperativeKernel((const void*)k_mega, dim3(grid), dim3(NTHR), args, LDS_BYTES, stream);
    if (e != hipSuccess) fprintf(stderr, "kernel_launch: cooperative launch failed: %s (grid %d)\n", hipGetErrorString(e), grid);
}
```

```cpp
#include <hip/hip_runtime.h>
#include <hip/hip_cooperative_groups.h>
#include <cstdio>
namespace cg = cooperative_groups;

typedef unsigned short bf16_t;
typedef float f32x4 __attribute__((ext_vector_type(4)));
typedef unsigned u32x4 __attribute__((ext_vector_type(4)));
typedef unsigned u32x2 __attribute__((ext_vector_type(2)));
typedef short bf16x8 __attribute__((ext_vector_type(8)));
typedef int v4i __attribute__((ext_vector_type(4)));
typedef int v8i __attribute__((ext_vector_type(8)));

constexpr int T_ = 16384, D_ = 2048, DIN = 5120, DP = 4096, NE = 32, DE = 512, SEQ = 4096, LCAP = 16384;
constexpr float EPS = 1e-6f;
#ifndef DUP_PHASE
#define DUP_PHASE -1
#endif
constexpr int NTHR = 512;
constexpr int LDS_BYTES = 163840;
constexpr int LCNT_OFF = 131072, LBAR_OFF = 131072 + 2048, XS_OFF = 131072 + 4096, XM_OFF = XS_OFF + 8192, RS_OFF = XM_OFF;
constexpr int RS_UNITS = 4;
static_assert(XM_OFF + 512 * 32 <= LDS_BYTES && RS_UNITS * 256 * 8 <= 512 * 32, "LDS map");

constexpr size_t SZ_A = (size_t)T_ * DIN * 2;
constexpr size_t SZ_B = (size_t)T_ * D_ * 2;
constexpr size_t OFF_A = 0;
constexpr size_t OFF_B = OFF_A + SZ_A;
constexpr size_t OFF_HB = OFF_B + SZ_B;
constexpr size_t OFF_H8 = OFF_A + (size_t)2 * T_ * D_ * 2;
constexpr float WGU_SCALE = 32.f, WD_SCALE = 16.f, YS_SCALE = 16.f;
constexpr size_t OFF_WIN = OFF_HB + SZ_B;
constexpr size_t OFF_WOUT = OFF_WIN + (size_t)DIN * D_ * 2;
constexpr size_t OFF_WGU = OFF_WOUT + (size_t)D_ * D_ * 2;
constexpr size_t OFF_WD = OFF_WGU + (size_t)NE * 1024 * D_ * 2;
constexpr size_t OFF_WR = OFF_WD + (size_t)NE * D_ * DE * 2;
constexpr size_t OFF_WSB = OFF_WR + (size_t)48 * D_ * 2;
constexpr size_t OFF_SSQ = OFF_WSB + (size_t)8 * 128 * 128 * 2;
constexpr size_t OFF_CNT = OFF_SSQ + (size_t)3 * T_ * 4;
constexpr size_t OFF_RINFO = OFF_CNT + 256;
constexpr size_t OFF_RW = OFF_RINFO + (size_t)NE * LCAP * 4;
constexpr size_t OFF_BAR = OFF_RW + (size_t)NE * LCAP * 4;
constexpr size_t BAR_BYTES = 49152;
constexpr size_t OFF_CMAX = OFF_BAR + 16384;
constexpr size_t OFF_SX = OFF_BAR + BAR_BYTES;
constexpr size_t OFF_SW = OFF_SX + (size_t)T_ * 4;
constexpr size_t WS_END = OFF_SW + 32768;
constexpr size_t OFF_DUMMY = WS_END;
constexpr size_t DUMMY_BYTES = (OFF_BAR - OFF_SSQ);

struct Params {
    const float *x, *norm_mix_g, *w_in, *v_norm_g, *gmlp_ws, *gmlp_bs, *conv_w, *g_a, *g_b, *w_out, *g_ffn, *rgw, *rgb, *rew, *reb, *ewg, *ewu, *ewd, *g_final;
    float* out; unsigned char* ws;
};

__device__ __forceinline__ unsigned cvt_pk_bf16(float lo, float hi) { unsigned r; asm volatile("v_cvt_pk_bf16_f32 %0, %1, %2" : "=v"(r) : "v"(lo), "v"(hi)); return r; }
#define GAS __attribute__((address_space(1)))
typedef GAS unsigned char gbyte;
__device__ __forceinline__ gbyte* opaque_ws(unsigned char* w) { gbyte* g = (gbyte*)w; asm volatile("" : "+s"(g)); return g; }
__device__ __forceinline__ int opaque_tid() { int t = threadIdx.x; asm volatile("" : "+v"(t)); return t; }
__device__ __forceinline__ unsigned pk4_fp8(float a, float b, float c, float d) { int w = 0; w = __builtin_amdgcn_cvt_pk_fp8_f32(a, b, w, false); w = __builtin_amdgcn_cvt_pk_fp8_f32(c, d, w, true); return (unsigned)w; }
__device__ __forceinline__ void up4_fp8(unsigned w, float& a, float& b, float& c, float& d) {
    const auto lo = __builtin_amdgcn_cvt_pk_f32_fp8((int)w, false), hi = __builtin_amdgcn_cvt_pk_f32_fp8((int)w, true); a = lo[0]; b = lo[1]; c = hi[0]; d = hi[1]; }
__device__ __forceinline__ float bflo(unsigned w) { return __uint_as_float(w << 16); }
__device__ __forceinline__ float bfhi(unsigned w) { return __uint_as_float(w & 0xffff0000u); }
__device__ __forceinline__ float wave_sum(float v) {
#pragma unroll
    for (int o = 1; o < 64; o <<= 1) v += __shfl_xor(v, o);
    return v;
}
__device__ __forceinline__ float gelu_t(float x) {
    const float u = x * (0.7978845608f + 0.0356774081f * x * x);
    return x * __builtin_amdgcn_rcpf(1.f + __builtin_amdgcn_exp2f(-2.885390082f * u));
}
__device__ __forceinline__ f32x4 gelu_t4(f32x4 x) {
    const f32x4 u = x * (x * x * (-2.885390082f * 0.0356774081f) + (-2.885390082f * 0.7978845608f));
    f32x4 d;
#pragma unroll
    for (int j = 0; j < 4; ++j) d[j] = __builtin_amdgcn_exp2f(u[j]);
    d = d + 1.f;
#pragma unroll
    for (int j = 0; j < 4; ++j) d[j] = __builtin_amdgcn_rcpf(d[j]);
    return x * d;
}
__device__ __forceinline__ float silu_f(float x) { return x * __builtin_amdgcn_rcpf(1.f + __builtin_amdgcn_exp2f(-1.442695041f * x)); }

#define PG8_LAS __attribute__((address_space(3)))
struct Unit { int pm, pn, e, r0, pnl; };

constexpr int MT_CNT = 0, MT_PST = 32, MT_NT = 65, MT_T2E = 66, MT_WORDS = 66 + 192;
typedef const PG8_LAS int* lcnt_t;
__device__ __forceinline__ bool moe_unit(lcnt_t tb, int NT, int L, Unit& u) {
    const int pt = L / NT;
    if (pt >= __builtin_amdgcn_readfirstlane(tb[MT_NT])) return false;
    const int e = __builtin_amdgcn_readfirstlane(tb[MT_T2E + pt]), mt = pt - __builtin_amdgcn_readfirstlane(tb[MT_PST + e]), j = L - pt * NT;
    u.e = e; u.pm = pt; u.r0 = mt * 256; u.pnl = j; u.pn = e * NT + j; return true;
}

struct NoMeta {};
struct Meta8 { u32x4 lo, hi; };
struct Epi1 {
    static constexpr bool PERM = true, PERM2 = false, MIDSCALE = false;
    typedef Meta8 Meta;
    unsigned char* ws;
    __device__ __forceinline__ Meta meta_load(const Unit& u, int wr, int fr) const {
        const GAS unsigned* sx = (const GAS unsigned*)(opaque_ws(ws) + OFF_SX) + u.pm * 256 + wr * 64 + fr; Meta mt;
#pragma unroll
        for (int q = 0; q < 4; ++q) { mt.lo[q] = sx[q * 16]; mt.hi[q] = sx[128 + q * 16]; }
        return mt;
    }
    __device__ __forceinline__ void operator()(f32x4 (&acc)[2][2][4][2], const Unit& u, int wr, int wc, int fr, int fq, const Meta& mt) const {
        gbyte* w_ = opaque_ws(ws);
        GAS bf16_t* P = (GAS bf16_t*)(w_ + OFF_A);
        const GAS float* sw = (const GAS float*)(w_ + OFF_SW) + u.pn * 256 + wc * 32 + 8 * fq;
        f32x4 cs[2][2];
#pragma unroll
        for (int bj = 0; bj < 2; ++bj) { cs[bj][0] = *(const GAS f32x4*)(sw + bj * 128); cs[bj][1] = *(const GAS f32x4*)(sw + bj * 128 + 4); }
        if (u.pn >= 12) {
#pragma unroll
            for (int ai = 0; ai < 2; ++ai)
#pragma unroll
                for (int m = 0; m < 4; ++m) {
                    const int row = u.pm * 256 + ai * 128 + wr * 64 + m * 16 + fr; const float rs = __uint_as_float(ai ? mt.hi[m] : mt.lo[m]);
                    GAS bf16_t* rowp = P + (size_t)row * DP + 3072 + (u.pn - 12) * 128 + wc * 16 + 4 * fq;
#pragma unroll
                    for (int bj = 0; bj < 2; ++bj) { const f32x4 z = (acc[ai][bj][m][0] * cs[bj][0]) * (acc[ai][bj][m][1] * cs[bj][1]) * (rs * rs);
                        u32x2 w; w.x = cvt_pk_bf16(z[0], z[1]); w.y = cvt_pk_bf16(z[2], z[3]); *(GAS u32x2*)(rowp + bj * 64) = w; }
                }
            return;
        }
        const bool act = u.pn < 8;
#pragma unroll
        for (int ai = 0; ai < 2; ++ai)
#pragma unroll
            for (int m = 0; m < 4; ++m) {
                const int row = u.pm * 256 + ai * 128 + wr * 64 + m * 16 + fr; const float rs = __uint_as_float(ai ? mt.hi[m] : mt.lo[m]);
                GAS bf16_t* rowp = P + (size_t)row * DP + u.pn * 256 + wc * 32 + 8 * fq;
#pragma unroll
                for (int bj = 0; bj < 2; ++bj) {
                    f32x4 v0 = acc[ai][bj][m][0] * cs[bj][0] * rs, v1 = acc[ai][bj][m][1] * cs[bj][1] * rs;
                    if (act) { v0 = gelu_t4(v0); v1 = gelu_t4(v1); }
                    u32x4 w; w.x = cvt_pk_bf16(v0[0], v0[1]); w.y = cvt_pk_bf16(v0[2], v0[3]); w.z = cvt_pk_bf16(v1[0], v1[1]); w.w = cvt_pk_bf16(v1[2], v1[3]);
                    *(GAS u32x4*)(rowp + bj * 128) = w;
                }
            }
    }
};
struct Epi2 {
    static constexpr bool PERM = true, PERM2 = false, MIDSCALE = true;
    const float* x; unsigned char* ws; size_t so;
    const PG8_LAS float* rsl;
    __device__ __forceinline__ void midscale(f32x4 (&acc)[2][2][4][2], const Unit& u, int wr, int wc, int fr, int fq) const {
        const PG8_LAS float* pr = rsl + (u.e * 256 + wr * 64 + fr) * 2;
#pragma unroll
        for (int ai = 0; ai < 2; ++ai)
#pragma unroll
            for (int m = 0; m < 4; ++m) {
                const float s = pr[(ai * 128 + m * 16) * 2];
#pragma unroll
                for (int bj = 0; bj < 2; ++bj)
#pragma unroll
                    for (int n = 0; n < 2; ++n) acc[ai][bj][m][n] *= s;
            }
    }
    typedef NoMeta Meta;
    __device__ __forceinline__ Meta meta_load(const Unit&, int, int) const { return Meta{}; }
    __device__ __forceinline__ void operator()(f32x4 (&acc)[2][2][4][2], const Unit& u, int wr, int wc, int fr, int fq, const Meta&) const {
        gbyte* w_ = opaque_ws(ws);
        GAS bf16_t* hb = (GAS bf16_t*)(w_ + OFF_HB); gbyte* h8 = w_ + OFF_H8; float* ssq_h = (float*)(ws + OFF_SSQ + so) + 2 * T_;
#pragma unroll
        for (int ai = 0; ai < 2; ++ai)
#pragma unroll
            for (int m = 0; m < 4; ++m) {
                const int row = u.pm * 256 + ai * 128 + wr * 64 + m * 16 + fr;
                const float rb = rsl[(u.e * 256 + ai * 128 + wr * 64 + m * 16 + fr) * 2 + 1];
                const size_t off = (size_t)row * D_ + u.pn * 256 + wc * 32 + 8 * fq;
                float ss = 0.f;
#pragma unroll
                for (int bj = 0; bj < 2; ++bj) {
                    const f32x4 x0 = *(const f32x4*)(x + off + bj * 128), x1 = *(const f32x4*)(x + off + bj * 128 + 4);
                    const f32x4 h0 = x0 + acc[ai][bj][m][0] * rb, h1 = x1 + acc[ai][bj][m][1] * rb;
                    ss += (h0[0] * h0[0] + h0[1] * h0[1]) + (h0[2] * h0[2] + h0[3] * h0[3]) + (h1[0] * h1[0] + h1[1] * h1[1]) + (h1[2] * h1[2] + h1[3] * h1[3]);
                    u32x4 w; w.x = cvt_pk_bf16(h0[0], h0[1]); w.y = cvt_pk_bf16(h0[2], h0[3]); w.z = cvt_pk_bf16(h1[0], h1[1]); w.w = cvt_pk_bf16(h1[2], h1[3]);
                    *(GAS u32x4*)(hb + off + bj * 128) = w;
                    u32x2 w8; w8.x = pk4_fp8(h0[0], h0[1], h0[2], h0[3]); w8.y = pk4_fp8(h1[0], h1[1], h1[2], h1[3]);
                    *(GAS u32x2*)(h8 + off + bj * 128) = w8;
                }
                ss += __shfl_xor(ss, 16); ss += __shfl_xor(ss, 32);
                if (fq == 0) atomicAdd(ssq_h + row, ss);
                if (m == 3) asm volatile("" ::: "memory");
            }
    }
};
struct Epi5 {
    static constexpr bool PERM = true, PERM2 = false, MIDSCALE = false;
    typedef Meta8 Meta;
    unsigned char* ws; lcnt_t cnt;
    __device__ __forceinline__ Meta meta_load(const Unit& u, int wr, int fr) const {
        const GAS unsigned* rrs = (const GAS unsigned*)(opaque_ws(ws) + OFF_RW) + u.e * LCAP; const int ce = __builtin_amdgcn_readfirstlane(cnt[u.e]); Meta mt;
#pragma unroll
        for (int q = 0; q < 4; ++q) { const int i0 = u.r0 + wr * 64 + q * 16 + fr, i1 = i0 + 128;
            const unsigned a = rrs[min(i0, ce - 1)], b = rrs[min(i1, ce - 1)]; mt.lo[q] = (i0 < ce) ? a : 0u; mt.hi[q] = (i1 < ce) ? b : 0u; }
        return mt;
    }
    __device__ __forceinline__ void operator()(f32x4 (&acc)[2][2][4][2], const Unit& u, int wr, int wc, int fr, int fq, const Meta& mt) const {
        gbyte* hbuf = opaque_ws(ws) + OFF_B;
#pragma unroll
        for (int ai = 0; ai < 2; ++ai)
#pragma unroll
            for (int m = 0; m < 4; ++m) {
                const int r = ai * 128 + wr * 64 + m * 16 + fr;
                const float rs = __uint_as_float(ai ? mt.hi[m] : mt.lo[m]);
                float o[8];
#pragma unroll
                for (int n = 0; n < 2; ++n)
#pragma unroll
                    for (int j = 0; j < 4; ++j) o[4 * n + j] = silu_f(acc[ai][0][m][n][j] * rs) * (acc[ai][1][m][n][j] * rs);
                u32x2 w; w.x = pk4_fp8(o[0], o[1], o[2], o[3]); w.y = pk4_fp8(o[4], o[5], o[6], o[7]);
                *(GAS u32x2*)(hbuf + (size_t)(u.pm * 256 + r) * DE + u.pnl * 128 + wc * 32 + 8 * fq) = w;
                if (m & 1) asm volatile("" ::: "memory");
            }
    }
};
struct Epi6 {
    static constexpr bool PERM = true, PERM2 = true, MIDSCALE = false;
    typedef Meta8 Meta;
    unsigned char* ws; lcnt_t cnt;
    __device__ __forceinline__ Meta meta_load(const Unit& u, int wr, int fr) const {
        const GAS unsigned* rpk = (const GAS unsigned*)(opaque_ws(ws) + OFF_RINFO) + u.e * LCAP; const int ce = __builtin_amdgcn_readfirstlane(cnt[u.e]); Meta mt;
#pragma unroll
        for (int q = 0; q < 4; ++q) { const int i0 = u.r0 + wr * 64 + q * 16 + fr, i1 = i0 + 128;
            const unsigned a = rpk[min(i0, ce - 1)], b = rpk[min(i1, ce - 1)]; mt.lo[q] = (i0 < ce) ? a : 0xFFFFFFFFu; mt.hi[q] = (i1 < ce) ? b : 0xFFFFFFFFu; }
        return mt;
    }
    __device__ __forceinline__ void operator()(f32x4 (&acc)[2][2][4][2], const Unit& u, int wr, int wc, int fr, int fq, const Meta& mt) const {
        gbyte* ys2 = opaque_ws(ws) + OFF_A;
#pragma unroll
        for (int ai = 0; ai < 2; ++ai)
#pragma unroll
            for (int m = 0; m < 4; ++m) {
                const unsigned pk = ai ? mt.hi[m] : mt.lo[m]; const unsigned info = pk & 0xFFFFu;
                if (info < 2u * T_) {
                    const float g = __uint_as_float(pk & 0xFFFF0000u) * (YS_SCALE / WD_SCALE);
                    gbyte* dst = ys2 + (size_t)info * D_ + u.pnl * 256 + wc * 64 + 16 * fq;
                    const f32x4 v0 = acc[ai][0][m][0] * g, v1 = acc[ai][0][m][1] * g, v2 = acc[ai][1][m][0] * g, v3 = acc[ai][1][m][1] * g;
                    u32x4 w; w.x = pk4_fp8(v0[0], v0[1], v0[2], v0[3]); w.y = pk4_fp8(v1[0], v1[1], v1[2], v1[3]); w.z = pk4_fp8(v2[0], v2[1], v2[2], v2[3]); w.w = pk4_fp8(v3[0], v3[1], v3[2], v3[3]);
                    *(GAS u32x4*)dst = w;
                }
            }
    }
};

namespace pg8 {
constexpr int BM = 256, BK = 64, HALF = 128, HTB = HALF * BK * 2, STAGE_BYTES = 8 * HTB, NXCD = 8, WGM = 8;
__host__ __device__ __forceinline__ int lds_byte(int r, int c) { const int st = (r >> 4) * 2 + (c >> 5), rr = r & 15, cc = c & 31, ob = rr * 64 + cc * 2; return st * 1024 + (ob ^ (((ob >> 9) & 1) << 5)); }
__host__ __device__ __forceinline__ void stage_rc(int b, int& R, int& C) { const int st = b / 1024, sb = b % 1024, swz = sb ^ (((sb >> 9) & 1) << 5); R = (st >> 1) * 16 + swz / 64; C = (st & 1) * 32 + (swz % 64) / 2; }
__host__ __device__ __forceinline__ int perm32(int rho) { const int n = rho >> 4, i = rho & 15; return 8 * (i >> 2) + 4 * n + (i & 3); }

struct StaticOrder {
    int nM, nN, nwg, G, c, i0, i1;
    __device__ void init(int M, int N, int G_, int c_) { nM = M / BM; nN = N / BM; nwg = nM * nN; G = G_; c = c_; i0 = 0; i1 = 1 << 30; }
    __device__ int count() const { return (nwg - c + G - 1) / G; }
    __device__ bool next(int ii, Unit& u) const {
        const int i = ii + i0; if (i >= i1) return false;
        const long L = (long)i * G + c; if (L >= nwg) return false;
        int wgid = (int)L; { const int q = nwg / NXCD, r = nwg % NXCD, xcd = wgid % NXCD, off = wgid / NXCD; wgid = (xcd < r ? xcd * (q + 1) : r * (q + 1) + (xcd - r) * q) + off; }
        const int nig = WGM * nN, gid = wgid / nig, fm = gid * WGM, gsz = (nM - fm) < WGM ? (nM - fm) : WGM;
        u.pm = fm + ((wgid % nig) % gsz); u.pn = (wgid % nig) / gsz; u.e = i; u.r0 = 0; u.pnl = u.pn; return true;
    }
};
struct MoeOrder {
    lcnt_t cnt; int NT, G, c;
    __device__ __forceinline__ bool next(int i, Unit& u) const { return moe_unit(cnt, NT, i * G + c, u); }
};
struct AOffDirect { int K; struct Pre {};
    __device__ __forceinline__ Pre pre(const Unit&, int, int) const { return Pre{}; }
    __device__ __forceinline__ unsigned fin(const Pre&, const Unit& u, int h, int i, int R, int C) const { return (unsigned)(((u.pm * 256 + h * 128 + R) * K + C) * 2); } };
struct AOffGather { unsigned char* ws; lcnt_t cnt; int K;
    struct Pre { unsigned pk[2][2]; };
    __device__ __forceinline__ Pre pre(const Unit& u, int R0, int R1) const {
        const GAS unsigned* rpk = (const GAS unsigned*)(opaque_ws(ws) + OFF_RINFO) + u.e * LCAP; const int ce = __builtin_amdgcn_readfirstlane(cnt[u.e]); Pre p;
#pragma unroll
        for (int h = 0; h < 2; ++h) { const int i0 = u.r0 + h * 128 + R0, i1 = u.r0 + h * 128 + R1;
            p.pk[h][0] = rpk[min(i0, ce - 1)]; p.pk[h][1] = rpk[min(i1, ce - 1)]; }
        return p;
    }
    __device__ __forceinline__ unsigned fin(const Pre& p, const Unit&, int h, int i, int, int C) const { const int tok = (int)((p.pk[h][i] & 0xFFFFu) >> 1); return (unsigned)((tok * K + C) * 2); } };

template <class Epi, class Sched, class AOff, bool ALIGN_EPI, int QM = 0>
__device__ __forceinline__ void gemm_phase(PG8_LAS unsigned char* lds, const bf16_t* Ag, const bf16_t* Btg, const int K, const Sched& S, const AOff& AO, const Epi& E) {
    const int tid = opaque_tid(), wid = __builtin_amdgcn_readfirstlane(tid >> 6), lane = tid & 63, wr = wid >> 2, wc = wid & 3, fr = lane & 15, fq = lane >> 4;
    int nt = K / BK; asm volatile("" : "+s"(nt));
    unsigned voffB[2];
#pragma unroll
    for (int i = 0; i < 2; ++i) { int R, C; stage_rc(tid * 16 + i * 8192, R, C);
        const int Rb = Epi::PERM2 ? (64 * (R >> 5) + 16 * ((R >> 2) & 3) + 4 * ((R >> 4) & 1) + (R & 3)) : Epi::PERM ? ((R & ~31) + perm32(R & 31)) : R; voffB[i] = (unsigned)(Rb * K + C) * 2u; }
#define PG8_APRE(u, pv_) do { int _t = tid; asm volatile("" : "+v"(_t)); int _R0, _R1, _C; stage_rc(_t * 16, _R0, _C); stage_rc(_t * 16 + 8192, _R1, _C); pv_ = AO.pre(u, _R0, _R1); } while (0)
#define PG8_AFIN(u, pv_, d0, d1) do { int _t = tid; asm volatile("" : "+v"(_t)); _Pragma("unroll") for (int _i = 0; _i < 2; ++_i) { int _R, _C; stage_rc(_t * 16 + _i * 8192, _R, _C); d0[_i] = AO.fin(pv_, u, 0, _i, _R, _C); d1[_i] = AO.fin(pv_, u, 1, _i, _R, _C); } } while (0)
#define PG8_LANE(fr_, fq_) int fr_, fq_; { int _t = tid; asm volatile("" : "+v"(_t)); fr_ = _t & 15; fq_ = (_t & 63) >> 4; }
    const unsigned kstep = (unsigned)(BK * 2), tstep = 2u * (unsigned)HALF * (unsigned)K * 2u, hstep = Epi::PERM2 ? 8u * (unsigned)K * 2u : tstep / 2u;
    const unsigned ldsw = (unsigned)wid * 1024u;
    const int aoff = lds_byte(wr * 64 + fr, fq * 8), boff = lds_byte(wc * 32 + fr, fq * 8);
    const char* const Ab = (const char*)Ag; const char* const Bb = (const char*)Btg;
#define PG8_SA(b, h) (((b) * 2 + (h)) * HTB)
#define PG8_SB(b, h) ((4 + (b) * 2 + (h)) * HTB)
#define PG8_STAGE(bufoff, gbase, uoff, voff) do { _Pragma("unroll") for (int _i = 0; _i < 2; ++_i) \
        __builtin_amdgcn_global_load_lds((const unsigned*)((gbase) + (size_t)(unsigned)((uoff) + (voff)[_i])), (PG8_LAS unsigned*)(lds + (bufoff) + ldsw + _i * 8192), 16, 0, 0); } while (0)
#define PG8_LD32(base) __builtin_shufflevector(*(const PG8_LAS v4i*)(base), *(const PG8_LAS v4i*)((base) + 1024), 0, 1, 2, 3, 4, 5, 6, 7)
#define PG8_LDA(dst, b, h) do { _Pragma("unroll") for (int m = 0; m < 4; ++m) dst[m] = PG8_LD32(lds + PG8_SA(b, h) + aoff + m * 2048); } while (0)
#define PG8_LDB(dst, b, h) do { _Pragma("unroll") for (int n = 0; n < 2; ++n) dst[n] = PG8_LD32(lds + PG8_SB(b, h) + boff + n * 2048); } while (0)
#define PG8_LO(x) __builtin_bit_cast(bf16x8, __builtin_shufflevector((x), (x), 0, 1, 2, 3))
#define PG8_HI(x) __builtin_bit_cast(bf16x8, __builtin_shufflevector((x), (x), 4, 5, 6, 7))
#define PG8_LOI(x) __builtin_shufflevector((x), (x), 0, 1, 2, 3)
#define PG8_HII(x) __builtin_shufflevector((x), (x), 4, 5, 6, 7)
#define PG8_MMA(ai, bj, At, Bt) do { __builtin_amdgcn_s_setprio(1); _Pragma("unroll") for (int m = 0; m < 4; ++m) _Pragma("unroll") for (int n = 0; n < 2; ++n) { \
        if constexpr (QM == 1) acc[ai][bj][m][n] = __builtin_amdgcn_mfma_scale_f32_16x16x128_f8f6f4(Bt[n], At[m], acc[ai][bj][m][n], 0, 0, 0, 0, 0, 0);   \
        else if constexpr (QM == 2) { v4i c_ = __builtin_bit_cast(v4i, acc[ai][bj][m][n]); c_ = __builtin_amdgcn_mfma_i32_16x16x64_i8(PG8_LOI(Bt[n]), PG8_LOI(At[m]), c_, 0, 0, 0); \
               c_ = __builtin_amdgcn_mfma_i32_16x16x64_i8(PG8_HII(Bt[n]), PG8_HII(At[m]), c_, 0, 0, 0); acc[ai][bj][m][n] = __builtin_bit_cast(f32x4, c_); } \
        else { acc[ai][bj][m][n] = __builtin_amdgcn_mfma_f32_16x16x32_bf16(PG8_LO(Bt[n]), PG8_LO(At[m]), acc[ai][bj][m][n], 0, 0, 0); \
               acc[ai][bj][m][n] = __builtin_amdgcn_mfma_f32_16x16x32_bf16(PG8_HI(Bt[n]), PG8_HI(At[m]), acc[ai][bj][m][n], 0, 0, 0); } } \
        __builtin_amdgcn_s_setprio(0); } while (0)
#define PG8_WAIT_V(n) asm volatile("s_waitcnt vmcnt(" #n ")" ::: "memory")
#define PG8_WAIT_L(n) asm volatile("s_waitcnt lgkmcnt(" #n ")" ::: "memory")
#define PG8_BAR __builtin_amdgcn_s_barrier()
#define PG8_SCHED __builtin_amdgcn_sched_barrier(0)
    Unit cur, nxt; int ui = 0;
    if (!S.next(0, cur)) return;
    f32x4 acc[2][2][4][2];
#pragma unroll
    for (int a = 0; a < 2; ++a)
#pragma unroll
        for (int b = 0; b < 2; ++b)
#pragma unroll
            for (int m = 0; m < 4; ++m)
#pragma unroll
                for (int n = 0; n < 2; ++n) acc[a][b][m][n] = (f32x4){0.f, 0.f, 0.f, 0.f};
    v8i At[4], B0[2], B1[2];
    unsigned vo0[2], vo1[2];
    PG8_LAS u32x4* const svn = (PG8_LAS u32x4*)(lds + XS_OFF) + tid;
    PG8_LAS u32x4* const smeta = (PG8_LAS u32x4*)(lds + XM_OFF + tid * 32);
    constexpr bool HAS_META = sizeof(typename Epi::Meta) > 1;
    bool has_next = S.next(1, nxt);
    { typename AOff::Pre pc; PG8_APRE(cur, pc); PG8_AFIN(cur, pc, vo0, vo1);
      unsigned vn0[2], vn1[2];
      if (has_next) { typename AOff::Pre pn; PG8_APRE(nxt, pn); PG8_AFIN(nxt, pn, vn0, vn1); } else { vn0[0] = vo0[0]; vn0[1] = vo0[1]; vn1[0] = vo1[0]; vn1[1] = vo1[1]; }
      *svn = (u32x4){vn0[0], vn0[1], vn1[0], vn1[1]}; }
    if constexpr (HAS_META) { PG8_LANE(fr_, fq_); (void)fq_; const typename Epi::Meta m0 = E.meta_load(cur, wr, fr_); smeta[0] = m0.lo; smeta[1] = m0.hi; }
    unsigned cB = (unsigned)cur.pn * tstep;
    PG8_STAGE(PG8_SB(0, 0), Bb, cB, voffB); PG8_STAGE(PG8_SB(0, 1), Bb, cB + hstep, voffB); PG8_STAGE(PG8_SA(0, 0), Ab, 0u, vo0); PG8_STAGE(PG8_SA(0, 1), Ab, 0u, vo1);
    if (wr == 1) PG8_BAR;
    PG8_WAIT_V(2); PG8_BAR;
    PG8_STAGE(PG8_SB(1, 0), Bb, cB + kstep, voffB); PG8_STAGE(PG8_SA(1, 0), Ab, kstep, vo0); PG8_STAGE(PG8_SB(1, 1), Bb, cB + hstep + kstep, voffB);
    PG8_WAIT_V(6); PG8_BAR;
    for (;;) {
        const unsigned nB = has_next ? (unsigned)nxt.pn * tstep : cB;
#pragma clang loop unroll(disable)
        for (int t = 0; t < nt; t += 2) {
            const bool last = (t == nt - 2);
            if constexpr (Epi::MIDSCALE) { if (t == nt / 2) { PG8_LANE(fr_, fq_); E.midscale(acc, cur, wr, wc, fr_, fq_); } }
            const unsigned k1 = (unsigned)(t + 1) * kstep, k2 = last ? 0u : (unsigned)(t + 2) * kstep, k3 = k2 + kstep;
            const unsigned b2 = last ? nB : cB + (unsigned)(t + 2) * kstep, b3 = b2 + kstep;
            PG8_LDB(B0, 0, 0); PG8_LDB(B1, 0, 1); PG8_SCHED; PG8_LDA(At, 0, 0); PG8_STAGE(PG8_SA(1, 1), Ab, k1, vo1);
            PG8_WAIT_V(8); PG8_WAIT_L(0); PG8_BAR; PG8_MMA(0, 0, At, B0); PG8_MMA(0, 1, At, B1); PG8_BAR; PG8_SCHED;
            if (last) { PG8_LAS u32x4* sp_ = svn; asm volatile("" : "+v"(sp_));
                const u32x4 v = *sp_; vo0[0] = v.x; vo0[1] = v.y; vo1[0] = v.z; vo1[1] = v.w; }
            PG8_LDA(At, 0, 1); PG8_STAGE(PG8_SB(0, 0), Bb, b2, voffB); PG8_STAGE(PG8_SB(0, 1), Bb, b2 + hstep, voffB); PG8_STAGE(PG8_SA(0, 0), Ab, k2, vo0);
            PG8_WAIT_V(8); PG8_WAIT_L(0); PG8_BAR; PG8_MMA(1, 0, At, B0); PG8_MMA(1, 1, At, B1); PG8_BAR; PG8_SCHED;
            PG8_LDB(B0, 1, 0); PG8_LDB(B1, 1, 1); PG8_SCHED; PG8_LDA(At, 1, 0); PG8_STAGE(PG8_SA(0, 1), Ab, k2, vo1);
            PG8_WAIT_V(8); PG8_WAIT_L(0); PG8_BAR; PG8_MMA(0, 0, At, B0); PG8_MMA(0, 1, At, B1); PG8_BAR; PG8_SCHED;
            PG8_LDA(At, 1, 1); PG8_STAGE(PG8_SB(1, 0), Bb, b3, voffB); PG8_STAGE(PG8_SB(1, 1), Bb, b3 + hstep, voffB); PG8_STAGE(PG8_SA(1, 0), Ab, k3, vo0);
            PG8_WAIT_V(8); PG8_WAIT_L(0); PG8_BAR; PG8_MMA(1, 0, At, B0); PG8_MMA(1, 1, At, B1); PG8_BAR; PG8_SCHED;
        }
        if constexpr (ALIGN_EPI) { if (wr == 0) PG8_BAR; }
        Unit nn; const bool has2 = has_next && S.next(ui + 2, nn);
        typename Epi::Meta mnext;
        { PG8_LANE(fr_, fq_);
          typename Epi::Meta meta; if constexpr (HAS_META) { PG8_LAS u32x4* sp_ = smeta; asm volatile("" : "+v"(sp_)); meta.lo = sp_[0]; meta.hi = sp_[1]; }
          if (has_next) mnext = E.meta_load(nxt, wr, fr_);
          if (has2) { typename AOff::Pre pnn; PG8_APRE(nn, pnn); unsigned vn0[2], vn1[2]; PG8_AFIN(nn, pnn, vn0, vn1); *svn = (u32x4){vn0[0], vn0[1], vn1[0], vn1[1]}; }
          if constexpr (QM == 2) {
#pragma unroll
              for (int a = 0; a < 2; ++a)
#pragma unroll
                  for (int b = 0; b < 2; ++b)
#pragma unroll
                      for (int m = 0; m < 4; ++m)
#pragma unroll
                          for (int n = 0; n < 2; ++n) { const v4i c_ = __builtin_bit_cast(v4i, acc[a][b][m][n]); acc[a][b][m][n] = (f32x4){(float)c_[0], (float)c_[1], (float)c_[2], (float)c_[3]}; } }
          E(acc, cur, wr, wc, fr_, fq_, meta); }
        if (!has_next) break;
        if constexpr (HAS_META) { smeta[0] = mnext.lo; smeta[1] = mnext.hi; }
#pragma unroll
        for (int a = 0; a < 2; ++a)
#pragma unroll
            for (int b = 0; b < 2; ++b)
#pragma unroll
                for (int m = 0; m < 4; ++m)
#pragma unroll
                    for (int n = 0; n < 2; ++n) acc[a][b][m][n] = (f32x4){0.f, 0.f, 0.f, 0.f};
        cur = nxt; nxt = nn; has_next = has2; cB = nB; ++ui;
        if constexpr (ALIGN_EPI) { if (wr == 1) PG8_BAR; }
    }
    PG8_WAIT_V(0);
    if constexpr (!ALIGN_EPI) { if (wr == 0) PG8_BAR; }
    PG8_BAR;
#undef PG8_APRE
#undef PG8_AFIN
#undef PG8_LANE
#undef PG8_SA
#undef PG8_SB
#undef PG8_STAGE
#undef PG8_LDA
#undef PG8_LDB
#undef PG8_MMA
#undef PG8_LO
#undef PG8_HI
#undef PG8_LOI
#undef PG8_HII
#undef PG8_LD32
#undef PG8_WAIT_V
#undef PG8_WAIT_L
#undef PG8_BAR
#undef PG8_SCHED
}
}


#define XB_TMO      128
#define XB_XCNT(j)  (256  + 64 * (j))
#define XB_XSUB(j)  (1280 + 64 * (j))
#define XB_XGEN(j)  (2304 + 64 * (j))
#define XB_TOP      3328
#define XB_TOPGEN   3392
#define XCD_BAR_WORDS 3456
#define XB_SPIN_CAP (1u << 18)
__device__ __forceinline__ unsigned xb_ld(unsigned* p)              { return __hip_atomic_load(p, __ATOMIC_RELAXED, __HIP_MEMORY_SCOPE_AGENT); }
__device__ __forceinline__ unsigned xb_add(unsigned* p, unsigned v) { return __hip_atomic_fetch_add(p, v, __ATOMIC_RELAXED, __HIP_MEMORY_SCOPE_AGENT); }
__device__ __forceinline__ unsigned xb_xcc_id() { return (unsigned)__builtin_amdgcn_s_getreg((3 << 11) | 20) & 0xFu; }
#define XB_SPIN(cond, bar) do { unsigned _sp = 0; while (cond) { __builtin_amdgcn_s_sleep(1); \
    if ((++_sp & 255u) == 0u) { if (xb_ld(&(bar)[XB_TMO])) break; if (_sp > XB_SPIN_CAP) { atomicAdd(&(bar)[XB_TMO], 1u); break; } } } } while (0)
struct XcdBarrier { unsigned* bar; unsigned x; volatile PG8_LAS unsigned* st; };
__device__ __forceinline__ XcdBarrier xcd_barrier_post(unsigned* bar, volatile PG8_LAS unsigned* st) {
    XcdBarrier b; b.bar = bar; b.x = xb_xcc_id(); b.st = st;
    if (threadIdx.x == 0) (void)xb_add(&bar[XB_XCNT(b.x)], 1u);
    return b;
}
__device__ __forceinline__ void xcd_barrier_complete(unsigned* bar, unsigned x, unsigned& nloc, unsigned& nx) {
    const unsigned G = gridDim.x * gridDim.y * gridDim.z;
    unsigned sum, cnt, mine, sp = 0u;
    for (;;) {
        sum = 0u; cnt = 0u; mine = 0u;
#pragma unroll
        for (unsigned j = 0; j < 16; ++j) { const unsigned c = xb_ld(&bar[XB_XCNT(j)]); sum += c; cnt += (c > 0u) ? 1u : 0u; mine = (j == x) ? c : mine; }
        if (sum == G) break;
        __builtin_amdgcn_s_sleep(1);
        if ((++sp & 255u) == 0u) { if (xb_ld(&bar[XB_TMO])) break; if (sp > XB_SPIN_CAP) { atomicAdd(&bar[XB_TMO], 1u); break; } }
    }
    nloc = mine > 0u ? mine : 1u; nx = cnt > 0u ? cnt : 1u;
}
__device__ __forceinline__ void xcd_barrier(const XcdBarrier& b) {
    asm volatile("s_waitcnt vmcnt(0)" ::: "memory");
    __syncthreads();
    if (threadIdx.x == 0) {
        unsigned* bar = b.bar;
        __builtin_amdgcn_s_waitcnt(0);
        unsigned nloc = b.st[0], nx = b.st[1];
        if (nloc == 0u) { xcd_barrier_complete(bar, b.x, nloc, nx); b.st[0] = nloc; b.st[1] = nx; }
        const unsigned old = xb_add(&bar[XB_XSUB(b.x)], 1u);
        const unsigned gen = old / nloc;
        if (old + 1u == (gen + 1u) * nloc) {
            __builtin_amdgcn_fence(__ATOMIC_RELEASE, "agent");
            asm volatile("s_waitcnt vmcnt(0)" ::: "memory");
            const unsigned og = xb_add(&bar[XB_TOP], 1u);
            const unsigned tg = og / nx;
            if (og + 1u == (tg + 1u) * nx) xb_add(&bar[XB_TOPGEN], 1u);
            else XB_SPIN(xb_ld(&bar[XB_TOPGEN]) == tg, bar);
            __builtin_amdgcn_fence(__ATOMIC_ACQUIRE, "agent");
            xb_add(&bar[XB_XGEN(b.x)], 1u);
            asm volatile("s_waitcnt vmcnt(0)" ::: "memory");
        } else {
            XB_SPIN(xb_ld(&bar[XB_XGEN(b.x)]) == gen, bar);
            __builtin_amdgcn_fence(__ATOMIC_ACQUIRE, "agent");
            asm volatile("s_waitcnt vmcnt(0)" ::: "memory");
        }
    }
    __syncthreads();
}

struct TJob { const float* src; int ld; unsigned char* dst; int lddst; float sc; const float* sk; int fp8; int rmap; int row0; int tr0; const unsigned* sk2; float* swp; };
__device__ __forceinline__ bool tjob_decode(const Params& p, int q, TJob& j, int w_in_kind = 3) {
    j.rmap = 0; j.row0 = 0; j.tr0 = 0; j.sk2 = (const unsigned*)(p.ws + OFF_CMAX); j.swp = (float*)(p.ws + OFF_SW); j.sk = nullptr; j.sc = 1.f; j.fp8 = 0;
    constexpr int N_IN = 16 * 80, N_OUT = 16 * 32, N_G = 32 * 128;
    if (q < N_IN) { const int tr = q / 80, tc = q % 80; j.src = p.w_in + (size_t)tr * 128 * DIN + tc * 64; j.ld = DIN; j.sc = 1.f; j.sk = nullptr; j.fp8 = w_in_kind; j.lddst = D_; j.rmap = 0;
        if (tc < 48) { j.row0 = tc * 64; }
        else { const int hsel = tc >= 64, ch0 = (tc - (hsel ? 64 : 48)) * 64; j.rmap = 1 + hsel; j.row0 = 3072 + 256 * (ch0 >> 7) + 2 * (ch0 & 127); }
        j.dst = p.ws + OFF_WIN + (size_t)j.row0 * D_ + tr * 128; j.sk2 = (const unsigned*)(p.ws + OFF_CMAX); j.swp = (float*)(p.ws + OFF_SW); j.tr0 = (tr == 0);
        return true; } q -= N_IN;
    if (q < N_OUT) { const int tr = q / 32, tc = q % 32; j.src = p.w_out + (size_t)tr * 128 * D_ + tc * 64; j.ld = D_; j.dst = p.ws + OFF_WOUT + ((size_t)tc * 64 * D_ + tr * 128) * 2; j.lddst = D_ * 2; j.sc = 1.f;
        j.sk = (tr < 8 ? p.g_a + tr * 128 : p.g_b + (tr - 8) * 128); j.fp8 = 0; j.rmap = 0; return true; } q -= N_OUT;
    if (q < 2 * N_G) { const int up = q >= N_G; if (up) q -= N_G; const int e = q >> 7, rem = q & 127, tr = rem >> 3, tc = rem & 7, c0 = tc * 64;
        j.src = (up ? p.ewu : p.ewg) + (size_t)e * D_ * DE + (size_t)tr * 128 * DE + c0; j.ld = DE;
        j.dst = p.ws + OFF_WGU + (size_t)e * 1024 * D_ + (size_t)((c0 >> 7) * 256 + (up ? 128 : 0) + (c0 & 127)) * D_ + tr * 128; j.lddst = D_; j.sc = WGU_SCALE; j.sk = p.g_ffn + tr * 128; j.fp8 = 1; j.rmap = 0; return true; } q -= 2 * N_G;
    if (q < N_G) { const int e = q >> 7, rem = q & 127, tr = rem >> 5, tc = rem & 31;
        j.src = p.ewd + (size_t)e * DE * D_ + (size_t)tr * 128 * D_ + tc * 64; j.ld = D_; j.dst = p.ws + OFF_WD + (size_t)e * D_ * DE + (size_t)tc * 64 * DE + tr * 128; j.lddst = DE; j.sc = WD_SCALE; j.sk = nullptr; j.fp8 = 1; j.rmap = 0; return true; }
    return false;
}
constexpr int N_TJOBS_IN = 16 * 80, N_TJOBS_DENSE = 16 * 80 + 16 * 32, N_TJOBS_GU = N_TJOBS_DENSE + 2 * 32 * 128, N_TJOBS = N_TJOBS_GU + 32 * 128;
__device__ __forceinline__ void tjob_stage(const TJob& j, int tid, unsigned char* lds, int b) {
    PG8_LAS unsigned char* L = (PG8_LAS unsigned char*)lds + b * 32768 + __builtin_amdgcn_readfirstlane(tid >> 6) * 1024;
#pragma unroll
    for (int i = 0; i < 4; ++i) { const int k = i * 32 + (tid >> 4), pn = (tid & 15) ^ ((k >> 4) & 7);
        __builtin_amdgcn_global_load_lds((const unsigned*)(j.src + (size_t)k * j.ld + 4 * pn), (PG8_LAS unsigned*)(L + i * 8192), 16, 0, 2); }
    const float* aux = (j.fp8 == 3) ? (const float*)(j.sk2 + j.row0) : (j.sk ? j.sk : j.src);
    __builtin_amdgcn_global_load_lds((const unsigned*)(aux + (tid & 31) * 4), (PG8_LAS unsigned*)((PG8_LAS unsigned char*)lds + XS_OFF + b * 1024), 16, 0, 0);
}
__device__ __forceinline__ void tjob_finish(const TJob& j, int tid, unsigned char* lds, int b) {
    const int c = tid >> 3, kb = tid & 7, rr = kb * 16; float v[16];
    { const PG8_LAS float* lt = (const PG8_LAS float*)((PG8_LAS unsigned char*)lds + b * 32768) + rr * 64 + 4 * ((c >> 2) ^ kb) + (c & 3);
#pragma unroll
      for (int q = 0; q < 16; ++q) v[q] = lt[q * 64]; }
    const PG8_LAS float* ax = (const PG8_LAS float*)((PG8_LAS unsigned char*)lds + XS_OFF + b * 1024);
    if (j.sk) {
#pragma unroll
        for (int q4 = 0; q4 < 4; ++q4) { const f32x4 f = *(const PG8_LAS f32x4*)(ax + rr + 4 * q4);
#pragma unroll
            for (int e = 0; e < 4; ++e) v[4 * q4 + e] *= j.sc * f[e]; } }
    else {
#pragma unroll
        for (int q = 0; q < 16; ++q) v[q] *= j.sc; }
    const int drow = j.rmap ? 8 * (c >> 2) + 4 * (j.rmap - 1) + (c & 3) : c;
    unsigned char* d = j.dst + (size_t)drow * j.lddst;
    if (j.fp8 == 2) {
        float am = 0.f;
#pragma unroll
        for (int q = 0; q < 16; ++q) am = fmaxf(am, fabsf(v[q]));
        am = fmaxf(am, __shfl_xor(am, 1)); am = fmaxf(am, __shfl_xor(am, 2)); am = fmaxf(am, __shfl_xor(am, 4));
        if ((tid & 7) == 0) atomicMax((unsigned*)(j.sk2) + j.row0 + drow, __float_as_uint(am)); }
    else if (j.fp8 == 3) {
        const float am = fmaxf(ax[drow], 1e-30f), qi = 127.f / am;
        unsigned w[4];
#pragma unroll
        for (int q = 0; q < 4; ++q) { const int a = (int)rintf(v[4 * q] * qi), b2 = (int)rintf(v[4 * q + 1] * qi), c2 = (int)rintf(v[4 * q + 2] * qi), d2 = (int)rintf(v[4 * q + 3] * qi);
            w[q] = (unsigned)(a & 255) | ((unsigned)(b2 & 255) << 8) | ((unsigned)(c2 & 255) << 16) | ((unsigned)(d2 & 255) << 24); }
        *(u32x4*)(d + rr) = (u32x4){w[0], w[1], w[2], w[3]};
        if (rr == 0 && j.tr0) j.swp[j.row0 + drow] = am * (1.f / 127.f); }
    else if (j.fp8) { u32x4 w; w.x = pk4_fp8(v[0], v[1], v[2], v[3]); w.y = pk4_fp8(v[4], v[5], v[6], v[7]); w.z = pk4_fp8(v[8], v[9], v[10], v[11]); w.w = pk4_fp8(v[12], v[13], v[14], v[15]);
        *(u32x4*)(d + rr) = w; }
    else { u32x4 w0, w1; w0.x = cvt_pk_bf16(v[0], v[1]); w0.y = cvt_pk_bf16(v[2], v[3]); w0.z = cvt_pk_bf16(v[4], v[5]); w0.w = cvt_pk_bf16(v[6], v[7]);
        w1.x = cvt_pk_bf16(v[8], v[9]); w1.y = cvt_pk_bf16(v[10], v[11]); w1.z = cvt_pk_bf16(v[12], v[13]); w1.w = cvt_pk_bf16(v[14], v[15]);
        *(u32x4*)(d + rr * 2) = w0; *(u32x4*)(d + rr * 2 + 16) = w1; }
}
__device__ __forceinline__ void run_tjobs(const Params& p, unsigned char* lds, int qlo, int qhi, int k0 = 0, int k1 = 1 << 20, int first = -1, int stride = 0, int w_in_kind = 3) {
    const int tid = opaque_tid(), nb = stride > 0 ? stride : (int)gridDim.x;
    const int qb = qlo + (first >= 0 ? first : (int)blockIdx.x);
#define TJ_OK(kk) ((kk) < k1 && qb + (kk) * nb < qhi)
    asm volatile("s_waitcnt vmcnt(0)" ::: "memory");
#pragma unroll
    for (int i = 0; i < 3; ++i) if (TJ_OK(k0 + i)) { TJob j; tjob_decode(p, qb + (k0 + i) * nb, j, w_in_kind); tjob_stage(j, tid, lds, i); }
    int b = 0;
#pragma clang loop unroll(disable)
    for (int k = k0; TJ_OK(k); ++k) {
        if (TJ_OK(k + 2)) asm volatile("s_waitcnt vmcnt(10)" ::: "memory");
        else if (TJ_OK(k + 1)) asm volatile("s_waitcnt vmcnt(5)" ::: "memory");
        else asm volatile("s_waitcnt vmcnt(0)" ::: "memory");
        __builtin_amdgcn_s_barrier();
        asm volatile("" ::: "memory");
        if (TJ_OK(k + 3)) { TJob jn; tjob_decode(p, qb + (k + 3) * nb, jn, w_in_kind); tjob_stage(jn, tid, lds, (b + 3) & 3); }
        { TJob j; tjob_decode(p, qb + k * nb, j, w_in_kind); tjob_finish(j, tid, lds, b); }
        b = (b + 1) & 3;
    }
#undef TJ_OK
    __syncthreads();
}
__device__ __forceinline__ void phase0(const Params& p, unsigned char* lds) {
    const int tid = opaque_tid(), nb = gridDim.x, bid = blockIdx.x, wid = tid >> 6, lane = tid & 63;
    { float* z = (float*)(p.ws + OFF_SSQ);
      for (int i = bid * NTHR + tid; i < 3 * T_ + 64; i += nb * NTHR) z[i] = 0.f;
      if (DUP_PHASE >= 2 && DUP_PHASE <= 4) { float* zd = (float*)(p.ws + OFF_SSQ + (OFF_DUMMY - OFF_SSQ)); for (int i = bid * NTHR + tid; i < 3 * T_ + 64; i += nb * NTHR) zd[i] = 0.f; } }
    { bf16_t* wrt = (bf16_t*)(p.ws + OFF_WR);
      for (int i = bid * NTHR + tid; i < 48 * D_; i += nb * NTHR) {
          const int o = i >> 11, k = i & 2047; float v = 0.f;
          if (o < 4) v = p.rgw[k * 4 + o]; else if (o < 36) v = p.rew[k * 32 + (o - 4)];
          wrt[i] = (bf16_t)(cvt_pk_bf16(v * p.g_ffn[k], 0.f) & 0xffffu); } }
    { bf16_t* wsb = (bf16_t*)(p.ws + OFF_WSB);
      for (int i = bid * NTHR + tid; i < 8 * 128 * 128; i += nb * NTHR) { const int r = (i >> 7) & 127, c = i & 127;
          wsb[i] = (bf16_t)(cvt_pk_bf16(((r >> 6) >= (c >> 6)) ? p.gmlp_ws[i] : 0.f, 0.f) & 0xffffu); } }
    { unsigned char* xq = p.ws + OFF_B; float* sx = (float*)(p.ws + OFF_SX);
      for (int row = bid * 8 + wid; row < T_; row += nb * 8) {
          const float* xr = p.x + (size_t)row * D_;
          f32x4 v[8]; float s = 0.f;
#pragma unroll
          for (int i = 0; i < 8; ++i) { v[i] = *(const f32x4*)(xr + i * 256 + lane * 4); s += (v[i][0] * v[i][0] + v[i][1] * v[i][1]) + (v[i][2] * v[i][2] + v[i][3] * v[i][3]); }
          const float rstd = rsqrtf(wave_sum(s) * (1.f / D_) + EPS);
          float amax = 0.f;
#pragma unroll
          for (int i = 0; i < 8; ++i) { const f32x4 g = *(const f32x4*)(p.norm_mix_g + i * 256 + lane * 4); v[i] = v[i] * rstd * g;
              amax = fmaxf(amax, fmaxf(fmaxf(fabsf(v[i][0]), fabsf(v[i][1])), fmaxf(fabsf(v[i][2]), fabsf(v[i][3])))); }
#pragma unroll
          for (int o_ = 1; o_ < 64; o_ <<= 1) amax = fmaxf(amax, __shfl_xor(amax, o_));
          amax = fmaxf(amax, 1e-30f); const float qi = 127.f / amax;
          if (lane == 0) sx[row] = amax * (1.f / 127.f);
#pragma unroll
          for (int i = 0; i < 8; ++i) { const int a = (int)rintf(v[i][0] * qi), b = (int)rintf(v[i][1] * qi), c = (int)rintf(v[i][2] * qi), d = (int)rintf(v[i][3] * qi);
              *(unsigned*)(xq + (size_t)row * D_ + i * 256 + lane * 4) = (unsigned)(a & 255) | ((unsigned)(b & 255) << 8) | ((unsigned)(c & 255) << 16) | ((unsigned)(d & 255) << 24); } } }
    run_tjobs(p, lds, 0, N_TJOBS_IN, 0, 1 << 20, -1, 0, 2);
}
__device__ __forceinline__ void phase0b(const Params& p, unsigned char* lds) { run_tjobs(p, lds, 0, N_TJOBS_IN, 0, 1 << 20, -1, 0, 3); }

__device__ __forceinline__ int side_rounds(int nb) { return (N_TJOBS_GU - N_TJOBS_IN + nb - 1) / nb; }
__device__ __forceinline__ void phase1(const Params& p, unsigned char* lds) {
    const Epi1 E{p.ws};
    pg8::StaticOrder S; S.init(T_, DIN, gridDim.x, blockIdx.x); const pg8::AOffDirect AO{D_ / 2};
    const int nu = S.count(), col = blockIdx.x & 3, split = col == 0 ? 0 : col == 1 ? (2 * nu) / 5 : col == 2 ? (3 * nu) / 5 : nu;
    const int kr = side_rounds(gridDim.x), k1 = kr / 2;
    S.i0 = 0; S.i1 = split;
    pg8::gemm_phase<Epi1, pg8::StaticOrder, pg8::AOffDirect, true, 2>((PG8_LAS unsigned char*)lds, (const bf16_t*)(p.ws + OFF_B), (const bf16_t*)(p.ws + OFF_WIN), D_ / 2, S, AO, E);
    run_tjobs(p, lds, N_TJOBS_IN, N_TJOBS_GU, 0, k1);
    S.i0 = split; S.i1 = nu;
    pg8::gemm_phase<Epi1, pg8::StaticOrder, pg8::AOffDirect, true, 2>((PG8_LAS unsigned char*)lds, (const bf16_t*)(p.ws + OFF_B), (const bf16_t*)(p.ws + OFF_WIN), D_ / 2, S, AO, E);
}

struct VRegs { u32x4 v[4]; };
__device__ __forceinline__ void gmlp_load_v(const Params& p, int item, int tid, VRegs& r) {
    const int h = item & 7, t0 = (item >> 3) * 128, j = tid >> 2, dc = (tid & 3) * 32;
    const u32x4* src = (const u32x4*)((const bf16_t*)(p.ws + OFF_A) + (size_t)(t0 + j) * DP + 1024 + h * 128 + dc);
#pragma unroll
    for (int q = 0; q < 4; ++q) r.v[q] = src[q];
}
__device__ __forceinline__ void mixer_gmlp_item(const Params& p, bf16_t* Vt, int item, const VRegs& r, size_t so) {
    const int tid = opaque_tid(), wid = tid >> 6, lane = tid & 63, fr = lane & 15, fq = lane >> 4;
    const int h = item & 7, t0 = (item >> 3) * 128;
    const bf16_t* P = (const bf16_t*)(p.ws + OFF_A); bf16_t* Y = (bf16_t*)(p.ws + OFF_B); float* ssq_a = (float*)(p.ws + OFF_SSQ + so);
    const bf16_t* wsb = (const bf16_t*)(p.ws + OFF_WSB) + (size_t)h * 16384;
    { const int j = tid >> 2, dc = (tid & 3) * 32; float s = 0.f;
#pragma unroll
      for (int q = 0; q < 4; ++q)
#pragma unroll
          for (int w = 0; w < 4; ++w) { const float lo = bflo(r.v[q][w]), hi = bfhi(r.v[q][w]); s += lo * lo + hi * hi; }
      s += __shfl_xor(s, 1); s += __shfl_xor(s, 2);
      const float rs = rsqrtf(s * (1.f / 128.f) + EPS);
#pragma unroll
      for (int q = 0; q < 4; ++q)
#pragma unroll
          for (int w = 0; w < 4; ++w) { const int d = dc + q * 8 + w * 2; const unsigned pk = cvt_pk_bf16(bflo(r.v[q][w]) * rs, bfhi(r.v[q][w]) * rs);
              Vt[d * 136 + j] = (bf16_t)(pk & 0xffffu); Vt[(d + 1) * 136 + j] = (bf16_t)(pk >> 16); } }
    const int i = 16 * wid + fr, t = t0 + i; const float bias = p.gmlp_bs[h * 128 + i];
    u32x2 uu[8];
#pragma unroll
    for (int n = 0; n < 8; ++n) uu[n] = *(const u32x2*)(P + (size_t)t * DP + h * 128 + 16 * n + 4 * fq);
    const int ksteps = (wid < 4) ? 2 : 4;
    bf16x8 bw[4];
#pragma unroll
    for (int ks = 0; ks < 4; ++ks) bw[ks] = *(const bf16x8*)(wsb + (16 * wid + fr) * 128 + ks * 32 + fq * 8);
    __syncthreads();
    f32x4 acc[8];
#pragma unroll
    for (int n = 0; n < 8; ++n) acc[n] = (f32x4){0.f, 0.f, 0.f, 0.f};
#pragma unroll
    for (int ks = 0; ks < 4; ++ks) { if (ks < ksteps) {
#pragma unroll
        for (int n = 0; n < 8; ++n) { const bf16x8 av = *(const bf16x8*)(Vt + (16 * n + fr) * 136 + ks * 32 + fq * 8);
            acc[n] = __builtin_amdgcn_mfma_f32_16x16x32_bf16(av, bw[ks], acc[n], 0, 0, 0); } } }
    float ss = 0.f;
#pragma unroll
    for (int n = 0; n < 8; ++n) { const int c = h * 128 + 16 * n + 4 * fq;
        const f32x4 g = *(const f32x4*)(p.v_norm_g + c);
        const float y0 = bflo(uu[n].x) * (acc[n][0] * g[0] + bias), y1 = bfhi(uu[n].x) * (acc[n][1] * g[1] + bias), y2 = bflo(uu[n].y) * (acc[n][2] * g[2] + bias), y3 = bfhi(uu[n].y) * (acc[n][3] * g[3] + bias);
        ss += (y0 * y0 + y1 * y1) + (y2 * y2 + y3 * y3);
        u32x2 w; w.x = cvt_pk_bf16(y0, y1); w.y = cvt_pk_bf16(y2, y3); *(u32x2*)(Y + (size_t)t * D_ + c) = w; }
    ss += __shfl_xor(ss, 16); ss += __shfl_xor(ss, 32);
    if (fq == 0) atomicAdd(ssq_a + t, ss);
}
__device__ __forceinline__ void mixer_conv_item(const Params& p, int item, size_t so) {
    const int tid = opaque_tid(), cl = tid & 31, ts = tid >> 5;
    const int c = (item & 3) * 256 + cl * 8, tbeg = (item >> 2) * 128 + ts * 8;
    const bf16_t* P = (const bf16_t*)(p.ws + OFF_A); bf16_t* Y = (bf16_t*)(p.ws + OFF_B); float* ssq_b = (float*)(p.ws + OFF_SSQ + so) + T_;
    float w0[8], w1[8], w2[8], z1[8], z2[8];
    { const f32x4 a0 = *(const f32x4*)(p.conv_w + c), a1 = *(const f32x4*)(p.conv_w + c + 4), b0 = *(const f32x4*)(p.conv_w + 1024 + c), b1 = *(const f32x4*)(p.conv_w + 1024 + c + 4),
                  c0 = *(const f32x4*)(p.conv_w + 2048 + c), c1 = *(const f32x4*)(p.conv_w + 2048 + c + 4);
#pragma unroll
      for (int q = 0; q < 4; ++q) { w0[q] = a0[q]; w0[4 + q] = a1[q]; w1[q] = b0[q]; w1[4 + q] = b1[q]; w2[q] = c0[q]; w2[4 + q] = c1[q]; } }
#pragma unroll
    for (int q = 0; q < 8; ++q) { z1[q] = 0.f; z2[q] = 0.f; }
    if ((tbeg % SEQ) != 0) {
        const u32x4 za = *(const u32x4*)(P + (size_t)(tbeg - 1) * DP + 3072 + c), zb = *(const u32x4*)(P + (size_t)(tbeg - 2) * DP + 3072 + c);
#pragma unroll
        for (int q = 0; q < 4; ++q) { z1[2 * q] = bflo(za[q]); z1[2 * q + 1] = bfhi(za[q]); z2[2 * q] = bflo(zb[q]); z2[2 * q + 1] = bfhi(zb[q]); }
    }
    u32x4 bgA[8], zA[8];
#pragma unroll
    for (int tt = 0; tt < 8; ++tt) { const bf16_t* pr = P + (size_t)(tbeg + tt) * DP + c; bgA[tt] = *(const u32x4*)(pr + 2048); zA[tt] = *(const u32x4*)(pr + 3072); }
#pragma unroll
    for (int tt = 0; tt < 8; ++tt) {
        const int t = tbeg + tt;
        const u32x4 bg = bgA[tt], zv = zA[tt];
        float z[8], y[8], ss = 0.f;
#pragma unroll
        for (int q = 0; q < 4; ++q) { z[2 * q] = bflo(zv[q]); z[2 * q + 1] = bfhi(zv[q]); }
#pragma unroll
        for (int q = 0; q < 4; ++q) {
            y[2 * q] = bflo(bg[q]) * (w0[2 * q] * z2[2 * q] + w1[2 * q] * z1[2 * q] + w2[2 * q] * z[2 * q]);
            y[2 * q + 1] = bfhi(bg[q]) * (w0[2 * q + 1] * z2[2 * q + 1] + w1[2 * q + 1] * z1[2 * q + 1] + w2[2 * q + 1] * z[2 * q + 1]); }
#pragma unroll
        for (int q = 0; q < 8; ++q) { ss += y[q] * y[q]; z2[q] = z1[q]; z1[q] = z[q]; }
        u32x4 w; w.x = cvt_pk_bf16(y[0], y[1]); w.y = cvt_pk_bf16(y[2], y[3]); w.z = cvt_pk_bf16(y[4], y[5]); w.w = cvt_pk_bf16(y[6], y[7]);
        *(u32x4*)(Y + (size_t)t * D_ + 1024 + c) = w;
        ss += __shfl_xor(ss, 1); ss += __shfl_xor(ss, 2); ss += __shfl_xor(ss, 4); ss += __shfl_xor(ss, 8); ss += __shfl_xor(ss, 16);
        if (cl == 0) atomicAdd(ssq_b + t, ss);
    }
}
__device__ __forceinline__ void phase2(const Params& p, unsigned char* lds, size_t so = 0) {
    const int nb = gridDim.x, bid = blockIdx.x, tid = opaque_tid();
    for (int it = bid; it < 512; it += nb) mixer_conv_item(p, it, so);
    bf16_t* Vt0 = (bf16_t*)lds; bf16_t* Vt1 = Vt0 + 128 * 136;
    VRegs ra, rb; int it = bid; bool ha = it < 1024, hb_ = it + nb < 1024;
    if (ha) gmlp_load_v(p, it, tid, ra);
    while (ha) {
        if (hb_) gmlp_load_v(p, it + nb, tid, rb);
        mixer_gmlp_item(p, Vt0, it, ra, so);
        if (!hb_) break;
        it += 2 * nb; ha = it < 1024;
        if (ha) gmlp_load_v(p, it, tid, ra);
        mixer_gmlp_item(p, Vt1, it - nb, rb, so);
        hb_ = it + nb < 1024;
    }
    __syncthreads();
}

__device__ __forceinline__ void phase3(const Params& p, unsigned char* lds, size_t so = 0) {
    pg8::StaticOrder S; S.init(T_, D_, gridDim.x, blockIdx.x); const pg8::AOffDirect AO{D_};
    PG8_LAS float* rsl = (PG8_LAS float*)((PG8_LAS unsigned char*)lds + RS_OFF);
    { const float* ssq = (const float*)(p.ws + OFF_SSQ); const int tid = opaque_tid();
      for (int i = 0; i < RS_UNITS; ++i) { Unit u; if (!S.next(i, u)) break;
          if (tid < 256) { const int row = u.pm * 256 + tid; const float va = ssq[row] * (1.f / 1024.f) + EPS, vb = ssq[T_ + row] * (1.f / 1024.f) + EPS;
              rsl[(i * 256 + tid) * 2] = __builtin_amdgcn_sqrtf(vb * __builtin_amdgcn_rcpf(va)); rsl[(i * 256 + tid) * 2 + 1] = __builtin_amdgcn_rsqf(vb); } }
      __syncthreads(); }
    const Epi2 E{p.x, p.ws, so, rsl};
    const int kr = side_rounds(gridDim.x), k0 = kr / 2; const bool side = (so == 0);
    const int col = blockIdx.x & 1, km = col ? kr : k0;
    if (side) run_tjobs(p, lds, N_TJOBS_IN, N_TJOBS_GU, k0, km);
    pg8::gemm_phase<Epi2, pg8::StaticOrder, pg8::AOffDirect, true>((PG8_LAS unsigned char*)lds, (const bf16_t*)(p.ws + OFF_B), (const bf16_t*)(p.ws + OFF_WOUT), D_, S, AO, E);
    if (side) run_tjobs(p, lds, N_TJOBS_IN, N_TJOBS_GU, km, kr);
}

__device__ __forceinline__ void route_item(const Params& p, unsigned char* lds, int item, size_t so) {
    const int tid = opaque_tid(), wid = tid >> 6, lane = tid & 63, fr = lane & 15, fq = lane >> 4;
    float* lg = (float*)lds;
    float* ls = lg + 8 * 64 * 48;
    int* lcnt = (int*)(ls + 64 * 48); int* lbase = lcnt + 32;
    const bf16_t* hb = (const bf16_t*)(p.ws + OFF_HB); const bf16_t* wrt = (const bf16_t*)(p.ws + OFF_WR);
    const float* ssq_h = (const float*)(p.ws + OFF_SSQ) + 2 * T_;
    int* cnt = (int*)(p.ws + OFF_CNT + so); int* rinfo = (int*)(p.ws + OFF_RINFO + so); float* rw = (float*)(p.ws + OFF_RW + so);
    const int t0 = item * 64;
    if (tid < 32) lcnt[tid] = 0;
    f32x4 acc[4][3];
#pragma unroll
    for (int m = 0; m < 4; ++m)
#pragma unroll
        for (int n = 0; n < 3; ++n) acc[m][n] = (f32x4){0.f, 0.f, 0.f, 0.f};
    const bf16_t* ap = hb + (size_t)(t0 + fr) * D_ + wid * 256 + fq * 8; const bf16_t* bp = wrt + (size_t)fr * D_ + wid * 256 + fq * 8;
#pragma unroll 4
    for (int ks = 0; ks < 8; ++ks) {
        bf16x8 a[4], b[3];
#pragma unroll
        for (int m = 0; m < 4; ++m) a[m] = *(const bf16x8*)(ap + (size_t)m * 16 * D_ + ks * 32);
#pragma unroll
        for (int n = 0; n < 3; ++n) b[n] = *(const bf16x8*)(bp + (size_t)n * 16 * D_ + ks * 32);
#pragma unroll
        for (int m = 0; m < 4; ++m)
#pragma unroll
            for (int n = 0; n < 3; ++n) acc[m][n] = __builtin_amdgcn_mfma_f32_16x16x32_bf16(a[m], b[n], acc[m][n], 0, 0, 0);
    }
#pragma unroll
    for (int m = 0; m < 4; ++m)
#pragma unroll
        for (int n = 0; n < 3; ++n)
#pragma unroll
            for (int j = 0; j < 4; ++j) lg[(wid * 64 + m * 16 + 4 * fq + j) * 48 + 16 * n + fr] = acc[m][n][j];
    __syncthreads();
    for (int i = tid; i < 64 * 48; i += NTHR) { float v = 0.f;
#pragma unroll
        for (int w = 0; w < 8; ++w) v += lg[w * 64 * 48 + i];
        ls[i] = v; }
    __syncthreads();
    int e0 = 0, e1 = 0, r0 = 0, r1 = 0; float g0 = 0.f, g1 = 0.f, rsc = 0.f; const int t = t0 + tid;
    if (tid < 64) {
        const float* l0 = ls + tid * 48; const float rstd = rsqrtf(ssq_h[t] * (1.f / D_) + EPS); rsc = rstd * (1.f / WGU_SCALE);
        float gm = -3.0e38f; int gi = 0; float gl[4];
#pragma unroll
        for (int o = 0; o < 4; ++o) { gl[o] = l0[o] * rstd + p.rgb[o]; if (gl[o] > gm) { gm = gl[o]; gi = o; } }
        float gs = 0.f;
#pragma unroll
        for (int o = 0; o < 4; ++o) gs += __expf(gl[o] - gm);
        const float pg = 1.f / gs;
        float b1 = -3.0e38f, b2 = -3.0e38f; int i1 = 0, i2 = 0;
        for (int q = 0; q < 8; ++q) { const float v = l0[4 + gi * 8 + q] * rstd + p.reb[gi * 8 + q];
            if (v > b1) { b2 = b1; i2 = i1; b1 = v; i1 = q; } else if (v > b2) { b2 = v; i2 = q; } }
        const float wa = 1.f / (1.f + __expf(b2 - b1));
        e0 = gi * 8 + i1; e1 = gi * 8 + i2; g0 = pg * wa; g1 = pg * (1.f - wa);
        r0 = atomicAdd(&lcnt[e0], 1); r1 = atomicAdd(&lcnt[e1], 1);
    }
    __syncthreads();
    if (tid < 32) lbase[tid] = atomicAdd(cnt + tid, lcnt[tid]);
    __syncthreads();
    if (tid < 64) { const int i0 = lbase[e0] + r0, i1 = lbase[e1] + r1;
        rinfo[e0 * LCAP + i0] = (int)((cvt_pk_bf16(g0, 0.f) << 16) | (unsigned)(2 * t)); rinfo[e1 * LCAP + i1] = (int)((cvt_pk_bf16(g1, 0.f) << 16) | (unsigned)(2 * t + 1));
        rw[e0 * LCAP + i0] = rsc; rw[e1 * LCAP + i1] = rsc; }
    __syncthreads();
}
__device__ __forceinline__ void phase4(const Params& p, unsigned char* lds, size_t so = 0) { for (int it = blockIdx.x; it < T_ / 64; it += gridDim.x) route_item(p, lds, it, so); }

__device__ __forceinline__ int moe_slot() { const int G = gridDim.x, c = blockIdx.x; return (G & 7) ? c : (c & 7) * (G >> 3) + (c >> 3); }
__device__ __forceinline__ PG8_LAS int* moe_tables_to_lds(const Params& p, unsigned char* lds, bool build) {
    PG8_LAS int* tb = (PG8_LAS int*)((PG8_LAS unsigned char*)lds + LCNT_OFF); const int* cnt = (const int*)(p.ws + OFF_CNT);
    if (!build) return tb;
    if (threadIdx.x < 64) {
        const int e = threadIdx.x, c = (e < NE) ? __hip_atomic_load(cnt + e, __ATOMIC_RELAXED, __HIP_MEMORY_SCOPE_AGENT) : 0, nt = (c + 255) >> 8;
        int inc = nt;
#pragma unroll
        for (int o = 1; o < 64; o <<= 1) { const int v = __shfl_up(inc, o); if (e >= o) inc += v; }
        const int pst = inc - nt;
        if (e < NE) { tb[MT_CNT + e] = c; tb[MT_PST + e] = pst;
#pragma clang loop unroll(disable)
            for (int i = 0; i < nt; ++i) tb[MT_T2E + pst + i] = e; }
        if (e == NE) { tb[MT_PST + NE] = pst; tb[MT_NT] = pst; }
    }
    __syncthreads();
    return tb;
}
__device__ __forceinline__ void phase5(const Params& p, unsigned char* lds) {
    PG8_LAS int* lc = moe_tables_to_lds(p, lds, true);
    const Epi5 E{p.ws, lc};
    const int cx = moe_slot();
    const pg8::MoeOrder S{lc, 4, (int)gridDim.x, cx}; const pg8::AOffGather AO{p.ws, lc, D_ / 2};
    pg8::gemm_phase<Epi5, pg8::MoeOrder, pg8::AOffGather, true, 1>((PG8_LAS unsigned char*)lds, (const bf16_t*)(p.ws + OFF_H8), (const bf16_t*)(p.ws + OFF_WGU), D_ / 2, S, AO, E);
    { const int G = gridDim.x, c = cx, U = 4 * __builtin_amdgcn_readfirstlane(lc[MT_NT]), rem = U % G, idle = G - rem, NJ = N_TJOBS - N_TJOBS_GU;
      const int per = rem == 0 ? 0 : min(32, (NJ + idle - 1) / idle), early = min(NJ, idle * per);
      if (rem != 0 && c >= rem) run_tjobs(p, lds, N_TJOBS_GU, N_TJOBS_GU + early, 0, per, c - rem, idle);
      if (early < NJ) run_tjobs(p, lds, N_TJOBS_GU + early, N_TJOBS, 0, 1 << 20, c, G); }
}
__device__ __forceinline__ void phase6(const Params& p, unsigned char* lds) {
    PG8_LAS int* lc = moe_tables_to_lds(p, lds, DUP_PHASE == 6);
    const Epi6 E{p.ws, lc};
    const pg8::MoeOrder S{lc, 8, (int)gridDim.x, moe_slot()}; const pg8::AOffDirect AO{DE / 2};
    pg8::gemm_phase<Epi6, pg8::MoeOrder, pg8::AOffDirect, true, 1>((PG8_LAS unsigned char*)lds, (const bf16_t*)(p.ws + OFF_B), (const bf16_t*)(p.ws + OFF_WD), DE / 2, S, AO, E);
}
__device__ __forceinline__ void phase7(const Params& p) {
    const int tid = opaque_tid(), wid = tid >> 6, lane = tid & 63;
    const bf16_t* hb = (const bf16_t*)(p.ws + OFF_HB); const unsigned char* ys2 = p.ws + OFF_A;
    for (int t = blockIdx.x * 8 + wid; t < T_; t += gridDim.x * 8) {
        float v[4][8]; float s = 0.f;
#pragma unroll
        for (int i = 0; i < 4; ++i) { const int c = i * 512 + lane * 8;
            const u32x4 a = *(const u32x4*)(hb + (size_t)t * D_ + c); const u32x2 b = *(const u32x2*)(ys2 + (size_t)(2 * t) * D_ + c), d = *(const u32x2*)(ys2 + (size_t)(2 * t + 1) * D_ + c);
            float y0[8], y1[8];
            up4_fp8(b.x, y0[0], y0[1], y0[2], y0[3]); up4_fp8(b.y, y0[4], y0[5], y0[6], y0[7]); up4_fp8(d.x, y1[0], y1[1], y1[2], y1[3]); up4_fp8(d.y, y1[4], y1[5], y1[6], y1[7]);
#pragma unroll
            for (int q = 0; q < 4; ++q) { v[i][2 * q] = bflo(a[q]) + (y0[2 * q] + y1[2 * q]) * (1.f / YS_SCALE); v[i][2 * q + 1] = bfhi(a[q]) + (y0[2 * q + 1] + y1[2 * q + 1]) * (1.f / YS_SCALE);
                s += v[i][2 * q] * v[i][2 * q] + v[i][2 * q + 1] * v[i][2 * q + 1]; } }
        const float rstd = rsqrtf(wave_sum(s) * (1.f / D_) + EPS);
#pragma unroll
        for (int i = 0; i < 4; ++i) { const int c = i * 512 + lane * 8;
            const f32x4 g0 = *(const f32x4*)(p.g_final + c), g1 = *(const f32x4*)(p.g_final + c + 4);
            f32x4 o0, o1;
#pragma unroll
            for (int q = 0; q < 4; ++q) { o0[q] = v[i][q] * rstd * g0[q]; o1[q] = v[i][4 + q] * rstd * g1[q]; }
            *(f32x4*)(p.out + (size_t)t * D_ + c) = o0; *(f32x4*)(p.out + (size_t)t * D_ + c + 4) = o1; }
    }
}

__global__ void __launch_bounds__(NTHR, 2) k_mega(Params p) {
    extern __shared__ __attribute__((aligned(16))) unsigned char lds[];
    cg::grid_group grid = cg::this_grid();
    volatile PG8_LAS unsigned* bst = (volatile PG8_LAS unsigned*)((PG8_LAS unsigned char*)lds + LBAR_OFF);
    if (threadIdx.x < 2) bst[threadIdx.x] = 0u;
    __syncthreads();
    (void)xcd_barrier_post((unsigned*)(p.ws + OFF_BAR), bst);
#define GRID_BAR() do { XcdBarrier b_; b_.bar = (unsigned*)(opaque_ws(p.ws) + OFF_BAR); b_.x = xb_xcc_id(); b_.st = bst; xcd_barrier(b_); } while (0)
    if (DUP_PHASE == 0) { phase0(p, lds); GRID_BAR(); phase0b(p, lds); GRID_BAR(); }
    if (p.ws == nullptr) grid.sync();
    phase0(p, lds); GRID_BAR();
    phase0b(p, lds); GRID_BAR();
    if (DUP_PHASE == 1) { phase1(p, lds); GRID_BAR(); }
    phase1(p, lds); GRID_BAR();
    if (DUP_PHASE == 2) { phase2(p, lds, OFF_DUMMY - OFF_SSQ); GRID_BAR(); }
    phase2(p, lds); GRID_BAR();
    if (DUP_PHASE == 3) { phase3(p, lds, OFF_DUMMY - OFF_SSQ); GRID_BAR(); }
    phase3(p, lds); GRID_BAR();
    if (DUP_PHASE == 4) { phase4(p, lds, OFF_DUMMY - OFF_SSQ); GRID_BAR(); }
    phase4(p, lds); GRID_BAR();
    if (DUP_PHASE == 5) { phase5(p, lds); GRID_BAR(); }
    phase5(p, lds); GRID_BAR();
    if (DUP_PHASE == 6) { phase6(p, lds); GRID_BAR(); }
    phase6(p, lds); GRID_BAR();
    if (DUP_PHASE == 8) { for (int i = 0; i < 10; ++i) GRID_BAR(); }
    if (DUP_PHASE == 9) { grid.sync(); grid.sync(); }
    if (DUP_PHASE == 7) { phase7(p); GRID_BAR(); }
    phase7(p);
}

extern "C" void kernel_launch(void* const* d_in, const int* in_sizes, int n_in, void* d_out, int out_size, void* d_ws, size_t ws_size, hipStream_t stream) {
    static int grid = 0;
    if (grid == 0) {
        if (n_in != 19 || in_sizes[0] != T_ * D_ || out_size != T_ * D_ || ws_size < WS_END + (DUP_PHASE >= 2 && DUP_PHASE <= 4 ? DUMMY_BYTES : 0)) { fprintf(stderr, "kernel_launch: unexpected shapes (n_in %d, in0 %d, out %d, ws %zu < %zu); nothing launched\n", n_in, n_in > 0 ? in_sizes[0] : -1, out_size, ws_size, (size_t)WS_END); grid = -1; return; }
        int dev = 0, cus = 0, per_cu = 0;
        if (hipGetDevice(&dev) != hipSuccess || hipDeviceGetAttribute(&cus, hipDeviceAttributeMultiprocessorCount, dev) != hipSuccess) { grid = -1; return; }
        if (hipFuncSetAttribute((const void*)k_mega, hipFuncAttributeMaxDynamicSharedMemorySize, LDS_BYTES) != hipSuccess) { fprintf(stderr, "kernel_launch: hipFuncSetAttribute failed\n"); grid = -1; return; }
        if (hipOccupancyMaxActiveBlocksPerMultiprocessor(&per_cu, (const void*)k_mega, NTHR, LDS_BYTES) != hipSuccess || per_cu < 1) { fprintf(stderr, "kernel_launch: occupancy query says %d blocks per CU\n", per_cu); grid = -1; return; }
        grid = cus * per_cu;
    }
    if (grid < 0) return;
    Params p{};
    const float** f = (const float**)&p;
    for (int i = 0; i < 19; ++i) f[i] = (const float*)d_in[i];
    p.out = (float*)d_out; p.ws = (unsigned char*)d_ws;
    if (hipMemsetAsync((unsigned char*)d_ws + OFF_BAR, 0, BAR_BYTES, stream) != hipSuccess) { fprintf(stderr, "kernel_launch: memset of the barrier words failed\n"); return; }
    void* args[] = {&p};
    const hipError_t e = hipLaunchCooperativeKernel((const void*)k_mega, dim3(grid), dim3(NTHR), args, LDS_BYTES, stream);
    if (e != hipSuccess) fprintf(stderr, "kernel_launch: cooperative launch failed: %s (grid %d)\n", hipGetErrorString(e), grid);
}
```

```cpp
#include <hip/hip_runtime.h>
#include <hip/hip_cooperative_groups.h>
#include <cstdio>
namespace cg = cooperative_groups;

typedef unsigned short bf16_t;
typedef float f32x4 __attribute__((ext_vector_type(4)));
typedef unsigned u32x4 __attribute__((ext_vector_type(4)));
typedef unsigned u32x2 __attribute__((ext_vector_type(2)));
typedef short bf16x8 __attribute__((ext_vector_type(8)));
typedef int v4i __attribute__((ext_vector_type(4)));
typedef int v8i __attribute__((ext_vector_type(8)));

constexpr int T_ = 16384, D_ = 2048, DIN = 5120, DP = 4096, NE = 32, DE = 512, SEQ = 4096, LCAP = 16384;
constexpr float EPS = 1e-6f;
#ifndef DUP_PHASE
#define DUP_PHASE -1
#endif
constexpr int NTHR = 512;
constexpr int LDS_BYTES = 163840;
constexpr int LCNT_OFF = 131072, LBAR_OFF = 131072 + 2048, XS_OFF = 131072 + 4096, XM_OFF = XS_OFF + 8192, RS_OFF = XM_OFF;
constexpr int RS_UNITS = 4;
static_assert(XM_OFF + 512 * 32 <= LDS_BYTES && RS_UNITS * 256 * 8 <= 512 * 32, "LDS map");

constexpr size_t SZ_A = (size_t)T_ * DIN * 2;
constexpr size_t SZ_B = (size_t)T_ * D_ * 2;
constexpr size_t OFF_A = 0;
constexpr size_t OFF_B = OFF_A + SZ_A;
constexpr size_t OFF_HB = OFF_B + SZ_B;
constexpr size_t OFF_H8 = OFF_A + (size_t)2 * T_ * D_ * 2;
constexpr float WGU_SCALE = 32.f, WD_SCALE = 16.f, YS_SCALE = 16.f;
constexpr size_t OFF_WIN = OFF_HB + SZ_B;
constexpr size_t OFF_WOUT = OFF_WIN + (size_t)DIN * D_ * 2;
constexpr size_t OFF_WGU = OFF_WOUT + (size_t)D_ * D_ * 2;
constexpr size_t OFF_WD = OFF_WGU + (size_t)NE * 1024 * D_ * 2;
constexpr size_t OFF_WR = OFF_WD + (size_t)NE * D_ * DE * 2;
constexpr size_t OFF_WSB = OFF_WR + (size_t)48 * D_ * 2;
constexpr size_t OFF_SSQ = OFF_WSB + (size_t)8 * 128 * 128 * 2;
constexpr size_t OFF_CNT = OFF_SSQ + (size_t)3 * T_ * 4;
constexpr size_t OFF_RINFO = OFF_CNT + 256;
constexpr size_t OFF_RW = OFF_RINFO + (size_t)NE * LCAP * 4;
constexpr size_t OFF_BAR = OFF_RW + (size_t)NE * LCAP * 4;
constexpr size_t BAR_BYTES = 49152;
constexpr size_t OFF_CMAX = OFF_BAR + 16384;
constexpr size_t OFF_SX = OFF_BAR + BAR_BYTES;
constexpr size_t OFF_SW = OFF_SX + (size_t)T_ * 4;
constexpr size_t WS_END = OFF_SW + 32768;
constexpr size_t OFF_DUMMY = WS_END;
constexpr size_t DUMMY_BYTES = (OFF_BAR - OFF_SSQ);

struct Params {
    const float *x, *norm_mix_g, *w_in, *v_norm_g, *gmlp_ws, *gmlp_bs, *conv_w, *g_a, *g_b, *w_out, *g_ffn, *rgw, *rgb, *rew, *reb, *ewg, *ewu, *ewd, *g_final;
    float* out; unsigned char* ws;
};

__device__ __forceinline__ unsigned cvt_pk_bf16(float lo, float hi) { unsigned r; asm volatile("v_cvt_pk_bf16_f32 %0, %1, %2" : "=v"(r) : "v"(lo), "v"(hi)); return r; }
#define GAS __attribute__((address_space(1)))
typedef GAS unsigned char gbyte;
__device__ __forceinline__ gbyte* opaque_ws(unsigned char* w) { gbyte* g = (gbyte*)w; asm volatile("" : "+s"(g)); return g; }
__device__ __forceinline__ int opaque_tid() { int t = threadIdx.x; asm volatile("" : "+v"(t)); return t; }
__device__ __forceinline__ unsigned pk4_fp8(float a, float b, float c, float d) { int w = 0; w = __builtin_amdgcn_cvt_pk_fp8_f32(a, b, w, false); w = __builtin_amdgcn_cvt_pk_fp8_f32(c, d, w, true); return (unsigned)w; }
__device__ __forceinline__ void up4_fp8(unsigned w, float& a, float& b, float& c, float& d) {
    const auto lo = __builtin_amdgcn_cvt_pk_f32_fp8((int)w, false), hi = __builtin_amdgcn_cvt_pk_f32_fp8((int)w, true); a = lo[0]; b = lo[1]; c = hi[0]; d = hi[1]; }
__device__ __forceinline__ float bflo(unsigned w) { return __uint_as_float(w << 16); }
__device__ __forceinline__ float bfhi(unsigned w) { return __uint_as_float(w & 0xffff0000u); }
__device__ __forceinline__ float wave_sum(float v) {
#pragma unroll
    for (int o = 1; o < 64; o <<= 1) v += __shfl_xor(v, o);
    return v;
}
__device__ __forceinline__ float gelu_t(float x) {
    const float u = x * (0.7978845608f + 0.0356774081f * x * x);
    return x * __builtin_amdgcn_rcpf(1.f + __builtin_amdgcn_exp2f(-2.885390082f * u));
}
__device__ __forceinline__ f32x4 gelu_t4(f32x4 x) {
    const f32x4 u = x * (x * x * (-2.885390082f * 0.0356774081f) + (-2.885390082f * 0.7978845608f));
    f32x4 d;
#pragma unroll
    for (int j = 0; j < 4; ++j) d[j] = __builtin_amdgcn_exp2f(u[j]);
    d = d + 1.f;
#pragma unroll
    for (int j = 0; j < 4; ++j) d[j] = __builtin_amdgcn_rcpf(d[j]);
    return x * d;
}
__device__ __forceinline__ float silu_f(float x) { return x * __builtin_amdgcn_rcpf(1.f + __builtin_amdgcn_exp2f(-1.442695041f * x)); }

#define PG8_LAS __attribute__((address_space(3)))
struct Unit { int pm, pn, e, r0, pnl; };

constexpr int MT_CNT = 0, MT_PST = 32, MT_NT = 65, MT_T2E = 66, MT_WORDS = 66 + 192;
typedef const PG8_LAS int* lcnt_t;
__device__ __forceinline__ bool moe_unit(lcnt_t tb, int NT, int L, Unit& u) {
    const int pt = L / NT;
    if (pt >= __builtin_amdgcn_readfirstlane(tb[MT_NT])) return false;
    const int e = __builtin_amdgcn_readfirstlane(tb[MT_T2E + pt]), mt = pt - __builtin_amdgcn_readfirstlane(tb[MT_PST + e]), j = L - pt * NT;
    u.e = e; u.pm = pt; u.r0 = mt * 256; u.pnl = j; u.pn = e * NT + j; return true;
}

struct NoMeta {};
struct Meta8 { u32x4 lo, hi; };
struct Epi1 {
    static constexpr bool PERM = true, PERM2 = false, MIDSCALE = false;
    typedef Meta8 Meta;
    unsigned char* ws;
    __device__ __forceinline__ Meta meta_load(const Unit& u, int wr, int fr) const {
        const GAS unsigned* sx = (const GAS unsigned*)(opaque_ws(ws) + OFF_SX) + u.pm * 256 + wr * 64 + fr; Meta mt;
#pragma unroll
        for (int q = 0; q < 4; ++q) { mt.lo[q] = sx[q * 16]; mt.hi[q] = sx[128 + q * 16]; }
        return mt;
    }
    __device__ __forceinline__ void operator()(f32x4 (&acc)[2][2][4][2], const Unit& u, int wr, int wc, int fr, int fq, const Meta& mt) const {
        gbyte* w_ = opaque_ws(ws);
        GAS bf16_t* P = (GAS bf16_t*)(w_ + OFF_A);
        const GAS float* sw = (const GAS float*)(w_ + OFF_SW) + u.pn * 256 + wc * 32 + 8 * fq;
        f32x4 cs[2][2];
#pragma unroll
        for (int bj = 0; bj < 2; ++bj) { cs[bj][0] = *(const GAS f32x4*)(sw + bj * 128); cs[bj][1] = *(const GAS f32x4*)(sw + bj * 128 + 4); }
        if (u.pn >= 12) {
#pragma unroll
            for (int ai = 0; ai < 2; ++ai)
#pragma unroll
                for (int m = 0; m < 4; ++m) {
                    const int row = u.pm * 256 + ai * 128 + wr * 64 + m * 16 + fr; const float rs = __uint_as_float(ai ? mt.hi[m] : mt.lo[m]);
                    GAS bf16_t* rowp = P + (size_t)row * DP + 3072 + (u.pn - 12) * 128 + wc * 16 + 4 * fq;
#pragma unroll
                    for (int bj = 0; bj < 2; ++bj) { const f32x4 z = (acc[ai][bj][m][0] * cs[bj][0]) * (acc[ai][bj][m][1] * cs[bj][1]) * (rs * rs);
                        u32x2 w; w.x = cvt_pk_bf16(z[0], z[1]); w.y = cvt_pk_bf16(z[2], z[3]); *(GAS u32x2*)(rowp + bj * 64) = w; }
                }
            return;
        }
        const bool act = u.pn < 8;
#pragma unroll
        for (int ai = 0; ai < 2; ++ai)
#pragma unroll
            for (int m = 0; m < 4; ++m) {
                const int row = u.pm * 256 + ai * 128 + wr * 64 + m * 16 + fr; const float rs = __uint_as_float(ai ? mt.hi[m] : mt.lo[m]);
                GAS bf16_t* rowp = P + (size_t)row * DP + u.pn * 256 + wc * 32 + 8 * fq;
#pragma unroll
                for (int bj = 0; bj < 2; ++bj) {
                    f32x4 v0 = acc[ai][bj][m][0] * cs[bj][0] * rs, v1 = acc[ai][bj][m][1] * cs[bj][1] * rs;
                    if (act) { v0 = gelu_t4(v0); v1 = gelu_t4(v1); }
                    u32x4 w; w.x = cvt_pk_bf16(v0[0], v0[1]); w.y = cvt_pk_bf16(v0[2], v0[3]); w.z = cvt_pk_bf16(v1[0], v1[1]); w.w = cvt_pk_bf16(v1[2], v1[3]);
                    *(GAS u32x4*)(rowp + bj * 128) = w;
                }
            }
    }
};
struct Epi2 {
    static constexpr bool PERM = true, PERM2 = false, MIDSCALE = true;
    const float* x; unsigned char* ws; size_t so;
    const PG8_LAS float* rsl;
    __device__ __forceinline__ void midscale(f32x4 (&acc)[2][2][4][2], const Unit& u, int wr, int wc, int fr, int fq) const {
        const PG8_LAS float* pr = rsl + (u.e * 256 + wr * 64 + fr) * 2;
#pragma unroll
        for (int ai = 0; ai < 2; ++ai)
#pragma unroll
            for (int m = 0; m < 4; ++m) {
                const float s = pr[(ai * 128 + m * 16) * 2];
#pragma unroll
                for (int bj = 0; bj < 2; ++bj)
#pragma unroll
                    for (int n = 0; n < 2; ++n) acc[ai][bj][m][n] *= s;
            }
    }
    typedef NoMeta Meta;
    __device__ __forceinline__ Meta meta_load(const Unit&, int, int) const { return Meta{}; }
    __device__ __forceinline__ void operator()(f32x4 (&acc)[2][2][4][2], const Unit& u, int wr, int wc, int fr, int fq, const Meta&) const {
        gbyte* w_ = opaque_ws(ws);
        GAS bf16_t* hb = (GAS bf16_t*)(w_ + OFF_HB); gbyte* h8 = w_ + OFF_H8; float* ssq_h = (float*)(ws + OFF_SSQ + so) + 2 * T_;
#pragma unroll
        for (int ai = 0; ai < 2; ++ai)
#pragma unroll
            for (int m = 0; m < 4; ++m) {
                const int row = u.pm * 256 + ai * 128 + wr * 64 + m * 16 + fr;
                const float rb = rsl[(u.e * 256 + ai * 128 + wr * 64 + m * 16 + fr) * 2 + 1];
                const size_t off = (size_t)row * D_ + u.pn * 256 + wc * 32 + 8 * fq;
                float ss = 0.f;
#pragma unroll
                for (int bj = 0; bj < 2; ++bj) {
                    const f32x4 x0 = *(const f32x4*)(x + off + bj * 128), x1 = *(const f32x4*)(x + off + bj * 128 + 4);
                    const f32x4 h0 = x0 + acc[ai][bj][m][0] * rb, h1 = x1 + acc[ai][bj][m][1] * rb;
                    ss += (h0[0] * h0[0] + h0[1] * h0[1]) + (h0[2] * h0[2] + h0[3] * h0[3]) + (h1[0] * h1[0] + h1[1] * h1[1]) + (h1[2] * h1[2] + h1[3] * h1[3]);
                    u32x4 w; w.x = cvt_pk_bf16(h0[0], h0[1]); w.y = cvt_pk_bf16(h0[2], h0[3]); w.z = cvt_pk_bf16(h1[0], h1[1]); w.w = cvt_pk_bf16(h1[2], h1[3]);
                    *(GAS u32x4*)(hb + off + bj * 128) = w;
                    u32x2 w8; w8.x = pk4_fp8(h0[0], h0[1], h0[2], h0[3]); w8.y = pk4_fp8(h1[0], h1[1], h1[2], h1[3]);
                    *(GAS u32x2*)(h8 + off + bj * 128) = w8;
                }
                ss += __shfl_xor(ss, 16); ss += __shfl_xor(ss, 32);
                if (fq == 0) atomicAdd(ssq_h + row, ss);
                if (m == 3) asm volatile("" ::: "memory");
            }
    }
};
struct Epi5 {
    static constexpr bool PERM = true, PERM2 = false, MIDSCALE = false;
    typedef Meta8 Meta;
    unsigned char* ws; lcnt_t cnt;
    __device__ __forceinline__ Meta meta_load(const Unit& u, int wr, int fr) const {
        const GAS unsigned* rrs = (const GAS unsigned*)(opaque_ws(ws) + OFF_RW) + u.e * LCAP; const int ce = __builtin_amdgcn_readfirstlane(cnt[u.e]); Meta mt;
#pragma unroll
        for (int q = 0; q < 4; ++q) { const int i0 = u.r0 + wr * 64 + q * 16 + fr, i1 = i0 + 128;
            const unsigned a = rrs[min(i0, ce - 1)], b = rrs[min(i1, ce - 1)]; mt.lo[q] = (i0 < ce) ? a : 0u; mt.hi[q] = (i1 < ce) ? b : 0u; }
        return mt;
    }
    __device__ __forceinline__ void operator()(f32x4 (&acc)[2][2][4][2], const Unit& u, int wr, int wc, int fr, int fq, const Meta& mt) const {
        gbyte* hbuf = opaque_ws(ws) + OFF_B;
#pragma unroll
        for (int ai = 0; ai < 2; ++ai)
#pragma unroll
            for (int m = 0; m < 4; ++m) {
                const int r = ai * 128 + wr * 64 + m * 16 + fr;
                const float rs = __uint_as_float(ai ? mt.hi[m] : mt.lo[m]);
                float o[8];
#pragma unroll
                for (int n = 0; n < 2; ++n)
#pragma unroll
                    for (int j = 0; j < 4; ++j) o[4 * n + j] = silu_f(acc[ai][0][m][n][j] * rs) * (acc[ai][1][m][n][j] * rs);
                u32x2 w; w.x = pk4_fp8(o[0], o[1], o[2], o[3]); w.y = pk4_fp8(o[4], o[5], o[6], o[7]);
                *(GAS u32x2*)(hbuf + (size_t)(u.pm * 256 + r) * DE + u.pnl * 128 + wc * 32 + 8 * fq) = w;
                if (m & 1) asm volatile("" ::: "memory");
            }
    }
};
struct Epi6 {
    static constexpr bool PERM = true, PERM2 = true, MIDSCALE = false;
    typedef Meta8 Meta;
    unsigned char* ws; lcnt_t cnt;
    __device__ __forceinline__ Meta meta_load(const Unit& u, int wr, int fr) const {
        const GAS unsigned* rpk = (const GAS unsigned*)(opaque_ws(ws) + OFF_RINFO) + u.e * LCAP; const int ce = __builtin_amdgcn_readfirstlane(cnt[u.e]); Meta mt;
#pragma unroll
        for (int q = 0; q < 4; ++q) { const int i0 = u.r0 + wr * 64 + q * 16 + fr, i1 = i0 + 128;
            const unsigned a = rpk[min(i0, ce - 1)], b = rpk[min(i1, ce - 1)]; mt.lo[q] = (i0 < ce) ? a : 0xFFFFFFFFu; mt.hi[q] = (i1 < ce) ? b : 0xFFFFFFFFu; }
        return mt;
    }
    __device__ __forceinline__ void operator()(f32x4 (&acc)[2][2][4][2], const Unit& u, int wr, int wc, int fr, int fq, const Meta& mt) const {
        gbyte* ys2 = opaque_ws(ws) + OFF_A;
#pragma unroll
        for (int ai = 0; ai < 2; ++ai)
#pragma unroll
            for (int m = 0; m < 4; ++m) {
                const unsigned pk = ai ? mt.hi[m] : mt.lo[m]; const unsigned info = pk & 0xFFFFu;
                if (info < 2u * T_) {
                    const float g = __uint_as_float(pk & 0xFFFF0000u) * (YS_SCALE / WD_SCALE);
                    gbyte* dst = ys2 + (size_t)info * D_ + u.pnl * 256 + wc * 64 + 16 * fq;
                    const f32x4 v0 = acc[ai][0][m][0] * g, v1 = acc[ai][0][m][1] * g, v2 = acc[ai][1][m][0] * g, v3 = acc[ai][1][m][1] * g;
                    u32x4 w; w.x = pk4_fp8(v0[0], v0[1], v0[2], v0[3]); w.y = pk4_fp8(v1[0], v1[1], v1[2], v1[3]); w.z = pk4_fp8(v2[0], v2[1], v2[2], v2[3]); w.w = pk4_fp8(v3[0], v3[1], v3[2], v3[3]);
                    *(GAS u32x4*)dst = w;
                }
            }
    }
};

namespace pg8 {
constexpr int BM = 256, BK = 64, HALF = 128, HTB = HALF * BK * 2, STAGE_BYTES = 8 * HTB, NXCD = 8, WGM = 8;
__host__ __device__ __forceinline__ int lds_byte(int r, int c) { const int st = (r >> 4) * 2 + (c >> 5), rr = r & 15, cc = c & 31, ob = rr * 64 + cc * 2; return st * 1024 + (ob ^ (((ob >> 9) & 1) << 5)); }
__host__ __device__ __forceinline__ void stage_rc(int b, int& R, int& C) { const int st = b / 1024, sb = b % 1024, swz = sb ^ (((sb >> 9) & 1) << 5); R = (st >> 1) * 16 + swz / 64; C = (st & 1) * 32 + (swz % 64) / 2; }
__host__ __device__ __forceinline__ int perm32(int rho) { const int n = rho >> 4, i = rho & 15; return 8 * (i >> 2) + 4 * n + (i & 3); }

struct StaticOrder {
    int nM, nN, nwg, G, c, i0, i1;
    __device__ void init(int M, int N, int G_, int c_) { nM = M / BM; nN = N / BM; nwg = nM * nN; G = G_; c = c_; i0 = 0; i1 = 1 << 30; }
    __device__ int count() const { return (nwg - c + G - 1) / G; }
    __device__ bool next(int ii, Unit& u) const {
        const int i = ii + i0; if (i >= i1) return false;
        const long L = (long)i * G + c; if (L >= nwg) return false;
        int wgid = (int)L; { const int q = nwg / NXCD, r = nwg % NXCD, xcd = wgid % NXCD, off = wgid / NXCD; wgid = (xcd < r ? xcd * (q + 1) : r * (q + 1) + (xcd - r) * q) + off; }
        const int nig = WGM * nN, gid = wgid / nig, fm = gid * WGM, gsz = (nM - fm) < WGM ? (nM - fm) : WGM;
        u.pm = fm + ((wgid % nig) % gsz); u.pn = (wgid % nig) / gsz; u.e = i; u.r0 = 0; u.pnl = u.pn; return true;
    }
};
struct MoeOrder {
    lcnt_t cnt; int NT, G, c;
    __device__ __forceinline__ bool next(int i, Unit& u) const { return moe_unit(cnt, NT, i * G + c, u); }
};
struct AOffDirect { int K; struct Pre {};
    __device__ __forceinline__ Pre pre(const Unit&, int, int) const { return Pre{}; }
    __device__ __forceinline__ unsigned fin(const Pre&, const Unit& u, int h, int i, int R, int C) const { return (unsigned)(((u.pm * 256 + h * 128 + R) * K + C) * 2); } };
struct AOffGather { unsigned char* ws; lcnt_t cnt; int K;
    struct Pre { unsigned pk[2][2]; };
    __device__ __forceinline__ Pre pre(const Unit& u, int R0, int R1) const {
        const GAS unsigned* rpk = (const GAS unsigned*)(opaque_ws(ws) + OFF_RINFO) + u.e * LCAP; const int ce = __builtin_amdgcn_readfirstlane(cnt[u.e]); Pre p;
#pragma unroll
        for (int h = 0; h < 2; ++h) { const int i0 = u.r0 + h * 128 + R0, i1 = u.r0 + h * 128 + R1;
            p.pk[h][0] = rpk[min(i0, ce - 1)]; p.pk[h][1] = rpk[min(i1, ce - 1)]; }
        return p;
    }
    __device__ __forceinline__ unsigned fin(const Pre& p, const Unit&, int h, int i, int, int C) const { const int tok = (int)((p.pk[h][i] & 0xFFFFu) >> 1); return (unsigned)((tok * K + C) * 2); } };

template <class Epi, class Sched, class AOff, bool ALIGN_EPI, int QM = 0>
__device__ __forceinline__ void gemm_phase(PG8_LAS unsigned char* lds, const bf16_t* Ag, const bf16_t* Btg, const int K, const Sched& S, const AOff& AO, const Epi& E) {
    const int tid = opaque_tid(), wid = __builtin_amdgcn_readfirstlane(tid >> 6), lane = tid & 63, wr = wid >> 2, wc = wid & 3, fr = lane & 15, fq = lane >> 4;
    int nt = K / BK; asm volatile("" : "+s"(nt));
    unsigned voffB[2];
#pragma unroll
    for (int i = 0; i < 2; ++i) { int R, C; stage_rc(tid * 16 + i * 8192, R, C);
        const int Rb = Epi::PERM2 ? (64 * (R >> 5) + 16 * ((R >> 2) & 3) + 4 * ((R >> 4) & 1) + (R & 3)) : Epi::PERM ? ((R & ~31) + perm32(R & 31)) : R; voffB[i] = (unsigned)(Rb * K + C) * 2u; }
#define PG8_APRE(u, pv_) do { int _t = tid; asm volatile("" : "+v"(_t)); int _R0, _R1, _C; stage_rc(_t * 16, _R0, _C); stage_rc(_t * 16 + 8192, _R1, _C); pv_ = AO.pre(u, _R0, _R1); } while (0)
#define PG8_AFIN(u, pv_, d0, d1) do { int _t = tid; asm volatile("" : "+v"(_t)); _Pragma("unroll") for (int _i = 0; _i < 2; ++_i) { int _R, _C; stage_rc(_t * 16 + _i * 8192, _R, _C); d0[_i] = AO.fin(pv_, u, 0, _i, _R, _C); d1[_i] = AO.fin(pv_, u, 1, _i, _R, _C); } } while (0)
#define PG8_LANE(fr_, fq_) int fr_, fq_; { int _t = tid; asm volatile("" : "+v"(_t)); fr_ = _t & 15; fq_ = (_t & 63) >> 4; }
    const unsigned kstep = (unsigned)(BK * 2), tstep = 2u * (unsigned)HALF * (unsigned)K * 2u, hstep = Epi::PERM2 ? 8u * (unsigned)K * 2u : tstep / 2u;
    const unsigned ldsw = (unsigned)wid * 1024u;
    const int aoff = lds_byte(wr * 64 + fr, fq * 8), boff = lds_byte(wc * 32 + fr, fq * 8);
    const char* const Ab = (const char*)Ag; const char* const Bb = (const char*)Btg;
#define PG8_SA(b, h) (((b) * 2 + (h)) * HTB)
#define PG8_SB(b, h) ((4 + (b) * 2 + (h)) * HTB)
#define PG8_STAGE(bufoff, gbase, uoff, voff) do { _Pragma("unroll") for (int _i = 0; _i < 2; ++_i) \
        __builtin_amdgcn_global_load_lds((const unsigned*)((gbase) + (size_t)(unsigned)((uoff) + (voff)[_i])), (PG8_LAS unsigned*)(lds + (bufoff) + ldsw + _i * 8192), 16, 0, 0); } while (0)
#define PG8_LD32(base) __builtin_shufflevector(*(const PG8_LAS v4i*)(base), *(const PG8_LAS v4i*)((base) + 1024), 0, 1, 2, 3, 4, 5, 6, 7)
#define PG8_LDA(dst, b, h) do { _Pragma("unroll") for (int m = 0; m < 4; ++m) dst[m] = PG8_LD32(lds + PG8_SA(b, h) + aoff + m * 2048); } while (0)
#define PG8_LDB(dst, b, h) do { _Pragma("unroll") for (int n = 0; n < 2; ++n) dst[n] = PG8_LD32(lds + PG8_SB(b, h) + boff + n * 2048); } while (0)
#define PG8_LO(x) __builtin_bit_cast(bf16x8, __builtin_shufflevector((x), (x), 0, 1, 2, 3))
#define PG8_HI(x) __builtin_bit_cast(bf16x8, __builtin_shufflevector((x), (x), 4, 5, 6, 7))
#define PG8_LOI(x) __builtin_shufflevector((x), (x), 0, 1, 2, 3)
#define PG8_HII(x) __builtin_shufflevector((x), (x), 4, 5, 6, 7)
#define PG8_MMA(ai, bj, At, Bt) do { __builtin_amdgcn_s_setprio(1); _Pragma("unroll") for (int m = 0; m < 4; ++m) _Pragma("unroll") for (int n = 0; n < 2; ++n) { \
        if constexpr (QM == 1) acc[ai][bj][m][n] = __builtin_amdgcn_mfma_scale_f32_16x16x128_f8f6f4(Bt[n], At[m], acc[ai][bj][m][n], 0, 0, 0, 0, 0, 0);   \
        else if constexpr (QM == 2) { v4i c_ = __builtin_bit_cast(v4i, acc[ai][bj][m][n]); c_ = __builtin_amdgcn_mfma_i32_16x16x64_i8(PG8_LOI(Bt[n]), PG8_LOI(At[m]), c_, 0, 0, 0); \
               c_ = __builtin_amdgcn_mfma_i32_16x16x64_i8(PG8_HII(Bt[n]), PG8_HII(At[m]), c_, 0, 0, 0); acc[ai][bj][m][n] = __builtin_bit_cast(f32x4, c_); } \
        else { acc[ai][bj][m][n] = __builtin_amdgcn_mfma_f32_16x16x32_bf16(PG8_LO(Bt[n]), PG8_LO(At[m]), acc[ai][bj][m][n], 0, 0, 0); \
               acc[ai][bj][m][n] = __builtin_amdgcn_mfma_f32_16x16x32_bf16(PG8_HI(Bt[n]), PG8_HI(At[m]), acc[ai][bj][m][n], 0, 0, 0); } } \
        __builtin_amdgcn_s_setprio(0); } while (0)
#define PG8_WAIT_V(n) asm volatile("s_waitcnt vmcnt(" #n ")" ::: "memory")
#define PG8_WAIT_L(n) asm volatile("s_waitcnt lgkmcnt(" #n ")" ::: "memory")
#define PG8_BAR __builtin_amdgcn_s_barrier()
#define PG8_SCHED __builtin_amdgcn_sched_barrier(0)
    Unit cur, nxt; int ui = 0;
    if (!S.next(0, cur)) return;
    f32x4 acc[2][2][4][2];
#pragma unroll
    for (int a = 0; a < 2; ++a)
#pragma unroll
        for (int b = 0; b < 2; ++b)
#pragma unroll
            for (int m = 0; m < 4; ++m)
#pragma unroll
                for (int n = 0; n < 2; ++n) acc[a][b][m][n] = (f32x4){0.f, 0.f, 0.f, 0.f};
    v8i At[4], B0[2], B1[2];
    unsigned vo0[2], vo1[2];
    PG8_LAS u32x4* const svn = (PG8_LAS u32x4*)(lds + XS_OFF) + tid;
    PG8_LAS u32x4* const smeta = (PG8_LAS u32x4*)(lds + XM_OFF + tid * 32);
    constexpr bool HAS_META = sizeof(typename Epi::Meta) > 1;
    bool has_next = S.next(1, nxt);
    { typename AOff::Pre pc; PG8_APRE(cur, pc); PG8_AFIN(cur, pc, vo0, vo1);
      unsigned vn0[2], vn1[2];
      if (has_next) { typename AOff::Pre pn; PG8_APRE(nxt, pn); PG8_AFIN(nxt, pn, vn0, vn1); } else { vn0[0] = vo0[0]; vn0[1] = vo0[1]; vn1[0] = vo1[0]; vn1[1] = vo1[1]; }
      *svn = (u32x4){vn0[0], vn0[1], vn1[0], vn1[1]}; }
    if constexpr (HAS_META) { PG8_LANE(fr_, fq_); (void)fq_; const typename Epi::Meta m0 = E.meta_load(cur, wr, fr_); smeta[0] = m0.lo; smeta[1] = m0.hi; }
    unsigned cB = (unsigned)cur.pn * tstep;
    PG8_STAGE(PG8_SB(0, 0), Bb, cB, voffB); PG8_STAGE(PG8_SB(0, 1), Bb, cB + hstep, voffB); PG8_STAGE(PG8_SA(0, 0), Ab, 0u, vo0); PG8_STAGE(PG8_SA(0, 1), Ab, 0u, vo1);
    if (wr == 1) PG8_BAR;
    PG8_WAIT_V(2); PG8_BAR;
    PG8_STAGE(PG8_SB(1, 0), Bb, cB + kstep, voffB); PG8_STAGE(PG8_SA(1, 0), Ab, kstep, vo0); PG8_STAGE(PG8_SB(1, 1), Bb, cB + hstep + kstep, voffB);
    PG8_WAIT_V(6); PG8_BAR;
    for (;;) {
        const unsigned nB = has_next ? (unsigned)nxt.pn * tstep : cB;
#pragma clang loop unroll(disable)
        for (int t = 0; t < nt; t += 2) {
            const bool last = (t == nt - 2);
            if constexpr (Epi::MIDSCALE) { if (t == nt / 2) { PG8_LANE(fr_, fq_); E.midscale(acc, cur, wr, wc, fr_, fq_); } }
            const unsigned k1 = (unsigned)(t + 1) * kstep, k2 = last ? 0u : (unsigned)(t + 2) * kstep, k3 = k2 + kstep;
            const unsigned b2 = last ? nB : cB + (unsigned)(t + 2) * kstep, b3 = b2 + kstep;
            PG8_LDB(B0, 0, 0); PG8_LDB(B1, 0, 1); PG8_SCHED; PG8_LDA(At, 0, 0); PG8_STAGE(PG8_SA(1, 1), Ab, k1, vo1);
            PG8_WAIT_V(8); PG8_WAIT_L(0); PG8_BAR; PG8_MMA(0, 0, At, B0); PG8_MMA(0, 1, At, B1); PG8_BAR; PG8_SCHED;
            if (last) { PG8_LAS u32x4* sp_ = svn; asm volatile("" : "+v"(sp_));
                const u32x4 v = *sp_; vo0[0] = v.x; vo0[1] = v.y; vo1[0] = v.z; vo1[1] = v.w; }
            PG8_LDA(At, 0, 1); PG8_STAGE(PG8_SB(0, 0), Bb, b2, voffB); PG8_STAGE(PG8_SB(0, 1), Bb, b2 + hstep, voffB); PG8_STAGE(PG8_SA(0, 0), Ab, k2, vo0);
            PG8_WAIT_V(8); PG8_WAIT_L(0); PG8_BAR; PG8_MMA(1, 0, At, B0); PG8_MMA(1, 1, At, B1); PG8_BAR; PG8_SCHED;
            PG8_LDB(B0, 1, 0); PG8_LDB(B1, 1, 1); PG8_SCHED; PG8_LDA(At, 1, 0); PG8_STAGE(PG8_SA(0, 1), Ab, k2, vo1);
            PG8_WAIT_V(8); PG8_WAIT_L(0); PG8_BAR; PG8_MMA(0, 0, At, B0); PG8_MMA(0, 1, At, B1); PG8_BAR; PG8_SCHED;
            PG8_LDA(At, 1, 1); PG8_STAGE(PG8_SB(1, 0), Bb, b3, voffB); PG8_STAGE(PG8_SB(1, 1), Bb, b3 + hstep, voffB); PG8_STAGE(PG8_SA(1, 0), Ab, k3, vo0);
            PG8_WAIT_V(8); PG8_WAIT_L(0); PG8_BAR; PG8_MMA(1, 0, At, B0); PG8_MMA(1, 1, At, B1); PG8_BAR; PG8_SCHED;
        }
        if constexpr (ALIGN_EPI) { if (wr == 0) PG8_BAR; }
        Unit nn; const bool has2 = has_next && S.next(ui + 2, nn);
        typename Epi::Meta mnext;
        { PG8_LANE(fr_, fq_);
          typename Epi::Meta meta; if constexpr (HAS_META) { PG8_LAS u32x4* sp_ = smeta; asm volatile("" : "+v"(sp_)); meta.lo = sp_[0]; meta.hi = sp_[1]; }
          if (has_next) mnext = E.meta_load(nxt, wr, fr_);
          if (has2) { typename AOff::Pre pnn; PG8_APRE(nn, pnn); unsigned vn0[2], vn1[2]; PG8_AFIN(nn, pnn, vn0, vn1); *svn = (u32x4){vn0[0], vn0[1], vn1[0], vn1[1]}; }
          if constexpr (QM == 2) {
#pragma unroll
              for (int a = 0; a < 2; ++a)
#pragma unroll
                  for (int b = 0; b < 2; ++b)
#pragma unroll
                      for (int m = 0; m < 4; ++m)
#pragma unroll
                          for (int n = 0; n < 2; ++n) { const v4i c_ = __builtin_bit_cast(v4i, acc[a][b][m][n]); acc[a][b][m][n] = (f32x4){(float)c_[0], (float)c_[1], (float)c_[2], (float)c_[3]}; } }
          E(acc, cur, wr, wc, fr_, fq_, meta); }
        if (!has_next) break;
        if constexpr (HAS_META) { smeta[0] = mnext.lo; smeta[1] = mnext.hi; }
#pragma unroll
        for (int a = 0; a < 2; ++a)
#pragma unroll
            for (int b = 0; b < 2; ++b)
#pragma unroll
                for (int m = 0; m < 4; ++m)
#pragma unroll
                    for (int n = 0; n < 2; ++n) acc[a][b][m][n] = (f32x4){0.f, 0.f, 0.f, 0.f};
        cur = nxt; nxt = nn; has_next = has2; cB = nB; ++ui;
        if constexpr (ALIGN_EPI) { if (wr == 1) PG8_BAR; }
    }
    PG8_WAIT_V(0);
    if constexpr (!ALIGN_EPI) { if (wr == 0) PG8_BAR; }
    PG8_BAR;
#undef PG8_APRE
#undef PG8_AFIN
#undef PG8_LANE
#undef PG8_SA
#undef PG8_SB
#undef PG8_STAGE
#undef PG8_LDA
#undef PG8_LDB
#undef PG8_MMA
#undef PG8_LO
#undef PG8_HI
#undef PG8_LOI
#undef PG8_HII
#undef PG8_LD32
#undef PG8_WAIT_V
#undef PG8_WAIT_L
#undef PG8_BAR
#undef PG8_SCHED
}
}


#define XB_TMO      128
#define XB_XCNT(j)  (256  + 64 * (j))
#define XB_XSUB(j)  (1280 + 64 * (j))
#define XB_XGEN(j)  (2304 + 64 * (j))
#define XB_TOP      3328
#define XB_TOPGEN   3392
#define XCD_BAR_WORDS 3456
#define XB_SPIN_CAP (1u << 18)
__device__ __forceinline__ unsigned xb_ld(unsigned* p)              { return __hip_atomic_load(p, __ATOMIC_RELAXED, __HIP_MEMORY_SCOPE_AGENT); }
__device__ __forceinline__ unsigned xb_add(unsigned* p, unsigned v) { return __hip_atomic_fetch_add(p, v, __ATOMIC_RELAXED, __HIP_MEMORY_SCOPE_AGENT); }
__device__ __forceinline__ unsigned xb_xcc_id() { return (unsigned)__builtin_amdgcn_s_getreg((3 << 11) | 20) & 0xFu; }
#define XB_SPIN(cond, bar) do { unsigned _sp = 0; while (cond) { __builtin_amdgcn_s_sleep(1); \
    if ((++_sp & 255u) == 0u) { if (xb_ld(&(bar)[XB_TMO])) break; if (_sp > XB_SPIN_CAP) { atomicAdd(&(bar)[XB_TMO], 1u); break; } } } } while (0)
struct XcdBarrier { unsigned* bar; unsigned x; volatile PG8_LAS unsigned* st; };
__device__ __forceinline__ XcdBarrier xcd_barrier_post(unsigned* bar, volatile PG8_LAS unsigned* st) {
    XcdBarrier b; b.bar = bar; b.x = xb_xcc_id(); b.st = st;
    if (threadIdx.x == 0) (void)xb_add(&bar[XB_XCNT(b.x)], 1u);
    return b;
}
__device__ __forceinline__ void xcd_barrier_complete(unsigned* bar, unsigned x, unsigned& nloc, unsigned& nx) {
    const unsigned G = gridDim.x * gridDim.y * gridDim.z;
    unsigned sum, cnt, mine, sp = 0u;
    for (;;) {
        sum = 0u; cnt = 0u; mine = 0u;
#pragma unroll
        for (unsigned j = 0; j < 16; ++j) { const unsigned c = xb_ld(&bar[XB_XCNT(j)]); sum += c; cnt += (c > 0u) ? 1u : 0u; mine = (j == x) ? c : mine; }
        if (sum == G) break;
        __builtin_amdgcn_s_sleep(1);
        if ((++sp & 255u) == 0u) { if (xb_ld(&bar[XB_TMO])) break; if (sp > XB_SPIN_CAP) { atomicAdd(&bar[XB_TMO], 1u); break; } }
    }
    nloc = mine > 0u ? mine : 1u; nx = cnt > 0u ? cnt : 1u;
}
__device__ __forceinline__ void xcd_barrier(const XcdBarrier& b) {
    asm volatile("s_waitcnt vmcnt(0)" ::: "memory");
    __syncthreads();
    if (threadIdx.x == 0) {
        unsigned* bar = b.bar;
        __builtin_amdgcn_s_waitcnt(0);
        unsigned nloc = b.st[0], nx = b.st[1];
        if (nloc == 0u) { xcd_barrier_complete(bar, b.x, nloc, nx); b.st[0] = nloc; b.st[1] = nx; }
        const unsigned old = xb_add(&bar[XB_XSUB(b.x)], 1u);
        const unsigned gen = old / nloc;
        if (old + 1u == (gen + 1u) * nloc) {
            __builtin_amdgcn_fence(__ATOMIC_RELEASE, "agent");
            asm volatile("s_waitcnt vmcnt(0)" ::: "memory");
            const unsigned og = xb_add(&bar[XB_TOP], 1u);
            const unsigned tg = og / nx;
            if (og + 1u == (tg + 1u) * nx) xb_add(&bar[XB_TOPGEN], 1u);
            else XB_SPIN(xb_ld(&bar[XB_TOPGEN]) == tg, bar);
            __builtin_amdgcn_fence(__ATOMIC_ACQUIRE, "agent");
            xb_add(&bar[XB_XGEN(b.x)], 1u);
            asm volatile("s_waitcnt vmcnt(0)" ::: "memory");
        } else {
            XB_SPIN(xb_ld(&bar[XB_XGEN(b.x)]) == gen, bar);
            __builtin_amdgcn_fence(__ATOMIC_ACQUIRE, "agent");
            asm volatile("s_waitcnt vmcnt(0)" ::: "memory");
        }
    }
    __syncthreads();
}

struct TJob { const float* src; int ld; unsigned char* dst; int lddst; float sc; const float* sk; int fp8; int rmap; int row0; int tr0; const unsigned* sk2; float* swp; };
__device__ __forceinline__ bool tjob_decode(const Params& p, int q, TJob& j, int w_in_kind = 3) {
    j.rmap = 0; j.row0 = 0; j.tr0 = 0; j.sk2 = (const unsigned*)(p.ws + OFF_CMAX); j.swp = (float*)(p.ws + OFF_SW); j.sk = nullptr; j.sc = 1.f; j.fp8 = 0;
    constexpr int N_IN = 16 * 80, N_OUT = 16 * 32, N_G = 32 * 128;
    if (q < N_IN) { const int tr = q / 80, tc = q % 80; j.src = p.w_in + (size_t)tr * 128 * DIN + tc * 64; j.ld = DIN; j.sc = 1.f; j.sk = nullptr; j.fp8 = w_in_kind; j.lddst = D_; j.rmap = 0;
        if (tc < 48) { j.row0 = tc * 64; }
        else { const int hsel = tc >= 64, ch0 = (tc - (hsel ? 64 : 48)) * 64; j.rmap = 1 + hsel; j.row0 = 3072 + 256 * (ch0 >> 7) + 2 * (ch0 & 127); }
        j.dst = p.ws + OFF_WIN + (size_t)j.row0 * D_ + tr * 128; j.sk2 = (const unsigned*)(p.ws + OFF_CMAX); j.swp = (float*)(p.ws + OFF_SW); j.tr0 = (tr == 0);
        return true; } q -= N_IN;
    if (q < N_OUT) { const int tr = q / 32, tc = q % 32; j.src = p.w_out + (size_t)tr * 128 * D_ + tc * 64; j.ld = D_; j.dst = p.ws + OFF_WOUT + ((size_t)tc * 64 * D_ + tr * 128) * 2; j.lddst = D_ * 2; j.sc = 1.f;
        j.sk = (tr < 8 ? p.g_a + tr * 128 : p.g_b + (tr - 8) * 128); j.fp8 = 0; j.rmap = 0; return true; } q -= N_OUT;
    if (q < 2 * N_G) { const int up = q >= N_G; if (up) q -= N_G; const int e = q >> 7, rem = q & 127, tr = rem >> 3, tc = rem & 7, c0 = tc * 64;
        j.src = (up ? p.ewu : p.ewg) + (size_t)e * D_ * DE + (size_t)tr * 128 * DE + c0; j.ld = DE;
        j.dst = p.ws + OFF_WGU + (size_t)e * 1024 * D_ + (size_t)((c0 >> 7) * 256 + (up ? 128 : 0) + (c0 & 127)) * D_ + tr * 128; j.lddst = D_; j.sc = WGU_SCALE; j.sk = p.g_ffn + tr * 128; j.fp8 = 1; j.rmap = 0; return true; } q -= 2 * N_G;
    if (q < N_G) { const int e = q >> 7, rem = q & 127, tr = rem >> 5, tc = rem & 31;
        j.src = p.ewd + (size_t)e * DE * D_ + (size_t)tr * 128 * D_ + tc * 64; j.ld = D_; j.dst = p.ws + OFF_WD + (size_t)e * D_ * DE + (size_t)tc * 64 * DE + tr * 128; j.lddst = DE; j.sc = WD_SCALE; j.sk = nullptr; j.fp8 = 1; j.rmap = 0; return true; }
    return false;
}
constexpr int N_TJOBS_IN = 16 * 80, N_TJOBS_DENSE = 16 * 80 + 16 * 32, N_TJOBS_GU = N_TJOBS_DENSE + 2 * 32 * 128, N_TJOBS = N_TJOBS_GU + 32 * 128;
__device__ __forceinline__ void tjob_stage(const TJob& j, int tid, unsigned char* lds, int b) {
    PG8_LAS unsigned char* L = (PG8_LAS unsigned char*)lds + b * 32768 + __builtin_amdgcn_readfirstlane(tid >> 6) * 1024;
#pragma unroll
    for (int i = 0; i < 4; ++i) { const int k = i * 32 + (tid >> 4), pn = (tid & 15) ^ ((k >> 4) & 7);
        __builtin_amdgcn_global_load_lds((const unsigned*)(j.src + (size_t)k * j.ld + 4 * pn), (PG8_LAS unsigned*)(L + i * 8192), 16, 0, 2); }
    const float* aux = (j.fp8 == 3) ? (const float*)(j.sk2 + j.row0) : (j.sk ? j.sk : j.src);
    __builtin_amdgcn_global_load_lds((const unsigned*)(aux + (tid & 31) * 4), (PG8_LAS unsigned*)((PG8_LAS unsigned char*)lds + XS_OFF + b * 1024), 16, 0, 0);
}
__device__ __forceinline__ void tjob_finish(const TJob& j, int tid, unsigned char* lds, int b) {
    const int c = tid >> 3, kb = tid & 7, rr = kb * 16; float v[16];
    { const PG8_LAS float* lt = (const PG8_LAS float*)((PG8_LAS unsigned char*)lds + b * 32768) + rr * 64 + 4 * ((c >> 2) ^ kb) + (c & 3);
#pragma unroll
      for (int q = 0; q < 16; ++q) v[q] = lt[q * 64]; }
    const PG8_LAS float* ax = (const PG8_LAS float*)((PG8_LAS unsigned char*)lds + XS_OFF + b * 1024);
    if (j.sk) {
#pragma unroll
        for (int q4 = 0; q4 < 4; ++q4) { const f32x4 f = *(const PG8_LAS f32x4*)(ax + rr + 4 * q4);
#pragma unroll
            for (int e = 0; e < 4; ++e) v[4 * q4 + e] *= j.sc * f[e]; } }
    else {
#pragma unroll
        for (int q = 0; q < 16; ++q) v[q] *= j.sc; }
    const int drow = j.rmap ? 8 * (c >> 2) + 4 * (j.rmap - 1) + (c & 3) : c;
    unsigned char* d = j.dst + (size_t)drow * j.lddst;
    if (j.fp8 == 2) {
        float am = 0.f;
#pragma unroll
        for (int q = 0; q < 16; ++q) am = fmaxf(am, fabsf(v[q]));
        am = fmaxf(am, __shfl_xor(am, 1)); am = fmaxf(am, __shfl_xor(am, 2)); am = fmaxf(am, __shfl_xor(am, 4));
        if ((tid & 7) == 0) atomicMax((unsigned*)(j.sk2) + j.row0 + drow, __float_as_uint(am)); }
    else if (j.fp8 == 3) {
        const float am = fmaxf(ax[drow], 1e-30f), qi = 127.f / am;
        unsigned w[4];
#pragma unroll
        for (int q = 0; q < 4; ++q) { const int a = (int)rintf(v[4 * q] * qi), b2 = (int)rintf(v[4 * q + 1] * qi), c2 = (int)rintf(v[4 * q + 2] * qi), d2 = (int)rintf(v[4 * q + 3] * qi);
            w[q] = (unsigned)(a & 255) | ((unsigned)(b2 & 255) << 8) | ((unsigned)(c2 & 255) << 16) | ((unsigned)(d2 & 255) << 24); }
        *(u32x4*)(d + rr) = (u32x4){w[0], w[1], w[2], w[3]};
        if (rr == 0 && j.tr0) j.swp[j.row0 + drow] = am * (1.f / 127.f); }
    else if (j.fp8) { u32x4 w; w.x = pk4_fp8(v[0], v[1], v[2], v[3]); w.y = pk4_fp8(v[4], v[5], v[6], v[7]); w.z = pk4_fp8(v[8], v[9], v[10], v[11]); w.w = pk4_fp8(v[12], v[13], v[14], v[15]);
        *(u32x4*)(d + rr) = w; }
    else { u32x4 w0, w1; w0.x = cvt_pk_bf16(v[0], v[1]); w0.y = cvt_pk_bf16(v[2], v[3]); w0.z = cvt_pk_bf16(v[4], v[5]); w0.w = cvt_pk_bf16(v[6], v[7]);
        w1.x = cvt_pk_bf16(v[8], v[9]); w1.y = cvt_pk_bf16(v[10], v[11]); w1.z = cvt_pk_bf16(v[12], v[13]); w1.w = cvt_pk_bf16(v[14], v[15]);
        *(u32x4*)(d + rr * 2) = w0; *(u32x4*)(d + rr * 2 + 16) = w1; }
}
__device__ __forceinline__ void run_tjobs(const Params& p, unsigned char* lds, int qlo, int qhi, int k0 = 0, int k1 = 1 << 20, int first = -1, int stride = 0, int w_in_kind = 3) {
    const int tid = opaque_tid(), nb = stride > 0 ? stride : (int)gridDim.x;
    const int qb = qlo + (first >= 0 ? first : (int)blockIdx.x);
#define TJ_OK(kk) ((kk) < k1 && qb + (kk) * nb < qhi)
    asm volatile("s_waitcnt vmcnt(0)" ::: "memory");
#pragma unroll
    for (int i = 0; i < 3; ++i) if (TJ_OK(k0 + i)) { TJob j; tjob_decode(p, qb + (k0 + i) * nb, j, w_in_kind); tjob_stage(j, tid, lds, i); }
    int b = 0;
#pragma clang loop unroll(disable)
    for (int k = k0; TJ_OK(k); ++k) {
        if (TJ_OK(k + 2)) asm volatile("s_waitcnt vmcnt(10)" ::: "memory");
        else if (TJ_OK(k + 1)) asm volatile("s_waitcnt vmcnt(5)" ::: "memory");
        else asm volatile("s_waitcnt vmcnt(0)" ::: "memory");
        __builtin_amdgcn_s_barrier();
        asm volatile("" ::: "memory");
        if (TJ_OK(k + 3)) { TJob jn; tjob_decode(p, qb + (k + 3) * nb, jn, w_in_kind); tjob_stage(jn, tid, lds, (b + 3) & 3); }
        { TJob j; tjob_decode(p, qb + k * nb, j, w_in_kind); tjob_finish(j, tid, lds, b); }
        b = (b + 1) & 3;
    }
#undef TJ_OK
    __syncthreads();
}
__device__ __forceinline__ void phase0(const Params& p, unsigned char* lds) {
    const int tid = opaque_tid(), nb = gridDim.x, bid = blockIdx.x, wid = tid >> 6, lane = tid & 63;
    { float* z = (float*)(p.ws + OFF_SSQ);
      for (int i = bid * NTHR + tid; i < 3 * T_ + 64; i += nb * NTHR) z[i] = 0.f;
      if (DUP_PHASE >= 2 && DUP_PHASE <= 4) { float* zd = (float*)(p.ws + OFF_SSQ + (OFF_DUMMY - OFF_SSQ)); for (int i = bid * NTHR + tid; i < 3 * T_ + 64; i += nb * NTHR) zd[i] = 0.f; } }
    { bf16_t* wrt = (bf16_t*)(p.ws + OFF_WR);
      for (int i = bid * NTHR + tid; i < 48 * D_; i += nb * NTHR) {
          const int o = i >> 11, k = i & 2047; float v = 0.f;
          if (o < 4) v = p.rgw[k * 4 + o]; else if (o < 36) v = p.rew[k * 32 + (o - 4)];
          wrt[i] = (bf16_t)(cvt_pk_bf16(v * p.g_ffn[k], 0.f) & 0xffffu); } }
    { bf16_t* wsb = (bf16_t*)(p.ws + OFF_WSB);
      for (int i = bid * NTHR + tid; i < 8 * 128 * 128; i += nb * NTHR) { const int r = (i >> 7) & 127, c = i & 127;
          wsb[i] = (bf16_t)(cvt_pk_bf16(((r >> 6) >= (c >> 6)) ? p.gmlp_ws[i] : 0.f, 0.f) & 0xffffu); } }
    { unsigned char* xq = p.ws + OFF_B; float* sx = (float*)(p.ws + OFF_SX);
      f32x4 gn[8];
#pragma unroll
      for (int i = 0; i < 8; ++i) gn[i] = *(const f32x4*)(p.norm_mix_g + i * 256 + lane * 4);
      const int st = nb * 8;
      for (int row0 = bid * 8 + wid; row0 < T_; row0 += 2 * st) {
          f32x4 vv[2][8];
#pragma unroll
          for (int q = 0; q < 2; ++q) { const float* xr = p.x + (size_t)min(row0 + q * st, T_ - 1) * D_;
#pragma unroll
              for (int i = 0; i < 8; ++i) vv[q][i] = *(const f32x4*)(xr + i * 256 + lane * 4); }
#pragma unroll
          for (int q = 0; q < 2; ++q) { const int row = row0 + q * st; if (row < T_) {
              float s = 0.f;
#pragma unroll
              for (int i = 0; i < 8; ++i) s += (vv[q][i][0] * vv[q][i][0] + vv[q][i][1] * vv[q][i][1]) + (vv[q][i][2] * vv[q][i][2] + vv[q][i][3] * vv[q][i][3]);
              const float rstd = rsqrtf(wave_sum(s) * (1.f / D_) + EPS);
              float amax = 0.f;
#pragma unroll
              for (int i = 0; i < 8; ++i) { vv[q][i] = vv[q][i] * rstd * gn[i];
                  amax = fmaxf(amax, fmaxf(fmaxf(fabsf(vv[q][i][0]), fabsf(vv[q][i][1])), fmaxf(fabsf(vv[q][i][2]), fabsf(vv[q][i][3])))); }
#pragma unroll
              for (int o_ = 1; o_ < 64; o_ <<= 1) amax = fmaxf(amax, __shfl_xor(amax, o_));
              amax = fmaxf(amax, 1e-30f); const float qi = 127.f / amax;
              if (lane == 0) sx[row] = amax * (1.f / 127.f);
#pragma unroll
              for (int i = 0; i < 8; ++i) { const int a = (int)rintf(vv[q][i][0] * qi), b = (int)rintf(vv[q][i][1] * qi), c = (int)rintf(vv[q][i][2] * qi), d = (int)rintf(vv[q][i][3] * qi);
                  *(unsigned*)(xq + (size_t)row * D_ + i * 256 + lane * 4) = (unsigned)(a & 255) | ((unsigned)(b & 255) << 8) | ((unsigned)(c & 255) << 16) | ((unsigned)(d & 255) << 24); } } } } }
    run_tjobs(p, lds, 0, N_TJOBS_IN, 0, 1 << 20, -1, 0, 2);
}
__device__ __forceinline__ void phase0b(const Params& p, unsigned char* lds) { run_tjobs(p, lds, 0, N_TJOBS_IN, 0, 1 << 20, -1, 0, 3); }

__device__ __forceinline__ int side_rounds(int nb) { return (N_TJOBS_GU - N_TJOBS_IN + nb - 1) / nb; }
__device__ __forceinline__ void phase1(const Params& p, unsigned char* lds) {
    const Epi1 E{p.ws};
    pg8::StaticOrder S; S.init(T_, DIN, gridDim.x, blockIdx.x); const pg8::AOffDirect AO{D_ / 2};
    const int nu = S.count(), col = blockIdx.x & 3, split = col == 0 ? 0 : col == 1 ? (2 * nu) / 5 : col == 2 ? (3 * nu) / 5 : nu;
    const int kr = side_rounds(gridDim.x), k1 = kr / 2;
    S.i0 = 0; S.i1 = split;
    pg8::gemm_phase<Epi1, pg8::StaticOrder, pg8::AOffDirect, true, 2>((PG8_LAS unsigned char*)lds, (const bf16_t*)(p.ws + OFF_B), (const bf16_t*)(p.ws + OFF_WIN), D_ / 2, S, AO, E);
    run_tjobs(p, lds, N_TJOBS_IN, N_TJOBS_GU, 0, k1);
    S.i0 = split; S.i1 = nu;
    pg8::gemm_phase<Epi1, pg8::StaticOrder, pg8::AOffDirect, true, 2>((PG8_LAS unsigned char*)lds, (const bf16_t*)(p.ws + OFF_B), (const bf16_t*)(p.ws + OFF_WIN), D_ / 2, S, AO, E);
}

struct VRegs { u32x4 v[4]; };
__device__ __forceinline__ void gmlp_load_v(const Params& p, int item, int tid, VRegs& r) {
    const int h = item & 7, t0 = (item >> 3) * 128, j = tid >> 2, dc = (tid & 3) * 32;
    const u32x4* src = (const u32x4*)((const bf16_t*)(p.ws + OFF_A) + (size_t)(t0 + j) * DP + 1024 + h * 128 + dc);
#pragma unroll
    for (int q = 0; q < 4; ++q) r.v[q] = src[q];
}
__device__ __forceinline__ void mixer_gmlp_item(const Params& p, bf16_t* Vt, int item, const VRegs& r, size_t so) {
    const int tid = opaque_tid(), wid = tid >> 6, lane = tid & 63, fr = lane & 15, fq = lane >> 4;
    const int h = item & 7, t0 = (item >> 3) * 128;
    const bf16_t* P = (const bf16_t*)(p.ws + OFF_A); bf16_t* Y = (bf16_t*)(p.ws + OFF_B); float* ssq_a = (float*)(p.ws + OFF_SSQ + so);
    const bf16_t* wsb = (const bf16_t*)(p.ws + OFF_WSB) + (size_t)h * 16384;
    { const int j = tid >> 2, dc = (tid & 3) * 32; float s = 0.f;
#pragma unroll
      for (int q = 0; q < 4; ++q)
#pragma unroll
          for (int w = 0; w < 4; ++w) { const float lo = bflo(r.v[q][w]), hi = bfhi(r.v[q][w]); s += lo * lo + hi * hi; }
      s += __shfl_xor(s, 1); s += __shfl_xor(s, 2);
      const float rs = rsqrtf(s * (1.f / 128.f) + EPS);
#pragma unroll
      for (int q = 0; q < 4; ++q)
#pragma unroll
          for (int w = 0; w < 4; ++w) { const int d = dc + q * 8 + w * 2; const unsigned pk = cvt_pk_bf16(bflo(r.v[q][w]) * rs, bfhi(r.v[q][w]) * rs);
              Vt[d * 136 + j] = (bf16_t)(pk & 0xffffu); Vt[(d + 1) * 136 + j] = (bf16_t)(pk >> 16); } }
    const int i = 16 * wid + fr, t = t0 + i; const float bias = p.gmlp_bs[h * 128 + i];
    u32x2 uu[8];
#pragma unroll
    for (int n = 0; n < 8; ++n) uu[n] = *(const u32x2*)(P + (size_t)t * DP + h * 128 + 16 * n + 4 * fq);
    const int ksteps = (wid < 4) ? 2 : 4;
    bf16x8 bw[4];
#pragma unroll
    for (int ks = 0; ks < 4; ++ks) bw[ks] = *(const bf16x8*)(wsb + (16 * wid + fr) * 128 + ks * 32 + fq * 8);
    __syncthreads();
    f32x4 acc[8];
#pragma unroll
    for (int n = 0; n < 8; ++n) acc[n] = (f32x4){0.f, 0.f, 0.f, 0.f};
#pragma unroll
    for (int ks = 0; ks < 4; ++ks) { if (ks < ksteps) {
#pragma unroll
        for (int n = 0; n < 8; ++n) { const bf16x8 av = *(const bf16x8*)(Vt + (16 * n + fr) * 136 + ks * 32 + fq * 8);
            acc[n] = __builtin_amdgcn_mfma_f32_16x16x32_bf16(av, bw[ks], acc[n], 0, 0, 0); } } }
    float ss = 0.f; f32x4 gv[8];
#pragma unroll
    for (int n = 0; n < 8; ++n) gv[n] = *(const f32x4*)(p.v_norm_g + h * 128 + 16 * n + 4 * fq);
#pragma unroll
    for (int n = 0; n < 8; ++n) { const int c = h * 128 + 16 * n + 4 * fq;
        const f32x4 g = gv[n];
        const float y0 = bflo(uu[n].x) * (acc[n][0] * g[0] + bias), y1 = bfhi(uu[n].x) * (acc[n][1] * g[1] + bias), y2 = bflo(uu[n].y) * (acc[n][2] * g[2] + bias), y3 = bfhi(uu[n].y) * (acc[n][3] * g[3] + bias);
        ss += (y0 * y0 + y1 * y1) + (y2 * y2 + y3 * y3);
        u32x2 w; w.x = cvt_pk_bf16(y0, y1); w.y = cvt_pk_bf16(y2, y3); *(u32x2*)(Y + (size_t)t * D_ + c) = w; }
    ss += __shfl_xor(ss, 16); ss += __shfl_xor(ss, 32);
    if (fq == 0) atomicAdd(ssq_a + t, ss);
}
__device__ __forceinline__ void mixer_conv_item(const Params& p, int item, size_t so) {
    const int tid = opaque_tid(), cl = tid & 31, ts = tid >> 5;
    const int c = (item & 3) * 256 + cl * 8, tbeg = (item >> 2) * 128 + ts * 8;
    const bf16_t* P = (const bf16_t*)(p.ws + OFF_A); bf16_t* Y = (bf16_t*)(p.ws + OFF_B); float* ssq_b = (float*)(p.ws + OFF_SSQ + so) + T_;
    float w0[8], w1[8], w2[8], z1[8], z2[8];
    { const f32x4 a0 = *(const f32x4*)(p.conv_w + c), a1 = *(const f32x4*)(p.conv_w + c + 4), b0 = *(const f32x4*)(p.conv_w + 1024 + c), b1 = *(const f32x4*)(p.conv_w + 1024 + c + 4),
                  c0 = *(const f32x4*)(p.conv_w + 2048 + c), c1 = *(const f32x4*)(p.conv_w + 2048 + c + 4);
#pragma unroll
      for (int q = 0; q < 4; ++q) { w0[q] = a0[q]; w0[4 + q] = a1[q]; w1[q] = b0[q]; w1[4 + q] = b1[q]; w2[q] = c0[q]; w2[4 + q] = c1[q]; } }
#pragma unroll
    for (int q = 0; q < 8; ++q) { z1[q] = 0.f; z2[q] = 0.f; }
    if ((tbeg % SEQ) != 0) {
        const u32x4 za = *(const u32x4*)(P + (size_t)(tbeg - 1) * DP + 3072 + c), zb = *(const u32x4*)(P + (size_t)(tbeg - 2) * DP + 3072 + c);
#pragma unroll
        for (int q = 0; q < 4; ++q) { z1[2 * q] = bflo(za[q]); z1[2 * q + 1] = bfhi(za[q]); z2[2 * q] = bflo(zb[q]); z2[2 * q + 1] = bfhi(zb[q]); }
    }
    u32x4 bgA[8], zA[8];
#pragma unroll
    for (int tt = 0; tt < 8; ++tt) { const bf16_t* pr = P + (size_t)(tbeg + tt) * DP + c; bgA[tt] = *(const u32x4*)(pr + 2048); zA[tt] = *(const u32x4*)(pr + 3072); }
#pragma unroll
    for (int tt = 0; tt < 8; ++tt) {
        const int t = tbeg + tt;
        const u32x4 bg = bgA[tt], zv = zA[tt];
        float z[8], y[8], ss = 0.f;
#pragma unroll
        for (int q = 0; q < 4; ++q) { z[2 * q] = bflo(zv[q]); z[2 * q + 1] = bfhi(zv[q]); }
#pragma unroll
        for (int q = 0; q < 4; ++q) {
            y[2 * q] = bflo(bg[q]) * (w0[2 * q] * z2[2 * q] + w1[2 * q] * z1[2 * q] + w2[2 * q] * z[2 * q]);
            y[2 * q + 1] = bfhi(bg[q]) * (w0[2 * q + 1] * z2[2 * q + 1] + w1[2 * q + 1] * z1[2 * q + 1] + w2[2 * q + 1] * z[2 * q + 1]); }
#pragma unroll
        for (int q = 0; q < 8; ++q) { ss += y[q] * y[q]; z2[q] = z1[q]; z1[q] = z[q]; }
        u32x4 w; w.x = cvt_pk_bf16(y[0], y[1]); w.y = cvt_pk_bf16(y[2], y[3]); w.z = cvt_pk_bf16(y[4], y[5]); w.w = cvt_pk_bf16(y[6], y[7]);
        *(u32x4*)(Y + (size_t)t * D_ + 1024 + c) = w;
        ss += __shfl_xor(ss, 1); ss += __shfl_xor(ss, 2); ss += __shfl_xor(ss, 4); ss += __shfl_xor(ss, 8); ss += __shfl_xor(ss, 16);
        if (cl == 0) atomicAdd(ssq_b + t, ss);
    }
}
__device__ __forceinline__ void phase2(const Params& p, unsigned char* lds, size_t so = 0) {
    const int nb = gridDim.x, bid = blockIdx.x, tid = opaque_tid();
    for (int it = bid; it < 512; it += nb) mixer_conv_item(p, it, so);
    bf16_t* Vt0 = (bf16_t*)lds; bf16_t* Vt1 = Vt0 + 128 * 136;
    VRegs ra, rb; int it = bid; bool ha = it < 1024, hb_ = it + nb < 1024;
    if (ha) gmlp_load_v(p, it, tid, ra);
    while (ha) {
        if (hb_) gmlp_load_v(p, it + nb, tid, rb);
        mixer_gmlp_item(p, Vt0, it, ra, so);
        if (!hb_) break;
        it += 2 * nb; ha = it < 1024;
        if (ha) gmlp_load_v(p, it, tid, ra);
        mixer_gmlp_item(p, Vt1, it - nb, rb, so);
        hb_ = it + nb < 1024;
    }
    __syncthreads();
}

__device__ __forceinline__ void phase3(const Params& p, unsigned char* lds, size_t so = 0) {
    pg8::StaticOrder S; S.init(T_, D_, gridDim.x, blockIdx.x); const pg8::AOffDirect AO{D_};
    PG8_LAS float* rsl = (PG8_LAS float*)((PG8_LAS unsigned char*)lds + RS_OFF);
    { const float* ssq = (const float*)(p.ws + OFF_SSQ); const int tid = opaque_tid();
      for (int i = 0; i < RS_UNITS; ++i) { Unit u; if (!S.next(i, u)) break;
          if (tid < 256) { const int row = u.pm * 256 + tid; const float va = ssq[row] * (1.f / 1024.f) + EPS, vb = ssq[T_ + row] * (1.f / 1024.f) + EPS;
              rsl[(i * 256 + tid) * 2] = __builtin_amdgcn_sqrtf(vb * __builtin_amdgcn_rcpf(va)); rsl[(i * 256 + tid) * 2 + 1] = __builtin_amdgcn_rsqf(vb); } }
      __syncthreads(); }
    const Epi2 E{p.x, p.ws, so, rsl};
    const int kr = side_rounds(gridDim.x), k0 = kr / 2; const bool side = (so == 0);
    const int col = blockIdx.x & 1, km = col ? kr : k0;
    if (side) run_tjobs(p, lds, N_TJOBS_IN, N_TJOBS_GU, k0, km);
    pg8::gemm_phase<Epi2, pg8::StaticOrder, pg8::AOffDirect, true>((PG8_LAS unsigned char*)lds, (const bf16_t*)(p.ws + OFF_B), (const bf16_t*)(p.ws + OFF_WOUT), D_, S, AO, E);
    if (side) run_tjobs(p, lds, N_TJOBS_IN, N_TJOBS_GU, km, kr);
}

__device__ __forceinline__ void route_item(const Params& p, unsigned char* lds, int item, size_t so) {
    const int tid = opaque_tid(), wid = tid >> 6, lane = tid & 63, fr = lane & 15, fq = lane >> 4;
    float* lg = (float*)lds;
    float* ls = lg + 8 * 64 * 48;
    int* lcnt = (int*)(ls + 64 * 48); int* lbase = lcnt + 32;
    const bf16_t* hb = (const bf16_t*)(p.ws + OFF_HB); const bf16_t* wrt = (const bf16_t*)(p.ws + OFF_WR);
    const float* ssq_h = (const float*)(p.ws + OFF_SSQ) + 2 * T_;
    int* cnt = (int*)(p.ws + OFF_CNT + so); int* rinfo = (int*)(p.ws + OFF_RINFO + so); float* rw = (float*)(p.ws + OFF_RW + so);
    const int t0 = item * 64;
    if (tid < 32) lcnt[tid] = 0;
    f32x4 acc[4][3];
#pragma unroll
    for (int m = 0; m < 4; ++m)
#pragma unroll
        for (int n = 0; n < 3; ++n) acc[m][n] = (f32x4){0.f, 0.f, 0.f, 0.f};
    const bf16_t* ap = hb + (size_t)(t0 + fr) * D_ + wid * 256 + fq * 8; const bf16_t* bp = wrt + (size_t)fr * D_ + wid * 256 + fq * 8;
#pragma unroll 4
    for (int ks = 0; ks < 8; ++ks) {
        bf16x8 a[4], b[3];
#pragma unroll
        for (int m = 0; m < 4; ++m) a[m] = *(const bf16x8*)(ap + (size_t)m * 16 * D_ + ks * 32);
#pragma unroll
        for (int n = 0; n < 3; ++n) b[n] = *(const bf16x8*)(bp + (size_t)n * 16 * D_ + ks * 32);
#pragma unroll
        for (int m = 0; m < 4; ++m)
#pragma unroll
            for (int n = 0; n < 3; ++n) acc[m][n] = __builtin_amdgcn_mfma_f32_16x16x32_bf16(a[m], b[n], acc[m][n], 0, 0, 0);
    }
#pragma unroll
    for (int m = 0; m < 4; ++m)
#pragma unroll
        for (int n = 0; n < 3; ++n)
#pragma unroll
            for (int j = 0; j < 4; ++j) lg[(wid * 64 + m * 16 + 4 * fq + j) * 48 + 16 * n + fr] = acc[m][n][j];
    __syncthreads();
    for (int i = tid; i < 64 * 48; i += NTHR) { float v = 0.f;
#pragma unroll
        for (int w = 0; w < 8; ++w) v += lg[w * 64 * 48 + i];
        ls[i] = v; }
    __syncthreads();
    int e0 = 0, e1 = 0, r0 = 0, r1 = 0; float g0 = 0.f, g1 = 0.f, rsc = 0.f; const int t = t0 + tid;
    if (tid < 64) {
        const float* l0 = ls + tid * 48; const float rstd = rsqrtf(ssq_h[t] * (1.f / D_) + EPS); rsc = rstd * (1.f / WGU_SCALE);
        float gm = -3.0e38f; int gi = 0; float gl[4];
#pragma unroll
        for (int o = 0; o < 4; ++o) { gl[o] = l0[o] * rstd + p.rgb[o]; if (gl[o] > gm) { gm = gl[o]; gi = o; } }
        float gs = 0.f;
#pragma unroll
        for (int o = 0; o < 4; ++o) gs += __expf(gl[o] - gm);
        const float pg = 1.f / gs;
        float b1 = -3.0e38f, b2 = -3.0e38f; int i1 = 0, i2 = 0;
        for (int q = 0; q < 8; ++q) { const float v = l0[4 + gi * 8 + q] * rstd + p.reb[gi * 8 + q];
            if (v > b1) { b2 = b1; i2 = i1; b1 = v; i1 = q; } else if (v > b2) { b2 = v; i2 = q; } }
        const float wa = 1.f / (1.f + __expf(b2 - b1));
        e0 = gi * 8 + i1; e1 = gi * 8 + i2; g0 = pg * wa; g1 = pg * (1.f - wa);
        r0 = atomicAdd(&lcnt[e0], 1); r1 = atomicAdd(&lcnt[e1], 1);
    }
    __syncthreads();
    if (tid < 32) lbase[tid] = atomicAdd(cnt + tid, lcnt[tid]);
    __syncthreads();
    if (tid < 64) { const int i0 = lbase[e0] + r0, i1 = lbase[e1] + r1;
        rinfo[e0 * LCAP + i0] = (int)((cvt_pk_bf16(g0, 0.f) << 16) | (unsigned)(2 * t)); rinfo[e1 * LCAP + i1] = (int)((cvt_pk_bf16(g1, 0.f) << 16) | (unsigned)(2 * t + 1));
        rw[e0 * LCAP + i0] = rsc; rw[e1 * LCAP + i1] = rsc; }
    __syncthreads();
}
__device__ __forceinline__ void phase4(const Params& p, unsigned char* lds, size_t so = 0) { for (int it = blockIdx.x; it < T_ / 64; it += gridDim.x) route_item(p, lds, it, so); }

__device__ __forceinline__ int moe_slot() { const int G = gridDim.x, c = blockIdx.x; return (G & 7) ? c : (c & 7) * (G >> 3) + (c >> 3); }
__device__ __forceinline__ PG8_LAS int* moe_tables_to_lds(const Params& p, unsigned char* lds, bool build) {
    PG8_LAS int* tb = (PG8_LAS int*)((PG8_LAS unsigned char*)lds + LCNT_OFF); const int* cnt = (const int*)(p.ws + OFF_CNT);
    if (!build) return tb;
    if (threadIdx.x < 64) {
        const int e = threadIdx.x, c = (e < NE) ? __hip_atomic_load(cnt + e, __ATOMIC_RELAXED, __HIP_MEMORY_SCOPE_AGENT) : 0, nt = (c + 255) >> 8;
        int inc = nt;
#pragma unroll
        for (int o = 1; o < 64; o <<= 1) { const int v = __shfl_up(inc, o); if (e >= o) inc += v; }
        const int pst = inc - nt;
        if (e < NE) { tb[MT_CNT + e] = c; tb[MT_PST + e] = pst;
#pragma clang loop unroll(disable)
            for (int i = 0; i < nt; ++i) tb[MT_T2E + pst + i] = e; }
        if (e == NE) { tb[MT_PST + NE] = pst; tb[MT_NT] = pst; }
    }
    __syncthreads();
    return tb;
}
__device__ __forceinline__ void phase5(const Params& p, unsigned char* lds) {
    PG8_LAS int* lc = moe_tables_to_lds(p, lds, true);
    const Epi5 E{p.ws, lc};
    const int cx = moe_slot();
    const pg8::MoeOrder S{lc, 4, (int)gridDim.x, cx}; const pg8::AOffGather AO{p.ws, lc, D_ / 2};
    pg8::gemm_phase<Epi5, pg8::MoeOrder, pg8::AOffGather, true, 1>((PG8_LAS unsigned char*)lds, (const bf16_t*)(p.ws + OFF_H8), (const bf16_t*)(p.ws + OFF_WGU), D_ / 2, S, AO, E);
    { const int G = gridDim.x, c = cx, U = 4 * __builtin_amdgcn_readfirstlane(lc[MT_NT]), rem = U % G, idle = G - rem, NJ = N_TJOBS - N_TJOBS_GU;
      const int per = rem == 0 ? 0 : min(32, (NJ + idle - 1) / idle), early = min(NJ, idle * per);
      if (rem != 0 && c >= rem) run_tjobs(p, lds, N_TJOBS_GU, N_TJOBS_GU + early, 0, per, c - rem, idle);
      if (early < NJ) run_tjobs(p, lds, N_TJOBS_GU + early, N_TJOBS, 0, 1 << 20, c, G); }
}
__device__ __forceinline__ void phase6(const Params& p, unsigned char* lds) {
    PG8_LAS int* lc = moe_tables_to_lds(p, lds, DUP_PHASE == 6);
    const Epi6 E{p.ws, lc};
    const pg8::MoeOrder S{lc, 8, (int)gridDim.x, moe_slot()}; const pg8::AOffDirect AO{DE / 2};
    pg8::gemm_phase<Epi6, pg8::MoeOrder, pg8::AOffDirect, true, 1>((PG8_LAS unsigned char*)lds, (const bf16_t*)(p.ws + OFF_B), (const bf16_t*)(p.ws + OFF_WD), DE / 2, S, AO, E);
}
struct R7 { u32x4 a[4]; u32x2 b[4], d[4]; };
__device__ __forceinline__ void p7_load(const Params& p, int t, int lane, R7& r) {
    const bf16_t* hb = (const bf16_t*)(p.ws + OFF_HB); const unsigned char* ys2 = p.ws + OFF_A;
#pragma unroll
    for (int i = 0; i < 4; ++i) { const int c = i * 512 + lane * 8;
        r.a[i] = *(const u32x4*)(hb + (size_t)t * D_ + c); r.b[i] = *(const u32x2*)(ys2 + (size_t)(2 * t) * D_ + c); r.d[i] = *(const u32x2*)(ys2 + (size_t)(2 * t + 1) * D_ + c); }
}
struct G7 { f32x4 g[4][2]; };
__device__ __forceinline__ void p7_row(const Params& p, int t, int lane, const R7& r, const G7& gg) {
    float v[4][8]; float s = 0.f;
#pragma unroll
    for (int i = 0; i < 4; ++i) { const u32x4 a = r.a[i]; const u32x2 b = r.b[i], d = r.d[i];
        float y0[8], y1[8];
        up4_fp8(b.x, y0[0], y0[1], y0[2], y0[3]); up4_fp8(b.y, y0[4], y0[5], y0[6], y0[7]); up4_fp8(d.x, y1[0], y1[1], y1[2], y1[3]); up4_fp8(d.y, y1[4], y1[5], y1[6], y1[7]);
#pragma unroll
        for (int q = 0; q < 4; ++q) { v[i][2 * q] = bflo(a[q]) + (y0[2 * q] + y1[2 * q]) * (1.f / YS_SCALE); v[i][2 * q + 1] = bfhi(a[q]) + (y0[2 * q + 1] + y1[2 * q + 1]) * (1.f / YS_SCALE);
            s += v[i][2 * q] * v[i][2 * q] + v[i][2 * q + 1] * v[i][2 * q + 1]; } }
    const float rstd = rsqrtf(wave_sum(s) * (1.f / D_) + EPS);
#pragma unroll
    for (int i = 0; i < 4; ++i) { const int c = i * 512 + lane * 8;
        const f32x4 g0 = gg.g[i][0], g1 = gg.g[i][1];
        f32x4 o0, o1;
#pragma unroll
        for (int q = 0; q < 4; ++q) { o0[q] = v[i][q] * rstd * g0[q]; o1[q] = v[i][4 + q] * rstd * g1[q]; }
        *(f32x4*)(p.out + (size_t)t * D_ + c) = o0; *(f32x4*)(p.out + (size_t)t * D_ + c + 4) = o1; }
}
__device__ __forceinline__ void phase7(const Params& p) {
    const int tid = opaque_tid(), wid = tid >> 6, lane = tid & 63, st = gridDim.x * 8;
    G7 gg;
#pragma unroll
    for (int i = 0; i < 4; ++i) { gg.g[i][0] = *(const f32x4*)(p.g_final + i * 512 + lane * 8); gg.g[i][1] = *(const f32x4*)(p.g_final + i * 512 + lane * 8 + 4); }
    for (int t = blockIdx.x * 8 + wid; t < T_; t += 4 * st) {
        R7 r[4];
#pragma unroll
        for (int q = 0; q < 4; ++q) p7_load(p, min(t + q * st, T_ - 1), lane, r[q]);
#pragma unroll
        for (int q = 0; q < 4; ++q) if (t + q * st < T_) p7_row(p, t + q * st, lane, r[q], gg);
    }
}

__global__ void __launch_bounds__(NTHR, 2) k_mega(Params p) {
    extern __shared__ __attribute__((aligned(16))) unsigned char lds[];
    cg::grid_group grid = cg::this_grid();
    volatile PG8_LAS unsigned* bst = (volatile PG8_LAS unsigned*)((PG8_LAS unsigned char*)lds + LBAR_OFF);
    if (threadIdx.x < 2) bst[threadIdx.x] = 0u;
    __syncthreads();
    (void)xcd_barrier_post((unsigned*)(p.ws + OFF_BAR), bst);
#define GRID_BAR() do { XcdBarrier b_; b_.bar = (unsigned*)(opaque_ws(p.ws) + OFF_BAR); b_.x = xb_xcc_id(); b_.st = bst; xcd_barrier(b_); } while (0)
    if (DUP_PHASE == 0) { phase0(p, lds); GRID_BAR(); phase0b(p, lds); GRID_BAR(); }
    if (p.ws == nullptr) grid.sync();
    phase0(p, lds); GRID_BAR();
    phase0b(p, lds); GRID_BAR();
    if (DUP_PHASE == 1) { phase1(p, lds); GRID_BAR(); }
    phase1(p, lds); GRID_BAR();
    if (DUP_PHASE == 2) { phase2(p, lds, OFF_DUMMY - OFF_SSQ); GRID_BAR(); }
    phase2(p, lds); GRID_BAR();
    if (DUP_PHASE == 3) { phase3(p, lds, OFF_DUMMY - OFF_SSQ); GRID_BAR(); }
    phase3(p, lds); GRID_BAR();
    if (DUP_PHASE == 4) { phase4(p, lds, OFF_DUMMY - OFF_SSQ); GRID_BAR(); }
    phase4(p, lds); GRID_BAR();
    if (DUP_PHASE == 5) { phase5(p, lds); GRID_BAR(); }
    phase5(p, lds); GRID_BAR();
    if (DUP_PHASE == 6) { phase6(p, lds); GRID_BAR(); }
    phase6(p, lds); GRID_BAR();
    if (DUP_PHASE == 8) { for (int i = 0; i < 10; ++i) GRID_BAR(); }
    if (DUP_PHASE == 9) { grid.sync(); grid.sync(); }
    if (DUP_PHASE == 7) { phase7(p); GRID_BAR(); }
    phase7(p);
}

extern "C" void kernel_launch(void* const* d_in, const int* in_sizes, int n_in, void* d_out, int out_size, void* d_ws, size_t ws_size, hipStream_t stream) {
    static int grid = 0;
    if (grid == 0) {
        if (n_in != 19 || in_sizes[0] != T_ * D_ || out_size != T_ * D_ || ws_size < WS_END + (DUP_PHASE >= 2 && DUP_PHASE <= 4 ? DUMMY_BYTES : 0)) { fprintf(stderr, "kernel_launch: unexpected shapes (n_in %d, in0 %d, out %d, ws %zu < %zu); nothing launched\n", n_in, n_in > 0 ? in_sizes[0] : -1, out_size, ws_size, (size_t)WS_END); grid = -1; return; }
        int dev = 0, cus = 0, per_cu = 0;
        if (hipGetDevice(&dev) != hipSuccess || hipDeviceGetAttribute(&cus, hipDeviceAttributeMultiprocessorCount, dev) != hipSuccess) { grid = -1; return; }
        if (hipFuncSetAttribute((const void*)k_mega, hipFuncAttributeMaxDynamicSharedMemorySize, LDS_BYTES) != hipSuccess) { fprintf(stderr, "kernel_launch: hipFuncSetAttribute failed\n"); grid = -1; return; }
        if (hipOccupancyMaxActiveBlocksPerMultiprocessor(&per_cu, (const void*)k_mega, NTHR, LDS_BYTES) != hipSuccess || per_cu < 1) { fprintf(stderr, "kernel_launch: occupancy query says %d blocks per CU\n", per_cu); grid = -1; return; }
        grid = cus * per_cu;
    }
    if (grid < 0) return;
    Params p{};
    const float** f = (const float**)&p;
    for (int i = 0; i < 19; ++i) f[i] = (const float*)d_in[i];
    p.out = (float*)d_out; p.ws = (unsigned char*)d_ws;
    if (hipMemsetAsync((unsigned char*)d_ws + OFF_BAR, 0, BAR_BYTES, stream) != hipSuccess) { fprintf(stderr, "kernel_launch: memset of the barrier words failed\n"); return; }
    void* args[] = {&p};
    const hipError_t e = hipLaunchCooperativeKernel((const void*)k_mega, dim3(grid), dim3(NTHR), args, LDS_BYTES, stream);
    if (e != hipSuccess) fprintf(stderr, "kernel_launch: cooperative launch failed: %s (grid %d)\n", hipGetErrorString(e), grid);
}
```
